# Optimizing an MI355X kernel written in HIP

```python
import jax
import jax.numpy as jnp
from jax import lax
import numpy as np

D_MODEL = 1024
BATCH = 32
SEQ = 2048
DEPTH = 1

GRID_W = 64
CTX_LEN = 256
N_MOD = 6
F_GROUPS = 4
F_GROUP_DIM = 128
F_WIDTH = F_GROUPS * F_GROUP_DIM
HG_HEADS = 4
HG_DK = 128
HG_DV = 128
HG_KEY_WIDTH = HG_HEADS * HG_DK
HG_WIDTH = HG_HEADS * HG_DV
CHUNK = 64
N_BRANCHES = 2
SPLIT_POINTS = (F_WIDTH, F_WIDTH + HG_KEY_WIDTH, F_WIDTH + 2 * HG_KEY_WIDTH, F_WIDTH + 3 * HG_KEY_WIDTH, F_WIDTH + 3 * HG_KEY_WIDTH + HG_WIDTH, F_WIDTH + 3 * HG_KEY_WIDTH + 2 * HG_WIDTH)
IN_WIDTH = SPLIT_POINTS[-1] + N_BRANCHES * D_MODEL
N_EXPERTS = 32
TOP_K = 4
D_EXPERT = D_MODEL
SWIGLU_LIMIT = 7.0
SWIGLU_ALPHA = 1.702
MOE_BLOCK = 256
DEEPNORM_ALPHA = (2.0 * DEPTH) ** 0.25
DEEPNORM_BETA = (8.0 * DEPTH) ** -0.25
LN_EPS = 1e-5
RMS_EPS = 1e-6

kernel_name = 'hybrid_fourier_hgrn2_moe_dit_block'


def _layer_norm(x, g, b):
    xf = x.astype(jnp.float32)
    mu = jnp.mean(xf, axis=-1, keepdims=True)
    xc = xf - mu
    var = jnp.mean(xc * xc, axis=-1, keepdims=True)
    return (xc * lax.rsqrt(var + LN_EPS) * g.astype(jnp.float32) + b.astype(jnp.float32)).astype(x.dtype)


def _split_in(p):
    return jnp.split(p, SPLIT_POINTS, axis=-1)


def _fourier_latent(t):
    b, length, _ = t.shape
    rows = length // GRID_W
    g = t.astype(jnp.float32).reshape(b, rows, GRID_W, F_GROUPS, F_GROUP_DIM)
    y = jnp.fft.fftn(g, axes=(1, 2, 4), norm='ortho').real
    return y.reshape(b, length, F_WIDTH).astype(t.dtype)


def _fourier_context(t):
    b, length, _ = t.shape
    g = t.astype(jnp.float32).reshape(b, length, F_GROUPS, F_GROUP_DIM)
    y = jnp.fft.fftn(g, axes=(1, 3), norm='ortho').real
    return y.reshape(b, length, F_WIDTH).astype(t.dtype)


def _to_heads(t, d):
    b, length, _ = t.shape
    return t.reshape(b, length, HG_HEADS, d).transpose(0, 2, 1, 3)


def _forget_gate(z, lb):
    f = lb + (1.0 - lb) * jax.nn.sigmoid(z.astype(jnp.float32))
    return _to_heads(1.0 - f, HG_DK), _to_heads(jnp.log(f), HG_DK)


def _gla_chunked(q, k, v, log_f, s0):
    b, h, length, dk = q.shape
    dv = v.shape[-1]
    n = length // CHUNK
    q, k, log_f = (t.reshape(b, h, n, CHUNK, dk) for t in (q, k, log_f))
    v = v.reshape(b, h, n, CHUNK, dv)
    cum = jnp.cumsum(log_f, axis=3)
    cum_last = cum[:, :, :, -1:, :]
    q_dec = q * jnp.exp(cum)
    k_inv = k * jnp.exp(-cum)
    k_end = k * jnp.exp(cum_last - cum)
    scores = jnp.einsum('bhncd,bhnsd->bhncs', q_dec, k_inv)
    tri = jnp.tril(jnp.ones((CHUNK, CHUNK), dtype=bool))
    scores = jnp.where(tri, scores, 0.0)
    o_intra = jnp.einsum('bhncs,bhnse->bhnce', scores, v)
    chunk_decay = jnp.exp(cum_last[:, :, :, 0, :])

    def step(state, inp):
        q_c, k_c, v_c, g_c = inp
        o_c = jnp.einsum('bhcd,bhde->bhce', q_c, state)
        state = g_c[..., None] * state + jnp.einsum('bhcd,bhce->bhde', k_c, v_c)
        return state, o_c

    xs = tuple(jnp.moveaxis(t, 2, 0) for t in (q_dec, k_end, v, chunk_decay))
    s_final, o_inter = lax.scan(step, s0, xs)
    o = o_intra + jnp.moveaxis(o_inter, 0, 2)
    return o.reshape(b, h, length, dv), s_final


def _hgrn2_bidir(pq, pzf, pzb, pv, lb, s0_f, s0_b):
    q = _to_heads(jax.nn.silu(pq.astype(jnp.float32)), HG_DK)
    v = _to_heads(pv.astype(jnp.float32), HG_DV)
    k_f, lf_f = _forget_gate(pzf, lb[0])
    k_b, lf_b = _forget_gate(pzb, lb[1])
    o_f, s_f = _gla_chunked(q, k_f, v, lf_f, s0_f)
    rev = lambda t: jnp.flip(t, axis=2)
    o_b, s_b = _gla_chunked(rev(q), rev(k_b), rev(v), rev(lf_b), s0_b)
    return o_f + rev(o_b), s_f, s_b


def _hgrn2_readout(o, pg, norm_g):
    b, _, length, _ = o.shape
    o = o.transpose(0, 2, 1, 3)
    o = o * lax.rsqrt(jnp.mean(o * o, axis=-1, keepdims=True) + RMS_EPS) * norm_g.astype(jnp.float32).reshape(HG_HEADS, HG_DV)
    y = o.reshape(b, length, HG_WIDTH) * jax.nn.silu(pg.astype(jnp.float32))
    return y.astype(pg.dtype)


def _merge(y_f, y_h, gates, w_fo, w_ho, w_o):
    g_f, g_h = jnp.split(gates, N_BRANCHES, axis=-1)
    m = jax.nn.sigmoid(g_f) * (y_f @ w_fo) + jax.nn.sigmoid(g_h) * (y_h @ w_ho)
    return m @ w_o


def _moe(h, w_router, b_router, w_gu, b_gu, w_down, b_down):
    n_tok, d = h.shape
    logits = (h @ w_router).astype(jnp.float32) + b_router.astype(jnp.float32)
    top_val, top_idx = lax.top_k(logits, TOP_K)
    top_w = jax.nn.softmax(top_val, axis=-1)
    n_asg = n_tok * TOP_K
    e_flat = top_idx.reshape(n_asg)
    order = jnp.argsort(e_flat)
    e_sorted = e_flat[order]
    tok_sorted = (order // TOP_K).astype(jnp.int32)
    w_sorted = top_w.reshape(n_asg)[order]
    counts = jnp.bincount(e_flat, length=N_EXPERTS)
    starts = jnp.cumsum(counts) - counts
    padded = (counts + MOE_BLOCK - 1) // MOE_BLOCK * MOE_BLOCK
    pad_ends = jnp.cumsum(padded)
    dest = pad_ends[e_sorted] - padded[e_sorted] + jnp.arange(n_asg) - starts[e_sorted]
    n_blocks = -(-n_asg // MOE_BLOCK) + N_EXPERTS
    n_rows = n_blocks * MOE_BLOCK
    row_tok = jnp.full((n_rows,), n_tok, dtype=jnp.int32).at[dest].set(tok_sorted)
    row_w = jnp.zeros((n_rows,), jnp.float32).at[dest].set(w_sorted)
    block_expert = jnp.minimum(jnp.searchsorted(pad_ends, jnp.arange(n_blocks) * MOE_BLOCK, side='right'), N_EXPERTS - 1)
    h_pad = jnp.concatenate([h, jnp.zeros((1, d), h.dtype)], axis=0)

    def expert_block(args):
        toks, e = args
        gu = h_pad[toks] @ w_gu[e] + b_gu[e]
        gate, up = jnp.split(gu, 2, axis=-1)
        gate = jnp.minimum(gate, SWIGLU_LIMIT)
        up = jnp.clip(up, -SWIGLU_LIMIT, SWIGLU_LIMIT)
        act = (up + 1.0) * gate * jax.nn.sigmoid(SWIGLU_ALPHA * gate)
        return act @ w_down[e] + b_down[e]

    out = lax.map(expert_block, (row_tok.reshape(n_blocks, MOE_BLOCK), block_expert))
    out = out.reshape(n_rows, d).astype(jnp.float32) * row_w[:, None]
    y = jax.ops.segment_sum(out, row_tok, num_segments=n_tok + 1)[:n_tok]
    return y.astype(h.dtype)


def setup_inputs(seed: int = 0) -> dict:
    key = jax.random.key(seed)
    ks = jax.random.split(key, 24)
    nrm = lambda k, shape, scale: jax.random.normal(k, shape, jnp.float32) * scale
    return {
        'x': nrm(ks[0], (BATCH, SEQ, D_MODEL), 1.0),
        'c': nrm(ks[1], (BATCH, D_MODEL), 1.0),
        'ctx': nrm(ks[2], (BATCH, CTX_LEN, D_MODEL), 1.0),
        'c_ctx': nrm(ks[3], (D_MODEL,), 1.0),
        'w_ada': nrm(ks[4], (DEPTH, D_MODEL, N_MOD * D_MODEL), 0.5 * D_MODEL ** -0.5),
        'b_ada': nrm(ks[5], (DEPTH, N_MOD * D_MODEL), 0.02),
        'w_in': nrm(ks[6], (DEPTH, D_MODEL, IN_WIDTH), D_MODEL ** -0.5),
        'lb_raw': nrm(ks[7], (DEPTH + 1, 2, HG_KEY_WIDTH), 0.1),
        'hg_norm_g': 1.0 + nrm(ks[8], (DEPTH, HG_WIDTH), 0.02),
        'w_four_out': nrm(ks[9], (DEPTH, F_WIDTH, D_MODEL), F_WIDTH ** -0.5),
        'w_hg_out': nrm(ks[10], (DEPTH, HG_WIDTH, D_MODEL), HG_WIDTH ** -0.5),
        'w_o': nrm(ks[11], (DEPTH, D_MODEL, D_MODEL), DEEPNORM_BETA * D_MODEL ** -0.5),
        'ln1_g': 1.0 + nrm(ks[12], (DEPTH, D_MODEL), 0.02),
        'ln1_b': nrm(ks[13], (DEPTH, D_MODEL), 0.02),
        'w_router': nrm(ks[14], (DEPTH, D_MODEL, N_EXPERTS), D_MODEL ** -0.5),
        'b_router': nrm(ks[15], (DEPTH, N_EXPERTS), 0.01),
        'w_gate_up': nrm(ks[16], (DEPTH, N_EXPERTS, D_MODEL, 2 * D_EXPERT), D_MODEL ** -0.5),
        'b_gate_up': nrm(ks[17], (DEPTH, N_EXPERTS, 2 * D_EXPERT), 0.02),
        'w_down': nrm(ks[18], (DEPTH, N_EXPERTS, D_EXPERT, D_MODEL), DEEPNORM_BETA * D_EXPERT ** -0.5),
        'b_down': nrm(ks[19], (DEPTH, N_EXPERTS, D_MODEL), 0.02),
        'ln2_g': 1.0 + nrm(ks[20], (DEPTH, D_MODEL), 0.02),
        'ln2_b': nrm(ks[21], (DEPTH, D_MODEL), 0.02),
    }


def reference(x, c, ctx, c_ctx, w_ada, b_ada, w_in, lb_raw, hg_norm_g, w_four_out, w_hg_out, w_o, ln1_g, ln1_b, w_router, b_router, w_gate_up, b_gate_up, w_down, b_down, ln2_g, ln2_b):
    b = x.shape[0]
    lower_bounds = jnp.cumsum(jax.nn.softmax(lb_raw.astype(jnp.float32), axis=0), axis=0)
    c_act = jax.nn.silu(c)
    c_ctx_act = jax.nn.silu(c_ctx)
    xc = ctx
    for l in range(DEPTH):
        last = l == DEPTH - 1
        shift1, scale1, gate1, shift2, scale2, gate2 = (t[:, None, :] for t in jnp.split(c_act @ w_ada[l] + b_ada[l], N_MOD, axis=-1))
        cshift1, cscale1, cgate1, cshift2, cscale2, cgate2 = jnp.split(c_ctx_act @ w_ada[l] + b_ada[l], N_MOD, axis=-1)
        lb = lower_bounds[l]
        u = x * (1.0 + scale1) + shift1
        uc = xc * (1.0 + cscale1) + cshift1
        pf, pq, pzf, pzb, pv, pg, gates = _split_in(u @ w_in[l])
        cpf, cpq, cpzf, cpzb, cpv, cpg, cgates = _split_in(uc @ w_in[l])
        zero_state = jnp.zeros((b, HG_HEADS, HG_DK, HG_DV), jnp.float32)
        oc, s_f, s_b = _hgrn2_bidir(cpq, cpzf, cpzb, cpv, lb, zero_state, zero_state)
        o, _, _ = _hgrn2_bidir(pq, pzf, pzb, pv, lb, s_f, s_b)
        mix = _merge(_fourier_latent(pf), _hgrn2_readout(o, pg, hg_norm_g[l]), gates, w_four_out[l], w_hg_out[l], w_o[l])
        x = _layer_norm(DEEPNORM_ALPHA * x + gate1 * mix, ln1_g[l], ln1_b[l])
        u2 = x * (1.0 + scale2) + shift2
        ff = _moe(u2.reshape(-1, D_MODEL), w_router[l], b_router[l], w_gate_up[l], b_gate_up[l], w_down[l], b_down[l]).reshape(x.shape)
        x = _layer_norm(DEEPNORM_ALPHA * x + gate2 * ff, ln2_g[l], ln2_b[l])
        if not last:
            mix_c = _merge(_fourier_context(cpf), _hgrn2_readout(oc, cpg, hg_norm_g[l]), cgates, w_four_out[l], w_hg_out[l], w_o[l])
            xc = _layer_norm(DEEPNORM_ALPHA * xc + cgate1 * mix_c, ln1_g[l], ln1_b[l])
            u2c = xc * (1.0 + cscale2) + cshift2
            ffc = _moe(u2c.reshape(-1, D_MODEL), w_router[l], b_router[l], w_gate_up[l], b_gate_up[l], w_down[l], b_down[l]).reshape(xc.shape)
            xc = _layer_norm(DEEPNORM_ALPHA * xc + cgate2 * ffc, ln2_g[l], ln2_b[l])
    return x
```

```cpp
#include <hip/hip_runtime.h>
#include <cstdio>
#include <cstdint>

#define LAS __attribute__((address_space(3)))
typedef unsigned short bf16_t;
typedef short bf16x8 __attribute__((ext_vector_type(8)));
typedef short bf16x4 __attribute__((ext_vector_type(4)));
typedef float f32x4 __attribute__((ext_vector_type(4)));
typedef float f32x2 __attribute__((ext_vector_type(2)));
typedef unsigned u32x4 __attribute__((ext_vector_type(4)));
typedef unsigned u32x2 __attribute__((ext_vector_type(2)));

constexpr int D = 1024, NB = 32, SEQ = 2048, T = NB * SEQ, CTX = 256, TCX = NB * CTX;
constexpr int NEXP = 32, TOPK = 4;
constexpr int NCH = 2, TCH = T / NCH;
constexpr int ROWS_CH = TCH * TOPK + NEXP * 256;
constexpr float DN_ALPHA = 1.189207115002721f;
constexpr float LN_EPS = 1e-5f, RMS_EPS = 1e-6f;
constexpr int NTHR = 512;

constexpr size_t MiB = 1ull << 20;
constexpr size_t WS_CTL = 0;
constexpr size_t CTL_BYTES = 65536;
constexpr size_t WS_ADA = 65536;
constexpr size_t WS_WIN1T = 1 * MiB;
constexpr size_t WS_WIN2T = 7 * MiB;
constexpr size_t WS_WMT = 12 * MiB;
constexpr size_t WS_WOT = 14 * MiB;
constexpr size_t WS_WGUT = 16 * MiB;
constexpr size_t WS_WDNT = 144 * MiB;
constexpr size_t WS_TOPI = 208 * MiB;
constexpr size_t WS_TOPW = 209 * MiB;
constexpr size_t WS_POS = 210 * MiB;
constexpr size_t WS_ROWTOK = 211 * MiB;
constexpr size_t WS_U = 216 * MiB;
constexpr size_t WS_PA = 344 * MiB;
constexpr size_t WS_PH = 472 * MiB;
constexpr size_t WS_PHC = 728 * MiB;
constexpr size_t WS_PG = 760 * MiB;
constexpr size_t WS_Y = 824 * MiB;
constexpr size_t WS_UC = WS_Y;
constexpr size_t WS_ACT = WS_PA;
constexpr size_t WS_YCH = WS_PA + 272 * MiB;
constexpr size_t WS_END = 952 * MiB;
static_assert(WS_YCH + 272 * MiB <= WS_END, "ws map");
constexpr int CW_CNT = 4096;
constexpr int CW_CUR = 4096 + 64;

constexpr int LDS_SCRATCH = 147456;
constexpr int LDS_MISC = LDS_SCRATCH;
constexpr int LDS_BYTES = LDS_SCRATCH + 2048;

typedef __bf16 bf16x2_t __attribute__((ext_vector_type(2)));
__device__ __forceinline__ unsigned cvt_pk_bf16(float lo, float hi) { const f32x2 v = {lo, hi}; const bf16x2_t r = __builtin_convertvector(v, bf16x2_t); return __builtin_bit_cast(unsigned, r); }
__device__ __forceinline__ float bf_lo(unsigned w) { return __uint_as_float(w << 16); }
__device__ __forceinline__ float bf_hi(unsigned w) { return __uint_as_float(w & 0xffff0000u); }
__device__ __forceinline__ float bf2f(bf16_t v) { return __uint_as_float(((unsigned)v) << 16); }
__device__ __forceinline__ float fast_exp(float x) { return __builtin_amdgcn_exp2f(x * 1.4426950408889634f); }
__device__ __forceinline__ float fast_sigmoid(float x) { return __builtin_amdgcn_rcpf(1.0f + fast_exp(-x)); }
__device__ __forceinline__ float fast_log(float x) { return __builtin_amdgcn_logf(x) * 0.6931471805599453f; }

#define XB_TMO      128
#define XB_XCNT(j)  (256  + 64 * (j))
#define XB_XSUB(j)  (1280 + 64 * (j))
#define XB_XGEN(j)  (2304 + 64 * (j))
#define XB_TOP      3328
#define XB_TOPGEN   3392
#define XCD_BAR_WORDS 3456
#define XB_SPIN_CAP (1u << 18)

__device__ __forceinline__ unsigned xb_ld(unsigned* p)              { return __hip_atomic_load(p, __ATOMIC_RELAXED, __HIP_MEMORY_SCOPE_AGENT); }
__device__ __forceinline__ unsigned xb_add(unsigned* p, unsigned v) { return __hip_atomic_fetch_add(p, v, __ATOMIC_RELAXED, __HIP_MEMORY_SCOPE_AGENT); }
__device__ __forceinline__ unsigned xb_xcc_id() { return (unsigned)__builtin_amdgcn_s_getreg((3 << 11) | 20) & 0xFu; }
#define XB_SPIN(cond, bar) do { unsigned _sp = 0; while (cond) { __builtin_amdgcn_s_sleep(1); \
    if ((++_sp & 255u) == 0u) { if (xb_ld(&(bar)[XB_TMO])) break; if (_sp > XB_SPIN_CAP) { atomicAdd(&(bar)[XB_TMO], 1u); break; } } } } while (0)

struct XcdBarrier { unsigned* bar; unsigned x; volatile LAS unsigned* st; };

__device__ __forceinline__ XcdBarrier xcd_barrier_post(unsigned* bar, volatile LAS unsigned* st) {
    XcdBarrier b; b.bar = bar; b.x = xb_xcc_id(); b.st = st;
    if (threadIdx.x == 0) (void)xb_add(&bar[XB_XCNT(b.x)], 1u);
    return b;
}
__device__ __forceinline__ void xcd_barrier_complete(unsigned* bar, unsigned x, unsigned& nloc, unsigned& nx) {
    const unsigned G = gridDim.x * gridDim.y * gridDim.z;
    unsigned sum, cnt, mine, sp = 0u;
    for (;;) {
        sum = 0u; cnt = 0u; mine = 0u;
#pragma unroll
        for (unsigned j = 0; j < 16; ++j) { const unsigned c = xb_ld(&bar[XB_XCNT(j)]); sum += c; cnt += (c > 0u) ? 1u : 0u; mine = (j == x) ? c : mine; }
        if (sum == G) break;
        __builtin_amdgcn_s_sleep(1);
        if ((++sp & 255u) == 0u) { if (xb_ld(&bar[XB_TMO])) break; if (sp > XB_SPIN_CAP) { atomicAdd(&bar[XB_TMO], 1u); break; } }
    }
    nloc = mine > 0u ? mine : 1u; nx = cnt > 0u ? cnt : 1u;
}
__device__ __forceinline__ void xcd_barrier(const XcdBarrier& b) {
    asm volatile("s_waitcnt vmcnt(0)" ::: "memory");
    __syncthreads();
    if (threadIdx.x == 0) {
        unsigned* bar = b.bar;
        __builtin_amdgcn_s_waitcnt(0);
        unsigned nloc = b.st[0], nx = b.st[1];
        if (nloc == 0u) { xcd_barrier_complete(bar, b.x, nloc, nx); b.st[0] = nloc; b.st[1] = nx; }
        const unsigned old = xb_add(&bar[XB_XSUB(b.x)], 1u);
        const unsigned gen = old / nloc;
        if (old + 1u == (gen + 1u) * nloc) {
            __builtin_amdgcn_fence(__ATOMIC_RELEASE, "agent");
            asm volatile("s_waitcnt vmcnt(0)" ::: "memory");
            const unsigned og = xb_add(&bar[XB_TOP], 1u);
            const unsigned tg = og / nx;
            if (og + 1u == (tg + 1u) * nx) xb_add(&bar[XB_TOPGEN], 1u);
            else XB_SPIN(xb_ld(&bar[XB_TOPGEN]) == tg, bar);
            __builtin_amdgcn_fence(__ATOMIC_ACQUIRE, "agent");
            xb_add(&bar[XB_XGEN(b.x)], 1u);
            asm volatile("s_waitcnt vmcnt(0)" ::: "memory");
        } else {
            XB_SPIN(xb_ld(&bar[XB_XGEN(b.x)]) == gen, bar);
            __builtin_amdgcn_fence(__ATOMIC_ACQUIRE, "agent");
            asm volatile("s_waitcnt vmcnt(0)" ::: "memory");
        }
    }
    __syncthreads();
}

namespace pg8 {
constexpr int BM = 256, BK = 64, HALF = 128, HTB = HALF * BK * 2, STAGE_BYTES = 8 * HTB, NXCD = 8, WGM = 8;
__host__ __device__ __forceinline__ int lds_byte(int r, int c) { const int st = (r >> 4) * 2 + (c >> 5), rr = r & 15, cc = c & 31, ob = rr * 64 + cc * 2; return st * 1024 + (ob ^ (((ob >> 9) & 1) << 5)); }
__host__ __device__ __forceinline__ void stage_rc(int b, int& R, int& C) { const int st = b / 1024, sb = b % 1024, swz = sb ^ (((sb >> 9) & 1) << 5); R = (st >> 1) * 16 + swz / 64; C = (st & 1) * 32 + (swz % 64) / 2; }
__host__ __device__ __forceinline__ int perm32(int rho) { const int n = rho >> 4, i = rho & 15; return 8 * (i >> 2) + 4 * n + (i & 3); }

struct Unit { int pm, pn, aux; };

__device__ __forceinline__ void grouped(int wgid, int nM, int nN, int& pm, int& pn) {
    const int nig = WGM * nN, gid = wgid / nig, fm = gid * WGM, gsz = (nM - fm) < WGM ? (nM - fm) : WGM;
    pm = fm + ((wgid % nig) % gsz); pn = (wgid % nig) / gsz;
}
__device__ __forceinline__ bool xcd_remap(int i, int G, int c, int nwg, int& wgid) {
    const long L = (long)i * G + c; if (L >= nwg) return false;
    wgid = (int)L; const int q = nwg / NXCD, r = nwg % NXCD, xcd = wgid % NXCD, off = wgid / NXCD;
    wgid = (xcd < r ? xcd * (q + 1) : r * (q + 1) + (xcd - r) * q) + off; return true;
}

template <class Prob, class Epi, bool ALIGN_EPI, bool HOOK>
__device__ __forceinline__ void gemm_phase(LAS unsigned char* lds, const Prob& P, const Epi& E) {
    int tid_ = threadIdx.x; asm volatile("" : "+v"(tid_));
    const int tid = tid_, wid = __builtin_amdgcn_readfirstlane(tid >> 6), lane = tid & 63, wr = wid >> 2, wc = wid & 3, fr = lane & 15, fq = lane >> 4;
    const int nt = P.nt;
    unsigned voffB[2], voffA[2];
#pragma unroll
    for (int i = 0; i < 2; ++i) { int R, C; stage_rc(tid * 16 + i * 8192, R, C); const int Rb = Epi::PERM ? ((R & ~31) + perm32(R & 31)) : R;
        voffB[i] = (unsigned)Rb * P.ldb2 + (unsigned)C * 2u; voffA[i] = (unsigned)R * 2048u + (unsigned)C * 2u; }
    auto gather_offs = [&](const Unit& u, unsigned (&o0)[2], unsigned (&o1)[2]) {
#pragma unroll
        for (int i = 0; i < 2; ++i) { int R, C; int tt = threadIdx.x; asm volatile("" : "+v"(tt)); stage_rc(tt * 16 + i * 8192, R, C); o0[i] = P.a_row(u, R) + (unsigned)C * 2u; o1[i] = P.a_row(u, HALF + R) + (unsigned)C * 2u; } };
    const size_t kstep = (size_t)(BK * 2);
    const size_t hstepB = (size_t)HALF * P.ldb2;
    const size_t hstepA = (size_t)HALF * 2048;
    const unsigned ldsw = (unsigned)wid * 1024u;
    const int aoff = lds_byte(wr * 64 + fr, fq * 8), boff = lds_byte(wc * 32 + fr, fq * 8);
#define PG8_SA(b, h) (((b) * 2 + (h)) * HTB)
#define PG8_SB(b, h) ((4 + (b) * 2 + (h)) * HTB)
#define PG8_STAGE(bufoff, gbase, voff) do { _Pragma("unroll") for (int _i = 0; _i < 2; ++_i) \
        __builtin_amdgcn_global_load_lds((const unsigned*)((const char*)(gbase) + (voff)[_i]), (LAS unsigned*)(lds + (bufoff) + ldsw + _i * 8192), 16, 0, 0); } while (0)
#define PG8_LDA(dst, b, h) do { _Pragma("unroll") for (int m = 0; m < 4; ++m) _Pragma("unroll") for (int k = 0; k < 2; ++k) dst[m][k] = *(const LAS bf16x8*)(lds + PG8_SA(b, h) + aoff + m * 2048 + k * 1024); } while (0)
#define PG8_LDB(dst, b, h) do { _Pragma("unroll") for (int n = 0; n < 2; ++n) _Pragma("unroll") for (int k = 0; k < 2; ++k) dst[n][k] = *(const LAS bf16x8*)(lds + PG8_SB(b, h) + boff + n * 2048 + k * 1024); } while (0)
#define PG8_MMA(ai, bj, At, Bt) do { __builtin_amdgcn_s_setprio(1); _Pragma("unroll") for (int m = 0; m < 4; ++m) _Pragma("unroll") for (int n = 0; n < 2; ++n) _Pragma("unroll") for (int k = 0; k < 2; ++k) \
        acc[ai][bj][m][n] = __builtin_amdgcn_mfma_f32_16x16x32_bf16(Bt[n][k], At[m][k], acc[ai][bj][m][n], 0, 0, 0); __builtin_amdgcn_s_setprio(0); } while (0)
#define PG8_WAIT_V(n) asm volatile("s_waitcnt vmcnt(" #n ")" ::: "memory")
#define PG8_WAIT_L(n) asm volatile("s_waitcnt lgkmcnt(" #n ")" ::: "memory")
#define PG8_BAR __builtin_amdgcn_s_barrier()
#define PG8_SCHED __builtin_amdgcn_sched_barrier(0)
    Unit cur, nxt; int ui = 0;
    if (!P.unit(0, cur)) return;
    f32x4 acc[2][2][4][2];
#pragma unroll
    for (int a = 0; a < 2; ++a)
#pragma unroll
        for (int b = 0; b < 2; ++b)
#pragma unroll
            for (int m = 0; m < 4; ++m)
#pragma unroll
                for (int n = 0; n < 2; ++n) acc[a][b][m][n] = (f32x4){0.f, 0.f, 0.f, 0.f};
    bf16x8 At[4][2], B0[2][2], B1[2][2];
    unsigned va0[2], va1[2], vn0[2], vn1[2];
    const char* const gA = P.Abase; const char* cA = gA; const char* nA = gA; const char* cB = P.b_tile(cur);
    if constexpr (Prob::GATHER) {
        gather_offs(cur, va0, va1);
    } else { cA = gA + P.a_row(cur, 0); }
#define PG8_STAGE_A(bufoff, h, koff, nx) do { if constexpr (Prob::GATHER) { unsigned _v[2]; _Pragma("unroll") for (int _i = 0; _i < 2; ++_i) _v[_i] = (nx) ? ((h) ? vn1[_i] : vn0[_i]) : ((h) ? va1[_i] : va0[_i]); PG8_STAGE(bufoff, gA + (koff), _v); } \
        else { PG8_STAGE(bufoff, ((nx) ? nA : cA) + (h) * hstepA + (koff), voffA); } } while (0)
    PG8_STAGE(PG8_SB(0, 0), cB, voffB); PG8_STAGE(PG8_SB(0, 1), cB + hstepB, voffB); PG8_STAGE_A(PG8_SA(0, 0), 0, 0, false); PG8_STAGE_A(PG8_SA(0, 1), 1, 0, false);
    if (wr == 1) PG8_BAR;
    PG8_WAIT_V(2); PG8_BAR;
    PG8_STAGE(PG8_SB(1, 0), cB + kstep, voffB); PG8_STAGE_A(PG8_SA(1, 0), 0, kstep, false); PG8_STAGE(PG8_SB(1, 1), cB + hstepB + kstep, voffB);
    PG8_WAIT_V(6); PG8_BAR;
    for (;;) {
        const bool has_next = P.unit(ui + 1, nxt);
        if (!has_next) nxt = cur;
        if constexpr (Prob::GATHER) {
            gather_offs(nxt, vn0, vn1);
        } else { nA = gA + P.a_row(nxt, 0); }
        const char* nB = P.b_tile(nxt);
        for (int t = 0; t < nt; t += 2) {
            const bool last = (t == nt - 2);
            if constexpr (HOOK) { if (t == (nt >> 1)) E.mid(acc, cur, wr, wc, fr, fq); }
            const size_t k1 = (size_t)(t + 1) * kstep, k2 = last ? 0 : (size_t)(t + 2) * kstep, k3 = k2 + kstep;
            const char* b2 = last ? nB : cB + (size_t)(t + 2) * kstep; const char* b3 = b2 + kstep;
            PG8_LDB(B0, 0, 0); PG8_LDB(B1, 0, 1); PG8_SCHED; PG8_LDA(At, 0, 0); PG8_STAGE_A(PG8_SA(1, 1), 1, k1, false);
            PG8_WAIT_V(8); PG8_WAIT_L(0); PG8_BAR; PG8_MMA(0, 0, At, B0); PG8_MMA(0, 1, At, B1); PG8_BAR; PG8_SCHED;
            PG8_LDA(At, 0, 1); PG8_STAGE(PG8_SB(0, 0), b2, voffB); PG8_STAGE(PG8_SB(0, 1), b2 + hstepB, voffB); PG8_STAGE_A(PG8_SA(0, 0), 0, k2, last);
            PG8_WAIT_V(8); PG8_WAIT_L(0); PG8_BAR; PG8_MMA(1, 0, At, B0); PG8_MMA(1, 1, At, B1); PG8_BAR; PG8_SCHED;
            PG8_LDB(B0, 1, 0); PG8_LDB(B1, 1, 1); PG8_SCHED; PG8_LDA(At, 1, 0); PG8_STAGE_A(PG8_SA(0, 1), 1, k2, last);
            PG8_WAIT_V(8); PG8_WAIT_L(0); PG8_BAR; PG8_MMA(0, 0, At, B0); PG8_MMA(0, 1, At, B1); PG8_BAR; PG8_SCHED;
            PG8_LDA(At, 1, 1); PG8_STAGE(PG8_SB(1, 0), b3, voffB); PG8_STAGE(PG8_SB(1, 1), b3 + hstepB, voffB); PG8_STAGE_A(PG8_SA(1, 0), 0, k3, last);
            PG8_WAIT_V(8); PG8_WAIT_L(0); PG8_BAR; PG8_MMA(1, 0, At, B0); PG8_MMA(1, 1, At, B1); PG8_BAR; PG8_SCHED;
        }
        if constexpr (ALIGN_EPI) { if (wr == 0) PG8_BAR; }
        E(acc, cur, wr, wc, fr, fq);
        if (!has_next) break;
#pragma unroll
        for (int a = 0; a < 2; ++a)
#pragma unroll
            for (int b = 0; b < 2; ++b)
#pragma unroll
                for (int m = 0; m < 4; ++m)
#pragma unroll
                    for (int n = 0; n < 2; ++n) acc[a][b][m][n] = (f32x4){0.f, 0.f, 0.f, 0.f};
        cur = nxt; cB = nB; cA = nA; ++ui;
        if constexpr (Prob::GATHER) {
#pragma unroll
            for (int i = 0; i < 2; ++i) { va0[i] = vn0[i]; va1[i] = vn1[i]; } }
        if constexpr (ALIGN_EPI) { if (wr == 1) PG8_BAR; }
    }
    PG8_WAIT_V(0);
    if constexpr (!ALIGN_EPI) { if (wr == 0) PG8_BAR; }
    PG8_BAR;
#undef PG8_SA
#undef PG8_SB
#undef PG8_STAGE
#undef PG8_STAGE_A
#undef PG8_LDA
#undef PG8_LDB
#undef PG8_MMA
#undef PG8_WAIT_V
#undef PG8_WAIT_L
#undef PG8_BAR
#undef PG8_SCHED
}
}

using pg8::Unit;

struct ProbDense {
    static constexpr bool GATHER = false;
    const char* Abase; int nt; unsigned ldb2; unsigned lda2; const char* Bt; int nM, nN, G, c;
    __device__ __forceinline__ bool unit(int i, Unit& u) const { int w; if (!pg8::xcd_remap(i, G, c, nM * nN, w)) return false; pg8::grouped(w, nM, nN, u.pm, u.pn); u.aux = 0; return true; }
    __device__ __forceinline__ unsigned a_row(const Unit& u, int r) const { return (unsigned)(u.pm * 256 + r) * lda2; }
    __device__ __forceinline__ const char* b_tile(const Unit& u) const { return Bt + (size_t)u.pn * 256 * ldb2; }
};
struct ProbP1 {
    static constexpr bool GATHER = false;
    const char* Abase; int nt; unsigned ldb2; const char* Bt; unsigned uc_off; int G, c;
    __device__ __forceinline__ bool unit(int i, Unit& u) const {
        int w; if (!pg8::xcd_remap(i, G, c, 3072 + 256, w)) return false;
        if (w < 3072) { pg8::grouped(w, 256, 12, u.pm, u.pn); u.aux = 0; }
        else { pg8::grouped(w - 3072, 32, 8, u.pm, u.pn); u.pn += 4; u.aux = 1; }
        return true; }
    __device__ __forceinline__ unsigned a_row(const Unit& u, int r) const { return (u.aux ? uc_off : 0u) + (unsigned)(u.pm * 256 + r) * 2048u; }
    __device__ __forceinline__ const char* b_tile(const Unit& u) const { return Bt + (size_t)u.pn * 256 * ldb2; }
};
template <bool GATHER_> struct ProbMoE {
    static constexpr bool GATHER = GATHER_;
    const char* Abase; int nt; unsigned ldb2; const char* Bt; size_t estride; int nN, nblk, G, c; const int* rowtok; const LAS unsigned char* blk_e;
    __device__ __forceinline__ bool unit(int i, Unit& u) const { int w; if (!pg8::xcd_remap(i, G, c, nblk * nN, w)) return false; pg8::grouped(w, nblk, nN, u.pm, u.pn); u.aux = (int)blk_e[u.pm]; return true; }
    __device__ __forceinline__ unsigned a_row(const Unit& u, int r) const { if (GATHER) return (unsigned)rowtok[u.pm * 256 + r] * 2048u; else return (unsigned)(u.pm * 256 + r) * 2048u; }
    __device__ __forceinline__ const char* b_tile(const Unit& u) const { return Bt + (size_t)u.aux * estride + (size_t)u.pn * 256 * ldb2; }
};

struct EpiP1 {
    static constexpr bool PERM = true;
    bf16_t* PA; bf16_t* PH; bf16_t* PHC;
    __device__ __forceinline__ void operator()(const f32x4 (&acc)[2][2][4][2], const Unit& u, int wr, int wc, int fr, int fq) const {
        bf16_t* base; int ldc, colt;
        if (u.aux) { base = PHC; ldc = 2048; colt = (u.pn - 4) * 256; }
        else if (u.pn < 4) { base = PA; ldc = 1024; colt = u.pn * 256; }
        else { base = PH; ldc = 2048; colt = (u.pn - 4) * 256; }
        const int row0 = u.pm * 256 + wr * 64 + fr, col0 = colt + wc * 32 + 8 * fq;
#pragma unroll
        for (int ai = 0; ai < 2; ++ai)
#pragma unroll
            for (int m = 0; m < 4; ++m) { bf16_t* rowp = base + (size_t)(row0 + ai * 128 + m * 16) * ldc + col0;
#pragma unroll
                for (int bj = 0; bj < 2; ++bj) { const f32x4 v0 = acc[ai][bj][m][0], v1 = acc[ai][bj][m][1];
                    u32x4 w; w.x = cvt_pk_bf16(v0[0], v0[1]); w.y = cvt_pk_bf16(v0[2], v0[3]); w.z = cvt_pk_bf16(v1[0], v1[1]); w.w = cvt_pk_bf16(v1[2], v1[3]);
                    *(u32x4*)(rowp + bj * 128) = w; } }
    }
    __device__ __forceinline__ void mid(f32x4 (&)[2][2][4][2], const Unit&, int, int, int, int) const {}
};
struct EpiP2 {
    static constexpr bool PERM = true;
    bf16_t* PG; bf16_t* GATES;
    __device__ __forceinline__ void operator()(const f32x4 (&acc)[2][2][4][2], const Unit& u, int wr, int wc, int fr, int fq) const {
        const bool isg = u.pn >= 2; bf16_t* base = isg ? GATES : PG; const int ldc = isg ? 2048 : 512, colt = isg ? (u.pn - 2) * 256 : u.pn * 256;
        const int row0 = u.pm * 256 + wr * 64 + fr, col0 = colt + wc * 32 + 8 * fq;
#pragma unroll
        for (int ai = 0; ai < 2; ++ai)
#pragma unroll
            for (int m = 0; m < 4; ++m) { bf16_t* rowp = base + (size_t)(row0 + ai * 128 + m * 16) * ldc + col0;
#pragma unroll
                for (int bj = 0; bj < 2; ++bj) { f32x4 v0 = acc[ai][bj][m][0], v1 = acc[ai][bj][m][1];
#pragma unroll
                    for (int j = 0; j < 4; ++j) { const float s0 = fast_sigmoid(v0[j]), s1 = fast_sigmoid(v1[j]); v0[j] = isg ? s0 : v0[j] * s0; v1[j] = isg ? s1 : v1[j] * s1; }
                    u32x4 w; w.x = cvt_pk_bf16(v0[0], v0[1]); w.y = cvt_pk_bf16(v0[2], v0[3]); w.z = cvt_pk_bf16(v1[0], v1[1]); w.w = cvt_pk_bf16(v1[2], v1[3]);
                    *(u32x4*)(rowp + bj * 128) = w; } }
    }
    __device__ __forceinline__ void mid(f32x4 (&)[2][2][4][2], const Unit&, int, int, int, int) const {}
};
struct EpiM1 {
    static constexpr bool PERM = true;
    const bf16_t* GATES; bf16_t* Mo;
    __device__ __forceinline__ void mid(f32x4 (&acc)[2][2][4][2], const Unit& u, int wr, int wc, int fr, int fq) const {
        int row0 = u.pm * 256 + wr * 64 + fr, col0 = u.pn * 256 + wc * 32 + 8 * fq;
        asm volatile("" : "+v"(row0), "+v"(col0));
#pragma unroll
        for (int ai = 0; ai < 2; ++ai)
#pragma unroll
            for (int m = 0; m < 4; ++m) { const bf16_t* gp = GATES + (size_t)(row0 + ai * 128 + m * 16) * 2048 + col0;
#pragma unroll
                for (int bj = 0; bj < 2; ++bj) { const u32x4 gf = *(const u32x4*)(gp + bj * 128), gh = *(const u32x4*)(gp + 1024 + bj * 128);
                    f32x4& v0 = acc[ai][bj][m][0]; f32x4& v1 = acc[ai][bj][m][1];
                    v0[0] *= bf_lo(gf.x) * __builtin_amdgcn_rcpf(fmaxf(bf_lo(gh.x), 1e-20f)); v0[1] *= bf_hi(gf.x) * __builtin_amdgcn_rcpf(fmaxf(bf_hi(gh.x), 1e-20f));
                    v0[2] *= bf_lo(gf.y) * __builtin_amdgcn_rcpf(fmaxf(bf_lo(gh.y), 1e-20f)); v0[3] *= bf_hi(gf.y) * __builtin_amdgcn_rcpf(fmaxf(bf_hi(gh.y), 1e-20f));
                    v1[0] *= bf_lo(gf.z) * __builtin_amdgcn_rcpf(fmaxf(bf_lo(gh.z), 1e-20f)); v1[1] *= bf_hi(gf.z) * __builtin_amdgcn_rcpf(fmaxf(bf_hi(gh.z), 1e-20f));
                    v1[2] *= bf_lo(gf.w) * __builtin_amdgcn_rcpf(fmaxf(bf_lo(gh.w), 1e-20f)); v1[3] *= bf_hi(gf.w) * __builtin_amdgcn_rcpf(fmaxf(bf_hi(gh.w), 1e-20f));
                    asm volatile("" : "+v"(v0), "+v"(v1) :: "memory"); } }
    }
    __device__ __forceinline__ void operator()(const f32x4 (&acc)[2][2][4][2], const Unit& u, int wr, int wc, int fr, int fq) const {
        const int row0 = u.pm * 256 + wr * 64 + fr, col0 = u.pn * 256 + wc * 32 + 8 * fq;
#pragma unroll
        for (int ai = 0; ai < 2; ++ai)
#pragma unroll
            for (int m = 0; m < 4; ++m) { const size_t r = (size_t)(row0 + ai * 128 + m * 16); const bf16_t* gp = GATES + r * 2048 + 1024 + col0; bf16_t* rowp = Mo + r * 1024 + col0;
#pragma unroll
                for (int bj = 0; bj < 2; ++bj) { const u32x4 gh = *(const u32x4*)(gp + bj * 128); const f32x4 v0 = acc[ai][bj][m][0], v1 = acc[ai][bj][m][1];
                    u32x4 w; w.x = cvt_pk_bf16(v0[0] * bf_lo(gh.x), v0[1] * bf_hi(gh.x)); w.y = cvt_pk_bf16(v0[2] * bf_lo(gh.y), v0[3] * bf_hi(gh.y));
                    w.z = cvt_pk_bf16(v1[0] * bf_lo(gh.z), v1[1] * bf_hi(gh.z)); w.w = cvt_pk_bf16(v1[2] * bf_lo(gh.w), v1[3] * bf_hi(gh.w));
                    *(u32x4*)(rowp + bj * 128) = w; }
                asm volatile("" ::: "memory"); }
    }
};
struct EpiM2 {
    static constexpr bool PERM = false;
    const float* X; const float* ada; float* V;
    __device__ __forceinline__ void operator()(const f32x4 (&acc)[2][2][4][2], const Unit& u, int wr, int wc, int fr, int fq) const {
        const int row0 = u.pm * 256 + wr * 64 + fr, col0 = u.pn * 256 + wc * 32 + 4 * fq;
        const float* g1 = ada + (size_t)(u.pm >> 3) * 6144 + 2048 + col0;
        f32x4 gv[2][2];
#pragma unroll
        for (int bj = 0; bj < 2; ++bj)
#pragma unroll
            for (int n = 0; n < 2; ++n) gv[bj][n] = *(const f32x4*)(g1 + bj * 128 + n * 16);
#pragma unroll
        for (int ai = 0; ai < 2; ++ai)
#pragma unroll
            for (int m = 0; m < 4; ++m) { const size_t off = (size_t)(row0 + ai * 128 + m * 16) * 1024 + col0;
#pragma unroll
                for (int bj = 0; bj < 2; ++bj)
#pragma unroll
                    for (int n = 0; n < 2; ++n) { const f32x4 xv = *(const f32x4*)(X + off + bj * 128 + n * 16);
                        *(f32x4*)(V + off + bj * 128 + n * 16) = xv * DN_ALPHA + gv[bj][n] * acc[ai][bj][m][n]; }
                asm volatile("" ::: "memory"); }
    }
    __device__ __forceinline__ void mid(f32x4 (&)[2][2][4][2], const Unit&, int, int, int, int) const {}
};
struct EpiGU {
    static constexpr bool PERM = true;
    const float* bgu; bf16_t* ACT;
    __device__ __forceinline__ void operator()(const f32x4 (&acc)[2][2][4][2], const Unit& u, int wr, int wc, int fr, int fq) const {
        const int row0 = u.pm * 256 + wr * 64 + fr, col0 = u.pn * 128 + wc * 32 + 8 * fq;
        const float* bp = bgu + (size_t)u.aux * 2048 + col0;
        const f32x4 bg0 = *(const f32x4*)(bp), bg1 = *(const f32x4*)(bp + 4), bu0 = *(const f32x4*)(bp + 1024), bu1 = *(const f32x4*)(bp + 1028);
#pragma unroll
        for (int ai = 0; ai < 2; ++ai)
#pragma unroll
            for (int m = 0; m < 4; ++m) { bf16_t* rowp = ACT + (size_t)(row0 + ai * 128 + m * 16) * 1024 + col0;
                f32x4 g0 = acc[ai][0][m][0] + bg0, g1 = acc[ai][0][m][1] + bg1, p0 = acc[ai][1][m][0] + bu0, p1 = acc[ai][1][m][1] + bu1;
#pragma unroll
                for (int j = 0; j < 4; ++j) {
                    float g = fminf(g0[j], 7.0f), p = fminf(fmaxf(p0[j], -7.0f), 7.0f); g0[j] = (p + 1.0f) * g * fast_sigmoid(1.702f * g);
                    g = fminf(g1[j], 7.0f); p = fminf(fmaxf(p1[j], -7.0f), 7.0f); g1[j] = (p + 1.0f) * g * fast_sigmoid(1.702f * g); }
                u32x4 w; w.x = cvt_pk_bf16(g0[0], g0[1]); w.y = cvt_pk_bf16(g0[2], g0[3]); w.z = cvt_pk_bf16(g1[0], g1[1]); w.w = cvt_pk_bf16(g1[2], g1[3]);
                *(u32x4*)rowp = w; }
    }
    __device__ __forceinline__ void mid(f32x4 (&)[2][2][4][2], const Unit&, int, int, int, int) const {}
};
struct EpiDN {
    static constexpr bool PERM = true;
    const float* bdn; bf16_t* Y;
    __device__ __forceinline__ void operator()(const f32x4 (&acc)[2][2][4][2], const Unit& u, int wr, int wc, int fr, int fq) const {
        const int row0 = u.pm * 256 + wr * 64 + fr, col0 = u.pn * 256 + wc * 32 + 8 * fq;
        const float* bp = bdn + (size_t)u.aux * 1024 + col0;
        f32x4 bv[2][2];
#pragma unroll
        for (int bj = 0; bj < 2; ++bj)
#pragma unroll
            for (int n = 0; n < 2; ++n) bv[bj][n] = *(const f32x4*)(bp + bj * 128 + 4 * n);
#pragma unroll
        for (int ai = 0; ai < 2; ++ai)
#pragma unroll
            for (int m = 0; m < 4; ++m) { bf16_t* rowp = Y + (size_t)(row0 + ai * 128 + m * 16) * 1024 + col0;
#pragma unroll
                for (int bj = 0; bj < 2; ++bj) { const f32x4 v0 = acc[ai][bj][m][0] + bv[bj][0], v1 = acc[ai][bj][m][1] + bv[bj][1];
                    u32x4 w; w.x = cvt_pk_bf16(v0[0], v0[1]); w.y = cvt_pk_bf16(v0[2], v0[3]); w.z = cvt_pk_bf16(v1[0], v1[1]); w.w = cvt_pk_bf16(v1[2], v1[3]);
                    *(u32x4*)(rowp + bj * 128) = w; } }
    }
    __device__ __forceinline__ void mid(f32x4 (&)[2][2][4][2], const Unit&, int, int, int, int) const {}
};

struct Frame {
    LAS unsigned char* lds; int tid, lane, wave, G, c;
    const float* const* in; float* out; unsigned char* ws; unsigned* ctl;
};
enum { I_X = 0, I_C, I_CTX, I_CCTX, I_WADA, I_BADA, I_WIN, I_LBRAW, I_HGG, I_WFO, I_WHO, I_WO, I_LN1G, I_LN1B, I_WR, I_BR, I_WGU, I_BGU, I_WDN, I_BDN, I_LN2G, I_LN2B };

__device__ __forceinline__ float wave_sum(float v) {
#pragma unroll
    for (int o = 32; o >= 1; o >>= 1) v += __shfl_xor(v, o);
    return v;
}

__device__ __forceinline__ void p0_ada(const Frame& F) {
    LAS float* cact = (LAS float*)F.lds;
    float* ada = (float*)(F.ws + WS_ADA);
    for (int cb = F.c; cb < 192; cb += F.G) {
        for (int i = F.tid; i < 33 * 1024; i += NTHR) { const int b = i >> 10, k = i & 1023; const float v = b < 32 ? F.in[I_C][b * 1024 + k] : F.in[I_CCTX][k]; cact[i] = v * fast_sigmoid(v); }
        __syncthreads();
        const int kg = F.tid >> 5, col = F.tid & 31, gcol = cb * 32 + col;
        float acc[33];
#pragma unroll
        for (int b = 0; b < 33; ++b) acc[b] = 0.f;
        for (int k = kg; k < 1024; k += 16) { const float w = F.in[I_WADA][(size_t)k * 6144 + gcol];
#pragma unroll
            for (int b = 0; b < 33; ++b) acc[b] += cact[b * 1024 + k] * w; }
        __syncthreads();
        LAS float* red = cact;
#pragma unroll
        for (int b = 0; b < 33; ++b) red[(kg * 33 + b) * 32 + col] = acc[b];
        __syncthreads();
        for (int o = F.tid; o < 33 * 32; o += NTHR) { const int b = o >> 5, cc = o & 31; float s = 0.f;
            for (int g = 0; g < 16; ++g) s += red[(g * 33 + b) * 32 + cc];
            ada[(size_t)b * 6144 + cb * 32 + cc] = s + F.in[I_BADA][cb * 32 + cc]; }
        __syncthreads();
    }
}
__device__ __forceinline__ void p0_fold(const Frame& F) {
    LAS float* xr = (LAS float*)F.lds;
    LAS float* cs = xr + 2048;
    bf16_t* W1 = (bf16_t*)(F.ws + WS_WIN1T);
    if (F.tid < 128) { const float a = (float)F.tid * (1.0f / 128.0f); cs[F.tid] = __builtin_amdgcn_cosf(a); cs[128 + F.tid] = __builtin_amdgcn_sinf(a); }
    for (int kb = F.c; kb < 256; kb += F.G) {
        __syncthreads();
        for (int i = F.tid; i < 2048; i += NTHR) xr[i] = F.in[I_WIN][(size_t)(4 * kb + (i >> 9)) * 5120 + (i & 511)];
        __syncthreads();
        const int g = F.tid >> 7, j = F.tid & 127;
        float ac[4] = {0.f, 0.f, 0.f, 0.f}, as[4] = {0.f, 0.f, 0.f, 0.f};
        for (int d = 0; d < 128; ++d) { const int idx = (d * j) & 127; const float cv = cs[idx], sv = cs[128 + idx];
#pragma unroll
            for (int r = 0; r < 4; ++r) { const float xv = xr[r * 512 + g * 128 + d]; ac[r] += xv * cv; as[r] += xv * sv; } }
        const float sc = 0.08838834764831845f;
        u32x2 wa, wb; wa.x = cvt_pk_bf16(ac[0] * sc, ac[1] * sc); wa.y = cvt_pk_bf16(ac[2] * sc, ac[3] * sc);
        wb.x = cvt_pk_bf16(-as[0] * sc, -as[1] * sc); wb.y = cvt_pk_bf16(-as[2] * sc, -as[3] * sc);
        *(u32x2*)(W1 + (size_t)(g * 128 + j) * 1024 + 4 * kb) = wa;
        *(u32x2*)(W1 + (size_t)(512 + g * 128 + j) * 1024 + 4 * kb) = wb;
    }
    __syncthreads();
}
__device__ __forceinline__ void cv_tile(const Frame& F, const float* src, int src_ld, bf16_t* dst, int dst_ld) {
    LAS float* tile = (LAS float*)F.lds;
    f32x4 v[8];
#pragma unroll
    for (int i = 0; i < 8; ++i) { const int idx = F.tid + i * NTHR, r = idx >> 5, c4 = idx & 31; v[i] = *(const f32x4*)(src + (size_t)r * src_ld + c4 * 4); }
#pragma unroll
    for (int i = 0; i < 8; ++i) { const int idx = F.tid + i * NTHR, r = idx >> 5, c4 = idx & 31; LAS float* p = tile + r * 129 + c4 * 4; p[0] = v[i][0]; p[1] = v[i][1]; p[2] = v[i][2]; p[3] = v[i][3]; }
    __syncthreads();
#pragma unroll
    for (int i = 0; i < 4; ++i) { const int idx = F.tid + i * NTHR, n = idx >> 4, kc = idx & 15; const LAS float* p = tile + (kc * 8) * 129 + n;
        u32x4 w; w.x = cvt_pk_bf16(p[0], p[129]); w.y = cvt_pk_bf16(p[2 * 129], p[3 * 129]); w.z = cvt_pk_bf16(p[4 * 129], p[5 * 129]); w.w = cvt_pk_bf16(p[6 * 129], p[7 * 129]);
        *(u32x4*)(dst + (size_t)n * dst_ld + kc * 8) = w; }
    __syncthreads();
}
__device__ __forceinline__ void p0_convert(const Frame& F) {
    constexpr int NJ = 128 + 160 + 32 + 32 + 64 + 4096 + 2048;
    for (int j = F.c; j < NJ; j += F.G) {
        const float* src; int sld; bf16_t* dst; int dld = 1024;
        if (j < 128) { const int kt = j >> 4, nt = j & 15; src = F.in[I_WIN] + (size_t)kt * 128 * 5120 + 512 + nt * 128; sld = 5120; dst = (bf16_t*)(F.ws + WS_WIN1T) + (size_t)(1024 + nt * 128) * 1024 + kt * 128; }
        else if (j < 288) { const int q = j - 128, kt = q / 20, nt = q % 20; src = F.in[I_WIN] + (size_t)kt * 128 * 5120 + 2560 + nt * 128; sld = 5120; dst = (bf16_t*)(F.ws + WS_WIN2T) + (size_t)(nt * 128) * 1024 + kt * 128; }
        else if (j < 320) { const int q = j - 288, kt = q >> 3, nt = q & 7; src = F.in[I_WFO] + (size_t)kt * 128 * 1024 + nt * 128; sld = 1024; dst = (bf16_t*)(F.ws + WS_WMT) + (size_t)(nt * 128) * 1024 + kt * 128; }
        else if (j < 352) { const int q = j - 320, kt = q >> 3, nt = q & 7; src = F.in[I_WHO] + (size_t)kt * 128 * 1024 + nt * 128; sld = 1024; dst = (bf16_t*)(F.ws + WS_WMT) + (size_t)(nt * 128) * 1024 + 512 + kt * 128; }
        else if (j < 416) { const int q = j - 352, kt = q >> 3, nt = q & 7; src = F.in[I_WO] + (size_t)kt * 128 * 1024 + nt * 128; sld = 1024; dst = (bf16_t*)(F.ws + WS_WOT) + (size_t)(nt * 128) * 1024 + kt * 128; }
        else if (j < 4512) { const int q = j - 416, e = q >> 7, r = q & 127, kt = r >> 4, jt = r & 15; src = F.in[I_WGU] + (size_t)e * 1024 * 2048 + (size_t)kt * 128 * 2048 + jt * 128; sld = 2048;
            dst = (bf16_t*)(F.ws + WS_WGUT) + (size_t)e * 2048 * 1024 + (size_t)((jt & 7) * 256 + (jt >> 3) * 128) * 1024 + kt * 128; }
        else { const int q = j - 4512, e = q >> 6, r = q & 63, kt = r >> 3, nt = r & 7; src = F.in[I_WDN] + (size_t)e * 1024 * 1024 + (size_t)kt * 128 * 1024 + nt * 128; sld = 1024;
            dst = (bf16_t*)(F.ws + WS_WDNT) + (size_t)e * 1024 * 1024 + (size_t)(nt * 128) * 1024 + kt * 128; }
        cv_tile(F, src, sld, dst, dld);
    }
}

__device__ __forceinline__ void p1_uprep(const Frame& F) {
    const float* ada = (const float*)(F.ws + WS_ADA);
    bf16_t* U = (bf16_t*)(F.ws + WS_U); bf16_t* Uc = (bf16_t*)(F.ws + WS_UC);
    const size_t NIT = (size_t)(T + TCX) * 128, stride = (size_t)F.G * NTHR;
    for (size_t idx = (size_t)F.c * NTHR + F.tid; idx < NIT; idx += stride) {
        const int row = (int)(idx >> 7), col = (int)(idx & 127) * 8;
        const bool lat = row < T; const int b = lat ? (row >> 11) : 32;
        const float* src = lat ? F.in[I_X] + (size_t)row * 1024 + col : F.in[I_CTX] + (size_t)(row - T) * 1024 + col;
        bf16_t* dst = lat ? U + (size_t)row * 1024 + col : Uc + (size_t)(row - T) * 1024 + col;
        const f32x4 a0 = *(const f32x4*)src, a1 = *(const f32x4*)(src + 4);
        const float* ap = ada + (size_t)b * 6144 + col;
        const f32x4 sh0 = *(const f32x4*)ap, sh1 = *(const f32x4*)(ap + 4), sc0 = *(const f32x4*)(ap + 1024), sc1 = *(const f32x4*)(ap + 1028);
        const f32x4 r0 = a0 * (sc0 + 1.0f) + sh0, r1 = a1 * (sc1 + 1.0f) + sh1;
        u32x4 w; w.x = cvt_pk_bf16(r0[0], r0[1]); w.y = cvt_pk_bf16(r0[2], r0[3]); w.z = cvt_pk_bf16(r1[0], r1[1]); w.w = cvt_pk_bf16(r1[2], r1[3]);
        *(u32x4*)dst = w;
    }
    int* rowtok = (int*)(F.ws + WS_ROWTOK);
    for (int i = F.c * NTHR + F.tid; i < NCH * ROWS_CH; i += F.G * NTHR) rowtok[i] = (i / ROWS_CH) * TCH;
}

__device__ __forceinline__ void p6_readout(const Frame& F) {
    const bf16_t* PH = (const bf16_t*)(F.ws + WS_PH); const bf16_t* PG = (const bf16_t*)(F.ws + WS_PG); bf16_t* Y = (bf16_t*)(F.ws + WS_Y);
    const int l8 = F.lane * 8;
    const f32x4 g0 = *(const f32x4*)(F.in[I_HGG] + l8), g1 = *(const f32x4*)(F.in[I_HGG] + l8 + 4);
    for (int t = F.c * 8 + F.wave; t < T; t += F.G * 8) {
        const u32x4 a = *(const u32x4*)(PH + (size_t)t * 2048 + 512 + l8), b = *(const u32x4*)(PH + (size_t)t * 2048 + 1024 + l8), p = *(const u32x4*)(PG + (size_t)t * 512 + l8);
        float o[8] = { bf_lo(a.x) + bf_lo(b.x), bf_hi(a.x) + bf_hi(b.x), bf_lo(a.y) + bf_lo(b.y), bf_hi(a.y) + bf_hi(b.y), bf_lo(a.z) + bf_lo(b.z), bf_hi(a.z) + bf_hi(b.z), bf_lo(a.w) + bf_lo(b.w), bf_hi(a.w) + bf_hi(b.w) };
        float ss = 0.f;
#pragma unroll
        for (int i = 0; i < 8; ++i) ss += o[i] * o[i];
        ss += __shfl_xor(ss, 1); ss += __shfl_xor(ss, 2); ss += __shfl_xor(ss, 4); ss += __shfl_xor(ss, 8);
        const float rs = __builtin_amdgcn_rsqf(ss * (1.0f / 128.0f) + RMS_EPS);
        const float sp[8] = { bf_lo(p.x), bf_hi(p.x), bf_lo(p.y), bf_hi(p.y), bf_lo(p.z), bf_hi(p.z), bf_lo(p.w), bf_hi(p.w) };
        u32x4 w; w.x = cvt_pk_bf16(o[0] * rs * g0[0] * sp[0], o[1] * rs * g0[1] * sp[1]); w.y = cvt_pk_bf16(o[2] * rs * g0[2] * sp[2], o[3] * rs * g0[3] * sp[3]);
        w.z = cvt_pk_bf16(o[4] * rs * g1[0] * sp[4], o[5] * rs * g1[1] * sp[5]); w.w = cvt_pk_bf16(o[6] * rs * g1[2] * sp[6], o[7] * rs * g1[3] * sp[7]);
        *(u32x4*)(Y + (size_t)t * 1024 + 512 + l8) = w;
    }
}

__device__ __forceinline__ void p9_ln1_router(const Frame& F) {
    LAS float* wrT = (LAS float*)F.lds;
    LAS float* lg = (LAS float*)(F.lds + 131072);
    LAS float* brs = (LAS float*)(F.lds + 131072 + 4096);
    LAS int* hist = (LAS int*)(F.lds + 131072 + 4096 + 128);
    for (int i = F.tid; i < 32768; i += NTHR) { const int k = i >> 5, e = i & 31; wrT[e * 1024 + k] = F.in[I_WR][i]; }
    if (F.tid < 32) brs[F.tid] = F.in[I_BR][F.tid];
    if (F.tid < NCH * 32) hist[F.tid] = 0;
    __syncthreads();
    float* V = F.out; bf16_t* U2 = (bf16_t*)(F.ws + WS_U); const float* ada = (const float*)(F.ws + WS_ADA);
    int* topi = (int*)(F.ws + WS_TOPI); float* topw = (float*)(F.ws + WS_TOPW);
    const int l4 = F.lane * 4;
    for (int g = F.c * 8 + F.wave; g < T / 4; g += F.G * 8) {
        const int t0 = g * 4, b = t0 >> 11;
        f32x4 xv[4][4];
#pragma unroll
        for (int tk = 0; tk < 4; ++tk)
#pragma unroll
            for (int j = 0; j < 4; ++j) xv[tk][j] = *(const f32x4*)(V + (size_t)(t0 + tk) * 1024 + 256 * j + l4);
        float mean[4], rstd[4];
#pragma unroll
        for (int tk = 0; tk < 4; ++tk) { float s = 0.f;
#pragma unroll
            for (int j = 0; j < 4; ++j) s += (xv[tk][j][0] + xv[tk][j][1]) + (xv[tk][j][2] + xv[tk][j][3]);
            s = wave_sum(s); mean[tk] = s * (1.0f / 1024.0f); float q = 0.f;
#pragma unroll
            for (int j = 0; j < 4; ++j) { const f32x4 d = xv[tk][j] - mean[tk]; q += (d[0] * d[0] + d[1] * d[1]) + (d[2] * d[2] + d[3] * d[3]); }
            q = wave_sum(q); rstd[tk] = __builtin_amdgcn_rsqf(q * (1.0f / 1024.0f) + LN_EPS); }
#pragma unroll
        for (int j = 0; j < 4; ++j) {
            const int k = 256 * j + l4;
            const f32x4 lg1 = *(const f32x4*)(F.in[I_LN1G] + k), lb1 = *(const f32x4*)(F.in[I_LN1B] + k);
            const f32x4 sh = *(const f32x4*)(ada + (size_t)b * 6144 + 3072 + k), sc = *(const f32x4*)(ada + (size_t)b * 6144 + 4096 + k);
#pragma unroll
            for (int tk = 0; tk < 4; ++tk) { const f32x4 x1 = (xv[tk][j] - mean[tk]) * rstd[tk] * lg1 + lb1;
                *(f32x4*)(V + (size_t)(t0 + tk) * 1024 + k) = x1;
                const f32x4 u2 = x1 * (sc + 1.0f) + sh; xv[tk][j] = u2;
                u32x2 w; w.x = cvt_pk_bf16(u2[0], u2[1]); w.y = cvt_pk_bf16(u2[2], u2[3]);
                *(u32x2*)(U2 + (size_t)(t0 + tk) * 1024 + k) = w; } }
#pragma unroll 1
        for (int eq = 0; eq < 4; ++eq) {
            float acc[4][8];
#pragma unroll
            for (int e = 0; e < 8; ++e) { acc[0][e] = 0.f; acc[1][e] = 0.f; acc[2][e] = 0.f; acc[3][e] = 0.f;
#pragma unroll
                for (int j = 0; j < 4; ++j) { const f32x4 w4 = *(const LAS f32x4*)(wrT + (eq * 8 + e) * 1024 + 256 * j + l4);
#pragma unroll
                    for (int tk = 0; tk < 4; ++tk) acc[tk][e] += (xv[tk][j][0] * w4[0] + xv[tk][j][1] * w4[1]) + (xv[tk][j][2] * w4[2] + xv[tk][j][3] * w4[3]); }
                if (e & 1) __builtin_amdgcn_sched_barrier(0); }
#pragma unroll
            for (int tk = 0; tk < 4; ++tk) {
                float v0, v1, v2, v3;
                { const bool up = (F.lane & 32) != 0;
                  v0 = (up ? acc[tk][4] : acc[tk][0]) + __shfl_xor(up ? acc[tk][0] : acc[tk][4], 32);
                  v1 = (up ? acc[tk][5] : acc[tk][1]) + __shfl_xor(up ? acc[tk][1] : acc[tk][5], 32);
                  v2 = (up ? acc[tk][6] : acc[tk][2]) + __shfl_xor(up ? acc[tk][2] : acc[tk][6], 32);
                  v3 = (up ? acc[tk][7] : acc[tk][3]) + __shfl_xor(up ? acc[tk][3] : acc[tk][7], 32); }
                { const bool up = (F.lane & 16) != 0;
                  const float a0 = (up ? v2 : v0) + __shfl_xor(up ? v0 : v2, 16), a1 = (up ? v3 : v1) + __shfl_xor(up ? v1 : v3, 16); v0 = a0; v1 = a1; }
                { const bool up = (F.lane & 8) != 0; v0 = (up ? v1 : v0) + __shfl_xor(up ? v0 : v1, 8); }
                v0 += __shfl_xor(v0, 4); v0 += __shfl_xor(v0, 2); v0 += __shfl_xor(v0, 1);
                const int e = eq * 8 + ((F.lane >> 5) & 1) * 4 + ((F.lane >> 4) & 1) * 2 + ((F.lane >> 3) & 1);
                if ((F.lane & 7) == 0) lg[(F.wave * 4 + tk) * 32 + e] = v0 + brs[e];
            }
        }
        asm volatile("s_waitcnt lgkmcnt(0)" ::: "memory");
        if (F.lane < 4) {
            const LAS float* L = lg + (F.wave * 4 + F.lane) * 32;
            float b0 = -3.0e38f, b1 = -3.0e38f, b2 = -3.0e38f, b3 = -3.0e38f; int i0 = 0, i1 = 0, i2 = 0, i3 = 0;
            for (int e = 0; e < 32; ++e) { const float x = L[e];
                if (x > b3) { b3 = x; i3 = e;
                    if (b3 > b2) { float tf = b2; b2 = b3; b3 = tf; int ti = i2; i2 = i3; i3 = ti;
                        if (b2 > b1) { tf = b1; b1 = b2; b2 = tf; ti = i1; i1 = i2; i2 = ti;
                            if (b1 > b0) { tf = b0; b0 = b1; b1 = tf; ti = i0; i0 = i1; i1 = ti; } } } } }
            const float p1 = fast_exp(b1 - b0), p2 = fast_exp(b2 - b0), p3 = fast_exp(b3 - b0), inv = 1.0f / (1.0f + p1 + p2 + p3);
            const int t = t0 + F.lane;
            *(int4*)(topi + (size_t)t * 4) = make_int4(i0, i1, i2, i3);
            *(f32x4*)(topw + (size_t)t * 4) = (f32x4){inv, p1 * inv, p2 * inv, p3 * inv};
            const int ch = t / TCH;
            atomicAdd((int*)(hist + ch * 32 + i0), 1); atomicAdd((int*)(hist + ch * 32 + i1), 1); atomicAdd((int*)(hist + ch * 32 + i2), 1); atomicAdd((int*)(hist + ch * 32 + i3), 1);
        }
    }
    __syncthreads();
    if (F.tid < NCH * 32) { const int h = hist[F.tid]; if (h) atomicAdd(F.ctl + CW_CNT + F.tid, (unsigned)h); }
}

__device__ __forceinline__ void p10_dispatch(const Frame& F) {
    LAS int* lcnt = (LAS int*)F.lds; LAS int* lbase = lcnt + 32; LAS int* pstart = lcnt + 64;
    const int* topi = (const int*)(F.ws + WS_TOPI); int* pos = (int*)(F.ws + WS_POS); int* rowtok = (int*)(F.ws + WS_ROWTOK);
    for (int s = F.c; s < T / 256; s += F.G) {
        const int ch = (s * 256) / TCH;
        __syncthreads();
        if (F.tid < 32) { lcnt[F.tid] = 0; int ps = 0; for (int e = 0; e < F.tid; ++e) { const int n = (int)__hip_atomic_load(F.ctl + CW_CNT + ch * 32 + e, __ATOMIC_RELAXED, __HIP_MEMORY_SCOPE_AGENT); ps += (n + 255) & ~255; } pstart[F.tid] = ps; }
        __syncthreads();
        int e2[2], r2[2];
#pragma unroll
        for (int i = 0; i < 2; ++i) { const int a = F.tid + i * NTHR; e2[i] = topi[(size_t)(s * 256) * 4 + a]; r2[i] = atomicAdd((int*)(lcnt + e2[i]), 1); }
        __syncthreads();
        if (F.tid < 32) lbase[F.tid] = (int)atomicAdd(F.ctl + CW_CUR + ch * 32 + F.tid, (unsigned)lcnt[F.tid]);
        __syncthreads();
#pragma unroll
        for (int i = 0; i < 2; ++i) { const int a = F.tid + i * NTHR, slot = pstart[e2[i]] + lbase[e2[i]] + r2[i];
            pos[(size_t)(s * 256) * 4 + a] = slot; rowtok[(size_t)ch * ROWS_CH + slot] = s * 256 + (a >> 2); }
    }
}
__device__ __forceinline__ int moe_blocks(const Frame& F, int ch, LAS unsigned char* blk_e) {
    LAS int* sh = (LAS int*)(blk_e + 1024);
    __syncthreads();
    if (F.tid == 0) { int nb = 0; for (int e = 0; e < 32; ++e) { const int n = ((int)__hip_atomic_load(F.ctl + CW_CNT + ch * 32 + e, __ATOMIC_RELAXED, __HIP_MEMORY_SCOPE_AGENT) + 255) >> 8; for (int i = 0; i < n; ++i) blk_e[nb + i] = (unsigned char)e; nb += n; } sh[0] = nb; }
    __syncthreads();
    return sh[0];
}

__device__ __forceinline__ void p13_combine_ln2(const Frame& F, int ch) {
    const bf16_t* YC = (const bf16_t*)(F.ws + WS_YCH); const int* pos = (const int*)(F.ws + WS_POS); const float* topw = (const float*)(F.ws + WS_TOPW);
    const float* ada = (const float*)(F.ws + WS_ADA); float* X1 = F.out;
    const int l4 = F.lane * 4;
    for (int t = ch * TCH + F.c * 8 + F.wave; t < (ch + 1) * TCH; t += F.G * 8) {
        const int b = t >> 11;
        const int4 ps = *(const int4*)(pos + (size_t)t * 4); const f32x4 tw = *(const f32x4*)(topw + (size_t)t * 4);
        f32x4 v[4];
#pragma unroll
        for (int j = 0; j < 4; ++j) { const int k = 256 * j + l4;
            const u32x2 y0 = *(const u32x2*)(YC + (size_t)ps.x * 1024 + k), y1 = *(const u32x2*)(YC + (size_t)ps.y * 1024 + k), y2 = *(const u32x2*)(YC + (size_t)ps.z * 1024 + k), y3 = *(const u32x2*)(YC + (size_t)ps.w * 1024 + k);
            f32x4 ff;
            ff[0] = tw[0] * bf_lo(y0.x) + tw[1] * bf_lo(y1.x) + tw[2] * bf_lo(y2.x) + tw[3] * bf_lo(y3.x);
            ff[1] = tw[0] * bf_hi(y0.x) + tw[1] * bf_hi(y1.x) + tw[2] * bf_hi(y2.x) + tw[3] * bf_hi(y3.x);
            ff[2] = tw[0] * bf_lo(y0.y) + tw[1] * bf_lo(y1.y) + tw[2] * bf_lo(y2.y) + tw[3] * bf_lo(y3.y);
            ff[3] = tw[0] * bf_hi(y0.y) + tw[1] * bf_hi(y1.y) + tw[2] * bf_hi(y2.y) + tw[3] * bf_hi(y3.y);
            const f32x4 x1 = *(const f32x4*)(X1 + (size_t)t * 1024 + k), g2 = *(const f32x4*)(ada + (size_t)b * 6144 + 5120 + k);
            v[j] = x1 * DN_ALPHA + g2 * ff; }
        float s = 0.f;
#pragma unroll
        for (int j = 0; j < 4; ++j) s += (v[j][0] + v[j][1]) + (v[j][2] + v[j][3]);
        s = wave_sum(s); const float mean = s * (1.0f / 1024.0f); float q = 0.f;
#pragma unroll
        for (int j = 0; j < 4; ++j) { const f32x4 d = v[j] - mean; q += (d[0] * d[0] + d[1] * d[1]) + (d[2] * d[2] + d[3] * d[3]); }
        q = wave_sum(q); const float rstd = __builtin_amdgcn_rsqf(q * (1.0f / 1024.0f) + LN_EPS);
#pragma unroll
        for (int j = 0; j < 4; ++j) { const int k = 256 * j + l4; const f32x4 g = *(const f32x4*)(F.in[I_LN2G] + k), bb = *(const f32x4*)(F.in[I_LN2B] + k);
            *(f32x4*)(X1 + (size_t)t * 1024 + k) = (v[j] - mean) * rstd * g + bb; }
    }
}

constexpr int SC_QD = 0, SC_KI = 17408, SC_KE = 34816, SC_VT = 53248, SC_SC = 71680, SC_ST = 80896, SC_GV = 115712, SC_CS = 116224;
__device__ __forceinline__ bf16x8 ldfrag(const LAS unsigned char* p) { return *(const LAS bf16x8*)p; }
__device__ __forceinline__ void p3_scan(const Frame& F) {
    LAS unsigned char* L = F.lds;
    const int tid = F.tid, w = F.wave, lane = F.lane, fr = lane & 15, fq = lane >> 4;
    const int d = tid & 127, qd = tid >> 7;
    bf16_t* PH = (bf16_t*)(F.ws + WS_PH); const bf16_t* PHC = (const bf16_t*)(F.ws + WS_PHC);
    for (int it = F.c; it < 256; it += F.G) {
        const int b = it >> 3, h = (it >> 1) & 3, dir = it & 1;
        const float r0 = F.in[I_LBRAW][dir * 512 + h * 128 + d], r1 = F.in[I_LBRAW][1024 + dir * 512 + h * 128 + d];
        const float lbv = fast_sigmoid(r0 - r1), oml = 1.0f - lbv;
        f32x4 Sacc[8];
#pragma unroll
        for (int i = 0; i < 8; ++i) Sacc[i] = (f32x4){0.f, 0.f, 0.f, 0.f};
        __syncthreads();
        for (int i = tid; i < 34816 / 4; i += NTHR) ((LAS unsigned*)(L + SC_ST))[i] = 0u;
        const int cq = h * 128 + d, cz = 512 + dir * 512 + h * 128 + d, cv = 1536 + h * 128 + d;
        bf16_t rq[16], rz[16], rv[16];
        {   const int n = dir ? 3 : 0; const bf16_t* base = PHC + (size_t)(b * 256 + 64 * n + 16 * qd) * 2048;
#pragma unroll
            for (int i = 0; i < 16; ++i) { rq[i] = base[(size_t)i * 2048 + cq]; rz[i] = base[(size_t)i * 2048 + cz]; rv[i] = base[(size_t)i * 2048 + cv]; } }
        for (int s = 0; s < 36; ++s) {
            const bool lat = s >= 4; const int n = lat ? (dir ? 31 - (s - 4) : (s - 4)) : (dir ? 3 - s : s);
            float kk[16], cum[16]; float run = 0.f;
#pragma unroll
            for (int i = 0; i < 16; ++i) { const float sg = fast_sigmoid(bf2f(rz[i])); kk[i] = oml * (1.0f - sg); cum[i] = fast_log(lbv + oml * sg); }
            if (dir == 0) {
#pragma unroll
                for (int i = 0; i < 16; ++i) { run += cum[i]; cum[i] = run; }
            } else {
#pragma unroll
                for (int i = 15; i >= 0; --i) { run += cum[i]; cum[i] = run; }
            }
            ((LAS float*)(L + SC_CS))[qd * 128 + d] = run;
            __syncthreads();
            {   const LAS float* cs = (const LAS float*)(L + SC_CS);
                const float c0 = cs[d], c1 = cs[128 + d], c2 = cs[256 + d], c3 = cs[384 + d], tot = (c0 + c1) + (c2 + c3);
                float off;
                if (dir == 0) off = (qd > 0 ? c0 : 0.f) + (qd > 1 ? c1 : 0.f) + (qd > 2 ? c2 : 0.f);
                else off = (qd < 3 ? c3 : 0.f) + (qd < 2 ? c2 : 0.f) + (qd < 1 ? c1 : 0.f);
                const float g = fast_exp(tot);
                if (qd == 0) ((LAS float*)(L + SC_GV))[d] = g;
                unsigned ke[8], vt[8];
#pragma unroll
                for (int i = 0; i < 16; i += 2) {
                    const float ca = cum[i] + off, cb = cum[i + 1] + off;
                    const float ea = fast_exp(ca), eb = fast_exp(cb), ia = __builtin_amdgcn_rcpf(ea), ib = __builtin_amdgcn_rcpf(eb);
                    const float qa = bf2f(rq[i]), qb = bf2f(rq[i + 1]);
                    const float qda = qa * fast_sigmoid(qa) * ea, qdb = qb * fast_sigmoid(qb) * eb;
                    const float kia = kk[i] * ia, kib = kk[i + 1] * ib;
                    const unsigned wa = cvt_pk_bf16(qda, kia), wb = cvt_pk_bf16(qdb, kib);
                    *(LAS bf16_t*)(L + SC_QD + (16 * qd + i) * 272 + d * 2) = (bf16_t)(wa & 0xffffu);
                    *(LAS bf16_t*)(L + SC_KI + (16 * qd + i) * 272 + d * 2) = (bf16_t)(wa >> 16);
                    *(LAS bf16_t*)(L + SC_QD + (16 * qd + i + 1) * 272 + d * 2) = (bf16_t)(wb & 0xffffu);
                    *(LAS bf16_t*)(L + SC_KI + (16 * qd + i + 1) * 272 + d * 2) = (bf16_t)(wb >> 16);
                    ke[i >> 1] = cvt_pk_bf16(kia * g, kib * g);
                    vt[i >> 1] = (unsigned)rv[i] | ((unsigned)rv[i + 1] << 16);
                }
                *(LAS u32x4*)(L + SC_KE + d * 144 + 32 * qd) = (u32x4){ke[0], ke[1], ke[2], ke[3]};
                *(LAS u32x4*)(L + SC_KE + d * 144 + 32 * qd + 16) = (u32x4){ke[4], ke[5], ke[6], ke[7]};
                *(LAS u32x4*)(L + SC_VT + d * 144 + 32 * qd) = (u32x4){vt[0], vt[1], vt[2], vt[3]};
                *(LAS u32x4*)(L + SC_VT + d * 144 + 32 * qd + 16) = (u32x4){vt[4], vt[5], vt[6], vt[7]};
            }
            if (s + 1 < 36) {
                const int s1 = s + 1; const bool lat1 = s1 >= 4; const int n1 = lat1 ? (dir ? 31 - (s1 - 4) : (s1 - 4)) : (dir ? 3 - s1 : s1);
                const bf16_t* base = lat1 ? (const bf16_t*)PH + (size_t)(b * 2048 + 64 * n1 + 16 * qd) * 2048 : PHC + (size_t)(b * 256 + 64 * n1 + 16 * qd) * 2048;
#pragma unroll
                for (int i = 0; i < 16; ++i) { rq[i] = base[(size_t)i * 2048 + cq]; rz[i] = base[(size_t)i * 2048 + cz]; rv[i] = base[(size_t)i * 2048 + cv]; }
            }
            __syncthreads();
            f32x4 oacc[4];
#pragma unroll
            for (int i = 0; i < 4; ++i) oacc[i] = (f32x4){0.f, 0.f, 0.f, 0.f};
            const int kb = fq * 16;
            if (lat) {
                const int ct = w >> 1, st0 = 2 * (w & 1);
#pragma unroll
                for (int j = 0; j < 2; ++j) { const int st = st0 + j; f32x4 sa = (f32x4){0.f, 0.f, 0.f, 0.f};
#pragma unroll
                    for (int ks = 0; ks < 4; ++ks) sa = __builtin_amdgcn_mfma_f32_16x16x32_bf16(ldfrag(L + SC_KI + (16 * st + fr) * 272 + ks * 64 + kb), ldfrag(L + SC_QD + (16 * ct + fr) * 272 + ks * 64 + kb), sa, 0, 0, 0);
                    const int cc = 16 * ct + fr, s0 = 16 * st + 4 * fq;
#pragma unroll
                    for (int i = 0; i < 4; ++i) { const bool keep = dir ? (s0 + i >= cc) : (s0 + i <= cc); sa[i] = keep ? sa[i] : 0.f; }
                    *(LAS u32x2*)(L + SC_SC + cc * 144 + s0 * 2) = (u32x2){cvt_pk_bf16(sa[0], sa[1]), cvt_pk_bf16(sa[2], sa[3])}; }
#pragma unroll
                for (int ct2 = 0; ct2 < 4; ++ct2)
#pragma unroll
                    for (int ks = 0; ks < 4; ++ks) oacc[ct2] = __builtin_amdgcn_mfma_f32_16x16x32_bf16(ldfrag(L + SC_ST + (16 * w + fr) * 272 + ks * 64 + kb), ldfrag(L + SC_QD + (16 * ct2 + fr) * 272 + ks * 64 + kb), oacc[ct2], 0, 0, 0);
            }
            {   const bf16x8 v0 = ldfrag(L + SC_VT + (16 * w + fr) * 144 + kb), v1 = ldfrag(L + SC_VT + (16 * w + fr) * 144 + 64 + kb);
#pragma unroll
                for (int dt = 0; dt < 8; ++dt) { const f32x4 gv = *(const LAS f32x4*)(L + SC_GV + (16 * dt + 4 * fq) * 4);
                    f32x4 a = Sacc[dt] * gv;
                    a = __builtin_amdgcn_mfma_f32_16x16x32_bf16(ldfrag(L + SC_KE + (16 * dt + fr) * 144 + kb), v0, a, 0, 0, 0);
                    a = __builtin_amdgcn_mfma_f32_16x16x32_bf16(ldfrag(L + SC_KE + (16 * dt + fr) * 144 + 64 + kb), v1, a, 0, 0, 0);
                    Sacc[dt] = a; } }
            __syncthreads();
#pragma unroll
            for (int dt = 0; dt < 8; ++dt) *(LAS u32x2*)(L + SC_ST + (16 * w + fr) * 272 + (16 * dt + 4 * fq) * 2) = (u32x2){cvt_pk_bf16(Sacc[dt][0], Sacc[dt][1]), cvt_pk_bf16(Sacc[dt][2], Sacc[dt][3])};
            if (lat) {
                const bf16x8 v0 = ldfrag(L + SC_VT + (16 * w + fr) * 144 + kb), v1 = ldfrag(L + SC_VT + (16 * w + fr) * 144 + 64 + kb);
                bf16_t* ob = PH + (size_t)(b * 2048 + 64 * n) * 2048 + 512 + dir * 512 + h * 128 + 16 * w + 4 * fq;
#pragma unroll
                for (int ct2 = 0; ct2 < 4; ++ct2) {
                    f32x4 a = oacc[ct2];
                    a = __builtin_amdgcn_mfma_f32_16x16x32_bf16(v0, ldfrag(L + SC_SC + (16 * ct2 + fr) * 144 + kb), a, 0, 0, 0);
                    a = __builtin_amdgcn_mfma_f32_16x16x32_bf16(v1, ldfrag(L + SC_SC + (16 * ct2 + fr) * 144 + 64 + kb), a, 0, 0, 0);
                    *(u32x2*)(ob + (size_t)(16 * ct2 + fr) * 2048) = (u32x2){cvt_pk_bf16(a[0], a[1]), cvt_pk_bf16(a[2], a[3])}; }
            }
        }
        __syncthreads();
    }
}

typedef short s16x4 __attribute__((ext_vector_type(4)));
__device__ __forceinline__ s16x4 tr_read(unsigned lds_addr) { s16x4 r; asm volatile("ds_read_b64_tr_b16 %0, %1\n\ts_waitcnt lgkmcnt(0)" : "=&v"(r) : "v"(lds_addr) : "memory"); return r; }
__device__ __forceinline__ bf16x8 cat4(s16x4 a, s16x4 b) { return (bf16x8){a[0], a[1], a[2], a[3], b[0], b[1], b[2], b[3]}; }
constexpr int FO_C = 131072, FO_S = 139264;
__device__ __forceinline__ void p4_fourier(const Frame& F) {
    LAS unsigned char* L = F.lds;
    const int tid = F.tid, w = F.wave, lane = F.lane, fr = lane & 15, fq = lane >> 4;
    const bf16_t* PA = (const bf16_t*)(F.ws + WS_PA); bf16_t* Y = (bf16_t*)(F.ws + WS_Y);
    __syncthreads();
    for (int i = tid; i < 4096; i += NTHR) { const int k2 = i >> 6, c = i & 63; const float a = (float)((k2 * c) & 63) * (1.0f / 64.0f);
        *(LAS bf16_t*)(L + FO_C + i * 2) = (bf16_t)(cvt_pk_bf16(__builtin_amdgcn_cosf(a) * 0.125f, 0.f) & 0xffffu);
        *(LAS bf16_t*)(L + FO_S + i * 2) = (bf16_t)(cvt_pk_bf16(__builtin_amdgcn_sinf(a) * 0.125f, 0.f) & 0xffffu); }
    bf16x8 Gf[2][2];
#pragma unroll
    for (int nt = 0; nt < 2; ++nt)
#pragma unroll
        for (int ks = 0; ks < 2; ++ks) { unsigned pk[4];
#pragma unroll
            for (int j = 0; j < 8; j += 2) { const int k1 = 16 * nt + fr, ra = 8 * fq + j, rb = ra + 1; const float aa = (float)((k1 * ra) & 31) * (1.0f / 32.0f), ab = (float)((k1 * rb) & 31) * (1.0f / 32.0f);
                const float va = (ks ? __builtin_amdgcn_sinf(aa) : __builtin_amdgcn_cosf(aa)) * 0.17677669529663687f, vb = (ks ? __builtin_amdgcn_sinf(ab) : __builtin_amdgcn_cosf(ab)) * 0.17677669529663687f;
                pk[j >> 1] = cvt_pk_bf16(va, vb); }
            u32x4 t4 = (u32x4){pk[0], pk[1], pk[2], pk[3]}; Gf[nt][ks] = *(bf16x8*)&t4; }
    const unsigned lbase = (unsigned)(size_t)L;
    for (int it = F.c; it < 1024; it += F.G) {
        const int xcd = it & 7, jj = it >> 3, slab = 4 * xcd + (jj & 3), b = jj >> 2;
        __syncthreads();
        {   u32x4 v[16];
#pragma unroll
            for (int n = 0; n < 16; ++n) { const int q = tid + NTHR * n, t = q >> 2, reim = (q >> 1) & 1, half = q & 1;
                v[n] = *(const u32x4*)(PA + (size_t)(b * 2048 + t) * 1024 + reim * 512 + slab * 16 + half * 8); }
#pragma unroll
            for (int n = 0; n < 16; ++n) *(LAS u32x4*)(L + (tid + NTHR * n) * 16) = v[n]; }
        __syncthreads();
#pragma unroll 1
        for (int rr = 0; rr < 4; ++rr) {
            const int r = w + 8 * rr;
            f32x4 acc[8];
#pragma unroll
            for (int i = 0; i < 8; ++i) acc[i] = (f32x4){0.f, 0.f, 0.f, 0.f};
#pragma unroll
            for (int ks = 0; ks < 4; ++ks) {
                const int ri = ks >> 1, c0 = 32 * (ks & 1) + 8 * fq + (fr >> 2);
                const unsigned a0 = lbase + (unsigned)((r * 64 + c0) * 64 + ri * 32 + (fr & 3) * 8);
                const bf16x8 af = cat4(tr_read(a0), tr_read(a0 + 4 * 64));
#pragma unroll
                for (int nt = 0; nt < 8; ++nt) { const int ro = nt >> 2, k2 = 16 * (nt & 3) + fr;
                    u32x4 bw = *(const LAS u32x4*)(L + ((ro == ri) ? FO_C : FO_S) + (k2 * 64 + 32 * (ks & 1) + 8 * fq) * 2);
                    if (ro == 1 && ri == 0) { bw.x ^= 0x80008000u; bw.y ^= 0x80008000u; bw.z ^= 0x80008000u; bw.w ^= 0x80008000u; }
                    acc[nt] = __builtin_amdgcn_mfma_f32_16x16x32_bf16(af, *(bf16x8*)&bw, acc[nt], 0, 0, 0); }
            }
#pragma unroll
            for (int nt = 0; nt < 8; ++nt) { const int ro = nt >> 2, k2 = 16 * (nt & 3) + fr;
                *(LAS u32x2*)(L + (r * 64 + k2) * 64 + ro * 32 + fq * 8) = (u32x2){cvt_pk_bf16(acc[nt][0], acc[nt][1]), cvt_pk_bf16(acc[nt][2], acc[nt][3])}; }
        }
        __syncthreads();
#pragma unroll 1
        for (int kk = 0; kk < 8; ++kk) {
            const int k2 = 8 * w + kk;
            f32x4 a2[2] = {(f32x4){0.f, 0.f, 0.f, 0.f}, (f32x4){0.f, 0.f, 0.f, 0.f}};
#pragma unroll
            for (int ks = 0; ks < 2; ++ks) {
                const int r0 = 8 * fq + (fr >> 2);
                const unsigned a0 = lbase + (unsigned)((r0 * 64 + k2) * 64 + ks * 32 + (fr & 3) * 8);
                const bf16x8 af = cat4(tr_read(a0), tr_read(a0 + 4 * 64 * 64));
                a2[0] = __builtin_amdgcn_mfma_f32_16x16x32_bf16(af, Gf[0][ks], a2[0], 0, 0, 0);
                a2[1] = __builtin_amdgcn_mfma_f32_16x16x32_bf16(af, Gf[1][ks], a2[1], 0, 0, 0);
            }
#pragma unroll
            for (int nt = 0; nt < 2; ++nt) { const int k1 = 16 * nt + fr;
                *(u32x2*)(Y + (size_t)(b * 2048 + k1 * 64 + k2) * 1024 + slab * 16 + 4 * fq) = (u32x2){cvt_pk_bf16(a2[nt][0], a2[nt][1]), cvt_pk_bf16(a2[nt][2], a2[nt][3])}; }
        }
    }
    __syncthreads();
}

struct Args { const float* in[22]; float* out; unsigned char* ws; int ph_lo, ph_hi; };
constexpr int N_PHASES = 9 + 3 * NCH;

__global__ void __launch_bounds__(NTHR, 2) mega_fwd(Args args) {
    extern __shared__ __attribute__((aligned(16))) unsigned char lds_raw[];
    Frame F;
    F.lds = (LAS unsigned char*)lds_raw;
    F.tid = threadIdx.x; F.lane = F.tid & 63; F.wave = __builtin_amdgcn_readfirstlane(F.tid >> 6);
    F.G = gridDim.x; F.c = blockIdx.x;
    F.in = args.in;
    F.out = args.out; F.ws = args.ws; F.ctl = (unsigned*)(args.ws + WS_CTL);
    volatile LAS unsigned* misc = (volatile LAS unsigned*)(F.lds + LDS_MISC);
    if (F.tid < 4) misc[F.tid] = 0u;
    __syncthreads();
    XcdBarrier bar = xcd_barrier_post(F.ctl, misc);
    const int lo = args.ph_lo, hi = args.ph_hi;
#ifndef PHASE_MASK
#define PHASE_MASK 0xFFFFFFFFu
#endif
#define IN(k) ((((PHASE_MASK) >> (k)) & 1u) && lo <= (k) && (k) < hi)
#define SEAM(k) do { if (IN(k) && IN((k) + 1)) xcd_barrier(bar); } while (0)
    unsigned char* ws = F.ws;
    LAS unsigned char* blk_e = F.lds + LDS_MISC + 64;

    if (IN(0)) { p0_ada(F); p0_fold(F); p0_convert(F); }
    SEAM(0);
    if (IN(1)) { p1_uprep(F); }
    SEAM(1);
    if (IN(2)) {
        ProbP1 P{(const char*)(ws + WS_U), 16, 2048u, (const char*)(ws + WS_WIN1T), (unsigned)(WS_UC - WS_U), F.G, F.c};
        EpiP1 E{(bf16_t*)(ws + WS_PA), (bf16_t*)(ws + WS_PH), (bf16_t*)(ws + WS_PHC)};
        pg8::gemm_phase<ProbP1, EpiP1, true, false>(F.lds, P, E);
    }
    SEAM(2);
    if (IN(3)) {
#ifndef NO_SCAN
        p3_scan(F);
#endif
#ifndef NO_FOURIER
        p4_fourier(F);
#endif
#ifndef NO_P2GEMM
        ProbDense P{(const char*)(ws + WS_U), 16, 2048u, 2048u, (const char*)(ws + WS_WIN2T), 256, 10, F.G, F.c};
        EpiP2 E{(bf16_t*)(ws + WS_PG), (bf16_t*)F.out};
        pg8::gemm_phase<ProbDense, EpiP2, true, false>(F.lds, P, E);
#endif
    }
    SEAM(3);
    if (IN(4)) { p6_readout(F); }
    SEAM(4);
    if (IN(5)) {
        ProbDense P{(const char*)(ws + WS_Y), 16, 2048u, 2048u, (const char*)(ws + WS_WMT), 256, 4, F.G, F.c};
        EpiM1 E{(const bf16_t*)F.out, (bf16_t*)(ws + WS_PA)};
        pg8::gemm_phase<ProbDense, EpiM1, true, true>(F.lds, P, E);
    }
    SEAM(5);
    if (IN(6)) {
        ProbDense P{(const char*)(ws + WS_PA), 16, 2048u, 2048u, (const char*)(ws + WS_WOT), 256, 4, F.G, F.c};
        EpiM2 E{F.in[I_X], (const float*)(ws + WS_ADA), F.out};
        pg8::gemm_phase<ProbDense, EpiM2, true, false>(F.lds, P, E);
    }
    SEAM(6);
    if (IN(7)) { p9_ln1_router(F); }
    SEAM(7);
    if (IN(8)) { p10_dispatch(F); }
    SEAM(8);
#pragma unroll
    for (int ch = 0; ch < NCH; ++ch) {
        if (IN(9 + 3 * ch)) {
            const int nblk = moe_blocks(F, ch, blk_e);
            ProbMoE<true> P{(const char*)(ws + WS_U), 16, 2048u, (const char*)(ws + WS_WGUT), (size_t)2048 * 1024 * 2, 8, nblk, F.G, F.c, (const int*)(ws + WS_ROWTOK) + (size_t)ch * ROWS_CH, blk_e};
            EpiGU E{F.in[I_BGU], (bf16_t*)(ws + WS_ACT)};
            pg8::gemm_phase<ProbMoE<true>, EpiGU, true, false>(F.lds, P, E);
        }
        SEAM(9 + 3 * ch);
        if (IN(10 + 3 * ch)) {
            const int nblk = moe_blocks(F, ch, blk_e);
            ProbMoE<false> P{(const char*)(ws + WS_ACT), 16, 2048u, (const char*)(ws + WS_WDNT), (size_t)1024 * 1024 * 2, 4, nblk, F.G, F.c, nullptr, blk_e};
            EpiDN E{F.in[I_BDN], (bf16_t*)(ws + WS_YCH)};
            pg8::gemm_phase<ProbMoE<false>, EpiDN, true, false>(F.lds, P, E);
        }
        SEAM(10 + 3 * ch);
        if (IN(11 + 3 * ch)) { p13_combine_ln2(F, ch); }
        SEAM(11 + 3 * ch);
    }
#ifdef DBG_K
    xcd_barrier(bar);
    {
        const unsigned char* buf = (DBG_OUT) ? (const unsigned char*)F.out : (const unsigned char*)(ws + (size_t)(DBG_OFF));
        const size_t wpr = (size_t)(DBG_CW) / 4, nw = (size_t)(DBG_ROWS) * wpr;
        unsigned long long cs = 0; unsigned bad = 0;
        for (size_t i = (size_t)F.c * NTHR + F.tid; i < nw; i += (size_t)F.G * NTHR) { const size_t r = i / wpr, cw = i % wpr; const unsigned w = *(const unsigned*)(buf + r * (size_t)(DBG_LD) + (DBG_C0) + cw * 4); cs += w;
            if (DBG_F32) { if ((w & 0x7f800000u) == 0x7f800000u) ++bad; } else { if ((w & 0x7f80u) == 0x7f80u) ++bad; if ((w & 0x7f800000u) == 0x7f800000u) ++bad; } }
        for (int o = 32; o >= 1; o >>= 1) { cs += __shfl_xor(cs, o); bad += __shfl_xor(bad, o); }
        if (F.lane == 0) { atomicAdd((unsigned long long*)(F.ctl + 8192), cs); atomicAdd(F.ctl + 8200, bad); }
        if (F.c == 0 && F.tid == 0) atomicAdd(F.ctl + 8201, xb_ld(&F.ctl[XB_TMO]));
    }
    xcd_barrier(bar);
    {
        const unsigned long long cs = __hip_atomic_load((unsigned long long*)(F.ctl + 8192), __ATOMIC_RELAXED, __HIP_MEMORY_SCOPE_AGENT);
        const unsigned bad = xb_ld(F.ctl + 8200), tmo = xb_ld(F.ctl + 8201);
        const float val = (float)(unsigned)((cs ^ (cs >> 16) ^ (cs >> 32)) & 0xFFFFu) * (1.0f / 65536.0f) + (bad ? 2.0f : 0.0f) + (tmo ? 4.0f : 0.0f);
        for (size_t i = (size_t)F.c * NTHR + F.tid; i < (size_t)T * D; i += (size_t)F.G * NTHR) F.out[i] = val;
    }
    return;
#endif
    if (F.c == 0 && F.tid == 0 && hi == N_PHASES) { if (xb_ld(&F.ctl[XB_TMO]) != 0u) F.out[0] = __builtin_nanf(""); }
#undef IN
#undef SEAM
}

extern "C" void kernel_launch(void* const* d_in, const int* in_sizes, int n_in, void* d_out, int out_size, void* d_ws, size_t ws_size, hipStream_t stream) {
    static int grid = 0;
    if (grid == 0) {
        if (n_in != 22 || out_size != T * D || ws_size < WS_END) { fprintf(stderr, "kernel_launch: unexpected shapes (n_in %d, out %d, ws %zu)\n", n_in, out_size, ws_size); grid = -1; return; }
        int dev = 0, cus = 0, per_cu = 0;
        if (hipGetDevice(&dev) != hipSuccess || hipDeviceGetAttribute(&cus, hipDeviceAttributeMultiprocessorCount, dev) != hipSuccess) { grid = -1; return; }
        if (hipFuncSetAttribute((const void*)mega_fwd, hipFuncAttributeMaxDynamicSharedMemorySize, LDS_BYTES) != hipSuccess) { fprintf(stderr, "kernel_launch: hipFuncSetAttribute failed\n"); grid = -1; return; }
        if (hipOccupancyMaxActiveBlocksPerMultiprocessor(&per_cu, (const void*)mega_fwd, NTHR, LDS_BYTES) != hipSuccess || per_cu < 1) fprintf(stderr, "kernel_launch: occupancy query reports %d blocks per CU\n", per_cu);
        (void)hipGetLastError();
        grid = cus;
    }
    if (grid < 0) return;
    (void)hipMemsetAsync((char*)d_ws + WS_CTL, 0, CTL_BYTES, stream);
    Args a{};
    for (int i = 0; i < 22; ++i) a.in[i] = (const float*)d_in[i];
    a.out = (float*)d_out; a.ws = (unsigned char*)d_ws; a.ph_lo = 0; a.ph_hi = N_PHASES;
#ifdef DBG_K
    a.ph_hi = DBG_K;
#endif
    hipLaunchKernelGGL(mega_fwd, dim3(grid), dim3(NTHR), LDS_BYTES, stream, a);
}
```

```cpp
#include <hip/hip_runtime.h>
#include <cstdio>
#include <cstdint>

#define LAS __attribute__((address_space(3)))
typedef unsigned short bf16_t;
typedef short bf16x8 __attribute__((ext_vector_type(8)));
typedef short bf16x4 __attribute__((ext_vector_type(4)));
typedef float f32x4 __attribute__((ext_vector_type(4)));
typedef float f32x2 __attribute__((ext_vector_type(2)));
typedef unsigned u32x4 __attribute__((ext_vector_type(4)));
typedef unsigned u32x2 __attribute__((ext_vector_type(2)));

constexpr int D = 1024, NB = 32, SEQ = 2048, T = NB * SEQ, CTX = 256, TCX = NB * CTX;
constexpr int NEXP = 32, TOPK = 4;
constexpr int NCH = 2, TCH = T / NCH;
constexpr int ROWS_CH = TCH * TOPK + NEXP * 256;
constexpr float DN_ALPHA = 1.189207115002721f;
constexpr float LN_EPS = 1e-5f, RMS_EPS = 1e-6f;
constexpr int NTHR = 512;

constexpr size_t MiB = 1ull << 20;
constexpr size_t WS_CTL = 0;
constexpr size_t CTL_BYTES = 65536;
constexpr size_t WS_ADA = 65536;
constexpr size_t WS_WIN1T = 1 * MiB;
constexpr size_t WS_WIN2T = 7 * MiB;
constexpr size_t WS_WMT = 12 * MiB;
constexpr size_t WS_WOT = 14 * MiB;
constexpr size_t WS_WGUT = 16 * MiB;
constexpr size_t WS_WDNT = 144 * MiB;
constexpr size_t WS_TOPI = 208 * MiB;
constexpr size_t WS_TOPW = 209 * MiB;
constexpr size_t WS_POS = 210 * MiB;
constexpr size_t WS_ROWTOK = 211 * MiB;
constexpr size_t WS_U = 216 * MiB;
constexpr size_t WS_PA = 344 * MiB;
constexpr size_t WS_PH = 472 * MiB;
constexpr size_t WS_PHC = 728 * MiB;
constexpr size_t WS_PG = 760 * MiB;
constexpr size_t WS_Y = 824 * MiB;
constexpr size_t WS_UC = WS_Y;
constexpr size_t WS_ACT = WS_PA;
constexpr size_t WS_YCH = WS_PA + 272 * MiB;
constexpr size_t WS_END = 952 * MiB;
static_assert(WS_YCH + 272 * MiB <= WS_END, "ws map");
constexpr int CW_CNT = 4096;
constexpr int CW_CUR = 4096 + 64;

constexpr int LDS_SCRATCH = 147456;
constexpr int LDS_MISC = LDS_SCRATCH;
constexpr int LDS_BYTES = LDS_SCRATCH + 2048;

typedef __bf16 bf16x2_t __attribute__((ext_vector_type(2)));
__device__ __forceinline__ unsigned cvt_pk_bf16(float lo, float hi) { const f32x2 v = {lo, hi}; const bf16x2_t r = __builtin_convertvector(v, bf16x2_t); return __builtin_bit_cast(unsigned, r); }
__device__ __forceinline__ unsigned cvt_pk4_fp8(float a, float b, float c, float d) {
    a = fminf(fmaxf(a, -448.f), 448.f); b = fminf(fmaxf(b, -448.f), 448.f); c = fminf(fmaxf(c, -448.f), 448.f); d = fminf(fmaxf(d, -448.f), 448.f);
    int w = __builtin_amdgcn_cvt_pk_fp8_f32(a, b, 0, false); w = __builtin_amdgcn_cvt_pk_fp8_f32(c, d, w, true); return (unsigned)w; }
constexpr float W8_SCALE = 32.0f, W8_INV = 1.0f / 32.0f;
__device__ __forceinline__ float bf_lo(unsigned w) { return __uint_as_float(w << 16); }
__device__ __forceinline__ float bf_hi(unsigned w) { return __uint_as_float(w & 0xffff0000u); }
__device__ __forceinline__ float bf2f(bf16_t v) { return __uint_as_float(((unsigned)v) << 16); }
__device__ __forceinline__ float fast_exp(float x) { return __builtin_amdgcn_exp2f(x * 1.4426950408889634f); }
__device__ __forceinline__ float fast_sigmoid(float x) { return __builtin_amdgcn_rcpf(1.0f + fast_exp(-x)); }
__device__ __forceinline__ float fast_log(float x) { return __builtin_amdgcn_logf(x) * 0.6931471805599453f; }

#define XB_TMO      128
#define XB_XCNT(j)  (256  + 64 * (j))
#define XB_XSUB(j)  (1280 + 64 * (j))
#define XB_XGEN(j)  (2304 + 64 * (j))
#define XB_TOP      3328
#define XB_TOPGEN   3392
#define XCD_BAR_WORDS 3456
#define XB_SPIN_CAP (1u << 18)

__device__ __forceinline__ unsigned xb_ld(unsigned* p)              { return __hip_atomic_load(p, __ATOMIC_RELAXED, __HIP_MEMORY_SCOPE_AGENT); }
__device__ __forceinline__ unsigned xb_add(unsigned* p, unsigned v) { return __hip_atomic_fetch_add(p, v, __ATOMIC_RELAXED, __HIP_MEMORY_SCOPE_AGENT); }
__device__ __forceinline__ unsigned xb_xcc_id() { return (unsigned)__builtin_amdgcn_s_getreg((3 << 11) | 20) & 0xFu; }
#define XB_SPIN(cond, bar) do { unsigned _sp = 0; while (cond) { __builtin_amdgcn_s_sleep(1); \
    if ((++_sp & 255u) == 0u) { if (xb_ld(&(bar)[XB_TMO])) break; if (_sp > XB_SPIN_CAP) { atomicAdd(&(bar)[XB_TMO], 1u); break; } } } } while (0)

struct XcdBarrier { unsigned* bar; unsigned x; volatile LAS unsigned* st; };

__device__ __forceinline__ XcdBarrier xcd_barrier_post(unsigned* bar, volatile LAS unsigned* st) {
    XcdBarrier b; b.bar = bar; b.x = xb_xcc_id(); b.st = st;
    if (threadIdx.x == 0) (void)xb_add(&bar[XB_XCNT(b.x)], 1u);
    return b;
}
__device__ __forceinline__ void xcd_barrier_complete(unsigned* bar, unsigned x, unsigned& nloc, unsigned& nx) {
    const unsigned G = gridDim.x * gridDim.y * gridDim.z;
    unsigned sum, cnt, mine, sp = 0u;
    for (;;) {
        sum = 0u; cnt = 0u; mine = 0u;
#pragma unroll
        for (unsigned j = 0; j < 16; ++j) { const unsigned c = xb_ld(&bar[XB_XCNT(j)]); sum += c; cnt += (c > 0u) ? 1u : 0u; mine = (j == x) ? c : mine; }
        if (sum == G) break;
        __builtin_amdgcn_s_sleep(1);
        if ((++sp & 255u) == 0u) { if (xb_ld(&bar[XB_TMO])) break; if (sp > XB_SPIN_CAP) { atomicAdd(&bar[XB_TMO], 1u); break; } }
    }
    nloc = mine > 0u ? mine : 1u; nx = cnt > 0u ? cnt : 1u;
}
__device__ __forceinline__ void xcd_barrier(const XcdBarrier& b) {
    asm volatile("s_waitcnt vmcnt(0)" ::: "memory");
    __syncthreads();
    if (threadIdx.x == 0) {
        unsigned* bar = b.bar;
        __builtin_amdgcn_s_waitcnt(0);
        unsigned nloc = b.st[0], nx = b.st[1];
        if (nloc == 0u) { xcd_barrier_complete(bar, b.x, nloc, nx); b.st[0] = nloc; b.st[1] = nx; }
        const unsigned old = xb_add(&bar[XB_XSUB(b.x)], 1u);
        const unsigned gen = old / nloc;
        if (old + 1u == (gen + 1u) * nloc) {
            __builtin_amdgcn_fence(__ATOMIC_RELEASE, "agent");
            asm volatile("s_waitcnt vmcnt(0)" ::: "memory");
            const unsigned og = xb_add(&bar[XB_TOP], 1u);
            const unsigned tg = og / nx;
            if (og + 1u == (tg + 1u) * nx) xb_add(&bar[XB_TOPGEN], 1u);
            else XB_SPIN(xb_ld(&bar[XB_TOPGEN]) == tg, bar);
            __builtin_amdgcn_fence(__ATOMIC_ACQUIRE, "agent");
            xb_add(&bar[XB_XGEN(b.x)], 1u);
            asm volatile("s_waitcnt vmcnt(0)" ::: "memory");
        } else {
            XB_SPIN(xb_ld(&bar[XB_XGEN(b.x)]) == gen, bar);
            __builtin_amdgcn_fence(__ATOMIC_ACQUIRE, "agent");
            asm volatile("s_waitcnt vmcnt(0)" ::: "memory");
        }
    }
    __syncthreads();
}

namespace pg8 {
constexpr int BM = 256, BK = 64, HALF = 128, HTB = HALF * BK * 2, STAGE_BYTES = 8 * HTB, NXCD = 8, WGM = 8;
__host__ __device__ __forceinline__ int lds_byte(int r, int c) { const int st = (r >> 4) * 2 + (c >> 5), rr = r & 15, cc = c & 31, ob = rr * 64 + cc * 2; return st * 1024 + (ob ^ (((ob >> 9) & 1) << 5)); }
__host__ __device__ __forceinline__ void stage_rc(int b, int& R, int& C) { const int st = b / 1024, sb = b % 1024, swz = sb ^ (((sb >> 9) & 1) << 5); R = (st >> 1) * 16 + swz / 64; C = (st & 1) * 32 + (swz % 64) / 2; }
__host__ __device__ __forceinline__ int perm32(int rho) { const int n = rho >> 4, i = rho & 15; return 8 * (i >> 2) + 4 * n + (i & 3); }

struct Unit { int pm, pn, aux; };

__device__ __forceinline__ void grouped(int wgid, int nM, int nN, int& pm, int& pn) {
    const int nig = WGM * nN, gid = wgid / nig, fm = gid * WGM, gsz = (nM - fm) < WGM ? (nM - fm) : WGM;
    pm = fm + ((wgid % nig) % gsz); pn = (wgid % nig) / gsz;
}
__device__ __forceinline__ bool xcd_remap(int i, int G, int c, int nwg, int& wgid) {
    const long L = (long)i * G + c; if (L >= nwg) return false;
    wgid = (int)L; const int q = nwg / NXCD, r = nwg % NXCD, xcd = wgid % NXCD, off = wgid / NXCD;
    wgid = (xcd < r ? xcd * (q + 1) : r * (q + 1) + (xcd - r) * q) + off; return true;
}

typedef int i32x8 __attribute__((ext_vector_type(8)));
typedef int i32x4 __attribute__((ext_vector_type(4)));
template <bool F8> struct Frags;
template <> struct Frags<false> { bf16x8 a[4][2], b0[2][2], b1[2][2]; };
template <> struct Frags<true> { i32x8 a[4], b0[2], b1[2]; };
template <class Prob, class Epi, bool ALIGN_EPI, bool HOOK, bool FP8 = false>
__device__ __forceinline__ void gemm_phase(LAS unsigned char* lds, const Prob& P, const Epi& E) {
    int tid_ = threadIdx.x; asm volatile("" : "+v"(tid_));
    const int tid = tid_, wid = __builtin_amdgcn_readfirstlane(tid >> 6), lane = tid & 63, wr = wid >> 2, wc = wid & 3, fr = lane & 15, fq = lane >> 4;
    const int nt = P.nt;
    unsigned voffB[2], voffA[2];
#pragma unroll
    for (int i = 0; i < 2; ++i) { int R, C; stage_rc(tid * 16 + i * 8192, R, C); const int Rb = Epi::PERM ? ((R & ~31) + perm32(R & 31)) : R;
        voffB[i] = (unsigned)Rb * P.ldb2 + (unsigned)C * 2u; voffA[i] = (unsigned)R * P.lda2 + (unsigned)C * 2u; }
    auto gather_offs = [&](const Unit& u, unsigned (&o0)[2], unsigned (&o1)[2]) {
#pragma unroll
        for (int i = 0; i < 2; ++i) { int R, C; int tt = threadIdx.x; asm volatile("" : "+v"(tt)); stage_rc(tt * 16 + i * 8192, R, C); o0[i] = P.a_row(u, R) + (unsigned)C * 2u; o1[i] = P.a_row(u, HALF + R) + (unsigned)C * 2u; } };
    const size_t kstep = (size_t)(BK * 2);
    const size_t hstepB = (size_t)HALF * P.ldb2;
    const size_t hstepA = (size_t)HALF * P.lda2;
    const unsigned ldsw = (unsigned)wid * 1024u;
    const int aoff = lds_byte(wr * 64 + fr, fq * 8), boff = lds_byte(wc * 32 + fr, fq * 8);
#define PG8_SA(b, h) (((b) * 2 + (h)) * HTB)
#define PG8_SB(b, h) ((4 + (b) * 2 + (h)) * HTB)
#define PG8_STAGE(bufoff, gbase, voff) do { _Pragma("unroll") for (int _i = 0; _i < 2; ++_i) \
        __builtin_amdgcn_global_load_lds((const unsigned*)((const char*)(gbase) + (voff)[_i]), (LAS unsigned*)(lds + (bufoff) + ldsw + _i * 8192), 16, 0, 0); } while (0)
#define PG8_LDA(dst, b, h) do { if constexpr (FP8) { _Pragma("unroll") for (int m = 0; m < 4; ++m) { FR.a[m].lo = *(const LAS i32x4*)(lds + PG8_SA(b, h) + aoff + m * 2048); FR.a[m].hi = *(const LAS i32x4*)(lds + PG8_SA(b, h) + aoff + m * 2048 + 1024); } } \
        else { _Pragma("unroll") for (int m = 0; m < 4; ++m) _Pragma("unroll") for (int k = 0; k < 2; ++k) FR.a[m][k] = *(const LAS bf16x8*)(lds + PG8_SA(b, h) + aoff + m * 2048 + k * 1024); } } while (0)
#define PG8_LDB(dst, b, h) do { if constexpr (FP8) { _Pragma("unroll") for (int n = 0; n < 2; ++n) { FR.dst[n].lo = *(const LAS i32x4*)(lds + PG8_SB(b, h) + boff + n * 2048); FR.dst[n].hi = *(const LAS i32x4*)(lds + PG8_SB(b, h) + boff + n * 2048 + 1024); } } \
        else { _Pragma("unroll") for (int n = 0; n < 2; ++n) _Pragma("unroll") for (int k = 0; k < 2; ++k) FR.dst[n][k] = *(const LAS bf16x8*)(lds + PG8_SB(b, h) + boff + n * 2048 + k * 1024); } } while (0)
#define PG8_MMA(ai, bj, At, Bt) do { __builtin_amdgcn_s_setprio(1); if constexpr (FP8) { _Pragma("unroll") for (int m = 0; m < 4; ++m) _Pragma("unroll") for (int n = 0; n < 2; ++n) \
            asm volatile("v_mfma_f32_16x16x128_f8f6f4 %0, %1, %2, %0" : "+v"(acc[ai][bj][m][n]) : "v"(FR.Bt[n]), "v"(FR.a[m])); } \
        else { _Pragma("unroll") for (int m = 0; m < 4; ++m) _Pragma("unroll") for (int n = 0; n < 2; ++n) _Pragma("unroll") for (int k = 0; k < 2; ++k) \
        acc[ai][bj][m][n] = __builtin_amdgcn_mfma_f32_16x16x32_bf16(FR.Bt[n][k], FR.a[m][k], acc[ai][bj][m][n], 0, 0, 0); } __builtin_amdgcn_s_setprio(0); } while (0)
#define PG8_WAIT_V(n) asm volatile("s_waitcnt vmcnt(" #n ")" ::: "memory")
#define PG8_WAIT_L(n) asm volatile("s_waitcnt lgkmcnt(" #n ")" ::: "memory")
#define PG8_BAR __builtin_amdgcn_s_barrier()
#define PG8_SCHED __builtin_amdgcn_sched_barrier(0)
    Unit cur, nxt; int ui = 0;
    if (!P.unit(0, cur)) return;
    f32x4 acc[2][2][4][2];
#pragma unroll
    for (int a = 0; a < 2; ++a)
#pragma unroll
        for (int b = 0; b < 2; ++b)
#pragma unroll
            for (int m = 0; m < 4; ++m)
#pragma unroll
                for (int n = 0; n < 2; ++n) acc[a][b][m][n] = (f32x4){0.f, 0.f, 0.f, 0.f};
    Frags<FP8> FR;
    unsigned va0[2], va1[2], vn0[2], vn1[2];
    const char* const gA = P.Abase; const char* cA = gA; const char* nA = gA; const char* cB = P.b_tile(cur);
    if constexpr (Prob::GATHER) {
        gather_offs(cur, va0, va1);
    } else { cA = gA + P.a_row(cur, 0); }
#define PG8_STAGE_A(bufoff, h, koff, nx) do { if constexpr (Prob::GATHER) { unsigned _v[2]; _Pragma("unroll") for (int _i = 0; _i < 2; ++_i) _v[_i] = (nx) ? ((h) ? vn1[_i] : vn0[_i]) : ((h) ? va1[_i] : va0[_i]); PG8_STAGE(bufoff, gA + (koff), _v); } \
        else { PG8_STAGE(bufoff, ((nx) ? nA : cA) + (h) * hstepA + (koff), voffA); } } while (0)
    PG8_STAGE(PG8_SB(0, 0), cB, voffB); PG8_STAGE(PG8_SB(0, 1), cB + hstepB, voffB); PG8_STAGE_A(PG8_SA(0, 0), 0, 0, false); PG8_STAGE_A(PG8_SA(0, 1), 1, 0, false);
    if (wr == 1) PG8_BAR;
    PG8_WAIT_V(2); PG8_BAR;
    PG8_STAGE(PG8_SB(1, 0), cB + kstep, voffB); PG8_STAGE_A(PG8_SA(1, 0), 0, kstep, false); PG8_STAGE(PG8_SB(1, 1), cB + hstepB + kstep, voffB);
    PG8_WAIT_V(6); PG8_BAR;
    for (;;) {
        const bool has_next = P.unit(ui + 1, nxt);
        if (!has_next) nxt = cur;
        if constexpr (Prob::GATHER) {
            gather_offs(nxt, vn0, vn1);
        } else { nA = gA + P.a_row(nxt, 0); }
        const char* nB = P.b_tile(nxt);
        for (int t = 0; t < nt; t += 2) {
            const bool last = (t == nt - 2);
            if constexpr (HOOK) { if (t == (nt >> 1)) E.mid(acc, cur, wr, wc, fr, fq); }
            const size_t k1 = (size_t)(t + 1) * kstep, k2 = last ? 0 : (size_t)(t + 2) * kstep, k3 = k2 + kstep;
            const char* b2 = last ? nB : cB + (size_t)(t + 2) * kstep; const char* b3 = b2 + kstep;
            PG8_LDB(b0, 0, 0); PG8_LDB(b1, 0, 1); PG8_SCHED; PG8_LDA(At, 0, 0); PG8_STAGE_A(PG8_SA(1, 1), 1, k1, false);
            PG8_WAIT_V(8); PG8_WAIT_L(0); PG8_BAR; PG8_MMA(0, 0, At, b0); PG8_MMA(0, 1, At, b1); PG8_BAR; PG8_SCHED;
            PG8_LDA(At, 0, 1); PG8_STAGE(PG8_SB(0, 0), b2, voffB); PG8_STAGE(PG8_SB(0, 1), b2 + hstepB, voffB); PG8_STAGE_A(PG8_SA(0, 0), 0, k2, last);
            PG8_WAIT_V(8); PG8_WAIT_L(0); PG8_BAR; PG8_MMA(1, 0, At, b0); PG8_MMA(1, 1, At, b1); PG8_BAR; PG8_SCHED;
            PG8_LDB(b0, 1, 0); PG8_LDB(b1, 1, 1); PG8_SCHED; PG8_LDA(At, 1, 0); PG8_STAGE_A(PG8_SA(0, 1), 1, k2, last);
            PG8_WAIT_V(8); PG8_WAIT_L(0); PG8_BAR; PG8_MMA(0, 0, At, b0); PG8_MMA(0, 1, At, b1); PG8_BAR; PG8_SCHED;
            PG8_LDA(At, 1, 1); PG8_STAGE(PG8_SB(1, 0), b3, voffB); PG8_STAGE(PG8_SB(1, 1), b3 + hstepB, voffB); PG8_STAGE_A(PG8_SA(1, 0), 0, k3, last);
            PG8_WAIT_V(8); PG8_WAIT_L(0); PG8_BAR; PG8_MMA(1, 0, At, b0); PG8_MMA(1, 1, At, b1); PG8_BAR; PG8_SCHED;
        }
        if constexpr (ALIGN_EPI) { if (wr == 0) PG8_BAR; }
        if constexpr (FP8) asm volatile("s_nop 15\n\ts_nop 15" ::: "memory");
        E(acc, cur, wr, wc, fr, fq);
        if (!has_next) break;
#pragma unroll
        for (int a = 0; a < 2; ++a)
#pragma unroll
            for (int b = 0; b < 2; ++b)
#pragma unroll
                for (int m = 0; m < 4; ++m)
#pragma unroll
                    for (int n = 0; n < 2; ++n) acc[a][b][m][n] = (f32x4){0.f, 0.f, 0.f, 0.f};
        cur = nxt; cB = nB; cA = nA; ++ui;
        if constexpr (Prob::GATHER) {
#pragma unroll
            for (int i = 0; i < 2; ++i) { va0[i] = vn0[i]; va1[i] = vn1[i]; } }
        if constexpr (ALIGN_EPI) { if (wr == 1) PG8_BAR; }
    }
    PG8_WAIT_V(0);
    if constexpr (!ALIGN_EPI) { if (wr == 0) PG8_BAR; }
    PG8_BAR;
#undef PG8_SA
#undef PG8_SB
#undef PG8_STAGE
#undef PG8_STAGE_A
#undef PG8_LDA
#undef PG8_LDB
#undef PG8_MMA
#undef PG8_WAIT_V
#undef PG8_WAIT_L
#undef PG8_BAR
#undef PG8_SCHED
}
}

using pg8::Unit;

struct ProbDense {
    static constexpr bool GATHER = false;
    const char* Abase; int nt; unsigned ldb2; unsigned lda2; const char* Bt; int nM, nN, G, c;
    __device__ __forceinline__ bool unit(int i, Unit& u) const { int w; if (!pg8::xcd_remap(i, G, c, nM * nN, w)) return false; pg8::grouped(w, nM, nN, u.pm, u.pn); u.aux = 0; return true; }
    __device__ __forceinline__ unsigned a_row(const Unit& u, int r) const { return (unsigned)(u.pm * 256 + r) * lda2; }
    __device__ __forceinline__ const char* b_tile(const Unit& u) const { return Bt + (size_t)u.pn * 256 * ldb2; }
};
struct ProbP1 {
    static constexpr bool GATHER = false;
    const char* Abase; int nt; unsigned ldb2; unsigned lda2; const char* Bt; unsigned uc_off; int G, c;
    __device__ __forceinline__ bool unit(int i, Unit& u) const {
        int w; if (!pg8::xcd_remap(i, G, c, 3072 + 256, w)) return false;
        if (w < 3072) { pg8::grouped(w, 256, 12, u.pm, u.pn); u.aux = 0; }
        else { pg8::grouped(w - 3072, 32, 8, u.pm, u.pn); u.pn += 4; u.aux = 1; }
        return true; }
    __device__ __forceinline__ unsigned a_row(const Unit& u, int r) const { return (u.aux ? uc_off : 0u) + (unsigned)(u.pm * 256 + r) * 2048u; }
    __device__ __forceinline__ const char* b_tile(const Unit& u) const { return Bt + (size_t)u.pn * 256 * ldb2; }
};
template <bool GATHER_> struct ProbMoE {
    static constexpr bool GATHER = GATHER_;
    const char* Abase; int nt; unsigned ldb2; unsigned lda2; const char* Bt; size_t estride; int nN, nblk, G, c; const int* rowtok; const LAS unsigned char* blk_e;
    __device__ __forceinline__ bool unit(int i, Unit& u) const { int w; if (!pg8::xcd_remap(i, G, c, nblk * nN, w)) return false; pg8::grouped(w, nblk, nN, u.pm, u.pn); u.aux = (int)blk_e[u.pm]; return true; }
    __device__ __forceinline__ unsigned a_row(const Unit& u, int r) const { if (GATHER) return (unsigned)rowtok[u.pm * 256 + r] * lda2; else return (unsigned)(u.pm * 256 + r) * lda2; }
    __device__ __forceinline__ const char* b_tile(const Unit& u) const { return Bt + (size_t)u.aux * estride + (size_t)u.pn * 256 * ldb2; }
};

struct EpiP1 {
    static constexpr bool PERM = true;
    bf16_t* PA; bf16_t* PH; bf16_t* PHC;
    __device__ __forceinline__ void operator()(const f32x4 (&acc)[2][2][4][2], const Unit& u, int wr, int wc, int fr, int fq) const {
        bf16_t* base; int ldc, colt;
        if (u.aux) { base = PHC; ldc = 2048; colt = (u.pn - 4) * 256; }
        else if (u.pn < 4) { base = PA; ldc = 1024; colt = u.pn * 256; }
        else { base = PH; ldc = 2048; colt = (u.pn - 4) * 256; }
        const int row0 = u.pm * 256 + wr * 64 + fr, col0 = colt + wc * 32 + 8 * fq;
#pragma unroll
        for (int ai = 0; ai < 2; ++ai)
#pragma unroll
            for (int m = 0; m < 4; ++m) { bf16_t* rowp = base + (size_t)(row0 + ai * 128 + m * 16) * ldc + col0;
#pragma unroll
                for (int bj = 0; bj < 2; ++bj) { const f32x4 v0 = acc[ai][bj][m][0], v1 = acc[ai][bj][m][1];
                    u32x4 w; w.x = cvt_pk_bf16(v0[0], v0[1]); w.y = cvt_pk_bf16(v0[2], v0[3]); w.z = cvt_pk_bf16(v1[0], v1[1]); w.w = cvt_pk_bf16(v1[2], v1[3]);
                    *(u32x4*)(rowp + bj * 128) = w; } }
    }
    __device__ __forceinline__ void mid(f32x4 (&)[2][2][4][2], const Unit&, int, int, int, int) const {}
};
struct EpiP2 {
    static constexpr bool PERM = true;
    bf16_t* PG; bf16_t* GATES;
    __device__ __forceinline__ void operator()(const f32x4 (&acc)[2][2][4][2], const Unit& u, int wr, int wc, int fr, int fq) const {
        const bool isg = u.pn >= 2; bf16_t* base = isg ? GATES : PG; const int ldc = isg ? 2048 : 512, colt = isg ? (u.pn - 2) * 256 : u.pn * 256;
        const int row0 = u.pm * 256 + wr * 64 + fr, col0 = colt + wc * 32 + 8 * fq;
#pragma unroll
        for (int ai = 0; ai < 2; ++ai)
#pragma unroll
            for (int m = 0; m < 4; ++m) { bf16_t* rowp = base + (size_t)(row0 + ai * 128 + m * 16) * ldc + col0;
#pragma unroll
                for (int bj = 0; bj < 2; ++bj) { f32x4 v0 = acc[ai][bj][m][0], v1 = acc[ai][bj][m][1];
#pragma unroll
                    for (int j = 0; j < 4; ++j) { const float s0 = fast_sigmoid(v0[j]), s1 = fast_sigmoid(v1[j]); v0[j] = isg ? s0 : v0[j] * s0; v1[j] = isg ? s1 : v1[j] * s1; }
                    u32x4 w; w.x = cvt_pk_bf16(v0[0], v0[1]); w.y = cvt_pk_bf16(v0[2], v0[3]); w.z = cvt_pk_bf16(v1[0], v1[1]); w.w = cvt_pk_bf16(v1[2], v1[3]);
                    *(u32x4*)(rowp + bj * 128) = w; } }
    }
    __device__ __forceinline__ void mid(f32x4 (&)[2][2][4][2], const Unit&, int, int, int, int) const {}
};
struct EpiM1 {
    static constexpr bool PERM = true;
    const bf16_t* GATES; bf16_t* Mo;
    __device__ __forceinline__ void mid(f32x4 (&acc)[2][2][4][2], const Unit& u, int wr, int wc, int fr, int fq) const {
        int row0 = u.pm * 256 + wr * 64 + fr, col0 = u.pn * 256 + wc * 32 + 8 * fq;
        asm volatile("" : "+v"(row0), "+v"(col0));
#pragma unroll
        for (int ai = 0; ai < 2; ++ai)
#pragma unroll
            for (int m = 0; m < 4; ++m) { const bf16_t* gp = GATES + (size_t)(row0 + ai * 128 + m * 16) * 2048 + col0;
#pragma unroll
                for (int bj = 0; bj < 2; ++bj) { const u32x4 gf = *(const u32x4*)(gp + bj * 128), gh = *(const u32x4*)(gp + 1024 + bj * 128);
                    f32x4& v0 = acc[ai][bj][m][0]; f32x4& v1 = acc[ai][bj][m][1];
                    v0[0] *= bf_lo(gf.x) * __builtin_amdgcn_rcpf(fmaxf(bf_lo(gh.x), 1e-20f)); v0[1] *= bf_hi(gf.x) * __builtin_amdgcn_rcpf(fmaxf(bf_hi(gh.x), 1e-20f));
                    v0[2] *= bf_lo(gf.y) * __builtin_amdgcn_rcpf(fmaxf(bf_lo(gh.y), 1e-20f)); v0[3] *= bf_hi(gf.y) * __builtin_amdgcn_rcpf(fmaxf(bf_hi(gh.y), 1e-20f));
                    v1[0] *= bf_lo(gf.z) * __builtin_amdgcn_rcpf(fmaxf(bf_lo(gh.z), 1e-20f)); v1[1] *= bf_hi(gf.z) * __builtin_amdgcn_rcpf(fmaxf(bf_hi(gh.z), 1e-20f));
                    v1[2] *= bf_lo(gf.w) * __builtin_amdgcn_rcpf(fmaxf(bf_lo(gh.w), 1e-20f)); v1[3] *= bf_hi(gf.w) * __builtin_amdgcn_rcpf(fmaxf(bf_hi(gh.w), 1e-20f));
                    asm volatile("" : "+v"(v0), "+v"(v1) :: "memory"); } }
    }
    __device__ __forceinline__ void operator()(const f32x4 (&acc)[2][2][4][2], const Unit& u, int wr, int wc, int fr, int fq) const {
        const int row0 = u.pm * 256 + wr * 64 + fr, col0 = u.pn * 256 + wc * 32 + 8 * fq;
#pragma unroll
        for (int ai = 0; ai < 2; ++ai)
#pragma unroll
            for (int m = 0; m < 4; ++m) { const size_t r = (size_t)(row0 + ai * 128 + m * 16); const bf16_t* gp = GATES + r * 2048 + 1024 + col0; bf16_t* rowp = Mo + r * 1024 + col0;
#pragma unroll
                for (int bj = 0; bj < 2; ++bj) { const u32x4 gh = *(const u32x4*)(gp + bj * 128); const f32x4 v0 = acc[ai][bj][m][0], v1 = acc[ai][bj][m][1];
                    u32x4 w; w.x = cvt_pk_bf16(v0[0] * bf_lo(gh.x), v0[1] * bf_hi(gh.x)); w.y = cvt_pk_bf16(v0[2] * bf_lo(gh.y), v0[3] * bf_hi(gh.y));
                    w.z = cvt_pk_bf16(v1[0] * bf_lo(gh.z), v1[1] * bf_hi(gh.z)); w.w = cvt_pk_bf16(v1[2] * bf_lo(gh.w), v1[3] * bf_hi(gh.w));
                    *(u32x4*)(rowp + bj * 128) = w; }
                asm volatile("" ::: "memory"); }
    }
};
struct EpiM2 {
    static constexpr bool PERM = false;
    const float* X; const float* ada; float* V;
    __device__ __forceinline__ void operator()(const f32x4 (&acc)[2][2][4][2], const Unit& u, int wr, int wc, int fr, int fq) const {
        const int row0 = u.pm * 256 + wr * 64 + fr, col0 = u.pn * 256 + wc * 32 + 4 * fq;
        const float* g1 = ada + (size_t)(u.pm >> 3) * 6144 + 2048 + col0;
        f32x4 gv[2][2];
#pragma unroll
        for (int bj = 0; bj < 2; ++bj)
#pragma unroll
            for (int n = 0; n < 2; ++n) gv[bj][n] = *(const f32x4*)(g1 + bj * 128 + n * 16);
#pragma unroll
        for (int ai = 0; ai < 2; ++ai)
#pragma unroll
            for (int m = 0; m < 4; ++m) { const size_t off = (size_t)(row0 + ai * 128 + m * 16) * 1024 + col0;
#pragma unroll
                for (int bj = 0; bj < 2; ++bj)
#pragma unroll
                    for (int n = 0; n < 2; ++n) { const f32x4 xv = *(const f32x4*)(X + off + bj * 128 + n * 16);
                        *(f32x4*)(V + off + bj * 128 + n * 16) = xv * DN_ALPHA + gv[bj][n] * acc[ai][bj][m][n]; }
                asm volatile("" ::: "memory"); }
    }
    __device__ __forceinline__ void mid(f32x4 (&)[2][2][4][2], const Unit&, int, int, int, int) const {}
};
struct EpiGU {
    static constexpr bool PERM = true;
    const float* bgu; unsigned char* ACT;
    __device__ __forceinline__ void operator()(const f32x4 (&acc)[2][2][4][2], const Unit& u, int wr, int wc, int fr, int fq) const {
        const int row0 = u.pm * 256 + wr * 64 + fr, col0 = u.pn * 128 + wc * 32 + 8 * fq;
        const float* bp = bgu + (size_t)u.aux * 2048 + col0;
        const f32x4 bg0 = *(const f32x4*)(bp), bg1 = *(const f32x4*)(bp + 4), bu0 = *(const f32x4*)(bp + 1024), bu1 = *(const f32x4*)(bp + 1028);
#pragma unroll
        for (int ai = 0; ai < 2; ++ai)
#pragma unroll
            for (int m = 0; m < 4; ++m) { unsigned char* rowp = ACT + (size_t)(row0 + ai * 128 + m * 16) * 1024 + col0;
                f32x4 g0 = acc[ai][0][m][0] * W8_INV + bg0, g1 = acc[ai][0][m][1] * W8_INV + bg1, p0 = acc[ai][1][m][0] * W8_INV + bu0, p1 = acc[ai][1][m][1] * W8_INV + bu1;
#pragma unroll
                for (int j = 0; j < 4; ++j) {
                    float g = fminf(g0[j], 7.0f), p = fminf(fmaxf(p0[j], -7.0f), 7.0f); g0[j] = (p + 1.0f) * g * fast_sigmoid(1.702f * g);
                    g = fminf(g1[j], 7.0f); p = fminf(fmaxf(p1[j], -7.0f), 7.0f); g1[j] = (p + 1.0f) * g * fast_sigmoid(1.702f * g); }
                u32x2 w; w.x = cvt_pk4_fp8(g0[0], g0[1], g0[2], g0[3]); w.y = cvt_pk4_fp8(g1[0], g1[1], g1[2], g1[3]);
                *(u32x2*)rowp = w; }
    }
    __device__ __forceinline__ void mid(f32x4 (&)[2][2][4][2], const Unit&, int, int, int, int) const {}
};
struct EpiDN {
    static constexpr bool PERM = true;
    const float* bdn; bf16_t* Y;
    __device__ __forceinline__ void operator()(const f32x4 (&acc)[2][2][4][2], const Unit& u, int wr, int wc, int fr, int fq) const {
        const int row0 = u.pm * 256 + wr * 64 + fr, col0 = u.pn * 256 + wc * 32 + 8 * fq;
        const float* bp = bdn + (size_t)u.aux * 1024 + col0;
        f32x4 bv[2][2];
#pragma unroll
        for (int bj = 0; bj < 2; ++bj)
#pragma unroll
            for (int n = 0; n < 2; ++n) bv[bj][n] = *(const f32x4*)(bp + bj * 128 + 4 * n);
#pragma unroll
        for (int ai = 0; ai < 2; ++ai)
#pragma unroll
            for (int m = 0; m < 4; ++m) { bf16_t* rowp = Y + (size_t)(row0 + ai * 128 + m * 16) * 1024 + col0;
#pragma unroll
                for (int bj = 0; bj < 2; ++bj) { const f32x4 v0 = acc[ai][bj][m][0] * W8_INV + bv[bj][0], v1 = acc[ai][bj][m][1] * W8_INV + bv[bj][1];
                    u32x4 w; w.x = cvt_pk_bf16(v0[0], v0[1]); w.y = cvt_pk_bf16(v0[2], v0[3]); w.z = cvt_pk_bf16(v1[0], v1[1]); w.w = cvt_pk_bf16(v1[2], v1[3]);
                    *(u32x4*)(rowp + bj * 128) = w; } }
    }
    __device__ __forceinline__ void mid(f32x4 (&)[2][2][4][2], const Unit&, int, int, int, int) const {}
};

struct Frame {
    LAS unsigned char* lds; int tid, lane, wave, G, c;
    const float* const* in; float* out; unsigned char* ws; unsigned* ctl;
};
enum { I_X = 0, I_C, I_CTX, I_CCTX, I_WADA, I_BADA, I_WIN, I_LBRAW, I_HGG, I_WFO, I_WHO, I_WO, I_LN1G, I_LN1B, I_WR, I_BR, I_WGU, I_BGU, I_WDN, I_BDN, I_LN2G, I_LN2B };

__device__ __forceinline__ float wave_sum(float v) {
#pragma unroll
    for (int o = 32; o >= 1; o >>= 1) v += __shfl_xor(v, o);
    return v;
}

__device__ __forceinline__ void p0_ada(const Frame& F) {
    LAS float* cact = (LAS float*)F.lds;
    float* ada = (float*)(F.ws + WS_ADA);
    for (int cb = F.c; cb < 192; cb += F.G) {
        for (int i = F.tid; i < 33 * 1024; i += NTHR) { const int b = i >> 10, k = i & 1023; const float v = b < 32 ? F.in[I_C][b * 1024 + k] : F.in[I_CCTX][k]; cact[i] = v * fast_sigmoid(v); }
        __syncthreads();
        const int kg = F.tid >> 5, col = F.tid & 31, gcol = cb * 32 + col;
        float acc[33];
#pragma unroll
        for (int b = 0; b < 33; ++b) acc[b] = 0.f;
        for (int k = kg; k < 1024; k += 16) { const float w = F.in[I_WADA][(size_t)k * 6144 + gcol];
#pragma unroll
            for (int b = 0; b < 33; ++b) acc[b] += cact[b * 1024 + k] * w; }
        __syncthreads();
        LAS float* red = cact;
#pragma unroll
        for (int b = 0; b < 33; ++b) red[(kg * 33 + b) * 32 + col] = acc[b];
        __syncthreads();
        for (int o = F.tid; o < 33 * 32; o += NTHR) { const int b = o >> 5, cc = o & 31; float s = 0.f;
            for (int g = 0; g < 16; ++g) s += red[(g * 33 + b) * 32 + cc];
            ada[(size_t)b * 6144 + cb * 32 + cc] = s + F.in[I_BADA][cb * 32 + cc]; }
        __syncthreads();
    }
}
__device__ __forceinline__ void p0_fold(const Frame& F) {
    LAS float* xr = (LAS float*)F.lds;
    LAS float* cs = xr + 2048;
    bf16_t* W1 = (bf16_t*)(F.ws + WS_WIN1T);
    if (F.tid < 128) { const float a = (float)F.tid * (1.0f / 128.0f); cs[F.tid] = __builtin_amdgcn_cosf(a); cs[128 + F.tid] = __builtin_amdgcn_sinf(a); }
    for (int kb = F.c; kb < 256; kb += F.G) {
        __syncthreads();
        for (int i = F.tid; i < 2048; i += NTHR) xr[i] = F.in[I_WIN][(size_t)(4 * kb + (i >> 9)) * 5120 + (i & 511)];
        __syncthreads();
        const int g = F.tid >> 7, j = F.tid & 127;
        float ac[4] = {0.f, 0.f, 0.f, 0.f}, as[4] = {0.f, 0.f, 0.f, 0.f};
        for (int d = 0; d < 128; ++d) { const int idx = (d * j) & 127; const float cv = cs[idx], sv = cs[128 + idx];
#pragma unroll
            for (int r = 0; r < 4; ++r) { const float xv = xr[r * 512 + g * 128 + d]; ac[r] += xv * cv; as[r] += xv * sv; } }
        const float sc = 0.08838834764831845f;
        u32x2 wa, wb; wa.x = cvt_pk_bf16(ac[0] * sc, ac[1] * sc); wa.y = cvt_pk_bf16(ac[2] * sc, ac[3] * sc);
        wb.x = cvt_pk_bf16(-as[0] * sc, -as[1] * sc); wb.y = cvt_pk_bf16(-as[2] * sc, -as[3] * sc);
        *(u32x2*)(W1 + (size_t)(g * 128 + j) * 1024 + 4 * kb) = wa;
        *(u32x2*)(W1 + (size_t)(512 + g * 128 + j) * 1024 + 4 * kb) = wb;
    }
    __syncthreads();
}
__device__ __forceinline__ void cv_tile(const Frame& F, const float* src, int src_ld, bf16_t* dst, int dst_ld) {
    LAS float* tile = (LAS float*)F.lds;
    f32x4 v[8];
#pragma unroll
    for (int i = 0; i < 8; ++i) { const int idx = F.tid + i * NTHR, r = idx >> 5, c4 = idx & 31; v[i] = *(const f32x4*)(src + (size_t)r * src_ld + c4 * 4); }
#pragma unroll
    for (int i = 0; i < 8; ++i) { const int idx = F.tid + i * NTHR, r = idx >> 5, c4 = idx & 31; LAS float* p = tile + r * 129 + c4 * 4; p[0] = v[i][0]; p[1] = v[i][1]; p[2] = v[i][2]; p[3] = v[i][3]; }
    __syncthreads();
#pragma unroll
    for (int i = 0; i < 4; ++i) { const int idx = F.tid + i * NTHR, n = idx >> 4, kc = idx & 15; const LAS float* p = tile + (kc * 8) * 129 + n;
        u32x4 w; w.x = cvt_pk_bf16(p[0], p[129]); w.y = cvt_pk_bf16(p[2 * 129], p[3 * 129]); w.z = cvt_pk_bf16(p[4 * 129], p[5 * 129]); w.w = cvt_pk_bf16(p[6 * 129], p[7 * 129]);
        *(u32x4*)(dst + (size_t)n * dst_ld + kc * 8) = w; }
    __syncthreads();
}
__device__ __forceinline__ void cv_tile_f8(const Frame& F, const float* src, int src_ld, unsigned char* dst, int dst_ld) {
    LAS float* tile = (LAS float*)F.lds;
    f32x4 v[8];
#pragma unroll
    for (int i = 0; i < 8; ++i) { const int idx = F.tid + i * NTHR, r = idx >> 5, c4 = idx & 31; v[i] = *(const f32x4*)(src + (size_t)r * src_ld + c4 * 4); }
#pragma unroll
    for (int i = 0; i < 8; ++i) { const int idx = F.tid + i * NTHR, r = idx >> 5, c4 = idx & 31; LAS float* p = tile + r * 129 + c4 * 4; p[0] = v[i][0] * W8_SCALE; p[1] = v[i][1] * W8_SCALE; p[2] = v[i][2] * W8_SCALE; p[3] = v[i][3] * W8_SCALE; }
    __syncthreads();
#pragma unroll
    for (int i = 0; i < 2; ++i) { const int idx = F.tid + i * NTHR, n = idx >> 3, kc = idx & 7; const LAS float* p = tile + (kc * 16) * 129 + n;
        u32x4 w; w.x = cvt_pk4_fp8(p[0], p[129], p[2 * 129], p[3 * 129]); w.y = cvt_pk4_fp8(p[4 * 129], p[5 * 129], p[6 * 129], p[7 * 129]);
        w.z = cvt_pk4_fp8(p[8 * 129], p[9 * 129], p[10 * 129], p[11 * 129]); w.w = cvt_pk4_fp8(p[12 * 129], p[13 * 129], p[14 * 129], p[15 * 129]);
        *(u32x4*)(dst + (size_t)n * dst_ld + kc * 16) = w; }
    __syncthreads();
}
__device__ __forceinline__ void p0_convert(const Frame& F) {
    constexpr int NJ = 128 + 160 + 32 + 32 + 64 + 4096 + 2048;
    for (int j = F.c; j < NJ; j += F.G) {
        const float* src; int sld; bf16_t* dst; int dld = 1024;
        if (j >= 416) {
            unsigned char* d8;
            if (j < 4512) { const int q = j - 416, e = q >> 7, r = q & 127, kt = r >> 4, jt = r & 15; src = F.in[I_WGU] + (size_t)e * 1024 * 2048 + (size_t)kt * 128 * 2048 + jt * 128; sld = 2048;
                d8 = (unsigned char*)(F.ws + WS_WGUT) + (size_t)e * 2048 * 1024 + (size_t)((jt & 7) * 256 + (jt >> 3) * 128) * 1024 + kt * 128; }
            else { const int q = j - 4512, e = q >> 6, r = q & 63, kt = r >> 3, nt = r & 7; src = F.in[I_WDN] + (size_t)e * 1024 * 1024 + (size_t)kt * 128 * 1024 + nt * 128; sld = 1024;
                d8 = (unsigned char*)(F.ws + WS_WDNT) + (size_t)e * 1024 * 1024 + (size_t)(nt * 128) * 1024 + kt * 128; }
            cv_tile_f8(F, src, sld, d8, 1024);
            continue;
        }
        if (j < 128) { const int kt = j >> 4, nt = j & 15; src = F.in[I_WIN] + (size_t)kt * 128 * 5120 + 512 + nt * 128; sld = 5120; dst = (bf16_t*)(F.ws + WS_WIN1T) + (size_t)(1024 + nt * 128) * 1024 + kt * 128; }
        else if (j < 288) { const int q = j - 128, kt = q / 20, nt = q % 20; src = F.in[I_WIN] + (size_t)kt * 128 * 5120 + 2560 + nt * 128; sld = 5120; dst = (bf16_t*)(F.ws + WS_WIN2T) + (size_t)(nt * 128) * 1024 + kt * 128; }
        else if (j < 320) { const int q = j - 288, kt = q >> 3, nt = q & 7; src = F.in[I_WFO] + (size_t)kt * 128 * 1024 + nt * 128; sld = 1024; dst = (bf16_t*)(F.ws + WS_WMT) + (size_t)(nt * 128) * 1024 + kt * 128; }
        else if (j < 352) { const int q = j - 320, kt = q >> 3, nt = q & 7; src = F.in[I_WHO] + (size_t)kt * 128 * 1024 + nt * 128; sld = 1024; dst = (bf16_t*)(F.ws + WS_WMT) + (size_t)(nt * 128) * 1024 + 512 + kt * 128; }
        else { const int q = j - 352, kt = q >> 3, nt = q & 7; src = F.in[I_WO] + (size_t)kt * 128 * 1024 + nt * 128; sld = 1024; dst = (bf16_t*)(F.ws + WS_WOT) + (size_t)(nt * 128) * 1024 + kt * 128; }
        cv_tile(F, src, sld, dst, dld);
    }
}

__device__ __forceinline__ void p1_uprep(const Frame& F) {
    const float* ada = (const float*)(F.ws + WS_ADA);
    bf16_t* U = (bf16_t*)(F.ws + WS_U); bf16_t* Uc = (bf16_t*)(F.ws + WS_UC);
    const size_t NIT = (size_t)(T + TCX) * 128, stride = (size_t)F.G * NTHR;
    for (size_t idx = (size_t)F.c * NTHR + F.tid; idx < NIT; idx += stride) {
        const int row = (int)(idx >> 7), col = (int)(idx & 127) * 8;
        const bool lat = row < T; const int b = lat ? (row >> 11) : 32;
        const float* src = lat ? F.in[I_X] + (size_t)row * 1024 + col : F.in[I_CTX] + (size_t)(row - T) * 1024 + col;
        bf16_t* dst = lat ? U + (size_t)row * 1024 + col : Uc + (size_t)(row - T) * 1024 + col;
        const f32x4 a0 = *(const f32x4*)src, a1 = *(const f32x4*)(src + 4);
        const float* ap = ada + (size_t)b * 6144 + col;
        const f32x4 sh0 = *(const f32x4*)ap, sh1 = *(const f32x4*)(ap + 4), sc0 = *(const f32x4*)(ap + 1024), sc1 = *(const f32x4*)(ap + 1028);
        const f32x4 r0 = a0 * (sc0 + 1.0f) + sh0, r1 = a1 * (sc1 + 1.0f) + sh1;
        u32x4 w; w.x = cvt_pk_bf16(r0[0], r0[1]); w.y = cvt_pk_bf16(r0[2], r0[3]); w.z = cvt_pk_bf16(r1[0], r1[1]); w.w = cvt_pk_bf16(r1[2], r1[3]);
        *(u32x4*)dst = w;
    }
    int* rowtok = (int*)(F.ws + WS_ROWTOK);
    for (int i = F.c * NTHR + F.tid; i < NCH * ROWS_CH; i += F.G * NTHR) rowtok[i] = (i / ROWS_CH) * TCH;
}

__device__ __forceinline__ void p6_readout(const Frame& F) {
    const bf16_t* PH = (const bf16_t*)(F.ws + WS_PH); const bf16_t* PG = (const bf16_t*)(F.ws + WS_PG); bf16_t* Y = (bf16_t*)(F.ws + WS_Y);
    const int l8 = F.lane * 8;
    const f32x4 g0 = *(const f32x4*)(F.in[I_HGG] + l8), g1 = *(const f32x4*)(F.in[I_HGG] + l8 + 4);
    for (int t = F.c * 8 + F.wave; t < T; t += F.G * 8) {
        const u32x4 a = *(const u32x4*)(PH + (size_t)t * 2048 + 512 + l8), b = *(const u32x4*)(PH + (size_t)t * 2048 + 1024 + l8), p = *(const u32x4*)(PG + (size_t)t * 512 + l8);
        float o[8] = { bf_lo(a.x) + bf_lo(b.x), bf_hi(a.x) + bf_hi(b.x), bf_lo(a.y) + bf_lo(b.y), bf_hi(a.y) + bf_hi(b.y), bf_lo(a.z) + bf_lo(b.z), bf_hi(a.z) + bf_hi(b.z), bf_lo(a.w) + bf_lo(b.w), bf_hi(a.w) + bf_hi(b.w) };
        float ss = 0.f;
#pragma unroll
        for (int i = 0; i < 8; ++i) ss += o[i] * o[i];
        ss += __shfl_xor(ss, 1); ss += __shfl_xor(ss, 2); ss += __shfl_xor(ss, 4); ss += __shfl_xor(ss, 8);
        const float rs = __builtin_amdgcn_rsqf(ss * (1.0f / 128.0f) + RMS_EPS);
        const float sp[8] = { bf_lo(p.x), bf_hi(p.x), bf_lo(p.y), bf_hi(p.y), bf_lo(p.z), bf_hi(p.z), bf_lo(p.w), bf_hi(p.w) };
        u32x4 w; w.x = cvt_pk_bf16(o[0] * rs * g0[0] * sp[0], o[1] * rs * g0[1] * sp[1]); w.y = cvt_pk_bf16(o[2] * rs * g0[2] * sp[2], o[3] * rs * g0[3] * sp[3]);
        w.z = cvt_pk_bf16(o[4] * rs * g1[0] * sp[4], o[5] * rs * g1[1] * sp[5]); w.w = cvt_pk_bf16(o[6] * rs * g1[2] * sp[6], o[7] * rs * g1[3] * sp[7]);
        *(u32x4*)(Y + (size_t)t * 1024 + 512 + l8) = w;
    }
}

__device__ __forceinline__ void p9_ln1_router(const Frame& F, const bool dry) {
    LAS float* wrT = (LAS float*)F.lds;
    LAS float* lg = (LAS float*)(F.lds + 131072);
    LAS float* brs = (LAS float*)(F.lds + 131072 + 4096);
    LAS int* hist = (LAS int*)(F.lds + 131072 + 4096 + 128);
    for (int i = F.tid; i < 32768; i += NTHR) { const int k = i >> 5, e = i & 31; wrT[e * 1024 + k] = F.in[I_WR][i]; }
    if (F.tid < 32) brs[F.tid] = F.in[I_BR][F.tid];
    if (F.tid < NCH * 32) hist[F.tid] = 0;
    __syncthreads();
    float* V = F.out; unsigned char* U2 = (unsigned char*)(F.ws + WS_U); const float* ada = (const float*)(F.ws + WS_ADA);
    int* topi = (int*)(F.ws + WS_TOPI); float* topw = (float*)(F.ws + WS_TOPW);
    const int l4 = F.lane * 4;
    for (int g = F.c * 8 + F.wave; g < T / 4; g += F.G * 8) {
        const int t0 = g * 4, b = t0 >> 11;
        f32x4 xv[4][4];
#pragma unroll
        for (int tk = 0; tk < 4; ++tk)
#pragma unroll
            for (int j = 0; j < 4; ++j) xv[tk][j] = *(const f32x4*)(V + (size_t)(t0 + tk) * 1024 + 256 * j + l4);
        float mean[4], rstd[4];
#pragma unroll
        for (int tk = 0; tk < 4; ++tk) { float s = 0.f;
#pragma unroll
            for (int j = 0; j < 4; ++j) s += (xv[tk][j][0] + xv[tk][j][1]) + (xv[tk][j][2] + xv[tk][j][3]);
            s = wave_sum(s); mean[tk] = s * (1.0f / 1024.0f); float q = 0.f;
#pragma unroll
            for (int j = 0; j < 4; ++j) { const f32x4 d = xv[tk][j] - mean[tk]; q += (d[0] * d[0] + d[1] * d[1]) + (d[2] * d[2] + d[3] * d[3]); }
            q = wave_sum(q); rstd[tk] = __builtin_amdgcn_rsqf(q * (1.0f / 1024.0f) + LN_EPS); }
#pragma unroll
        for (int j = 0; j < 4; ++j) {
            const int k = 256 * j + l4;
            const f32x4 lg1 = *(const f32x4*)(F.in[I_LN1G] + k), lb1 = *(const f32x4*)(F.in[I_LN1B] + k);
            const f32x4 sh = *(const f32x4*)(ada + (size_t)b * 6144 + 3072 + k), sc = *(const f32x4*)(ada + (size_t)b * 6144 + 4096 + k);
#pragma unroll
            for (int tk = 0; tk < 4; ++tk) { const f32x4 x1 = (xv[tk][j] - mean[tk]) * rstd[tk] * lg1 + lb1;
                if (!dry) *(f32x4*)(V + (size_t)(t0 + tk) * 1024 + k) = x1;
                const f32x4 u2 = x1 * (sc + 1.0f) + sh; xv[tk][j] = u2;
                if (!dry) *(unsigned*)(U2 + (size_t)(t0 + tk) * 1024 + k) = cvt_pk4_fp8(u2[0], u2[1], u2[2], u2[3]); } }
#pragma unroll 1
        for (int eq = 0; eq < 4; ++eq) {
            float acc[4][8];
#pragma unroll
            for (int e = 0; e < 8; ++e) { acc[0][e] = 0.f; acc[1][e] = 0.f; acc[2][e] = 0.f; acc[3][e] = 0.f;
#pragma unroll
                for (int j = 0; j < 4; ++j) { const f32x4 w4 = *(const LAS f32x4*)(wrT + (eq * 8 + e) * 1024 + 256 * j + l4);
#pragma unroll
                    for (int tk = 0; tk < 4; ++tk) acc[tk][e] += (xv[tk][j][0] * w4[0] + xv[tk][j][1] * w4[1]) + (xv[tk][j][2] * w4[2] + xv[tk][j][3] * w4[3]); }
                if (e & 1) __builtin_amdgcn_sched_barrier(0); }
#pragma unroll
            for (int tk = 0; tk < 4; ++tk) {
                float v0, v1, v2, v3;
                { const bool up = (F.lane & 32) != 0;
                  v0 = (up ? acc[tk][4] : acc[tk][0]) + __shfl_xor(up ? acc[tk][0] : acc[tk][4], 32);
                  v1 = (up ? acc[tk][5] : acc[tk][1]) + __shfl_xor(up ? acc[tk][1] : acc[tk][5], 32);
                  v2 = (up ? acc[tk][6] : acc[tk][2]) + __shfl_xor(up ? acc[tk][2] : acc[tk][6], 32);
                  v3 = (up ? acc[tk][7] : acc[tk][3]) + __shfl_xor(up ? acc[tk][3] : acc[tk][7], 32); }
                { const bool up = (F.lane & 16) != 0;
                  const float a0 = (up ? v2 : v0) + __shfl_xor(up ? v0 : v2, 16), a1 = (up ? v3 : v1) + __shfl_xor(up ? v1 : v3, 16); v0 = a0; v1 = a1; }
                { const bool up = (F.lane & 8) != 0; v0 = (up ? v1 : v0) + __shfl_xor(up ? v0 : v1, 8); }
                v0 += __shfl_xor(v0, 4); v0 += __shfl_xor(v0, 2); v0 += __shfl_xor(v0, 1);
                const int e = eq * 8 + ((F.lane >> 5) & 1) * 4 + ((F.lane >> 4) & 1) * 2 + ((F.lane >> 3) & 1);
                if ((F.lane & 7) == 0) lg[(F.wave * 4 + tk) * 32 + e] = v0 + brs[e];
            }
        }
        asm volatile("s_waitcnt lgkmcnt(0)" ::: "memory");
        if (F.lane < 4) {
            const LAS float* L = lg + (F.wave * 4 + F.lane) * 32;
            float b0 = -3.0e38f, b1 = -3.0e38f, b2 = -3.0e38f, b3 = -3.0e38f; int i0 = 0, i1 = 0, i2 = 0, i3 = 0;
            for (int e = 0; e < 32; ++e) { const float x = L[e];
                if (x > b3) { b3 = x; i3 = e;
                    if (b3 > b2) { float tf = b2; b2 = b3; b3 = tf; int ti = i2; i2 = i3; i3 = ti;
                        if (b2 > b1) { tf = b1; b1 = b2; b2 = tf; ti = i1; i1 = i2; i2 = ti;
                            if (b1 > b0) { tf = b0; b0 = b1; b1 = tf; ti = i0; i0 = i1; i1 = ti; } } } } }
            const float p1 = fast_exp(b1 - b0), p2 = fast_exp(b2 - b0), p3 = fast_exp(b3 - b0), inv = 1.0f / (1.0f + p1 + p2 + p3);
            const int t = t0 + F.lane;
            *(int4*)(topi + (size_t)t * 4) = make_int4(i0, i1, i2, i3);
            *(f32x4*)(topw + (size_t)t * 4) = (f32x4){inv, p1 * inv, p2 * inv, p3 * inv};
            const int ch = t / TCH;
            if (!dry) { atomicAdd((int*)(hist + ch * 32 + i0), 1); atomicAdd((int*)(hist + ch * 32 + i1), 1); atomicAdd((int*)(hist + ch * 32 + i2), 1); atomicAdd((int*)(hist + ch * 32 + i3), 1); }
        }
    }
    __syncthreads();
    if (F.tid < NCH * 32) { const int h = hist[F.tid]; if (h && !dry) atomicAdd(F.ctl + CW_CNT + F.tid, (unsigned)h); }
    __syncthreads();
}

__device__ __forceinline__ void p10_dispatch(const Frame& F) {
    LAS int* lcnt = (LAS int*)F.lds; LAS int* lbase = lcnt + 32; LAS int* pstart = lcnt + 64;
    const int* topi = (const int*)(F.ws + WS_TOPI); int* pos = (int*)(F.ws + WS_POS); int* rowtok = (int*)(F.ws + WS_ROWTOK);
    for (int s = F.c; s < T / 256; s += F.G) {
        const int ch = (s * 256) / TCH;
        __syncthreads();
        if (F.tid < 32) { lcnt[F.tid] = 0; int ps = 0; for (int e = 0; e < F.tid; ++e) { const int n = (int)__hip_atomic_load(F.ctl + CW_CNT + ch * 32 + e, __ATOMIC_RELAXED, __HIP_MEMORY_SCOPE_AGENT); ps += (n + 255) & ~255; } pstart[F.tid] = ps; }
        __syncthreads();
        int e2[2], r2[2];
#pragma unroll
        for (int i = 0; i < 2; ++i) { const int a = F.tid + i * NTHR; e2[i] = topi[(size_t)(s * 256) * 4 + a]; r2[i] = atomicAdd((int*)(lcnt + e2[i]), 1); }
        __syncthreads();
        if (F.tid < 32) lbase[F.tid] = (int)atomicAdd(F.ctl + CW_CUR + ch * 32 + F.tid, (unsigned)lcnt[F.tid]);
        __syncthreads();
#pragma unroll
        for (int i = 0; i < 2; ++i) { const int a = F.tid + i * NTHR, slot = pstart[e2[i]] + lbase[e2[i]] + r2[i];
            pos[(size_t)(s * 256) * 4 + a] = slot; rowtok[(size_t)ch * ROWS_CH + slot] = s * 256 + (a >> 2); }
    }
}
__device__ __forceinline__ int moe_blocks(const Frame& F, int ch, LAS unsigned char* blk_e) {
    LAS int* sh = (LAS int*)(blk_e + 1024);
    __syncthreads();
    if (F.tid == 0) { int nb = 0; for (int e = 0; e < 32; ++e) { const int n = ((int)__hip_atomic_load(F.ctl + CW_CNT + ch * 32 + e, __ATOMIC_RELAXED, __HIP_MEMORY_SCOPE_AGENT) + 255) >> 8; for (int i = 0; i < n; ++i) blk_e[nb + i] = (unsigned char)e; nb += n; } sh[0] = nb; }
    __syncthreads();
    return sh[0];
}

__device__ __forceinline__ void p13_combine_ln2(const Frame& F, int ch, const bool dry) {
    const bf16_t* YC = (const bf16_t*)(F.ws + WS_YCH); const int* pos = (const int*)(F.ws + WS_POS); const float* topw = (const float*)(F.ws + WS_TOPW);
    const float* ada = (const float*)(F.ws + WS_ADA); float* X1 = F.out;
    const int l4 = F.lane * 4;
    for (int t = ch * TCH + F.c * 8 + F.wave; t < (ch + 1) * TCH; t += F.G * 8) {
        const int b = t >> 11;
        const int4 ps = *(const int4*)(pos + (size_t)t * 4); const f32x4 tw = *(const f32x4*)(topw + (size_t)t * 4);
        f32x4 v[4];
#pragma unroll
        for (int j = 0; j < 4; ++j) { const int k = 256 * j + l4;
            const u32x2 y0 = *(const u32x2*)(YC + (size_t)ps.x * 1024 + k), y1 = *(const u32x2*)(YC + (size_t)ps.y * 1024 + k), y2 = *(const u32x2*)(YC + (size_t)ps.z * 1024 + k), y3 = *(const u32x2*)(YC + (size_t)ps.w * 1024 + k);
            f32x4 ff;
            ff[0] = tw[0] * bf_lo(y0.x) + tw[1] * bf_lo(y1.x) + tw[2] * bf_lo(y2.x) + tw[3] * bf_lo(y3.x);
            ff[1] = tw[0] * bf_hi(y0.x) + tw[1] * bf_hi(y1.x) + tw[2] * bf_hi(y2.x) + tw[3] * bf_hi(y3.x);
            ff[2] = tw[0] * bf_lo(y0.y) + tw[1] * bf_lo(y1.y) + tw[2] * bf_lo(y2.y) + tw[3] * bf_lo(y3.y);
            ff[3] = tw[0] * bf_hi(y0.y) + tw[1] * bf_hi(y1.y) + tw[2] * bf_hi(y2.y) + tw[3] * bf_hi(y3.y);
            const f32x4 x1 = *(const f32x4*)(X1 + (size_t)t * 1024 + k), g2 = *(const f32x4*)(ada + (size_t)b * 6144 + 5120 + k);
            v[j] = x1 * DN_ALPHA + g2 * ff; }
        float s = 0.f;
#pragma unroll
        for (int j = 0; j < 4; ++j) s += (v[j][0] + v[j][1]) + (v[j][2] + v[j][3]);
        s = wave_sum(s); const float mean = s * (1.0f / 1024.0f); float q = 0.f;
#pragma unroll
        for (int j = 0; j < 4; ++j) { const f32x4 d = v[j] - mean; q += (d[0] * d[0] + d[1] * d[1]) + (d[2] * d[2] + d[3] * d[3]); }
        q = wave_sum(q); const float rstd = __builtin_amdgcn_rsqf(q * (1.0f / 1024.0f) + LN_EPS);
#pragma unroll
        for (int j = 0; j < 4; ++j) { const int k = 256 * j + l4; const f32x4 g = *(const f32x4*)(F.in[I_LN2G] + k), bb = *(const f32x4*)(F.in[I_LN2B] + k);
            const f32x4 o4 = (v[j] - mean) * rstd * g + bb;
            if (!dry) *(f32x4*)(X1 + (size_t)t * 1024 + k) = o4; else if (o4[0] == 1.2345e30f) X1[0] = 1.f; }
    }
}

constexpr int SC_QD = 0, SC_KI = 17408, SC_KE = 34816, SC_VT = 53248, SC_SC = 71680, SC_ST = 80896, SC_GV = 115712, SC_CS = 116224;
__device__ __forceinline__ bf16x8 ldfrag(const LAS unsigned char* p) { return *(const LAS bf16x8*)p; }
__device__ __forceinline__ void p3_scan(const Frame& F, const bool dry) {
    LAS unsigned char* L = F.lds;
    const int tid = F.tid, w = F.wave, lane = F.lane, fr = lane & 15, fq = lane >> 4;
    const int d = tid & 127, qd = tid >> 7;
    bf16_t* PH = (bf16_t*)(F.ws + WS_PH); const bf16_t* PHC = (const bf16_t*)(F.ws + WS_PHC);
    for (int it = F.c; it < 256; it += F.G) {
        const int b = it >> 3, h = (it >> 1) & 3, dir = it & 1;
        const float r0 = F.in[I_LBRAW][dir * 512 + h * 128 + d], r1 = F.in[I_LBRAW][1024 + dir * 512 + h * 128 + d];
        const float lbv = fast_sigmoid(r0 - r1), oml = 1.0f - lbv;
        f32x4 Sacc[8];
#pragma unroll
        for (int i = 0; i < 8; ++i) Sacc[i] = (f32x4){0.f, 0.f, 0.f, 0.f};
        __syncthreads();
        for (int i = tid; i < 34816 / 4; i += NTHR) ((LAS unsigned*)(L + SC_ST))[i] = 0u;
        const int cq = h * 128 + d, cz = 512 + dir * 512 + h * 128 + d, cv = 1536 + h * 128 + d;
        bf16_t rq[16], rz[16], rv[16];
        {   const int n = dir ? 3 : 0; const bf16_t* base = PHC + (size_t)(b * 256 + 64 * n + 16 * qd) * 2048;
#pragma unroll
            for (int i = 0; i < 16; ++i) { rq[i] = base[(size_t)i * 2048 + cq]; rz[i] = base[(size_t)i * 2048 + cz]; rv[i] = base[(size_t)i * 2048 + cv]; } }
        for (int s = 0; s < 36; ++s) {
            const bool lat = s >= 4; const int n = lat ? (dir ? 31 - (s - 4) : (s - 4)) : (dir ? 3 - s : s);
            float kk[16], cum[16]; float run = 0.f;
#pragma unroll
            for (int i = 0; i < 16; ++i) { const float sg = fast_sigmoid(bf2f(rz[i])); kk[i] = oml * (1.0f - sg); cum[i] = fast_log(lbv + oml * sg); }
            if (dir == 0) {
#pragma unroll
                for (int i = 0; i < 16; ++i) { run += cum[i]; cum[i] = run; }
            } else {
#pragma unroll
                for (int i = 15; i >= 0; --i) { run += cum[i]; cum[i] = run; }
            }
            ((LAS float*)(L + SC_CS))[qd * 128 + d] = run;
            __syncthreads();
            {   const LAS float* cs = (const LAS float*)(L + SC_CS);
                const float c0 = cs[d], c1 = cs[128 + d], c2 = cs[256 + d], c3 = cs[384 + d], tot = (c0 + c1) + (c2 + c3);
                float off;
                if (dir == 0) off = (qd > 0 ? c0 : 0.f) + (qd > 1 ? c1 : 0.f) + (qd > 2 ? c2 : 0.f);
                else off = (qd < 3 ? c3 : 0.f) + (qd < 2 ? c2 : 0.f) + (qd < 1 ? c1 : 0.f);
                const float g = fast_exp(tot);
                if (qd == 0) ((LAS float*)(L + SC_GV))[d] = g;
                unsigned ke[8], vt[8];
#pragma unroll
                for (int i = 0; i < 16; i += 2) {
                    const float ca = cum[i] + off, cb = cum[i + 1] + off;
                    const float ea = fast_exp(ca), eb = fast_exp(cb), ia = __builtin_amdgcn_rcpf(ea), ib = __builtin_amdgcn_rcpf(eb);
                    const float qa = bf2f(rq[i]), qb = bf2f(rq[i + 1]);
                    const float qda = qa * fast_sigmoid(qa) * ea, qdb = qb * fast_sigmoid(qb) * eb;
                    const float kia = kk[i] * ia, kib = kk[i + 1] * ib;
                    const unsigned wa = cvt_pk_bf16(qda, kia), wb = cvt_pk_bf16(qdb, kib);
                    *(LAS bf16_t*)(L + SC_QD + (16 * qd + i) * 272 + d * 2) = (bf16_t)(wa & 0xffffu);
                    *(LAS bf16_t*)(L + SC_KI + (16 * qd + i) * 272 + d * 2) = (bf16_t)(wa >> 16);
                    *(LAS bf16_t*)(L + SC_QD + (16 * qd + i + 1) * 272 + d * 2) = (bf16_t)(wb & 0xffffu);
                    *(LAS bf16_t*)(L + SC_KI + (16 * qd + i + 1) * 272 + d * 2) = (bf16_t)(wb >> 16);
                    ke[i >> 1] = cvt_pk_bf16(kia * g, kib * g);
                    vt[i >> 1] = (unsigned)rv[i] | ((unsigned)rv[i + 1] << 16);
                }
                *(LAS u32x4*)(L + SC_KE + d * 144 + 32 * qd) = (u32x4){ke[0], ke[1], ke[2], ke[3]};
                *(LAS u32x4*)(L + SC_KE + d * 144 + 32 * qd + 16) = (u32x4){ke[4], ke[5], ke[6], ke[7]};
                *(LAS u32x4*)(L + SC_VT + d * 144 + 32 * qd) = (u32x4){vt[0], vt[1], vt[2], vt[3]};
                *(LAS u32x4*)(L + SC_VT + d * 144 + 32 * qd + 16) = (u32x4){vt[4], vt[5], vt[6], vt[7]};
            }
            if (s + 1 < 36) {
                const int s1 = s + 1; const bool lat1 = s1 >= 4; const int n1 = lat1 ? (dir ? 31 - (s1 - 4) : (s1 - 4)) : (dir ? 3 - s1 : s1);
                const bf16_t* base = lat1 ? (const bf16_t*)PH + (size_t)(b * 2048 + 64 * n1 + 16 * qd) * 2048 : PHC + (size_t)(b * 256 + 64 * n1 + 16 * qd) * 2048;
#pragma unroll
                for (int i = 0; i < 16; ++i) { rq[i] = base[(size_t)i * 2048 + cq]; rz[i] = base[(size_t)i * 2048 + cz]; rv[i] = base[(size_t)i * 2048 + cv]; }
            }
            __syncthreads();
            f32x4 oacc[4];
#pragma unroll
            for (int i = 0; i < 4; ++i) oacc[i] = (f32x4){0.f, 0.f, 0.f, 0.f};
            const int kb = fq * 16;
            if (lat) {
                const int ct = w >> 1, st0 = 2 * (w & 1);
#pragma unroll
                for (int j = 0; j < 2; ++j) { const int st = st0 + j; f32x4 sa = (f32x4){0.f, 0.f, 0.f, 0.f};
#pragma unroll
                    for (int ks = 0; ks < 4; ++ks) sa = __builtin_amdgcn_mfma_f32_16x16x32_bf16(ldfrag(L + SC_KI + (16 * st + fr) * 272 + ks * 64 + kb), ldfrag(L + SC_QD + (16 * ct + fr) * 272 + ks * 64 + kb), sa, 0, 0, 0);
                    const int cc = 16 * ct + fr, s0 = 16 * st + 4 * fq;
#pragma unroll
                    for (int i = 0; i < 4; ++i) { const bool keep = dir ? (s0 + i >= cc) : (s0 + i <= cc); sa[i] = keep ? sa[i] : 0.f; }
                    *(LAS u32x2*)(L + SC_SC + cc * 144 + s0 * 2) = (u32x2){cvt_pk_bf16(sa[0], sa[1]), cvt_pk_bf16(sa[2], sa[3])}; }
#pragma unroll
                for (int ct2 = 0; ct2 < 4; ++ct2)
#pragma unroll
                    for (int ks = 0; ks < 4; ++ks) oacc[ct2] = __builtin_amdgcn_mfma_f32_16x16x32_bf16(ldfrag(L + SC_ST + (16 * w + fr) * 272 + ks * 64 + kb), ldfrag(L + SC_QD + (16 * ct2 + fr) * 272 + ks * 64 + kb), oacc[ct2], 0, 0, 0);
            }
            {   const bf16x8 v0 = ldfrag(L + SC_VT + (16 * w + fr) * 144 + kb), v1 = ldfrag(L + SC_VT + (16 * w + fr) * 144 + 64 + kb);
#pragma unroll
                for (int dt = 0; dt < 8; ++dt) { const f32x4 gv = *(const LAS f32x4*)(L + SC_GV + (16 * dt + 4 * fq) * 4);
                    f32x4 a = Sacc[dt] * gv;
                    a = __builtin_amdgcn_mfma_f32_16x16x32_bf16(ldfrag(L + SC_KE + (16 * dt + fr) * 144 + kb), v0, a, 0, 0, 0);
                    a = __builtin_amdgcn_mfma_f32_16x16x32_bf16(ldfrag(L + SC_KE + (16 * dt + fr) * 144 + 64 + kb), v1, a, 0, 0, 0);
                    Sacc[dt] = a; } }
            __syncthreads();
#pragma unroll
            for (int dt = 0; dt < 8; ++dt) *(LAS u32x2*)(L + SC_ST + (16 * w + fr) * 272 + (16 * dt + 4 * fq) * 2) = (u32x2){cvt_pk_bf16(Sacc[dt][0], Sacc[dt][1]), cvt_pk_bf16(Sacc[dt][2], Sacc[dt][3])};
            if (lat) {
                const bf16x8 v0 = ldfrag(L + SC_VT + (16 * w + fr) * 144 + kb), v1 = ldfrag(L + SC_VT + (16 * w + fr) * 144 + 64 + kb);
                bf16_t* ob = PH + (size_t)(b * 2048 + 64 * n) * 2048 + 512 + dir * 512 + h * 128 + 16 * w + 4 * fq;
#pragma unroll
                for (int ct2 = 0; ct2 < 4; ++ct2) {
                    f32x4 a = oacc[ct2];
                    a = __builtin_amdgcn_mfma_f32_16x16x32_bf16(v0, ldfrag(L + SC_SC + (16 * ct2 + fr) * 144 + kb), a, 0, 0, 0);
                    a = __builtin_amdgcn_mfma_f32_16x16x32_bf16(v1, ldfrag(L + SC_SC + (16 * ct2 + fr) * 144 + 64 + kb), a, 0, 0, 0);
                    if (!dry) *(u32x2*)(ob + (size_t)(16 * ct2 + fr) * 2048) = (u32x2){cvt_pk_bf16(a[0], a[1]), cvt_pk_bf16(a[2], a[3])};
                    else if (a[0] == 1.2345e30f) ob[0] = 1; }
            }
        }
        __syncthreads();
    }
}

typedef short s16x4 __attribute__((ext_vector_type(4)));
__device__ __forceinline__ s16x4 tr_read(unsigned lds_addr) { s16x4 r; asm volatile("ds_read_b64_tr_b16 %0, %1\n\ts_waitcnt lgkmcnt(0)" : "=&v"(r) : "v"(lds_addr) : "memory"); return r; }
__device__ __forceinline__ bf16x8 cat4(s16x4 a, s16x4 b) { return (bf16x8){a[0], a[1], a[2], a[3], b[0], b[1], b[2], b[3]}; }
constexpr int FO_C = 131072, FO_S = 139264;
__device__ __forceinline__ void p4_fourier(const Frame& F) {
    LAS unsigned char* L = F.lds;
    const int tid = F.tid, w = F.wave, lane = F.lane, fr = lane & 15, fq = lane >> 4;
    const bf16_t* PA = (const bf16_t*)(F.ws + WS_PA); bf16_t* Y = (bf16_t*)(F.ws + WS_Y);
    __syncthreads();
    for (int i = tid; i < 4096; i += NTHR) { const int k2 = i >> 6, c = i & 63; const float a = (float)((k2 * c) & 63) * (1.0f / 64.0f);
        *(LAS bf16_t*)(L + FO_C + i * 2) = (bf16_t)(cvt_pk_bf16(__builtin_amdgcn_cosf(a) * 0.125f, 0.f) & 0xffffu);
        *(LAS bf16_t*)(L + FO_S + i * 2) = (bf16_t)(cvt_pk_bf16(__builtin_amdgcn_sinf(a) * 0.125f, 0.f) & 0xffffu); }
    bf16x8 Gf[2][2];
#pragma unroll
    for (int nt = 0; nt < 2; ++nt)
#pragma unroll
        for (int ks = 0; ks < 2; ++ks) { unsigned pk[4];
#pragma unroll
            for (int j = 0; j < 8; j += 2) { const int k1 = 16 * nt + fr, ra = 8 * fq + j, rb = ra + 1; const float aa = (float)((k1 * ra) & 31) * (1.0f / 32.0f), ab = (float)((k1 * rb) & 31) * (1.0f / 32.0f);
                const float va = (ks ? __builtin_amdgcn_sinf(aa) : __builtin_amdgcn_cosf(aa)) * 0.17677669529663687f, vb = (ks ? __builtin_amdgcn_sinf(ab) : __builtin_amdgcn_cosf(ab)) * 0.17677669529663687f;
                pk[j >> 1] = cvt_pk_bf16(va, vb); }
            u32x4 t4 = (u32x4){pk[0], pk[1], pk[2], pk[3]}; Gf[nt][ks] = *(bf16x8*)&t4; }
    const unsigned lbase = (unsigned)(size_t)L;
    for (int it = F.c; it < 1024; it += F.G) {
        const int xcd = it & 7, jj = it >> 3, slab = 4 * xcd + (jj & 3), b = jj >> 2;
        __syncthreads();
        {   u32x4 v[16];
#pragma unroll
            for (int n = 0; n < 16; ++n) { const int q = tid + NTHR * n, t = q >> 2, reim = (q >> 1) & 1, half = q & 1;
                v[n] = *(const u32x4*)(PA + (size_t)(b * 2048 + t) * 1024 + reim * 512 + slab * 16 + half * 8); }
#pragma unroll
            for (int n = 0; n < 16; ++n) *(LAS u32x4*)(L + (tid + NTHR * n) * 16) = v[n]; }
        __syncthreads();
#pragma unroll 1
        for (int rr = 0; rr < 4; ++rr) {
            const int r = w + 8 * rr;
            f32x4 acc[8];
#pragma unroll
            for (int i = 0; i < 8; ++i) acc[i] = (f32x4){0.f, 0.f, 0.f, 0.f};
#pragma unroll
            for (int ks = 0; ks < 4; ++ks) {
                const int ri = ks >> 1, c0 = 32 * (ks & 1) + 8 * fq + (fr >> 2);
                const unsigned a0 = lbase + (unsigned)((r * 64 + c0) * 64 + ri * 32 + (fr & 3) * 8);
                const bf16x8 af = cat4(tr_read(a0), tr_read(a0 + 4 * 64));
#pragma unroll
                for (int nt = 0; nt < 8; ++nt) { const int ro = nt >> 2, k2 = 16 * (nt & 3) + fr;
                    u32x4 bw = *(const LAS u32x4*)(L + ((ro == ri) ? FO_C : FO_S) + (k2 * 64 + 32 * (ks & 1) + 8 * fq) * 2);
                    if (ro == 1 && ri == 0) { bw.x ^= 0x80008000u; bw.y ^= 0x80008000u; bw.z ^= 0x80008000u; bw.w ^= 0x80008000u; }
                    acc[nt] = __builtin_amdgcn_mfma_f32_16x16x32_bf16(af, *(bf16x8*)&bw, acc[nt], 0, 0, 0); }
            }
#pragma unroll
            for (int nt = 0; nt < 8; ++nt) { const int ro = nt >> 2, k2 = 16 * (nt & 3) + fr;
                *(LAS u32x2*)(L + (r * 64 + k2) * 64 + ro * 32 + fq * 8) = (u32x2){cvt_pk_bf16(acc[nt][0], acc[nt][1]), cvt_pk_bf16(acc[nt][2], acc[nt][3])}; }
        }
        __syncthreads();
#pragma unroll 1
        for (int kk = 0; kk < 8; ++kk) {
            const int k2 = 8 * w + kk;
            f32x4 a2[2] = {(f32x4){0.f, 0.f, 0.f, 0.f}, (f32x4){0.f, 0.f, 0.f, 0.f}};
#pragma unroll
            for (int ks = 0; ks < 2; ++ks) {
                const int r0 = 8 * fq + (fr >> 2);
                const unsigned a0 = lbase + (unsigned)((r0 * 64 + k2) * 64 + ks * 32 + (fr & 3) * 8);
                const bf16x8 af = cat4(tr_read(a0), tr_read(a0 + 4 * 64 * 64));
                a2[0] = __builtin_amdgcn_mfma_f32_16x16x32_bf16(af, Gf[0][ks], a2[0], 0, 0, 0);
                a2[1] = __builtin_amdgcn_mfma_f32_16x16x32_bf16(af, Gf[1][ks], a2[1], 0, 0, 0);
            }
#pragma unroll
            for (int nt = 0; nt < 2; ++nt) { const int k1 = 16 * nt + fr;
                *(u32x2*)(Y + (size_t)(b * 2048 + k1 * 64 + k2) * 1024 + slab * 16 + 4 * fq) = (u32x2){cvt_pk_bf16(a2[nt][0], a2[nt][1]), cvt_pk_bf16(a2[nt][2], a2[nt][3])}; }
        }
    }
    __syncthreads();
}

struct Args { const float* in[22]; float* out; unsigned char* ws; int ph_lo, ph_hi; };
constexpr int N_PHASES = 9 + 3 * NCH;

__global__ void __launch_bounds__(NTHR, 2) mega_fwd(Args args) {
    extern __shared__ __attribute__((aligned(16))) unsigned char lds_raw[];
    Frame F;
    F.lds = (LAS unsigned char*)lds_raw;
    F.tid = threadIdx.x; F.lane = F.tid & 63; F.wave = __builtin_amdgcn_readfirstlane(F.tid >> 6);
    F.G = gridDim.x; F.c = blockIdx.x;
    F.in = args.in;
    F.out = args.out; F.ws = args.ws; F.ctl = (unsigned*)(args.ws + WS_CTL);
    volatile LAS unsigned* misc = (volatile LAS unsigned*)(F.lds + LDS_MISC);
    if (F.tid < 4) misc[F.tid] = 0u;
    __syncthreads();
    XcdBarrier bar = xcd_barrier_post(F.ctl, misc);
    const int lo = args.ph_lo, hi = args.ph_hi;
#ifndef PHASE_MASK
#define PHASE_MASK 0xFFFFFFFFu
#endif
#define IN(k) ((((PHASE_MASK) >> (k)) & 1u) && lo <= (k) && (k) < hi)
#define SEAM(k) do { if (IN(k) && IN((k) + 1)) xcd_barrier(bar); } while (0)
#ifndef REP_MASK
#define REP_MASK 0u
#endif
#define REPS(b) ((((REP_MASK) >> (b)) & 1u) ? 2 : 1)
#define REPBAR(b, r) do { if ((((REP_MASK) >> (b)) & 1u) && (r) == 0) xcd_barrier(bar); } while (0)
    unsigned char* ws = F.ws;
    LAS unsigned char* blk_e = F.lds + LDS_MISC + 64;

    if (IN(0)) { for (int r = 0; r < REPS(0); ++r) { p0_ada(F); p0_fold(F); p0_convert(F); REPBAR(0, r); } }
    SEAM(0);
    if (IN(1)) { for (int r = 0; r < REPS(1); ++r) { p1_uprep(F); REPBAR(1, r); } }
    SEAM(1);
    if (IN(2)) {
        ProbP1 P{(const char*)(ws + WS_U), 16, 2048u, 2048u, (const char*)(ws + WS_WIN1T), (unsigned)(WS_UC - WS_U), F.G, F.c};
        EpiP1 E{(bf16_t*)(ws + WS_PA), (bf16_t*)(ws + WS_PH), (bf16_t*)(ws + WS_PHC)};
        for (int r = 0; r < REPS(2); ++r) { pg8::gemm_phase<ProbP1, EpiP1, true, false>(F.lds, P, E); REPBAR(2, r); }
    }
    SEAM(2);
    if (IN(3)) {
#ifndef NO_SCAN
        for (int r = 0; r < REPS(3); ++r) { p3_scan(F, r + 1 < REPS(3)); REPBAR(3, r); }
#endif
#ifndef NO_FOURIER
        for (int r = 0; r < REPS(4); ++r) { p4_fourier(F); REPBAR(4, r); }
#endif
#ifndef NO_P2GEMM
        ProbDense P{(const char*)(ws + WS_U), 16, 2048u, 2048u, (const char*)(ws + WS_WIN2T), 256, 10, F.G, F.c};
        EpiP2 E{(bf16_t*)(ws + WS_PG), (bf16_t*)F.out};
        for (int r = 0; r < REPS(5); ++r) { pg8::gemm_phase<ProbDense, EpiP2, true, false>(F.lds, P, E); REPBAR(5, r); }
#endif
    }
    SEAM(3);
    if (IN(4)) { for (int r = 0; r < REPS(6); ++r) { p6_readout(F); REPBAR(6, r); } }
    SEAM(4);
    if (IN(5)) {
        ProbDense P{(const char*)(ws + WS_Y), 16, 2048u, 2048u, (const char*)(ws + WS_WMT), 256, 4, F.G, F.c};
        EpiM1 E{(const bf16_t*)F.out, (bf16_t*)(ws + WS_PA)};
        for (int r = 0; r < REPS(7); ++r) { pg8::gemm_phase<ProbDense, EpiM1, true, true>(F.lds, P, E); REPBAR(7, r); }
    }
    SEAM(5);
    if (IN(6)) {
        ProbDense P{(const char*)(ws + WS_PA), 16, 2048u, 2048u, (const char*)(ws + WS_WOT), 256, 4, F.G, F.c};
        EpiM2 E{F.in[I_X], (const float*)(ws + WS_ADA), F.out};
        for (int r = 0; r < REPS(8); ++r) { pg8::gemm_phase<ProbDense, EpiM2, true, false>(F.lds, P, E); REPBAR(8, r); }
    }
    SEAM(6);
    if (IN(7)) { for (int r = 0; r < REPS(9); ++r) { p9_ln1_router(F, r + 1 < REPS(9)); REPBAR(9, r); } }
    SEAM(7);
    if (IN(8)) { p10_dispatch(F); }
    SEAM(8);
#pragma unroll
    for (int ch = 0; ch < NCH; ++ch) {
        if (IN(9 + 3 * ch)) {
            const int nblk = moe_blocks(F, ch, blk_e);
            ProbMoE<true> P{(const char*)(ws + WS_U), 8, 1024u, 1024u, (const char*)(ws + WS_WGUT), (size_t)2048 * 1024, 8, nblk, F.G, F.c, (const int*)(ws + WS_ROWTOK) + (size_t)ch * ROWS_CH, blk_e};
            EpiGU E{F.in[I_BGU], (unsigned char*)(ws + WS_ACT)};
            for (int r = 0; r < (ch == 0 ? REPS(10) : 1); ++r) { pg8::gemm_phase<ProbMoE<true>, EpiGU, true, false, true>(F.lds, P, E); if (ch == 0) REPBAR(10, r); }
        }
        SEAM(9 + 3 * ch);
        if (IN(10 + 3 * ch)) {
            const int nblk = moe_blocks(F, ch, blk_e);
            ProbMoE<false> P{(const char*)(ws + WS_ACT), 8, 1024u, 1024u, (const char*)(ws + WS_WDNT), (size_t)1024 * 1024, 4, nblk, F.G, F.c, nullptr, blk_e};
            EpiDN E{F.in[I_BDN], (bf16_t*)(ws + WS_YCH)};
            for (int r = 0; r < (ch == 0 ? REPS(11) : 1); ++r) { pg8::gemm_phase<ProbMoE<false>, EpiDN, true, false, true>(F.lds, P, E); if (ch == 0) REPBAR(11, r); }
        }
        SEAM(10 + 3 * ch);
        if (IN(11 + 3 * ch)) { for (int r = 0; r < (ch == 0 ? REPS(12) : 1); ++r) { p13_combine_ln2(F, ch, ch == 0 && r + 1 < REPS(12)); if (ch == 0) REPBAR(12, r); } }
        SEAM(11 + 3 * ch);
    }
#ifdef DBG_K
    xcd_barrier(bar);
    {
        const unsigned char* buf = (DBG_OUT) ? (const unsigned char*)F.out : (const unsigned char*)(ws + (size_t)(DBG_OFF));
        const size_t wpr = (size_t)(DBG_CW) / 4, nw = (size_t)(DBG_ROWS) * wpr;
        unsigned long long cs = 0; unsigned bad = 0;
        for (size_t i = (size_t)F.c * NTHR + F.tid; i < nw; i += (size_t)F.G * NTHR) { const size_t r = i / wpr, cw = i % wpr; const unsigned w = *(const unsigned*)(buf + r * (size_t)(DBG_LD) + (DBG_C0) + cw * 4); cs += w;
            if (DBG_F32) { if ((w & 0x7f800000u) == 0x7f800000u) ++bad; } else { if ((w & 0x7f80u) == 0x7f80u) ++bad; if ((w & 0x7f800000u) == 0x7f800000u) ++bad; } }
        for (int o = 32; o >= 1; o >>= 1) { cs += __shfl_xor(cs, o); bad += __shfl_xor(bad, o); }
        if (F.lane == 0) { atomicAdd((unsigned long long*)(F.ctl + 8192), cs); atomicAdd(F.ctl + 8200, bad); }
        if (F.c == 0 && F.tid == 0) atomicAdd(F.ctl + 8201, xb_ld(&F.ctl[XB_TMO]));
    }
    xcd_barrier(bar);
    {
        const unsigned long long cs = __hip_atomic_load((unsigned long long*)(F.ctl + 8192), __ATOMIC_RELAXED, __HIP_MEMORY_SCOPE_AGENT);
        const unsigned bad = xb_ld(F.ctl + 8200), tmo = xb_ld(F.ctl + 8201);
        const float val = (float)(unsigned)((cs ^ (cs >> 16) ^ (cs >> 32)) & 0xFFFFu) * (1.0f / 65536.0f) + (bad ? 2.0f : 0.0f) + (tmo ? 4.0f : 0.0f);
        for (size_t i = (size_t)F.c * NTHR + F.tid; i < (size_t)T * D; i += (size_t)F.G * NTHR) F.out[i] = val;
    }
    return;
#endif
    if (F.c == 0 && F.tid == 0 && hi == N_PHASES) { if (xb_ld(&F.ctl[XB_TMO]) != 0u) F.out[0] = __builtin_nanf(""); }
#undef IN
#undef SEAM
}

extern "C" void kernel_launch(void* const* d_in, const int* in_sizes, int n_in, void* d_out, int out_size, void* d_ws, size_t ws_size, hipStream_t stream) {
    static int grid = 0;
    if (grid == 0) {
        if (n_in != 22 || out_size != T * D || ws_size < WS_END) { fprintf(stderr, "kernel_launch: unexpected shapes (n_in %d, out %d, ws %zu)\n", n_in, out_size, ws_size); grid = -1; return; }
        int dev = 0, cus = 0, per_cu = 0;
        if (hipGetDevice(&dev) != hipSuccess || hipDeviceGetAttribute(&cus, hipDeviceAttributeMultiprocessorCount, dev) != hipSuccess) { grid = -1; return; }
        if (hipFuncSetAttribute((const void*)mega_fwd, hipFuncAttributeMaxDynamicSharedMemorySize, LDS_BYTES) != hipSuccess) { fprintf(stderr, "kernel_launch: hipFuncSetAttribute failed\n"); grid = -1; return; }
        if (hipOccupancyMaxActiveBlocksPerMultiprocessor(&per_cu, (const void*)mega_fwd, NTHR, LDS_BYTES) != hipSuccess || per_cu < 1) fprintf(stderr, "kernel_launch: occupancy query reports %d blocks per CU\n", per_cu);
        (void)hipGetLastError();
        grid = cus;
    }
    if (grid < 0) return;
    (void)hipMemsetAsync((char*)d_ws + WS_CTL, 0, CTL_BYTES, stream);
    Args a{};
    for (int i = 0; i < 22; ++i) a.in[i] = (const float*)d_in[i];
    a.out = (float*)d_out; a.ws = (unsigned char*)d_ws; a.ph_lo = 0; a.ph_hi = N_PHASES;
#ifdef DBG_K
    a.ph_hi = DBG_K;
#endif
    hipLaunchKernelGGL(mega_fwd, dim3(grid), dim3(NTHR), LDS_BYTES, stream, a);
}
```

```cpp
#include <hip/hip_runtime.h>
#include <cstdio>
#include <cstdint>

#define LAS __attribute__((address_space(3)))
typedef unsigned short bf16_t;
typedef short bf16x8 __attribute__((ext_vector_type(8)));
typedef short bf16x4 __attribute__((ext_vector_type(4)));
typedef float f32x4 __attribute__((ext_vector_type(4)));
typedef float f32x2 __attribute__((ext_vector_type(2)));
typedef unsigned u32x4 __attribute__((ext_vector_type(4)));
typedef unsigned u32x2 __attribute__((ext_vector_type(2)));

constexpr int D = 1024, NB = 32, SEQ = 2048, T = NB * SEQ, CTX = 256, TCX = NB * CTX;
constexpr int NEXP = 32, TOPK = 4;
constexpr int NCH = 2, TCH = T / NCH;
constexpr int ROWS_CH = TCH * TOPK + NEXP * 256;
constexpr float DN_ALPHA = 1.189207115002721f;
constexpr float LN_EPS = 1e-5f, RMS_EPS = 1e-6f;
constexpr int NTHR = 512;

constexpr size_t MiB = 1ull << 20;
constexpr size_t WS_CTL = 0;
constexpr size_t CTL_BYTES = 65536;
constexpr size_t WS_ADA = 65536;
constexpr size_t WS_WIN1T = 1 * MiB;
constexpr size_t WS_WIN2T = 7 * MiB;
constexpr size_t WS_WMT = 12 * MiB;
constexpr size_t WS_WOT = 14 * MiB;
constexpr size_t WS_WGUT = 16 * MiB;
constexpr size_t WS_WDNT = 144 * MiB;
constexpr size_t WS_TOPI = 208 * MiB;
constexpr size_t WS_TOPW = 209 * MiB;
constexpr size_t WS_POS = 210 * MiB;
constexpr size_t WS_ROWTOK = 211 * MiB;
constexpr size_t WS_U = 216 * MiB;
constexpr size_t WS_PA = 344 * MiB;
constexpr size_t WS_PH = 472 * MiB;
constexpr size_t WS_PHC = 728 * MiB;
constexpr size_t WS_PG = 760 * MiB;
constexpr size_t WS_Y = 824 * MiB;
constexpr size_t WS_UC = WS_Y;
constexpr size_t WS_ACT = WS_PA;
constexpr size_t WS_YCH = WS_PA + 272 * MiB;
constexpr size_t WS_END = 952 * MiB;
static_assert(WS_YCH + 272 * MiB <= WS_END, "ws map");
constexpr int CW_CNT = 4096;
constexpr int CW_CUR = 4096 + 64;

constexpr int LDS_SCRATCH = 147456;
constexpr int LDS_MISC = LDS_SCRATCH;
constexpr int LDS_BYTES = LDS_SCRATCH + 2048;

typedef __bf16 bf16x2_t __attribute__((ext_vector_type(2)));
__device__ __forceinline__ unsigned cvt_pk_bf16(float lo, float hi) { const f32x2 v = {lo, hi}; const bf16x2_t r = __builtin_convertvector(v, bf16x2_t); return __builtin_bit_cast(unsigned, r); }
__device__ __forceinline__ unsigned cvt_pk4_fp8(float a, float b, float c, float d) {
    a = fminf(fmaxf(a, -448.f), 448.f); b = fminf(fmaxf(b, -448.f), 448.f); c = fminf(fmaxf(c, -448.f), 448.f); d = fminf(fmaxf(d, -448.f), 448.f);
    int w = __builtin_amdgcn_cvt_pk_fp8_f32(a, b, 0, false); w = __builtin_amdgcn_cvt_pk_fp8_f32(c, d, w, true); return (unsigned)w; }
constexpr float W8_SCALE = 32.0f, W8_INV = 1.0f / 32.0f;
__device__ __forceinline__ float bf_lo(unsigned w) { return __uint_as_float(w << 16); }
__device__ __forceinline__ float bf_hi(unsigned w) { return __uint_as_float(w & 0xffff0000u); }
__device__ __forceinline__ float bf2f(bf16_t v) { return __uint_as_float(((unsigned)v) << 16); }
__device__ __forceinline__ float fast_exp(float x) { return __builtin_amdgcn_exp2f(x * 1.4426950408889634f); }
__device__ __forceinline__ float fast_sigmoid(float x) { return __builtin_amdgcn_rcpf(1.0f + fast_exp(-x)); }
__device__ __forceinline__ float fast_log(float x) { return __builtin_amdgcn_logf(x) * 0.6931471805599453f; }

#define XB_TMO      128
#define XB_XCNT(j)  (256  + 64 * (j))
#define XB_XSUB(j)  (1280 + 64 * (j))
#define XB_XGEN(j)  (2304 + 64 * (j))
#define XB_TOP      3328
#define XB_TOPGEN   3392
#define XCD_BAR_WORDS 3456
#define XB_SPIN_CAP (1u << 18)

__device__ __forceinline__ unsigned xb_ld(unsigned* p)              { return __hip_atomic_load(p, __ATOMIC_RELAXED, __HIP_MEMORY_SCOPE_AGENT); }
__device__ __forceinline__ unsigned xb_add(unsigned* p, unsigned v) { return __hip_atomic_fetch_add(p, v, __ATOMIC_RELAXED, __HIP_MEMORY_SCOPE_AGENT); }
__device__ __forceinline__ unsigned xb_xcc_id() { return (unsigned)__builtin_amdgcn_s_getreg((3 << 11) | 20) & 0xFu; }
#define XB_SPIN(cond, bar) do { unsigned _sp = 0; while (cond) { __builtin_amdgcn_s_sleep(1); \
    if ((++_sp & 255u) == 0u) { if (xb_ld(&(bar)[XB_TMO])) break; if (_sp > XB_SPIN_CAP) { atomicAdd(&(bar)[XB_TMO], 1u); break; } } } } while (0)

struct XcdBarrier { unsigned* bar; unsigned x; volatile LAS unsigned* st; };

__device__ __forceinline__ XcdBarrier xcd_barrier_post(unsigned* bar, volatile LAS unsigned* st) {
    XcdBarrier b; b.bar = bar; b.x = xb_xcc_id(); b.st = st;
    if (threadIdx.x == 0) (void)xb_add(&bar[XB_XCNT(b.x)], 1u);
    return b;
}
__device__ __forceinline__ void xcd_barrier_complete(unsigned* bar, unsigned x, unsigned& nloc, unsigned& nx) {
    const unsigned G = gridDim.x * gridDim.y * gridDim.z;
    unsigned sum, cnt, mine, sp = 0u;
    for (;;) {
        sum = 0u; cnt = 0u; mine = 0u;
#pragma unroll
        for (unsigned j = 0; j < 16; ++j) { const unsigned c = xb_ld(&bar[XB_XCNT(j)]); sum += c; cnt += (c > 0u) ? 1u : 0u; mine = (j == x) ? c : mine; }
        if (sum == G) break;
        __builtin_amdgcn_s_sleep(1);
        if ((++sp & 255u) == 0u) { if (xb_ld(&bar[XB_TMO])) break; if (sp > XB_SPIN_CAP) { atomicAdd(&bar[XB_TMO], 1u); break; } }
    }
    nloc = mine > 0u ? mine : 1u; nx = cnt > 0u ? cnt : 1u;
}
__device__ __forceinline__ void xcd_barrier(const XcdBarrier& b) {
    asm volatile("s_waitcnt vmcnt(0)" ::: "memory");
    __syncthreads();
    if (threadIdx.x == 0) {
        unsigned* bar = b.bar;
        __builtin_amdgcn_s_waitcnt(0);
        unsigned nloc = b.st[0], nx = b.st[1];
        if (nloc == 0u) { xcd_barrier_complete(bar, b.x, nloc, nx); b.st[0] = nloc; b.st[1] = nx; }
        const unsigned old = xb_add(&bar[XB_XSUB(b.x)], 1u);
        const unsigned gen = old / nloc;
        if (old + 1u == (gen + 1u) * nloc) {
            __builtin_amdgcn_fence(__ATOMIC_RELEASE, "agent");
            asm volatile("s_waitcnt vmcnt(0)" ::: "memory");
            const unsigned og = xb_add(&bar[XB_TOP], 1u);
            const unsigned tg = og / nx;
            if (og + 1u == (tg + 1u) * nx) xb_add(&bar[XB_TOPGEN], 1u);
            else XB_SPIN(xb_ld(&bar[XB_TOPGEN]) == tg, bar);
            __builtin_amdgcn_fence(__ATOMIC_ACQUIRE, "agent");
            xb_add(&bar[XB_XGEN(b.x)], 1u);
            asm volatile("s_waitcnt vmcnt(0)" ::: "memory");
        } else {
            XB_SPIN(xb_ld(&bar[XB_XGEN(b.x)]) == gen, bar);
            __builtin_amdgcn_fence(__ATOMIC_ACQUIRE, "agent");
            asm volatile("s_waitcnt vmcnt(0)" ::: "memory");
        }
    }
    __syncthreads();
}

namespace pg8 {
constexpr int BM = 256, BK = 64, HALF = 128, HTB = HALF * BK * 2, STAGE_BYTES = 8 * HTB, NXCD = 8, WGM = 8;
__host__ __device__ __forceinline__ int lds_byte(int r, int c) { const int st = (r >> 4) * 2 + (c >> 5), rr = r & 15, cc = c & 31, ob = rr * 64 + cc * 2; return st * 1024 + (ob ^ (((ob >> 9) & 1) << 5)); }
__host__ __device__ __forceinline__ void stage_rc(int b, int& R, int& C) { const int st = b / 1024, sb = b % 1024, swz = sb ^ (((sb >> 9) & 1) << 5); R = (st >> 1) * 16 + swz / 64; C = (st & 1) * 32 + (swz % 64) / 2; }
__host__ __device__ __forceinline__ int perm32(int rho) { const int n = rho >> 4, i = rho & 15; return 8 * (i >> 2) + 4 * n + (i & 3); }

struct Unit { int pm, pn, aux; };

__device__ __forceinline__ void grouped(int wgid, int nM, int nN, int& pm, int& pn) {
    const int nig = WGM * nN, gid = wgid / nig, fm = gid * WGM, gsz = (nM - fm) < WGM ? (nM - fm) : WGM;
    pm = fm + ((wgid % nig) % gsz); pn = (wgid % nig) / gsz;
}
__device__ __forceinline__ bool xcd_remap(int i, int G, int c, int nwg, int& wgid) {
    const long L = (long)i * G + c; if (L >= nwg) return false;
    wgid = (int)L; const int q = nwg / NXCD, r = nwg % NXCD, xcd = wgid % NXCD, off = wgid / NXCD;
    wgid = (xcd < r ? xcd * (q + 1) : r * (q + 1) + (xcd - r) * q) + off; return true;
}

typedef int i32x8 __attribute__((ext_vector_type(8)));
typedef int i32x4 __attribute__((ext_vector_type(4)));
template <bool F8> struct Frags;
template <> struct Frags<false> { bf16x8 a[4][2], b0[2][2], b1[2][2]; };
template <> struct Frags<true> { i32x8 a[4], b0[2], b1[2]; };
template <class Prob, class Epi, bool ALIGN_EPI, bool HOOK, bool FP8 = false>
__device__ __forceinline__ void gemm_phase(LAS unsigned char* lds, const Prob& P, const Epi& E) {
    int tid_ = threadIdx.x; asm volatile("" : "+v"(tid_));
    const int tid = tid_, wid = __builtin_amdgcn_readfirstlane(tid >> 6), lane = tid & 63, wr = wid >> 2, wc = wid & 3, fr = lane & 15, fq = lane >> 4;
    const int nt = P.nt;
    unsigned voffB[2], voffA[2];
#pragma unroll
    for (int i = 0; i < 2; ++i) { int R, C; stage_rc(tid * 16 + i * 8192, R, C); const int Rb = Epi::PERM ? ((R & ~31) + perm32(R & 31)) : R;
        voffB[i] = (unsigned)Rb * P.ldb2 + (unsigned)C * 2u; voffA[i] = (unsigned)R * P.lda2 + (unsigned)C * 2u; }
    auto gather_offs = [&](const Unit& u, unsigned (&o0)[2], unsigned (&o1)[2]) {
#pragma unroll
        for (int i = 0; i < 2; ++i) { int R, C; int tt = threadIdx.x; asm volatile("" : "+v"(tt)); stage_rc(tt * 16 + i * 8192, R, C); o0[i] = P.a_row(u, R) + (unsigned)C * 2u; o1[i] = P.a_row(u, HALF + R) + (unsigned)C * 2u; } };
    const size_t kstep = (size_t)(BK * 2);
    const size_t hstepB = (size_t)HALF * P.ldb2;
    const size_t hstepA = (size_t)HALF * P.lda2;
    const unsigned ldsw = (unsigned)wid * 1024u;
    const int aoff = lds_byte(wr * 64 + fr, fq * 8), boff = lds_byte(wc * 32 + fr, fq * 8);
#define PG8_SA(b, h) (((b) * 2 + (h)) * HTB)
#define PG8_SB(b, h) ((4 + (b) * 2 + (h)) * HTB)
#define PG8_STAGE(bufoff, gbase, voff) do { _Pragma("unroll") for (int _i = 0; _i < 2; ++_i) \
        __builtin_amdgcn_global_load_lds((const unsigned*)((const char*)(gbase) + (voff)[_i]), (LAS unsigned*)(lds + (bufoff) + ldsw + _i * 8192), 16, 0, 0); } while (0)
#define PG8_LDA(dst, b, h) do { if constexpr (FP8) { _Pragma("unroll") for (int m = 0; m < 4; ++m) { FR.a[m].lo = *(const LAS i32x4*)(lds + PG8_SA(b, h) + aoff + m * 2048); FR.a[m].hi = *(const LAS i32x4*)(lds + PG8_SA(b, h) + aoff + m * 2048 + 1024); } } \
        else { _Pragma("unroll") for (int m = 0; m < 4; ++m) _Pragma("unroll") for (int k = 0; k < 2; ++k) FR.a[m][k] = *(const LAS bf16x8*)(lds + PG8_SA(b, h) + aoff + m * 2048 + k * 1024); } } while (0)
#define PG8_LDB(dst, b, h) do { if constexpr (FP8) { _Pragma("unroll") for (int n = 0; n < 2; ++n) { FR.dst[n].lo = *(const LAS i32x4*)(lds + PG8_SB(b, h) + boff + n * 2048); FR.dst[n].hi = *(const LAS i32x4*)(lds + PG8_SB(b, h) + boff + n * 2048 + 1024); } } \
        else { _Pragma("unroll") for (int n = 0; n < 2; ++n) _Pragma("unroll") for (int k = 0; k < 2; ++k) FR.dst[n][k] = *(const LAS bf16x8*)(lds + PG8_SB(b, h) + boff + n * 2048 + k * 1024); } } while (0)
#define PG8_MMA(ai, bj, At, Bt) do { __builtin_amdgcn_s_setprio(1); if constexpr (FP8) { _Pragma("unroll") for (int m = 0; m < 4; ++m) _Pragma("unroll") for (int n = 0; n < 2; ++n) \
            asm volatile("v_mfma_f32_16x16x128_f8f6f4 %0, %1, %2, %0" : "+v"(acc[ai][bj][m][n]) : "v"(FR.Bt[n]), "v"(FR.a[m])); } \
        else { _Pragma("unroll") for (int m = 0; m < 4; ++m) _Pragma("unroll") for (int n = 0; n < 2; ++n) _Pragma("unroll") for (int k = 0; k < 2; ++k) \
        acc[ai][bj][m][n] = __builtin_amdgcn_mfma_f32_16x16x32_bf16(FR.Bt[n][k], FR.a[m][k], acc[ai][bj][m][n], 0, 0, 0); } __builtin_amdgcn_s_setprio(0); } while (0)
#define PG8_WAIT_V(n) asm volatile("s_waitcnt vmcnt(" #n ")" ::: "memory")
#define PG8_WAIT_L(n) asm volatile("s_waitcnt lgkmcnt(" #n ")" ::: "memory")
#define PG8_BAR __builtin_amdgcn_s_barrier()
#define PG8_SCHED __builtin_amdgcn_sched_barrier(0)
    Unit cur, nxt; int ui = 0;
    if (!P.unit(0, cur)) return;
    f32x4 acc[2][2][4][2];
#pragma unroll
    for (int a = 0; a < 2; ++a)
#pragma unroll
        for (int b = 0; b < 2; ++b)
#pragma unroll
            for (int m = 0; m < 4; ++m)
#pragma unroll
                for (int n = 0; n < 2; ++n) acc[a][b][m][n] = (f32x4){0.f, 0.f, 0.f, 0.f};
    Frags<FP8> FR;
    unsigned va0[2], va1[2], vn0[2], vn1[2];
    const char* const gA = P.Abase; const char* cA = gA; const char* nA = gA; const char* cB = P.b_tile(cur);
    if constexpr (Prob::GATHER) {
        gather_offs(cur, va0, va1);
    } else { cA = gA + P.a_row(cur, 0); }
#define PG8_STAGE_A(bufoff, h, koff, nx) do { if constexpr (Prob::GATHER) { unsigned _v[2]; _Pragma("unroll") for (int _i = 0; _i < 2; ++_i) _v[_i] = (nx) ? ((h) ? vn1[_i] : vn0[_i]) : ((h) ? va1[_i] : va0[_i]); PG8_STAGE(bufoff, gA + (koff), _v); } \
        else { PG8_STAGE(bufoff, ((nx) ? nA : cA) + (h) * hstepA + (koff), voffA); } } while (0)
    PG8_STAGE(PG8_SB(0, 0), cB, voffB); PG8_STAGE(PG8_SB(0, 1), cB + hstepB, voffB); PG8_STAGE_A(PG8_SA(0, 0), 0, 0, false); PG8_STAGE_A(PG8_SA(0, 1), 1, 0, false);
    if (wr == 1) PG8_BAR;
    PG8_WAIT_V(2); PG8_BAR;
    PG8_STAGE(PG8_SB(1, 0), cB + kstep, voffB); PG8_STAGE_A(PG8_SA(1, 0), 0, kstep, false); PG8_STAGE(PG8_SB(1, 1), cB + hstepB + kstep, voffB);
    PG8_WAIT_V(6); PG8_BAR;
    for (;;) {
        const bool has_next = P.unit(ui + 1, nxt);
        if (!has_next) nxt = cur;
        if constexpr (Prob::GATHER) {
            gather_offs(nxt, vn0, vn1);
        } else { nA = gA + P.a_row(nxt, 0); }
        const char* nB = P.b_tile(nxt);
        for (int t = 0; t < nt; t += 2) {
            const bool last = (t == nt - 2);
            if constexpr (HOOK) { if (t == (nt >> 1)) E.mid(acc, cur, wr, wc, fr, fq); }
            const size_t k1 = (size_t)(t + 1) * kstep, k2 = last ? 0 : (size_t)(t + 2) * kstep, k3 = k2 + kstep;
            const char* b2 = last ? nB : cB + (size_t)(t + 2) * kstep; const char* b3 = b2 + kstep;
            PG8_LDB(b0, 0, 0); PG8_LDB(b1, 0, 1); PG8_SCHED; PG8_LDA(At, 0, 0); PG8_STAGE_A(PG8_SA(1, 1), 1, k1, false);
            PG8_WAIT_V(8); PG8_WAIT_L(0); PG8_BAR; PG8_MMA(0, 0, At, b0); PG8_MMA(0, 1, At, b1); PG8_BAR; PG8_SCHED;
            PG8_LDA(At, 0, 1); PG8_STAGE(PG8_SB(0, 0), b2, voffB); PG8_STAGE(PG8_SB(0, 1), b2 + hstepB, voffB); PG8_STAGE_A(PG8_SA(0, 0), 0, k2, last);
            PG8_WAIT_V(8); PG8_WAIT_L(0); PG8_BAR; PG8_MMA(1, 0, At, b0); PG8_MMA(1, 1, At, b1); PG8_BAR; PG8_SCHED;
            PG8_LDB(b0, 1, 0); PG8_LDB(b1, 1, 1); PG8_SCHED; PG8_LDA(At, 1, 0); PG8_STAGE_A(PG8_SA(0, 1), 1, k2, last);
            PG8_WAIT_V(8); PG8_WAIT_L(0); PG8_BAR; PG8_MMA(0, 0, At, b0); PG8_MMA(0, 1, At, b1); PG8_BAR; PG8_SCHED;
            PG8_LDA(At, 1, 1); PG8_STAGE(PG8_SB(1, 0), b3, voffB); PG8_STAGE(PG8_SB(1, 1), b3 + hstepB, voffB); PG8_STAGE_A(PG8_SA(1, 0), 0, k3, last);
            PG8_WAIT_V(8); PG8_WAIT_L(0); PG8_BAR; PG8_MMA(1, 0, At, b0); PG8_MMA(1, 1, At, b1); PG8_BAR; PG8_SCHED;
        }
        if constexpr (ALIGN_EPI) { if (wr == 0) PG8_BAR; }
        if constexpr (FP8) asm volatile("s_nop 15\n\ts_nop 15" ::: "memory");
        E(acc, cur, wr, wc, fr, fq);
        if (!has_next) break;
#pragma unroll
        for (int a = 0; a < 2; ++a)
#pragma unroll
            for (int b = 0; b < 2; ++b)
#pragma unroll
                for (int m = 0; m < 4; ++m)
#pragma unroll
                    for (int n = 0; n < 2; ++n) acc[a][b][m][n] = (f32x4){0.f, 0.f, 0.f, 0.f};
        cur = nxt; cB = nB; cA = nA; ++ui;
        if constexpr (Prob::GATHER) {
#pragma unroll
            for (int i = 0; i < 2; ++i) { va0[i] = vn0[i]; va1[i] = vn1[i]; } }
        if constexpr (ALIGN_EPI) { if (wr == 1) PG8_BAR; }
    }
    PG8_WAIT_V(0);
    if constexpr (!ALIGN_EPI) { if (wr == 0) PG8_BAR; }
    PG8_BAR;
#undef PG8_SA
#undef PG8_SB
#undef PG8_STAGE
#undef PG8_STAGE_A
#undef PG8_LDA
#undef PG8_LDB
#undef PG8_MMA
#undef PG8_WAIT_V
#undef PG8_WAIT_L
#undef PG8_BAR
#undef PG8_SCHED
}
}

using pg8::Unit;

struct ProbDense {
    static constexpr bool GATHER = false;
    const char* Abase; int nt; unsigned ldb2; unsigned lda2; const char* Bt; int nM, nN, G, c;
    __device__ __forceinline__ bool unit(int i, Unit& u) const { int w; if (!pg8::xcd_remap(i, G, c, nM * nN, w)) return false; pg8::grouped(w, nM, nN, u.pm, u.pn); u.aux = 0; return true; }
    __device__ __forceinline__ unsigned a_row(const Unit& u, int r) const { return (unsigned)(u.pm * 256 + r) * lda2; }
    __device__ __forceinline__ const char* b_tile(const Unit& u) const { return Bt + (size_t)u.pn * 256 * ldb2; }
};
struct ProbP1 {
    static constexpr bool GATHER = false;
    const char* Abase; int nt; unsigned ldb2; unsigned lda2; const char* Bt; unsigned uc_off; int G, c;
    __device__ __forceinline__ bool unit(int i, Unit& u) const {
        int w; if (!pg8::xcd_remap(i, G, c, 3072 + 256, w)) return false;
        if (w < 3072) { pg8::grouped(w, 256, 12, u.pm, u.pn); u.aux = 0; }
        else { pg8::grouped(w - 3072, 32, 8, u.pm, u.pn); u.pn += 4; u.aux = 1; }
        return true; }
    __device__ __forceinline__ unsigned a_row(const Unit& u, int r) const { return (u.aux ? uc_off : 0u) + (unsigned)(u.pm * 256 + r) * lda2; }
    __device__ __forceinline__ const char* b_tile(const Unit& u) const { return Bt + (size_t)u.pn * 256 * ldb2; }
};
template <bool GATHER_> struct ProbMoE {
    static constexpr bool GATHER = GATHER_;
    const char* Abase; int nt; unsigned ldb2; unsigned lda2; const char* Bt; size_t estride; int nN, nblk, G, c; const int* rowtok; const LAS unsigned char* blk_e;
    __device__ __forceinline__ bool unit(int i, Unit& u) const { int w; if (!pg8::xcd_remap(i, G, c, nblk * nN, w)) return false; pg8::grouped(w, nblk, nN, u.pm, u.pn); u.aux = (int)blk_e[u.pm]; return true; }
    __device__ __forceinline__ unsigned a_row(const Unit& u, int r) const { if (GATHER) return (unsigned)rowtok[u.pm * 256 + r] * lda2; else return (unsigned)(u.pm * 256 + r) * lda2; }
    __device__ __forceinline__ const char* b_tile(const Unit& u) const { return Bt + (size_t)u.aux * estride + (size_t)u.pn * 256 * ldb2; }
};

struct EpiP1 {
    static constexpr bool PERM = true;
    bf16_t* PA; bf16_t* PH; bf16_t* PHC;
    __device__ __forceinline__ void operator()(const f32x4 (&acc)[2][2][4][2], const Unit& u, int wr, int wc, int fr, int fq) const {
        bf16_t* base; int ldc, colt;
        if (u.aux) { base = PHC; ldc = 2048; colt = (u.pn - 4) * 256; }
        else if (u.pn < 4) { base = PA; ldc = 1024; colt = u.pn * 256; }
        else { base = PH; ldc = 2048; colt = (u.pn - 4) * 256; }
        const int row0 = u.pm * 256 + wr * 64 + fr, col0 = colt + wc * 32 + 8 * fq;
#pragma unroll
        for (int ai = 0; ai < 2; ++ai)
#pragma unroll
            for (int m = 0; m < 4; ++m) { bf16_t* rowp = base + (size_t)(row0 + ai * 128 + m * 16) * ldc + col0;
#pragma unroll
                for (int bj = 0; bj < 2; ++bj) { const f32x4 v0 = acc[ai][bj][m][0] * W8_INV, v1 = acc[ai][bj][m][1] * W8_INV;
                    u32x4 w; w.x = cvt_pk_bf16(v0[0], v0[1]); w.y = cvt_pk_bf16(v0[2], v0[3]); w.z = cvt_pk_bf16(v1[0], v1[1]); w.w = cvt_pk_bf16(v1[2], v1[3]);
                    *(u32x4*)(rowp + bj * 128) = w; } }
    }
    __device__ __forceinline__ void mid(f32x4 (&)[2][2][4][2], const Unit&, int, int, int, int) const {}
};
struct EpiP2 {
    static constexpr bool PERM = true;
    bf16_t* PG; bf16_t* GATES;
    __device__ __forceinline__ void operator()(const f32x4 (&acc)[2][2][4][2], const Unit& u, int wr, int wc, int fr, int fq) const {
        const bool isg = u.pn >= 2; bf16_t* base = isg ? GATES : PG; const int ldc = isg ? 2048 : 512, colt = isg ? (u.pn - 2) * 256 : u.pn * 256;
        const int row0 = u.pm * 256 + wr * 64 + fr, col0 = colt + wc * 32 + 8 * fq;
#pragma unroll
        for (int ai = 0; ai < 2; ++ai)
#pragma unroll
            for (int m = 0; m < 4; ++m) { bf16_t* rowp = base + (size_t)(row0 + ai * 128 + m * 16) * ldc + col0;
#pragma unroll
                for (int bj = 0; bj < 2; ++bj) { f32x4 v0 = acc[ai][bj][m][0] * W8_INV, v1 = acc[ai][bj][m][1] * W8_INV;
#pragma unroll
                    for (int j = 0; j < 4; ++j) { const float s0 = fast_sigmoid(v0[j]), s1 = fast_sigmoid(v1[j]); v0[j] = isg ? s0 : v0[j] * s0; v1[j] = isg ? s1 : v1[j] * s1; }
                    u32x4 w; w.x = cvt_pk_bf16(v0[0], v0[1]); w.y = cvt_pk_bf16(v0[2], v0[3]); w.z = cvt_pk_bf16(v1[0], v1[1]); w.w = cvt_pk_bf16(v1[2], v1[3]);
                    *(u32x4*)(rowp + bj * 128) = w; } }
    }
    __device__ __forceinline__ void mid(f32x4 (&)[2][2][4][2], const Unit&, int, int, int, int) const {}
};
struct EpiM1 {
    static constexpr bool PERM = true;
    const bf16_t* GATES; bf16_t* Mo;
    __device__ __forceinline__ void mid(f32x4 (&acc)[2][2][4][2], const Unit& u, int wr, int wc, int fr, int fq) const {
        int row0 = u.pm * 256 + wr * 64 + fr, col0 = u.pn * 256 + wc * 32 + 8 * fq;
        asm volatile("" : "+v"(row0), "+v"(col0));
#pragma unroll
        for (int ai = 0; ai < 2; ++ai) {
            u32x4 gf[4][2], gh[4][2];
#pragma unroll
            for (int m = 0; m < 4; ++m) { const bf16_t* gp = GATES + (size_t)(row0 + ai * 128 + m * 16) * 2048 + col0;
#pragma unroll
                for (int bj = 0; bj < 2; ++bj) { gf[m][bj] = *(const u32x4*)(gp + bj * 128); gh[m][bj] = *(const u32x4*)(gp + 1024 + bj * 128); } }
#pragma unroll
            for (int m = 0; m < 4; ++m)
#pragma unroll
                for (int bj = 0; bj < 2; ++bj) { const u32x4 f = gf[m][bj], h = gh[m][bj];
                    f32x4& v0 = acc[ai][bj][m][0]; f32x4& v1 = acc[ai][bj][m][1];
                    v0[0] *= bf_lo(f.x) * __builtin_amdgcn_rcpf(fmaxf(bf_lo(h.x), 1e-20f)); v0[1] *= bf_hi(f.x) * __builtin_amdgcn_rcpf(fmaxf(bf_hi(h.x), 1e-20f));
                    v0[2] *= bf_lo(f.y) * __builtin_amdgcn_rcpf(fmaxf(bf_lo(h.y), 1e-20f)); v0[3] *= bf_hi(f.y) * __builtin_amdgcn_rcpf(fmaxf(bf_hi(h.y), 1e-20f));
                    v1[0] *= bf_lo(f.z) * __builtin_amdgcn_rcpf(fmaxf(bf_lo(h.z), 1e-20f)); v1[1] *= bf_hi(f.z) * __builtin_amdgcn_rcpf(fmaxf(bf_hi(h.z), 1e-20f));
                    v1[2] *= bf_lo(f.w) * __builtin_amdgcn_rcpf(fmaxf(bf_lo(h.w), 1e-20f)); v1[3] *= bf_hi(f.w) * __builtin_amdgcn_rcpf(fmaxf(bf_hi(h.w), 1e-20f)); }
            asm volatile("" ::: "memory");
        }
    }
    __device__ __forceinline__ void operator()(const f32x4 (&acc)[2][2][4][2], const Unit& u, int wr, int wc, int fr, int fq) const {
        const int row0 = u.pm * 256 + wr * 64 + fr, col0 = u.pn * 256 + wc * 32 + 8 * fq;
#pragma unroll
        for (int ai = 0; ai < 2; ++ai) {
            u32x4 gh[4][2];
#pragma unroll
            for (int m = 0; m < 4; ++m) { const bf16_t* gp = GATES + (size_t)(row0 + ai * 128 + m * 16) * 2048 + 1024 + col0;
#pragma unroll
                for (int bj = 0; bj < 2; ++bj) gh[m][bj] = *(const u32x4*)(gp + bj * 128); }
#pragma unroll
            for (int m = 0; m < 4; ++m) { bf16_t* rowp = Mo + (size_t)(row0 + ai * 128 + m * 16) * 1024 + col0;
#pragma unroll
                for (int bj = 0; bj < 2; ++bj) { const u32x4 h = gh[m][bj]; const f32x4 v0 = acc[ai][bj][m][0], v1 = acc[ai][bj][m][1];
                    u32x4 w; w.x = cvt_pk_bf16(v0[0] * bf_lo(h.x), v0[1] * bf_hi(h.x)); w.y = cvt_pk_bf16(v0[2] * bf_lo(h.y), v0[3] * bf_hi(h.y));
                    w.z = cvt_pk_bf16(v1[0] * bf_lo(h.z), v1[1] * bf_hi(h.z)); w.w = cvt_pk_bf16(v1[2] * bf_lo(h.w), v1[3] * bf_hi(h.w));
                    *(u32x4*)(rowp + bj * 128) = w; } }
            asm volatile("" ::: "memory");
        }
    }
};
struct EpiM2 {
    static constexpr bool PERM = false;
    const float* X; const float* ada; float* V;
    __device__ __forceinline__ void operator()(const f32x4 (&acc)[2][2][4][2], const Unit& u, int wr, int wc, int fr, int fq) const {
        const int row0 = u.pm * 256 + wr * 64 + fr, col0 = u.pn * 256 + wc * 32 + 4 * fq;
        const float* g1 = ada + (size_t)(u.pm >> 3) * 6144 + 2048 + col0;
        f32x4 gv[2][2];
#pragma unroll
        for (int bj = 0; bj < 2; ++bj)
#pragma unroll
            for (int n = 0; n < 2; ++n) gv[bj][n] = *(const f32x4*)(g1 + bj * 128 + n * 16);
#pragma unroll
        for (int ai = 0; ai < 2; ++ai) {
            f32x4 xv[4][2][2];
#pragma unroll
            for (int m = 0; m < 4; ++m) { const size_t off = (size_t)(row0 + ai * 128 + m * 16) * 1024 + col0;
#pragma unroll
                for (int bj = 0; bj < 2; ++bj)
#pragma unroll
                    for (int n = 0; n < 2; ++n) xv[m][bj][n] = *(const f32x4*)(X + off + bj * 128 + n * 16); }
#pragma unroll
            for (int m = 0; m < 4; ++m) { const size_t off = (size_t)(row0 + ai * 128 + m * 16) * 1024 + col0;
#pragma unroll
                for (int bj = 0; bj < 2; ++bj)
#pragma unroll
                    for (int n = 0; n < 2; ++n) *(f32x4*)(V + off + bj * 128 + n * 16) = xv[m][bj][n] * DN_ALPHA + gv[bj][n] * acc[ai][bj][m][n]; }
            asm volatile("" ::: "memory");
        }
    }
    __device__ __forceinline__ void mid(f32x4 (&)[2][2][4][2], const Unit&, int, int, int, int) const {}
};
struct EpiGU {
    static constexpr bool PERM = true;
    const float* bgu; unsigned char* ACT;
    __device__ __forceinline__ void operator()(const f32x4 (&acc)[2][2][4][2], const Unit& u, int wr, int wc, int fr, int fq) const {
        const int row0 = u.pm * 256 + wr * 64 + fr, col0 = u.pn * 128 + wc * 32 + 8 * fq;
        const float* bp = bgu + (size_t)u.aux * 2048 + col0;
        const f32x4 bg0 = *(const f32x4*)(bp), bg1 = *(const f32x4*)(bp + 4), bu0 = *(const f32x4*)(bp + 1024), bu1 = *(const f32x4*)(bp + 1028);
#pragma unroll
        for (int ai = 0; ai < 2; ++ai)
#pragma unroll
            for (int m = 0; m < 4; ++m) { unsigned char* rowp = ACT + (size_t)(row0 + ai * 128 + m * 16) * 1024 + col0;
                f32x4 g0 = acc[ai][0][m][0] * W8_INV + bg0, g1 = acc[ai][0][m][1] * W8_INV + bg1, p0 = acc[ai][1][m][0] * W8_INV + bu0, p1 = acc[ai][1][m][1] * W8_INV + bu1;
#pragma unroll
                for (int j = 0; j < 4; ++j) {
                    float g = fminf(g0[j], 7.0f), p = fminf(fmaxf(p0[j], -7.0f), 7.0f); g0[j] = (p + 1.0f) * g * fast_sigmoid(1.702f * g);
                    g = fminf(g1[j], 7.0f); p = fminf(fmaxf(p1[j], -7.0f), 7.0f); g1[j] = (p + 1.0f) * g * fast_sigmoid(1.702f * g); }
                u32x2 w; w.x = cvt_pk4_fp8(g0[0], g0[1], g0[2], g0[3]); w.y = cvt_pk4_fp8(g1[0], g1[1], g1[2], g1[3]);
                *(u32x2*)rowp = w; }
    }
    __device__ __forceinline__ void mid(f32x4 (&)[2][2][4][2], const Unit&, int, int, int, int) const {}
};
struct EpiDN {
    static constexpr bool PERM = true;
    const float* bdn; bf16_t* Y;
    __device__ __forceinline__ void operator()(const f32x4 (&acc)[2][2][4][2], const Unit& u, int wr, int wc, int fr, int fq) const {
        const int row0 = u.pm * 256 + wr * 64 + fr, col0 = u.pn * 256 + wc * 32 + 8 * fq;
        const float* bp = bdn + (size_t)u.aux * 1024 + col0;
        f32x4 bv[2][2];
#pragma unroll
        for (int bj = 0; bj < 2; ++bj)
#pragma unroll
            for (int n = 0; n < 2; ++n) bv[bj][n] = *(const f32x4*)(bp + bj * 128 + 4 * n);
#pragma unroll
        for (int ai = 0; ai < 2; ++ai)
#pragma unroll
            for (int m = 0; m < 4; ++m) { bf16_t* rowp = Y + (size_t)(row0 + ai * 128 + m * 16) * 1024 + col0;
#pragma unroll
                for (int bj = 0; bj < 2; ++bj) { const f32x4 v0 = acc[ai][bj][m][0] * W8_INV + bv[bj][0], v1 = acc[ai][bj][m][1] * W8_INV + bv[bj][1];
                    u32x4 w; w.x = cvt_pk_bf16(v0[0], v0[1]); w.y = cvt_pk_bf16(v0[2], v0[3]); w.z = cvt_pk_bf16(v1[0], v1[1]); w.w = cvt_pk_bf16(v1[2], v1[3]);
                    *(u32x4*)(rowp + bj * 128) = w; } }
    }
    __device__ __forceinline__ void mid(f32x4 (&)[2][2][4][2], const Unit&, int, int, int, int) const {}
};

struct Frame {
    LAS unsigned char* lds; int tid, lane, wave, G, c;
    const float* const* in; float* out; unsigned char* ws; unsigned* ctl;
};
enum { I_X = 0, I_C, I_CTX, I_CCTX, I_WADA, I_BADA, I_WIN, I_LBRAW, I_HGG, I_WFO, I_WHO, I_WO, I_LN1G, I_LN1B, I_WR, I_BR, I_WGU, I_BGU, I_WDN, I_BDN, I_LN2G, I_LN2B };

__device__ __forceinline__ float wave_sum(float v) {
#pragma unroll
    for (int o = 32; o >= 1; o >>= 1) v += __shfl_xor(v, o);
    return v;
}

__device__ __forceinline__ void p0_ada(const Frame& F) {
    LAS float* cact = (LAS float*)F.lds;
    float* ada = (float*)(F.ws + WS_ADA);
    for (int cb = F.c; cb < 192; cb += F.G) {
        for (int i = F.tid; i < 33 * 1024; i += NTHR) { const int b = i >> 10, k = i & 1023; const float v = b < 32 ? F.in[I_C][b * 1024 + k] : F.in[I_CCTX][k]; cact[i] = v * fast_sigmoid(v); }
        __syncthreads();
        const int kg = F.tid >> 5, col = F.tid & 31, gcol = cb * 32 + col;
        float acc[33];
#pragma unroll
        for (int b = 0; b < 33; ++b) acc[b] = 0.f;
        for (int k = kg; k < 1024; k += 16) { const float w = F.in[I_WADA][(size_t)k * 6144 + gcol];
#pragma unroll
            for (int b = 0; b < 33; ++b) acc[b] += cact[b * 1024 + k] * w; }
        __syncthreads();
        LAS float* red = cact;
#pragma unroll
        for (int b = 0; b < 33; ++b) red[(kg * 33 + b) * 32 + col] = acc[b];
        __syncthreads();
        for (int o = F.tid; o < 33 * 32; o += NTHR) { const int b = o >> 5, cc = o & 31; float s = 0.f;
            for (int g = 0; g < 16; ++g) s += red[(g * 33 + b) * 32 + cc];
            ada[(size_t)b * 6144 + cb * 32 + cc] = s + F.in[I_BADA][cb * 32 + cc]; }
        __syncthreads();
    }
}
__device__ __forceinline__ void p0_fold(const Frame& F) {
    LAS float* xr = (LAS float*)F.lds;
    LAS float* cs = xr + 2048;
    unsigned char* W1 = (unsigned char*)(F.ws + WS_WIN1T);
    if (F.tid < 128) { const float a = (float)F.tid * (1.0f / 128.0f); cs[F.tid] = __builtin_amdgcn_cosf(a); cs[128 + F.tid] = __builtin_amdgcn_sinf(a); }
    for (int kb = F.c; kb < 256; kb += F.G) {
        __syncthreads();
        for (int i = F.tid; i < 2048; i += NTHR) xr[i] = F.in[I_WIN][(size_t)(4 * kb + (i >> 9)) * 5120 + (i & 511)];
        __syncthreads();
        const int g = F.tid >> 7, j = F.tid & 127;
        float ac[4] = {0.f, 0.f, 0.f, 0.f}, as[4] = {0.f, 0.f, 0.f, 0.f};
        for (int d = 0; d < 128; ++d) { const int idx = (d * j) & 127; const float cv = cs[idx], sv = cs[128 + idx];
#pragma unroll
            for (int r = 0; r < 4; ++r) { const float xv = xr[r * 512 + g * 128 + d]; ac[r] += xv * cv; as[r] += xv * sv; } }
        const float sc = 0.08838834764831845f * W8_SCALE;
        *(unsigned*)(W1 + (size_t)(g * 128 + j) * 1024 + 4 * kb) = cvt_pk4_fp8(ac[0] * sc, ac[1] * sc, ac[2] * sc, ac[3] * sc);
        *(unsigned*)(W1 + (size_t)(512 + g * 128 + j) * 1024 + 4 * kb) = cvt_pk4_fp8(-as[0] * sc, -as[1] * sc, -as[2] * sc, -as[3] * sc);
    }
    __syncthreads();
}
__device__ __forceinline__ void cv_tile(const Frame& F, const float* src, int src_ld, bf16_t* dst, int dst_ld) {
    LAS float* tile = (LAS float*)F.lds;
    f32x4 v[8];
#pragma unroll
    for (int i = 0; i < 8; ++i) { const int idx = F.tid + i * NTHR, r = idx >> 5, c4 = idx & 31; v[i] = *(const f32x4*)(src + (size_t)r * src_ld + c4 * 4); }
#pragma unroll
    for (int i = 0; i < 8; ++i) { const int idx = F.tid + i * NTHR, r = idx >> 5, c4 = idx & 31; LAS float* p = tile + r * 129 + c4 * 4; p[0] = v[i][0]; p[1] = v[i][1]; p[2] = v[i][2]; p[3] = v[i][3]; }
    __syncthreads();
#pragma unroll
    for (int i = 0; i < 4; ++i) { const int idx = F.tid + i * NTHR, n = idx >> 4, kc = idx & 15; const LAS float* p = tile + (kc * 8) * 129 + n;
        u32x4 w; w.x = cvt_pk_bf16(p[0], p[129]); w.y = cvt_pk_bf16(p[2 * 129], p[3 * 129]); w.z = cvt_pk_bf16(p[4 * 129], p[5 * 129]); w.w = cvt_pk_bf16(p[6 * 129], p[7 * 129]);
        *(u32x4*)(dst + (size_t)n * dst_ld + kc * 8) = w; }
    __syncthreads();
}
__device__ __forceinline__ void cv_tile_f8(const Frame& F, const float* src, int src_ld, unsigned char* dst, int dst_ld) {
    LAS float* tile = (LAS float*)F.lds;
    f32x4 v[8];
#pragma unroll
    for (int i = 0; i < 8; ++i) { const int idx = F.tid + i * NTHR, r = idx >> 5, c4 = idx & 31; v[i] = *(const f32x4*)(src + (size_t)r * src_ld + c4 * 4); }
#pragma unroll
    for (int i = 0; i < 8; ++i) { const int idx = F.tid + i * NTHR, r = idx >> 5, c4 = idx & 31; LAS float* p = tile + r * 129 + c4 * 4; p[0] = v[i][0] * W8_SCALE; p[1] = v[i][1] * W8_SCALE; p[2] = v[i][2] * W8_SCALE; p[3] = v[i][3] * W8_SCALE; }
    __syncthreads();
#pragma unroll
    for (int i = 0; i < 2; ++i) { const int idx = F.tid + i * NTHR, n = idx >> 3, kc = idx & 7; const LAS float* p = tile + (kc * 16) * 129 + n;
        u32x4 w; w.x = cvt_pk4_fp8(p[0], p[129], p[2 * 129], p[3 * 129]); w.y = cvt_pk4_fp8(p[4 * 129], p[5 * 129], p[6 * 129], p[7 * 129]);
        w.z = cvt_pk4_fp8(p[8 * 129], p[9 * 129], p[10 * 129], p[11 * 129]); w.w = cvt_pk4_fp8(p[12 * 129], p[13 * 129], p[14 * 129], p[15 * 129]);
        *(u32x4*)(dst + (size_t)n * dst_ld + kc * 16) = w; }
    __syncthreads();
}
__device__ __forceinline__ void p0_convert(const Frame& F) {
    constexpr int NJ = 128 + 160 + 32 + 32 + 64 + 4096 + 2048;
    for (int j = F.c; j < NJ; j += F.G) {
        const float* src; int sld; bf16_t* dst; int dld = 1024;
        if (j >= 416 || j < 288) {
            unsigned char* d8;
            if (j < 128) { const int kt = j >> 4, nt = j & 15; src = F.in[I_WIN] + (size_t)kt * 128 * 5120 + 512 + nt * 128; sld = 5120; d8 = (unsigned char*)(F.ws + WS_WIN1T) + (size_t)(1024 + nt * 128) * 1024 + kt * 128; }
            else if (j < 288) { const int q = j - 128, kt = q / 20, nt = q % 20; src = F.in[I_WIN] + (size_t)kt * 128 * 5120 + 2560 + nt * 128; sld = 5120; d8 = (unsigned char*)(F.ws + WS_WIN2T) + (size_t)(nt * 128) * 1024 + kt * 128; }
            else if (j < 4512) { const int q = j - 416, e = q >> 7, r = q & 127, kt = r >> 4, jt = r & 15; src = F.in[I_WGU] + (size_t)e * 1024 * 2048 + (size_t)kt * 128 * 2048 + jt * 128; sld = 2048;
                d8 = (unsigned char*)(F.ws + WS_WGUT) + (size_t)e * 2048 * 1024 + (size_t)((jt & 7) * 256 + (jt >> 3) * 128) * 1024 + kt * 128; }
            else { const int q = j - 4512, e = q >> 6, r = q & 63, kt = r >> 3, nt = r & 7; src = F.in[I_WDN] + (size_t)e * 1024 * 1024 + (size_t)kt * 128 * 1024 + nt * 128; sld = 1024;
                d8 = (unsigned char*)(F.ws + WS_WDNT) + (size_t)e * 1024 * 1024 + (size_t)(nt * 128) * 1024 + kt * 128; }
            cv_tile_f8(F, src, sld, d8, 1024);
            continue;
        }
        if (j < 320) { const int q = j - 288, kt = q >> 3, nt = q & 7; src = F.in[I_WFO] + (size_t)kt * 128 * 1024 + nt * 128; sld = 1024; dst = (bf16_t*)(F.ws + WS_WMT) + (size_t)(nt * 128) * 1024 + kt * 128; }
        else if (j < 352) { const int q = j - 320, kt = q >> 3, nt = q & 7; src = F.in[I_WHO] + (size_t)kt * 128 * 1024 + nt * 128; sld = 1024; dst = (bf16_t*)(F.ws + WS_WMT) + (size_t)(nt * 128) * 1024 + 512 + kt * 128; }
        else { const int q = j - 352, kt = q >> 3, nt = q & 7; src = F.in[I_WO] + (size_t)kt * 128 * 1024 + nt * 128; sld = 1024; dst = (bf16_t*)(F.ws + WS_WOT) + (size_t)(nt * 128) * 1024 + kt * 128; }
        cv_tile(F, src, sld, dst, dld);
    }
}

__device__ __forceinline__ void p1_uprep(const Frame& F) {
    const float* ada = (const float*)(F.ws + WS_ADA);
    unsigned char* U = (unsigned char*)(F.ws + WS_U); unsigned char* Uc = (unsigned char*)(F.ws + WS_UC);
    const size_t NIT = (size_t)(T + TCX) * 128, stride = (size_t)F.G * NTHR;
    for (size_t idx = (size_t)F.c * NTHR + F.tid; idx < NIT; idx += stride) {
        const int row = (int)(idx >> 7), col = (int)(idx & 127) * 8;
        const bool lat = row < T; const int b = lat ? (row >> 11) : 32;
        const float* src = lat ? F.in[I_X] + (size_t)row * 1024 + col : F.in[I_CTX] + (size_t)(row - T) * 1024 + col;
        unsigned char* dst = lat ? U + (size_t)row * 1024 + col : Uc + (size_t)(row - T) * 1024 + col;
        const f32x4 a0 = *(const f32x4*)src, a1 = *(const f32x4*)(src + 4);
        const float* ap = ada + (size_t)b * 6144 + col;
        const f32x4 sh0 = *(const f32x4*)ap, sh1 = *(const f32x4*)(ap + 4), sc0 = *(const f32x4*)(ap + 1024), sc1 = *(const f32x4*)(ap + 1028);
        const f32x4 r0 = a0 * (sc0 + 1.0f) + sh0, r1 = a1 * (sc1 + 1.0f) + sh1;
        *(u32x2*)dst = (u32x2){cvt_pk4_fp8(r0[0], r0[1], r0[2], r0[3]), cvt_pk4_fp8(r1[0], r1[1], r1[2], r1[3])};
    }
    int* rowtok = (int*)(F.ws + WS_ROWTOK);
    for (int i = F.c * NTHR + F.tid; i < NCH * ROWS_CH; i += F.G * NTHR) rowtok[i] = (i / ROWS_CH) * TCH;
}

__device__ __forceinline__ void p6_readout(const Frame& F) {
    const bf16_t* PH = (const bf16_t*)(F.ws + WS_PH); const bf16_t* PG = (const bf16_t*)(F.ws + WS_PG); bf16_t* Y = (bf16_t*)(F.ws + WS_Y);
    const int l8 = F.lane * 8;
    const f32x4 g0 = *(const f32x4*)(F.in[I_HGG] + l8), g1 = *(const f32x4*)(F.in[I_HGG] + l8 + 4);
    for (int t = F.c * 8 + F.wave; t < T; t += F.G * 8) {
        const u32x4 a = *(const u32x4*)(PH + (size_t)t * 2048 + 512 + l8), b = *(const u32x4*)(PH + (size_t)t * 2048 + 1024 + l8), p = *(const u32x4*)(PG + (size_t)t * 512 + l8);
        float o[8] = { bf_lo(a.x) + bf_lo(b.x), bf_hi(a.x) + bf_hi(b.x), bf_lo(a.y) + bf_lo(b.y), bf_hi(a.y) + bf_hi(b.y), bf_lo(a.z) + bf_lo(b.z), bf_hi(a.z) + bf_hi(b.z), bf_lo(a.w) + bf_lo(b.w), bf_hi(a.w) + bf_hi(b.w) };
        float ss = 0.f;
#pragma unroll
        for (int i = 0; i < 8; ++i) ss += o[i] * o[i];
        ss += __shfl_xor(ss, 1); ss += __shfl_xor(ss, 2); ss += __shfl_xor(ss, 4); ss += __shfl_xor(ss, 8);
        const float rs = __builtin_amdgcn_rsqf(ss * (1.0f / 128.0f) + RMS_EPS);
        const float sp[8] = { bf_lo(p.x), bf_hi(p.x), bf_lo(p.y), bf_hi(p.y), bf_lo(p.z), bf_hi(p.z), bf_lo(p.w), bf_hi(p.w) };
        u32x4 w; w.x = cvt_pk_bf16(o[0] * rs * g0[0] * sp[0], o[1] * rs * g0[1] * sp[1]); w.y = cvt_pk_bf16(o[2] * rs * g0[2] * sp[2], o[3] * rs * g0[3] * sp[3]);
        w.z = cvt_pk_bf16(o[4] * rs * g1[0] * sp[4], o[5] * rs * g1[1] * sp[5]); w.w = cvt_pk_bf16(o[6] * rs * g1[2] * sp[6], o[7] * rs * g1[3] * sp[7]);
        *(u32x4*)(Y + (size_t)t * 1024 + 512 + l8) = w;
    }
}

__device__ __forceinline__ void p9_ln1_router(const Frame& F, const bool dry) {
    LAS float* wrT = (LAS float*)F.lds;
    LAS float* lg = (LAS float*)(F.lds + 131072);
    LAS float* brs = (LAS float*)(F.lds + 131072 + 4096);
    LAS int* hist = (LAS int*)(F.lds + 131072 + 4096 + 128);
    for (int i = F.tid; i < 32768; i += NTHR) { const int k = i >> 5, e = i & 31; wrT[e * 1024 + k] = F.in[I_WR][i]; }
    if (F.tid < 32) brs[F.tid] = F.in[I_BR][F.tid];
    if (F.tid < NCH * 32) hist[F.tid] = 0;
    __syncthreads();
    float* V = F.out; unsigned char* U2 = (unsigned char*)(F.ws + WS_U); const float* ada = (const float*)(F.ws + WS_ADA);
    int* topi = (int*)(F.ws + WS_TOPI); float* topw = (float*)(F.ws + WS_TOPW);
    const int l4 = F.lane * 4;
    for (int g = F.c * 8 + F.wave; g < T / 4; g += F.G * 8) {
        const int t0 = g * 4, b = t0 >> 11;
        f32x4 xv[4][4];
#pragma unroll
        for (int tk = 0; tk < 4; ++tk)
#pragma unroll
            for (int j = 0; j < 4; ++j) xv[tk][j] = *(const f32x4*)(V + (size_t)(t0 + tk) * 1024 + 256 * j + l4);
        float mean[4], rstd[4];
#pragma unroll
        for (int tk = 0; tk < 4; ++tk) { float s = 0.f;
#pragma unroll
            for (int j = 0; j < 4; ++j) s += (xv[tk][j][0] + xv[tk][j][1]) + (xv[tk][j][2] + xv[tk][j][3]);
            s = wave_sum(s); mean[tk] = s * (1.0f / 1024.0f); float q = 0.f;
#pragma unroll
            for (int j = 0; j < 4; ++j) { const f32x4 d = xv[tk][j] - mean[tk]; q += (d[0] * d[0] + d[1] * d[1]) + (d[2] * d[2] + d[3] * d[3]); }
            q = wave_sum(q); rstd[tk] = __builtin_amdgcn_rsqf(q * (1.0f / 1024.0f) + LN_EPS); }
#pragma unroll
        for (int j = 0; j < 4; ++j) {
            const int k = 256 * j + l4;
            const f32x4 lg1 = *(const f32x4*)(F.in[I_LN1G] + k), lb1 = *(const f32x4*)(F.in[I_LN1B] + k);
            const f32x4 sh = *(const f32x4*)(ada + (size_t)b * 6144 + 3072 + k), sc = *(const f32x4*)(ada + (size_t)b * 6144 + 4096 + k);
#pragma unroll
            for (int tk = 0; tk < 4; ++tk) { const f32x4 x1 = (xv[tk][j] - mean[tk]) * rstd[tk] * lg1 + lb1;
                if (!dry) *(f32x4*)(V + (size_t)(t0 + tk) * 1024 + k) = x1;
                const f32x4 u2 = x1 * (sc + 1.0f) + sh; xv[tk][j] = u2;
                if (!dry) *(unsigned*)(U2 + (size_t)(t0 + tk) * 1024 + k) = cvt_pk4_fp8(u2[0], u2[1], u2[2], u2[3]); } }
#pragma unroll 1
        for (int eq = 0; eq < 4; ++eq) {
            float acc[4][8];
#pragma unroll
            for (int e = 0; e < 8; ++e) { acc[0][e] = 0.f; acc[1][e] = 0.f; acc[2][e] = 0.f; acc[3][e] = 0.f;
#pragma unroll
                for (int j = 0; j < 4; ++j) { const f32x4 w4 = *(const LAS f32x4*)(wrT + (eq * 8 + e) * 1024 + 256 * j + l4);
#pragma unroll
                    for (int tk = 0; tk < 4; ++tk) acc[tk][e] += (xv[tk][j][0] * w4[0] + xv[tk][j][1] * w4[1]) + (xv[tk][j][2] * w4[2] + xv[tk][j][3] * w4[3]); }
                if (e & 1) __builtin_amdgcn_sched_barrier(0); }
#pragma unroll
            for (int tk = 0; tk < 4; ++tk) {
                float v0, v1, v2, v3;
                { const bool up = (F.lane & 32) != 0;
                  v0 = (up ? acc[tk][4] : acc[tk][0]) + __shfl_xor(up ? acc[tk][0] : acc[tk][4], 32);
                  v1 = (up ? acc[tk][5] : acc[tk][1]) + __shfl_xor(up ? acc[tk][1] : acc[tk][5], 32);
                  v2 = (up ? acc[tk][6] : acc[tk][2]) + __shfl_xor(up ? acc[tk][2] : acc[tk][6], 32);
                  v3 = (up ? acc[tk][7] : acc[tk][3]) + __shfl_xor(up ? acc[tk][3] : acc[tk][7], 32); }
                { const bool up = (F.lane & 16) != 0;
                  const float a0 = (up ? v2 : v0) + __shfl_xor(up ? v0 : v2, 16), a1 = (up ? v3 : v1) + __shfl_xor(up ? v1 : v3, 16); v0 = a0; v1 = a1; }
                { const bool up = (F.lane & 8) != 0; v0 = (up ? v1 : v0) + __shfl_xor(up ? v0 : v1, 8); }
                v0 += __shfl_xor(v0, 4); v0 += __shfl_xor(v0, 2); v0 += __shfl_xor(v0, 1);
                const int e = eq * 8 + ((F.lane >> 5) & 1) * 4 + ((F.lane >> 4) & 1) * 2 + ((F.lane >> 3) & 1);
                if ((F.lane & 7) == 0) lg[(F.wave * 4 + tk) * 32 + e] = v0 + brs[e];
            }
        }
        asm volatile("s_waitcnt lgkmcnt(0)" ::: "memory");
        if (F.lane < 4) {
            const LAS float* L = lg + (F.wave * 4 + F.lane) * 32;
            float b0 = -3.0e38f, b1 = -3.0e38f, b2 = -3.0e38f, b3 = -3.0e38f; int i0 = 0, i1 = 0, i2 = 0, i3 = 0;
            for (int e = 0; e < 32; ++e) { const float x = L[e];
                if (x > b3) { b3 = x; i3 = e;
                    if (b3 > b2) { float tf = b2; b2 = b3; b3 = tf; int ti = i2; i2 = i3; i3 = ti;
                        if (b2 > b1) { tf = b1; b1 = b2; b2 = tf; ti = i1; i1 = i2; i2 = ti;
                            if (b1 > b0) { tf = b0; b0 = b1; b1 = tf; ti = i0; i0 = i1; i1 = ti; } } } } }
            const float p1 = fast_exp(b1 - b0), p2 = fast_exp(b2 - b0), p3 = fast_exp(b3 - b0), inv = 1.0f / (1.0f + p1 + p2 + p3);
            const int t = t0 + F.lane;
            *(int4*)(topi + (size_t)t * 4) = make_int4(i0, i1, i2, i3);
            *(f32x4*)(topw + (size_t)t * 4) = (f32x4){inv, p1 * inv, p2 * inv, p3 * inv};
            const int ch = t / TCH;
            if (!dry) { atomicAdd((int*)(hist + ch * 32 + i0), 1); atomicAdd((int*)(hist + ch * 32 + i1), 1); atomicAdd((int*)(hist + ch * 32 + i2), 1); atomicAdd((int*)(hist + ch * 32 + i3), 1); }
        }
    }
    __syncthreads();
    if (F.tid < NCH * 32) { const int h = hist[F.tid]; if (h && !dry) atomicAdd(F.ctl + CW_CNT + F.tid, (unsigned)h); }
    __syncthreads();
}

__device__ __forceinline__ void p10_dispatch(const Frame& F) {
    LAS int* lcnt = (LAS int*)F.lds; LAS int* lbase = lcnt + 32; LAS int* pstart = lcnt + 64;
    const int* topi = (const int*)(F.ws + WS_TOPI); int* pos = (int*)(F.ws + WS_POS); int* rowtok = (int*)(F.ws + WS_ROWTOK);
    for (int s = F.c; s < T / 256; s += F.G) {
        const int ch = (s * 256) / TCH;
        __syncthreads();
        if (F.tid < 32) { lcnt[F.tid] = 0; int ps = 0; for (int e = 0; e < F.tid; ++e) { const int n = (int)__hip_atomic_load(F.ctl + CW_CNT + ch * 32 + e, __ATOMIC_RELAXED, __HIP_MEMORY_SCOPE_AGENT); ps += (n + 255) & ~255; } pstart[F.tid] = ps; }
        __syncthreads();
        int e2[2], r2[2];
#pragma unroll
        for (int i = 0; i < 2; ++i) { const int a = F.tid + i * NTHR; e2[i] = topi[(size_t)(s * 256) * 4 + a]; r2[i] = atomicAdd((int*)(lcnt + e2[i]), 1); }
        __syncthreads();
        if (F.tid < 32) lbase[F.tid] = (int)atomicAdd(F.ctl + CW_CUR + ch * 32 + F.tid, (unsigned)lcnt[F.tid]);
        __syncthreads();
#pragma unroll
        for (int i = 0; i < 2; ++i) { const int a = F.tid + i * NTHR, slot = pstart[e2[i]] + lbase[e2[i]] + r2[i];
            pos[(size_t)(s * 256) * 4 + a] = slot; rowtok[(size_t)ch * ROWS_CH + slot] = s * 256 + (a >> 2); }
    }
}
__device__ __forceinline__ int moe_blocks(const Frame& F, int ch, LAS unsigned char* blk_e) {
    LAS int* sh = (LAS int*)(blk_e + 1024);
    __syncthreads();
    if (F.tid == 0) { int nb = 0; for (int e = 0; e < 32; ++e) { const int n = ((int)__hip_atomic_load(F.ctl + CW_CNT + ch * 32 + e, __ATOMIC_RELAXED, __HIP_MEMORY_SCOPE_AGENT) + 255) >> 8; for (int i = 0; i < n; ++i) blk_e[nb + i] = (unsigned char)e; nb += n; } sh[0] = nb; }
    __syncthreads();
    return sh[0];
}

__device__ __forceinline__ void p13_combine_ln2(const Frame& F, int ch, const bool dry) {
    const bf16_t* YC = (const bf16_t*)(F.ws + WS_YCH); const int* pos = (const int*)(F.ws + WS_POS); const float* topw = (const float*)(F.ws + WS_TOPW);
    const float* ada = (const float*)(F.ws + WS_ADA); float* X1 = F.out;
    const int l4 = F.lane * 4;
    for (int t = ch * TCH + F.c * 8 + F.wave; t < (ch + 1) * TCH; t += F.G * 8) {
        const int b = t >> 11;
        const int4 ps = *(const int4*)(pos + (size_t)t * 4); const f32x4 tw = *(const f32x4*)(topw + (size_t)t * 4);
        f32x4 v[4];
#pragma unroll
        for (int j = 0; j < 4; ++j) { const int k = 256 * j + l4;
            const u32x2 y0 = *(const u32x2*)(YC + (size_t)ps.x * 1024 + k), y1 = *(const u32x2*)(YC + (size_t)ps.y * 1024 + k), y2 = *(const u32x2*)(YC + (size_t)ps.z * 1024 + k), y3 = *(const u32x2*)(YC + (size_t)ps.w * 1024 + k);
            f32x4 ff;
            ff[0] = tw[0] * bf_lo(y0.x) + tw[1] * bf_lo(y1.x) + tw[2] * bf_lo(y2.x) + tw[3] * bf_lo(y3.x);
            ff[1] = tw[0] * bf_hi(y0.x) + tw[1] * bf_hi(y1.x) + tw[2] * bf_hi(y2.x) + tw[3] * bf_hi(y3.x);
            ff[2] = tw[0] * bf_lo(y0.y) + tw[1] * bf_lo(y1.y) + tw[2] * bf_lo(y2.y) + tw[3] * bf_lo(y3.y);
            ff[3] = tw[0] * bf_hi(y0.y) + tw[1] * bf_hi(y1.y) + tw[2] * bf_hi(y2.y) + tw[3] * bf_hi(y3.y);
            const f32x4 x1 = *(const f32x4*)(X1 + (size_t)t * 1024 + k), g2 = *(const f32x4*)(ada + (size_t)b * 6144 + 5120 + k);
            v[j] = x1 * DN_ALPHA + g2 * ff; }
        float s = 0.f;
#pragma unroll
        for (int j = 0; j < 4; ++j) s += (v[j][0] + v[j][1]) + (v[j][2] + v[j][3]);
        s = wave_sum(s); const float mean = s * (1.0f / 1024.0f); float q = 0.f;
#pragma unroll
        for (int j = 0; j < 4; ++j) { const f32x4 d = v[j] - mean; q += (d[0] * d[0] + d[1] * d[1]) + (d[2] * d[2] + d[3] * d[3]); }
        q = wave_sum(q); const float rstd = __builtin_amdgcn_rsqf(q * (1.0f / 1024.0f) + LN_EPS);
#pragma unroll
        for (int j = 0; j < 4; ++j) { const int k = 256 * j + l4; const f32x4 g = *(const f32x4*)(F.in[I_LN2G] + k), bb = *(const f32x4*)(F.in[I_LN2B] + k);
            const f32x4 o4 = (v[j] - mean) * rstd * g + bb;
            if (!dry) *(f32x4*)(X1 + (size_t)t * 1024 + k) = o4; else if (o4[0] == 1.2345e30f) X1[0] = 1.f; }
    }
}

constexpr int SC_QD = 0, SC_KI = 17408, SC_KE = 34816, SC_VT = 53248, SC_SC = 71680, SC_ST = 80896, SC_GV = 115712, SC_CS = 116224;
__device__ __forceinline__ bf16x8 ldfrag(const LAS unsigned char* p) { return *(const LAS bf16x8*)p; }
__device__ __forceinline__ void p3_scan(const Frame& F, const bool dry) {
    LAS unsigned char* L = F.lds;
    const int tid = F.tid, w = F.wave, lane = F.lane, fr = lane & 15, fq = lane >> 4;
    const int d = tid & 127, qd = tid >> 7;
    bf16_t* PH = (bf16_t*)(F.ws + WS_PH); const bf16_t* PHC = (const bf16_t*)(F.ws + WS_PHC);
    for (int it = F.c; it < 256; it += F.G) {
        const int b = it >> 3, h = (it >> 1) & 3, dir = it & 1;
        const float r0 = F.in[I_LBRAW][dir * 512 + h * 128 + d], r1 = F.in[I_LBRAW][1024 + dir * 512 + h * 128 + d];
        const float lbv = fast_sigmoid(r0 - r1), oml = 1.0f - lbv;
        f32x4 Sacc[8];
#pragma unroll
        for (int i = 0; i < 8; ++i) Sacc[i] = (f32x4){0.f, 0.f, 0.f, 0.f};
        __syncthreads();
        for (int i = tid; i < 34816 / 4; i += NTHR) ((LAS unsigned*)(L + SC_ST))[i] = 0u;
        const int cq = h * 128 + d, cz = 512 + dir * 512 + h * 128 + d, cv = 1536 + h * 128 + d;
        bf16_t rq[16], rz[16], rv[16];
        {   const int n = dir ? 3 : 0; const bf16_t* base = PHC + (size_t)(b * 256 + 64 * n + 16 * qd) * 2048;
#pragma unroll
            for (int i = 0; i < 16; ++i) { rq[i] = base[(size_t)i * 2048 + cq]; rz[i] = base[(size_t)i * 2048 + cz]; rv[i] = base[(size_t)i * 2048 + cv]; } }
        for (int s = 0; s < 36; ++s) {
            const bool lat = s >= 4; const int n = lat ? (dir ? 31 - (s - 4) : (s - 4)) : (dir ? 3 - s : s);
            float kk[16], cum[16]; float run = 0.f;
#pragma unroll
            for (int i = 0; i < 16; ++i) { const float sg = fast_sigmoid(bf2f(rz[i])); kk[i] = oml * (1.0f - sg); cum[i] = fast_log(lbv + oml * sg); }
            if (dir == 0) {
#pragma unroll
                for (int i = 0; i < 16; ++i) { run += cum[i]; cum[i] = run; }
            } else {
#pragma unroll
                for (int i = 15; i >= 0; --i) { run += cum[i]; cum[i] = run; }
            }
            ((LAS float*)(L + SC_CS))[qd * 128 + d] = run;
            __syncthreads();
            {   const LAS float* cs = (const LAS float*)(L + SC_CS);
                const float c0 = cs[d], c1 = cs[128 + d], c2 = cs[256 + d], c3 = cs[384 + d], tot = (c0 + c1) + (c2 + c3);
                float off;
                if (dir == 0) off = (qd > 0 ? c0 : 0.f) + (qd > 1 ? c1 : 0.f) + (qd > 2 ? c2 : 0.f);
                else off = (qd < 3 ? c3 : 0.f) + (qd < 2 ? c2 : 0.f) + (qd < 1 ? c1 : 0.f);
                const float g = fast_exp(tot);
                if (qd == 0) ((LAS float*)(L + SC_GV))[d] = g;
                unsigned ke[8], vt[8];
#pragma unroll
                for (int i = 0; i < 16; i += 2) {
                    const float ca = cum[i] + off, cb = cum[i + 1] + off;
                    const float ea = fast_exp(ca), eb = fast_exp(cb), ia = __builtin_amdgcn_rcpf(ea), ib = __builtin_amdgcn_rcpf(eb);
                    const float qa = bf2f(rq[i]), qb = bf2f(rq[i + 1]);
                    const float qda = qa * fast_sigmoid(qa) * ea, qdb = qb * fast_sigmoid(qb) * eb;
                    const float kia = kk[i] * ia, kib = kk[i + 1] * ib;
                    const unsigned wa = cvt_pk_bf16(qda, kia), wb = cvt_pk_bf16(qdb, kib);
                    *(LAS bf16_t*)(L + SC_QD + (16 * qd + i) * 272 + d * 2) = (bf16_t)(wa & 0xffffu);
                    *(LAS bf16_t*)(L + SC_KI + (16 * qd + i) * 272 + d * 2) = (bf16_t)(wa >> 16);
                    *(LAS bf16_t*)(L + SC_QD + (16 * qd + i + 1) * 272 + d * 2) = (bf16_t)(wb & 0xffffu);
                    *(LAS bf16_t*)(L + SC_KI + (16 * qd + i + 1) * 272 + d * 2) = (bf16_t)(wb >> 16);
                    ke[i >> 1] = cvt_pk_bf16(kia * g, kib * g);
                    vt[i >> 1] = (unsigned)rv[i] | ((unsigned)rv[i + 1] << 16);
                }
                *(LAS u32x4*)(L + SC_KE + d * 144 + 32 * qd) = (u32x4){ke[0], ke[1], ke[2], ke[3]};
                *(LAS u32x4*)(L + SC_KE + d * 144 + 32 * qd + 16) = (u32x4){ke[4], ke[5], ke[6], ke[7]};
                *(LAS u32x4*)(L + SC_VT + d * 144 + 32 * qd) = (u32x4){vt[0], vt[1], vt[2], vt[3]};
                *(LAS u32x4*)(L + SC_VT + d * 144 + 32 * qd + 16) = (u32x4){vt[4], vt[5], vt[6], vt[7]};
            }
            if (s + 1 < 36) {
                const int s1 = s + 1; const bool lat1 = s1 >= 4; const int n1 = lat1 ? (dir ? 31 - (s1 - 4) : (s1 - 4)) : (dir ? 3 - s1 : s1);
                const bf16_t* base = lat1 ? (const bf16_t*)PH + (size_t)(b * 2048 + 64 * n1 + 16 * qd) * 2048 : PHC + (size_t)(b * 256 + 64 * n1 + 16 * qd) * 2048;
#pragma unroll
                for (int i = 0; i < 16; ++i) { rq[i] = base[(size_t)i * 2048 + cq]; rz[i] = base[(size_t)i * 2048 + cz]; rv[i] = base[(size_t)i * 2048 + cv]; }
            }
            __syncthreads();
            f32x4 oacc[4];
#pragma unroll
            for (int i = 0; i < 4; ++i) oacc[i] = (f32x4){0.f, 0.f, 0.f, 0.f};
            const int kb = fq * 16;
            if (lat) {
                const int ct = w >> 1, st0 = 2 * (w & 1);
#pragma unroll
                for (int j = 0; j < 2; ++j) { const int st = st0 + j; f32x4 sa = (f32x4){0.f, 0.f, 0.f, 0.f};
#pragma unroll
                    for (int ks = 0; ks < 4; ++ks) sa = __builtin_amdgcn_mfma_f32_16x16x32_bf16(ldfrag(L + SC_KI + (16 * st + fr) * 272 + ks * 64 + kb), ldfrag(L + SC_QD + (16 * ct + fr) * 272 + ks * 64 + kb), sa, 0, 0, 0);
                    const int cc = 16 * ct + fr, s0 = 16 * st + 4 * fq;
#pragma unroll
                    for (int i = 0; i < 4; ++i) { const bool keep = dir ? (s0 + i >= cc) : (s0 + i <= cc); sa[i] = keep ? sa[i] : 0.f; }
                    *(LAS u32x2*)(L + SC_SC + cc * 144 + s0 * 2) = (u32x2){cvt_pk_bf16(sa[0], sa[1]), cvt_pk_bf16(sa[2], sa[3])}; }
#pragma unroll
                for (int ct2 = 0; ct2 < 4; ++ct2)
#pragma unroll
                    for (int ks = 0; ks < 4; ++ks) oacc[ct2] = __builtin_amdgcn_mfma_f32_16x16x32_bf16(ldfrag(L + SC_ST + (16 * w + fr) * 272 + ks * 64 + kb), ldfrag(L + SC_QD + (16 * ct2 + fr) * 272 + ks * 64 + kb), oacc[ct2], 0, 0, 0);
            }
            {   const bf16x8 v0 = ldfrag(L + SC_VT + (16 * w + fr) * 144 + kb), v1 = ldfrag(L + SC_VT + (16 * w + fr) * 144 + 64 + kb);
#pragma unroll
                for (int dt = 0; dt < 8; ++dt) { const f32x4 gv = *(const LAS f32x4*)(L + SC_GV + (16 * dt + 4 * fq) * 4);
                    f32x4 a = Sacc[dt] * gv;
                    a = __builtin_amdgcn_mfma_f32_16x16x32_bf16(ldfrag(L + SC_KE + (16 * dt + fr) * 144 + kb), v0, a, 0, 0, 0);
                    a = __builtin_amdgcn_mfma_f32_16x16x32_bf16(ldfrag(L + SC_KE + (16 * dt + fr) * 144 + 64 + kb), v1, a, 0, 0, 0);
                    Sacc[dt] = a; } }
            __syncthreads();
#pragma unroll
            for (int dt = 0; dt < 8; ++dt) *(LAS u32x2*)(L + SC_ST + (16 * w + fr) * 272 + (16 * dt + 4 * fq) * 2) = (u32x2){cvt_pk_bf16(Sacc[dt][0], Sacc[dt][1]), cvt_pk_bf16(Sacc[dt][2], Sacc[dt][3])};
            if (lat) {
                const bf16x8 v0 = ldfrag(L + SC_VT + (16 * w + fr) * 144 + kb), v1 = ldfrag(L + SC_VT + (16 * w + fr) * 144 + 64 + kb);
                bf16_t* ob = PH + (size_t)(b * 2048 + 64 * n) * 2048 + 512 + dir * 512 + h * 128 + 16 * w + 4 * fq;
#pragma unroll
                for (int ct2 = 0; ct2 < 4; ++ct2) {
                    f32x4 a = oacc[ct2];
                    a = __builtin_amdgcn_mfma_f32_16x16x32_bf16(v0, ldfrag(L + SC_SC + (16 * ct2 + fr) * 144 + kb), a, 0, 0, 0);
                    a = __builtin_amdgcn_mfma_f32_16x16x32_bf16(v1, ldfrag(L + SC_SC + (16 * ct2 + fr) * 144 + 64 + kb), a, 0, 0, 0);
                    if (!dry) *(u32x2*)(ob + (size_t)(16 * ct2 + fr) * 2048) = (u32x2){cvt_pk_bf16(a[0], a[1]), cvt_pk_bf16(a[2], a[3])};
                    else if (a[0] == 1.2345e30f) ob[0] = 1; }
            }
        }
        __syncthreads();
    }
}

typedef short s16x4 __attribute__((ext_vector_type(4)));
__device__ __forceinline__ s16x4 tr_read(unsigned lds_addr) { s16x4 r; asm volatile("ds_read_b64_tr_b16 %0, %1\n\ts_waitcnt lgkmcnt(0)" : "=&v"(r) : "v"(lds_addr) : "memory"); return r; }
__device__ __forceinline__ bf16x8 cat4(s16x4 a, s16x4 b) { return (bf16x8){a[0], a[1], a[2], a[3], b[0], b[1], b[2], b[3]}; }
constexpr int FO_C = 131072, FO_S = 139264;
__device__ __forceinline__ void p4_fourier(const Frame& F) {
    LAS unsigned char* L = F.lds;
    const int tid = F.tid, w = F.wave, lane = F.lane, fr = lane & 15, fq = lane >> 4;
    const bf16_t* PA = (const bf16_t*)(F.ws + WS_PA); bf16_t* Y = (bf16_t*)(F.ws + WS_Y);
    __syncthreads();
    for (int i = tid; i < 4096; i += NTHR) { const int k2 = i >> 6, c = i & 63; const float a = (float)((k2 * c) & 63) * (1.0f / 64.0f);
        *(LAS bf16_t*)(L + FO_C + i * 2) = (bf16_t)(cvt_pk_bf16(__builtin_amdgcn_cosf(a) * 0.125f, 0.f) & 0xffffu);
        *(LAS bf16_t*)(L + FO_S + i * 2) = (bf16_t)(cvt_pk_bf16(__builtin_amdgcn_sinf(a) * 0.125f, 0.f) & 0xffffu); }
    bf16x8 Gf[2][2];
#pragma unroll
    for (int nt = 0; nt < 2; ++nt)
#pragma unroll
        for (int ks = 0; ks < 2; ++ks) { unsigned pk[4];
#pragma unroll
            for (int j = 0; j < 8; j += 2) { const int k1 = 16 * nt + fr, ra = 8 * fq + j, rb = ra + 1; const float aa = (float)((k1 * ra) & 31) * (1.0f / 32.0f), ab = (float)((k1 * rb) & 31) * (1.0f / 32.0f);
                const float va = (ks ? __builtin_amdgcn_sinf(aa) : __builtin_amdgcn_cosf(aa)) * 0.17677669529663687f, vb = (ks ? __builtin_amdgcn_sinf(ab) : __builtin_amdgcn_cosf(ab)) * 0.17677669529663687f;
                pk[j >> 1] = cvt_pk_bf16(va, vb); }
            u32x4 t4 = (u32x4){pk[0], pk[1], pk[2], pk[3]}; Gf[nt][ks] = *(bf16x8*)&t4; }
    const unsigned lbase = (unsigned)(size_t)L;
    for (int it = F.c; it < 1024; it += F.G) {
        const int xcd = it & 7, jj = it >> 3, slab = 4 * xcd + (jj & 3), b = jj >> 2;
        __syncthreads();
        {   u32x4 v[16];
#pragma unroll
            for (int n = 0; n < 16; ++n) { const int q = tid + NTHR * n, t = q >> 2, reim = (q >> 1) & 1, half = q & 1;
                v[n] = *(const u32x4*)(PA + (size_t)(b * 2048 + t) * 1024 + reim * 512 + slab * 16 + half * 8); }
#pragma unroll
            for (int n = 0; n < 16; ++n) *(LAS u32x4*)(L + (tid + NTHR * n) * 16) = v[n]; }
        __syncthreads();
#pragma unroll 1
        for (int rr = 0; rr < 4; ++rr) {
            const int r = w + 8 * rr;
            f32x4 acc[8];
#pragma unroll
            for (int i = 0; i < 8; ++i) acc[i] = (f32x4){0.f, 0.f, 0.f, 0.f};
#pragma unroll
            for (int ks = 0; ks < 4; ++ks) {
                const int ri = ks >> 1, c0 = 32 * (ks & 1) + 8 * fq + (fr >> 2);
                const unsigned a0 = lbase + (unsigned)((r * 64 + c0) * 64 + ri * 32 + (fr & 3) * 8);
                const bf16x8 af = cat4(tr_read(a0), tr_read(a0 + 4 * 64));
#pragma unroll
                for (int nt = 0; nt < 8; ++nt) { const int ro = nt >> 2, k2 = 16 * (nt & 3) + fr;
                    u32x4 bw = *(const LAS u32x4*)(L + ((ro == ri) ? FO_C : FO_S) + (k2 * 64 + 32 * (ks & 1) + 8 * fq) * 2);
                    if (ro == 1 && ri == 0) { bw.x ^= 0x80008000u; bw.y ^= 0x80008000u; bw.z ^= 0x80008000u; bw.w ^= 0x80008000u; }
                    acc[nt] = __builtin_amdgcn_mfma_f32_16x16x32_bf16(af, *(bf16x8*)&bw, acc[nt], 0, 0, 0); }
            }
#pragma unroll
            for (int nt = 0; nt < 8; ++nt) { const int ro = nt >> 2, k2 = 16 * (nt & 3) + fr;
                *(LAS u32x2*)(L + (r * 64 + k2) * 64 + ro * 32 + fq * 8) = (u32x2){cvt_pk_bf16(acc[nt][0], acc[nt][1]), cvt_pk_bf16(acc[nt][2], acc[nt][3])}; }
        }
        __syncthreads();
#pragma unroll 1
        for (int kk = 0; kk < 8; ++kk) {
            const int k2 = 8 * w + kk;
            f32x4 a2[2] = {(f32x4){0.f, 0.f, 0.f, 0.f}, (f32x4){0.f, 0.f, 0.f, 0.f}};
#pragma unroll
            for (int ks = 0; ks < 2; ++ks) {
                const int r0 = 8 * fq + (fr >> 2);
                const unsigned a0 = lbase + (unsigned)((r0 * 64 + k2) * 64 + ks * 32 + (fr & 3) * 8);
                const bf16x8 af = cat4(tr_read(a0), tr_read(a0 + 4 * 64 * 64));
                a2[0] = __builtin_amdgcn_mfma_f32_16x16x32_bf16(af, Gf[0][ks], a2[0], 0, 0, 0);
                a2[1] = __builtin_amdgcn_mfma_f32_16x16x32_bf16(af, Gf[1][ks], a2[1], 0, 0, 0);
            }
#pragma unroll
            for (int nt = 0; nt < 2; ++nt) { const int k1 = 16 * nt + fr;
                *(u32x2*)(Y + (size_t)(b * 2048 + k1 * 64 + k2) * 1024 + slab * 16 + 4 * fq) = (u32x2){cvt_pk_bf16(a2[nt][0], a2[nt][1]), cvt_pk_bf16(a2[nt][2], a2[nt][3])}; }
        }
    }
    __syncthreads();
}

struct Args { const float* in[22]; float* out; unsigned char* ws; int ph_lo, ph_hi; };
constexpr int N_PHASES = 9 + 3 * NCH;

__global__ void __launch_bounds__(NTHR, 2) mega_fwd(Args args) {
    extern __shared__ __attribute__((aligned(16))) unsigned char lds_raw[];
    Frame F;
    F.lds = (LAS unsigned char*)lds_raw;
    F.tid = threadIdx.x; F.lane = F.tid & 63; F.wave = __builtin_amdgcn_readfirstlane(F.tid >> 6);
    F.G = gridDim.x; F.c = blockIdx.x;
    F.in = args.in;
    F.out = args.out; F.ws = args.ws; F.ctl = (unsigned*)(args.ws + WS_CTL);
    volatile LAS unsigned* misc = (volatile LAS unsigned*)(F.lds + LDS_MISC);
    if (F.tid < 4) misc[F.tid] = 0u;
    __syncthreads();
    XcdBarrier bar = xcd_barrier_post(F.ctl, misc);
    const int lo = args.ph_lo, hi = args.ph_hi;
#ifndef PHASE_MASK
#define PHASE_MASK 0xFFFFFFFFu
#endif
#define IN(k) ((((PHASE_MASK) >> (k)) & 1u) && lo <= (k) && (k) < hi)
#define SEAM(k) do { if (IN(k) && IN((k) + 1)) xcd_barrier(bar); } while (0)
#ifndef REP_MASK
#define REP_MASK 0u
#endif
#define REPS(b) ((((REP_MASK) >> (b)) & 1u) ? 2 : 1)
#define REPBAR(b, r) do { if ((((REP_MASK) >> (b)) & 1u) && (r) == 0) xcd_barrier(bar); } while (0)
    unsigned char* ws = F.ws;
    LAS unsigned char* blk_e = F.lds + LDS_MISC + 64;

    if (IN(0)) { for (int r = 0; r < REPS(0); ++r) { p0_ada(F); p0_fold(F); p0_convert(F); REPBAR(0, r); } }
    SEAM(0);
    if (IN(1)) { for (int r = 0; r < REPS(1); ++r) { p1_uprep(F); REPBAR(1, r); } }
    SEAM(1);
    if (IN(2)) {
        ProbP1 P{(const char*)(ws + WS_U), 8, 1024u, 1024u, (const char*)(ws + WS_WIN1T), (unsigned)(WS_UC - WS_U), F.G, F.c};
        EpiP1 E{(bf16_t*)(ws + WS_PA), (bf16_t*)(ws + WS_PH), (bf16_t*)(ws + WS_PHC)};
        for (int r = 0; r < REPS(2); ++r) { pg8::gemm_phase<ProbP1, EpiP1, true, false, true>(F.lds, P, E); REPBAR(2, r); }
    }
    SEAM(2);
    if (IN(3)) {
#ifndef NO_SCAN
        for (int r = 0; r < REPS(3); ++r) { p3_scan(F, r + 1 < REPS(3)); REPBAR(3, r); }
#endif
#ifndef NO_FOURIER
        for (int r = 0; r < REPS(4); ++r) { p4_fourier(F); REPBAR(4, r); }
#endif
#ifndef NO_P2GEMM
        ProbDense P{(const char*)(ws + WS_U), 8, 1024u, 1024u, (const char*)(ws + WS_WIN2T), 256, 10, F.G, F.c};
        EpiP2 E{(bf16_t*)(ws + WS_PG), (bf16_t*)F.out};
        for (int r = 0; r < REPS(5); ++r) { pg8::gemm_phase<ProbDense, EpiP2, true, false, true>(F.lds, P, E); REPBAR(5, r); }
#endif
    }
    SEAM(3);
    if (IN(4)) { for (int r = 0; r < REPS(6); ++r) { p6_readout(F); REPBAR(6, r); } }
    SEAM(4);
    if (IN(5)) {
        ProbDense P{(const char*)(ws + WS_Y), 16, 2048u, 2048u, (const char*)(ws + WS_WMT), 256, 4, F.G, F.c};
        EpiM1 E{(const bf16_t*)F.out, (bf16_t*)(ws + WS_PA)};
        for (int r = 0; r < REPS(7); ++r) { pg8::gemm_phase<ProbDense, EpiM1, true, true>(F.lds, P, E); REPBAR(7, r); }
    }
    SEAM(5);
    if (IN(6)) {
        ProbDense P{(const char*)(ws + WS_PA), 16, 2048u, 2048u, (const char*)(ws + WS_WOT), 256, 4, F.G, F.c};
        EpiM2 E{F.in[I_X], (const float*)(ws + WS_ADA), F.out};
        for (int r = 0; r < REPS(8); ++r) { pg8::gemm_phase<ProbDense, EpiM2, true, false>(F.lds, P, E); REPBAR(8, r); }
    }
    SEAM(6);
    if (IN(7)) { for (int r = 0; r < REPS(9); ++r) { p9_ln1_router(F, r + 1 < REPS(9)); REPBAR(9, r); } }
    SEAM(7);
    if (IN(8)) { p10_dispatch(F); }
    SEAM(8);
#pragma unroll
    for (int ch = 0; ch < NCH; ++ch) {
        if (IN(9 + 3 * ch)) {
            const int nblk = moe_blocks(F, ch, blk_e);
            ProbMoE<true> P{(const char*)(ws + WS_U), 8, 1024u, 1024u, (const char*)(ws + WS_WGUT), (size_t)2048 * 1024, 8, nblk, F.G, F.c, (const int*)(ws + WS_ROWTOK) + (size_t)ch * ROWS_CH, blk_e};
            EpiGU E{F.in[I_BGU], (unsigned char*)(ws + WS_ACT)};
            for (int r = 0; r < (ch == 0 ? REPS(10) : 1); ++r) { pg8::gemm_phase<ProbMoE<true>, EpiGU, true, false, true>(F.lds, P, E); if (ch == 0) REPBAR(10, r); }
        }
        SEAM(9 + 3 * ch);
        if (IN(10 + 3 * ch)) {
            const int nblk = moe_blocks(F, ch, blk_e);
            ProbMoE<false> P{(const char*)(ws + WS_ACT), 8, 1024u, 1024u, (const char*)(ws + WS_WDNT), (size_t)1024 * 1024, 4, nblk, F.G, F.c, nullptr, blk_e};
            EpiDN E{F.in[I_BDN], (bf16_t*)(ws + WS_YCH)};
            for (int r = 0; r < (ch == 0 ? REPS(11) : 1); ++r) { pg8::gemm_phase<ProbMoE<false>, EpiDN, true, false, true>(F.lds, P, E); if (ch == 0) REPBAR(11, r); }
        }
        SEAM(10 + 3 * ch);
        if (IN(11 + 3 * ch)) { for (int r = 0; r < (ch == 0 ? REPS(12) : 1); ++r) { p13_combine_ln2(F, ch, ch == 0 && r + 1 < REPS(12)); if (ch == 0) REPBAR(12, r); } }
        SEAM(11 + 3 * ch);
    }
#ifdef DBG_K
    xcd_barrier(bar);
    {
        const unsigned char* buf = (DBG_OUT) ? (const unsigned char*)F.out : (const unsigned char*)(ws + (size_t)(DBG_OFF));
        const size_t wpr = (size_t)(DBG_CW) / 4, nw = (size_t)(DBG_ROWS) * wpr;
        unsigned long long cs = 0; unsigned bad = 0;
        for (size_t i = (size_t)F.c * NTHR + F.tid; i < nw; i += (size_t)F.G * NTHR) { const size_t r = i / wpr, cw = i % wpr; const unsigned w = *(const unsigned*)(buf + r * (size_t)(DBG_LD) + (DBG_C0) + cw * 4); cs += w;
            if (DBG_F32) { if ((w & 0x7f800000u) == 0x7f800000u) ++bad; } else { if ((w & 0x7f80u) == 0x7f80u) ++bad; if ((w & 0x7f800000u) == 0x7f800000u) ++bad; } }
        for (int o = 32; o >= 1; o >>= 1) { cs += __shfl_xor(cs, o); bad += __shfl_xor(bad, o); }
        if (F.lane == 0) { atomicAdd((unsigned long long*)(F.ctl + 8192), cs); atomicAdd(F.ctl + 8200, bad); }
        if (F.c == 0 && F.tid == 0) atomicAdd(F.ctl + 8201, xb_ld(&F.ctl[XB_TMO]));
    }
    xcd_barrier(bar);
    {
        const unsigned long long cs = __hip_atomic_load((unsigned long long*)(F.ctl + 8192), __ATOMIC_RELAXED, __HIP_MEMORY_SCOPE_AGENT);
        const unsigned bad = xb_ld(F.ctl + 8200), tmo = xb_ld(F.ctl + 8201);
        const float val = (float)(unsigned)((cs ^ (cs >> 16) ^ (cs >> 32)) & 0xFFFFu) * (1.0f / 65536.0f) + (bad ? 2.0f : 0.0f) + (tmo ? 4.0f : 0.0f);
        for (size_t i = (size_t)F.c * NTHR + F.tid; i < (size_t)T * D; i += (size_t)F.G * NTHR) F.out[i] = val;
    }
    return;
#endif
    if (F.c == 0 && F.tid == 0 && hi == N_PHASES) { if (xb_ld(&F.ctl[XB_TMO]) != 0u) F.out[0] = __builtin_nanf(""); }
#undef IN
#undef SEAM
}

extern "C" void kernel_launch(void* const* d_in, const int* in_sizes, int n_in, void* d_out, int out_size, void* d_ws, size_t ws_size, hipStream_t stream) {
    static int grid = 0;
    if (grid == 0) {
        if (n_in != 22 || out_size != T * D || ws_size < WS_END) { fprintf(stderr, "kernel_launch: unexpected shapes (n_in %d, out %d, ws %zu)\n", n_in, out_size, ws_size); grid = -1; return; }
        int dev = 0, cus = 0, per_cu = 0;
        if (hipGetDevice(&dev) != hipSuccess || hipDeviceGetAttribute(&cus, hipDeviceAttributeMultiprocessorCount, dev) != hipSuccess) { grid = -1; return; }
        if (hipFuncSetAttribute((const void*)mega_fwd, hipFuncAttributeMaxDynamicSharedMemorySize, LDS_BYTES) != hipSuccess) { fprintf(stderr, "kernel_launch: hipFuncSetAttribute failed\n"); grid = -1; return; }
        if (hipOccupancyMaxActiveBlocksPerMultiprocessor(&per_cu, (const void*)mega_fwd, NTHR, LDS_BYTES) != hipSuccess || per_cu < 1) fprintf(stderr, "kernel_launch: occupancy query reports %d blocks per CU\n", per_cu);
        (void)hipGetLastError();
        grid = cus;
    }
    if (grid < 0) return;
    (void)hipMemsetAsync((char*)d_ws + WS_CTL, 0, CTL_BYTES, stream);
    Args a{};
    for (int i = 0; i < 22; ++i) a.in[i] = (const float*)d_in[i];
    a.out = (float*)d_out; a.ws = (unsigned char*)d_ws; a.ph_lo = 0; a.ph_hi = N_PHASES;
#ifdef DBG_K
    a.ph_hi = DBG_K;
#endif
    hipLaunchKernelGGL(mega_fwd, dim3(grid), dim3(NTHR), LDS_BYTES, stream, a);
}
```

```cpp
#include <hip/hip_runtime.h>
#include <cstdio>
#include <cstdint>

#define LAS __attribute__((address_space(3)))
typedef unsigned short bf16_t;
typedef short bf16x8 __attribute__((ext_vector_type(8)));
typedef short bf16x4 __attribute__((ext_vector_type(4)));
typedef float f32x4 __attribute__((ext_vector_type(4)));
typedef float f32x2 __attribute__((ext_vector_type(2)));
typedef unsigned u32x4 __attribute__((ext_vector_type(4)));
typedef unsigned u32x2 __attribute__((ext_vector_type(2)));

constexpr int D = 1024, NB = 32, SEQ = 2048, T = NB * SEQ, CTX = 256, TCX = NB * CTX;
constexpr int NEXP = 32, TOPK = 4;
constexpr int NCH = 1, TCH = T / NCH;
constexpr int ROWS_CH = TCH * TOPK + NEXP * 256;
constexpr float DN_ALPHA = 1.189207115002721f;
constexpr float LN_EPS = 1e-5f, RMS_EPS = 1e-6f;
constexpr int NTHR = 512;

constexpr size_t MiB = 1ull << 20;
constexpr size_t WS_CTL = 0;
constexpr size_t CTL_BYTES = 65536;
constexpr size_t WS_ADA = 65536;
constexpr size_t WS_WIN1T = 1 * MiB;
constexpr size_t WS_WIN2T = 7 * MiB;
constexpr size_t WS_WMT = 12 * MiB;
constexpr size_t WS_WOT = 14 * MiB;
constexpr size_t WS_WGUT = 16 * MiB;
constexpr size_t WS_WDNT = 80 * MiB;
constexpr size_t WS_TOPI = 112 * MiB;
constexpr size_t WS_TOPW = 113 * MiB;
constexpr size_t WS_POS = 114 * MiB;
constexpr size_t WS_ROWTOK = 115 * MiB;
constexpr size_t WS_U = 120 * MiB;
constexpr size_t WS_PA = 184 * MiB;
constexpr size_t WS_PH = 312 * MiB;
constexpr size_t WS_PHC = 568 * MiB;
constexpr size_t WS_PG = 600 * MiB;
constexpr size_t WS_Y = 664 * MiB;
constexpr size_t WS_UC = WS_Y;
constexpr size_t WS_ACT = WS_PA;
constexpr size_t WS_YCH = WS_PA + 264 * MiB;
constexpr size_t WS_X1 = WS_YCH + 264 * MiB;
constexpr size_t WS_END = 976 * MiB;
static_assert(WS_X1 + 128 * MiB <= WS_END && (size_t)ROWS_CH * 1024 <= 264 * MiB && WS_Y + 128 * MiB <= WS_END, "ws map");
constexpr int CW_CNT = 4096;
constexpr int CW_CUR = 4096 + 64;

constexpr int LDS_SCRATCH = 147456;
constexpr int LDS_MISC = LDS_SCRATCH;
constexpr int LDS_BYTES = LDS_SCRATCH + 2048;

typedef __bf16 bf16x2_t __attribute__((ext_vector_type(2)));
__device__ __forceinline__ unsigned cvt_pk_bf16(float lo, float hi) { const f32x2 v = {lo, hi}; const bf16x2_t r = __builtin_convertvector(v, bf16x2_t); return __builtin_bit_cast(unsigned, r); }
__device__ __forceinline__ unsigned cvt_pk4_fp8(float a, float b, float c, float d) {
    a = fminf(fmaxf(a, -448.f), 448.f); b = fminf(fmaxf(b, -448.f), 448.f); c = fminf(fmaxf(c, -448.f), 448.f); d = fminf(fmaxf(d, -448.f), 448.f);
    int w = __builtin_amdgcn_cvt_pk_fp8_f32(a, b, 0, false); w = __builtin_amdgcn_cvt_pk_fp8_f32(c, d, w, true); return (unsigned)w; }
constexpr float W8_SCALE = 32.0f, W8_INV = 1.0f / 32.0f;
typedef float f32x2v __attribute__((ext_vector_type(2)));
__device__ __forceinline__ f32x4 fp8x4_to_f32(unsigned w) { const f32x2v a = __builtin_amdgcn_cvt_pk_f32_fp8((int)w, false), b = __builtin_amdgcn_cvt_pk_f32_fp8((int)w, true); return (f32x4){a[0], a[1], b[0], b[1]}; }
__device__ __forceinline__ float bf_lo(unsigned w) { return __uint_as_float(w << 16); }
__device__ __forceinline__ float bf_hi(unsigned w) { return __uint_as_float(w & 0xffff0000u); }
__device__ __forceinline__ float bf2f(bf16_t v) { return __uint_as_float(((unsigned)v) << 16); }
__device__ __forceinline__ float fast_exp(float x) { return __builtin_amdgcn_exp2f(x * 1.4426950408889634f); }
__device__ __forceinline__ float fast_sigmoid(float x) { return __builtin_amdgcn_rcpf(1.0f + fast_exp(-x)); }
__device__ __forceinline__ float fast_log(float x) { return __builtin_amdgcn_logf(x) * 0.6931471805599453f; }

#define XB_TMO      128
#define XB_XCNT(j)  (256  + 64 * (j))
#define XB_XSUB(j)  (1280 + 64 * (j))
#define XB_XGEN(j)  (2304 + 64 * (j))
#define XB_TOP      3328
#define XB_TOPGEN   3392
#define XCD_BAR_WORDS 3456
#define XB_SPIN_CAP (1u << 18)

__device__ __forceinline__ unsigned xb_ld(unsigned* p)              { return __hip_atomic_load(p, __ATOMIC_RELAXED, __HIP_MEMORY_SCOPE_AGENT); }
__device__ __forceinline__ unsigned xb_add(unsigned* p, unsigned v) { return __hip_atomic_fetch_add(p, v, __ATOMIC_RELAXED, __HIP_MEMORY_SCOPE_AGENT); }
__device__ __forceinline__ unsigned xb_xcc_id() { return (unsigned)__builtin_amdgcn_s_getreg((3 << 11) | 20) & 0xFu; }
#define XB_SPIN(cond, bar) do { unsigned _sp = 0; while (cond) { __builtin_amdgcn_s_sleep(1); \
    if ((++_sp & 255u) == 0u) { if (xb_ld(&(bar)[XB_TMO])) break; if (_sp > XB_SPIN_CAP) { atomicAdd(&(bar)[XB_TMO], 1u); break; } } } } while (0)

struct XcdBarrier { unsigned* bar; unsigned x; volatile LAS unsigned* st; };

__device__ __forceinline__ XcdBarrier xcd_barrier_post(unsigned* bar, volatile LAS unsigned* st) {
    XcdBarrier b; b.bar = bar; b.x = xb_xcc_id(); b.st = st;
    if (threadIdx.x == 0) (void)xb_add(&bar[XB_XCNT(b.x)], 1u);
    return b;
}
__device__ __forceinline__ void xcd_barrier_complete(unsigned* bar, unsigned x, unsigned& nloc, unsigned& nx) {
    const unsigned G = gridDim.x * gridDim.y * gridDim.z;
    unsigned sum, cnt, mine, sp = 0u;
    for (;;) {
        sum = 0u; cnt = 0u; mine = 0u;
#pragma unroll
        for (unsigned j = 0; j < 16; ++j) { const unsigned c = xb_ld(&bar[XB_XCNT(j)]); sum += c; cnt += (c > 0u) ? 1u : 0u; mine = (j == x) ? c : mine; }
        if (sum == G) break;
        __builtin_amdgcn_s_sleep(1);
        if ((++sp & 255u) == 0u) { if (xb_ld(&bar[XB_TMO])) break; if (sp > XB_SPIN_CAP) { atomicAdd(&bar[XB_TMO], 1u); break; } }
    }
    nloc = mine > 0u ? mine : 1u; nx = cnt > 0u ? cnt : 1u;
}
__device__ __forceinline__ void xcd_barrier(const XcdBarrier& b) {
    asm volatile("s_waitcnt vmcnt(0)" ::: "memory");
    __syncthreads();
    if (threadIdx.x == 0) {
        unsigned* bar = b.bar;
        __builtin_amdgcn_s_waitcnt(0);
        unsigned nloc = b.st[0], nx = b.st[1];
        if (nloc == 0u) { xcd_barrier_complete(bar, b.x, nloc, nx); b.st[0] = nloc; b.st[1] = nx; }
        const unsigned old = xb_add(&bar[XB_XSUB(b.x)], 1u);
        const unsigned gen = old / nloc;
        if (old + 1u == (gen + 1u) * nloc) {
            __builtin_amdgcn_fence(__ATOMIC_RELEASE, "agent");
            asm volatile("s_waitcnt vmcnt(0)" ::: "memory");
            const unsigned og = xb_add(&bar[XB_TOP], 1u);
            const unsigned tg = og / nx;
            if (og + 1u == (tg + 1u) * nx) xb_add(&bar[XB_TOPGEN], 1u);
            else XB_SPIN(xb_ld(&bar[XB_TOPGEN]) == tg, bar);
            __builtin_amdgcn_fence(__ATOMIC_ACQUIRE, "agent");
            xb_add(&bar[XB_XGEN(b.x)], 1u);
            asm volatile("s_waitcnt vmcnt(0)" ::: "memory");
        } else {
            XB_SPIN(xb_ld(&bar[XB_XGEN(b.x)]) == gen, bar);
            __builtin_amdgcn_fence(__ATOMIC_ACQUIRE, "agent");
            asm volatile("s_waitcnt vmcnt(0)" ::: "memory");
        }
    }
    __syncthreads();
}

namespace pg8 {
constexpr int BM = 256, BK = 64, HALF = 128, HTB = HALF * BK * 2, STAGE_BYTES = 8 * HTB, NXCD = 8, WGM = 8;
__host__ __device__ __forceinline__ int lds_byte(int r, int c) { const int st = (r >> 4) * 2 + (c >> 5), rr = r & 15, cc = c & 31, ob = rr * 64 + cc * 2; return st * 1024 + (ob ^ (((ob >> 9) & 1) << 5)); }
__host__ __device__ __forceinline__ void stage_rc(int b, int& R, int& C) { const int st = b / 1024, sb = b % 1024, swz = sb ^ (((sb >> 9) & 1) << 5); R = (st >> 1) * 16 + swz / 64; C = (st & 1) * 32 + (swz % 64) / 2; }
__host__ __device__ __forceinline__ int perm32(int rho) { const int n = rho >> 4, i = rho & 15; return 8 * (i >> 2) + 4 * n + (i & 3); }

struct Unit { int pm, pn, aux; };

__device__ __forceinline__ void grouped(int wgid, int nM, int nN, int& pm, int& pn) {
    const int nig = WGM * nN, gid = wgid / nig, fm = gid * WGM, gsz = (nM - fm) < WGM ? (nM - fm) : WGM;
    pm = fm + ((wgid % nig) % gsz); pn = (wgid % nig) / gsz;
}
__device__ __forceinline__ bool xcd_remap(int i, int G, int c, int nwg, int& wgid) {
    const long L = (long)i * G + c; if (L >= nwg) return false;
    wgid = (int)L; const int q = nwg / NXCD, r = nwg % NXCD, xcd = wgid % NXCD, off = wgid / NXCD;
    wgid = (xcd < r ? xcd * (q + 1) : r * (q + 1) + (xcd - r) * q) + off; return true;
}

typedef int i32x8 __attribute__((ext_vector_type(8)));
typedef int i32x4 __attribute__((ext_vector_type(4)));
template <bool F8> struct Frags;
template <> struct Frags<false> { bf16x8 a[4][2], b0[2][2], b1[2][2]; };
template <> struct Frags<true> { i32x8 a[4], b0[2], b1[2]; };
template <class Prob, class Epi, bool ALIGN_EPI, bool HOOK, bool FP8 = false>
__device__ __forceinline__ void gemm_phase(LAS unsigned char* lds, const Prob& P, const Epi& E) {
    int tid_ = threadIdx.x; asm volatile("" : "+v"(tid_));
    const int tid = tid_, wid = __builtin_amdgcn_readfirstlane(tid >> 6), lane = tid & 63, wr = wid >> 2, wc = wid & 3, fr = lane & 15, fq = lane >> 4;
    const int nt = P.nt;
    unsigned voffB[2], voffA[2];
#pragma unroll
    for (int i = 0; i < 2; ++i) { int R, C; stage_rc(tid * 16 + i * 8192, R, C); const int Rb = Epi::PERM ? ((R & ~31) + perm32(R & 31)) : R;
        voffB[i] = (unsigned)Rb * P.ldb2 + (unsigned)C * 2u; voffA[i] = (unsigned)R * P.lda2 + (unsigned)C * 2u; }
    auto gather_offs = [&](const Unit& u, unsigned (&o0)[2], unsigned (&o1)[2]) {
#pragma unroll
        for (int i = 0; i < 2; ++i) { int R, C; int tt = threadIdx.x; asm volatile("" : "+v"(tt)); stage_rc(tt * 16 + i * 8192, R, C); o0[i] = P.a_row(u, R) + (unsigned)C * 2u; o1[i] = P.a_row(u, HALF + R) + (unsigned)C * 2u; } };
    const size_t kstep = (size_t)(BK * 2);
    const size_t hstepB = (size_t)HALF * P.ldb2;
    const size_t hstepA = (size_t)HALF * P.lda2;
    const unsigned ldsw = (unsigned)wid * 1024u;
    const int aoff = lds_byte(wr * 64 + fr, fq * 8), boff = lds_byte(wc * 32 + fr, fq * 8);
#define PG8_SA(b, h) (((b) * 2 + (h)) * HTB)
#define PG8_SB(b, h) ((4 + (b) * 2 + (h)) * HTB)
#define PG8_STAGE(bufoff, gbase, voff) do { _Pragma("unroll") for (int _i = 0; _i < 2; ++_i) \
        __builtin_amdgcn_global_load_lds((const unsigned*)((const char*)(gbase) + (voff)[_i]), (LAS unsigned*)(lds + (bufoff) + ldsw + _i * 8192), 16, 0, 0); } while (0)
#define PG8_LDA(dst, b, h) do { if constexpr (FP8) { _Pragma("unroll") for (int m = 0; m < 4; ++m) { FR.a[m].lo = *(const LAS i32x4*)(lds + PG8_SA(b, h) + aoff + m * 2048); FR.a[m].hi = *(const LAS i32x4*)(lds + PG8_SA(b, h) + aoff + m * 2048 + 1024); } } \
        else { _Pragma("unroll") for (int m = 0; m < 4; ++m) _Pragma("unroll") for (int k = 0; k < 2; ++k) FR.a[m][k] = *(const LAS bf16x8*)(lds + PG8_SA(b, h) + aoff + m * 2048 + k * 1024); } } while (0)
#define PG8_LDB(dst, b, h) do { if constexpr (FP8) { _Pragma("unroll") for (int n = 0; n < 2; ++n) { FR.dst[n].lo = *(const LAS i32x4*)(lds + PG8_SB(b, h) + boff + n * 2048); FR.dst[n].hi = *(const LAS i32x4*)(lds + PG8_SB(b, h) + boff + n * 2048 + 1024); } } \
        else { _Pragma("unroll") for (int n = 0; n < 2; ++n) _Pragma("unroll") for (int k = 0; k < 2; ++k) FR.dst[n][k] = *(const LAS bf16x8*)(lds + PG8_SB(b, h) + boff + n * 2048 + k * 1024); } } while (0)
#define PG8_MMA(ai, bj, At, Bt) do { __builtin_amdgcn_s_setprio(1); if constexpr (FP8) { _Pragma("unroll") for (int m = 0; m < 4; ++m) _Pragma("unroll") for (int n = 0; n < 2; ++n) \
            asm volatile("v_mfma_f32_16x16x128_f8f6f4 %0, %1, %2, %0" : "+v"(acc[ai][bj][m][n]) : "v"(FR.Bt[n]), "v"(FR.a[m])); } \
        else { _Pragma("unroll") for (int m = 0; m < 4; ++m) _Pragma("unroll") for (int n = 0; n < 2; ++n) _Pragma("unroll") for (int k = 0; k < 2; ++k) \
        acc[ai][bj][m][n] = __builtin_amdgcn_mfma_f32_16x16x32_bf16(FR.Bt[n][k], FR.a[m][k], acc[ai][bj][m][n], 0, 0, 0); } __builtin_amdgcn_s_setprio(0); } while (0)
#define PG8_WAIT_V(n) asm volatile("s_waitcnt vmcnt(" #n ")" ::: "memory")
#define PG8_WAIT_L(n) asm volatile("s_waitcnt lgkmcnt(" #n ")" ::: "memory")
#define PG8_BAR __builtin_amdgcn_s_barrier()
#define PG8_SCHED __builtin_amdgcn_sched_barrier(0)
    Unit cur, nxt; int ui = 0;
    if (!P.unit(0, cur)) return;
    f32x4 acc[2][2][4][2];
#pragma unroll
    for (int a = 0; a < 2; ++a)
#pragma unroll
        for (int b = 0; b < 2; ++b)
#pragma unroll
            for (int m = 0; m < 4; ++m)
#pragma unroll
                for (int n = 0; n < 2; ++n) acc[a][b][m][n] = (f32x4){0.f, 0.f, 0.f, 0.f};
    Frags<FP8> FR;
    unsigned va0[2], va1[2], vn0[2], vn1[2];
    const char* const gA = P.Abase; const char* cA = gA; const char* nA = gA; const char* cB = P.b_tile(cur);
    if constexpr (Prob::GATHER) {
        gather_offs(cur, va0, va1);
    } else { cA = gA + P.a_row(cur, 0); }
#define PG8_STAGE_A(bufoff, h, koff, nx) do { if constexpr (Prob::GATHER) { unsigned _v[2]; _Pragma("unroll") for (int _i = 0; _i < 2; ++_i) _v[_i] = (nx) ? ((h) ? vn1[_i] : vn0[_i]) : ((h) ? va1[_i] : va0[_i]); PG8_STAGE(bufoff, gA + (koff), _v); } \
        else { PG8_STAGE(bufoff, ((nx) ? nA : cA) + (h) * hstepA + (koff), voffA); } } while (0)
    PG8_STAGE(PG8_SB(0, 0), cB, voffB); PG8_STAGE(PG8_SB(0, 1), cB + hstepB, voffB); PG8_STAGE_A(PG8_SA(0, 0), 0, 0, false); PG8_STAGE_A(PG8_SA(0, 1), 1, 0, false);
    if (wr == 1) PG8_BAR;
    PG8_WAIT_V(2); PG8_BAR;
    PG8_STAGE(PG8_SB(1, 0), cB + kstep, voffB); PG8_STAGE_A(PG8_SA(1, 0), 0, kstep, false); PG8_STAGE(PG8_SB(1, 1), cB + hstepB + kstep, voffB);
    PG8_WAIT_V(6); PG8_BAR;
    for (;;) {
        const bool has_next = P.unit(ui + 1, nxt);
        if (!has_next) nxt = cur;
        if constexpr (Prob::GATHER) {
            gather_offs(nxt, vn0, vn1);
        } else { nA = gA + P.a_row(nxt, 0); }
        const char* nB = P.b_tile(nxt);
        for (int t = 0; t < nt; t += 2) {
            const bool last = (t == nt - 2);
            if constexpr (HOOK) { if (t == (nt >> 1)) E.mid(acc, cur, wr, wc, fr, fq); }
            const size_t k1 = (size_t)(t + 1) * kstep, k2 = last ? 0 : (size_t)(t + 2) * kstep, k3 = k2 + kstep;
            const char* b2 = last ? nB : cB + (size_t)(t + 2) * kstep; const char* b3 = b2 + kstep;
            PG8_LDB(b0, 0, 0); PG8_LDB(b1, 0, 1); PG8_SCHED; PG8_LDA(At, 0, 0); PG8_STAGE_A(PG8_SA(1, 1), 1, k1, false);
            PG8_WAIT_V(8); PG8_WAIT_L(0); PG8_BAR; PG8_MMA(0, 0, At, b0); PG8_MMA(0, 1, At, b1); PG8_BAR; PG8_SCHED;
            PG8_LDA(At, 0, 1); PG8_STAGE(PG8_SB(0, 0), b2, voffB); PG8_STAGE(PG8_SB(0, 1), b2 + hstepB, voffB); PG8_STAGE_A(PG8_SA(0, 0), 0, k2, last);
            PG8_WAIT_V(8); PG8_WAIT_L(0); PG8_BAR; PG8_MMA(1, 0, At, b0); PG8_MMA(1, 1, At, b1); PG8_BAR; PG8_SCHED;
            PG8_LDB(b0, 1, 0); PG8_LDB(b1, 1, 1); PG8_SCHED; PG8_LDA(At, 1, 0); PG8_STAGE_A(PG8_SA(0, 1), 1, k2, last);
            PG8_WAIT_V(8); PG8_WAIT_L(0); PG8_BAR; PG8_MMA(0, 0, At, b0); PG8_MMA(0, 1, At, b1); PG8_BAR; PG8_SCHED;
            PG8_LDA(At, 1, 1); PG8_STAGE(PG8_SB(1, 0), b3, voffB); PG8_STAGE(PG8_SB(1, 1), b3 + hstepB, voffB); PG8_STAGE_A(PG8_SA(1, 0), 0, k3, last);
            PG8_WAIT_V(8); PG8_WAIT_L(0); PG8_BAR; PG8_MMA(1, 0, At, b0); PG8_MMA(1, 1, At, b1); PG8_BAR; PG8_SCHED;
        }
        if constexpr (ALIGN_EPI) { if (wr == 0) PG8_BAR; }
        if constexpr (FP8) asm volatile("s_nop 15\n\ts_nop 15" ::: "memory");
        E(acc, cur, wr, wc, fr, fq);
        if (!has_next) break;
#pragma unroll
        for (int a = 0; a < 2; ++a)
#pragma unroll
            for (int b = 0; b < 2; ++b)
#pragma unroll
                for (int m = 0; m < 4; ++m)
#pragma unroll
                    for (int n = 0; n < 2; ++n) acc[a][b][m][n] = (f32x4){0.f, 0.f, 0.f, 0.f};
        cur = nxt; cB = nB; cA = nA; ++ui;
        if constexpr (Prob::GATHER) {
#pragma unroll
            for (int i = 0; i < 2; ++i) { va0[i] = vn0[i]; va1[i] = vn1[i]; } }
        if constexpr (ALIGN_EPI) { if (wr == 1) PG8_BAR; }
    }
    PG8_WAIT_V(0);
    if constexpr (!ALIGN_EPI) { if (wr == 0) PG8_BAR; }
    PG8_BAR;
#undef PG8_SA
#undef PG8_SB
#undef PG8_STAGE
#undef PG8_STAGE_A
#undef PG8_LDA
#undef PG8_LDB
#undef PG8_MMA
#undef PG8_WAIT_V
#undef PG8_WAIT_L
#undef PG8_BAR
#undef PG8_SCHED
}
}

using pg8::Unit;

struct ProbDense {
    static constexpr bool GATHER = false;
    const char* Abase; int nt; unsigned ldb2; unsigned lda2; const char* Bt; int nM, nN, G, c;
    __device__ __forceinline__ bool unit(int i, Unit& u) const { int w; if (!pg8::xcd_remap(i, G, c, nM * nN, w)) return false; pg8::grouped(w, nM, nN, u.pm, u.pn); u.aux = 0; return true; }
    __device__ __forceinline__ unsigned a_row(const Unit& u, int r) const { return (unsigned)(u.pm * 256 + r) * lda2; }
    __device__ __forceinline__ const char* b_tile(const Unit& u) const { return Bt + (size_t)u.pn * 256 * ldb2; }
};
struct ProbP1 {
    static constexpr bool GATHER = false;
    const char* Abase; int nt; unsigned ldb2; unsigned lda2; const char* Bt; unsigned uc_off; int G, c;
    __device__ __forceinline__ bool unit(int i, Unit& u) const {
        int w; if (!pg8::xcd_remap(i, G, c, 3072 + 256, w)) return false;
        if (w < 3072) { pg8::grouped(w, 256, 12, u.pm, u.pn); u.aux = 0; }
        else { pg8::grouped(w - 3072, 32, 8, u.pm, u.pn); u.pn += 4; u.aux = 1; }
        return true; }
    __device__ __forceinline__ unsigned a_row(const Unit& u, int r) const { return (u.aux ? uc_off : 0u) + (unsigned)(u.pm * 256 + r) * lda2; }
    __device__ __forceinline__ const char* b_tile(const Unit& u) const { return Bt + (size_t)u.pn * 256 * ldb2; }
};
template <bool GATHER_> struct ProbMoE {
    static constexpr bool GATHER = GATHER_;
    const char* Abase; int nt; unsigned ldb2; unsigned lda2; const char* Bt; size_t estride; int nN, nblk, G, c; const int* rowtok; const LAS unsigned char* blk_e;
    __device__ __forceinline__ bool unit(int i, Unit& u) const { int w; if (!pg8::xcd_remap(i, G, c, nblk * nN, w)) return false; pg8::grouped(w, nblk, nN, u.pm, u.pn); u.aux = (int)blk_e[u.pm]; return true; }
    __device__ __forceinline__ unsigned a_row(const Unit& u, int r) const { if (GATHER) return (unsigned)rowtok[u.pm * 256 + r] * lda2; else return (unsigned)(u.pm * 256 + r) * lda2; }
    __device__ __forceinline__ const char* b_tile(const Unit& u) const { return Bt + (size_t)u.aux * estride + (size_t)u.pn * 256 * ldb2; }
};

struct EpiP1 {
    static constexpr bool PERM = true;
    bf16_t* PA; bf16_t* PH; bf16_t* PHC;
    __device__ __forceinline__ void operator()(const f32x4 (&acc)[2][2][4][2], const Unit& u, int wr, int wc, int fr, int fq) const {
        bf16_t* base; int ldc, colt;
        if (u.aux) { base = PHC; ldc = 2048; colt = (u.pn - 4) * 256; }
        else if (u.pn < 4) { base = PA; ldc = 1024; colt = u.pn * 256; }
        else { base = PH; ldc = 2048; colt = (u.pn - 4) * 256; }
        const int row0 = u.pm * 256 + wr * 64 + fr, col0 = colt + wc * 32 + 8 * fq;
#pragma unroll
        for (int ai = 0; ai < 2; ++ai)
#pragma unroll
            for (int m = 0; m < 4; ++m) { bf16_t* rowp = base + (size_t)(row0 + ai * 128 + m * 16) * ldc + col0;
#pragma unroll
                for (int bj = 0; bj < 2; ++bj) { const f32x4 v0 = acc[ai][bj][m][0] * W8_INV, v1 = acc[ai][bj][m][1] * W8_INV;
                    u32x4 w; w.x = cvt_pk_bf16(v0[0], v0[1]); w.y = cvt_pk_bf16(v0[2], v0[3]); w.z = cvt_pk_bf16(v1[0], v1[1]); w.w = cvt_pk_bf16(v1[2], v1[3]);
                    *(u32x4*)(rowp + bj * 128) = w; } }
    }
    __device__ __forceinline__ void mid(f32x4 (&)[2][2][4][2], const Unit&, int, int, int, int) const {}
};
struct EpiP2 {
    static constexpr bool PERM = true;
    bf16_t* PG; bf16_t* GATES;
    __device__ __forceinline__ void operator()(const f32x4 (&acc)[2][2][4][2], const Unit& u, int wr, int wc, int fr, int fq) const {
        const bool isg = u.pn >= 2; bf16_t* base = isg ? GATES : PG; const int ldc = isg ? 2048 : 512, colt = isg ? (u.pn - 2) * 256 : u.pn * 256;
        const int row0 = u.pm * 256 + wr * 64 + fr, col0 = colt + wc * 32 + 8 * fq;
#pragma unroll
        for (int ai = 0; ai < 2; ++ai)
#pragma unroll
            for (int m = 0; m < 4; ++m) { bf16_t* rowp = base + (size_t)(row0 + ai * 128 + m * 16) * ldc + col0;
#pragma unroll
                for (int bj = 0; bj < 2; ++bj) { f32x4 v0 = acc[ai][bj][m][0] * W8_INV, v1 = acc[ai][bj][m][1] * W8_INV;
#pragma unroll
                    for (int j = 0; j < 4; ++j) { const float s0 = fast_sigmoid(v0[j]), s1 = fast_sigmoid(v1[j]); v0[j] = isg ? s0 : v0[j] * s0; v1[j] = isg ? s1 : v1[j] * s1; }
                    u32x4 w; w.x = cvt_pk_bf16(v0[0], v0[1]); w.y = cvt_pk_bf16(v0[2], v0[3]); w.z = cvt_pk_bf16(v1[0], v1[1]); w.w = cvt_pk_bf16(v1[2], v1[3]);
                    *(u32x4*)(rowp + bj * 128) = w; } }
    }
    __device__ __forceinline__ void mid(f32x4 (&)[2][2][4][2], const Unit&, int, int, int, int) const {}
};
struct EpiM1 {
    static constexpr bool PERM = true;
    const bf16_t* GATES; bf16_t* Mo;
    __device__ __forceinline__ void mid(f32x4 (&acc)[2][2][4][2], const Unit& u, int wr, int wc, int fr, int fq) const {
        int row0 = u.pm * 256 + wr * 64 + fr, col0 = u.pn * 256 + wc * 32 + 8 * fq;
        asm volatile("" : "+v"(row0), "+v"(col0));
#pragma unroll
        for (int ai = 0; ai < 2; ++ai) {
            u32x4 gf[4][2], gh[4][2];
#pragma unroll
            for (int m = 0; m < 4; ++m) { const bf16_t* gp = GATES + (size_t)(row0 + ai * 128 + m * 16) * 2048 + col0;
#pragma unroll
                for (int bj = 0; bj < 2; ++bj) { gf[m][bj] = *(const u32x4*)(gp + bj * 128); gh[m][bj] = *(const u32x4*)(gp + 1024 + bj * 128); } }
#pragma unroll
            for (int m = 0; m < 4; ++m)
#pragma unroll
                for (int bj = 0; bj < 2; ++bj) { const u32x4 f = gf[m][bj], h = gh[m][bj];
                    f32x4& v0 = acc[ai][bj][m][0]; f32x4& v1 = acc[ai][bj][m][1];
                    v0[0] *= bf_lo(f.x) * __builtin_amdgcn_rcpf(fmaxf(bf_lo(h.x), 1e-20f)); v0[1] *= bf_hi(f.x) * __builtin_amdgcn_rcpf(fmaxf(bf_hi(h.x), 1e-20f));
                    v0[2] *= bf_lo(f.y) * __builtin_amdgcn_rcpf(fmaxf(bf_lo(h.y), 1e-20f)); v0[3] *= bf_hi(f.y) * __builtin_amdgcn_rcpf(fmaxf(bf_hi(h.y), 1e-20f));
                    v1[0] *= bf_lo(f.z) * __builtin_amdgcn_rcpf(fmaxf(bf_lo(h.z), 1e-20f)); v1[1] *= bf_hi(f.z) * __builtin_amdgcn_rcpf(fmaxf(bf_hi(h.z), 1e-20f));
                    v1[2] *= bf_lo(f.w) * __builtin_amdgcn_rcpf(fmaxf(bf_lo(h.w), 1e-20f)); v1[3] *= bf_hi(f.w) * __builtin_amdgcn_rcpf(fmaxf(bf_hi(h.w), 1e-20f)); }
            asm volatile("" ::: "memory");
        }
    }
    __device__ __forceinline__ void operator()(const f32x4 (&acc)[2][2][4][2], const Unit& u, int wr, int wc, int fr, int fq) const {
        const int row0 = u.pm * 256 + wr * 64 + fr, col0 = u.pn * 256 + wc * 32 + 8 * fq;
#pragma unroll
        for (int ai = 0; ai < 2; ++ai) {
            u32x4 gh[4][2];
#pragma unroll
            for (int m = 0; m < 4; ++m) { const bf16_t* gp = GATES + (size_t)(row0 + ai * 128 + m * 16) * 2048 + 1024 + col0;
#pragma unroll
                for (int bj = 0; bj < 2; ++bj) gh[m][bj] = *(const u32x4*)(gp + bj * 128); }
#pragma unroll
            for (int m = 0; m < 4; ++m) { bf16_t* rowp = Mo + (size_t)(row0 + ai * 128 + m * 16) * 1024 + col0;
#pragma unroll
                for (int bj = 0; bj < 2; ++bj) { const u32x4 h = gh[m][bj]; const f32x4 v0 = acc[ai][bj][m][0], v1 = acc[ai][bj][m][1];
                    u32x4 w; w.x = cvt_pk_bf16(v0[0] * bf_lo(h.x), v0[1] * bf_hi(h.x)); w.y = cvt_pk_bf16(v0[2] * bf_lo(h.y), v0[3] * bf_hi(h.y));
                    w.z = cvt_pk_bf16(v1[0] * bf_lo(h.z), v1[1] * bf_hi(h.z)); w.w = cvt_pk_bf16(v1[2] * bf_lo(h.w), v1[3] * bf_hi(h.w));
                    *(u32x4*)(rowp + bj * 128) = w; } }
            asm volatile("" ::: "memory");
        }
    }
};
struct EpiM2 {
    static constexpr bool PERM = true;
    const float* X; const float* ada; bf16_t* V;
    __device__ __forceinline__ void operator()(const f32x4 (&acc)[2][2][4][2], const Unit& u, int wr, int wc, int fr, int fq) const {
        const int row0 = u.pm * 256 + wr * 64 + fr, col0 = u.pn * 256 + wc * 32 + 8 * fq;
        const float* g1 = ada + (size_t)(u.pm >> 3) * 6144 + 2048 + col0;
        f32x4 gv[2][2];
#pragma unroll
        for (int bj = 0; bj < 2; ++bj)
#pragma unroll
            for (int n = 0; n < 2; ++n) gv[bj][n] = *(const f32x4*)(g1 + bj * 128 + n * 4);
#pragma unroll
        for (int ai = 0; ai < 2; ++ai) {
            f32x4 xv[4][2][2];
#pragma unroll
            for (int m = 0; m < 4; ++m) { const size_t off = (size_t)(row0 + ai * 128 + m * 16) * 1024 + col0;
#pragma unroll
                for (int bj = 0; bj < 2; ++bj)
#pragma unroll
                    for (int n = 0; n < 2; ++n) xv[m][bj][n] = *(const f32x4*)(X + off + bj * 128 + n * 4); }
#pragma unroll
            for (int m = 0; m < 4; ++m) { const size_t off = (size_t)(row0 + ai * 128 + m * 16) * 1024 + col0;
#pragma unroll
                for (int bj = 0; bj < 2; ++bj) { const f32x4 v0 = xv[m][bj][0] * DN_ALPHA + gv[bj][0] * acc[ai][bj][m][0], v1 = xv[m][bj][1] * DN_ALPHA + gv[bj][1] * acc[ai][bj][m][1];
                    u32x4 w; w.x = cvt_pk_bf16(v0[0], v0[1]); w.y = cvt_pk_bf16(v0[2], v0[3]); w.z = cvt_pk_bf16(v1[0], v1[1]); w.w = cvt_pk_bf16(v1[2], v1[3]);
                    *(u32x4*)(V + off + bj * 128) = w; } }
            asm volatile("" ::: "memory");
        }
    }
    __device__ __forceinline__ void mid(f32x4 (&)[2][2][4][2], const Unit&, int, int, int, int) const {}
};
struct EpiGU {
    static constexpr bool PERM = true;
    const float* bgu; unsigned char* ACT;
    __device__ __forceinline__ void operator()(const f32x4 (&acc)[2][2][4][2], const Unit& u, int wr, int wc, int fr, int fq) const {
        const int row0 = u.pm * 256 + wr * 64 + fr, col0 = u.pn * 128 + wc * 32 + 8 * fq;
        const float* bp = bgu + (size_t)u.aux * 2048 + col0;
        const f32x4 bg0 = *(const f32x4*)(bp), bg1 = *(const f32x4*)(bp + 4), bu0 = *(const f32x4*)(bp + 1024), bu1 = *(const f32x4*)(bp + 1028);
#pragma unroll
        for (int ai = 0; ai < 2; ++ai)
#pragma unroll
            for (int m = 0; m < 4; ++m) { unsigned char* rowp = ACT + (size_t)(row0 + ai * 128 + m * 16) * 1024 + col0;
                f32x4 g0 = acc[ai][0][m][0] * W8_INV + bg0, g1 = acc[ai][0][m][1] * W8_INV + bg1, p0 = acc[ai][1][m][0] * W8_INV + bu0, p1 = acc[ai][1][m][1] * W8_INV + bu1;
#pragma unroll
                for (int j = 0; j < 4; ++j) {
                    float g = fminf(g0[j], 7.0f), p = fminf(fmaxf(p0[j], -7.0f), 7.0f); g0[j] = (p + 1.0f) * g * fast_sigmoid(1.702f * g);
                    g = fminf(g1[j], 7.0f); p = fminf(fmaxf(p1[j], -7.0f), 7.0f); g1[j] = (p + 1.0f) * g * fast_sigmoid(1.702f * g); }
                u32x2 w; w.x = cvt_pk4_fp8(g0[0], g0[1], g0[2], g0[3]); w.y = cvt_pk4_fp8(g1[0], g1[1], g1[2], g1[3]);
                *(u32x2*)rowp = w; }
    }
    __device__ __forceinline__ void mid(f32x4 (&)[2][2][4][2], const Unit&, int, int, int, int) const {}
};
struct EpiDN {
    static constexpr bool PERM = true;
    const float* bdn; unsigned char* Y;
    __device__ __forceinline__ void operator()(const f32x4 (&acc)[2][2][4][2], const Unit& u, int wr, int wc, int fr, int fq) const {
        const int row0 = u.pm * 256 + wr * 64 + fr, col0 = u.pn * 256 + wc * 32 + 8 * fq;
        const float* bp = bdn + (size_t)u.aux * 1024 + col0;
        f32x4 bv[2][2];
#pragma unroll
        for (int bj = 0; bj < 2; ++bj)
#pragma unroll
            for (int n = 0; n < 2; ++n) bv[bj][n] = *(const f32x4*)(bp + bj * 128 + 4 * n);
#pragma unroll
        for (int ai = 0; ai < 2; ++ai)
#pragma unroll
            for (int m = 0; m < 4; ++m) { unsigned char* rowp = Y + (size_t)(row0 + ai * 128 + m * 16) * 1024 + col0;
#pragma unroll
                for (int bj = 0; bj < 2; ++bj) { const f32x4 v0 = acc[ai][bj][m][0] * W8_INV + bv[bj][0], v1 = acc[ai][bj][m][1] * W8_INV + bv[bj][1];
                    *(u32x2*)(rowp + bj * 128) = (u32x2){cvt_pk4_fp8(v0[0], v0[1], v0[2], v0[3]), cvt_pk4_fp8(v1[0], v1[1], v1[2], v1[3])}; } }
    }
    __device__ __forceinline__ void mid(f32x4 (&)[2][2][4][2], const Unit&, int, int, int, int) const {}
};

struct Frame {
    LAS unsigned char* lds; int tid, lane, wave, G, c;
    const float* const* in; float* out; unsigned char* ws; unsigned* ctl;
};
enum { I_X = 0, I_C, I_CTX, I_CCTX, I_WADA, I_BADA, I_WIN, I_LBRAW, I_HGG, I_WFO, I_WHO, I_WO, I_LN1G, I_LN1B, I_WR, I_BR, I_WGU, I_BGU, I_WDN, I_BDN, I_LN2G, I_LN2B };

__device__ __forceinline__ float wave_sum(float v) {
#pragma unroll
    for (int o = 32; o >= 1; o >>= 1) v += __shfl_xor(v, o);
    return v;
}

__device__ __forceinline__ void p0_ada(const Frame& F) {
    LAS float* cact = (LAS float*)F.lds;
    float* ada = (float*)(F.ws + WS_ADA);
    for (int cb = F.c; cb < 192; cb += F.G) {
        for (int i = F.tid; i < 33 * 1024; i += NTHR) { const int b = i >> 10, k = i & 1023; const float v = b < 32 ? F.in[I_C][b * 1024 + k] : F.in[I_CCTX][k]; cact[i] = v * fast_sigmoid(v); }
        __syncthreads();
        const int kg = F.tid >> 5, col = F.tid & 31, gcol = cb * 32 + col;
        float acc[33];
#pragma unroll
        for (int b = 0; b < 33; ++b) acc[b] = 0.f;
        for (int k = kg; k < 1024; k += 16) { const float w = F.in[I_WADA][(size_t)k * 6144 + gcol];
#pragma unroll
            for (int b = 0; b < 33; ++b) acc[b] += cact[b * 1024 + k] * w; }
        __syncthreads();
        LAS float* red = cact;
#pragma unroll
        for (int b = 0; b < 33; ++b) red[(kg * 33 + b) * 32 + col] = acc[b];
        __syncthreads();
        for (int o = F.tid; o < 33 * 32; o += NTHR) { const int b = o >> 5, cc = o & 31; float s = 0.f;
            for (int g = 0; g < 16; ++g) s += red[(g * 33 + b) * 32 + cc];
            ada[(size_t)b * 6144 + cb * 32 + cc] = s + F.in[I_BADA][cb * 32 + cc]; }
        __syncthreads();
    }
}
__device__ __forceinline__ void p0_fold(const Frame& F) {
    LAS float* xr = (LAS float*)F.lds;
    LAS float* cs = xr + 2048;
    unsigned char* W1 = (unsigned char*)(F.ws + WS_WIN1T);
    if (F.tid < 128) { const float a = (float)F.tid * (1.0f / 128.0f); cs[F.tid] = __builtin_amdgcn_cosf(a); cs[128 + F.tid] = __builtin_amdgcn_sinf(a); }
    for (int kb = F.c; kb < 256; kb += F.G) {
        __syncthreads();
        for (int i = F.tid; i < 2048; i += NTHR) xr[i] = F.in[I_WIN][(size_t)(4 * kb + (i >> 9)) * 5120 + (i & 511)];
        __syncthreads();
        const int g = F.tid >> 7, j = F.tid & 127;
        float ac[4] = {0.f, 0.f, 0.f, 0.f}, as[4] = {0.f, 0.f, 0.f, 0.f};
        for (int d = 0; d < 128; ++d) { const int idx = (d * j) & 127; const float cv = cs[idx], sv = cs[128 + idx];
#pragma unroll
            for (int r = 0; r < 4; ++r) { const float xv = xr[r * 512 + g * 128 + d]; ac[r] += xv * cv; as[r] += xv * sv; } }
        const float sc = 0.08838834764831845f * W8_SCALE;
        *(unsigned*)(W1 + (size_t)(g * 128 + j) * 1024 + 4 * kb) = cvt_pk4_fp8(ac[0] * sc, ac[1] * sc, ac[2] * sc, ac[3] * sc);
        *(unsigned*)(W1 + (size_t)(512 + g * 128 + j) * 1024 + 4 * kb) = cvt_pk4_fp8(-as[0] * sc, -as[1] * sc, -as[2] * sc, -as[3] * sc);
    }
    __syncthreads();
}
__device__ __forceinline__ void cv_tile(const Frame& F, const float* src, int src_ld, bf16_t* dst, int dst_ld) {
    LAS float* tile = (LAS float*)F.lds;
    f32x4 v[8];
#pragma unroll
    for (int i = 0; i < 8; ++i) { const int idx = F.tid + i * NTHR, r = idx >> 5, c4 = idx & 31; v[i] = *(const f32x4*)(src + (size_t)r * src_ld + c4 * 4); }
#pragma unroll
    for (int i = 0; i < 8; ++i) { const int idx = F.tid + i * NTHR, r = idx >> 5, c4 = idx & 31; LAS float* p = tile + r * 129 + c4 * 4; p[0] = v[i][0]; p[1] = v[i][1]; p[2] = v[i][2]; p[3] = v[i][3]; }
    __syncthreads();
#pragma unroll
    for (int i = 0; i < 4; ++i) { const int idx = F.tid + i * NTHR, n = idx >> 4, kc = idx & 15; const LAS float* p = tile + (kc * 8) * 129 + n;
        u32x4 w; w.x = cvt_pk_bf16(p[0], p[129]); w.y = cvt_pk_bf16(p[2 * 129], p[3 * 129]); w.z = cvt_pk_bf16(p[4 * 129], p[5 * 129]); w.w = cvt_pk_bf16(p[6 * 129], p[7 * 129]);
        *(u32x4*)(dst + (size_t)n * dst_ld + kc * 8) = w; }
    __syncthreads();
}
__device__ __forceinline__ void cv_tile_f8(const Frame& F, const float* src, int src_ld, unsigned char* dst, int dst_ld) {
    LAS float* tile = (LAS float*)F.lds;
    f32x4 v[8];
#pragma unroll
    for (int i = 0; i < 8; ++i) { const int idx = F.tid + i * NTHR, r = idx >> 5, c4 = idx & 31; v[i] = *(const f32x4*)(src + (size_t)r * src_ld + c4 * 4); }
#pragma unroll
    for (int i = 0; i < 8; ++i) { const int idx = F.tid + i * NTHR, r = idx >> 5, c4 = idx & 31; LAS float* p = tile + r * 129 + c4 * 4; p[0] = v[i][0] * W8_SCALE; p[1] = v[i][1] * W8_SCALE; p[2] = v[i][2] * W8_SCALE; p[3] = v[i][3] * W8_SCALE; }
    __syncthreads();
#pragma unroll
    for (int i = 0; i < 2; ++i) { const int idx = F.tid + i * NTHR, n = idx >> 3, kc = idx & 7; const LAS float* p = tile + (kc * 16) * 129 + n;
        u32x4 w; w.x = cvt_pk4_fp8(p[0], p[129], p[2 * 129], p[3 * 129]); w.y = cvt_pk4_fp8(p[4 * 129], p[5 * 129], p[6 * 129], p[7 * 129]);
        w.z = cvt_pk4_fp8(p[8 * 129], p[9 * 129], p[10 * 129], p[11 * 129]); w.w = cvt_pk4_fp8(p[12 * 129], p[13 * 129], p[14 * 129], p[15 * 129]);
        *(u32x4*)(dst + (size_t)n * dst_ld + kc * 16) = w; }
    __syncthreads();
}
__device__ __forceinline__ void p0_convert(const Frame& F) {
    constexpr int NJ = 128 + 160 + 32 + 32 + 64 + 4096 + 2048;
    for (int j = F.c; j < NJ; j += F.G) {
        const float* src; int sld; bf16_t* dst; int dld = 1024;
        if (j >= 416 || j < 288) {
            unsigned char* d8;
            if (j < 128) { const int kt = j >> 4, nt = j & 15; src = F.in[I_WIN] + (size_t)kt * 128 * 5120 + 512 + nt * 128; sld = 5120; d8 = (unsigned char*)(F.ws + WS_WIN1T) + (size_t)(1024 + nt * 128) * 1024 + kt * 128; }
            else if (j < 288) { const int q = j - 128, kt = q / 20, nt = q % 20; src = F.in[I_WIN] + (size_t)kt * 128 * 5120 + 2560 + nt * 128; sld = 5120; d8 = (unsigned char*)(F.ws + WS_WIN2T) + (size_t)(nt * 128) * 1024 + kt * 128; }
            else if (j < 4512) { const int q = j - 416, e = q >> 7, r = q & 127, kt = r >> 4, jt = r & 15; src = F.in[I_WGU] + (size_t)e * 1024 * 2048 + (size_t)kt * 128 * 2048 + jt * 128; sld = 2048;
                d8 = (unsigned char*)(F.ws + WS_WGUT) + (size_t)e * 2048 * 1024 + (size_t)((jt & 7) * 256 + (jt >> 3) * 128) * 1024 + kt * 128; }
            else { const int q = j - 4512, e = q >> 6, r = q & 63, kt = r >> 3, nt = r & 7; src = F.in[I_WDN] + (size_t)e * 1024 * 1024 + (size_t)kt * 128 * 1024 + nt * 128; sld = 1024;
                d8 = (unsigned char*)(F.ws + WS_WDNT) + (size_t)e * 1024 * 1024 + (size_t)(nt * 128) * 1024 + kt * 128; }
            cv_tile_f8(F, src, sld, d8, 1024);
            continue;
        }
        if (j < 320) { const int q = j - 288, kt = q >> 3, nt = q & 7; src = F.in[I_WFO] + (size_t)kt * 128 * 1024 + nt * 128; sld = 1024; dst = (bf16_t*)(F.ws + WS_WMT) + (size_t)(nt * 128) * 1024 + kt * 128; }
        else if (j < 352) { const int q = j - 320, kt = q >> 3, nt = q & 7; src = F.in[I_WHO] + (size_t)kt * 128 * 1024 + nt * 128; sld = 1024; dst = (bf16_t*)(F.ws + WS_WMT) + (size_t)(nt * 128) * 1024 + 512 + kt * 128; }
        else { const int q = j - 352, kt = q >> 3, nt = q & 7; src = F.in[I_WO] + (size_t)kt * 128 * 1024 + nt * 128; sld = 1024; dst = (bf16_t*)(F.ws + WS_WOT) + (size_t)(nt * 128) * 1024 + kt * 128; }
        cv_tile(F, src, sld, dst, dld);
    }
}

__device__ __forceinline__ void p1_uprep(const Frame& F) {
    const float* ada = (const float*)(F.ws + WS_ADA);
    unsigned char* U = (unsigned char*)(F.ws + WS_U); unsigned char* Uc = (unsigned char*)(F.ws + WS_UC);
    const size_t NIT = (size_t)(T + TCX) * 128, stride = (size_t)F.G * NTHR;
    for (size_t idx = (size_t)F.c * NTHR + F.tid; idx < NIT; idx += stride) {
        const int row = (int)(idx >> 7), col = (int)(idx & 127) * 8;
        const bool lat = row < T; const int b = lat ? (row >> 11) : 32;
        const float* src = lat ? F.in[I_X] + (size_t)row * 1024 + col : F.in[I_CTX] + (size_t)(row - T) * 1024 + col;
        unsigned char* dst = lat ? U + (size_t)row * 1024 + col : Uc + (size_t)(row - T) * 1024 + col;
        const f32x4 a0 = *(const f32x4*)src, a1 = *(const f32x4*)(src + 4);
        const float* ap = ada + (size_t)b * 6144 + col;
        const f32x4 sh0 = *(const f32x4*)ap, sh1 = *(const f32x4*)(ap + 4), sc0 = *(const f32x4*)(ap + 1024), sc1 = *(const f32x4*)(ap + 1028);
        const f32x4 r0 = a0 * (sc0 + 1.0f) + sh0, r1 = a1 * (sc1 + 1.0f) + sh1;
        *(u32x2*)dst = (u32x2){cvt_pk4_fp8(r0[0], r0[1], r0[2], r0[3]), cvt_pk4_fp8(r1[0], r1[1], r1[2], r1[3])};
    }
    int* rowtok = (int*)(F.ws + WS_ROWTOK);
    for (int i = F.c * NTHR + F.tid; i < NCH * ROWS_CH; i += F.G * NTHR) rowtok[i] = (i / ROWS_CH) * TCH;
}

__device__ __forceinline__ void p6_readout(const Frame& F) {
    const bf16_t* PH = (const bf16_t*)(F.ws + WS_PH); const bf16_t* PG = (const bf16_t*)(F.ws + WS_PG); bf16_t* Y = (bf16_t*)(F.ws + WS_Y);
    const int l8 = F.lane * 8;
    const f32x4 g0 = *(const f32x4*)(F.in[I_HGG] + l8), g1 = *(const f32x4*)(F.in[I_HGG] + l8 + 4);
    for (int t = F.c * 8 + F.wave; t < T; t += F.G * 8) {
        const u32x4 a = *(const u32x4*)(PH + (size_t)t * 2048 + 512 + l8), b = *(const u32x4*)(PH + (size_t)t * 2048 + 1024 + l8), p = *(const u32x4*)(PG + (size_t)t * 512 + l8);
        float o[8] = { bf_lo(a.x) + bf_lo(b.x), bf_hi(a.x) + bf_hi(b.x), bf_lo(a.y) + bf_lo(b.y), bf_hi(a.y) + bf_hi(b.y), bf_lo(a.z) + bf_lo(b.z), bf_hi(a.z) + bf_hi(b.z), bf_lo(a.w) + bf_lo(b.w), bf_hi(a.w) + bf_hi(b.w) };
        float ss = 0.f;
#pragma unroll
        for (int i = 0; i < 8; ++i) ss += o[i] * o[i];
        ss += __shfl_xor(ss, 1); ss += __shfl_xor(ss, 2); ss += __shfl_xor(ss, 4); ss += __shfl_xor(ss, 8);
        const float rs = __builtin_amdgcn_rsqf(ss * (1.0f / 128.0f) + RMS_EPS);
        const float sp[8] = { bf_lo(p.x), bf_hi(p.x), bf_lo(p.y), bf_hi(p.y), bf_lo(p.z), bf_hi(p.z), bf_lo(p.w), bf_hi(p.w) };
        u32x4 w; w.x = cvt_pk_bf16(o[0] * rs * g0[0] * sp[0], o[1] * rs * g0[1] * sp[1]); w.y = cvt_pk_bf16(o[2] * rs * g0[2] * sp[2], o[3] * rs * g0[3] * sp[3]);
        w.z = cvt_pk_bf16(o[4] * rs * g1[0] * sp[4], o[5] * rs * g1[1] * sp[5]); w.w = cvt_pk_bf16(o[6] * rs * g1[2] * sp[6], o[7] * rs * g1[3] * sp[7]);
        *(u32x4*)(Y + (size_t)t * 1024 + 512 + l8) = w;
    }
}

__device__ __forceinline__ void p9_ln1_router(const Frame& F, const bool dry) {
    LAS float* wrT = (LAS float*)F.lds;
    LAS float* lg = (LAS float*)(F.lds + 131072);
    LAS float* brs = (LAS float*)(F.lds + 131072 + 4096);
    LAS int* hist = (LAS int*)(F.lds + 131072 + 4096 + 128);
    for (int i = F.tid; i < 32768; i += NTHR) { const int k = i >> 5, e = i & 31; wrT[e * 1024 + k] = F.in[I_WR][i]; }
    if (F.tid < 32) brs[F.tid] = F.in[I_BR][F.tid];
    if (F.tid < NCH * 32) hist[F.tid] = 0;
    __syncthreads();
    const bf16_t* V = (const bf16_t*)F.out; bf16_t* X1 = (bf16_t*)(F.ws + WS_X1); unsigned char* U2 = (unsigned char*)(F.ws + WS_U); const float* ada = (const float*)(F.ws + WS_ADA);
    int* topi = (int*)(F.ws + WS_TOPI); float* topw = (float*)(F.ws + WS_TOPW);
    const int l4 = F.lane * 4;
    for (int g = F.c * 8 + F.wave; g < T / 4; g += F.G * 8) {
        const int t0 = g * 4, b = t0 >> 11;
        f32x4 xv[4][4];
#pragma unroll
        for (int tk = 0; tk < 4; ++tk)
#pragma unroll
            for (int j = 0; j < 4; ++j) { const u32x2 w = *(const u32x2*)(V + (size_t)(t0 + tk) * 1024 + 256 * j + l4); xv[tk][j] = (f32x4){bf_lo(w.x), bf_hi(w.x), bf_lo(w.y), bf_hi(w.y)}; }
        float mean[4], rstd[4];
#pragma unroll
        for (int tk = 0; tk < 4; ++tk) { float s = 0.f;
#pragma unroll
            for (int j = 0; j < 4; ++j) s += (xv[tk][j][0] + xv[tk][j][1]) + (xv[tk][j][2] + xv[tk][j][3]);
            s = wave_sum(s); mean[tk] = s * (1.0f / 1024.0f); float q = 0.f;
#pragma unroll
            for (int j = 0; j < 4; ++j) { const f32x4 d = xv[tk][j] - mean[tk]; q += (d[0] * d[0] + d[1] * d[1]) + (d[2] * d[2] + d[3] * d[3]); }
            q = wave_sum(q); rstd[tk] = __builtin_amdgcn_rsqf(q * (1.0f / 1024.0f) + LN_EPS); }
#pragma unroll
        for (int j = 0; j < 4; ++j) {
            const int k = 256 * j + l4;
            const f32x4 lg1 = *(const f32x4*)(F.in[I_LN1G] + k), lb1 = *(const f32x4*)(F.in[I_LN1B] + k);
            const f32x4 sh = *(const f32x4*)(ada + (size_t)b * 6144 + 3072 + k), sc = *(const f32x4*)(ada + (size_t)b * 6144 + 4096 + k);
#pragma unroll
            for (int tk = 0; tk < 4; ++tk) { const f32x4 x1 = (xv[tk][j] - mean[tk]) * rstd[tk] * lg1 + lb1;
                if (!dry) *(u32x2*)(X1 + (size_t)(t0 + tk) * 1024 + k) = (u32x2){cvt_pk_bf16(x1[0], x1[1]), cvt_pk_bf16(x1[2], x1[3])};
                const f32x4 u2 = x1 * (sc + 1.0f) + sh; xv[tk][j] = u2;
                if (!dry) *(unsigned*)(U2 + (size_t)(t0 + tk) * 1024 + k) = cvt_pk4_fp8(u2[0], u2[1], u2[2], u2[3]); } }
#pragma unroll 1
        for (int eq = 0; eq < 4; ++eq) {
            float acc[4][8];
#pragma unroll
            for (int e = 0; e < 8; ++e) { acc[0][e] = 0.f; acc[1][e] = 0.f; acc[2][e] = 0.f; acc[3][e] = 0.f;
#pragma unroll
                for (int j = 0; j < 4; ++j) { const f32x4 w4 = *(const LAS f32x4*)(wrT + (eq * 8 + e) * 1024 + 256 * j + l4);
#pragma unroll
                    for (int tk = 0; tk < 4; ++tk) acc[tk][e] += (xv[tk][j][0] * w4[0] + xv[tk][j][1] * w4[1]) + (xv[tk][j][2] * w4[2] + xv[tk][j][3] * w4[3]); }
                if (e & 1) __builtin_amdgcn_sched_barrier(0); }
#pragma unroll
            for (int tk = 0; tk < 4; ++tk) {
                float v0, v1, v2, v3;
                { const bool up = (F.lane & 32) != 0;
                  v0 = (up ? acc[tk][4] : acc[tk][0]) + __shfl_xor(up ? acc[tk][0] : acc[tk][4], 32);
                  v1 = (up ? acc[tk][5] : acc[tk][1]) + __shfl_xor(up ? acc[tk][1] : acc[tk][5], 32);
                  v2 = (up ? acc[tk][6] : acc[tk][2]) + __shfl_xor(up ? acc[tk][2] : acc[tk][6], 32);
                  v3 = (up ? acc[tk][7] : acc[tk][3]) + __shfl_xor(up ? acc[tk][3] : acc[tk][7], 32); }
                { const bool up = (F.lane & 16) != 0;
                  const float a0 = (up ? v2 : v0) + __shfl_xor(up ? v0 : v2, 16), a1 = (up ? v3 : v1) + __shfl_xor(up ? v1 : v3, 16); v0 = a0; v1 = a1; }
                { const bool up = (F.lane & 8) != 0; v0 = (up ? v1 : v0) + __shfl_xor(up ? v0 : v1, 8); }
                v0 += __shfl_xor(v0, 4); v0 += __shfl_xor(v0, 2); v0 += __shfl_xor(v0, 1);
                const int e = eq * 8 + ((F.lane >> 5) & 1) * 4 + ((F.lane >> 4) & 1) * 2 + ((F.lane >> 3) & 1);
                if ((F.lane & 7) == 0) lg[(F.wave * 4 + tk) * 32 + e] = v0 + brs[e];
            }
        }
        asm volatile("s_waitcnt lgkmcnt(0)" ::: "memory");
        if (F.lane < 4) {
            const LAS float* L = lg + (F.wave * 4 + F.lane) * 32;
            float b0 = -3.0e38f, b1 = -3.0e38f, b2 = -3.0e38f, b3 = -3.0e38f; int i0 = 0, i1 = 0, i2 = 0, i3 = 0;
            for (int e = 0; e < 32; ++e) { const float x = L[e];
                if (x > b3) { b3 = x; i3 = e;
                    if (b3 > b2) { float tf = b2; b2 = b3; b3 = tf; int ti = i2; i2 = i3; i3 = ti;
                        if (b2 > b1) { tf = b1; b1 = b2; b2 = tf; ti = i1; i1 = i2; i2 = ti;
                            if (b1 > b0) { tf = b0; b0 = b1; b1 = tf; ti = i0; i0 = i1; i1 = ti; } } } } }
            const float p1 = fast_exp(b1 - b0), p2 = fast_exp(b2 - b0), p3 = fast_exp(b3 - b0), inv = 1.0f / (1.0f + p1 + p2 + p3);
            const int t = t0 + F.lane;
            *(int4*)(topi + (size_t)t * 4) = make_int4(i0, i1, i2, i3);
            *(f32x4*)(topw + (size_t)t * 4) = (f32x4){inv, p1 * inv, p2 * inv, p3 * inv};
            const int ch = t / TCH;
            if (!dry) { atomicAdd((int*)(hist + ch * 32 + i0), 1); atomicAdd((int*)(hist + ch * 32 + i1), 1); atomicAdd((int*)(hist + ch * 32 + i2), 1); atomicAdd((int*)(hist + ch * 32 + i3), 1); }
        }
    }
    __syncthreads();
    if (F.tid < NCH * 32) { const int h = hist[F.tid]; if (h && !dry) atomicAdd(F.ctl + CW_CNT + F.tid, (unsigned)h); }
    __syncthreads();
}

__device__ __forceinline__ void p10_dispatch(const Frame& F) {
    LAS int* lcnt = (LAS int*)F.lds; LAS int* lbase = lcnt + 32; LAS int* pstart = lcnt + 64;
    const int* topi = (const int*)(F.ws + WS_TOPI); int* pos = (int*)(F.ws + WS_POS); int* rowtok = (int*)(F.ws + WS_ROWTOK);
    for (int s = F.c; s < T / 256; s += F.G) {
        const int ch = (s * 256) / TCH;
        __syncthreads();
        if (F.tid < 32) { lcnt[F.tid] = 0; int ps = 0; for (int e = 0; e < F.tid; ++e) { const int n = (int)__hip_atomic_load(F.ctl + CW_CNT + ch * 32 + e, __ATOMIC_RELAXED, __HIP_MEMORY_SCOPE_AGENT); ps += (n + 255) & ~255; } pstart[F.tid] = ps; }
        __syncthreads();
        int e2[2], r2[2];
#pragma unroll
        for (int i = 0; i < 2; ++i) { const int a = F.tid + i * NTHR; e2[i] = topi[(size_t)(s * 256) * 4 + a]; r2[i] = atomicAdd((int*)(lcnt + e2[i]), 1); }
        __syncthreads();
        if (F.tid < 32) lbase[F.tid] = (int)atomicAdd(F.ctl + CW_CUR + ch * 32 + F.tid, (unsigned)lcnt[F.tid]);
        __syncthreads();
#pragma unroll
        for (int i = 0; i < 2; ++i) { const int a = F.tid + i * NTHR, slot = pstart[e2[i]] + lbase[e2[i]] + r2[i];
            pos[(size_t)(s * 256) * 4 + a] = slot; rowtok[(size_t)ch * ROWS_CH + slot] = s * 256 + (a >> 2); }
    }
}
__device__ __forceinline__ int moe_blocks(const Frame& F, int ch, LAS unsigned char* blk_e) {
    LAS int* sh = (LAS int*)(blk_e + 1152);
    __syncthreads();
    if (F.tid == 0) { int nb = 0; for (int e = 0; e < 32; ++e) { const int n = ((int)__hip_atomic_load(F.ctl + CW_CNT + ch * 32 + e, __ATOMIC_RELAXED, __HIP_MEMORY_SCOPE_AGENT) + 255) >> 8; for (int i = 0; i < n; ++i) blk_e[nb + i] = (unsigned char)e; nb += n; } sh[0] = nb; }
    __syncthreads();
    return sh[0];
}

__device__ __forceinline__ void p13_combine_ln2(const Frame& F, int ch, const bool dry) {
    const unsigned char* YC = (const unsigned char*)(F.ws + WS_YCH); const int* pos = (const int*)(F.ws + WS_POS); const float* topw = (const float*)(F.ws + WS_TOPW);
    const float* ada = (const float*)(F.ws + WS_ADA); const bf16_t* X1 = (const bf16_t*)(F.ws + WS_X1); float* O = F.out;
    const int l8 = F.lane * 8;
    for (int t0 = ch * TCH + F.c * 8 + F.wave; t0 < (ch + 1) * TCH; t0 += 2 * F.G * 8) {
        int tt[2]; tt[0] = t0; tt[1] = t0 + F.G * 8; const bool two = tt[1] < (ch + 1) * TCH; if (!two) tt[1] = t0;
        f32x4 v[2][2][2];
#pragma unroll
        for (int q = 0; q < 2; ++q) { const int t = tt[q], b = t >> 11;
            const int4 ps = *(const int4*)(pos + (size_t)t * 4); const f32x4 tw = *(const f32x4*)(topw + (size_t)t * 4);
#pragma unroll
            for (int j = 0; j < 2; ++j) { const int k = 512 * j + l8;
                const u32x2 y0 = *(const u32x2*)(YC + (size_t)ps.x * 1024 + k), y1 = *(const u32x2*)(YC + (size_t)ps.y * 1024 + k), y2 = *(const u32x2*)(YC + (size_t)ps.z * 1024 + k), y3 = *(const u32x2*)(YC + (size_t)ps.w * 1024 + k);
                const u32x4 xw = *(const u32x4*)(X1 + (size_t)t * 1024 + k);
                const f32x4 g2a = *(const f32x4*)(ada + (size_t)b * 6144 + 5120 + k), g2b = *(const f32x4*)(ada + (size_t)b * 6144 + 5120 + k + 4);
                const f32x4 ffa = fp8x4_to_f32(y0.x) * tw[0] + fp8x4_to_f32(y1.x) * tw[1] + fp8x4_to_f32(y2.x) * tw[2] + fp8x4_to_f32(y3.x) * tw[3];
                const f32x4 ffb = fp8x4_to_f32(y0.y) * tw[0] + fp8x4_to_f32(y1.y) * tw[1] + fp8x4_to_f32(y2.y) * tw[2] + fp8x4_to_f32(y3.y) * tw[3];
                v[q][j][0] = (f32x4){bf_lo(xw.x), bf_hi(xw.x), bf_lo(xw.y), bf_hi(xw.y)} * DN_ALPHA + g2a * ffa;
                v[q][j][1] = (f32x4){bf_lo(xw.z), bf_hi(xw.z), bf_lo(xw.w), bf_hi(xw.w)} * DN_ALPHA + g2b * ffb; } }
#pragma unroll
        for (int q = 0; q < 2; ++q) { const int t = tt[q];
            float s = 0.f;
#pragma unroll
            for (int j = 0; j < 2; ++j)
#pragma unroll
                for (int h = 0; h < 2; ++h) s += (v[q][j][h][0] + v[q][j][h][1]) + (v[q][j][h][2] + v[q][j][h][3]);
            s = wave_sum(s); const float mean = s * (1.0f / 1024.0f); float qq = 0.f;
#pragma unroll
            for (int j = 0; j < 2; ++j)
#pragma unroll
                for (int h = 0; h < 2; ++h) { const f32x4 d = v[q][j][h] - mean; qq += (d[0] * d[0] + d[1] * d[1]) + (d[2] * d[2] + d[3] * d[3]); }
            qq = wave_sum(qq); const float rstd = __builtin_amdgcn_rsqf(qq * (1.0f / 1024.0f) + LN_EPS);
            if (q == 0 || two) {
#pragma unroll
                for (int j = 0; j < 2; ++j)
#pragma unroll
                    for (int h = 0; h < 2; ++h) { const int k = 512 * j + l8 + 4 * h; const f32x4 g = *(const f32x4*)(F.in[I_LN2G] + k), bb = *(const f32x4*)(F.in[I_LN2B] + k);
                        const f32x4 o4 = (v[q][j][h] - mean) * rstd * g + bb;
                        if (!dry) *(f32x4*)(O + (size_t)t * 1024 + k) = o4; else if (o4[0] == 1.2345e30f) O[0] = 1.f; } }
        }
    }
}

constexpr int SC_QD = 0, SC_KI = 17408, SC_KE = 34816, SC_VT = 53248, SC_SC = 71680, SC_ST = 80896, SC_GV = 115712, SC_CS = 116224;
__device__ __forceinline__ bf16x8 ldfrag(const LAS unsigned char* p) { return *(const LAS bf16x8*)p; }
__device__ __forceinline__ void p3_scan(const Frame& F, const bool dry) {
    LAS unsigned char* L = F.lds;
    const int tid = F.tid, w = F.wave, lane = F.lane, fr = lane & 15, fq = lane >> 4;
    const int d = tid & 127, qd = tid >> 7;
    bf16_t* PH = (bf16_t*)(F.ws + WS_PH); const bf16_t* PHC = (const bf16_t*)(F.ws + WS_PHC);
    for (int it = F.c; it < 256; it += F.G) {
        const int b = it >> 3, h = (it >> 1) & 3, dir = it & 1;
        const float r0 = F.in[I_LBRAW][dir * 512 + h * 128 + d], r1 = F.in[I_LBRAW][1024 + dir * 512 + h * 128 + d];
        const float lbv = fast_sigmoid(r0 - r1), oml = 1.0f - lbv;
        f32x4 Sacc[8];
#pragma unroll
        for (int i = 0; i < 8; ++i) Sacc[i] = (f32x4){0.f, 0.f, 0.f, 0.f};
        __syncthreads();
        for (int i = tid; i < 34816 / 4; i += NTHR) ((LAS unsigned*)(L + SC_ST))[i] = 0u;
        const int cq = h * 128 + d, cz = 512 + dir * 512 + h * 128 + d, cv = 1536 + h * 128 + d;
        bf16_t rq[16], rz[16], rv[16];
        {   const int n = dir ? 3 : 0; const bf16_t* base = PHC + (size_t)(b * 256 + 64 * n + 16 * qd) * 2048;
#pragma unroll
            for (int i = 0; i < 16; ++i) { rq[i] = base[(size_t)i * 2048 + cq]; rz[i] = base[(size_t)i * 2048 + cz]; rv[i] = base[(size_t)i * 2048 + cv]; } }
        for (int s = 0; s < 36; ++s) {
            const bool lat = s >= 4; const int n = lat ? (dir ? 31 - (s - 4) : (s - 4)) : (dir ? 3 - s : s);
            float kk[16], cum[16]; float run = 0.f;
#pragma unroll
            for (int i = 0; i < 16; ++i) { const float sg = fast_sigmoid(bf2f(rz[i])); kk[i] = oml * (1.0f - sg); cum[i] = fast_log(lbv + oml * sg); }
            if (dir == 0) {
#pragma unroll
                for (int i = 0; i < 16; ++i) { run += cum[i]; cum[i] = run; }
            } else {
#pragma unroll
                for (int i = 15; i >= 0; --i) { run += cum[i]; cum[i] = run; }
            }
            ((LAS float*)(L + SC_CS))[qd * 128 + d] = run;
            __syncthreads();
            {   const LAS float* cs = (const LAS float*)(L + SC_CS);
                const float c0 = cs[d], c1 = cs[128 + d], c2 = cs[256 + d], c3 = cs[384 + d], tot = (c0 + c1) + (c2 + c3);
                float off;
                if (dir == 0) off = (qd > 0 ? c0 : 0.f) + (qd > 1 ? c1 : 0.f) + (qd > 2 ? c2 : 0.f);
                else off = (qd < 3 ? c3 : 0.f) + (qd < 2 ? c2 : 0.f) + (qd < 1 ? c1 : 0.f);
                const float g = fast_exp(tot);
                if (qd == 0) ((LAS float*)(L + SC_GV))[d] = g;
                unsigned ke[8], vt[8];
#pragma unroll
                for (int i = 0; i < 16; i += 2) {
                    const float ca = cum[i] + off, cb = cum[i + 1] + off;
                    const float ea = fast_exp(ca), eb = fast_exp(cb), ia = __builtin_amdgcn_rcpf(ea), ib = __builtin_amdgcn_rcpf(eb);
                    const float qa = bf2f(rq[i]), qb = bf2f(rq[i + 1]);
                    const float qda = qa * fast_sigmoid(qa) * ea, qdb = qb * fast_sigmoid(qb) * eb;
                    const float kia = kk[i] * ia, kib = kk[i + 1] * ib;
                    const unsigned wa = cvt_pk_bf16(qda, kia), wb = cvt_pk_bf16(qdb, kib);
                    *(LAS bf16_t*)(L + SC_QD + (16 * qd + i) * 272 + d * 2) = (bf16_t)(wa & 0xffffu);
                    *(LAS bf16_t*)(L + SC_KI + (16 * qd + i) * 272 + d * 2) = (bf16_t)(wa >> 16);
                    *(LAS bf16_t*)(L + SC_QD + (16 * qd + i + 1) * 272 + d * 2) = (bf16_t)(wb & 0xffffu);
                    *(LAS bf16_t*)(L + SC_KI + (16 * qd + i + 1) * 272 + d * 2) = (bf16_t)(wb >> 16);
                    ke[i >> 1] = cvt_pk_bf16(kia * g, kib * g);
                    vt[i >> 1] = (unsigned)rv[i] | ((unsigned)rv[i + 1] << 16);
                }
                *(LAS u32x4*)(L + SC_KE + d * 144 + 32 * qd) = (u32x4){ke[0], ke[1], ke[2], ke[3]};
                *(LAS u32x4*)(L + SC_KE + d * 144 + 32 * qd + 16) = (u32x4){ke[4], ke[5], ke[6], ke[7]};
                *(LAS u32x4*)(L + SC_VT + d * 144 + 32 * qd) = (u32x4){vt[0], vt[1], vt[2], vt[3]};
                *(LAS u32x4*)(L + SC_VT + d * 144 + 32 * qd + 16) = (u32x4){vt[4], vt[5], vt[6], vt[7]};
            }
            if (s + 1 < 36) {
                const int s1 = s + 1; const bool lat1 = s1 >= 4; const int n1 = lat1 ? (dir ? 31 - (s1 - 4) : (s1 - 4)) : (dir ? 3 - s1 : s1);
                const bf16_t* base = lat1 ? (const bf16_t*)PH + (size_t)(b * 2048 + 64 * n1 + 16 * qd) * 2048 : PHC + (size_t)(b * 256 + 64 * n1 + 16 * qd) * 2048;
#pragma unroll
                for (int i = 0; i < 16; ++i) { rq[i] = base[(size_t)i * 2048 + cq]; rz[i] = base[(size_t)i * 2048 + cz]; rv[i] = base[(size_t)i * 2048 + cv]; }
            }
            __syncthreads();
            f32x4 oacc[4];
#pragma unroll
            for (int i = 0; i < 4; ++i) oacc[i] = (f32x4){0.f, 0.f, 0.f, 0.f};
            const int kb = fq * 16;
            if (lat) {
                const int ct = w >> 1, st0 = 2 * (w & 1);
#pragma unroll
                for (int j = 0; j < 2; ++j) { const int st = st0 + j; f32x4 sa = (f32x4){0.f, 0.f, 0.f, 0.f};
#pragma unroll
                    for (int ks = 0; ks < 4; ++ks) sa = __builtin_amdgcn_mfma_f32_16x16x32_bf16(ldfrag(L + SC_KI + (16 * st + fr) * 272 + ks * 64 + kb), ldfrag(L + SC_QD + (16 * ct + fr) * 272 + ks * 64 + kb), sa, 0, 0, 0);
                    const int cc = 16 * ct + fr, s0 = 16 * st + 4 * fq;
#pragma unroll
                    for (int i = 0; i < 4; ++i) { const bool keep = dir ? (s0 + i >= cc) : (s0 + i <= cc); sa[i] = keep ? sa[i] : 0.f; }
                    *(LAS u32x2*)(L + SC_SC + cc * 144 + s0 * 2) = (u32x2){cvt_pk_bf16(sa[0], sa[1]), cvt_pk_bf16(sa[2], sa[3])}; }
#pragma unroll
                for (int ct2 = 0; ct2 < 4; ++ct2)
#pragma unroll
                    for (int ks = 0; ks < 4; ++ks) oacc[ct2] = __builtin_amdgcn_mfma_f32_16x16x32_bf16(ldfrag(L + SC_ST + (16 * w + fr) * 272 + ks * 64 + kb), ldfrag(L + SC_QD + (16 * ct2 + fr) * 272 + ks * 64 + kb), oacc[ct2], 0, 0, 0);
            }
            {   const bf16x8 v0 = ldfrag(L + SC_VT + (16 * w + fr) * 144 + kb), v1 = ldfrag(L + SC_VT + (16 * w + fr) * 144 + 64 + kb);
#pragma unroll
                for (int dt = 0; dt < 8; ++dt) { const f32x4 gv = *(const LAS f32x4*)(L + SC_GV + (16 * dt + 4 * fq) * 4);
                    f32x4 a = Sacc[dt] * gv;
                    a = __builtin_amdgcn_mfma_f32_16x16x32_bf16(ldfrag(L + SC_KE + (16 * dt + fr) * 144 + kb), v0, a, 0, 0, 0);
                    a = __builtin_amdgcn_mfma_f32_16x16x32_bf16(ldfrag(L + SC_KE + (16 * dt + fr) * 144 + 64 + kb), v1, a, 0, 0, 0);
                    Sacc[dt] = a; } }
            __syncthreads();
#pragma unroll
            for (int dt = 0; dt < 8; ++dt) *(LAS u32x2*)(L + SC_ST + (16 * w + fr) * 272 + (16 * dt + 4 * fq) * 2) = (u32x2){cvt_pk_bf16(Sacc[dt][0], Sacc[dt][1]), cvt_pk_bf16(Sacc[dt][2], Sacc[dt][3])};
            if (lat) {
                const bf16x8 v0 = ldfrag(L + SC_VT + (16 * w + fr) * 144 + kb), v1 = ldfrag(L + SC_VT + (16 * w + fr) * 144 + 64 + kb);
                bf16_t* ob = PH + (size_t)(b * 2048 + 64 * n) * 2048 + 512 + dir * 512 + h * 128 + 16 * w + 4 * fq;
#pragma unroll
                for (int ct2 = 0; ct2 < 4; ++ct2) {
                    f32x4 a = oacc[ct2];
                    a = __builtin_amdgcn_mfma_f32_16x16x32_bf16(v0, ldfrag(L + SC_SC + (16 * ct2 + fr) * 144 + kb), a, 0, 0, 0);
                    a = __builtin_amdgcn_mfma_f32_16x16x32_bf16(v1, ldfrag(L + SC_SC + (16 * ct2 + fr) * 144 + 64 + kb), a, 0, 0, 0);
                    if (!dry) *(u32x2*)(ob + (size_t)(16 * ct2 + fr) * 2048) = (u32x2){cvt_pk_bf16(a[0], a[1]), cvt_pk_bf16(a[2], a[3])};
                    else if (a[0] == 1.2345e30f) ob[0] = 1; }
            }
        }
        __syncthreads();
    }
}

typedef short s16x4 __attribute__((ext_vector_type(4)));
__device__ __forceinline__ s16x4 tr_read(unsigned lds_addr) { s16x4 r; asm volatile("ds_read_b64_tr_b16 %0, %1\n\ts_waitcnt lgkmcnt(0)" : "=&v"(r) : "v"(lds_addr) : "memory"); return r; }
__device__ __forceinline__ bf16x8 cat4(s16x4 a, s16x4 b) { return (bf16x8){a[0], a[1], a[2], a[3], b[0], b[1], b[2], b[3]}; }
constexpr int FO_C = 131072, FO_S = 139264;
__device__ __forceinline__ void p4_fourier(const Frame& F) {
    LAS unsigned char* L = F.lds;
    const int tid = F.tid, w = F.wave, lane = F.lane, fr = lane & 15, fq = lane >> 4;
    const bf16_t* PA = (const bf16_t*)(F.ws + WS_PA); bf16_t* Y = (bf16_t*)(F.ws + WS_Y);
    __syncthreads();
    for (int i = tid; i < 4096; i += NTHR) { const int k2 = i >> 6, c = i & 63; const float a = (float)((k2 * c) & 63) * (1.0f / 64.0f);
        *(LAS bf16_t*)(L + FO_C + i * 2) = (bf16_t)(cvt_pk_bf16(__builtin_amdgcn_cosf(a) * 0.125f, 0.f) & 0xffffu);
        *(LAS bf16_t*)(L + FO_S + i * 2) = (bf16_t)(cvt_pk_bf16(__builtin_amdgcn_sinf(a) * 0.125f, 0.f) & 0xffffu); }
    bf16x8 Gf[2][2];
#pragma unroll
    for (int nt = 0; nt < 2; ++nt)
#pragma unroll
        for (int ks = 0; ks < 2; ++ks) { unsigned pk[4];
#pragma unroll
            for (int j = 0; j < 8; j += 2) { const int k1 = 16 * nt + fr, ra = 8 * fq + j, rb = ra + 1; const float aa = (float)((k1 * ra) & 31) * (1.0f / 32.0f), ab = (float)((k1 * rb) & 31) * (1.0f / 32.0f);
                const float va = (ks ? __builtin_amdgcn_sinf(aa) : __builtin_amdgcn_cosf(aa)) * 0.17677669529663687f, vb = (ks ? __builtin_amdgcn_sinf(ab) : __builtin_amdgcn_cosf(ab)) * 0.17677669529663687f;
                pk[j >> 1] = cvt_pk_bf16(va, vb); }
            u32x4 t4 = (u32x4){pk[0], pk[1], pk[2], pk[3]}; Gf[nt][ks] = *(bf16x8*)&t4; }
    const unsigned lbase = (unsigned)(size_t)L;
    for (int it = F.c; it < 1024; it += F.G) {
        const int xcd = it & 7, jj = it >> 3, slab = 4 * xcd + (jj & 3), b = jj >> 2;
        __syncthreads();
        {   u32x4 v[16];
#pragma unroll
            for (int n = 0; n < 16; ++n) { const int q = tid + NTHR * n, t = q >> 2, reim = (q >> 1) & 1, half = q & 1;
                v[n] = *(const u32x4*)(PA + (size_t)(b * 2048 + t) * 1024 + reim * 512 + slab * 16 + half * 8); }
#pragma unroll
            for (int n = 0; n < 16; ++n) *(LAS u32x4*)(L + (tid + NTHR * n) * 16) = v[n]; }
        __syncthreads();
#pragma unroll 1
        for (int rr = 0; rr < 4; ++rr) {
            const int r = w + 8 * rr;
            f32x4 acc[8];
#pragma unroll
            for (int i = 0; i < 8; ++i) acc[i] = (f32x4){0.f, 0.f, 0.f, 0.f};
#pragma unroll
            for (int ks = 0; ks < 4; ++ks) {
                const int ri = ks >> 1, c0 = 32 * (ks & 1) + 8 * fq + (fr >> 2);
                const unsigned a0 = lbase + (unsigned)((r * 64 + c0) * 64 + ri * 32 + (fr & 3) * 8);
                const bf16x8 af = cat4(tr_read(a0), tr_read(a0 + 4 * 64));
#pragma unroll
                for (int nt = 0; nt < 8; ++nt) { const int ro = nt >> 2, k2 = 16 * (nt & 3) + fr;
                    u32x4 bw = *(const LAS u32x4*)(L + ((ro == ri) ? FO_C : FO_S) + (k2 * 64 + 32 * (ks & 1) + 8 * fq) * 2);
                    if (ro == 1 && ri == 0) { bw.x ^= 0x80008000u; bw.y ^= 0x80008000u; bw.z ^= 0x80008000u; bw.w ^= 0x80008000u; }
                    acc[nt] = __builtin_amdgcn_mfma_f32_16x16x32_bf16(af, *(bf16x8*)&bw, acc[nt], 0, 0, 0); }
            }
#pragma unroll
            for (int nt = 0; nt < 8; ++nt) { const int ro = nt >> 2, k2 = 16 * (nt & 3) + fr;
                *(LAS u32x2*)(L + (r * 64 + k2) * 64 + ro * 32 + fq * 8) = (u32x2){cvt_pk_bf16(acc[nt][0], acc[nt][1]), cvt_pk_bf16(acc[nt][2], acc[nt][3])}; }
        }
        __syncthreads();
#pragma unroll 1
        for (int kk = 0; kk < 8; ++kk) {
            const int k2 = 8 * w + kk;
            f32x4 a2[2] = {(f32x4){0.f, 0.f, 0.f, 0.f}, (f32x4){0.f, 0.f, 0.f, 0.f}};
#pragma unroll
            for (int ks = 0; ks < 2; ++ks) {
                const int r0 = 8 * fq + (fr >> 2);
                const unsigned a0 = lbase + (unsigned)((r0 * 64 + k2) * 64 + ks * 32 + (fr & 3) * 8);
                const bf16x8 af = cat4(tr_read(a0), tr_read(a0 + 4 * 64 * 64));
                a2[0] = __builtin_amdgcn_mfma_f32_16x16x32_bf16(af, Gf[0][ks], a2[0], 0, 0, 0);
                a2[1] = __builtin_amdgcn_mfma_f32_16x16x32_bf16(af, Gf[1][ks], a2[1], 0, 0, 0);
            }
#pragma unroll
            for (int nt = 0; nt < 2; ++nt) { const int k1 = 16 * nt + fr;
                *(u32x2*)(Y + (size_t)(b * 2048 + k1 * 64 + k2) * 1024 + slab * 16 + 4 * fq) = (u32x2){cvt_pk_bf16(a2[nt][0], a2[nt][1]), cvt_pk_bf16(a2[nt][2], a2[nt][3])}; }
        }
    }
    __syncthreads();
}

struct Args { const float* in[22]; float* out; unsigned char* ws; int ph_lo, ph_hi; };
constexpr int N_PHASES = 9 + 3 * NCH;

__global__ void __launch_bounds__(NTHR, 2) mega_fwd(Args args) {
    extern __shared__ __attribute__((aligned(16))) unsigned char lds_raw[];
    Frame F;
    F.lds = (LAS unsigned char*)lds_raw;
    F.tid = threadIdx.x; F.lane = F.tid & 63; F.wave = __builtin_amdgcn_readfirstlane(F.tid >> 6);
    F.G = gridDim.x; F.c = blockIdx.x;
    F.in = args.in;
    F.out = args.out; F.ws = args.ws; F.ctl = (unsigned*)(args.ws + WS_CTL);
    volatile LAS unsigned* misc = (volatile LAS unsigned*)(F.lds + LDS_MISC);
    if (F.tid < 4) misc[F.tid] = 0u;
    __syncthreads();
    XcdBarrier bar = xcd_barrier_post(F.ctl, misc);
    const int lo = args.ph_lo, hi = args.ph_hi;
#ifndef PHASE_MASK
#define PHASE_MASK 0xFFFFFFFFu
#endif
#define IN(k) ((((PHASE_MASK) >> (k)) & 1u) && lo <= (k) && (k) < hi)
#define SEAM(k) do { if (IN(k) && IN((k) + 1)) xcd_barrier(bar); } while (0)
#ifndef REP_MASK
#define REP_MASK 0u
#endif
#define REPS(b) ((((REP_MASK) >> (b)) & 1u) ? 2 : 1)
#define REPBAR(b, r) do { if ((((REP_MASK) >> (b)) & 1u) && (r) == 0) xcd_barrier(bar); } while (0)
    unsigned char* ws = F.ws;
    LAS unsigned char* blk_e = F.lds + LDS_MISC + 64;

    if (IN(0)) { for (int r = 0; r < REPS(0); ++r) { p0_ada(F); p0_fold(F); p0_convert(F); REPBAR(0, r); } }
    SEAM(0);
    if (IN(1)) { for (int r = 0; r < REPS(1); ++r) { p1_uprep(F); REPBAR(1, r); } }
    SEAM(1);
    if (IN(2)) {
        ProbP1 P{(const char*)(ws + WS_U), 8, 1024u, 1024u, (const char*)(ws + WS_WIN1T), (unsigned)(WS_UC - WS_U), F.G, F.c};
        EpiP1 E{(bf16_t*)(ws + WS_PA), (bf16_t*)(ws + WS_PH), (bf16_t*)(ws + WS_PHC)};
        for (int r = 0; r < REPS(2); ++r) { pg8::gemm_phase<ProbP1, EpiP1, true, false, true>(F.lds, P, E); REPBAR(2, r); }
    }
    SEAM(2);
    if (IN(3)) {
#ifndef NO_SCAN
        for (int r = 0; r < REPS(3); ++r) { p3_scan(F, r + 1 < REPS(3)); REPBAR(3, r); }
#endif
#ifndef NO_FOURIER
        for (int r = 0; r < REPS(4); ++r) { p4_fourier(F); REPBAR(4, r); }
#endif
#ifndef NO_P2GEMM
        ProbDense P{(const char*)(ws + WS_U), 8, 1024u, 1024u, (const char*)(ws + WS_WIN2T), 256, 10, F.G, F.c};
        EpiP2 E{(bf16_t*)(ws + WS_PG), (bf16_t*)F.out};
        for (int r = 0; r < REPS(5); ++r) { pg8::gemm_phase<ProbDense, EpiP2, true, false, true>(F.lds, P, E); REPBAR(5, r); }
#endif
    }
    SEAM(3);
    if (IN(4)) { for (int r = 0; r < REPS(6); ++r) { p6_readout(F); REPBAR(6, r); } }
    SEAM(4);
    if (IN(5)) {
        ProbDense P{(const char*)(ws + WS_Y), 16, 2048u, 2048u, (const char*)(ws + WS_WMT), 256, 4, F.G, F.c};
        EpiM1 E{(const bf16_t*)F.out, (bf16_t*)(ws + WS_PA)};
        for (int r = 0; r < REPS(7); ++r) { pg8::gemm_phase<ProbDense, EpiM1, true, true>(F.lds, P, E); REPBAR(7, r); }
    }
    SEAM(5);
    if (IN(6)) {
        ProbDense P{(const char*)(ws + WS_PA), 16, 2048u, 2048u, (const char*)(ws + WS_WOT), 256, 4, F.G, F.c};
        EpiM2 E{F.in[I_X], (const float*)(ws + WS_ADA), (bf16_t*)F.out};
        for (int r = 0; r < REPS(8); ++r) { pg8::gemm_phase<ProbDense, EpiM2, true, false>(F.lds, P, E); REPBAR(8, r); }
    }
    SEAM(6);
    if (IN(7)) { for (int r = 0; r < REPS(9); ++r) { p9_ln1_router(F, r + 1 < REPS(9)); REPBAR(9, r); } }
    SEAM(7);
    if (IN(8)) { p10_dispatch(F); }
    SEAM(8);
#pragma unroll
    for (int ch = 0; ch < NCH; ++ch) {
        if (IN(9 + 3 * ch)) {
            const int nblk = moe_blocks(F, ch, blk_e);
            ProbMoE<true> P{(const char*)(ws + WS_U), 8, 1024u, 1024u, (const char*)(ws + WS_WGUT), (size_t)2048 * 1024, 8, nblk, F.G, F.c, (const int*)(ws + WS_ROWTOK) + (size_t)ch * ROWS_CH, blk_e};
            EpiGU E{F.in[I_BGU], (unsigned char*)(ws + WS_ACT)};
            for (int r = 0; r < (ch == 0 ? REPS(10) : 1); ++r) { pg8::gemm_phase<ProbMoE<true>, EpiGU, true, false, true>(F.lds, P, E); if (ch == 0) REPBAR(10, r); }
        }
        SEAM(9 + 3 * ch);
        if (IN(10 + 3 * ch)) {
            const int nblk = moe_blocks(F, ch, blk_e);
            ProbMoE<false> P{(const char*)(ws + WS_ACT), 8, 1024u, 1024u, (const char*)(ws + WS_WDNT), (size_t)1024 * 1024, 4, nblk, F.G, F.c, nullptr, blk_e};
            EpiDN E{F.in[I_BDN], (unsigned char*)(ws + WS_YCH)};
            for (int r = 0; r < (ch == 0 ? REPS(11) : 1); ++r) { pg8::gemm_phase<ProbMoE<false>, EpiDN, true, false, true>(F.lds, P, E); if (ch == 0) REPBAR(11, r); }
        }
        SEAM(10 + 3 * ch);
        if (IN(11 + 3 * ch)) { for (int r = 0; r < (ch == 0 ? REPS(12) : 1); ++r) { p13_combine_ln2(F, ch, ch == 0 && r + 1 < REPS(12)); if (ch == 0) REPBAR(12, r); } }
        SEAM(11 + 3 * ch);
    }
#ifdef DBG_K
    xcd_barrier(bar);
    {
        const unsigned char* buf = (DBG_OUT) ? (const unsigned char*)F.out : (const unsigned char*)(ws + (size_t)(DBG_OFF));
        const size_t wpr = (size_t)(DBG_CW) / 4, nw = (size_t)(DBG_ROWS) * wpr;
        unsigned long long cs = 0; unsigned bad = 0;
        for (size_t i = (size_t)F.c * NTHR + F.tid; i < nw; i += (size_t)F.G * NTHR) { const size_t r = i / wpr, cw = i % wpr; const unsigned w = *(const unsigned*)(buf + r * (size_t)(DBG_LD) + (DBG_C0) + cw * 4); cs += w;
            if (DBG_F32) { if ((w & 0x7f800000u) == 0x7f800000u) ++bad; } else { if ((w & 0x7f80u) == 0x7f80u) ++bad; if ((w & 0x7f800000u) == 0x7f800000u) ++bad; } }
        for (int o = 32; o >= 1; o >>= 1) { cs += __shfl_xor(cs, o); bad += __shfl_xor(bad, o); }
        if (F.lane == 0) { atomicAdd((unsigned long long*)(F.ctl + 8192), cs); atomicAdd(F.ctl + 8200, bad); }
        if (F.c == 0 && F.tid == 0) atomicAdd(F.ctl + 8201, xb_ld(&F.ctl[XB_TMO]));
    }
    xcd_barrier(bar);
    {
        const unsigned long long cs = __hip_atomic_load((unsigned long long*)(F.ctl + 8192), __ATOMIC_RELAXED, __HIP_MEMORY_SCOPE_AGENT);
        const unsigned bad = xb_ld(F.ctl + 8200), tmo = xb_ld(F.ctl + 8201);
        const float val = (float)(unsigned)((cs ^ (cs >> 16) ^ (cs >> 32)) & 0xFFFFu) * (1.0f / 65536.0f) + (bad ? 2.0f : 0.0f) + (tmo ? 4.0f : 0.0f);
        for (size_t i = (size_t)F.c * NTHR + F.tid; i < (size_t)T * D; i += (size_t)F.G * NTHR) F.out[i] = val;
    }
    return;
#endif
    if (F.c == 0 && F.tid == 0 && hi == N_PHASES) { if (xb_ld(&F.ctl[XB_TMO]) != 0u) F.out[0] = __builtin_nanf(""); }
#undef IN
#undef SEAM
}

extern "C" void kernel_launch(void* const* d_in, const int* in_sizes, int n_in, void* d_out, int out_size, void* d_ws, size_t ws_size, hipStream_t stream) {
    static int grid = 0;
    if (grid == 0) {
        if (n_in != 22 || out_size != T * D || ws_size < WS_END) { fprintf(stderr, "kernel_launch: unexpected shapes (n_in %d, out %d, ws %zu)\n", n_in, out_size, ws_size); grid = -1; return; }
        int dev = 0, cus = 0, per_cu = 0;
        if (hipGetDevice(&dev) != hipSuccess || hipDeviceGetAttribute(&cus, hipDeviceAttributeMultiprocessorCount, dev) != hipSuccess) { grid = -1; return; }
        if (hipFuncSetAttribute((const void*)mega_fwd, hipFuncAttributeMaxDynamicSharedMemorySize, LDS_BYTES) != hipSuccess) { fprintf(stderr, "kernel_launch: hipFuncSetAttribute failed\n"); grid = -1; return; }
        if (hipOccupancyMaxActiveBlocksPerMultiprocessor(&per_cu, (const void*)mega_fwd, NTHR, LDS_BYTES) != hipSuccess || per_cu < 1) fprintf(stderr, "kernel_launch: occupancy query reports %d blocks per CU\n", per_cu);
        (void)hipGetLastError();
        grid = cus;
    }
    if (grid < 0) return;
    (void)hipMemsetAsync((char*)d_ws + WS_CTL, 0, CTL_BYTES, stream);
    Args a{};
    for (int i = 0; i < 22; ++i) a.in[i] = (const float*)d_in[i];
    a.out = (float*)d_out; a.ws = (unsigned char*)d_ws; a.ph_lo = 0; a.ph_hi = N_PHASES;
#ifdef DBG_K
    a.ph_hi = DBG_K;
#endif
    hipLaunchKernelGGL(mega_fwd, dim3(grid), dim3(NTHR), LDS_BYTES, stream, a);
}
```

```cpp
#include <hip/hip_runtime.h>
#include <cstdio>
#include <cstdint>

#define LAS __attribute__((address_space(3)))
typedef unsigned short bf16_t;
typedef short bf16x8 __attribute__((ext_vector_type(8)));
typedef short bf16x4 __attribute__((ext_vector_type(4)));
typedef float f32x4 __attribute__((ext_vector_type(4)));
typedef float f32x2 __attribute__((ext_vector_type(2)));
typedef unsigned u32x4 __attribute__((ext_vector_type(4)));
typedef unsigned u32x2 __attribute__((ext_vector_type(2)));

constexpr int D = 1024, NB = 32, SEQ = 2048, T = NB * SEQ, CTX = 256, TCX = NB * CTX;
#ifndef NCH_SET
#define NCH_SET 1
#endif
constexpr int NEXP = 32, TOPK = 4;
constexpr int NCH = NCH_SET, TCH = T / NCH;
constexpr int ROWS_CH = TCH * TOPK + NEXP * 256;
constexpr float DN_ALPHA = 1.189207115002721f;
constexpr float LN_EPS = 1e-5f, RMS_EPS = 1e-6f;
constexpr int NTHR = 512;

constexpr size_t MiB = 1ull << 20;
constexpr size_t WS_CTL = 0;
constexpr size_t CTL_BYTES = 65536;
constexpr size_t WS_ADA = 65536;
constexpr size_t WS_WIN1T = 1 * MiB;
constexpr size_t WS_WIN2T = 7 * MiB;
constexpr size_t WS_WMT = 12 * MiB;
constexpr size_t WS_WOT = 14 * MiB;
constexpr size_t WS_WGUT = 16 * MiB;
constexpr size_t WS_WDNT = 80 * MiB;
constexpr size_t WS_TOPI = 112 * MiB;
constexpr size_t WS_TOPW = 113 * MiB;
constexpr size_t WS_POS = 114 * MiB;
constexpr size_t WS_ROWTOK = 115 * MiB;
constexpr size_t WS_U = 120 * MiB;
constexpr size_t WS_PA = 184 * MiB;
constexpr size_t WS_PH = 312 * MiB;
constexpr size_t WS_PHC = 568 * MiB;
constexpr size_t WS_PG = 600 * MiB;
constexpr size_t WS_Y = 664 * MiB;
constexpr size_t WS_UC = WS_Y;
constexpr size_t WS_ACT = WS_PA;
constexpr size_t WS_YCH = WS_PA + 264 * MiB;
constexpr size_t WS_X1 = WS_YCH + 264 * MiB;
constexpr size_t WS_END = 976 * MiB;
static_assert(WS_X1 + 128 * MiB <= WS_END && (size_t)ROWS_CH * 1024 <= 264 * MiB && WS_Y + 128 * MiB <= WS_END, "ws map");
constexpr int CW_CNT = 4096;
constexpr int CW_CUR = 4096 + 64;

constexpr int LDS_SCRATCH = 147456;
constexpr int LDS_MISC = LDS_SCRATCH;
constexpr int LDS_BYTES = LDS_SCRATCH + 2048;

typedef __bf16 bf16x2_t __attribute__((ext_vector_type(2)));
__device__ __forceinline__ unsigned cvt_pk_bf16(float lo, float hi) { const f32x2 v = {lo, hi}; const bf16x2_t r = __builtin_convertvector(v, bf16x2_t); return __builtin_bit_cast(unsigned, r); }
__device__ __forceinline__ unsigned cvt_pk4_fp8(float a, float b, float c, float d) {
    a = fminf(fmaxf(a, -448.f), 448.f); b = fminf(fmaxf(b, -448.f), 448.f); c = fminf(fmaxf(c, -448.f), 448.f); d = fminf(fmaxf(d, -448.f), 448.f);
    int w = __builtin_amdgcn_cvt_pk_fp8_f32(a, b, 0, false); w = __builtin_amdgcn_cvt_pk_fp8_f32(c, d, w, true); return (unsigned)w; }
constexpr float W8_SCALE = 32.0f, W8_INV = 1.0f / 32.0f;
typedef float f32x2v __attribute__((ext_vector_type(2)));
__device__ __forceinline__ f32x4 fp8x4_to_f32(unsigned w) { const f32x2v a = __builtin_amdgcn_cvt_pk_f32_fp8((int)w, false), b = __builtin_amdgcn_cvt_pk_f32_fp8((int)w, true); return (f32x4){a[0], a[1], b[0], b[1]}; }
__device__ __forceinline__ u32x4 widen16(u32x2 a, u32x2 b) {
    const u32x2 rx = __builtin_amdgcn_permlane16_swap(a.x, b.x, false, false), ry = __builtin_amdgcn_permlane16_swap(a.y, b.y, false, false);
    return (u32x4){rx[0], ry[0], rx[1], ry[1]}; }
__device__ __forceinline__ float bf_lo(unsigned w) { return __uint_as_float(w << 16); }
__device__ __forceinline__ float bf_hi(unsigned w) { return __uint_as_float(w & 0xffff0000u); }
__device__ __forceinline__ float bf2f(bf16_t v) { return __uint_as_float(((unsigned)v) << 16); }
__device__ __forceinline__ float fast_exp(float x) { return __builtin_amdgcn_exp2f(x * 1.4426950408889634f); }
__device__ __forceinline__ float fast_sigmoid(float x) { return __builtin_amdgcn_rcpf(1.0f + fast_exp(-x)); }
__device__ __forceinline__ float fast_log(float x) { return __builtin_amdgcn_logf(x) * 0.6931471805599453f; }

#define XB_TMO      128
#define XB_XCNT(j)  (256  + 64 * (j))
#define XB_XSUB(j)  (1280 + 64 * (j))
#define XB_XGEN(j)  (2304 + 64 * (j))
#define XB_TOP      3328
#define XB_TOPGEN   3392
#define XCD_BAR_WORDS 3456
#define XB_SPIN_CAP (1u << 18)

__device__ __forceinline__ unsigned xb_ld(unsigned* p)              { return __hip_atomic_load(p, __ATOMIC_RELAXED, __HIP_MEMORY_SCOPE_AGENT); }
__device__ __forceinline__ unsigned xb_add(unsigned* p, unsigned v) { return __hip_atomic_fetch_add(p, v, __ATOMIC_RELAXED, __HIP_MEMORY_SCOPE_AGENT); }
__device__ __forceinline__ unsigned xb_xcc_id() { return (unsigned)__builtin_amdgcn_s_getreg((3 << 11) | 20) & 0xFu; }
#define XB_SPIN(cond, bar) do { unsigned _sp = 0; while (cond) { __builtin_amdgcn_s_sleep(1); \
    if ((++_sp & 255u) == 0u) { if (xb_ld(&(bar)[XB_TMO])) break; if (_sp > XB_SPIN_CAP) { atomicAdd(&(bar)[XB_TMO], 1u); break; } } } } while (0)

struct XcdBarrier { unsigned* bar; unsigned x; volatile LAS unsigned* st; };

__device__ __forceinline__ XcdBarrier xcd_barrier_post(unsigned* bar, volatile LAS unsigned* st) {
    XcdBarrier b; b.bar = bar; b.x = xb_xcc_id(); b.st = st;
    if (threadIdx.x == 0) (void)xb_add(&bar[XB_XCNT(b.x)], 1u);
    return b;
}
__device__ __forceinline__ void xcd_barrier_complete(unsigned* bar, unsigned x, unsigned& nloc, unsigned& nx) {
    const unsigned G = gridDim.x * gridDim.y * gridDim.z;
    unsigned sum, cnt, mine, sp = 0u;
    for (;;) {
        sum = 0u; cnt = 0u; mine = 0u;
#pragma unroll
        for (unsigned j = 0; j < 16; ++j) { const unsigned c = xb_ld(&bar[XB_XCNT(j)]); sum += c; cnt += (c > 0u) ? 1u : 0u; mine = (j == x) ? c : mine; }
        if (sum == G) break;
        __builtin_amdgcn_s_sleep(1);
        if ((++sp & 255u) == 0u) { if (xb_ld(&bar[XB_TMO])) break; if (sp > XB_SPIN_CAP) { atomicAdd(&bar[XB_TMO], 1u); break; } }
    }
    nloc = mine > 0u ? mine : 1u; nx = cnt > 0u ? cnt : 1u;
}
__device__ __forceinline__ void xcd_barrier(const XcdBarrier& b) {
    asm volatile("s_waitcnt vmcnt(0)" ::: "memory");
    __syncthreads();
    if (threadIdx.x == 0) {
        unsigned* bar = b.bar;
        __builtin_amdgcn_s_waitcnt(0);
        unsigned nloc = b.st[0], nx = b.st[1];
        if (nloc == 0u) { xcd_barrier_complete(bar, b.x, nloc, nx); b.st[0] = nloc; b.st[1] = nx; }
        const unsigned old = xb_add(&bar[XB_XSUB(b.x)], 1u);
        const unsigned gen = old / nloc;
        if (old + 1u == (gen + 1u) * nloc) {
            __builtin_amdgcn_fence(__ATOMIC_RELEASE, "agent");
            asm volatile("s_waitcnt vmcnt(0)" ::: "memory");
            const unsigned og = xb_add(&bar[XB_TOP], 1u);
            const unsigned tg = og / nx;
            if (og + 1u == (tg + 1u) * nx) xb_add(&bar[XB_TOPGEN], 1u);
            else XB_SPIN(xb_ld(&bar[XB_TOPGEN]) == tg, bar);
            __builtin_amdgcn_fence(__ATOMIC_ACQUIRE, "agent");
            xb_add(&bar[XB_XGEN(b.x)], 1u);
            asm volatile("s_waitcnt vmcnt(0)" ::: "memory");
        } else {
            XB_SPIN(xb_ld(&bar[XB_XGEN(b.x)]) == gen, bar);
            __builtin_amdgcn_fence(__ATOMIC_ACQUIRE, "agent");
            asm volatile("s_waitcnt vmcnt(0)" ::: "memory");
        }
    }
    __syncthreads();
}

#ifndef WGM_SET
#define WGM_SET 8
#endif
namespace pg8 {
constexpr int BM = 256, BK = 64, HALF = 128, HTB = HALF * BK * 2, STAGE_BYTES = 8 * HTB, NXCD = 8, WGM = WGM_SET;
__host__ __device__ __forceinline__ int lds_byte(int r, int c) { const int st = (r >> 4) * 2 + (c >> 5), rr = r & 15, cc = c & 31, ob = rr * 64 + cc * 2; return st * 1024 + (ob ^ (((ob >> 9) & 1) << 5)); }
__host__ __device__ __forceinline__ void stage_rc(int b, int& R, int& C) { const int st = b / 1024, sb = b % 1024, swz = sb ^ (((sb >> 9) & 1) << 5); R = (st >> 1) * 16 + swz / 64; C = (st & 1) * 32 + (swz % 64) / 2; }
__host__ __device__ __forceinline__ int perm32(int rho) { const int n = rho >> 4, i = rho & 15; return 8 * (i >> 2) + 4 * n + (i & 3); }

struct Unit { int pm, pn, aux; };

__device__ __forceinline__ void grouped(int wgid, int nM, int nN, int& pm, int& pn) {
    const int nig = WGM * nN, gid = wgid / nig, fm = gid * WGM, gsz = (nM - fm) < WGM ? (nM - fm) : WGM;
    pm = fm + ((wgid % nig) % gsz); pn = (wgid % nig) / gsz;
}
__device__ __forceinline__ bool xcd_remap(int i, int G, int c, int nwg, int& wgid) {
    const long L = (long)i * G + c; if (L >= nwg) return false;
    wgid = (int)L; const int q = nwg / NXCD, r = nwg % NXCD, xcd = wgid % NXCD, off = wgid / NXCD;
    wgid = (xcd < r ? xcd * (q + 1) : r * (q + 1) + (xcd - r) * q) + off; return true;
}

typedef int i32x8 __attribute__((ext_vector_type(8)));
typedef int i32x4 __attribute__((ext_vector_type(4)));
template <bool F8> struct Frags;
template <> struct Frags<false> { bf16x8 a[4][2], b0[2][2], b1[2][2]; };
template <> struct Frags<true> { i32x8 a[4], b0[2], b1[2]; };
template <class Prob, class Epi, bool ALIGN_EPI, bool HOOK, bool FP8 = false, int DRY = 0>
__device__ __forceinline__ void gemm_phase(LAS unsigned char* lds, const Prob& P, const Epi& E) {
    int tid_ = threadIdx.x; asm volatile("" : "+v"(tid_));
    const int tid = tid_, wid = __builtin_amdgcn_readfirstlane(tid >> 6), lane = tid & 63, wr = wid >> 2, wc = wid & 3, fr = lane & 15, fq = lane >> 4;
    const int nt = P.nt;
    unsigned voffB[2], voffA[2];
#pragma unroll
    for (int i = 0; i < 2; ++i) { int R, C; stage_rc(tid * 16 + i * 8192, R, C); const int Rb = Epi::PERM ? ((R & ~31) + perm32(R & 31)) : R;
        voffB[i] = (unsigned)Rb * P.ldb2 + (unsigned)C * 2u; voffA[i] = (unsigned)R * P.lda2 + (unsigned)C * 2u; }
    auto gather_offs = [&](const Unit& u, unsigned (&o0)[2], unsigned (&o1)[2]) {
#pragma unroll
        for (int i = 0; i < 2; ++i) { int R, C; int tt = threadIdx.x; asm volatile("" : "+v"(tt)); stage_rc(tt * 16 + i * 8192, R, C); o0[i] = P.a_row(u, R) + (unsigned)C * 2u; o1[i] = P.a_row(u, HALF + R) + (unsigned)C * 2u; } };
    const size_t kstep = (size_t)(BK * 2);
    const size_t hstepB = (size_t)HALF * P.ldb2;
    const size_t hstepA = (size_t)HALF * P.lda2;
    const unsigned ldsw = (unsigned)wid * 1024u;
    const int aoff = lds_byte(wr * 64 + fr, fq * 8), boff = lds_byte(wc * 32 + fr, fq * 8);
#define PG8_SA(b, h) (((b) * 2 + (h)) * HTB)
#define PG8_SB(b, h) ((4 + (b) * 2 + (h)) * HTB)
#define PG8_STAGE(bufoff, gbase, voff) do { if constexpr ((DRY & 2) == 0) _Pragma("unroll") for (int _i = 0; _i < 2; ++_i) \
        __builtin_amdgcn_global_load_lds((const unsigned*)((const char*)(gbase) + (voff)[_i]), (LAS unsigned*)(lds + (bufoff) + ldsw + _i * 8192), 16, 0, 0); } while (0)
#define PG8_LDA(dst, b, h) do { if constexpr (FP8) { _Pragma("unroll") for (int m = 0; m < 4; ++m) { FR.a[m].lo = *(const LAS i32x4*)(lds + PG8_SA(b, h) + aoff + m * 2048); FR.a[m].hi = *(const LAS i32x4*)(lds + PG8_SA(b, h) + aoff + m * 2048 + 1024); } } \
        else { _Pragma("unroll") for (int m = 0; m < 4; ++m) _Pragma("unroll") for (int k = 0; k < 2; ++k) FR.a[m][k] = *(const LAS bf16x8*)(lds + PG8_SA(b, h) + aoff + m * 2048 + k * 1024); } } while (0)
#define PG8_LDB(dst, b, h) do { if constexpr (FP8) { _Pragma("unroll") for (int n = 0; n < 2; ++n) { FR.dst[n].lo = *(const LAS i32x4*)(lds + PG8_SB(b, h) + boff + n * 2048); FR.dst[n].hi = *(const LAS i32x4*)(lds + PG8_SB(b, h) + boff + n * 2048 + 1024); } } \
        else { _Pragma("unroll") for (int n = 0; n < 2; ++n) _Pragma("unroll") for (int k = 0; k < 2; ++k) FR.dst[n][k] = *(const LAS bf16x8*)(lds + PG8_SB(b, h) + boff + n * 2048 + k * 1024); } } while (0)
#define PG8_MMA(ai, bj, At, Bt) do { __builtin_amdgcn_s_setprio(1); if constexpr ((DRY & 1) != 0) { asm volatile("" :: "v"(FR.a[0]), "v"(FR.a[3]), "v"(FR.Bt[0]), "v"(FR.Bt[1])); } else if constexpr (FP8) { _Pragma("unroll") for (int m = 0; m < 4; ++m) _Pragma("unroll") for (int n = 0; n < 2; ++n) \
            asm volatile("v_mfma_f32_16x16x128_f8f6f4 %0, %1, %2, %0" : "+v"(acc[ai][bj][m][n]) : "v"(FR.Bt[n]), "v"(FR.a[m])); } \
        else { _Pragma("unroll") for (int m = 0; m < 4; ++m) _Pragma("unroll") for (int n = 0; n < 2; ++n) _Pragma("unroll") for (int k = 0; k < 2; ++k) \
        acc[ai][bj][m][n] = __builtin_amdgcn_mfma_f32_16x16x32_bf16(FR.Bt[n][k], FR.a[m][k], acc[ai][bj][m][n], 0, 0, 0); } __builtin_amdgcn_s_setprio(0); } while (0)
#define PG8_WAIT_V(n) asm volatile("s_waitcnt vmcnt(" #n ")" ::: "memory")
#define PG8_WAIT_L(n) asm volatile("s_waitcnt lgkmcnt(" #n ")" ::: "memory")
#define PG8_BAR __builtin_amdgcn_s_barrier()
#define PG8_SCHED __builtin_amdgcn_sched_barrier(0)
    Unit cur, nxt; int ui = 0;
    if (!P.unit(0, cur)) return;
    f32x4 acc[2][2][4][2];
#pragma unroll
    for (int a = 0; a < 2; ++a)
#pragma unroll
        for (int b = 0; b < 2; ++b)
#pragma unroll
            for (int m = 0; m < 4; ++m)
#pragma unroll
                for (int n = 0; n < 2; ++n) acc[a][b][m][n] = (f32x4){0.f, 0.f, 0.f, 0.f};
    Frags<FP8> FR;
    unsigned va0[2], va1[2], vn0[2], vn1[2];
    const char* const gA = P.Abase; const char* cA = gA; const char* nA = gA; const char* cB = P.b_tile(cur);
    if constexpr (Prob::GATHER) {
        gather_offs(cur, va0, va1);
    } else { cA = gA + P.a_row(cur, 0); }
#define PG8_STAGE_A(bufoff, h, koff, nx) do { if constexpr (Prob::GATHER) { unsigned _v[2]; _Pragma("unroll") for (int _i = 0; _i < 2; ++_i) _v[_i] = (nx) ? ((h) ? vn1[_i] : vn0[_i]) : ((h) ? va1[_i] : va0[_i]); PG8_STAGE(bufoff, gA + (koff), _v); } \
        else { PG8_STAGE(bufoff, ((nx) ? nA : cA) + (h) * hstepA + (koff), voffA); } } while (0)
    PG8_STAGE(PG8_SB(0, 0), cB, voffB); PG8_STAGE(PG8_SB(0, 1), cB + hstepB, voffB); PG8_STAGE_A(PG8_SA(0, 0), 0, 0, false); PG8_STAGE_A(PG8_SA(0, 1), 1, 0, false);
    if (wr == 1) PG8_BAR;
    PG8_WAIT_V(2); PG8_BAR;
    PG8_STAGE(PG8_SB(1, 0), cB + kstep, voffB); PG8_STAGE_A(PG8_SA(1, 0), 0, kstep, false); PG8_STAGE(PG8_SB(1, 1), cB + hstepB + kstep, voffB);
    PG8_WAIT_V(6); PG8_BAR;
    Unit nx2; unsigned vq0[2], vq1[2]; bool has_next = P.unit(1, nxt);
    if (!has_next) nxt = cur;
    if constexpr (Prob::GATHER) gather_offs(nxt, vn0, vn1);
    for (;;) {
        if constexpr (!Prob::GATHER) { has_next = P.unit(ui + 1, nxt); if (!has_next) nxt = cur; nA = gA + P.a_row(nxt, 0); }
        const char* nB = P.b_tile(nxt);
        for (int t = 0; t < nt; t += 2) {
            const bool last = (t == nt - 2);
            if constexpr (HOOK) { if (t == (nt >> 1)) { if constexpr (FP8) asm volatile("s_nop 15\n\ts_nop 15" ::: "memory"); E.mid(acc, cur, wr, wc, fr, fq); } }
            const size_t k1 = (size_t)(t + 1) * kstep, k2 = last ? 0 : (size_t)(t + 2) * kstep, k3 = k2 + kstep;
            const char* b2 = last ? nB : cB + (size_t)(t + 2) * kstep; const char* b3 = b2 + kstep;
            PG8_LDB(b0, 0, 0); PG8_LDB(b1, 0, 1); PG8_SCHED; PG8_LDA(At, 0, 0); PG8_STAGE_A(PG8_SA(1, 1), 1, k1, false);
            PG8_WAIT_V(8); PG8_WAIT_L(0); PG8_BAR; PG8_MMA(0, 0, At, b0); PG8_MMA(0, 1, At, b1); PG8_BAR; PG8_SCHED;
            PG8_LDA(At, 0, 1); PG8_STAGE(PG8_SB(0, 0), b2, voffB); PG8_STAGE(PG8_SB(0, 1), b2 + hstepB, voffB); PG8_STAGE_A(PG8_SA(0, 0), 0, k2, last);
            PG8_WAIT_V(8); PG8_WAIT_L(0); PG8_BAR; PG8_MMA(1, 0, At, b0); PG8_MMA(1, 1, At, b1); PG8_BAR; PG8_SCHED;
            PG8_LDB(b0, 1, 0); PG8_LDB(b1, 1, 1); PG8_SCHED; PG8_LDA(At, 1, 0); PG8_STAGE_A(PG8_SA(0, 1), 1, k2, last);
            PG8_WAIT_V(8); PG8_WAIT_L(0); PG8_BAR; PG8_MMA(0, 0, At, b0); PG8_MMA(0, 1, At, b1); PG8_BAR; PG8_SCHED;
            PG8_LDA(At, 1, 1); PG8_STAGE(PG8_SB(1, 0), b3, voffB); PG8_STAGE(PG8_SB(1, 1), b3 + hstepB, voffB); PG8_STAGE_A(PG8_SA(1, 0), 0, k3, last);
            PG8_WAIT_V(8); PG8_WAIT_L(0); PG8_BAR; PG8_MMA(1, 0, At, b0); PG8_MMA(1, 1, At, b1); PG8_BAR; PG8_SCHED;
        }
        if constexpr (ALIGN_EPI) { if (wr == 0) PG8_BAR; }
        bool has_next2 = false;
        if constexpr (Prob::GATHER) { has_next2 = has_next && P.unit(ui + 2, nx2); if (!has_next2) nx2 = nxt; gather_offs(nx2, vq0, vq1); }
        if constexpr (FP8) asm volatile("s_nop 15\n\ts_nop 15" ::: "memory");
        if constexpr (DRY == 0) E(acc, cur, wr, wc, fr, fq); else { if (acc[0][0][0][0][0] == 1.2345e30f) *(volatile int*)P.Abase = 1; }
        if (!has_next) break;
#pragma unroll
        for (int a = 0; a < 2; ++a)
#pragma unroll
            for (int b = 0; b < 2; ++b)
#pragma unroll
                for (int m = 0; m < 4; ++m)
#pragma unroll
                    for (int n = 0; n < 2; ++n) acc[a][b][m][n] = (f32x4){0.f, 0.f, 0.f, 0.f};
        cur = nxt; cB = nB; cA = nA; ++ui;
        if constexpr (Prob::GATHER) {
#pragma unroll
            for (int i = 0; i < 2; ++i) { va0[i] = vn0[i]; va1[i] = vn1[i]; vn0[i] = vq0[i]; vn1[i] = vq1[i]; }
            nxt = nx2; has_next = has_next2; }
        if constexpr (ALIGN_EPI) { if (wr == 1) PG8_BAR; }
    }
    PG8_WAIT_V(0);
    if constexpr (!ALIGN_EPI) { if (wr == 0) PG8_BAR; }
    PG8_BAR;
#undef PG8_SA
#undef PG8_SB
#undef PG8_STAGE
#undef PG8_STAGE_A
#undef PG8_LDA
#undef PG8_LDB
#undef PG8_MMA
#undef PG8_WAIT_V
#undef PG8_WAIT_L
#undef PG8_BAR
#undef PG8_SCHED
}
}

using pg8::Unit;

struct ProbDense {
    static constexpr bool GATHER = false;
    const char* Abase; int nt; unsigned ldb2; unsigned lda2; const char* Bt; int nM, nN, G, c; int rev;
    __device__ __forceinline__ bool unit(int i, Unit& u) const { int w; if (!pg8::xcd_remap(i, G, c, nM * nN, w)) return false; pg8::grouped(w, nM, nN, u.pm, u.pn); if (rev) u.pm = nM - 1 - u.pm; u.aux = 0; return true; }
    __device__ __forceinline__ unsigned a_row(const Unit& u, int r) const { return (unsigned)(u.pm * 256 + r) * lda2; }
    __device__ __forceinline__ const char* b_tile(const Unit& u) const { return Bt + (size_t)u.pn * 256 * ldb2; }
};
struct ProbP1 {
    static constexpr bool GATHER = false;
    const char* Abase; int nt; unsigned ldb2; unsigned lda2; const char* Bt; unsigned uc_off; int G, c;
    __device__ __forceinline__ bool unit(int i, Unit& u) const {
        int w; if (!pg8::xcd_remap(i, G, c, 3072 + 256, w)) return false;
        if (w < 3072) { pg8::grouped(w, 256, 12, u.pm, u.pn); u.pm = 255 - u.pm; u.aux = 0; }
        else { pg8::grouped(w - 3072, 32, 8, u.pm, u.pn); u.pn += 4; u.aux = 1; }
        return true; }
    __device__ __forceinline__ unsigned a_row(const Unit& u, int r) const { return (u.aux ? uc_off : 0u) + (unsigned)(u.pm * 256 + r) * lda2; }
    __device__ __forceinline__ const char* b_tile(const Unit& u) const { return Bt + (size_t)u.pn * 256 * ldb2; }
};
template <bool GATHER_> struct ProbMoE {
    static constexpr bool GATHER = GATHER_;
    const char* Abase; int nt; unsigned ldb2; unsigned lda2; const char* Bt; size_t estride; int nN, nblk, G, c; const int* rowtok; const LAS unsigned char* blk_e;
    __device__ __forceinline__ bool unit(int i, Unit& u) const { int w; if (!pg8::xcd_remap(i, G, c, nblk * nN, w)) return false; pg8::grouped(w, nblk, nN, u.pm, u.pn); if (!GATHER) u.pm = nblk - 1 - u.pm;
        u.aux = (int)blk_e[u.pm]; return true; }
    __device__ __forceinline__ unsigned a_row(const Unit& u, int r) const { if (GATHER) return (unsigned)rowtok[u.pm * 256 + r] * lda2; else return (unsigned)(u.pm * 256 + r) * lda2; }
    __device__ __forceinline__ const char* b_tile(const Unit& u) const { return Bt + (size_t)u.aux * estride + (size_t)u.pn * 256 * ldb2; }
};

struct EpiP1 {
    static constexpr bool PERM = true;
    bf16_t* PA; bf16_t* PH; bf16_t* PHC;
    __device__ __forceinline__ void operator()(const f32x4 (&acc)[2][2][4][2], const Unit& u, int wr, int wc, int fr, int fq) const {
        const int row0 = u.pm * 256 + wr * 64 + fr;
        if (!u.aux && u.pn < 4) {
            const int col0 = u.pn * 256 + wc * 32 + 8 * fq;
#pragma unroll
            for (int ai = 0; ai < 2; ++ai)
#pragma unroll
                for (int m = 0; m < 4; ++m) { const int row = row0 + ai * 128 + m * 16, b = row >> 11, t = row & 2047;
#pragma unroll
                    for (int bj = 0; bj < 2; ++bj) { const int col = col0 + bj * 128, reim = col >> 9, c5 = col & 511, slab = c5 >> 4, half = (c5 >> 3) & 1;
                        const f32x4 v0 = acc[ai][bj][m][0] * W8_INV, v1 = acc[ai][bj][m][1] * W8_INV;
                        u32x4 w; w.x = cvt_pk_bf16(v0[0], v0[1]); w.y = cvt_pk_bf16(v0[2], v0[3]); w.z = cvt_pk_bf16(v1[0], v1[1]); w.w = cvt_pk_bf16(v1[2], v1[3]);
                        *(u32x4*)(PA + ((((size_t)(b * 32 + slab) * 2048 + t) * 2 + reim) * 16 + half * 8)) = w; } }
            return;
        }
        bf16_t* base = u.aux ? PHC : PH; const int ldc = 2048, colt = (u.pn - 4) * 256;
        const int col0 = colt + wc * 32 + 8 * fq;
#pragma unroll
        for (int ai = 0; ai < 2; ++ai)
#pragma unroll
            for (int m = 0; m < 4; ++m) { bf16_t* rowp = base + (size_t)(row0 + ai * 128 + m * 16) * ldc + col0;
#pragma unroll
                for (int bj = 0; bj < 2; ++bj) { const f32x4 v0 = acc[ai][bj][m][0] * W8_INV, v1 = acc[ai][bj][m][1] * W8_INV;
                    u32x4 w; w.x = cvt_pk_bf16(v0[0], v0[1]); w.y = cvt_pk_bf16(v0[2], v0[3]); w.z = cvt_pk_bf16(v1[0], v1[1]); w.w = cvt_pk_bf16(v1[2], v1[3]);
                    *(u32x4*)(rowp + bj * 128) = w; } }
    }
    __device__ __forceinline__ void mid(f32x4 (&)[2][2][4][2], const Unit&, int, int, int, int) const {}
};
struct EpiP2 {
    static constexpr bool PERM = true;
    bf16_t* PG; bf16_t* GATES;
    __device__ __forceinline__ void operator()(const f32x4 (&acc)[2][2][4][2], const Unit& u, int wr, int wc, int fr, int fq) const {
        const bool isg = u.pn >= 2; bf16_t* base = isg ? GATES : PG; const int ldc = isg ? 2048 : 512, colt = isg ? (u.pn - 2) * 256 : u.pn * 256;
        const int row0 = u.pm * 256 + wr * 64 + fr, col0 = colt + wc * 32 + 8 * fq;
#pragma unroll
        for (int ai = 0; ai < 2; ++ai)
#pragma unroll
            for (int m = 0; m < 4; ++m) { bf16_t* rowp = base + (size_t)(row0 + ai * 128 + m * 16) * ldc + col0;
#pragma unroll
                for (int bj = 0; bj < 2; ++bj) { f32x4 v0 = acc[ai][bj][m][0] * W8_INV, v1 = acc[ai][bj][m][1] * W8_INV;
#pragma unroll
                    for (int j = 0; j < 4; ++j) { const float s0 = fast_sigmoid(v0[j]), s1 = fast_sigmoid(v1[j]); v0[j] = isg ? s0 : v0[j] * s0; v1[j] = isg ? s1 : v1[j] * s1; }
                    u32x4 w; w.x = cvt_pk_bf16(v0[0], v0[1]); w.y = cvt_pk_bf16(v0[2], v0[3]); w.z = cvt_pk_bf16(v1[0], v1[1]); w.w = cvt_pk_bf16(v1[2], v1[3]);
                    *(u32x4*)(rowp + bj * 128) = w; } }
    }
    __device__ __forceinline__ void mid(f32x4 (&)[2][2][4][2], const Unit&, int, int, int, int) const {}
};
struct EpiM1 {
    static constexpr bool PERM = true;
    const bf16_t* GATES; unsigned char* Mo;
    __device__ __forceinline__ void mid(f32x4 (&acc)[2][2][4][2], const Unit& u, int wr, int wc, int fr, int fq) const {
        int row0 = u.pm * 256 + wr * 64 + fr, col0 = u.pn * 256 + wc * 32 + 8 * fq;
        asm volatile("" : "+v"(row0), "+v"(col0));
#pragma unroll
        for (int ai = 0; ai < 2; ++ai) {
            u32x4 gf[4][2], gh[4][2];
#pragma unroll
            for (int m = 0; m < 4; ++m) { const bf16_t* gp = GATES + (size_t)(row0 + ai * 128 + m * 16) * 2048 + col0;
#pragma unroll
                for (int bj = 0; bj < 2; ++bj) { gf[m][bj] = *(const u32x4*)(gp + bj * 128); gh[m][bj] = *(const u32x4*)(gp + 1024 + bj * 128); } }
#pragma unroll
            for (int m = 0; m < 4; ++m)
#pragma unroll
                for (int bj = 0; bj < 2; ++bj) { const u32x4 f = gf[m][bj], h = gh[m][bj];
                    f32x4& v0 = acc[ai][bj][m][0]; f32x4& v1 = acc[ai][bj][m][1];
                    v0[0] *= bf_lo(f.x) * __builtin_amdgcn_rcpf(fmaxf(bf_lo(h.x), 1e-20f)); v0[1] *= bf_hi(f.x) * __builtin_amdgcn_rcpf(fmaxf(bf_hi(h.x), 1e-20f));
                    v0[2] *= bf_lo(f.y) * __builtin_amdgcn_rcpf(fmaxf(bf_lo(h.y), 1e-20f)); v0[3] *= bf_hi(f.y) * __builtin_amdgcn_rcpf(fmaxf(bf_hi(h.y), 1e-20f));
                    v1[0] *= bf_lo(f.z) * __builtin_amdgcn_rcpf(fmaxf(bf_lo(h.z), 1e-20f)); v1[1] *= bf_hi(f.z) * __builtin_amdgcn_rcpf(fmaxf(bf_hi(h.z), 1e-20f));
                    v1[2] *= bf_lo(f.w) * __builtin_amdgcn_rcpf(fmaxf(bf_lo(h.w), 1e-20f)); v1[3] *= bf_hi(f.w) * __builtin_amdgcn_rcpf(fmaxf(bf_hi(h.w), 1e-20f)); }
            asm volatile("" ::: "memory");
        }
    }
    __device__ __forceinline__ void operator()(const f32x4 (&acc)[2][2][4][2], const Unit& u, int wr, int wc, int fr, int fq) const {
        const int row0 = u.pm * 256 + wr * 64 + fr, col0 = u.pn * 256 + wc * 32 + 8 * fq;
#pragma unroll
        for (int ai = 0; ai < 2; ++ai) {
            u32x4 gh[4][2];
#pragma unroll
            for (int m = 0; m < 4; ++m) { const bf16_t* gp = GATES + (size_t)(row0 + ai * 128 + m * 16) * 2048 + 1024 + col0;
#pragma unroll
                for (int bj = 0; bj < 2; ++bj) gh[m][bj] = *(const u32x4*)(gp + bj * 128); }
#pragma unroll
            for (int bj = 0; bj < 2; ++bj) { u32x2 pk[4];
#pragma unroll
                for (int m = 0; m < 4; ++m) { const u32x4 h = gh[m][bj]; const f32x4 v0 = acc[ai][bj][m][0] * W8_INV, v1 = acc[ai][bj][m][1] * W8_INV;
                    pk[m] = (u32x2){cvt_pk4_fp8(v0[0] * bf_lo(h.x), v0[1] * bf_hi(h.x), v0[2] * bf_lo(h.y), v0[3] * bf_hi(h.y)), cvt_pk4_fp8(v1[0] * bf_lo(h.z), v1[1] * bf_hi(h.z), v1[2] * bf_lo(h.w), v1[3] * bf_hi(h.w))}; }
#pragma unroll
                for (int mp = 0; mp < 2; ++mp)
                    *(u32x4*)(Mo + (size_t)(row0 + ai * 128 + (2 * mp + (fq & 1)) * 16) * 1024 + u.pn * 256 + bj * 128 + wc * 32 + (fq >> 1) * 16) = widen16(pk[2 * mp], pk[2 * mp + 1]); }
            asm volatile("" ::: "memory");
        }
    }
};
struct EpiM2 {
    static constexpr bool PERM = true;
    const float* X; const float* ada; bf16_t* V;
    __device__ __forceinline__ void operator()(const f32x4 (&acc)[2][2][4][2], const Unit& u, int wr, int wc, int fr, int fq) const {
        const int row0 = u.pm * 256 + wr * 64 + fr, col0 = u.pn * 256 + wc * 32 + 8 * fq;
        const float* g1 = ada + (size_t)(u.pm >> 3) * 6144 + 2048 + col0;
        f32x4 gv[2][2];
#pragma unroll
        for (int bj = 0; bj < 2; ++bj)
#pragma unroll
            for (int n = 0; n < 2; ++n) gv[bj][n] = *(const f32x4*)(g1 + bj * 128 + n * 4);
#pragma unroll
        for (int ai = 0; ai < 2; ++ai) {
            f32x4 xv[4][2][2];
#pragma unroll
            for (int m = 0; m < 4; ++m) { const size_t off = (size_t)(row0 + ai * 128 + m * 16) * 1024 + col0;
#pragma unroll
                for (int bj = 0; bj < 2; ++bj)
#pragma unroll
                    for (int n = 0; n < 2; ++n) xv[m][bj][n] = *(const f32x4*)(X + off + bj * 128 + n * 4); }
#pragma unroll
            for (int m = 0; m < 4; ++m) { const size_t off = (size_t)(row0 + ai * 128 + m * 16) * 1024 + col0;
#pragma unroll
                for (int bj = 0; bj < 2; ++bj) { const f32x4 v0 = xv[m][bj][0] * DN_ALPHA + gv[bj][0] * (acc[ai][bj][m][0] * W8_INV), v1 = xv[m][bj][1] * DN_ALPHA + gv[bj][1] * (acc[ai][bj][m][1] * W8_INV);
                    u32x4 w; w.x = cvt_pk_bf16(v0[0], v0[1]); w.y = cvt_pk_bf16(v0[2], v0[3]); w.z = cvt_pk_bf16(v1[0], v1[1]); w.w = cvt_pk_bf16(v1[2], v1[3]);
                    *(u32x4*)(V + off + bj * 128) = w; } }
            asm volatile("" ::: "memory");
        }
    }
    __device__ __forceinline__ void mid(f32x4 (&)[2][2][4][2], const Unit&, int, int, int, int) const {}
};
struct EpiGU {
    static constexpr bool PERM = true;
    const float* bgu; unsigned char* ACT;
    __device__ __forceinline__ void operator()(const f32x4 (&acc)[2][2][4][2], const Unit& u, int wr, int wc, int fr, int fq) const {
        const int row0 = u.pm * 256 + wr * 64 + fr, col0 = u.pn * 128 + wc * 32 + 8 * fq;
        const float* bp = bgu + (size_t)u.aux * 2048 + col0;
        const f32x4 bg0 = *(const f32x4*)(bp), bg1 = *(const f32x4*)(bp + 4), bu0 = *(const f32x4*)(bp + 1024), bu1 = *(const f32x4*)(bp + 1028);
#pragma unroll
        for (int ai = 0; ai < 2; ++ai) { u32x2 pk[4];
#pragma unroll
            for (int m = 0; m < 4; ++m) {
                f32x4 g0 = acc[ai][0][m][0] * W8_INV + bg0, g1 = acc[ai][0][m][1] * W8_INV + bg1, p0 = acc[ai][1][m][0] * W8_INV + bu0, p1 = acc[ai][1][m][1] * W8_INV + bu1;
#pragma unroll
                for (int j = 0; j < 4; ++j) {
                    float g = fminf(g0[j], 7.0f), p = fminf(fmaxf(p0[j], -7.0f), 7.0f); g0[j] = (p + 1.0f) * g * fast_sigmoid(1.702f * g);
                    g = fminf(g1[j], 7.0f); p = fminf(fmaxf(p1[j], -7.0f), 7.0f); g1[j] = (p + 1.0f) * g * fast_sigmoid(1.702f * g); }
                pk[m] = (u32x2){cvt_pk4_fp8(g0[0], g0[1], g0[2], g0[3]), cvt_pk4_fp8(g1[0], g1[1], g1[2], g1[3])}; }
#pragma unroll
            for (int mp = 0; mp < 2; ++mp)
                *(u32x4*)(ACT + (size_t)(row0 + ai * 128 + (2 * mp + (fq & 1)) * 16) * 1024 + u.pn * 128 + wc * 32 + (fq >> 1) * 16) = widen16(pk[2 * mp], pk[2 * mp + 1]); }
    }
    __device__ __forceinline__ void mid(f32x4 (&)[2][2][4][2], const Unit&, int, int, int, int) const {}
};
struct EpiDN {
    static constexpr bool PERM = true;
    const float* bdn; unsigned char* Y;
    __device__ __forceinline__ void operator()(const f32x4 (&acc)[2][2][4][2], const Unit& u, int wr, int wc, int fr, int fq) const {
        const int row0 = u.pm * 256 + wr * 64 + fr, col0 = u.pn * 256 + wc * 32 + 8 * fq;
        const float* bp = bdn + (size_t)u.aux * 1024 + col0;
        f32x4 bv[2][2];
#pragma unroll
        for (int bj = 0; bj < 2; ++bj)
#pragma unroll
            for (int n = 0; n < 2; ++n) bv[bj][n] = *(const f32x4*)(bp + bj * 128 + 4 * n);
#pragma unroll
        for (int ai = 0; ai < 2; ++ai)
#pragma unroll
            for (int bj = 0; bj < 2; ++bj) { u32x2 pk[4];
#pragma unroll
                for (int m = 0; m < 4; ++m) { const f32x4 v0 = acc[ai][bj][m][0] * W8_INV + bv[bj][0], v1 = acc[ai][bj][m][1] * W8_INV + bv[bj][1];
                    pk[m] = (u32x2){cvt_pk4_fp8(v0[0], v0[1], v0[2], v0[3]), cvt_pk4_fp8(v1[0], v1[1], v1[2], v1[3])}; }
#pragma unroll
                for (int mp = 0; mp < 2; ++mp)
                    *(u32x4*)(Y + (size_t)(row0 + ai * 128 + (2 * mp + (fq & 1)) * 16) * 1024 + u.pn * 256 + bj * 128 + wc * 32 + (fq >> 1) * 16) = widen16(pk[2 * mp], pk[2 * mp + 1]); }
    }
    __device__ __forceinline__ void mid(f32x4 (&)[2][2][4][2], const Unit&, int, int, int, int) const {}
};

struct Frame {
    LAS unsigned char* lds; int tid, lane, wave, G, c;
    const float* const* in; float* out; unsigned char* ws; unsigned* ctl;
};
enum { I_X = 0, I_C, I_CTX, I_CCTX, I_WADA, I_BADA, I_WIN, I_LBRAW, I_HGG, I_WFO, I_WHO, I_WO, I_LN1G, I_LN1B, I_WR, I_BR, I_WGU, I_BGU, I_WDN, I_BDN, I_LN2G, I_LN2B };

__device__ __forceinline__ float wave_sum(float v) {
#pragma unroll
    for (int o = 32; o >= 1; o >>= 1) v += __shfl_xor(v, o);
    return v;
}

__device__ __forceinline__ void p0_ada(const Frame& F) {
    LAS float* cact = (LAS float*)F.lds;
    float* ada = (float*)(F.ws + WS_ADA);
    for (int cb = F.c; cb < 192; cb += F.G) {
        for (int i = F.tid; i < 33 * 1024; i += NTHR) { const int b = i >> 10, k = i & 1023; const float v = b < 32 ? F.in[I_C][b * 1024 + k] : F.in[I_CCTX][k]; cact[i] = v * fast_sigmoid(v); }
        __syncthreads();
        const int kg = F.tid >> 5, col = F.tid & 31, gcol = cb * 32 + col;
        float acc[33];
#pragma unroll
        for (int b = 0; b < 33; ++b) acc[b] = 0.f;
        for (int k = kg; k < 1024; k += 16) { const float w = F.in[I_WADA][(size_t)k * 6144 + gcol];
#pragma unroll
            for (int b = 0; b < 33; ++b) acc[b] += cact[b * 1024 + k] * w; }
        __syncthreads();
        LAS float* red = cact;
#pragma unroll
        for (int b = 0; b < 33; ++b) red[(kg * 33 + b) * 32 + col] = acc[b];
        __syncthreads();
        for (int o = F.tid; o < 33 * 32; o += NTHR) { const int b = o >> 5, cc = o & 31; float s = 0.f;
            for (int g = 0; g < 16; ++g) s += red[(g * 33 + b) * 32 + cc];
            ada[(size_t)b * 6144 + cb * 32 + cc] = s + F.in[I_BADA][cb * 32 + cc]; }
        __syncthreads();
    }
}
__device__ __forceinline__ void p0_fold(const Frame& F) {
    LAS float* xr = (LAS float*)F.lds;
    LAS float* cs = xr + 2048;
    unsigned char* W1 = (unsigned char*)(F.ws + WS_WIN1T);
    if (F.tid < 128) { const float a = (float)F.tid * (1.0f / 128.0f); cs[F.tid] = __builtin_amdgcn_cosf(a); cs[128 + F.tid] = __builtin_amdgcn_sinf(a); }
    for (int kb = F.c; kb < 256; kb += F.G) {
        __syncthreads();
        for (int i = F.tid; i < 2048; i += NTHR) xr[i] = F.in[I_WIN][(size_t)(4 * kb + (i >> 9)) * 5120 + (i & 511)];
        __syncthreads();
        const int g = F.tid >> 7, j = F.tid & 127;
        float ac[4] = {0.f, 0.f, 0.f, 0.f}, as[4] = {0.f, 0.f, 0.f, 0.f};
        for (int d = 0; d < 128; ++d) { const int idx = (d * j) & 127; const float cv = cs[idx], sv = cs[128 + idx];
#pragma unroll
            for (int r = 0; r < 4; ++r) { const float xv = xr[r * 512 + g * 128 + d]; ac[r] += xv * cv; as[r] += xv * sv; } }
        const float sc = 0.08838834764831845f * W8_SCALE;
        *(unsigned*)(W1 + (size_t)(g * 128 + j) * 1024 + 4 * kb) = cvt_pk4_fp8(ac[0] * sc, ac[1] * sc, ac[2] * sc, ac[3] * sc);
        *(unsigned*)(W1 + (size_t)(512 + g * 128 + j) * 1024 + 4 * kb) = cvt_pk4_fp8(-as[0] * sc, -as[1] * sc, -as[2] * sc, -as[3] * sc);
    }
    __syncthreads();
}
struct CvJob { const float* src; int sld; unsigned char* dst; int f8; };
__device__ __forceinline__ CvJob cv_job(const Frame& F, int j) {
    CvJob J;
    if (j < 128) { const int kt = j >> 4, nt = j & 15; J.src = F.in[I_WIN] + (size_t)kt * 128 * 5120 + 512 + nt * 128; J.sld = 5120; J.dst = F.ws + WS_WIN1T + (size_t)(1024 + nt * 128) * 1024 + kt * 128; J.f8 = 1; }
    else if (j < 288) { const int q = j - 128, kt = q / 20, nt = q % 20; J.src = F.in[I_WIN] + (size_t)kt * 128 * 5120 + 2560 + nt * 128; J.sld = 5120; J.dst = F.ws + WS_WIN2T + (size_t)(nt * 128) * 1024 + kt * 128; J.f8 = 1; }
    else if (j < 320) { const int q = j - 288, kt = q >> 3, nt = q & 7; J.src = F.in[I_WFO] + (size_t)kt * 128 * 1024 + nt * 128; J.sld = 1024; J.dst = F.ws + WS_WMT + ((size_t)(nt * 128) * 1024 + kt * 128); J.f8 = 1; }
    else if (j < 352) { const int q = j - 320, kt = q >> 3, nt = q & 7; J.src = F.in[I_WHO] + (size_t)kt * 128 * 1024 + nt * 128; J.sld = 1024; J.dst = F.ws + WS_WMT + ((size_t)(nt * 128) * 1024 + 512 + kt * 128); J.f8 = 1; }
    else if (j < 416) { const int q = j - 352, kt = q >> 3, nt = q & 7; J.src = F.in[I_WO] + (size_t)kt * 128 * 1024 + nt * 128; J.sld = 1024; J.dst = F.ws + WS_WOT + ((size_t)(nt * 128) * 1024 + kt * 128); J.f8 = 1; }
    else if (j < 4512) { const int q = j - 416, e = q >> 7, r = q & 127, kt = r >> 4, jt = r & 15; J.src = F.in[I_WGU] + (size_t)e * 1024 * 2048 + (size_t)kt * 128 * 2048 + jt * 128; J.sld = 2048;
        J.dst = F.ws + WS_WGUT + (size_t)e * 2048 * 1024 + (size_t)((jt & 7) * 256 + (jt >> 3) * 128) * 1024 + kt * 128; J.f8 = 1; }
    else { const int q = j - 4512, e = q >> 6, r = q & 63, kt = r >> 3, nt = r & 7; J.src = F.in[I_WDN] + (size_t)e * 1024 * 1024 + (size_t)kt * 128 * 1024 + nt * 128; J.sld = 1024;
        J.dst = F.ws + WS_WDNT + (size_t)e * 1024 * 1024 + (size_t)(nt * 128) * 1024 + kt * 128; J.f8 = 1; }
    return J;
}
__device__ __forceinline__ void p0_convert(const Frame& F) {
    constexpr int NJ = 128 + 160 + 32 + 32 + 64 + 4096 + 2048;
    LAS float* tile = (LAS float*)F.lds;
    int j = F.c; if (j >= NJ) return;
    CvJob J = cv_job(F, j);
    f32x4 v[8];
#pragma unroll
    for (int i = 0; i < 8; ++i) { const int idx = F.tid + i * NTHR, r = idx >> 5, c4 = idx & 31; v[i] = *(const f32x4*)(J.src + (size_t)r * J.sld + c4 * 4); }
    for (;;) {
        const float sc = J.f8 ? W8_SCALE : 1.0f;
#pragma unroll
        for (int i = 0; i < 8; ++i) { const int idx = F.tid + i * NTHR, r = idx >> 5, c4 = idx & 31; LAS float* p = tile + r * 129 + c4 * 4; p[0] = v[i][0] * sc; p[1] = v[i][1] * sc; p[2] = v[i][2] * sc; p[3] = v[i][3] * sc; }
        __syncthreads();
        const CvJob Jc = J; const int jn = j + F.G; const bool more = jn < NJ;
        if (more) { J = cv_job(F, jn);
#pragma unroll
            for (int i = 0; i < 8; ++i) { const int idx = F.tid + i * NTHR, r = idx >> 5, c4 = idx & 31; v[i] = *(const f32x4*)(J.src + (size_t)r * J.sld + c4 * 4); } }
        if (Jc.f8) {
#pragma unroll
            for (int i = 0; i < 2; ++i) { const int idx = F.tid + i * NTHR, n = idx >> 3, kc = idx & 7; const LAS float* p = tile + (kc * 16) * 129 + n;
                u32x4 w; w.x = cvt_pk4_fp8(p[0], p[129], p[2 * 129], p[3 * 129]); w.y = cvt_pk4_fp8(p[4 * 129], p[5 * 129], p[6 * 129], p[7 * 129]);
                w.z = cvt_pk4_fp8(p[8 * 129], p[9 * 129], p[10 * 129], p[11 * 129]); w.w = cvt_pk4_fp8(p[12 * 129], p[13 * 129], p[14 * 129], p[15 * 129]);
                *(u32x4*)(Jc.dst + (size_t)n * 1024 + kc * 16) = w; }
        } else {
#pragma unroll
            for (int i = 0; i < 4; ++i) { const int idx = F.tid + i * NTHR, n = idx >> 4, kc = idx & 15; const LAS float* p = tile + (kc * 8) * 129 + n;
                u32x4 w; w.x = cvt_pk_bf16(p[0], p[129]); w.y = cvt_pk_bf16(p[2 * 129], p[3 * 129]); w.z = cvt_pk_bf16(p[4 * 129], p[5 * 129]); w.w = cvt_pk_bf16(p[6 * 129], p[7 * 129]);
                *(u32x4*)((bf16_t*)Jc.dst + (size_t)n * 1024 + kc * 8) = w; }
        }
        __syncthreads();
        if (!more) break;
        j = jn;
    }
}

__device__ __forceinline__ void p1_uprep(const Frame& F) {
    const float* ada = (const float*)(F.ws + WS_ADA);
    unsigned char* U = (unsigned char*)(F.ws + WS_U); unsigned char* Uc = (unsigned char*)(F.ws + WS_UC);
    const size_t NIT = (size_t)(T + TCX) * 128, stride = (size_t)F.G * NTHR;
    for (size_t idx = (size_t)F.c * NTHR + F.tid; idx < NIT; idx += stride) {
        const int row = (int)(idx >> 7), col = (int)(idx & 127) * 8;
        const bool lat = row < T; const int b = lat ? (row >> 11) : 32;
        const float* src = lat ? F.in[I_X] + (size_t)row * 1024 + col : F.in[I_CTX] + (size_t)(row - T) * 1024 + col;
        unsigned char* dst = lat ? U + (size_t)row * 1024 + col : Uc + (size_t)(row - T) * 1024 + col;
        const f32x4 a0 = *(const f32x4*)src, a1 = *(const f32x4*)(src + 4);
        const float* ap = ada + (size_t)b * 6144 + col;
        const f32x4 sh0 = *(const f32x4*)ap, sh1 = *(const f32x4*)(ap + 4), sc0 = *(const f32x4*)(ap + 1024), sc1 = *(const f32x4*)(ap + 1028);
        const f32x4 r0 = a0 * (sc0 + 1.0f) + sh0, r1 = a1 * (sc1 + 1.0f) + sh1;
        *(u32x2*)dst = (u32x2){cvt_pk4_fp8(r0[0], r0[1], r0[2], r0[3]), cvt_pk4_fp8(r1[0], r1[1], r1[2], r1[3])};
    }
    int* rowtok = (int*)(F.ws + WS_ROWTOK);
    for (int i = F.c * NTHR + F.tid; i < NCH * ROWS_CH; i += F.G * NTHR) rowtok[i] = (i / ROWS_CH) * TCH;
}

__device__ __forceinline__ void p6_readout(const Frame& F) {
    const bf16_t* PH = (const bf16_t*)(F.ws + WS_PH); const bf16_t* PG = (const bf16_t*)(F.ws + WS_PG); unsigned char* Y = (unsigned char*)(F.ws + WS_Y);
    const int l8 = F.lane * 8;
    const f32x4 g0 = *(const f32x4*)(F.in[I_HGG] + l8), g1 = *(const f32x4*)(F.in[I_HGG] + l8 + 4);
    for (int t = F.c * 8 + F.wave; t < T; t += F.G * 8) {
        const u32x4 a = *(const u32x4*)(PH + (size_t)t * 2048 + 512 + l8), b = *(const u32x4*)(PH + (size_t)t * 2048 + 1024 + l8), p = *(const u32x4*)(PG + (size_t)t * 512 + l8);
        float o[8] = { bf_lo(a.x) + bf_lo(b.x), bf_hi(a.x) + bf_hi(b.x), bf_lo(a.y) + bf_lo(b.y), bf_hi(a.y) + bf_hi(b.y), bf_lo(a.z) + bf_lo(b.z), bf_hi(a.z) + bf_hi(b.z), bf_lo(a.w) + bf_lo(b.w), bf_hi(a.w) + bf_hi(b.w) };
        float ss = 0.f;
#pragma unroll
        for (int i = 0; i < 8; ++i) ss += o[i] * o[i];
        ss += __shfl_xor(ss, 1); ss += __shfl_xor(ss, 2); ss += __shfl_xor(ss, 4); ss += __shfl_xor(ss, 8);
        const float rs = __builtin_amdgcn_rsqf(ss * (1.0f / 128.0f) + RMS_EPS);
        const float sp[8] = { bf_lo(p.x), bf_hi(p.x), bf_lo(p.y), bf_hi(p.y), bf_lo(p.z), bf_hi(p.z), bf_lo(p.w), bf_hi(p.w) };
        *(u32x2*)(Y + (size_t)t * 1024 + 512 + l8) = (u32x2){cvt_pk4_fp8(o[0] * rs * g0[0] * sp[0], o[1] * rs * g0[1] * sp[1], o[2] * rs * g0[2] * sp[2], o[3] * rs * g0[3] * sp[3]), cvt_pk4_fp8(o[4] * rs * g1[0] * sp[4], o[5] * rs * g1[1] * sp[5], o[6] * rs * g1[2] * sp[6], o[7] * rs * g1[3] * sp[7])};
    }
}

__device__ __forceinline__ void p9_ln1_router(const Frame& F, const bool dry) {
    LAS float* wrT = (LAS float*)F.lds;
    LAS float* lg = (LAS float*)(F.lds + 131072);
    LAS float* brs = (LAS float*)(F.lds + 131072 + 4096);
    LAS int* hist = (LAS int*)(F.lds + 131072 + 4096 + 128);
    for (int i = F.tid; i < 32768; i += NTHR) { const int k = i >> 5, e = i & 31; wrT[e * 1024 + k] = F.in[I_WR][i]; }
    if (F.tid < 32) brs[F.tid] = F.in[I_BR][F.tid];
    if (F.tid < NCH * 32) hist[F.tid] = 0;
    __syncthreads();
    const bf16_t* V = (const bf16_t*)F.out; bf16_t* X1 = (bf16_t*)(F.ws + WS_X1); unsigned char* U2 = (unsigned char*)(F.ws + WS_U); const float* ada = (const float*)(F.ws + WS_ADA);
    int* topi = (int*)(F.ws + WS_TOPI); float* topw = (float*)(F.ws + WS_TOPW);
    const int l4 = F.lane * 4;
    for (int gi = F.c * 8 + F.wave; gi < T / 4; gi += F.G * 8) {
        const int g = T / 4 - 1 - gi;
        const int t0 = g * 4, b = t0 >> 11;
        f32x4 xv[4][4];
#pragma unroll
        for (int tk = 0; tk < 4; ++tk)
#pragma unroll
            for (int j = 0; j < 4; ++j) { const u32x2 w = *(const u32x2*)(V + (size_t)(t0 + tk) * 1024 + 256 * j + l4); xv[tk][j] = (f32x4){bf_lo(w.x), bf_hi(w.x), bf_lo(w.y), bf_hi(w.y)}; }
        float mean[4], rstd[4];
#pragma unroll
        for (int tk = 0; tk < 4; ++tk) { float s = 0.f;
#pragma unroll
            for (int j = 0; j < 4; ++j) s += (xv[tk][j][0] + xv[tk][j][1]) + (xv[tk][j][2] + xv[tk][j][3]);
            s = wave_sum(s); mean[tk] = s * (1.0f / 1024.0f); float q = 0.f;
#pragma unroll
            for (int j = 0; j < 4; ++j) { const f32x4 d = xv[tk][j] - mean[tk]; q += (d[0] * d[0] + d[1] * d[1]) + (d[2] * d[2] + d[3] * d[3]); }
            q = wave_sum(q); rstd[tk] = __builtin_amdgcn_rsqf(q * (1.0f / 1024.0f) + LN_EPS); }
#pragma unroll
        for (int j = 0; j < 4; ++j) {
            const int k = 256 * j + l4;
            const f32x4 lg1 = *(const f32x4*)(F.in[I_LN1G] + k), lb1 = *(const f32x4*)(F.in[I_LN1B] + k);
            const f32x4 sh = *(const f32x4*)(ada + (size_t)b * 6144 + 3072 + k), sc = *(const f32x4*)(ada + (size_t)b * 6144 + 4096 + k);
#pragma unroll
            for (int tk = 0; tk < 4; ++tk) { const f32x4 x1 = (xv[tk][j] - mean[tk]) * rstd[tk] * lg1 + lb1;
                if (!dry) *(u32x2*)(X1 + (size_t)(t0 + tk) * 1024 + k) = (u32x2){cvt_pk_bf16(x1[0], x1[1]), cvt_pk_bf16(x1[2], x1[3])};
                const f32x4 u2 = x1 * (sc + 1.0f) + sh; xv[tk][j] = u2;
                if (!dry) *(unsigned*)(U2 + (size_t)(t0 + tk) * 1024 + k) = cvt_pk4_fp8(u2[0], u2[1], u2[2], u2[3]); } }
#pragma unroll 1
        for (int eq = 0; eq < 4; ++eq) {
            f32x2 acc2[4][8];
#pragma unroll
            for (int e = 0; e < 8; ++e) { acc2[0][e] = (f32x2){0.f, 0.f}; acc2[1][e] = (f32x2){0.f, 0.f}; acc2[2][e] = (f32x2){0.f, 0.f}; acc2[3][e] = (f32x2){0.f, 0.f};
#pragma unroll
                for (int j = 0; j < 4; ++j) { const f32x4 w4 = *(const LAS f32x4*)(wrT + (eq * 8 + e) * 1024 + 256 * j + l4); const f32x2 wlo = {w4[0], w4[1]}, whi = {w4[2], w4[3]};
#pragma unroll
                    for (int tk = 0; tk < 4; ++tk) { const f32x2 xlo = {xv[tk][j][0], xv[tk][j][1]}, xhi = {xv[tk][j][2], xv[tk][j][3]};
                        acc2[tk][e] = __builtin_elementwise_fma(xlo, wlo, acc2[tk][e]); acc2[tk][e] = __builtin_elementwise_fma(xhi, whi, acc2[tk][e]); } }
                if (e & 1) __builtin_amdgcn_sched_barrier(0); }
            float acc[4][8];
#pragma unroll
            for (int tk = 0; tk < 4; ++tk)
#pragma unroll
                for (int e = 0; e < 8; ++e) acc[tk][e] = acc2[tk][e][0] + acc2[tk][e][1];
#pragma unroll
            for (int tk = 0; tk < 4; ++tk) {
                float v0, v1, v2, v3;
                { const bool up = (F.lane & 32) != 0;
                  v0 = (up ? acc[tk][4] : acc[tk][0]) + __shfl_xor(up ? acc[tk][0] : acc[tk][4], 32);
                  v1 = (up ? acc[tk][5] : acc[tk][1]) + __shfl_xor(up ? acc[tk][1] : acc[tk][5], 32);
                  v2 = (up ? acc[tk][6] : acc[tk][2]) + __shfl_xor(up ? acc[tk][2] : acc[tk][6], 32);
                  v3 = (up ? acc[tk][7] : acc[tk][3]) + __shfl_xor(up ? acc[tk][3] : acc[tk][7], 32); }
                { const bool up = (F.lane & 16) != 0;
                  const float a0 = (up ? v2 : v0) + __shfl_xor(up ? v0 : v2, 16), a1 = (up ? v3 : v1) + __shfl_xor(up ? v1 : v3, 16); v0 = a0; v1 = a1; }
                { const bool up = (F.lane & 8) != 0; v0 = (up ? v1 : v0) + __shfl_xor(up ? v0 : v1, 8); }
                v0 += __shfl_xor(v0, 4); v0 += __shfl_xor(v0, 2); v0 += __shfl_xor(v0, 1);
                const int e = eq * 8 + ((F.lane >> 5) & 1) * 4 + ((F.lane >> 4) & 1) * 2 + ((F.lane >> 3) & 1);
                if ((F.lane & 7) == 0) lg[(F.wave * 4 + tk) * 32 + e] = v0 + brs[e];
            }
        }
        asm volatile("s_waitcnt lgkmcnt(0)" ::: "memory");
        if (F.lane < 4) {
            const LAS float* L = lg + (F.wave * 4 + F.lane) * 32;
            float b0 = -3.0e38f, b1 = -3.0e38f, b2 = -3.0e38f, b3 = -3.0e38f; int i0 = 0, i1 = 0, i2 = 0, i3 = 0;
            for (int e = 0; e < 32; ++e) { const float x = L[e];
                if (x > b3) { b3 = x; i3 = e;
                    if (b3 > b2) { float tf = b2; b2 = b3; b3 = tf; int ti = i2; i2 = i3; i3 = ti;
                        if (b2 > b1) { tf = b1; b1 = b2; b2 = tf; ti = i1; i1 = i2; i2 = ti;
                            if (b1 > b0) { tf = b0; b0 = b1; b1 = tf; ti = i0; i0 = i1; i1 = ti; } } } } }
            const float p1 = fast_exp(b1 - b0), p2 = fast_exp(b2 - b0), p3 = fast_exp(b3 - b0), inv = 1.0f / (1.0f + p1 + p2 + p3);
            const int t = t0 + F.lane;
            *(int4*)(topi + (size_t)t * 4) = make_int4(i0, i1, i2, i3);
            *(f32x4*)(topw + (size_t)t * 4) = (f32x4){inv, p1 * inv, p2 * inv, p3 * inv};
            const int ch = t / TCH;
            if (!dry) { atomicAdd((int*)(hist + ch * 32 + i0), 1); atomicAdd((int*)(hist + ch * 32 + i1), 1); atomicAdd((int*)(hist + ch * 32 + i2), 1); atomicAdd((int*)(hist + ch * 32 + i3), 1); }
        }
    }
    __syncthreads();
    if (F.tid < NCH * 32) { const int h = hist[F.tid]; if (h && !dry) atomicAdd(F.ctl + CW_CNT + F.tid, (unsigned)h); }
    __syncthreads();
}

__device__ __forceinline__ void p10_dispatch(const Frame& F) {
    LAS int* lcnt = (LAS int*)F.lds; LAS int* lbase = lcnt + 32; LAS int* pstart = lcnt + 64;
    const int* topi = (const int*)(F.ws + WS_TOPI); int* pos = (int*)(F.ws + WS_POS); int* rowtok = (int*)(F.ws + WS_ROWTOK);
    for (int s = F.c; s < T / 256; s += F.G) {
        const int ch = (s * 256) / TCH;
        __syncthreads();
        if (F.tid < 32) { lcnt[F.tid] = 0; int ps = 0; for (int e = 0; e < F.tid; ++e) { const int n = (int)__hip_atomic_load(F.ctl + CW_CNT + ch * 32 + e, __ATOMIC_RELAXED, __HIP_MEMORY_SCOPE_AGENT); ps += (n + 255) & ~255; } pstart[F.tid] = ps; }
        __syncthreads();
        int e2[2], r2[2];
#pragma unroll
        for (int i = 0; i < 2; ++i) { const int a = F.tid + i * NTHR; e2[i] = topi[(size_t)(s * 256) * 4 + a]; r2[i] = atomicAdd((int*)(lcnt + e2[i]), 1); }
        __syncthreads();
        if (F.tid < 32) lbase[F.tid] = (int)atomicAdd(F.ctl + CW_CUR + ch * 32 + F.tid, (unsigned)lcnt[F.tid]);
        __syncthreads();
#pragma unroll
        for (int i = 0; i < 2; ++i) { const int a = F.tid + i * NTHR, slot = pstart[e2[i]] + lbase[e2[i]] + r2[i];
            pos[(size_t)(s * 256) * 4 + a] = slot; rowtok[(size_t)ch * ROWS_CH + slot] = s * 256 + (a >> 2); }
    }
}
__device__ __forceinline__ int moe_blocks(const Frame& F, int ch, LAS unsigned char* blk_e) {
    LAS int* sh = (LAS int*)(blk_e + 1152);
    __syncthreads();
    if (F.tid < 32) {
        int start = 0, mine = 0;
        for (int e = 0; e < 32; ++e) { const int n = ((int)__hip_atomic_load(F.ctl + CW_CNT + ch * 32 + e, __ATOMIC_RELAXED, __HIP_MEMORY_SCOPE_AGENT) + 255) >> 8; if (e < F.tid) start += n; if (e == F.tid) mine = n; }
        for (int i = 0; i < mine; ++i) blk_e[start + i] = (unsigned char)F.tid;
        if (F.tid == 31) sh[0] = start + mine;
    }
    __syncthreads();
    return sh[0];
}

__device__ __forceinline__ void p13_combine_ln2(const Frame& F, int ch, const bool dry) {
    const unsigned char* YC = (const unsigned char*)(F.ws + WS_YCH); const int* pos = (const int*)(F.ws + WS_POS); const float* topw = (const float*)(F.ws + WS_TOPW);
    const float* ada = (const float*)(F.ws + WS_ADA); const bf16_t* X1 = (const bf16_t*)(F.ws + WS_X1); float* O = F.out;
    const int l8 = F.lane * 8;
    for (int t0 = ch * TCH + F.c * 8 + F.wave; t0 < (ch + 1) * TCH; t0 += 2 * F.G * 8) {
        int tt[2]; tt[0] = t0; tt[1] = t0 + F.G * 8; const bool two = tt[1] < (ch + 1) * TCH; if (!two) tt[1] = t0;
        f32x4 v[2][2][2];
#pragma unroll
        for (int q = 0; q < 2; ++q) { const int t = tt[q], b = t >> 11;
            const int4 ps = *(const int4*)(pos + (size_t)t * 4); const f32x4 tw = *(const f32x4*)(topw + (size_t)t * 4);
#pragma unroll
            for (int j = 0; j < 2; ++j) { const int k = 512 * j + l8;
                const u32x2 y0 = *(const u32x2*)(YC + (size_t)ps.x * 1024 + k), y1 = *(const u32x2*)(YC + (size_t)ps.y * 1024 + k), y2 = *(const u32x2*)(YC + (size_t)ps.z * 1024 + k), y3 = *(const u32x2*)(YC + (size_t)ps.w * 1024 + k);
                const u32x4 xw = *(const u32x4*)(X1 + (size_t)t * 1024 + k);
                const f32x4 g2a = *(const f32x4*)(ada + (size_t)b * 6144 + 5120 + k), g2b = *(const f32x4*)(ada + (size_t)b * 6144 + 5120 + k + 4);
                const f32x4 ffa = fp8x4_to_f32(y0.x) * tw[0] + fp8x4_to_f32(y1.x) * tw[1] + fp8x4_to_f32(y2.x) * tw[2] + fp8x4_to_f32(y3.x) * tw[3];
                const f32x4 ffb = fp8x4_to_f32(y0.y) * tw[0] + fp8x4_to_f32(y1.y) * tw[1] + fp8x4_to_f32(y2.y) * tw[2] + fp8x4_to_f32(y3.y) * tw[3];
                v[q][j][0] = (f32x4){bf_lo(xw.x), bf_hi(xw.x), bf_lo(xw.y), bf_hi(xw.y)} * DN_ALPHA + g2a * ffa;
                v[q][j][1] = (f32x4){bf_lo(xw.z), bf_hi(xw.z), bf_lo(xw.w), bf_hi(xw.w)} * DN_ALPHA + g2b * ffb; } }
#pragma unroll
        for (int q = 0; q < 2; ++q) { const int t = tt[q];
            float s = 0.f;
#pragma unroll
            for (int j = 0; j < 2; ++j)
#pragma unroll
                for (int h = 0; h < 2; ++h) s += (v[q][j][h][0] + v[q][j][h][1]) + (v[q][j][h][2] + v[q][j][h][3]);
            s = wave_sum(s); const float mean = s * (1.0f / 1024.0f); float qq = 0.f;
#pragma unroll
            for (int j = 0; j < 2; ++j)
#pragma unroll
                for (int h = 0; h < 2; ++h) { const f32x4 d = v[q][j][h] - mean; qq += (d[0] * d[0] + d[1] * d[1]) + (d[2] * d[2] + d[3] * d[3]); }
            qq = wave_sum(qq); const float rstd = __builtin_amdgcn_rsqf(qq * (1.0f / 1024.0f) + LN_EPS);
            if (q == 0 || two) {
#pragma unroll
                for (int j = 0; j < 2; ++j)
#pragma unroll
                    for (int h = 0; h < 2; ++h) { const int k = 512 * j + l8 + 4 * h; const f32x4 g = *(const f32x4*)(F.in[I_LN2G] + k), bb = *(const f32x4*)(F.in[I_LN2B] + k);
                        const f32x4 o4 = (v[q][j][h] - mean) * rstd * g + bb;
                        if (!dry) *(f32x4*)(O + (size_t)t * 1024 + k) = o4; else if (o4[0] == 1.2345e30f) O[0] = 1.f; } }
        }
    }
}

constexpr int SC_QD = 0, SC_KI = 17408, SC_KE = 34816, SC_VT = 53248, SC_SC = 71680, SC_ST = 80896, SC_GV = 115712, SC_CS = 116224;
__device__ __forceinline__ bf16x8 ldfrag(const LAS unsigned char* p) { return *(const LAS bf16x8*)p; }
__device__ __forceinline__ void p3_scan(const Frame& F, const bool dry) {
    LAS unsigned char* L = F.lds;
    const int tid = F.tid, w = F.wave, lane = F.lane, fr = lane & 15, fq = lane >> 4;
    const int d = tid & 127, qd = tid >> 7;
    bf16_t* PH = (bf16_t*)(F.ws + WS_PH); const bf16_t* PHC = (const bf16_t*)(F.ws + WS_PHC);
    for (int it = F.c; it < 256; it += F.G) {
        const int b = it >> 3, h = (it >> 1) & 3, dir = it & 1;
        const float r0 = F.in[I_LBRAW][dir * 512 + h * 128 + d], r1 = F.in[I_LBRAW][1024 + dir * 512 + h * 128 + d];
        const float lbv = fast_sigmoid(r0 - r1), oml = 1.0f - lbv;
        f32x4 Sacc[8];
#pragma unroll
        for (int i = 0; i < 8; ++i) Sacc[i] = (f32x4){0.f, 0.f, 0.f, 0.f};
        __syncthreads();
        for (int i = tid; i < 34816 / 4; i += NTHR) ((LAS unsigned*)(L + SC_ST))[i] = 0u;
        const int cq = h * 128 + d, cz = 512 + dir * 512 + h * 128 + d, cv = 1536 + h * 128 + d;
        bf16_t rq[16], rz[16], rv[16];
        {   const int n = dir ? 3 : 0; const bf16_t* base = PHC + (size_t)(b * 256 + 64 * n + 16 * qd) * 2048;
#pragma unroll
            for (int i = 0; i < 16; ++i) { rq[i] = base[(size_t)i * 2048 + cq]; rz[i] = base[(size_t)i * 2048 + cz]; rv[i] = base[(size_t)i * 2048 + cv]; } }
        for (int s = 0; s < 36; ++s) {
            const bool lat = s >= 4; const int n = lat ? (dir ? 31 - (s - 4) : (s - 4)) : (dir ? 3 - s : s);
            float kk[16], cum[16]; float run = 0.f;
#pragma unroll
            for (int i = 0; i < 16; ++i) { const float sg = fast_sigmoid(bf2f(rz[i])); kk[i] = oml * (1.0f - sg); cum[i] = fast_log(lbv + oml * sg); }
            if (dir == 0) {
#pragma unroll
                for (int i = 0; i < 16; ++i) { run += cum[i]; cum[i] = run; }
            } else {
#pragma unroll
                for (int i = 15; i >= 0; --i) { run += cum[i]; cum[i] = run; }
            }
            ((LAS float*)(L + SC_CS))[qd * 128 + d] = run;
            __syncthreads();
            {   const LAS float* cs = (const LAS float*)(L + SC_CS);
                const float c0 = cs[d], c1 = cs[128 + d], c2 = cs[256 + d], c3 = cs[384 + d], tot = (c0 + c1) + (c2 + c3);
                float off;
                if (dir == 0) off = (qd > 0 ? c0 : 0.f) + (qd > 1 ? c1 : 0.f) + (qd > 2 ? c2 : 0.f);
                else off = (qd < 3 ? c3 : 0.f) + (qd < 2 ? c2 : 0.f) + (qd < 1 ? c1 : 0.f);
                const float g = fast_exp(tot);
                if (qd == 0) ((LAS float*)(L + SC_GV))[d] = g;
                unsigned ke[8], vt[8];
#pragma unroll
                for (int i = 0; i < 16; i += 2) {
                    const float ca = cum[i] + off, cb = cum[i + 1] + off;
                    const float ea = fast_exp(ca), eb = fast_exp(cb), ia = __builtin_amdgcn_rcpf(ea), ib = __builtin_amdgcn_rcpf(eb);
                    const float qa = bf2f(rq[i]), qb = bf2f(rq[i + 1]);
                    const float qda = qa * fast_sigmoid(qa) * ea, qdb = qb * fast_sigmoid(qb) * eb;
                    const float kia = kk[i] * ia, kib = kk[i + 1] * ib;
                    const unsigned wa = cvt_pk_bf16(qda, kia), wb = cvt_pk_bf16(qdb, kib);
                    *(LAS bf16_t*)(L + SC_QD + (16 * qd + i) * 272 + d * 2) = (bf16_t)(wa & 0xffffu);
                    *(LAS bf16_t*)(L + SC_KI + (16 * qd + i) * 272 + d * 2) = (bf16_t)(wa >> 16);
                    *(LAS bf16_t*)(L + SC_QD + (16 * qd + i + 1) * 272 + d * 2) = (bf16_t)(wb & 0xffffu);
                    *(LAS bf16_t*)(L + SC_KI + (16 * qd + i + 1) * 272 + d * 2) = (bf16_t)(wb >> 16);
                    ke[i >> 1] = cvt_pk_bf16(kia * g, kib * g);
                    vt[i >> 1] = (unsigned)rv[i] | ((unsigned)rv[i + 1] << 16);
                }
                *(LAS u32x4*)(L + SC_KE + d * 144 + 32 * qd) = (u32x4){ke[0], ke[1], ke[2], ke[3]};
                *(LAS u32x4*)(L + SC_KE + d * 144 + 32 * qd + 16) = (u32x4){ke[4], ke[5], ke[6], ke[7]};
                *(LAS u32x4*)(L + SC_VT + d * 144 + 32 * qd) = (u32x4){vt[0], vt[1], vt[2], vt[3]};
                *(LAS u32x4*)(L + SC_VT + d * 144 + 32 * qd + 16) = (u32x4){vt[4], vt[5], vt[6], vt[7]};
            }
            if (s + 1 < 36) {
                const int s1 = s + 1; const bool lat1 = s1 >= 4; const int n1 = lat1 ? (dir ? 31 - (s1 - 4) : (s1 - 4)) : (dir ? 3 - s1 : s1);
                const bf16_t* base = lat1 ? (const bf16_t*)PH + (size_t)(b * 2048 + 64 * n1 + 16 * qd) * 2048 : PHC + (size_t)(b * 256 + 64 * n1 + 16 * qd) * 2048;
#pragma unroll
                for (int i = 0; i < 16; ++i) { rq[i] = base[(size_t)i * 2048 + cq]; rz[i] = base[(size_t)i * 2048 + cz]; rv[i] = base[(size_t)i * 2048 + cv]; }
            }
            __syncthreads();
            f32x4 oacc[4];
#pragma unroll
            for (int i = 0; i < 4; ++i) oacc[i] = (f32x4){0.f, 0.f, 0.f, 0.f};
            const int kb = fq * 16;
            if (lat) {
                const int ct = w >> 1, st0 = 2 * (w & 1);
#pragma unroll
                for (int j = 0; j < 2; ++j) { const int st = st0 + j; f32x4 sa = (f32x4){0.f, 0.f, 0.f, 0.f};
#pragma unroll
                    for (int ks = 0; ks < 4; ++ks) sa = __builtin_amdgcn_mfma_f32_16x16x32_bf16(ldfrag(L + SC_KI + (16 * st + fr) * 272 + ks * 64 + kb), ldfrag(L + SC_QD + (16 * ct + fr) * 272 + ks * 64 + kb), sa, 0, 0, 0);
                    const int cc = 16 * ct + fr, s0 = 16 * st + 4 * fq;
#pragma unroll
                    for (int i = 0; i < 4; ++i) { const bool keep = dir ? (s0 + i >= cc) : (s0 + i <= cc); sa[i] = keep ? sa[i] : 0.f; }
                    *(LAS u32x2*)(L + SC_SC + cc * 144 + s0 * 2) = (u32x2){cvt_pk_bf16(sa[0], sa[1]), cvt_pk_bf16(sa[2], sa[3])}; }
#pragma unroll
                for (int ct2 = 0; ct2 < 4; ++ct2)
#pragma unroll
                    for (int ks = 0; ks < 4; ++ks) oacc[ct2] = __builtin_amdgcn_mfma_f32_16x16x32_bf16(ldfrag(L + SC_ST + (16 * w + fr) * 272 + ks * 64 + kb), ldfrag(L + SC_QD + (16 * ct2 + fr) * 272 + ks * 64 + kb), oacc[ct2], 0, 0, 0);
            }
            {   const bf16x8 v0 = ldfrag(L + SC_VT + (16 * w + fr) * 144 + kb), v1 = ldfrag(L + SC_VT + (16 * w + fr) * 144 + 64 + kb);
#pragma unroll
                for (int dt = 0; dt < 8; ++dt) { const f32x4 gv = *(const LAS f32x4*)(L + SC_GV + (16 * dt + 4 * fq) * 4);
                    f32x4 a = Sacc[dt] * gv;
                    a = __builtin_amdgcn_mfma_f32_16x16x32_bf16(ldfrag(L + SC_KE + (16 * dt + fr) * 144 + kb), v0, a, 0, 0, 0);
                    a = __builtin_amdgcn_mfma_f32_16x16x32_bf16(ldfrag(L + SC_KE + (16 * dt + fr) * 144 + 64 + kb), v1, a, 0, 0, 0);
                    Sacc[dt] = a; } }
            __syncthreads();
#pragma unroll
            for (int dt = 0; dt < 8; ++dt) *(LAS u32x2*)(L + SC_ST + (16 * w + fr) * 272 + (16 * dt + 4 * fq) * 2) = (u32x2){cvt_pk_bf16(Sacc[dt][0], Sacc[dt][1]), cvt_pk_bf16(Sacc[dt][2], Sacc[dt][3])};
            if (lat) {
                const bf16x8 v0 = ldfrag(L + SC_VT + (16 * w + fr) * 144 + kb), v1 = ldfrag(L + SC_VT + (16 * w + fr) * 144 + 64 + kb);
                bf16_t* ob = PH + (size_t)(b * 2048 + 64 * n) * 2048 + 512 + dir * 512 + h * 128 + 16 * w + 4 * fq;
#pragma unroll
                for (int ct2 = 0; ct2 < 4; ++ct2) {
                    f32x4 a = oacc[ct2];
                    a = __builtin_amdgcn_mfma_f32_16x16x32_bf16(v0, ldfrag(L + SC_SC + (16 * ct2 + fr) * 144 + kb), a, 0, 0, 0);
                    a = __builtin_amdgcn_mfma_f32_16x16x32_bf16(v1, ldfrag(L + SC_SC + (16 * ct2 + fr) * 144 + 64 + kb), a, 0, 0, 0);
                    if (!dry) *(u32x2*)(ob + (size_t)(16 * ct2 + fr) * 2048) = (u32x2){cvt_pk_bf16(a[0], a[1]), cvt_pk_bf16(a[2], a[3])};
                    else if (a[0] == 1.2345e30f) ob[0] = 1; }
            }
        }
        __syncthreads();
    }
}

typedef short s16x4 __attribute__((ext_vector_type(4)));
__device__ __forceinline__ s16x4 tr_read(unsigned lds_addr) { s16x4 r; asm volatile("ds_read_b64_tr_b16 %0, %1\n\ts_waitcnt lgkmcnt(0)" : "=&v"(r) : "v"(lds_addr) : "memory"); return r; }
__device__ __forceinline__ void tr_read8(unsigned a0, unsigned a1, unsigned a2, unsigned a3, unsigned d, s16x4 (&r)[8]) {
    asm volatile("ds_read_b64_tr_b16 %0, %8\n\tds_read_b64_tr_b16 %1, %9\n\tds_read_b64_tr_b16 %2, %10\n\tds_read_b64_tr_b16 %3, %11\n\t"
                 "ds_read_b64_tr_b16 %4, %12\n\tds_read_b64_tr_b16 %5, %13\n\tds_read_b64_tr_b16 %6, %14\n\tds_read_b64_tr_b16 %7, %15\n\ts_waitcnt lgkmcnt(0)"
                 : "=&v"(r[0]), "=&v"(r[1]), "=&v"(r[2]), "=&v"(r[3]), "=&v"(r[4]), "=&v"(r[5]), "=&v"(r[6]), "=&v"(r[7])
                 : "v"(a0), "v"(a0 + d), "v"(a1), "v"(a1 + d), "v"(a2), "v"(a2 + d), "v"(a3), "v"(a3 + d) : "memory");
}
__device__ __forceinline__ void tr_read4(unsigned a0, unsigned a1, unsigned d, s16x4 (&r)[4]) {
    asm volatile("ds_read_b64_tr_b16 %0, %4\n\tds_read_b64_tr_b16 %1, %5\n\tds_read_b64_tr_b16 %2, %6\n\tds_read_b64_tr_b16 %3, %7\n\ts_waitcnt lgkmcnt(0)"
                 : "=&v"(r[0]), "=&v"(r[1]), "=&v"(r[2]), "=&v"(r[3]) : "v"(a0), "v"(a0 + d), "v"(a1), "v"(a1 + d) : "memory");
}
__device__ __forceinline__ bf16x8 cat4(s16x4 a, s16x4 b) { return (bf16x8){a[0], a[1], a[2], a[3], b[0], b[1], b[2], b[3]}; }
constexpr int FO_C = 131072, FO_S = 139264;
__device__ __forceinline__ void p4_fourier(const Frame& F) {
    LAS unsigned char* L = F.lds;
    const int tid = F.tid, w = F.wave, lane = F.lane, fr = lane & 15, fq = lane >> 4;
    const bf16_t* PA = (const bf16_t*)(F.ws + WS_PA); unsigned char* Y = (unsigned char*)(F.ws + WS_Y);
    __syncthreads();
    for (int i = tid; i < 4096; i += NTHR) { const int k2 = i >> 6, c = i & 63; const float a = (float)((k2 * c) & 63) * (1.0f / 64.0f);
        *(LAS bf16_t*)(L + FO_C + i * 2) = (bf16_t)(cvt_pk_bf16(__builtin_amdgcn_cosf(a) * 0.125f, 0.f) & 0xffffu);
        *(LAS bf16_t*)(L + FO_S + i * 2) = (bf16_t)(cvt_pk_bf16(__builtin_amdgcn_sinf(a) * 0.125f, 0.f) & 0xffffu); }
    bf16x8 Gf[2][2];
#pragma unroll
    for (int nt = 0; nt < 2; ++nt)
#pragma unroll
        for (int ks = 0; ks < 2; ++ks) { unsigned pk[4];
#pragma unroll
            for (int j = 0; j < 8; j += 2) { const int k1 = 16 * nt + fr, ra = 8 * fq + j, rb = ra + 1; const float aa = (float)((k1 * ra) & 31) * (1.0f / 32.0f), ab = (float)((k1 * rb) & 31) * (1.0f / 32.0f);
                const float va = (ks ? __builtin_amdgcn_sinf(aa) : __builtin_amdgcn_cosf(aa)) * 0.17677669529663687f, vb = (ks ? __builtin_amdgcn_sinf(ab) : __builtin_amdgcn_cosf(ab)) * 0.17677669529663687f;
                pk[j >> 1] = cvt_pk_bf16(va, vb); }
            u32x4 t4 = (u32x4){pk[0], pk[1], pk[2], pk[3]}; Gf[nt][ks] = *(bf16x8*)&t4; }
    const unsigned lbase = (unsigned)(size_t)L;
    for (int it = F.c; it < 1024; it += F.G) {
        const int xcd = it & 7, jj = it >> 3, slab = 4 * xcd + (jj & 3), b = jj >> 2;
        __syncthreads();
        {   const bf16_t* src = PA + (size_t)(b * 32 + slab) * 2048 * 32;
            u32x4 v[16];
#pragma unroll
            for (int n = 0; n < 16; ++n) v[n] = *(const u32x4*)(src + (size_t)(tid + NTHR * n) * 8);
#pragma unroll
            for (int n = 0; n < 16; ++n) *(LAS u32x4*)(L + (tid + NTHR * n) * 16) = v[n]; }
        __syncthreads();
#pragma unroll 1
        for (int rr = 0; rr < 4; ++rr) {
            const int r = w + 8 * rr;
            f32x4 acc[8];
#pragma unroll
            for (int i = 0; i < 8; ++i) acc[i] = (f32x4){0.f, 0.f, 0.f, 0.f};
            s16x4 tr[8];
            {   unsigned aa[4];
#pragma unroll
                for (int ks = 0; ks < 4; ++ks) { const int ri = ks >> 1, c0 = 32 * (ks & 1) + 8 * fq + (fr >> 2); aa[ks] = lbase + (unsigned)((r * 64 + c0) * 64 + ri * 32 + (fr & 3) * 8); }
                tr_read8(aa[0], aa[1], aa[2], aa[3], 4u * 64u, tr); }
#pragma unroll
            for (int ks = 0; ks < 4; ++ks) {
                const int ri = ks >> 1;
                const bf16x8 af = cat4(tr[2 * ks], tr[2 * ks + 1]);
#pragma unroll
                for (int nt = 0; nt < 8; ++nt) { const int ro = nt >> 2, k2 = 16 * (nt & 3) + fr;
                    u32x4 bw = *(const LAS u32x4*)(L + ((ro == ri) ? FO_C : FO_S) + (k2 * 64 + 32 * (ks & 1) + 8 * fq) * 2);
                    if (ro == 1 && ri == 0) { bw.x ^= 0x80008000u; bw.y ^= 0x80008000u; bw.z ^= 0x80008000u; bw.w ^= 0x80008000u; }
                    acc[nt] = __builtin_amdgcn_mfma_f32_16x16x32_bf16(af, *(bf16x8*)&bw, acc[nt], 0, 0, 0); }
            }
#pragma unroll
            for (int nt = 0; nt < 8; ++nt) { const int ro = nt >> 2, k2 = 16 * (nt & 3) + fr;
                *(LAS u32x2*)(L + (r * 64 + k2) * 64 + ro * 32 + fq * 8) = (u32x2){cvt_pk_bf16(acc[nt][0], acc[nt][1]), cvt_pk_bf16(acc[nt][2], acc[nt][3])}; }
        }
        __syncthreads();
#pragma unroll 1
        for (int kk = 0; kk < 8; ++kk) {
            const int k2 = 8 * w + kk;
            f32x4 a2[2] = {(f32x4){0.f, 0.f, 0.f, 0.f}, (f32x4){0.f, 0.f, 0.f, 0.f}};
            s16x4 t4[4];
            {   const int r0 = 8 * fq + (fr >> 2); const unsigned a0 = lbase + (unsigned)((r0 * 64 + k2) * 64 + (fr & 3) * 8);
                tr_read4(a0, a0 + 32u, 4u * 64u * 64u, t4); }
#pragma unroll
            for (int ks = 0; ks < 2; ++ks) {
                const bf16x8 af = cat4(t4[2 * ks], t4[2 * ks + 1]);
                a2[0] = __builtin_amdgcn_mfma_f32_16x16x32_bf16(af, Gf[0][ks], a2[0], 0, 0, 0);
                a2[1] = __builtin_amdgcn_mfma_f32_16x16x32_bf16(af, Gf[1][ks], a2[1], 0, 0, 0);
            }
#pragma unroll
            for (int nt = 0; nt < 2; ++nt) { const int k1 = 16 * nt + fr;
                *(unsigned*)(Y + (size_t)(b * 2048 + k1 * 64 + k2) * 1024 + slab * 16 + 4 * fq) = cvt_pk4_fp8(a2[nt][0], a2[nt][1], a2[nt][2], a2[nt][3]); }
        }
    }
    __syncthreads();
}

struct Args { const float* in[22]; float* out; unsigned char* ws; int ph_lo, ph_hi; };
constexpr int N_PHASES = 9 + 3 * NCH;

__global__ void __launch_bounds__(NTHR, 2) mega_fwd(Args args) {
    extern __shared__ __attribute__((aligned(16))) unsigned char lds_raw[];
    Frame F;
    F.lds = (LAS unsigned char*)lds_raw;
    F.tid = threadIdx.x; F.lane = F.tid & 63; F.wave = __builtin_amdgcn_readfirstlane(F.tid >> 6);
    F.G = gridDim.x; F.c = blockIdx.x;
    F.in = args.in;
    F.out = args.out; F.ws = args.ws; F.ctl = (unsigned*)(args.ws + WS_CTL);
    volatile LAS unsigned* misc = (volatile LAS unsigned*)(F.lds + LDS_MISC);
    if (F.tid < 4) misc[F.tid] = 0u;
    __syncthreads();
    XcdBarrier bar = xcd_barrier_post(F.ctl, misc);
    const int lo = args.ph_lo, hi = args.ph_hi;
#ifndef PHASE_MASK
#define PHASE_MASK 0xFFFFFFFFu
#endif
#define IN(k) ((((PHASE_MASK) >> (k)) & 1u) && lo <= (k) && (k) < hi)
#define SEAM(k) do { if (IN(k) && IN((k) + 1)) xcd_barrier(bar); } while (0)
#ifndef REP_MASK
#define REP_MASK 0u
#endif
#define REPS(b) ((((REP_MASK) >> (b)) & 1u) ? 2 : 1)
#define REPBAR(b, r) do { if ((((REP_MASK) >> (b)) & 1u) && (r) == 0) xcd_barrier(bar); } while (0)
    unsigned char* ws = F.ws;
    LAS unsigned char* blk_e = F.lds + LDS_MISC + 64;
#ifdef PR_A
    unsigned long long* stamps = (unsigned long long*)(ws + 980 * MiB);
#define STAMP(slot) do { if (F.tid == 0) stamps[(slot) * 256 + F.c] = __builtin_amdgcn_s_memrealtime(); } while (0)
#else
#define STAMP(slot) do { } while (0)
#endif
    STAMP(0);

    if (IN(0)) { for (int r = 0; r < REPS(0); ++r) { p0_ada(F); p0_fold(F); p0_convert(F); REPBAR(0, r); } }
    STAMP(1);
    SEAM(0);
    if (IN(1)) { for (int r = 0; r < REPS(1); ++r) { p1_uprep(F); REPBAR(1, r); } }
    STAMP(2);
    SEAM(1);
    if (IN(2)) {
        ProbP1 P{(const char*)(ws + WS_U), 8, 1024u, 1024u, (const char*)(ws + WS_WIN1T), (unsigned)(WS_UC - WS_U), F.G, F.c};
        EpiP1 E{(bf16_t*)(ws + WS_PA), (bf16_t*)(ws + WS_PH), (bf16_t*)(ws + WS_PHC)};
        for (int r = 0; r < REPS(2); ++r) { pg8::gemm_phase<ProbP1, EpiP1, true, false, true>(F.lds, P, E); REPBAR(2, r); }
    }
    STAMP(3);
    SEAM(2);
    if (IN(3)) {
#ifndef NO_FOURIER
        for (int r = 0; r < REPS(4); ++r) { p4_fourier(F); REPBAR(4, r); }
        STAMP(5);
#endif
#ifndef NO_SCAN
        for (int r = 0; r < REPS(3); ++r) { p3_scan(F, r + 1 < REPS(3)); REPBAR(3, r); }
        STAMP(4);
#endif
#ifndef NO_P2GEMM
        ProbDense P{(const char*)(ws + WS_U), 8, 1024u, 1024u, (const char*)(ws + WS_WIN2T), 256, 10, F.G, F.c, 0};
        EpiP2 E{(bf16_t*)(ws + WS_PG), (bf16_t*)F.out};
        for (int r = 0; r < REPS(5); ++r) { pg8::gemm_phase<ProbDense, EpiP2, true, false, true>(F.lds, P, E); REPBAR(5, r); }
#endif
    }
    STAMP(6);
    SEAM(3);
    if (IN(4)) { for (int r = 0; r < REPS(6); ++r) { p6_readout(F); REPBAR(6, r); } }
    STAMP(7);
    SEAM(4);
    if (IN(5)) {
        ProbDense P{(const char*)(ws + WS_Y), 8, 1024u, 1024u, (const char*)(ws + WS_WMT), 256, 4, F.G, F.c, 1};
        EpiM1 E{(const bf16_t*)F.out, (unsigned char*)(ws + WS_PA)};
        for (int r = 0; r < REPS(7); ++r) { pg8::gemm_phase<ProbDense, EpiM1, true, true, true>(F.lds, P, E); REPBAR(7, r); }
    }
    STAMP(8);
    SEAM(5);
    if (IN(6)) {
        ProbDense P{(const char*)(ws + WS_PA), 8, 1024u, 1024u, (const char*)(ws + WS_WOT), 256, 4, F.G, F.c, 0};
        EpiM2 E{F.in[I_X], (const float*)(ws + WS_ADA), (bf16_t*)F.out};
        for (int r = 0; r < REPS(8); ++r) { pg8::gemm_phase<ProbDense, EpiM2, true, false, true>(F.lds, P, E); REPBAR(8, r); }
    }
    STAMP(9);
    SEAM(6);
    if (IN(7)) { for (int r = 0; r < REPS(9); ++r) { p9_ln1_router(F, r + 1 < REPS(9)); REPBAR(9, r); } }
    STAMP(10);
    SEAM(7);
    if (IN(8)) { p10_dispatch(F); }
    STAMP(11);
    SEAM(8);
#pragma unroll
    for (int ch = 0; ch < NCH; ++ch) {
        if (IN(9 + 3 * ch)) {
            const int nblk = moe_blocks(F, ch, blk_e);
            ProbMoE<true> P{(const char*)(ws + WS_U), 8, 1024u, 1024u, (const char*)(ws + WS_WGUT), (size_t)2048 * 1024, 8, nblk, F.G, F.c, (const int*)(ws + WS_ROWTOK) + (size_t)ch * ROWS_CH, blk_e};
            EpiGU E{F.in[I_BGU], (unsigned char*)(ws + WS_ACT)};
#ifdef GU_DRY
            pg8::gemm_phase<ProbMoE<true>, EpiGU, true, false, true, GU_DRY>(F.lds, P, E); xcd_barrier(bar);
#endif
            for (int r = 0; r < (ch == 0 ? REPS(10) : 1); ++r) { pg8::gemm_phase<ProbMoE<true>, EpiGU, true, false, true>(F.lds, P, E); if (ch == 0) REPBAR(10, r); }
        }
        STAMP(12);
        SEAM(9 + 3 * ch);
        if (IN(10 + 3 * ch)) {
            const int nblk = moe_blocks(F, ch, blk_e);
            ProbMoE<false> P{(const char*)(ws + WS_ACT), 8, 1024u, 1024u, (const char*)(ws + WS_WDNT), (size_t)1024 * 1024, 4, nblk, F.G, F.c, nullptr, blk_e};
            EpiDN E{F.in[I_BDN], (unsigned char*)(ws + WS_YCH)};
            for (int r = 0; r < (ch == 0 ? REPS(11) : 1); ++r) { pg8::gemm_phase<ProbMoE<false>, EpiDN, true, false, true>(F.lds, P, E); if (ch == 0) REPBAR(11, r); }
        }
        STAMP(13);
        SEAM(10 + 3 * ch);
        if (IN(11 + 3 * ch)) { for (int r = 0; r < (ch == 0 ? REPS(12) : 1); ++r) { p13_combine_ln2(F, ch, ch == 0 && r + 1 < REPS(12)); if (ch == 0) REPBAR(12, r); } }
        STAMP(14);
        SEAM(11 + 3 * ch);
    }
#ifdef DBG_K
    xcd_barrier(bar);
    {
        const unsigned char* buf = (DBG_OUT) ? (const unsigned char*)F.out : (const unsigned char*)(ws + (size_t)(DBG_OFF));
        const size_t wpr = (size_t)(DBG_CW) / 4, nw = (size_t)(DBG_ROWS) * wpr;
        unsigned long long cs = 0; unsigned bad = 0;
        for (size_t i = (size_t)F.c * NTHR + F.tid; i < nw; i += (size_t)F.G * NTHR) { const size_t r = i / wpr, cw = i % wpr; const unsigned w = *(const unsigned*)(buf + r * (size_t)(DBG_LD) + (DBG_C0) + cw * 4); cs += w;
            if (DBG_F32) { if ((w & 0x7f800000u) == 0x7f800000u) ++bad; } else { if ((w & 0x7f80u) == 0x7f80u) ++bad; if ((w & 0x7f800000u) == 0x7f800000u) ++bad; } }
        for (int o = 32; o >= 1; o >>= 1) { cs += __shfl_xor(cs, o); bad += __shfl_xor(bad, o); }
        if (F.lane == 0) { atomicAdd((unsigned long long*)(F.ctl + 8192), cs); atomicAdd(F.ctl + 8200, bad); }
        if (F.c == 0 && F.tid == 0) atomicAdd(F.ctl + 8201, xb_ld(&F.ctl[XB_TMO]));
    }
    xcd_barrier(bar);
    {
        const unsigned long long cs = __hip_atomic_load((unsigned long long*)(F.ctl + 8192), __ATOMIC_RELAXED, __HIP_MEMORY_SCOPE_AGENT);
        const unsigned bad = xb_ld(F.ctl + 8200), tmo = xb_ld(F.ctl + 8201);
        const float val = (float)(unsigned)((cs ^ (cs >> 16) ^ (cs >> 32)) & 0xFFFFu) * (1.0f / 65536.0f) + (bad ? 2.0f : 0.0f) + (tmo ? 4.0f : 0.0f);
        for (size_t i = (size_t)F.c * NTHR + F.tid; i < (size_t)T * D; i += (size_t)F.G * NTHR) F.out[i] = val;
    }
    return;
#endif
#ifdef PR_A
    xcd_barrier(bar);
    {
        auto maxs = [&](int sl) { unsigned long long m = 0; for (int w = 0; w < (int)F.G; ++w) { const unsigned long long v = stamps[sl * 256 + w]; m = v > m ? v : m; } return m; };
        auto dur = [&](int sl) -> float {
            if (sl == 4) { const unsigned long long st = maxs(3); double a = 0; for (int w = 0; w < (int)F.G; ++w) a += (double)(stamps[4 * 256 + w] - st); return (float)(a / F.G) * 0.01f; }
            if (sl == 5) { double a = 0; for (int w = 0; w < (int)F.G; ++w) a += (double)(stamps[5 * 256 + w] - stamps[4 * 256 + w]); return (float)(a / F.G) * 0.01f; }
            if (sl == 6) { double a = 0; for (int w = 0; w < (int)F.G; ++w) a += (double)(stamps[6 * 256 + w] - stamps[5 * 256 + w]); return (float)(a / F.G) * 0.01f; }
            if (sl == 16) return (float)(maxs(6) - maxs(3)) * 0.01f;
            return (float)(maxs(sl) - maxs(sl - 1)) * 0.01f; };
        const float va = rintf(dur(PR_A) * 0.1f + (PR_OFF)) * 0.1f, vb = rintf(dur(PR_B) * 0.1f + (PR_OFF)) * 10.0f;
        for (size_t i = (size_t)F.c * NTHR + F.tid; i < (size_t)T * D; i += (size_t)F.G * NTHR) F.out[i] = va;
        __syncthreads();
        if (F.c == 0 && F.tid == 0) F.out[12345] = vb;
    }
    return;
#endif
    if (F.c == 0 && F.tid == 0 && hi == N_PHASES) { if (xb_ld(&F.ctl[XB_TMO]) != 0u) F.out[0] = __builtin_nanf(""); }
#undef IN
#undef SEAM
}

extern "C" void kernel_launch(void* const* d_in, const int* in_sizes, int n_in, void* d_out, int out_size, void* d_ws, size_t ws_size, hipStream_t stream) {
    static int grid = 0;
    if (grid == 0) {
        if (n_in != 22 || out_size != T * D || ws_size < WS_END) { fprintf(stderr, "kernel_launch: unexpected shapes (n_in %d, out %d, ws %zu)\n", n_in, out_size, ws_size); grid = -1; return; }
        int dev = 0, cus = 0, per_cu = 0;
        if (hipGetDevice(&dev) != hipSuccess || hipDeviceGetAttribute(&cus, hipDeviceAttributeMultiprocessorCount, dev) != hipSuccess) { grid = -1; return; }
        if (hipFuncSetAttribute((const void*)mega_fwd, hipFuncAttributeMaxDynamicSharedMemorySize, LDS_BYTES) != hipSuccess) { fprintf(stderr, "kernel_launch: hipFuncSetAttribute failed\n"); grid = -1; return; }
        if (hipOccupancyMaxActiveBlocksPerMultiprocessor(&per_cu, (const void*)mega_fwd, NTHR, LDS_BYTES) != hipSuccess || per_cu < 1) fprintf(stderr, "kernel_launch: occupancy query reports %d blocks per CU\n", per_cu);
        (void)hipGetLastError();
        grid = cus;
    }
    if (grid < 0) return;
    (void)hipMemsetAsync((char*)d_ws + WS_CTL, 0, CTL_BYTES, stream);
    Args a{};
    for (int i = 0; i < 22; ++i) a.in[i] = (const float*)d_in[i];
    a.out = (float*)d_out; a.ws = (unsigned char*)d_ws; a.ph_lo = 0; a.ph_hi = N_PHASES;
#ifdef DBG_K
    a.ph_hi = DBG_K;
#endif
    hipLaunchKernelGGL(mega_fwd, dim3(grid), dim3(NTHR), LDS_BYTES, stream, a);
}
```

```cpp
#include <hip/hip_runtime.h>
#include <cstdio>
#include <cstdint>

#define LAS __attribute__((address_space(3)))
typedef unsigned short bf16_t;
typedef short bf16x8 __attribute__((ext_vector_type(8)));
typedef short bf16x4 __attribute__((ext_vector_type(4)));
typedef float f32x4 __attribute__((ext_vector_type(4)));
typedef float f32x2 __attribute__((ext_vector_type(2)));
typedef unsigned u32x4 __attribute__((ext_vector_type(4)));
typedef unsigned u32x2 __attribute__((ext_vector_type(2)));

constexpr int D = 1024, NB = 32, SEQ = 2048, T = NB * SEQ, CTX = 256, TCX = NB * CTX;
#ifndef NCH_SET
#define NCH_SET 1
#endif
constexpr int NEXP = 32, TOPK = 4;
constexpr int NCH = NCH_SET, TCH = T / NCH;
constexpr int ROWS_CH = TCH * TOPK + NEXP * 256;
constexpr float DN_ALPHA = 1.189207115002721f;
constexpr float LN_EPS = 1e-5f, RMS_EPS = 1e-6f;
constexpr int NTHR = 512;

constexpr size_t MiB = 1ull << 20;
constexpr size_t WS_CTL = 0;
constexpr size_t CTL_BYTES = 65536;
constexpr size_t WS_ADA = 65536;
constexpr size_t WS_WIN1T = 1 * MiB;
constexpr size_t WS_WIN2T = 7 * MiB;
constexpr size_t WS_WMT = 12 * MiB;
constexpr size_t WS_WOT = 14 * MiB;
constexpr size_t WS_WGUT = 16 * MiB;
constexpr size_t WS_WDNT = 80 * MiB;
constexpr size_t WS_TOPI = 112 * MiB;
constexpr size_t WS_TOPW = 113 * MiB;
constexpr size_t WS_POS = 114 * MiB;
constexpr size_t WS_ROWTOK = 115 * MiB;
constexpr size_t WS_U = 120 * MiB;
constexpr size_t WS_PA = 184 * MiB;
constexpr size_t WS_PH = 312 * MiB;
constexpr size_t WS_PHC = 568 * MiB;
constexpr size_t WS_PG = 600 * MiB;
constexpr size_t WS_Y = 664 * MiB;
constexpr size_t WS_UC = WS_Y;
constexpr size_t WS_ACT = WS_PA;
constexpr size_t WS_YCH = WS_PA + 264 * MiB;
constexpr size_t WS_X1 = WS_YCH + 264 * MiB;
constexpr size_t WS_END = 976 * MiB;
static_assert(WS_X1 + 128 * MiB <= WS_END && (size_t)ROWS_CH * 1024 <= 264 * MiB && WS_Y + 128 * MiB <= WS_END, "ws map");
constexpr int CW_CNT = 4096;
constexpr int CW_CUR = 4096 + 64;

constexpr int LDS_SCRATCH = 147456;
constexpr int LDS_MISC = LDS_SCRATCH;
constexpr int LDS_BYTES = LDS_SCRATCH + 2048;

typedef __bf16 bf16x2_t __attribute__((ext_vector_type(2)));
__device__ __forceinline__ unsigned cvt_pk_bf16(float lo, float hi) { const f32x2 v = {lo, hi}; const bf16x2_t r = __builtin_convertvector(v, bf16x2_t); return __builtin_bit_cast(unsigned, r); }
__device__ __forceinline__ unsigned cvt_pk4_fp8(float a, float b, float c, float d) {
    a = fminf(fmaxf(a, -448.f), 448.f); b = fminf(fmaxf(b, -448.f), 448.f); c = fminf(fmaxf(c, -448.f), 448.f); d = fminf(fmaxf(d, -448.f), 448.f);
    int w = __builtin_amdgcn_cvt_pk_fp8_f32(a, b, 0, false); w = __builtin_amdgcn_cvt_pk_fp8_f32(c, d, w, true); return (unsigned)w; }
constexpr float W8_SCALE = 32.0f, W8_INV = 1.0f / 32.0f;
typedef float f32x2v __attribute__((ext_vector_type(2)));
__device__ __forceinline__ f32x4 fp8x4_to_f32(unsigned w) { const f32x2v a = __builtin_amdgcn_cvt_pk_f32_fp8((int)w, false), b = __builtin_amdgcn_cvt_pk_f32_fp8((int)w, true); return (f32x4){a[0], a[1], b[0], b[1]}; }
__device__ __forceinline__ u32x4 widen16(u32x2 a, u32x2 b) {
    const u32x2 rx = __builtin_amdgcn_permlane16_swap(a.x, b.x, false, false), ry = __builtin_amdgcn_permlane16_swap(a.y, b.y, false, false);
    return (u32x4){rx[0], ry[0], rx[1], ry[1]}; }
__device__ __forceinline__ float bf_lo(unsigned w) { return __uint_as_float(w << 16); }
__device__ __forceinline__ float bf_hi(unsigned w) { return __uint_as_float(w & 0xffff0000u); }
__device__ __forceinline__ float bf2f(bf16_t v) { return __uint_as_float(((unsigned)v) << 16); }
__device__ __forceinline__ float fast_exp(float x) { return __builtin_amdgcn_exp2f(x * 1.4426950408889634f); }
__device__ __forceinline__ float fast_sigmoid(float x) { return __builtin_amdgcn_rcpf(1.0f + fast_exp(-x)); }
__device__ __forceinline__ float fast_log(float x) { return __builtin_amdgcn_logf(x) * 0.6931471805599453f; }

#define XB_TMO      128
#define XB_XCNT(j)  (256  + 64 * (j))
#define XB_XSUB(j)  (1280 + 64 * (j))
#define XB_XGEN(j)  (2304 + 64 * (j))
#define XB_TOP      3328
#define XB_TOPGEN   3392
#define XCD_BAR_WORDS 3456
#define XB_SPIN_CAP (1u << 18)

__device__ __forceinline__ unsigned xb_ld(unsigned* p)              { return __hip_atomic_load(p, __ATOMIC_RELAXED, __HIP_MEMORY_SCOPE_AGENT); }
__device__ __forceinline__ unsigned xb_add(unsigned* p, unsigned v) { return __hip_atomic_fetch_add(p, v, __ATOMIC_RELAXED, __HIP_MEMORY_SCOPE_AGENT); }
__device__ __forceinline__ unsigned xb_xcc_id() { return (unsigned)__builtin_amdgcn_s_getreg((3 << 11) | 20) & 0xFu; }
#define XB_SPIN(cond, bar) do { unsigned _sp = 0; while (cond) { __builtin_amdgcn_s_sleep(1); \
    if ((++_sp & 255u) == 0u) { if (xb_ld(&(bar)[XB_TMO])) break; if (_sp > XB_SPIN_CAP) { atomicAdd(&(bar)[XB_TMO], 1u); break; } } } } while (0)

struct XcdBarrier { unsigned* bar; unsigned x; volatile LAS unsigned* st; };

__device__ __forceinline__ XcdBarrier xcd_barrier_post(unsigned* bar, volatile LAS unsigned* st) {
    XcdBarrier b; b.bar = bar; b.x = xb_xcc_id(); b.st = st;
    if (threadIdx.x == 0) (void)xb_add(&bar[XB_XCNT(b.x)], 1u);
    return b;
}
__device__ __forceinline__ void xcd_barrier_complete(unsigned* bar, unsigned x, unsigned& nloc, unsigned& nx) {
    const unsigned G = gridDim.x * gridDim.y * gridDim.z;
    unsigned sum, cnt, mine, sp = 0u;
    for (;;) {
        sum = 0u; cnt = 0u; mine = 0u;
#pragma unroll
        for (unsigned j = 0; j < 16; ++j) { const unsigned c = xb_ld(&bar[XB_XCNT(j)]); sum += c; cnt += (c > 0u) ? 1u : 0u; mine = (j == x) ? c : mine; }
        if (sum == G) break;
        __builtin_amdgcn_s_sleep(1);
        if ((++sp & 255u) == 0u) { if (xb_ld(&bar[XB_TMO])) break; if (sp > XB_SPIN_CAP) { atomicAdd(&bar[XB_TMO], 1u); break; } }
    }
    nloc = mine > 0u ? mine : 1u; nx = cnt > 0u ? cnt : 1u;
}
__device__ __forceinline__ void xcd_barrier(const XcdBarrier& b) {
    asm volatile("s_waitcnt vmcnt(0)" ::: "memory");
    __syncthreads();
    if (threadIdx.x == 0) {
        unsigned* bar = b.bar;
        __builtin_amdgcn_s_waitcnt(0);
        unsigned nloc = b.st[0], nx = b.st[1];
        if (nloc == 0u) { xcd_barrier_complete(bar, b.x, nloc, nx); b.st[0] = nloc; b.st[1] = nx; }
        const unsigned old = xb_add(&bar[XB_XSUB(b.x)], 1u);
        const unsigned gen = old / nloc;
        if (old + 1u == (gen + 1u) * nloc) {
            __builtin_amdgcn_fence(__ATOMIC_RELEASE, "agent");
            asm volatile("s_waitcnt vmcnt(0)" ::: "memory");
            const unsigned og = xb_add(&bar[XB_TOP], 1u);
            const unsigned tg = og / nx;
            if (og + 1u == (tg + 1u) * nx) xb_add(&bar[XB_TOPGEN], 1u);
            else XB_SPIN(xb_ld(&bar[XB_TOPGEN]) == tg, bar);
            __builtin_amdgcn_fence(__ATOMIC_ACQUIRE, "agent");
            xb_add(&bar[XB_XGEN(b.x)], 1u);
            asm volatile("s_waitcnt vmcnt(0)" ::: "memory");
        } else {
            XB_SPIN(xb_ld(&bar[XB_XGEN(b.x)]) == gen, bar);
            __builtin_amdgcn_fence(__ATOMIC_ACQUIRE, "agent");
            asm volatile("s_waitcnt vmcnt(0)" ::: "memory");
        }
    }
    __syncthreads();
}

#ifndef WGM_SET
#define WGM_SET 8
#endif
namespace pg8 {
constexpr int BM = 256, BK = 64, HALF = 128, HTB = HALF * BK * 2, STAGE_BYTES = 8 * HTB, NXCD = 8, WGM = WGM_SET;
__host__ __device__ __forceinline__ int lds_byte(int r, int c) { const int st = (r >> 4) * 2 + (c >> 5), rr = r & 15, cc = c & 31, ob = rr * 64 + cc * 2; return st * 1024 + (ob ^ (((ob >> 9) & 1) << 5)); }
__host__ __device__ __forceinline__ void stage_rc(int b, int& R, int& C) { const int st = b / 1024, sb = b % 1024, swz = sb ^ (((sb >> 9) & 1) << 5); R = (st >> 1) * 16 + swz / 64; C = (st & 1) * 32 + (swz % 64) / 2; }
__host__ __device__ __forceinline__ int perm32(int rho) { const int n = rho >> 4, i = rho & 15; return 8 * (i >> 2) + 4 * n + (i & 3); }

struct Unit { int pm, pn, aux; };

__device__ __forceinline__ void grouped(int wgid, int nM, int nN, int& pm, int& pn) {
    const int nig = WGM * nN, gid = wgid / nig, fm = gid * WGM, gsz = (nM - fm) < WGM ? (nM - fm) : WGM;
    pm = fm + ((wgid % nig) % gsz); pn = (wgid % nig) / gsz;
}
__device__ __forceinline__ bool xcd_remap(int i, int G, int c, int nwg, int& wgid) {
    const long L = (long)i * G + c; if (L >= nwg) return false;
    wgid = (int)L; const int q = nwg / NXCD, r = nwg % NXCD, xcd = wgid % NXCD, off = wgid / NXCD;
    wgid = (xcd < r ? xcd * (q + 1) : r * (q + 1) + (xcd - r) * q) + off; return true;
}

typedef int i32x8 __attribute__((ext_vector_type(8)));
typedef int i32x4 __attribute__((ext_vector_type(4)));
template <bool F8> struct Frags;
template <> struct Frags<false> { bf16x8 a[4][2], b0[2][2], b1[2][2]; };
template <> struct Frags<true> { i32x8 a[4], b0[2], b1[2]; };
template <class Prob, class Epi, bool ALIGN_EPI, bool HOOK, bool FP8 = false, int DRY = 0>
__device__ __forceinline__ void gemm_phase(LAS unsigned char* lds, const Prob& P, const Epi& E) {
    int tid_ = threadIdx.x; asm volatile("" : "+v"(tid_));
    const int tid = tid_, wid = __builtin_amdgcn_readfirstlane(tid >> 6), lane = tid & 63, wr = wid >> 2, wc = wid & 3, fr = lane & 15, fq = lane >> 4;
    const int nt = P.nt;
    unsigned voffB[2], voffA[2];
#pragma unroll
    for (int i = 0; i < 2; ++i) { int R, C; stage_rc(tid * 16 + i * 8192, R, C); const int Rb = Epi::PERM ? ((R & ~31) + perm32(R & 31)) : R;
        voffB[i] = (unsigned)Rb * P.ldb2 + (unsigned)C * 2u; voffA[i] = (unsigned)R * P.lda2 + (unsigned)C * 2u; }
    auto gather_offs = [&](const Unit& u, unsigned (&o0)[2], unsigned (&o1)[2]) {
#pragma unroll
        for (int i = 0; i < 2; ++i) { int R, C; int tt = threadIdx.x; asm volatile("" : "+v"(tt)); stage_rc(tt * 16 + i * 8192, R, C); o0[i] = P.a_row(u, R) + (unsigned)C * 2u; o1[i] = P.a_row(u, HALF + R) + (unsigned)C * 2u; } };
    const size_t kstep = (size_t)(BK * 2);
    const size_t hstepB = (size_t)HALF * P.ldb2;
    const size_t hstepA = (size_t)HALF * P.lda2;
    const unsigned ldsw = (unsigned)wid * 1024u;
    const int aoff = lds_byte(wr * 64 + fr, fq * 8), boff = lds_byte(wc * 32 + fr, fq * 8);
#define PG8_SA(b, h) (((b) * 2 + (h)) * HTB)
#define PG8_SB(b, h) ((4 + (b) * 2 + (h)) * HTB)
#define PG8_STAGE(bufoff, gbase, voff) do { if constexpr ((DRY & 2) == 0) _Pragma("unroll") for (int _i = 0; _i < 2; ++_i) \
        __builtin_amdgcn_global_load_lds((const unsigned*)((const char*)(gbase) + (voff)[_i]), (LAS unsigned*)(lds + (bufoff) + ldsw + _i * 8192), 16, 0, 0); } while (0)
#define PG8_LDA(dst, b, h) do { if constexpr (FP8) { _Pragma("unroll") for (int m = 0; m < 4; ++m) { FR.a[m].lo = *(const LAS i32x4*)(lds + PG8_SA(b, h) + aoff + m * 2048); FR.a[m].hi = *(const LAS i32x4*)(lds + PG8_SA(b, h) + aoff + m * 2048 + 1024); } } \
        else { _Pragma("unroll") for (int m = 0; m < 4; ++m) _Pragma("unroll") for (int k = 0; k < 2; ++k) FR.a[m][k] = *(const LAS bf16x8*)(lds + PG8_SA(b, h) + aoff + m * 2048 + k * 1024); } } while (0)
#define PG8_LDB(dst, b, h) do { if constexpr (FP8) { _Pragma("unroll") for (int n = 0; n < 2; ++n) { FR.dst[n].lo = *(const LAS i32x4*)(lds + PG8_SB(b, h) + boff + n * 2048); FR.dst[n].hi = *(const LAS i32x4*)(lds + PG8_SB(b, h) + boff + n * 2048 + 1024); } } \
        else { _Pragma("unroll") for (int n = 0; n < 2; ++n) _Pragma("unroll") for (int k = 0; k < 2; ++k) FR.dst[n][k] = *(const LAS bf16x8*)(lds + PG8_SB(b, h) + boff + n * 2048 + k * 1024); } } while (0)
#define PG8_MMA(ai, bj, At, Bt) do { __builtin_amdgcn_s_setprio(1); if constexpr ((DRY & 1) != 0) { asm volatile("" :: "v"(FR.a[0]), "v"(FR.a[3]), "v"(FR.Bt[0]), "v"(FR.Bt[1])); } else if constexpr (FP8) { _Pragma("unroll") for (int m = 0; m < 4; ++m) _Pragma("unroll") for (int n = 0; n < 2; ++n) \
            asm volatile("v_mfma_f32_16x16x128_f8f6f4 %0, %1, %2, %0" : "+v"(acc[ai][bj][m][n]) : "v"(FR.Bt[n]), "v"(FR.a[m])); } \
        else { _Pragma("unroll") for (int m = 0; m < 4; ++m) _Pragma("unroll") for (int n = 0; n < 2; ++n) _Pragma("unroll") for (int k = 0; k < 2; ++k) \
        acc[ai][bj][m][n] = __builtin_amdgcn_mfma_f32_16x16x32_bf16(FR.Bt[n][k], FR.a[m][k], acc[ai][bj][m][n], 0, 0, 0); } __builtin_amdgcn_s_setprio(0); } while (0)
#define PG8_WAIT_V(n) asm volatile("s_waitcnt vmcnt(" #n ")" ::: "memory")
#define PG8_WAIT_L(n) asm volatile("s_waitcnt lgkmcnt(" #n ")" ::: "memory")
#define PG8_BAR __builtin_amdgcn_s_barrier()
#define PG8_SCHED __builtin_amdgcn_sched_barrier(0)
    Unit cur, nxt; int ui = 0;
    if (!P.unit(0, cur)) return;
    f32x4 acc[2][2][4][2];
#pragma unroll
    for (int a = 0; a < 2; ++a)
#pragma unroll
        for (int b = 0; b < 2; ++b)
#pragma unroll
            for (int m = 0; m < 4; ++m)
#pragma unroll
                for (int n = 0; n < 2; ++n) acc[a][b][m][n] = (f32x4){0.f, 0.f, 0.f, 0.f};
    Frags<FP8> FR;
    unsigned va0[2], va1[2], vn0[2], vn1[2];
    const char* const gA = P.Abase; const char* cA = gA; const char* nA = gA; const char* cB = P.b_tile(cur);
    if constexpr (Prob::GATHER) {
        gather_offs(cur, va0, va1);
    } else { cA = gA + P.a_row(cur, 0); }
#define PG8_STAGE_A(bufoff, h, koff, nx) do { if constexpr (Prob::GATHER) { unsigned _v[2]; _Pragma("unroll") for (int _i = 0; _i < 2; ++_i) _v[_i] = (nx) ? ((h) ? vn1[_i] : vn0[_i]) : ((h) ? va1[_i] : va0[_i]); PG8_STAGE(bufoff, gA + (koff), _v); } \
        else { PG8_STAGE(bufoff, ((nx) ? nA : cA) + (h) * hstepA + (koff), voffA); } } while (0)
    PG8_STAGE(PG8_SB(0, 0), cB, voffB); PG8_STAGE(PG8_SB(0, 1), cB + hstepB, voffB); PG8_STAGE_A(PG8_SA(0, 0), 0, 0, false); PG8_STAGE_A(PG8_SA(0, 1), 1, 0, false);
    if (wr == 1) PG8_BAR;
    PG8_WAIT_V(2); PG8_BAR;
    PG8_STAGE(PG8_SB(1, 0), cB + kstep, voffB); PG8_STAGE_A(PG8_SA(1, 0), 0, kstep, false); PG8_STAGE(PG8_SB(1, 1), cB + hstepB + kstep, voffB);
    PG8_WAIT_V(6); PG8_BAR;
    Unit nx2; unsigned vq0[2], vq1[2]; bool has_next = P.unit(1, nxt);
    if (!has_next) nxt = cur;
    if constexpr (Prob::GATHER) gather_offs(nxt, vn0, vn1);
    for (;;) {
        if constexpr (!Prob::GATHER) { has_next = P.unit(ui + 1, nxt); if (!has_next) nxt = cur; nA = gA + P.a_row(nxt, 0); }
        const char* nB = P.b_tile(nxt);
        for (int t = 0; t < nt; t += 2) {
            const bool last = (t == nt - 2);
            if constexpr (HOOK) { if (t == (nt >> 1)) { if constexpr (FP8) asm volatile("s_nop 15\n\ts_nop 15" ::: "memory"); E.mid(acc, cur, wr, wc, fr, fq); } }
            const size_t k1 = (size_t)(t + 1) * kstep, k2 = last ? 0 : (size_t)(t + 2) * kstep, k3 = k2 + kstep;
            const char* b2 = last ? nB : cB + (size_t)(t + 2) * kstep; const char* b3 = b2 + kstep;
            PG8_LDB(b0, 0, 0); PG8_LDB(b1, 0, 1); PG8_SCHED; PG8_LDA(At, 0, 0); PG8_STAGE_A(PG8_SA(1, 1), 1, k1, false);
            PG8_WAIT_V(8); PG8_WAIT_L(0); PG8_BAR; PG8_MMA(0, 0, At, b0); PG8_MMA(0, 1, At, b1); PG8_BAR; PG8_SCHED;
            PG8_LDA(At, 0, 1); PG8_STAGE(PG8_SB(0, 0), b2, voffB); PG8_STAGE(PG8_SB(0, 1), b2 + hstepB, voffB); PG8_STAGE_A(PG8_SA(0, 0), 0, k2, last);
            PG8_WAIT_V(8); PG8_WAIT_L(0); PG8_BAR; PG8_MMA(1, 0, At, b0); PG8_MMA(1, 1, At, b1); PG8_BAR; PG8_SCHED;
            PG8_LDB(b0, 1, 0); PG8_LDB(b1, 1, 1); PG8_SCHED; PG8_LDA(At, 1, 0); PG8_STAGE_A(PG8_SA(0, 1), 1, k2, last);
            PG8_WAIT_V(8); PG8_WAIT_L(0); PG8_BAR; PG8_MMA(0, 0, At, b0); PG8_MMA(0, 1, At, b1); PG8_BAR; PG8_SCHED;
            PG8_LDA(At, 1, 1); PG8_STAGE(PG8_SB(1, 0), b3, voffB); PG8_STAGE(PG8_SB(1, 1), b3 + hstepB, voffB); PG8_STAGE_A(PG8_SA(1, 0), 0, k3, last);
            PG8_WAIT_V(8); PG8_WAIT_L(0); PG8_BAR; PG8_MMA(1, 0, At, b0); PG8_MMA(1, 1, At, b1); PG8_BAR; PG8_SCHED;
        }
        if constexpr (ALIGN_EPI) { if (wr == 0) PG8_BAR; }
        bool has_next2 = false;
        if constexpr (Prob::GATHER) { has_next2 = has_next && P.unit(ui + 2, nx2); if (!has_next2) nx2 = nxt; gather_offs(nx2, vq0, vq1); }
        if constexpr (FP8) asm volatile("s_nop 15\n\ts_nop 15" ::: "memory");
        if constexpr (DRY == 0) E(acc, cur, wr, wc, fr, fq); else { if (acc[0][0][0][0][0] == 1.2345e30f) *(volatile int*)P.Abase = 1; }
        if (!has_next) break;
#pragma unroll
        for (int a = 0; a < 2; ++a)
#pragma unroll
            for (int b = 0; b < 2; ++b)
#pragma unroll
                for (int m = 0; m < 4; ++m)
#pragma unroll
                    for (int n = 0; n < 2; ++n) acc[a][b][m][n] = (f32x4){0.f, 0.f, 0.f, 0.f};
        cur = nxt; cB = nB; cA = nA; ++ui;
        if constexpr (Prob::GATHER) {
#pragma unroll
            for (int i = 0; i < 2; ++i) { va0[i] = vn0[i]; va1[i] = vn1[i]; vn0[i] = vq0[i]; vn1[i] = vq1[i]; }
            nxt = nx2; has_next = has_next2; }
        if constexpr (ALIGN_EPI) { if (wr == 1) PG8_BAR; }
    }
    PG8_WAIT_V(0);
    if constexpr (!ALIGN_EPI) { if (wr == 0) PG8_BAR; }
    PG8_BAR;
#undef PG8_SA
#undef PG8_SB
#undef PG8_STAGE
#undef PG8_STAGE_A
#undef PG8_LDA
#undef PG8_LDB
#undef PG8_MMA
#undef PG8_WAIT_V
#undef PG8_WAIT_L
#undef PG8_BAR
#undef PG8_SCHED
}
}

using pg8::Unit;

struct ProbDense {
    static constexpr bool GATHER = false;
    const char* Abase; int nt; unsigned ldb2; unsigned lda2; const char* Bt; int nM, nN, G, c; int rev;
    __device__ __forceinline__ bool unit(int i, Unit& u) const { int w; if (!pg8::xcd_remap(i, G, c, nM * nN, w)) return false; pg8::grouped(w, nM, nN, u.pm, u.pn); if (rev) u.pm = nM - 1 - u.pm; u.aux = 0; return true; }
    __device__ __forceinline__ unsigned a_row(const Unit& u, int r) const { return (unsigned)(u.pm * 256 + r) * lda2; }
    __device__ __forceinline__ const char* b_tile(const Unit& u) const { return Bt + (size_t)u.pn * 256 * ldb2; }
};
struct ProbP1 {
    static constexpr bool GATHER = false;
    const char* Abase; int nt; unsigned ldb2; unsigned lda2; const char* Bt; unsigned uc_off; int G, c;
    __device__ __forceinline__ bool unit(int i, Unit& u) const {
        int w; if (!pg8::xcd_remap(i, G, c, 3072 + 256, w)) return false;
        if (w < 3072) { pg8::grouped(w, 256, 12, u.pm, u.pn); u.pm = 255 - u.pm; u.aux = 0; }
        else { pg8::grouped(w - 3072, 32, 8, u.pm, u.pn); u.pn += 4; u.aux = 1; }
        return true; }
    __device__ __forceinline__ unsigned a_row(const Unit& u, int r) const { return (u.aux ? uc_off : 0u) + (unsigned)(u.pm * 256 + r) * lda2; }
    __device__ __forceinline__ const char* b_tile(const Unit& u) const { return Bt + (size_t)u.pn * 256 * ldb2; }
};
template <bool GATHER_> struct ProbMoE {
    static constexpr bool GATHER = GATHER_;
    const char* Abase; int nt; unsigned ldb2; unsigned lda2; const char* Bt; size_t estride; int nN, nblk, G, c; const int* rowtok; const LAS unsigned char* blk_e;
    __device__ __forceinline__ bool unit(int i, Unit& u) const { int w; if (!pg8::xcd_remap(i, G, c, nblk * nN, w)) return false; pg8::grouped(w, nblk, nN, u.pm, u.pn); if (!GATHER) u.pm = nblk - 1 - u.pm;
        u.aux = (int)blk_e[u.pm]; return true; }
    __device__ __forceinline__ unsigned a_row(const Unit& u, int r) const { if (GATHER) return (unsigned)rowtok[u.pm * 256 + r] * lda2; else return (unsigned)(u.pm * 256 + r) * lda2; }
    __device__ __forceinline__ const char* b_tile(const Unit& u) const { return Bt + (size_t)u.aux * estride + (size_t)u.pn * 256 * ldb2; }
};

struct EpiP1 {
    static constexpr bool PERM = true;
    bf16_t* PA; bf16_t* PH; bf16_t* PHC;
    __device__ __forceinline__ void operator()(const f32x4 (&acc)[2][2][4][2], const Unit& u, int wr, int wc, int fr, int fq) const {
        const int row0 = u.pm * 256 + wr * 64 + fr;
        if (!u.aux && u.pn < 4) {
            const int col0 = u.pn * 256 + wc * 32 + 8 * fq;
#pragma unroll
            for (int ai = 0; ai < 2; ++ai)
#pragma unroll
                for (int m = 0; m < 4; ++m) { const int row = row0 + ai * 128 + m * 16, b = row >> 11, t = row & 2047;
#pragma unroll
                    for (int bj = 0; bj < 2; ++bj) { const int col = col0 + bj * 128, reim = col >> 9, c5 = col & 511, slab = c5 >> 4, half = (c5 >> 3) & 1;
                        const f32x4 v0 = acc[ai][bj][m][0] * W8_INV, v1 = acc[ai][bj][m][1] * W8_INV;
                        u32x4 w; w.x = cvt_pk_bf16(v0[0], v0[1]); w.y = cvt_pk_bf16(v0[2], v0[3]); w.z = cvt_pk_bf16(v1[0], v1[1]); w.w = cvt_pk_bf16(v1[2], v1[3]);
                        *(u32x4*)(PA + ((((size_t)(b * 32 + slab) * 2048 + t) * 2 + reim) * 16 + half * 8)) = w; } }
            return;
        }
        bf16_t* base = u.aux ? PHC : PH; const int ldc = 2048, colt = (u.pn - 4) * 256;
        const int col0 = colt + wc * 32 + 8 * fq;
#pragma unroll
        for (int ai = 0; ai < 2; ++ai)
#pragma unroll
            for (int m = 0; m < 4; ++m) { bf16_t* rowp = base + (size_t)(row0 + ai * 128 + m * 16) * ldc + col0;
#pragma unroll
                for (int bj = 0; bj < 2; ++bj) { const f32x4 v0 = acc[ai][bj][m][0] * W8_INV, v1 = acc[ai][bj][m][1] * W8_INV;
                    u32x4 w; w.x = cvt_pk_bf16(v0[0], v0[1]); w.y = cvt_pk_bf16(v0[2], v0[3]); w.z = cvt_pk_bf16(v1[0], v1[1]); w.w = cvt_pk_bf16(v1[2], v1[3]);
                    *(u32x4*)(rowp + bj * 128) = w; } }
    }
    __device__ __forceinline__ void mid(f32x4 (&)[2][2][4][2], const Unit&, int, int, int, int) const {}
};
struct EpiP2 {
    static constexpr bool PERM = true;
    bf16_t* PG; bf16_t* GATES;
    __device__ __forceinline__ void operator()(const f32x4 (&acc)[2][2][4][2], const Unit& u, int wr, int wc, int fr, int fq) const {
        const bool isg = u.pn >= 2; bf16_t* base = isg ? GATES : PG; const int ldc = isg ? 2048 : 512, colt = isg ? (u.pn - 2) * 256 : u.pn * 256;
        const int row0 = u.pm * 256 + wr * 64 + fr, col0 = colt + wc * 32 + 8 * fq;
#pragma unroll
        for (int ai = 0; ai < 2; ++ai)
#pragma unroll
            for (int m = 0; m < 4; ++m) { bf16_t* rowp = base + (size_t)(row0 + ai * 128 + m * 16) * ldc + col0;
#pragma unroll
                for (int bj = 0; bj < 2; ++bj) { f32x4 v0 = acc[ai][bj][m][0] * W8_INV, v1 = acc[ai][bj][m][1] * W8_INV;
#pragma unroll
                    for (int j = 0; j < 4; ++j) { const float s0 = fast_sigmoid(v0[j]), s1 = fast_sigmoid(v1[j]); v0[j] = isg ? s0 : v0[j] * s0; v1[j] = isg ? s1 : v1[j] * s1; }
                    u32x4 w; w.x = cvt_pk_bf16(v0[0], v0[1]); w.y = cvt_pk_bf16(v0[2], v0[3]); w.z = cvt_pk_bf16(v1[0], v1[1]); w.w = cvt_pk_bf16(v1[2], v1[3]);
                    *(u32x4*)(rowp + bj * 128) = w; } }
    }
    __device__ __forceinline__ void mid(f32x4 (&)[2][2][4][2], const Unit&, int, int, int, int) const {}
};
struct EpiM1 {
    static constexpr bool PERM = true;
    const bf16_t* GATES; unsigned char* Mo;
    __device__ __forceinline__ void mid(f32x4 (&acc)[2][2][4][2], const Unit& u, int wr, int wc, int fr, int fq) const {
        int row0 = u.pm * 256 + wr * 64 + fr, col0 = u.pn * 256 + wc * 32 + 8 * fq;
        asm volatile("" : "+v"(row0), "+v"(col0));
#pragma unroll
        for (int ai = 0; ai < 2; ++ai) {
            u32x4 gf[4][2], gh[4][2];
#pragma unroll
            for (int m = 0; m < 4; ++m) { const bf16_t* gp = GATES + (size_t)(row0 + ai * 128 + m * 16) * 2048 + col0;
#pragma unroll
                for (int bj = 0; bj < 2; ++bj) { gf[m][bj] = *(const u32x4*)(gp + bj * 128); gh[m][bj] = *(const u32x4*)(gp + 1024 + bj * 128); } }
#pragma unroll
            for (int m = 0; m < 4; ++m)
#pragma unroll
                for (int bj = 0; bj < 2; ++bj) { const u32x4 f = gf[m][bj], h = gh[m][bj];
                    f32x4& v0 = acc[ai][bj][m][0]; f32x4& v1 = acc[ai][bj][m][1];
                    v0[0] *= bf_lo(f.x) * __builtin_amdgcn_rcpf(fmaxf(bf_lo(h.x), 1e-20f)); v0[1] *= bf_hi(f.x) * __builtin_amdgcn_rcpf(fmaxf(bf_hi(h.x), 1e-20f));
                    v0[2] *= bf_lo(f.y) * __builtin_amdgcn_rcpf(fmaxf(bf_lo(h.y), 1e-20f)); v0[3] *= bf_hi(f.y) * __builtin_amdgcn_rcpf(fmaxf(bf_hi(h.y), 1e-20f));
                    v1[0] *= bf_lo(f.z) * __builtin_amdgcn_rcpf(fmaxf(bf_lo(h.z), 1e-20f)); v1[1] *= bf_hi(f.z) * __builtin_amdgcn_rcpf(fmaxf(bf_hi(h.z), 1e-20f));
                    v1[2] *= bf_lo(f.w) * __builtin_amdgcn_rcpf(fmaxf(bf_lo(h.w), 1e-20f)); v1[3] *= bf_hi(f.w) * __builtin_amdgcn_rcpf(fmaxf(bf_hi(h.w), 1e-20f)); }
            asm volatile("" ::: "memory");
        }
    }
    __device__ __forceinline__ void operator()(const f32x4 (&acc)[2][2][4][2], const Unit& u, int wr, int wc, int fr, int fq) const {
        const int row0 = u.pm * 256 + wr * 64 + fr, col0 = u.pn * 256 + wc * 32 + 8 * fq;
#pragma unroll
        for (int ai = 0; ai < 2; ++ai) {
            u32x4 gh[4][2];
#pragma unroll
            for (int m = 0; m < 4; ++m) { const bf16_t* gp = GATES + (size_t)(row0 + ai * 128 + m * 16) * 2048 + 1024 + col0;
#pragma unroll
                for (int bj = 0; bj < 2; ++bj) gh[m][bj] = *(const u32x4*)(gp + bj * 128); }
#pragma unroll
            for (int bj = 0; bj < 2; ++bj) { u32x2 pk[4];
#pragma unroll
                for (int m = 0; m < 4; ++m) { const u32x4 h = gh[m][bj]; const f32x4 v0 = acc[ai][bj][m][0] * W8_INV, v1 = acc[ai][bj][m][1] * W8_INV;
                    pk[m] = (u32x2){cvt_pk4_fp8(v0[0] * bf_lo(h.x), v0[1] * bf_hi(h.x), v0[2] * bf_lo(h.y), v0[3] * bf_hi(h.y)), cvt_pk4_fp8(v1[0] * bf_lo(h.z), v1[1] * bf_hi(h.z), v1[2] * bf_lo(h.w), v1[3] * bf_hi(h.w))}; }
#pragma unroll
                for (int mp = 0; mp < 2; ++mp)
                    *(u32x4*)(Mo + (size_t)(row0 + ai * 128 + (2 * mp + (fq & 1)) * 16) * 1024 + u.pn * 256 + bj * 128 + wc * 32 + (fq >> 1) * 16) = widen16(pk[2 * mp], pk[2 * mp + 1]); }
            asm volatile("" ::: "memory");
        }
    }
};
struct EpiM2 {
    static constexpr bool PERM = true;
    const float* X; const float* ada; bf16_t* V;
    __device__ __forceinline__ void operator()(const f32x4 (&acc)[2][2][4][2], const Unit& u, int wr, int wc, int fr, int fq) const {
        const int row0 = u.pm * 256 + wr * 64 + fr, col0 = u.pn * 256 + wc * 32 + 8 * fq;
        const float* g1 = ada + (size_t)(u.pm >> 3) * 6144 + 2048 + col0;
        f32x4 gv[2][2];
#pragma unroll
        for (int bj = 0; bj < 2; ++bj)
#pragma unroll
            for (int n = 0; n < 2; ++n) gv[bj][n] = *(const f32x4*)(g1 + bj * 128 + n * 4);
#pragma unroll
        for (int ai = 0; ai < 2; ++ai) {
            f32x4 xv[4][2][2];
#pragma unroll
            for (int m = 0; m < 4; ++m) { const size_t off = (size_t)(row0 + ai * 128 + m * 16) * 1024 + col0;
#pragma unroll
                for (int bj = 0; bj < 2; ++bj)
#pragma unroll
                    for (int n = 0; n < 2; ++n) xv[m][bj][n] = *(const f32x4*)(X + off + bj * 128 + n * 4); }
#pragma unroll
            for (int m = 0; m < 4; ++m) { const size_t off = (size_t)(row0 + ai * 128 + m * 16) * 1024 + col0;
#pragma unroll
                for (int bj = 0; bj < 2; ++bj) { const f32x4 v0 = xv[m][bj][0] * DN_ALPHA + gv[bj][0] * (acc[ai][bj][m][0] * W8_INV), v1 = xv[m][bj][1] * DN_ALPHA + gv[bj][1] * (acc[ai][bj][m][1] * W8_INV);
                    u32x4 w; w.x = cvt_pk_bf16(v0[0], v0[1]); w.y = cvt_pk_bf16(v0[2], v0[3]); w.z = cvt_pk_bf16(v1[0], v1[1]); w.w = cvt_pk_bf16(v1[2], v1[3]);
                    *(u32x4*)(V + off + bj * 128) = w; } }
            asm volatile("" ::: "memory");
        }
    }
    __device__ __forceinline__ void mid(f32x4 (&)[2][2][4][2], const Unit&, int, int, int, int) const {}
};
struct EpiGU {
    static constexpr bool PERM = true;
    const float* bgu; unsigned char* ACT;
    __device__ __forceinline__ void operator()(const f32x4 (&acc)[2][2][4][2], const Unit& u, int wr, int wc, int fr, int fq) const {
        const int row0 = u.pm * 256 + wr * 64 + fr, col0 = u.pn * 128 + wc * 32 + 8 * fq;
        const float* bp = bgu + (size_t)u.aux * 2048 + col0;
        const f32x4 bg0 = *(const f32x4*)(bp), bg1 = *(const f32x4*)(bp + 4), bu0 = *(const f32x4*)(bp + 1024), bu1 = *(const f32x4*)(bp + 1028);
#pragma unroll
        for (int ai = 0; ai < 2; ++ai) { u32x2 pk[4];
#pragma unroll
            for (int m = 0; m < 4; ++m) {
                f32x4 g0 = acc[ai][0][m][0] * W8_INV + bg0, g1 = acc[ai][0][m][1] * W8_INV + bg1, p0 = acc[ai][1][m][0] * W8_INV + bu0, p1 = acc[ai][1][m][1] * W8_INV + bu1;
#pragma unroll
                for (int j = 0; j < 4; ++j) {
                    float g = fminf(g0[j], 7.0f), p = fminf(fmaxf(p0[j], -7.0f), 7.0f); g0[j] = (p + 1.0f) * g * fast_sigmoid(1.702f * g);
                    g = fminf(g1[j], 7.0f); p = fminf(fmaxf(p1[j], -7.0f), 7.0f); g1[j] = (p + 1.0f) * g * fast_sigmoid(1.702f * g); }
                pk[m] = (u32x2){cvt_pk4_fp8(g0[0], g0[1], g0[2], g0[3]), cvt_pk4_fp8(g1[0], g1[1], g1[2], g1[3])}; }
#pragma unroll
            for (int mp = 0; mp < 2; ++mp)
                *(u32x4*)(ACT + (size_t)(row0 + ai * 128 + (2 * mp + (fq & 1)) * 16) * 1024 + u.pn * 128 + wc * 32 + (fq >> 1) * 16) = widen16(pk[2 * mp], pk[2 * mp + 1]); }
    }
    __device__ __forceinline__ void mid(f32x4 (&)[2][2][4][2], const Unit&, int, int, int, int) const {}
};
struct EpiDN {
    static constexpr bool PERM = true;
    const float* bdn; unsigned char* Y;
    __device__ __forceinline__ void operator()(const f32x4 (&acc)[2][2][4][2], const Unit& u, int wr, int wc, int fr, int fq) const {
        const int row0 = u.pm * 256 + wr * 64 + fr, col0 = u.pn * 256 + wc * 32 + 8 * fq;
        const float* bp = bdn + (size_t)u.aux * 1024 + col0;
        f32x4 bv[2][2];
#pragma unroll
        for (int bj = 0; bj < 2; ++bj)
#pragma unroll
            for (int n = 0; n < 2; ++n) bv[bj][n] = *(const f32x4*)(bp + bj * 128 + 4 * n);
#pragma unroll
        for (int ai = 0; ai < 2; ++ai)
#pragma unroll
            for (int bj = 0; bj < 2; ++bj) { u32x2 pk[4];
#pragma unroll
                for (int m = 0; m < 4; ++m) { const f32x4 v0 = acc[ai][bj][m][0] * W8_INV + bv[bj][0], v1 = acc[ai][bj][m][1] * W8_INV + bv[bj][1];
                    pk[m] = (u32x2){cvt_pk4_fp8(v0[0], v0[1], v0[2], v0[3]), cvt_pk4_fp8(v1[0], v1[1], v1[2], v1[3])}; }
#pragma unroll
                for (int mp = 0; mp < 2; ++mp)
                    *(u32x4*)(Y + (size_t)(row0 + ai * 128 + (2 * mp + (fq & 1)) * 16) * 1024 + u.pn * 256 + bj * 128 + wc * 32 + (fq >> 1) * 16) = widen16(pk[2 * mp], pk[2 * mp + 1]); }
    }
    __device__ __forceinline__ void mid(f32x4 (&)[2][2][4][2], const Unit&, int, int, int, int) const {}
};

struct Frame {
    LAS unsigned char* lds; int tid, lane, wave, G, c;
    const float* const* in; float* out; unsigned char* ws; unsigned* ctl;
};
enum { I_X = 0, I_C, I_CTX, I_CCTX, I_WADA, I_BADA, I_WIN, I_LBRAW, I_HGG, I_WFO, I_WHO, I_WO, I_LN1G, I_LN1B, I_WR, I_BR, I_WGU, I_BGU, I_WDN, I_BDN, I_LN2G, I_LN2B };

__device__ __forceinline__ float wave_sum(float v) {
#pragma unroll
    for (int o = 32; o >= 1; o >>= 1) v += __shfl_xor(v, o);
    return v;
}

__device__ __forceinline__ void p0_ada(const Frame& F) {
    LAS float* cact = (LAS float*)F.lds;
    float* ada = (float*)(F.ws + WS_ADA);
    for (int cb = F.c; cb < 192; cb += F.G) {
        const int kg = F.tid >> 5, col = F.tid & 31, gcol = cb * 32 + col;
        float w[16][4];
#pragma unroll
        for (int i = 0; i < 16; ++i)
#pragma unroll
            for (int j = 0; j < 4; ++j) w[i][j] = F.in[I_WADA][(size_t)(4 * kg + 64 * i + j) * 6144 + gcol];
        f32x4 cv[17];
#pragma unroll
        for (int it = 0; it < 17; ++it) { const int q = F.tid + it * NTHR, bq = q >> 8, k4 = (q & 255) * 4; cv[it] = (f32x4){0.f, 0.f, 0.f, 0.f};
            if (q < 33 * 256) cv[it] = *(const f32x4*)(bq < 32 ? F.in[I_C] + bq * 1024 + k4 : F.in[I_CCTX] + k4); }
#pragma unroll
        for (int it = 0; it < 17; ++it) { const int q = F.tid + it * NTHR; f32x4 v = cv[it];
#pragma unroll
            for (int j = 0; j < 4; ++j) v[j] = v[j] * fast_sigmoid(v[j]);
            if (q < 33 * 256) *(LAS f32x4*)(cact + q * 4) = v; }
        __syncthreads();
        float acc[33];
#pragma unroll
        for (int bb = 0; bb < 33; ++bb) acc[bb] = 0.f;
#pragma unroll
        for (int i = 0; i < 16; ++i)
#pragma unroll
            for (int bb = 0; bb < 33; ++bb) { const f32x4 c4 = *(const LAS f32x4*)(cact + bb * 1024 + 4 * kg + 64 * i);
                acc[bb] += (c4[0] * w[i][0] + c4[1] * w[i][1]) + (c4[2] * w[i][2] + c4[3] * w[i][3]); }
        __syncthreads();
        LAS float* red = cact;
#pragma unroll
        for (int bb = 0; bb < 33; ++bb) red[(kg * 33 + bb) * 32 + col] = acc[bb];
        __syncthreads();
        for (int o = F.tid; o < 33 * 32; o += NTHR) { const int bb = o >> 5, cc = o & 31; float sum = 0.f;
#pragma unroll
            for (int g = 0; g < 16; ++g) sum += red[(g * 33 + bb) * 32 + cc];
            ada[(size_t)bb * 6144 + cb * 32 + cc] = sum + F.in[I_BADA][cb * 32 + cc]; }
        __syncthreads();
    }
}
__device__ __forceinline__ void p0_fold(const Frame& F) {
    LAS float* xr = (LAS float*)F.lds;
    LAS float* cs = xr + 2048;
    unsigned char* W1 = (unsigned char*)(F.ws + WS_WIN1T);
    if (F.tid < 128) { const float a = (float)F.tid * (1.0f / 128.0f); cs[F.tid] = __builtin_amdgcn_cosf(a); cs[128 + F.tid] = __builtin_amdgcn_sinf(a); }
    for (int kb = F.c; kb < 256; kb += F.G) {
        __syncthreads();
        for (int i = F.tid; i < 2048; i += NTHR) xr[i] = F.in[I_WIN][(size_t)(4 * kb + (i >> 9)) * 5120 + (i & 511)];
        __syncthreads();
        const int g = F.tid >> 7, j = F.tid & 127;
        float ac[4] = {0.f, 0.f, 0.f, 0.f}, as[4] = {0.f, 0.f, 0.f, 0.f};
        for (int d = 0; d < 128; ++d) { const int idx = (d * j) & 127; const float cv = cs[idx], sv = cs[128 + idx];
#pragma unroll
            for (int r = 0; r < 4; ++r) { const float xv = xr[r * 512 + g * 128 + d]; ac[r] += xv * cv; as[r] += xv * sv; } }
        const float sc = 0.08838834764831845f * W8_SCALE;
        *(unsigned*)(W1 + (size_t)(g * 128 + j) * 1024 + 4 * kb) = cvt_pk4_fp8(ac[0] * sc, ac[1] * sc, ac[2] * sc, ac[3] * sc);
        *(unsigned*)(W1 + (size_t)(512 + g * 128 + j) * 1024 + 4 * kb) = cvt_pk4_fp8(-as[0] * sc, -as[1] * sc, -as[2] * sc, -as[3] * sc);
    }
    __syncthreads();
}
struct CvJob { const float* src; int sld; unsigned char* dst; int f8; };
__device__ __forceinline__ CvJob cv_job(const Frame& F, int j) {
    CvJob J;
    if (j < 128) { const int kt = j >> 4, nt = j & 15; J.src = F.in[I_WIN] + (size_t)kt * 128 * 5120 + 512 + nt * 128; J.sld = 5120; J.dst = F.ws + WS_WIN1T + (size_t)(1024 + nt * 128) * 1024 + kt * 128; J.f8 = 1; }
    else if (j < 288) { const int q = j - 128, kt = q / 20, nt = q % 20; J.src = F.in[I_WIN] + (size_t)kt * 128 * 5120 + 2560 + nt * 128; J.sld = 5120; J.dst = F.ws + WS_WIN2T + (size_t)(nt * 128) * 1024 + kt * 128; J.f8 = 1; }
    else if (j < 320) { const int q = j - 288, kt = q >> 3, nt = q & 7; J.src = F.in[I_WFO] + (size_t)kt * 128 * 1024 + nt * 128; J.sld = 1024; J.dst = F.ws + WS_WMT + ((size_t)(nt * 128) * 1024 + kt * 128); J.f8 = 1; }
    else if (j < 352) { const int q = j - 320, kt = q >> 3, nt = q & 7; J.src = F.in[I_WHO] + (size_t)kt * 128 * 1024 + nt * 128; J.sld = 1024; J.dst = F.ws + WS_WMT + ((size_t)(nt * 128) * 1024 + 512 + kt * 128); J.f8 = 1; }
    else if (j < 416) { const int q = j - 352, kt = q >> 3, nt = q & 7; J.src = F.in[I_WO] + (size_t)kt * 128 * 1024 + nt * 128; J.sld = 1024; J.dst = F.ws + WS_WOT + ((size_t)(nt * 128) * 1024 + kt * 128); J.f8 = 1; }
    else if (j < 4512) { const int q = j - 416, e = q >> 7, r = q & 127, kt = r >> 4, jt = r & 15; J.src = F.in[I_WGU] + (size_t)e * 1024 * 2048 + (size_t)kt * 128 * 2048 + jt * 128; J.sld = 2048;
        J.dst = F.ws + WS_WGUT + (size_t)e * 2048 * 1024 + (size_t)((jt & 7) * 256 + (jt >> 3) * 128) * 1024 + kt * 128; J.f8 = 1; }
    else { const int q = j - 4512, e = q >> 6, r = q & 63, kt = r >> 3, nt = r & 7; J.src = F.in[I_WDN] + (size_t)e * 1024 * 1024 + (size_t)kt * 128 * 1024 + nt * 128; J.sld = 1024;
        J.dst = F.ws + WS_WDNT + (size_t)e * 1024 * 1024 + (size_t)(nt * 128) * 1024 + kt * 128; J.f8 = 1; }
    return J;
}
__device__ __forceinline__ void p0_convert(const Frame& F) {
    constexpr int NJ = 128 + 160 + 32 + 32 + 64 + 4096 + 2048;
    LAS float* tile = (LAS float*)F.lds;
    int j = F.c; if (j >= NJ) return;
    CvJob J = cv_job(F, j);
    f32x4 v[8];
#pragma unroll
    for (int i = 0; i < 8; ++i) { const int idx = F.tid + i * NTHR, r = idx >> 5, c4 = idx & 31; v[i] = *(const f32x4*)(J.src + (size_t)r * J.sld + c4 * 4); }
    for (;;) {
        const float sc = J.f8 ? W8_SCALE : 1.0f;
#pragma unroll
        for (int i = 0; i < 8; ++i) { const int idx = F.tid + i * NTHR, r = idx >> 5, c4 = idx & 31; LAS float* p = tile + r * 129 + c4 * 4; p[0] = v[i][0] * sc; p[1] = v[i][1] * sc; p[2] = v[i][2] * sc; p[3] = v[i][3] * sc; }
        __syncthreads();
        const CvJob Jc = J; const int jn = j + F.G; const bool more = jn < NJ;
        if (more) { J = cv_job(F, jn);
#pragma unroll
            for (int i = 0; i < 8; ++i) { const int idx = F.tid + i * NTHR, r = idx >> 5, c4 = idx & 31; v[i] = *(const f32x4*)(J.src + (size_t)r * J.sld + c4 * 4); } }
        if (Jc.f8) {
#pragma unroll
            for (int i = 0; i < 2; ++i) { const int idx = F.tid + i * NTHR, n = idx >> 3, kc = idx & 7; const LAS float* p = tile + (kc * 16) * 129 + n;
                u32x4 w; w.x = cvt_pk4_fp8(p[0], p[129], p[2 * 129], p[3 * 129]); w.y = cvt_pk4_fp8(p[4 * 129], p[5 * 129], p[6 * 129], p[7 * 129]);
                w.z = cvt_pk4_fp8(p[8 * 129], p[9 * 129], p[10 * 129], p[11 * 129]); w.w = cvt_pk4_fp8(p[12 * 129], p[13 * 129], p[14 * 129], p[15 * 129]);
                *(u32x4*)(Jc.dst + (size_t)n * 1024 + kc * 16) = w; }
        } else {
#pragma unroll
            for (int i = 0; i < 4; ++i) { const int idx = F.tid + i * NTHR, n = idx >> 4, kc = idx & 15; const LAS float* p = tile + (kc * 8) * 129 + n;
                u32x4 w; w.x = cvt_pk_bf16(p[0], p[129]); w.y = cvt_pk_bf16(p[2 * 129], p[3 * 129]); w.z = cvt_pk_bf16(p[4 * 129], p[5 * 129]); w.w = cvt_pk_bf16(p[6 * 129], p[7 * 129]);
                *(u32x4*)((bf16_t*)Jc.dst + (size_t)n * 1024 + kc * 8) = w; }
        }
        __syncthreads();
        if (!more) break;
        j = jn;
    }
}

__device__ __forceinline__ void p1_uprep(const Frame& F) {
    const float* ada = (const float*)(F.ws + WS_ADA);
    unsigned char* U = (unsigned char*)(F.ws + WS_U); unsigned char* Uc = (unsigned char*)(F.ws + WS_UC);
    const size_t NIT = (size_t)(T + TCX) * 128, stride = (size_t)F.G * NTHR;
    for (size_t base = (size_t)F.c * NTHR + F.tid; base < NIT; base += 4 * stride) {
        const int col = (int)(base & 127) * 8;
        f32x4 a0[4], a1[4], sh0[4], sh1[4], sc0[4], sc1[4]; unsigned char* dst[4]; bool ok[4];
#pragma unroll
        for (int u = 0; u < 4; ++u) {
            const size_t idx = base + (size_t)u * stride; ok[u] = idx < NIT;
            const int row = (int)((ok[u] ? idx : base) >> 7);
            const bool lat = row < T; const int b = lat ? (row >> 11) : 32;
            const float* src = lat ? F.in[I_X] + (size_t)row * 1024 + col : F.in[I_CTX] + (size_t)(row - T) * 1024 + col;
            dst[u] = lat ? U + (size_t)row * 1024 + col : Uc + (size_t)(row - T) * 1024 + col;
            a0[u] = *(const f32x4*)src; a1[u] = *(const f32x4*)(src + 4);
            const float* ap = ada + (size_t)b * 6144 + col;
            sh0[u] = *(const f32x4*)ap; sh1[u] = *(const f32x4*)(ap + 4); sc0[u] = *(const f32x4*)(ap + 1024); sc1[u] = *(const f32x4*)(ap + 1028);
        }
#pragma unroll
        for (int u = 0; u < 4; ++u) {
            const f32x4 r0 = a0[u] * (sc0[u] + 1.0f) + sh0[u], r1 = a1[u] * (sc1[u] + 1.0f) + sh1[u];
            if (ok[u]) *(u32x2*)dst[u] = (u32x2){cvt_pk4_fp8(r0[0], r0[1], r0[2], r0[3]), cvt_pk4_fp8(r1[0], r1[1], r1[2], r1[3])};
        }
    }
    int* rowtok = (int*)(F.ws + WS_ROWTOK);
    for (int i = F.c * NTHR + F.tid; i < NCH * ROWS_CH; i += F.G * NTHR) rowtok[i] = (i / ROWS_CH) * TCH;
}

__device__ __forceinline__ void p6_readout(const Frame& F) {
    const bf16_t* PH = (const bf16_t*)(F.ws + WS_PH); const bf16_t* PG = (const bf16_t*)(F.ws + WS_PG); unsigned char* Y = (unsigned char*)(F.ws + WS_Y);
    const int l8 = F.lane * 8;
    const f32x4 g0 = *(const f32x4*)(F.in[I_HGG] + l8), g1 = *(const f32x4*)(F.in[I_HGG] + l8 + 4);
    const int tstr = F.G * 8;
    for (int t0 = F.c * 8 + F.wave; t0 < T; t0 += 4 * tstr) {
        u32x4 av[4], bv[4], pv[4]; bool ok[4]; int tt[4];
#pragma unroll
        for (int u = 0; u < 4; ++u) { const int t = t0 + u * tstr; ok[u] = t < T; tt[u] = ok[u] ? t : t0;
            av[u] = *(const u32x4*)(PH + (size_t)tt[u] * 2048 + 512 + l8); bv[u] = *(const u32x4*)(PH + (size_t)tt[u] * 2048 + 1024 + l8); pv[u] = *(const u32x4*)(PG + (size_t)tt[u] * 512 + l8); }
#pragma unroll
        for (int u = 0; u < 4; ++u) {
            const u32x4 a = av[u], b = bv[u], p = pv[u];
            float o[8] = { bf_lo(a.x) + bf_lo(b.x), bf_hi(a.x) + bf_hi(b.x), bf_lo(a.y) + bf_lo(b.y), bf_hi(a.y) + bf_hi(b.y), bf_lo(a.z) + bf_lo(b.z), bf_hi(a.z) + bf_hi(b.z), bf_lo(a.w) + bf_lo(b.w), bf_hi(a.w) + bf_hi(b.w) };
            float ss = 0.f;
#pragma unroll
            for (int i = 0; i < 8; ++i) ss += o[i] * o[i];
            ss += __shfl_xor(ss, 1); ss += __shfl_xor(ss, 2); ss += __shfl_xor(ss, 4); ss += __shfl_xor(ss, 8);
            const float rs = __builtin_amdgcn_rsqf(ss * (1.0f / 128.0f) + RMS_EPS);
            const float sp[8] = { bf_lo(p.x), bf_hi(p.x), bf_lo(p.y), bf_hi(p.y), bf_lo(p.z), bf_hi(p.z), bf_lo(p.w), bf_hi(p.w) };
            if (ok[u]) *(u32x2*)(Y + (size_t)tt[u] * 1024 + 512 + l8) = (u32x2){cvt_pk4_fp8(o[0] * rs * g0[0] * sp[0], o[1] * rs * g0[1] * sp[1], o[2] * rs * g0[2] * sp[2], o[3] * rs * g0[3] * sp[3]), cvt_pk4_fp8(o[4] * rs * g1[0] * sp[4], o[5] * rs * g1[1] * sp[5], o[6] * rs * g1[2] * sp[6], o[7] * rs * g1[3] * sp[7])};
        }
    }
}

__device__ __forceinline__ void p9_ln1_router(const Frame& F, const bool dry) {
    LAS float* wrT = (LAS float*)F.lds;
    LAS float* lg = (LAS float*)(F.lds + 131072);
    LAS float* brs = (LAS float*)(F.lds + 131072 + 4096);
    LAS int* hist = (LAS int*)(F.lds + 131072 + 4096 + 128);
    for (int i = F.tid; i < 32768; i += NTHR) { const int k = i >> 5, e = i & 31; wrT[e * 1024 + k] = F.in[I_WR][i]; }
    if (F.tid < 32) brs[F.tid] = F.in[I_BR][F.tid];
    if (F.tid < NCH * 32) hist[F.tid] = 0;
    __syncthreads();
    const bf16_t* V = (const bf16_t*)F.out; bf16_t* X1 = (bf16_t*)(F.ws + WS_X1); unsigned char* U2 = (unsigned char*)(F.ws + WS_U); const float* ada = (const float*)(F.ws + WS_ADA);
    int* topi = (int*)(F.ws + WS_TOPI); float* topw = (float*)(F.ws + WS_TOPW);
    const int l4 = F.lane * 4;
    for (int gi = F.c * 8 + F.wave; gi < T / 4; gi += F.G * 8) {
        const int g = T / 4 - 1 - gi;
        const int t0 = g * 4, b = t0 >> 11;
        f32x4 xv[4][4];
#pragma unroll
        for (int tk = 0; tk < 4; ++tk)
#pragma unroll
            for (int j = 0; j < 4; ++j) { const u32x2 w = *(const u32x2*)(V + (size_t)(t0 + tk) * 1024 + 256 * j + l4); xv[tk][j] = (f32x4){bf_lo(w.x), bf_hi(w.x), bf_lo(w.y), bf_hi(w.y)}; }
        float mean[4], rstd[4];
#pragma unroll
        for (int tk = 0; tk < 4; ++tk) { float s = 0.f;
#pragma unroll
            for (int j = 0; j < 4; ++j) s += (xv[tk][j][0] + xv[tk][j][1]) + (xv[tk][j][2] + xv[tk][j][3]);
            s = wave_sum(s); mean[tk] = s * (1.0f / 1024.0f); float q = 0.f;
#pragma unroll
            for (int j = 0; j < 4; ++j) { const f32x4 d = xv[tk][j] - mean[tk]; q += (d[0] * d[0] + d[1] * d[1]) + (d[2] * d[2] + d[3] * d[3]); }
            q = wave_sum(q); rstd[tk] = __builtin_amdgcn_rsqf(q * (1.0f / 1024.0f) + LN_EPS); }
#pragma unroll
        for (int j = 0; j < 4; ++j) {
            const int k = 256 * j + l4;
            const f32x4 lg1 = *(const f32x4*)(F.in[I_LN1G] + k), lb1 = *(const f32x4*)(F.in[I_LN1B] + k);
            const f32x4 sh = *(const f32x4*)(ada + (size_t)b * 6144 + 3072 + k), sc = *(const f32x4*)(ada + (size_t)b * 6144 + 4096 + k);
#pragma unroll
            for (int tk = 0; tk < 4; ++tk) { const f32x4 x1 = (xv[tk][j] - mean[tk]) * rstd[tk] * lg1 + lb1;
                if (!dry) *(u32x2*)(X1 + (size_t)(t0 + tk) * 1024 + k) = (u32x2){cvt_pk_bf16(x1[0], x1[1]), cvt_pk_bf16(x1[2], x1[3])};
                const f32x4 u2 = x1 * (sc + 1.0f) + sh; xv[tk][j] = u2;
                if (!dry) *(unsigned*)(U2 + (size_t)(t0 + tk) * 1024 + k) = cvt_pk4_fp8(u2[0], u2[1], u2[2], u2[3]); } }
#pragma unroll 1
        for (int eq = 0; eq < 4; ++eq) {
            f32x2 acc2[4][8];
#pragma unroll
            for (int e = 0; e < 8; ++e) { acc2[0][e] = (f32x2){0.f, 0.f}; acc2[1][e] = (f32x2){0.f, 0.f}; acc2[2][e] = (f32x2){0.f, 0.f}; acc2[3][e] = (f32x2){0.f, 0.f};
#pragma unroll
                for (int j = 0; j < 4; ++j) { const f32x4 w4 = *(const LAS f32x4*)(wrT + (eq * 8 + e) * 1024 + 256 * j + l4); const f32x2 wlo = {w4[0], w4[1]}, whi = {w4[2], w4[3]};
#pragma unroll
                    for (int tk = 0; tk < 4; ++tk) { const f32x2 xlo = {xv[tk][j][0], xv[tk][j][1]}, xhi = {xv[tk][j][2], xv[tk][j][3]};
                        acc2[tk][e] = __builtin_elementwise_fma(xlo, wlo, acc2[tk][e]); acc2[tk][e] = __builtin_elementwise_fma(xhi, whi, acc2[tk][e]); } }
                if (e & 1) __builtin_amdgcn_sched_barrier(0); }
            float acc[4][8];
#pragma unroll
            for (int tk = 0; tk < 4; ++tk)
#pragma unroll
                for (int e = 0; e < 8; ++e) acc[tk][e] = acc2[tk][e][0] + acc2[tk][e][1];
#pragma unroll
            for (int tk = 0; tk < 4; ++tk) {
                float v0, v1, v2, v3;
                { const bool up = (F.lane & 32) != 0;
                  v0 = (up ? acc[tk][4] : acc[tk][0]) + __shfl_xor(up ? acc[tk][0] : acc[tk][4], 32);
                  v1 = (up ? acc[tk][5] : acc[tk][1]) + __shfl_xor(up ? acc[tk][1] : acc[tk][5], 32);
                  v2 = (up ? acc[tk][6] : acc[tk][2]) + __shfl_xor(up ? acc[tk][2] : acc[tk][6], 32);
                  v3 = (up ? acc[tk][7] : acc[tk][3]) + __shfl_xor(up ? acc[tk][3] : acc[tk][7], 32); }
                { const bool up = (F.lane & 16) != 0;
                  const float a0 = (up ? v2 : v0) + __shfl_xor(up ? v0 : v2, 16), a1 = (up ? v3 : v1) + __shfl_xor(up ? v1 : v3, 16); v0 = a0; v1 = a1; }
                { const bool up = (F.lane & 8) != 0; v0 = (up ? v1 : v0) + __shfl_xor(up ? v0 : v1, 8); }
                v0 += __shfl_xor(v0, 4); v0 += __shfl_xor(v0, 2); v0 += __shfl_xor(v0, 1);
                const int e = eq * 8 + ((F.lane >> 5) & 1) * 4 + ((F.lane >> 4) & 1) * 2 + ((F.lane >> 3) & 1);
                if ((F.lane & 7) == 0) lg[(F.wave * 4 + tk) * 32 + e] = v0 + brs[e];
            }
        }
        asm volatile("s_waitcnt lgkmcnt(0)" ::: "memory");
        if (F.lane < 4) {
            const LAS float* L = lg + (F.wave * 4 + F.lane) * 32;
            float b0 = -3.0e38f, b1 = -3.0e38f, b2 = -3.0e38f, b3 = -3.0e38f; int i0 = 0, i1 = 0, i2 = 0, i3 = 0;
            for (int e = 0; e < 32; ++e) { const float x = L[e];
                if (x > b3) { b3 = x; i3 = e;
                    if (b3 > b2) { float tf = b2; b2 = b3; b3 = tf; int ti = i2; i2 = i3; i3 = ti;
                        if (b2 > b1) { tf = b1; b1 = b2; b2 = tf; ti = i1; i1 = i2; i2 = ti;
                            if (b1 > b0) { tf = b0; b0 = b1; b1 = tf; ti = i0; i0 = i1; i1 = ti; } } } } }
            const float p1 = fast_exp(b1 - b0), p2 = fast_exp(b2 - b0), p3 = fast_exp(b3 - b0), inv = 1.0f / (1.0f + p1 + p2 + p3);
            const int t = t0 + F.lane;
            *(int4*)(topi + (size_t)t * 4) = make_int4(i0, i1, i2, i3);
            *(f32x4*)(topw + (size_t)t * 4) = (f32x4){inv, p1 * inv, p2 * inv, p3 * inv};
            const int ch = t / TCH;
            if (!dry) { atomicAdd((int*)(hist + ch * 32 + i0), 1); atomicAdd((int*)(hist + ch * 32 + i1), 1); atomicAdd((int*)(hist + ch * 32 + i2), 1); atomicAdd((int*)(hist + ch * 32 + i3), 1); }
        }
    }
    __syncthreads();
    if (F.tid < NCH * 32) { const int h = hist[F.tid]; if (h && !dry) atomicAdd(F.ctl + CW_CNT + F.tid, (unsigned)h); }
    __syncthreads();
}

__device__ __forceinline__ void p10_dispatch(const Frame& F) {
    LAS int* lcnt = (LAS int*)F.lds; LAS int* lbase = lcnt + 32; LAS int* pstart = lcnt + 64;
    const int* topi = (const int*)(F.ws + WS_TOPI); int* pos = (int*)(F.ws + WS_POS); int* rowtok = (int*)(F.ws + WS_ROWTOK);
    for (int s = F.c; s < T / 256; s += F.G) {
        const int ch = (s * 256) / TCH;
        __syncthreads();
        if (F.tid < 32) { lcnt[F.tid] = 0; int ps = 0; for (int e = 0; e < F.tid; ++e) { const int n = (int)__hip_atomic_load(F.ctl + CW_CNT + ch * 32 + e, __ATOMIC_RELAXED, __HIP_MEMORY_SCOPE_AGENT); ps += (n + 255) & ~255; } pstart[F.tid] = ps; }
        __syncthreads();
        int e2[2], r2[2];
#pragma unroll
        for (int i = 0; i < 2; ++i) { const int a = F.tid + i * NTHR; e2[i] = topi[(size_t)(s * 256) * 4 + a]; r2[i] = atomicAdd((int*)(lcnt + e2[i]), 1); }
        __syncthreads();
        if (F.tid < 32) lbase[F.tid] = (int)atomicAdd(F.ctl + CW_CUR + ch * 32 + F.tid, (unsigned)lcnt[F.tid]);
        __syncthreads();
#pragma unroll
        for (int i = 0; i < 2; ++i) { const int a = F.tid + i * NTHR, slot = pstart[e2[i]] + lbase[e2[i]] + r2[i];
            pos[(size_t)(s * 256) * 4 + a] = slot; rowtok[(size_t)ch * ROWS_CH + slot] = s * 256 + (a >> 2); }
    }
}
__device__ __forceinline__ int moe_blocks(const Frame& F, int ch, LAS unsigned char* blk_e) {
    LAS int* sh = (LAS int*)(blk_e + 1152);
    __syncthreads();
    if (F.tid < 32) {
        int start = 0, mine = 0;
        for (int e = 0; e < 32; ++e) { const int n = ((int)__hip_atomic_load(F.ctl + CW_CNT + ch * 32 + e, __ATOMIC_RELAXED, __HIP_MEMORY_SCOPE_AGENT) + 255) >> 8; if (e < F.tid) start += n; if (e == F.tid) mine = n; }
        for (int i = 0; i < mine; ++i) blk_e[start + i] = (unsigned char)F.tid;
        if (F.tid == 31) sh[0] = start + mine;
    }
    __syncthreads();
    return sh[0];
}

__device__ __forceinline__ void p13_combine_ln2(const Frame& F, int ch, const bool dry) {
    const unsigned char* YC = (const unsigned char*)(F.ws + WS_YCH); const int* pos = (const int*)(F.ws + WS_POS); const float* topw = (const float*)(F.ws + WS_TOPW);
    const float* ada = (const float*)(F.ws + WS_ADA); const bf16_t* X1 = (const bf16_t*)(F.ws + WS_X1); float* O = F.out;
    const int l8 = F.lane * 8;
    for (int t0 = ch * TCH + F.c * 8 + F.wave; t0 < (ch + 1) * TCH; t0 += 2 * F.G * 8) {
        int tt[2]; tt[0] = t0; tt[1] = t0 + F.G * 8; const bool two = tt[1] < (ch + 1) * TCH; if (!two) tt[1] = t0;
        f32x4 v[2][2][2];
#pragma unroll
        for (int q = 0; q < 2; ++q) { const int t = tt[q], b = t >> 11;
            const int4 ps = *(const int4*)(pos + (size_t)t * 4); const f32x4 tw = *(const f32x4*)(topw + (size_t)t * 4);
#pragma unroll
            for (int j = 0; j < 2; ++j) { const int k = 512 * j + l8;
                const u32x2 y0 = *(const u32x2*)(YC + (size_t)ps.x * 1024 + k), y1 = *(const u32x2*)(YC + (size_t)ps.y * 1024 + k), y2 = *(const u32x2*)(YC + (size_t)ps.z * 1024 + k), y3 = *(const u32x2*)(YC + (size_t)ps.w * 1024 + k);
                const u32x4 xw = *(const u32x4*)(X1 + (size_t)t * 1024 + k);
                const f32x4 g2a = *(const f32x4*)(ada + (size_t)b * 6144 + 5120 + k), g2b = *(const f32x4*)(ada + (size_t)b * 6144 + 5120 + k + 4);
                const f32x4 ffa = fp8x4_to_f32(y0.x) * tw[0] + fp8x4_to_f32(y1.x) * tw[1] + fp8x4_to_f32(y2.x) * tw[2] + fp8x4_to_f32(y3.x) * tw[3];
                const f32x4 ffb = fp8x4_to_f32(y0.y) * tw[0] + fp8x4_to_f32(y1.y) * tw[1] + fp8x4_to_f32(y2.y) * tw[2] + fp8x4_to_f32(y3.y) * tw[3];
                v[q][j][0] = (f32x4){bf_lo(xw.x), bf_hi(xw.x), bf_lo(xw.y), bf_hi(xw.y)} * DN_ALPHA + g2a * ffa;
                v[q][j][1] = (f32x4){bf_lo(xw.z), bf_hi(xw.z), bf_lo(xw.w), bf_hi(xw.w)} * DN_ALPHA + g2b * ffb; } }
#pragma unroll
        for (int q = 0; q < 2; ++q) { const int t = tt[q];
            float s = 0.f;
#pragma unroll
            for (int j = 0; j < 2; ++j)
#pragma unroll
                for (int h = 0; h < 2; ++h) s += (v[q][j][h][0] + v[q][j][h][1]) + (v[q][j][h][2] + v[q][j][h][3]);
            s = wave_sum(s); const float mean = s * (1.0f / 1024.0f); float qq = 0.f;
#pragma unroll
            for (int j = 0; j < 2; ++j)
#pragma unroll
                for (int h = 0; h < 2; ++h) { const f32x4 d = v[q][j][h] - mean; qq += (d[0] * d[0] + d[1] * d[1]) + (d[2] * d[2] + d[3] * d[3]); }
            qq = wave_sum(qq); const float rstd = __builtin_amdgcn_rsqf(qq * (1.0f / 1024.0f) + LN_EPS);
            if (q == 0 || two) {
#pragma unroll
                for (int j = 0; j < 2; ++j)
#pragma unroll
                    for (int h = 0; h < 2; ++h) { const int k = 512 * j + l8 + 4 * h; const f32x4 g = *(const f32x4*)(F.in[I_LN2G] + k), bb = *(const f32x4*)(F.in[I_LN2B] + k);
                        const f32x4 o4 = (v[q][j][h] - mean) * rstd * g + bb;
                        if (!dry) *(f32x4*)(O + (size_t)t * 1024 + k) = o4; else if (o4[0] == 1.2345e30f) O[0] = 1.f; } }
        }
    }
}

constexpr int SC_QD = 0, SC_KI = 17408, SC_KE = 34816, SC_VT = 53248, SC_SC = 71680, SC_ST = 80896, SC_GV = 115712, SC_CS = 116224;
__device__ __forceinline__ bf16x8 ldfrag(const LAS unsigned char* p) { return *(const LAS bf16x8*)p; }
__device__ __forceinline__ void p3_scan(const Frame& F, const bool dry) {
    LAS unsigned char* L = F.lds;
    const int tid = F.tid, w = F.wave, lane = F.lane, fr = lane & 15, fq = lane >> 4;
    const int d = tid & 127, qd = tid >> 7;
    bf16_t* PH = (bf16_t*)(F.ws + WS_PH); const bf16_t* PHC = (const bf16_t*)(F.ws + WS_PHC);
    for (int it = F.c; it < 256; it += F.G) {
        const int b = it >> 3, h = (it >> 1) & 3, dir = it & 1;
        const float r0 = F.in[I_LBRAW][dir * 512 + h * 128 + d], r1 = F.in[I_LBRAW][1024 + dir * 512 + h * 128 + d];
        const float lbv = fast_sigmoid(r0 - r1), oml = 1.0f - lbv;
        f32x4 Sacc[8];
#pragma unroll
        for (int i = 0; i < 8; ++i) Sacc[i] = (f32x4){0.f, 0.f, 0.f, 0.f};
        __syncthreads();
        for (int i = tid; i < 34816 / 4; i += NTHR) ((LAS unsigned*)(L + SC_ST))[i] = 0u;
        const int cq = h * 128 + d, cz = 512 + dir * 512 + h * 128 + d, cv = 1536 + h * 128 + d;
        bf16_t rq[16], rz[16], rv[16];
        {   const int n = dir ? 3 : 0; const bf16_t* base = PHC + (size_t)(b * 256 + 64 * n + 16 * qd) * 2048;
#pragma unroll
            for (int i = 0; i < 16; ++i) { rq[i] = base[(size_t)i * 2048 + cq]; rz[i] = base[(size_t)i * 2048 + cz]; rv[i] = base[(size_t)i * 2048 + cv]; } }
        for (int s = 0; s < 36; ++s) {
            const bool lat = s >= 4; const int n = lat ? (dir ? 31 - (s - 4) : (s - 4)) : (dir ? 3 - s : s);
            float kk[16], cum[16]; float run = 0.f;
#pragma unroll
            for (int i = 0; i < 16; ++i) { const float sg = fast_sigmoid(bf2f(rz[i])); kk[i] = oml * (1.0f - sg); cum[i] = fast_log(lbv + oml * sg); }
            if (dir == 0) {
#pragma unroll
                for (int i = 0; i < 16; ++i) { run += cum[i]; cum[i] = run; }
            } else {
#pragma unroll
                for (int i = 15; i >= 0; --i) { run += cum[i]; cum[i] = run; }
            }
            ((LAS float*)(L + SC_CS))[qd * 128 + d] = run;
            __syncthreads();
            {   const LAS float* cs = (const LAS float*)(L + SC_CS);
                const float c0 = cs[d], c1 = cs[128 + d], c2 = cs[256 + d], c3 = cs[384 + d], tot = (c0 + c1) + (c2 + c3);
                float off;
                if (dir == 0) off = (qd > 0 ? c0 : 0.f) + (qd > 1 ? c1 : 0.f) + (qd > 2 ? c2 : 0.f);
                else off = (qd < 3 ? c3 : 0.f) + (qd < 2 ? c2 : 0.f) + (qd < 1 ? c1 : 0.f);
                const float g = fast_exp(tot);
                if (qd == 0) ((LAS float*)(L + SC_GV))[d] = g;
                unsigned ke[8], vt[8];
#pragma unroll
                for (int i = 0; i < 16; i += 2) {
                    const float ca = cum[i] + off, cb = cum[i + 1] + off;
                    const float ea = fast_exp(ca), eb = fast_exp(cb), ia = __builtin_amdgcn_rcpf(ea), ib = __builtin_amdgcn_rcpf(eb);
                    const float qa = bf2f(rq[i]), qb = bf2f(rq[i + 1]);
                    const float qda = qa * fast_sigmoid(qa) * ea, qdb = qb * fast_sigmoid(qb) * eb;
                    const float kia = kk[i] * ia, kib = kk[i + 1] * ib;
                    const unsigned wa = cvt_pk_bf16(qda, kia), wb = cvt_pk_bf16(qdb, kib);
                    *(LAS bf16_t*)(L + SC_QD + (16 * qd + i) * 272 + d * 2) = (bf16_t)(wa & 0xffffu);
                    *(LAS bf16_t*)(L + SC_KI + (16 * qd + i) * 272 + d * 2) = (bf16_t)(wa >> 16);
                    *(LAS bf16_t*)(L + SC_QD + (16 * qd + i + 1) * 272 + d * 2) = (bf16_t)(wb & 0xffffu);
                    *(LAS bf16_t*)(L + SC_KI + (16 * qd + i + 1) * 272 + d * 2) = (bf16_t)(wb >> 16);
                    ke[i >> 1] = cvt_pk_bf16(kia * g, kib * g);
                    vt[i >> 1] = (unsigned)rv[i] | ((unsigned)rv[i + 1] << 16);
                }
                *(LAS u32x4*)(L + SC_KE + d * 144 + 32 * qd) = (u32x4){ke[0], ke[1], ke[2], ke[3]};
                *(LAS u32x4*)(L + SC_KE + d * 144 + 32 * qd + 16) = (u32x4){ke[4], ke[5], ke[6], ke[7]};
                *(LAS u32x4*)(L + SC_VT + d * 144 + 32 * qd) = (u32x4){vt[0], vt[1], vt[2], vt[3]};
                *(LAS u32x4*)(L + SC_VT + d * 144 + 32 * qd + 16) = (u32x4){vt[4], vt[5], vt[6], vt[7]};
            }
            if (s + 1 < 36) {
                const int s1 = s + 1; const bool lat1 = s1 >= 4; const int n1 = lat1 ? (dir ? 31 - (s1 - 4) : (s1 - 4)) : (dir ? 3 - s1 : s1);
                const bf16_t* base = lat1 ? (const bf16_t*)PH + (size_t)(b * 2048 + 64 * n1 + 16 * qd) * 2048 : PHC + (size_t)(b * 256 + 64 * n1 + 16 * qd) * 2048;
#pragma unroll
                for (int i = 0; i < 16; ++i) { rq[i] = base[(size_t)i * 2048 + cq]; rz[i] = base[(size_t)i * 2048 + cz]; rv[i] = base[(size_t)i * 2048 + cv]; }
            }
            __syncthreads();
            f32x4 oacc[4];
#pragma unroll
            for (int i = 0; i < 4; ++i) oacc[i] = (f32x4){0.f, 0.f, 0.f, 0.f};
            const int kb = fq * 16;
            if (lat) {
                const int ct = w >> 1, st0 = 2 * (w & 1);
#pragma unroll
                for (int j = 0; j < 2; ++j) { const int st = st0 + j; f32x4 sa = (f32x4){0.f, 0.f, 0.f, 0.f};
#pragma unroll
                    for (int ks = 0; ks < 4; ++ks) sa = __builtin_amdgcn_mfma_f32_16x16x32_bf16(ldfrag(L + SC_KI + (16 * st + fr) * 272 + ks * 64 + kb), ldfrag(L + SC_QD + (16 * ct + fr) * 272 + ks * 64 + kb), sa, 0, 0, 0);
                    const int cc = 16 * ct + fr, s0 = 16 * st + 4 * fq;
#pragma unroll
                    for (int i = 0; i < 4; ++i) { const bool keep = dir ? (s0 + i >= cc) : (s0 + i <= cc); sa[i] = keep ? sa[i] : 0.f; }
                    *(LAS u32x2*)(L + SC_SC + cc * 144 + s0 * 2) = (u32x2){cvt_pk_bf16(sa[0], sa[1]), cvt_pk_bf16(sa[2], sa[3])}; }
#pragma unroll
                for (int ct2 = 0; ct2 < 4; ++ct2)
#pragma unroll
                    for (int ks = 0; ks < 4; ++ks) oacc[ct2] = __builtin_amdgcn_mfma_f32_16x16x32_bf16(ldfrag(L + SC_ST + (16 * w + fr) * 272 + ks * 64 + kb), ldfrag(L + SC_QD + (16 * ct2 + fr) * 272 + ks * 64 + kb), oacc[ct2], 0, 0, 0);
            }
            {   const bf16x8 v0 = ldfrag(L + SC_VT + (16 * w + fr) * 144 + kb), v1 = ldfrag(L + SC_VT + (16 * w + fr) * 144 + 64 + kb);
#pragma unroll
                for (int dt = 0; dt < 8; ++dt) { const f32x4 gv = *(const LAS f32x4*)(L + SC_GV + (16 * dt + 4 * fq) * 4);
                    f32x4 a = Sacc[dt] * gv;
                    a = __builtin_amdgcn_mfma_f32_16x16x32_bf16(ldfrag(L + SC_KE + (16 * dt + fr) * 144 + kb), v0, a, 0, 0, 0);
                    a = __builtin_amdgcn_mfma_f32_16x16x32_bf16(ldfrag(L + SC_KE + (16 * dt + fr) * 144 + 64 + kb), v1, a, 0, 0, 0);
                    Sacc[dt] = a; } }
            __syncthreads();
#pragma unroll
            for (int dt = 0; dt < 8; ++dt) *(LAS u32x2*)(L + SC_ST + (16 * w + fr) * 272 + (16 * dt + 4 * fq) * 2) = (u32x2){cvt_pk_bf16(Sacc[dt][0], Sacc[dt][1]), cvt_pk_bf16(Sacc[dt][2], Sacc[dt][3])};
            if (lat) {
                const bf16x8 v0 = ldfrag(L + SC_VT + (16 * w + fr) * 144 + kb), v1 = ldfrag(L + SC_VT + (16 * w + fr) * 144 + 64 + kb);
                bf16_t* ob = PH + (size_t)(b * 2048 + 64 * n) * 2048 + 512 + dir * 512 + h * 128 + 16 * w + 4 * fq;
#pragma unroll
                for (int ct2 = 0; ct2 < 4; ++ct2) {
                    f32x4 a = oacc[ct2];
                    a = __builtin_amdgcn_mfma_f32_16x16x32_bf16(v0, ldfrag(L + SC_SC + (16 * ct2 + fr) * 144 + kb), a, 0, 0, 0);
                    a = __builtin_amdgcn_mfma_f32_16x16x32_bf16(v1, ldfrag(L + SC_SC + (16 * ct2 + fr) * 144 + 64 + kb), a, 0, 0, 0);
                    if (!dry) *(u32x2*)(ob + (size_t)(16 * ct2 + fr) * 2048) = (u32x2){cvt_pk_bf16(a[0], a[1]), cvt_pk_bf16(a[2], a[3])};
                    else if (a[0] == 1.2345e30f) ob[0] = 1; }
            }
        }
        __syncthreads();
    }
}

typedef short s16x4 __attribute__((ext_vector_type(4)));
__device__ __forceinline__ s16x4 tr_read(unsigned lds_addr) { s16x4 r; asm volatile("ds_read_b64_tr_b16 %0, %1\n\ts_waitcnt lgkmcnt(0)" : "=&v"(r) : "v"(lds_addr) : "memory"); return r; }
__device__ __forceinline__ void tr_read8(unsigned a0, unsigned a1, unsigned a2, unsigned a3, unsigned d, s16x4 (&r)[8]) {
    asm volatile("ds_read_b64_tr_b16 %0, %8\n\tds_read_b64_tr_b16 %1, %9\n\tds_read_b64_tr_b16 %2, %10\n\tds_read_b64_tr_b16 %3, %11\n\t"
                 "ds_read_b64_tr_b16 %4, %12\n\tds_read_b64_tr_b16 %5, %13\n\tds_read_b64_tr_b16 %6, %14\n\tds_read_b64_tr_b16 %7, %15\n\ts_waitcnt lgkmcnt(0)"
                 : "=&v"(r[0]), "=&v"(r[1]), "=&v"(r[2]), "=&v"(r[3]), "=&v"(r[4]), "=&v"(r[5]), "=&v"(r[6]), "=&v"(r[7])
                 : "v"(a0), "v"(a0 + d), "v"(a1), "v"(a1 + d), "v"(a2), "v"(a2 + d), "v"(a3), "v"(a3 + d) : "memory");
}
__device__ __forceinline__ void tr_read4(unsigned a0, unsigned a1, unsigned d, s16x4 (&r)[4]) {
    asm volatile("ds_read_b64_tr_b16 %0, %4\n\tds_read_b64_tr_b16 %1, %5\n\tds_read_b64_tr_b16 %2, %6\n\tds_read_b64_tr_b16 %3, %7\n\ts_waitcnt lgkmcnt(0)"
                 : "=&v"(r[0]), "=&v"(r[1]), "=&v"(r[2]), "=&v"(r[3]) : "v"(a0), "v"(a0 + d), "v"(a1), "v"(a1 + d) : "memory");
}
__device__ __forceinline__ bf16x8 cat4(s16x4 a, s16x4 b) { return (bf16x8){a[0], a[1], a[2], a[3], b[0], b[1], b[2], b[3]}; }
constexpr int FO_C = 131072, FO_S = 139264;
__device__ __forceinline__ void p4_fourier(const Frame& F) {
    LAS unsigned char* L = F.lds;
    const int tid = F.tid, w = F.wave, lane = F.lane, fr = lane & 15, fq = lane >> 4;
    const bf16_t* PA = (const bf16_t*)(F.ws + WS_PA); unsigned char* Y = (unsigned char*)(F.ws + WS_Y);
    __syncthreads();
    for (int i = tid; i < 4096; i += NTHR) { const int k2 = i >> 6, c = i & 63; const float a = (float)((k2 * c) & 63) * (1.0f / 64.0f);
        *(LAS bf16_t*)(L + FO_C + i * 2) = (bf16_t)(cvt_pk_bf16(__builtin_amdgcn_cosf(a) * 0.125f, 0.f) & 0xffffu);
        *(LAS bf16_t*)(L + FO_S + i * 2) = (bf16_t)(cvt_pk_bf16(__builtin_amdgcn_sinf(a) * 0.125f, 0.f) & 0xffffu); }
    bf16x8 Gf[2][2];
#pragma unroll
    for (int nt = 0; nt < 2; ++nt)
#pragma unroll
        for (int ks = 0; ks < 2; ++ks) { unsigned pk[4];
#pragma unroll
            for (int j = 0; j < 8; j += 2) { const int k1 = 16 * nt + fr, ra = 8 * fq + j, rb = ra + 1; const float aa = (float)((k1 * ra) & 31) * (1.0f / 32.0f), ab = (float)((k1 * rb) & 31) * (1.0f / 32.0f);
                const float va = (ks ? __builtin_amdgcn_sinf(aa) : __builtin_amdgcn_cosf(aa)) * 0.17677669529663687f, vb = (ks ? __builtin_amdgcn_sinf(ab) : __builtin_amdgcn_cosf(ab)) * 0.17677669529663687f;
                pk[j >> 1] = cvt_pk_bf16(va, vb); }
            u32x4 t4 = (u32x4){pk[0], pk[1], pk[2], pk[3]}; Gf[nt][ks] = *(bf16x8*)&t4; }
    const unsigned lbase = (unsigned)(size_t)L;
    for (int it = F.c; it < 1024; it += F.G) {
        const int xcd = it & 7, jj = it >> 3, slab = 4 * xcd + (jj & 3), b = jj >> 2;
        __syncthreads();
        {   const bf16_t* src = PA + (size_t)(b * 32 + slab) * 2048 * 32;
            u32x4 v[16];
#pragma unroll
            for (int n = 0; n < 16; ++n) v[n] = *(const u32x4*)(src + (size_t)(tid + NTHR * n) * 8);
#pragma unroll
            for (int n = 0; n < 16; ++n) *(LAS u32x4*)(L + (tid + NTHR * n) * 16) = v[n]; }
        __syncthreads();
#pragma unroll 1
        for (int rr = 0; rr < 4; ++rr) {
            const int r = w + 8 * rr;
            f32x4 acc[8];
#pragma unroll
            for (int i = 0; i < 8; ++i) acc[i] = (f32x4){0.f, 0.f, 0.f, 0.f};
            s16x4 tr[8];
            {   unsigned aa[4];
#pragma unroll
                for (int ks = 0; ks < 4; ++ks) { const int ri = ks >> 1, c0 = 32 * (ks & 1) + 8 * fq + (fr >> 2); aa[ks] = lbase + (unsigned)((r * 64 + c0) * 64 + ri * 32 + (fr & 3) * 8); }
                tr_read8(aa[0], aa[1], aa[2], aa[3], 4u * 64u, tr); }
#pragma unroll
            for (int ks = 0; ks < 4; ++ks) {
                const int ri = ks >> 1;
                const bf16x8 af = cat4(tr[2 * ks], tr[2 * ks + 1]);
#pragma unroll
                for (int nt = 0; nt < 8; ++nt) { const int ro = nt >> 2, k2 = 16 * (nt & 3) + fr;
                    u32x4 bw = *(const LAS u32x4*)(L + ((ro == ri) ? FO_C : FO_S) + (k2 * 64 + 32 * (ks & 1) + 8 * fq) * 2);
                    if (ro == 1 && ri == 0) { bw.x ^= 0x80008000u; bw.y ^= 0x80008000u; bw.z ^= 0x80008000u; bw.w ^= 0x80008000u; }
                    acc[nt] = __builtin_amdgcn_mfma_f32_16x16x32_bf16(af, *(bf16x8*)&bw, acc[nt], 0, 0, 0); }
            }
#pragma unroll
            for (int nt = 0; nt < 8; ++nt) { const int ro = nt >> 2, k2 = 16 * (nt & 3) + fr;
                *(LAS u32x2*)(L + (r * 64 + k2) * 64 + ro * 32 + fq * 8) = (u32x2){cvt_pk_bf16(acc[nt][0], acc[nt][1]), cvt_pk_bf16(acc[nt][2], acc[nt][3])}; }
        }
        __syncthreads();
#pragma unroll 1
        for (int kk = 0; kk < 8; ++kk) {
            const int k2 = 8 * w + kk;
            f32x4 a2[2] = {(f32x4){0.f, 0.f, 0.f, 0.f}, (f32x4){0.f, 0.f, 0.f, 0.f}};
            s16x4 t4[4];
            {   const int r0 = 8 * fq + (fr >> 2); const unsigned a0 = lbase + (unsigned)((r0 * 64 + k2) * 64 + (fr & 3) * 8);
                tr_read4(a0, a0 + 32u, 4u * 64u * 64u, t4); }
#pragma unroll
            for (int ks = 0; ks < 2; ++ks) {
                const bf16x8 af = cat4(t4[2 * ks], t4[2 * ks + 1]);
                a2[0] = __builtin_amdgcn_mfma_f32_16x16x32_bf16(af, Gf[0][ks], a2[0], 0, 0, 0);
                a2[1] = __builtin_amdgcn_mfma_f32_16x16x32_bf16(af, Gf[1][ks], a2[1], 0, 0, 0);
            }
#pragma unroll
            for (int nt = 0; nt < 2; ++nt) { const int k1 = 16 * nt + fr;
                *(unsigned*)(Y + (size_t)(b * 2048 + k1 * 64 + k2) * 1024 + slab * 16 + 4 * fq) = cvt_pk4_fp8(a2[nt][0], a2[nt][1], a2[nt][2], a2[nt][3]); }
        }
    }
    __syncthreads();
}

struct Args { const float* in[22]; float* out; unsigned char* ws; int ph_lo, ph_hi; };
constexpr int N_PHASES = 9 + 3 * NCH;

__global__ void __launch_bounds__(NTHR, 2) mega_fwd(Args args) {
    extern __shared__ __attribute__((aligned(16))) unsigned char lds_raw[];
    Frame F;
    F.lds = (LAS unsigned char*)lds_raw;
    F.tid = threadIdx.x; F.lane = F.tid & 63; F.wave = __builtin_amdgcn_readfirstlane(F.tid >> 6);
    F.G = gridDim.x; F.c = blockIdx.x;
    F.in = args.in;
    F.out = args.out; F.ws = args.ws; F.ctl = (unsigned*)(args.ws + WS_CTL);
    volatile LAS unsigned* misc = (volatile LAS unsigned*)(F.lds + LDS_MISC);
    if (F.tid < 4) misc[F.tid] = 0u;
    __syncthreads();
    XcdBarrier bar = xcd_barrier_post(F.ctl, misc);
    const int lo = args.ph_lo, hi = args.ph_hi;
#ifndef PHASE_MASK
#define PHASE_MASK 0xFFFFFFFFu
#endif
#define IN(k) ((((PHASE_MASK) >> (k)) & 1u) && lo <= (k) && (k) < hi)
#define SEAM(k) do { if (IN(k) && IN((k) + 1)) xcd_barrier(bar); } while (0)
#ifndef REP_MASK
#define REP_MASK 0u
#endif
#define REPS(b) ((((REP_MASK) >> (b)) & 1u) ? 2 : 1)
#define REPBAR(b, r) do { if ((((REP_MASK) >> (b)) & 1u) && (r) == 0) xcd_barrier(bar); } while (0)
    unsigned char* ws = F.ws;
    LAS unsigned char* blk_e = F.lds + LDS_MISC + 64;
#ifdef PR_A
    unsigned long long* stamps = (unsigned long long*)(ws + 980 * MiB);
#define STAMP(slot) do { if (F.tid == 0) stamps[(slot) * 256 + F.c] = __builtin_amdgcn_s_memrealtime(); } while (0)
#else
#define STAMP(slot) do { } while (0)
#endif
    STAMP(0);

    if (IN(0)) { for (int r = 0; r < REPS(0); ++r) { p0_ada(F); p0_fold(F); p0_convert(F); REPBAR(0, r); } }
    STAMP(1);
    SEAM(0);
    if (IN(1)) { for (int r = 0; r < REPS(1); ++r) { p1_uprep(F); REPBAR(1, r); } }
    STAMP(2);
    SEAM(1);
    if (IN(2)) {
        ProbP1 P{(const char*)(ws + WS_U), 8, 1024u, 1024u, (const char*)(ws + WS_WIN1T), (unsigned)(WS_UC - WS_U), F.G, F.c};
        EpiP1 E{(bf16_t*)(ws + WS_PA), (bf16_t*)(ws + WS_PH), (bf16_t*)(ws + WS_PHC)};
        for (int r = 0; r < REPS(2); ++r) { pg8::gemm_phase<ProbP1, EpiP1, true, false, true>(F.lds, P, E); REPBAR(2, r); }
    }
    STAMP(3);
    SEAM(2);
    if (IN(3)) {
#ifndef NO_FOURIER
        for (int r = 0; r < REPS(4); ++r) { p4_fourier(F); REPBAR(4, r); }
        STAMP(5);
#endif
#ifndef NO_SCAN
        for (int r = 0; r < REPS(3); ++r) { p3_scan(F, r + 1 < REPS(3)); REPBAR(3, r); }
        STAMP(4);
#endif
#ifndef NO_P2GEMM
        ProbDense P{(const char*)(ws + WS_U), 8, 1024u, 1024u, (const char*)(ws + WS_WIN2T), 256, 10, F.G, F.c, 0};
        EpiP2 E{(bf16_t*)(ws + WS_PG), (bf16_t*)F.out};
        for (int r = 0; r < REPS(5); ++r) { pg8::gemm_phase<ProbDense, EpiP2, true, false, true>(F.lds, P, E); REPBAR(5, r); }
#endif
    }
    STAMP(6);
    SEAM(3);
    if (IN(4)) { for (int r = 0; r < REPS(6); ++r) { p6_readout(F); REPBAR(6, r); } }
    STAMP(7);
    SEAM(4);
    if (IN(5)) {
        ProbDense P{(const char*)(ws + WS_Y), 8, 1024u, 1024u, (const char*)(ws + WS_WMT), 256, 4, F.G, F.c, 1};
        EpiM1 E{(const bf16_t*)F.out, (unsigned char*)(ws + WS_PA)};
        for (int r = 0; r < REPS(7); ++r) { pg8::gemm_phase<ProbDense, EpiM1, true, true, true>(F.lds, P, E); REPBAR(7, r); }
    }
    STAMP(8);
    SEAM(5);
    if (IN(6)) {
        ProbDense P{(const char*)(ws + WS_PA), 8, 1024u, 1024u, (const char*)(ws + WS_WOT), 256, 4, F.G, F.c, 0};
        EpiM2 E{F.in[I_X], (const float*)(ws + WS_ADA), (bf16_t*)F.out};
        for (int r = 0; r < REPS(8); ++r) { pg8::gemm_phase<ProbDense, EpiM2, true, false, true>(F.lds, P, E); REPBAR(8, r); }
    }
    STAMP(9);
    SEAM(6);
    if (IN(7)) { for (int r = 0; r < REPS(9); ++r) { p9_ln1_router(F, r + 1 < REPS(9)); REPBAR(9, r); } }
    STAMP(10);
    SEAM(7);
    if (IN(8)) { p10_dispatch(F); }
    STAMP(11);
    SEAM(8);
#pragma unroll
    for (int ch = 0; ch < NCH; ++ch) {
        if (IN(9 + 3 * ch)) {
            const int nblk = moe_blocks(F, ch, blk_e);
            ProbMoE<true> P{(const char*)(ws + WS_U), 8, 1024u, 1024u, (const char*)(ws + WS_WGUT), (size_t)2048 * 1024, 8, nblk, F.G, F.c, (const int*)(ws + WS_ROWTOK) + (size_t)ch * ROWS_CH, blk_e};
            EpiGU E{F.in[I_BGU], (unsigned char*)(ws + WS_ACT)};
#ifdef GU_DRY
            pg8::gemm_phase<ProbMoE<true>, EpiGU, true, false, true, GU_DRY>(F.lds, P, E); xcd_barrier(bar);
#endif
            for (int r = 0; r < (ch == 0 ? REPS(10) : 1); ++r) { pg8::gemm_phase<ProbMoE<true>, EpiGU, true, false, true>(F.lds, P, E); if (ch == 0) REPBAR(10, r); }
        }
        STAMP(12);
        SEAM(9 + 3 * ch);
        if (IN(10 + 3 * ch)) {
            const int nblk = moe_blocks(F, ch, blk_e);
            ProbMoE<false> P{(const char*)(ws + WS_ACT), 8, 1024u, 1024u, (const char*)(ws + WS_WDNT), (size_t)1024 * 1024, 4, nblk, F.G, F.c, nullptr, blk_e};
            EpiDN E{F.in[I_BDN], (unsigned char*)(ws + WS_YCH)};
            for (int r = 0; r < (ch == 0 ? REPS(11) : 1); ++r) { pg8::gemm_phase<ProbMoE<false>, EpiDN, true, false, true>(F.lds, P, E); if (ch == 0) REPBAR(11, r); }
        }
        STAMP(13);
        SEAM(10 + 3 * ch);
        if (IN(11 + 3 * ch)) { for (int r = 0; r < (ch == 0 ? REPS(12) : 1); ++r) { p13_combine_ln2(F, ch, ch == 0 && r + 1 < REPS(12)); if (ch == 0) REPBAR(12, r); } }
        STAMP(14);
        SEAM(11 + 3 * ch);
    }
#ifdef DBG_K
    xcd_barrier(bar);
    {
        const unsigned char* buf = (DBG_OUT) ? (const unsigned char*)F.out : (const unsigned char*)(ws + (size_t)(DBG_OFF));
        const size_t wpr = (size_t)(DBG_CW) / 4, nw = (size_t)(DBG_ROWS) * wpr;
        unsigned long long cs = 0; unsigned bad = 0;
        for (size_t i = (size_t)F.c * NTHR + F.tid; i < nw; i += (size_t)F.G * NTHR) { const size_t r = i / wpr, cw = i % wpr; const unsigned w = *(const unsigned*)(buf + r * (size_t)(DBG_LD) + (DBG_C0) + cw * 4); cs += w;
            if (DBG_F32) { if ((w & 0x7f800000u) == 0x7f800000u) ++bad; } else { if ((w & 0x7f80u) == 0x7f80u) ++bad; if ((w & 0x7f800000u) == 0x7f800000u) ++bad; } }
        for (int o = 32; o >= 1; o >>= 1) { cs += __shfl_xor(cs, o); bad += __shfl_xor(bad, o); }
        if (F.lane == 0) { atomicAdd((unsigned long long*)(F.ctl + 8192), cs); atomicAdd(F.ctl + 8200, bad); }
        if (F.c == 0 && F.tid == 0) atomicAdd(F.ctl + 8201, xb_ld(&F.ctl[XB_TMO]));
    }
    xcd_barrier(bar);
    {
        const unsigned long long cs = __hip_atomic_load((unsigned long long*)(F.ctl + 8192), __ATOMIC_RELAXED, __HIP_MEMORY_SCOPE_AGENT);
        const unsigned bad = xb_ld(F.ctl + 8200), tmo = xb_ld(F.ctl + 8201);
        const float val = (float)(unsigned)((cs ^ (cs >> 16) ^ (cs >> 32)) & 0xFFFFu) * (1.0f / 65536.0f) + (bad ? 2.0f : 0.0f) + (tmo ? 4.0f : 0.0f);
        for (size_t i = (size_t)F.c * NTHR + F.tid; i < (size_t)T * D; i += (size_t)F.G * NTHR) F.out[i] = val;
    }
    return;
#endif
#ifdef PR_A
    xcd_barrier(bar);
    {
        auto maxs = [&](int sl) { unsigned long long m = 0; for (int w = 0; w < (int)F.G; ++w) { const unsigned long long v = stamps[sl * 256 + w]; m = v > m ? v : m; } return m; };
        auto dur = [&](int sl) -> float {
            if (sl == 4) { const unsigned long long st = maxs(3); double a = 0; for (int w = 0; w < (int)F.G; ++w) a += (double)(stamps[4 * 256 + w] - st); return (float)(a / F.G) * 0.01f; }
            if (sl == 5) { double a = 0; for (int w = 0; w < (int)F.G; ++w) a += (double)(stamps[5 * 256 + w] - stamps[4 * 256 + w]); return (float)(a / F.G) * 0.01f; }
            if (sl == 6) { double a = 0; for (int w = 0; w < (int)F.G; ++w) a += (double)(stamps[6 * 256 + w] - stamps[5 * 256 + w]); return (float)(a / F.G) * 0.01f; }
            if (sl == 16) return (float)(maxs(6) - maxs(3)) * 0.01f;
            return (float)(maxs(sl) - maxs(sl - 1)) * 0.01f; };
        const float va = rintf(dur(PR_A) * 0.1f + (PR_OFF)) * 0.1f, vb = rintf(dur(PR_B) * 0.1f + (PR_OFF)) * 10.0f;
        for (size_t i = (size_t)F.c * NTHR + F.tid; i < (size_t)T * D; i += (size_t)F.G * NTHR) F.out[i] = va;
        __syncthreads();
        if (F.c == 0 && F.tid == 0) F.out[12345] = vb;
    }
    return;
#endif
    if (F.c == 0 && F.tid == 0 && hi == N_PHASES) { if (xb_ld(&F.ctl[XB_TMO]) != 0u) F.out[0] = __builtin_nanf(""); }
#undef IN
#undef SEAM
}

extern "C" void kernel_launch(void* const* d_in, const int* in_sizes, int n_in, void* d_out, int out_size, void* d_ws, size_t ws_size, hipStream_t stream) {
    static int grid = 0;
    if (grid == 0) {
        if (n_in != 22 || out_size != T * D || ws_size < WS_END) { fprintf(stderr, "kernel_launch: unexpected shapes (n_in %d, out %d, ws %zu)\n", n_in, out_size, ws_size); grid = -1; return; }
        int dev = 0, cus = 0, per_cu = 0;
        if (hipGetDevice(&dev) != hipSuccess || hipDeviceGetAttribute(&cus, hipDeviceAttributeMultiprocessorCount, dev) != hipSuccess) { grid = -1; return; }
        if (hipFuncSetAttribute((const void*)mega_fwd, hipFuncAttributeMaxDynamicSharedMemorySize, LDS_BYTES) != hipSuccess) { fprintf(stderr, "kernel_launch: hipFuncSetAttribute failed\n"); grid = -1; return; }
        if (hipOccupancyMaxActiveBlocksPerMultiprocessor(&per_cu, (const void*)mega_fwd, NTHR, LDS_BYTES) != hipSuccess || per_cu < 1) fprintf(stderr, "kernel_launch: occupancy query reports %d blocks per CU\n", per_cu);
        (void)hipGetLastError();
        grid = cus;
    }
    if (grid < 0) return;
    (void)hipMemsetAsync((char*)d_ws + WS_CTL, 0, CTL_BYTES, stream);
    Args a{};
    for (int i = 0; i < 22; ++i) a.in[i] = (const float*)d_in[i];
    a.out = (float*)d_out; a.ws = (unsigned char*)d_ws; a.ph_lo = 0; a.ph_hi = N_PHASES;
#ifdef DBG_K
    a.ph_hi = DBG_K;
#endif
    hipLaunchKernelGGL(mega_fwd, dim3(grid), dim3(NTHR), LDS_BYTES, stream, a);
}
```

```cpp
#include <hip/hip_runtime.h>
#include <cstdio>
#include <cstdint>

#define LAS __attribute__((address_space(3)))
typedef unsigned short bf16_t;
typedef short bf16x8 __attribute__((ext_vector_type(8)));
typedef short bf16x4 __attribute__((ext_vector_type(4)));
typedef float f32x4 __attribute__((ext_vector_type(4)));
typedef float f32x2 __attribute__((ext_vector_type(2)));
typedef unsigned u32x4 __attribute__((ext_vector_type(4)));
typedef unsigned u32x2 __attribute__((ext_vector_type(2)));

constexpr int D = 1024, NB = 32, SEQ = 2048, T = NB * SEQ, CTX = 256, TCX = NB * CTX;
#ifndef NCH_SET
#define NCH_SET 1
#endif
constexpr int NEXP = 32, TOPK = 4;
constexpr int NCH = NCH_SET, TCH = T / NCH;
constexpr int ROWS_CH = TCH * TOPK + NEXP * 256;
constexpr float DN_ALPHA = 1.189207115002721f;
constexpr float LN_EPS = 1e-5f, RMS_EPS = 1e-6f;
constexpr int NTHR = 512;

constexpr size_t MiB = 1ull << 20;
constexpr size_t WS_CTL = 0;
constexpr size_t CTL_BYTES = 65536;
constexpr size_t WS_ADA = 65536;
constexpr size_t WS_WIN1T = 1 * MiB;
constexpr size_t WS_WIN2T = 7 * MiB;
constexpr size_t WS_WMT = 12 * MiB;
constexpr size_t WS_WOT = 14 * MiB;
constexpr size_t WS_WGUT = 16 * MiB;
constexpr size_t WS_WDNT = 80 * MiB;
constexpr size_t WS_TOPI = 112 * MiB;
constexpr size_t WS_TOPW = 113 * MiB;
constexpr size_t WS_POS = 114 * MiB;
constexpr size_t WS_ROWTOK = 115 * MiB;
constexpr size_t WS_U = 120 * MiB;
constexpr size_t WS_PA = 184 * MiB;
constexpr size_t WS_PH = 312 * MiB;
constexpr size_t WS_PHC = 568 * MiB;
constexpr size_t WS_PG = 600 * MiB;
constexpr size_t WS_Y = 664 * MiB;
constexpr size_t WS_UC = WS_Y;
constexpr size_t WS_ACT = WS_PA;
constexpr size_t WS_YCH = WS_PA + 264 * MiB;
constexpr size_t WS_X1 = WS_YCH + 264 * MiB;
constexpr size_t WS_END = 976 * MiB;
static_assert(WS_X1 + 128 * MiB <= WS_END && (size_t)ROWS_CH * 1024 <= 264 * MiB && WS_Y + 128 * MiB <= WS_END, "ws map");
constexpr int CW_CNT = 4096;
constexpr int CW_CUR = 4096 + 64;

constexpr int LDS_SCRATCH = 147456;
constexpr int LDS_MISC = LDS_SCRATCH;
constexpr int LDS_BYTES = LDS_SCRATCH + 2048;

typedef __bf16 bf16x2_t __attribute__((ext_vector_type(2)));
__device__ __forceinline__ unsigned cvt_pk_bf16(float lo, float hi) { const f32x2 v = {lo, hi}; const bf16x2_t r = __builtin_convertvector(v, bf16x2_t); return __builtin_bit_cast(unsigned, r); }
__device__ __forceinline__ unsigned cvt_pk4_fp8(float a, float b, float c, float d) {
    a = fminf(fmaxf(a, -448.f), 448.f); b = fminf(fmaxf(b, -448.f), 448.f); c = fminf(fmaxf(c, -448.f), 448.f); d = fminf(fmaxf(d, -448.f), 448.f);
    int w = __builtin_amdgcn_cvt_pk_fp8_f32(a, b, 0, false); w = __builtin_amdgcn_cvt_pk_fp8_f32(c, d, w, true); return (unsigned)w; }
constexpr float W8_SCALE = 32.0f, W8_INV = 1.0f / 32.0f;
typedef float f32x2v __attribute__((ext_vector_type(2)));
__device__ __forceinline__ f32x4 fp8x4_to_f32(unsigned w) { const f32x2v a = __builtin_amdgcn_cvt_pk_f32_fp8((int)w, false), b = __builtin_amdgcn_cvt_pk_f32_fp8((int)w, true); return (f32x4){a[0], a[1], b[0], b[1]}; }
__device__ __forceinline__ u32x4 widen16(u32x2 a, u32x2 b) {
    const u32x2 rx = __builtin_amdgcn_permlane16_swap(a.x, b.x, false, false), ry = __builtin_amdgcn_permlane16_swap(a.y, b.y, false, false);
    return (u32x4){rx[0], ry[0], rx[1], ry[1]}; }
__device__ __forceinline__ void unwiden16(u32x4 L, u32x2& a, u32x2& b) {
    const u32x2 rx = __builtin_amdgcn_permlane16_swap(L.x, L.z, false, false), ry = __builtin_amdgcn_permlane16_swap(L.y, L.w, false, false);
    a = (u32x2){rx[0], ry[0]}; b = (u32x2){rx[1], ry[1]}; }
__device__ __forceinline__ unsigned pack4_u8(float a, float b, float c, float d) {
    unsigned w = __builtin_amdgcn_cvt_pk_u8_f32(__builtin_rintf(a), 0, 0u); w = __builtin_amdgcn_cvt_pk_u8_f32(__builtin_rintf(b), 1, w);
    w = __builtin_amdgcn_cvt_pk_u8_f32(__builtin_rintf(c), 2, w); return __builtin_amdgcn_cvt_pk_u8_f32(__builtin_rintf(d), 3, w); }
__device__ __forceinline__ f32x4 u8x4_to_f32(unsigned w) { return (f32x4){(float)(w & 0xffu), (float)((w >> 8) & 0xffu), (float)((w >> 16) & 0xffu), (float)(w >> 24)}; }
__device__ __forceinline__ float bf_lo(unsigned w) { return __uint_as_float(w << 16); }
__device__ __forceinline__ float bf_hi(unsigned w) { return __uint_as_float(w & 0xffff0000u); }
__device__ __forceinline__ float bf2f(bf16_t v) { return __uint_as_float(((unsigned)v) << 16); }
__device__ __forceinline__ float fast_exp(float x) { return __builtin_amdgcn_exp2f(x * 1.4426950408889634f); }
__device__ __forceinline__ float fast_sigmoid(float x) { return __builtin_amdgcn_rcpf(1.0f + fast_exp(-x)); }
__device__ __forceinline__ float fast_log(float x) { return __builtin_amdgcn_logf(x) * 0.6931471805599453f; }

#define XB_TMO      128
#define XB_XCNT(j)  (256  + 64 * (j))
#define XB_XSUB(j)  (1280 + 64 * (j))
#define XB_XGEN(j)  (2304 + 64 * (j))
#define XB_TOP      3328
#define XB_TOPGEN   3392
#define XCD_BAR_WORDS 3456
#define XB_SPIN_CAP (1u << 18)

__device__ __forceinline__ unsigned xb_ld(unsigned* p)              { return __hip_atomic_load(p, __ATOMIC_RELAXED, __HIP_MEMORY_SCOPE_AGENT); }
__device__ __forceinline__ unsigned xb_add(unsigned* p, unsigned v) { return __hip_atomic_fetch_add(p, v, __ATOMIC_RELAXED, __HIP_MEMORY_SCOPE_AGENT); }
__device__ __forceinline__ unsigned xb_xcc_id() { return (unsigned)__builtin_amdgcn_s_getreg((3 << 11) | 20) & 0xFu; }
#define XB_SPIN(cond, bar) do { unsigned _sp = 0; while (cond) { __builtin_amdgcn_s_sleep(1); \
    if ((++_sp & 255u) == 0u) { if (xb_ld(&(bar)[XB_TMO])) break; if (_sp > XB_SPIN_CAP) { atomicAdd(&(bar)[XB_TMO], 1u); break; } } } } while (0)

struct XcdBarrier { unsigned* bar; unsigned x; volatile LAS unsigned* st; };

__device__ __forceinline__ XcdBarrier xcd_barrier_post(unsigned* bar, volatile LAS unsigned* st) {
    XcdBarrier b; b.bar = bar; b.x = xb_xcc_id(); b.st = st;
    if (threadIdx.x == 0) (void)xb_add(&bar[XB_XCNT(b.x)], 1u);
    return b;
}
__device__ __forceinline__ void xcd_barrier_complete(unsigned* bar, unsigned x, unsigned& nloc, unsigned& nx) {
    const unsigned G = gridDim.x * gridDim.y * gridDim.z;
    unsigned sum, cnt, mine, sp = 0u;
    for (;;) {
        sum = 0u; cnt = 0u; mine = 0u;
#pragma unroll
        for (unsigned j = 0; j < 16; ++j) { const unsigned c = xb_ld(&bar[XB_XCNT(j)]); sum += c; cnt += (c > 0u) ? 1u : 0u; mine = (j == x) ? c : mine; }
        if (sum == G) break;
        __builtin_amdgcn_s_sleep(1);
        if ((++sp & 255u) == 0u) { if (xb_ld(&bar[XB_TMO])) break; if (sp > XB_SPIN_CAP) { atomicAdd(&bar[XB_TMO], 1u); break; } }
    }
    nloc = mine > 0u ? mine : 1u; nx = cnt > 0u ? cnt : 1u;
}
__device__ __forceinline__ void xcd_barrier(const XcdBarrier& b) {
    asm volatile("s_waitcnt vmcnt(0)" ::: "memory");
    __syncthreads();
    if (threadIdx.x == 0) {
        unsigned* bar = b.bar;
        __builtin_amdgcn_s_waitcnt(0);
        unsigned nloc = b.st[0], nx = b.st[1];
        if (nloc == 0u) { xcd_barrier_complete(bar, b.x, nloc, nx); b.st[0] = nloc; b.st[1] = nx; }
        const unsigned old = xb_add(&bar[XB_XSUB(b.x)], 1u);
        const unsigned gen = old / nloc;
        if (old + 1u == (gen + 1u) * nloc) {
            __builtin_amdgcn_fence(__ATOMIC_RELEASE, "agent");
            asm volatile("s_waitcnt vmcnt(0)" ::: "memory");
            const unsigned og = xb_add(&bar[XB_TOP], 1u);
            const unsigned tg = og / nx;
            if (og + 1u == (tg + 1u) * nx) xb_add(&bar[XB_TOPGEN], 1u);
            else XB_SPIN(xb_ld(&bar[XB_TOPGEN]) == tg, bar);
            __builtin_amdgcn_fence(__ATOMIC_ACQUIRE, "agent");
            xb_add(&bar[XB_XGEN(b.x)], 1u);
            asm volatile("s_waitcnt vmcnt(0)" ::: "memory");
        } else {
            XB_SPIN(xb_ld(&bar[XB_XGEN(b.x)]) == gen, bar);
            __builtin_amdgcn_fence(__ATOMIC_ACQUIRE, "agent");
            asm volatile("s_waitcnt vmcnt(0)" ::: "memory");
        }
    }
    __syncthreads();
}

#ifndef WGM_SET
#define WGM_SET 8
#endif
namespace pg8 {
constexpr int BM = 256, BK = 64, HALF = 128, HTB = HALF * BK * 2, STAGE_BYTES = 8 * HTB, NXCD = 8, WGM = WGM_SET;
__host__ __device__ __forceinline__ int lds_byte(int r, int c) { const int st = (r >> 4) * 2 + (c >> 5), rr = r & 15, cc = c & 31, ob = rr * 64 + cc * 2; return st * 1024 + (ob ^ (((ob >> 9) & 1) << 5)); }
__host__ __device__ __forceinline__ void stage_rc(int b, int& R, int& C) { const int st = b / 1024, sb = b % 1024, swz = sb ^ (((sb >> 9) & 1) << 5); R = (st >> 1) * 16 + swz / 64; C = (st & 1) * 32 + (swz % 64) / 2; }
__host__ __device__ __forceinline__ int perm32(int rho) { const int n = rho >> 4, i = rho & 15; return 8 * (i >> 2) + 4 * n + (i & 3); }

struct Unit { int pm, pn, aux; };

__device__ __forceinline__ void grouped(int wgid, int nM, int nN, int& pm, int& pn) {
    const int nig = WGM * nN, gid = wgid / nig, fm = gid * WGM, gsz = (nM - fm) < WGM ? (nM - fm) : WGM;
    pm = fm + ((wgid % nig) % gsz); pn = (wgid % nig) / gsz;
}
__device__ __forceinline__ bool xcd_remap(int i, int G, int c, int nwg, int& wgid) {
    const long L = (long)i * G + c; if (L >= nwg) return false;
    wgid = (int)L; const int q = nwg / NXCD, r = nwg % NXCD, xcd = wgid % NXCD, off = wgid / NXCD;
    wgid = (xcd < r ? xcd * (q + 1) : r * (q + 1) + (xcd - r) * q) + off; return true;
}

typedef int i32x8 __attribute__((ext_vector_type(8)));
typedef int i32x4 __attribute__((ext_vector_type(4)));
template <bool F8> struct Frags;
template <> struct Frags<false> { bf16x8 a[4][2], b0[2][2], b1[2][2]; };
template <> struct Frags<true> { i32x8 a[4], b0[2], b1[2]; };
template <class Prob, class Epi, bool ALIGN_EPI, bool HOOK, bool FP8 = false, int DRY = 0>
__device__ __forceinline__ void gemm_phase(LAS unsigned char* lds, const Prob& P, const Epi& E) {
    int tid_ = threadIdx.x; asm volatile("" : "+v"(tid_));
    const int tid = tid_, wid = __builtin_amdgcn_readfirstlane(tid >> 6), lane = tid & 63, wr = wid >> 2, wc = wid & 3, fr = lane & 15, fq = lane >> 4;
    const int nt = P.nt;
    unsigned voffB[2], voffA[2];
#pragma unroll
    for (int i = 0; i < 2; ++i) { int R, C; stage_rc(tid * 16 + i * 8192, R, C); const int Rb = Epi::PERM ? ((R & ~31) + perm32(R & 31)) : R;
        voffB[i] = (unsigned)Rb * P.ldb2 + (unsigned)C * 2u; voffA[i] = (unsigned)R * P.lda2 + (unsigned)C * 2u; }
    auto gather_offs = [&](const Unit& u, unsigned (&o0)[2], unsigned (&o1)[2]) {
#pragma unroll
        for (int i = 0; i < 2; ++i) { int R, C; int tt = threadIdx.x; asm volatile("" : "+v"(tt)); stage_rc(tt * 16 + i * 8192, R, C); o0[i] = P.a_row(u, R) + (unsigned)C * 2u; o1[i] = P.a_row(u, HALF + R) + (unsigned)C * 2u; } };
    const size_t kstep = (size_t)(BK * 2);
    const size_t hstepB = (size_t)HALF * P.ldb2;
    const size_t hstepA = (size_t)HALF * P.lda2;
    const unsigned ldsw = (unsigned)wid * 1024u;
    const int aoff = lds_byte(wr * 64 + fr, fq * 8), boff = lds_byte(wc * 32 + fr, fq * 8);
#define PG8_SA(b, h) (((b) * 2 + (h)) * HTB)
#define PG8_SB(b, h) ((4 + (b) * 2 + (h)) * HTB)
#define PG8_STAGE(bufoff, gbase, voff) do { if constexpr ((DRY & 2) == 0) _Pragma("unroll") for (int _i = 0; _i < 2; ++_i) \
        __builtin_amdgcn_global_load_lds((const unsigned*)((const char*)(gbase) + (voff)[_i]), (LAS unsigned*)(lds + (bufoff) + ldsw + _i * 8192), 16, 0, 0); } while (0)
#define PG8_LDA(dst, b, h) do { if constexpr (FP8) { _Pragma("unroll") for (int m = 0; m < 4; ++m) { FR.a[m].lo = *(const LAS i32x4*)(lds + PG8_SA(b, h) + aoff + m * 2048); FR.a[m].hi = *(const LAS i32x4*)(lds + PG8_SA(b, h) + aoff + m * 2048 + 1024); } } \
        else { _Pragma("unroll") for (int m = 0; m < 4; ++m) _Pragma("unroll") for (int k = 0; k < 2; ++k) FR.a[m][k] = *(const LAS bf16x8*)(lds + PG8_SA(b, h) + aoff + m * 2048 + k * 1024); } } while (0)
#define PG8_LDB(dst, b, h) do { if constexpr (FP8) { _Pragma("unroll") for (int n = 0; n < 2; ++n) { FR.dst[n].lo = *(const LAS i32x4*)(lds + PG8_SB(b, h) + boff + n * 2048); FR.dst[n].hi = *(const LAS i32x4*)(lds + PG8_SB(b, h) + boff + n * 2048 + 1024); } } \
        else { _Pragma("unroll") for (int n = 0; n < 2; ++n) _Pragma("unroll") for (int k = 0; k < 2; ++k) FR.dst[n][k] = *(const LAS bf16x8*)(lds + PG8_SB(b, h) + boff + n * 2048 + k * 1024); } } while (0)
#define PG8_MMA(ai, bj, At, Bt) do { __builtin_amdgcn_s_setprio(1); if constexpr ((DRY & 1) != 0) { asm volatile("" :: "v"(FR.a[0]), "v"(FR.a[3]), "v"(FR.Bt[0]), "v"(FR.Bt[1])); } else if constexpr (FP8) { _Pragma("unroll") for (int m = 0; m < 4; ++m) _Pragma("unroll") for (int n = 0; n < 2; ++n) \
            asm volatile("v_mfma_f32_16x16x128_f8f6f4 %0, %1, %2, %0" : "+v"(acc[ai][bj][m][n]) : "v"(FR.Bt[n]), "v"(FR.a[m])); } \
        else { _Pragma("unroll") for (int m = 0; m < 4; ++m) _Pragma("unroll") for (int n = 0; n < 2; ++n) _Pragma("unroll") for (int k = 0; k < 2; ++k) \
        acc[ai][bj][m][n] = __builtin_amdgcn_mfma_f32_16x16x32_bf16(FR.Bt[n][k], FR.a[m][k], acc[ai][bj][m][n], 0, 0, 0); } __builtin_amdgcn_s_setprio(0); } while (0)
#define PG8_WAIT_V(n) asm volatile("s_waitcnt vmcnt(" #n ")" ::: "memory")
#define PG8_WAIT_L(n) asm volatile("s_waitcnt lgkmcnt(" #n ")" ::: "memory")
#define PG8_BAR __builtin_amdgcn_s_barrier()
#define PG8_SCHED __builtin_amdgcn_sched_barrier(0)
    Unit cur, nxt; int ui = 0;
    if (!P.unit(0, cur)) return;
    f32x4 acc[2][2][4][2];
#pragma unroll
    for (int a = 0; a < 2; ++a)
#pragma unroll
        for (int b = 0; b < 2; ++b)
#pragma unroll
            for (int m = 0; m < 4; ++m)
#pragma unroll
                for (int n = 0; n < 2; ++n) acc[a][b][m][n] = (f32x4){0.f, 0.f, 0.f, 0.f};
    Frags<FP8> FR;
    unsigned va0[2], va1[2], vn0[2], vn1[2];
    const char* const gA = P.Abase; const char* cA = gA; const char* nA = gA; const char* cB = P.b_tile(cur);
    if constexpr (Prob::GATHER) {
        gather_offs(cur, va0, va1);
    } else { cA = gA + P.a_row(cur, 0); }
#define PG8_STAGE_A(bufoff, h, koff, nx) do { if constexpr (Prob::GATHER) { unsigned _v[2]; _Pragma("unroll") for (int _i = 0; _i < 2; ++_i) _v[_i] = (nx) ? ((h) ? vn1[_i] : vn0[_i]) : ((h) ? va1[_i] : va0[_i]); PG8_STAGE(bufoff, gA + (koff), _v); } \
        else { PG8_STAGE(bufoff, ((nx) ? nA : cA) + (h) * hstepA + (koff), voffA); } } while (0)
    PG8_STAGE(PG8_SB(0, 0), cB, voffB); PG8_STAGE(PG8_SB(0, 1), cB + hstepB, voffB); PG8_STAGE_A(PG8_SA(0, 0), 0, 0, false); PG8_STAGE_A(PG8_SA(0, 1), 1, 0, false);
    if (wr == 1) PG8_BAR;
    PG8_WAIT_V(2); PG8_BAR;
    PG8_STAGE(PG8_SB(1, 0), cB + kstep, voffB); PG8_STAGE_A(PG8_SA(1, 0), 0, kstep, false); PG8_STAGE(PG8_SB(1, 1), cB + hstepB + kstep, voffB);
    PG8_WAIT_V(6); PG8_BAR;
    Unit nx2; unsigned vq0[2], vq1[2]; bool has_next = P.unit(1, nxt);
    if (!has_next) nxt = cur;
    if constexpr (Prob::GATHER) gather_offs(nxt, vn0, vn1);
    for (;;) {
        if constexpr (!Prob::GATHER) { has_next = P.unit(ui + 1, nxt); if (!has_next) nxt = cur; nA = gA + P.a_row(nxt, 0); }
        const char* nB = P.b_tile(nxt);
        for (int t = 0; t < nt; t += 2) {
            const bool last = (t == nt - 2);
            if constexpr (HOOK) { if (t == (nt >> 1)) { if constexpr (FP8) asm volatile("s_nop 15\n\ts_nop 15" ::: "memory"); E.mid(acc, cur, wr, wc, fr, fq); } }
            const size_t k1 = (size_t)(t + 1) * kstep, k2 = last ? 0 : (size_t)(t + 2) * kstep, k3 = k2 + kstep;
            const char* b2 = last ? nB : cB + (size_t)(t + 2) * kstep; const char* b3 = b2 + kstep;
            PG8_LDB(b0, 0, 0); PG8_LDB(b1, 0, 1); PG8_SCHED; PG8_LDA(At, 0, 0); PG8_STAGE_A(PG8_SA(1, 1), 1, k1, false);
            PG8_WAIT_V(8); PG8_WAIT_L(0); PG8_BAR; PG8_MMA(0, 0, At, b0); PG8_MMA(0, 1, At, b1); PG8_BAR; PG8_SCHED;
            PG8_LDA(At, 0, 1); PG8_STAGE(PG8_SB(0, 0), b2, voffB); PG8_STAGE(PG8_SB(0, 1), b2 + hstepB, voffB); PG8_STAGE_A(PG8_SA(0, 0), 0, k2, last);
            PG8_WAIT_V(8); PG8_WAIT_L(0); PG8_BAR; PG8_MMA(1, 0, At, b0); PG8_MMA(1, 1, At, b1); PG8_BAR; PG8_SCHED;
            PG8_LDB(b0, 1, 0); PG8_LDB(b1, 1, 1); PG8_SCHED; PG8_LDA(At, 1, 0); PG8_STAGE_A(PG8_SA(0, 1), 1, k2, last);
            PG8_WAIT_V(8); PG8_WAIT_L(0); PG8_BAR; PG8_MMA(0, 0, At, b0); PG8_MMA(0, 1, At, b1); PG8_BAR; PG8_SCHED;
            PG8_LDA(At, 1, 1); PG8_STAGE(PG8_SB(1, 0), b3, voffB); PG8_STAGE(PG8_SB(1, 1), b3 + hstepB, voffB); PG8_STAGE_A(PG8_SA(1, 0), 0, k3, last);
            PG8_WAIT_V(8); PG8_WAIT_L(0); PG8_BAR; PG8_MMA(1, 0, At, b0); PG8_MMA(1, 1, At, b1); PG8_BAR; PG8_SCHED;
        }
        if constexpr (ALIGN_EPI) { if (wr == 0) PG8_BAR; }
        bool has_next2 = false;
        if constexpr (Prob::GATHER) { has_next2 = has_next && P.unit(ui + 2, nx2); if (!has_next2) nx2 = nxt; gather_offs(nx2, vq0, vq1); }
        if constexpr (FP8) asm volatile("s_nop 15\n\ts_nop 15" ::: "memory");
        if constexpr (DRY == 0) E(acc, cur, wr, wc, fr, fq); else { if (acc[0][0][0][0][0] == 1.2345e30f) *(volatile int*)P.Abase = 1; }
        if (!has_next) break;
#pragma unroll
        for (int a = 0; a < 2; ++a)
#pragma unroll
            for (int b = 0; b < 2; ++b)
#pragma unroll
                for (int m = 0; m < 4; ++m)
#pragma unroll
                    for (int n = 0; n < 2; ++n) acc[a][b][m][n] = (f32x4){0.f, 0.f, 0.f, 0.f};
        cur = nxt; cB = nB; cA = nA; ++ui;
        if constexpr (Prob::GATHER) {
#pragma unroll
            for (int i = 0; i < 2; ++i) { va0[i] = vn0[i]; va1[i] = vn1[i]; vn0[i] = vq0[i]; vn1[i] = vq1[i]; }
            nxt = nx2; has_next = has_next2; }
        if constexpr (ALIGN_EPI) { if (wr == 1) PG8_BAR; }
    }
    PG8_WAIT_V(0);
    if constexpr (!ALIGN_EPI) { if (wr == 0) PG8_BAR; }
    PG8_BAR;
#undef PG8_SA
#undef PG8_SB
#undef PG8_STAGE
#undef PG8_STAGE_A
#undef PG8_LDA
#undef PG8_LDB
#undef PG8_MMA
#undef PG8_WAIT_V
#undef PG8_WAIT_L
#undef PG8_BAR
#undef PG8_SCHED
}
}

using pg8::Unit;

struct ProbDense {
    static constexpr bool GATHER = false;
    const char* Abase; int nt; unsigned ldb2; unsigned lda2; const char* Bt; int nM, nN, G, c; int rev;
    __device__ __forceinline__ bool unit(int i, Unit& u) const { int w; if (!pg8::xcd_remap(i, G, c, nM * nN, w)) return false; pg8::grouped(w, nM, nN, u.pm, u.pn); if (rev) u.pm = nM - 1 - u.pm; u.aux = 0; return true; }
    __device__ __forceinline__ unsigned a_row(const Unit& u, int r) const { return (unsigned)(u.pm * 256 + r) * lda2; }
    __device__ __forceinline__ const char* b_tile(const Unit& u) const { return Bt + (size_t)u.pn * 256 * ldb2; }
};
struct ProbP1 {
    static constexpr bool GATHER = false;
    const char* Abase; int nt; unsigned ldb2; unsigned lda2; const char* Bt; unsigned uc_off; int G, c;
    __device__ __forceinline__ bool unit(int i, Unit& u) const {
        int w; if (!pg8::xcd_remap(i, G, c, 3072 + 256, w)) return false;
        if (w < 3072) { pg8::grouped(w, 256, 12, u.pm, u.pn); u.pm = 255 - u.pm; u.aux = 0; }
        else { pg8::grouped(w - 3072, 32, 8, u.pm, u.pn); u.pn += 4; u.aux = 1; }
        return true; }
    __device__ __forceinline__ unsigned a_row(const Unit& u, int r) const { return (u.aux ? uc_off : 0u) + (unsigned)(u.pm * 256 + r) * lda2; }
    __device__ __forceinline__ const char* b_tile(const Unit& u) const { return Bt + (size_t)u.pn * 256 * ldb2; }
};
template <bool GATHER_> struct ProbMoE {
    static constexpr bool GATHER = GATHER_;
    const char* Abase; int nt; unsigned ldb2; unsigned lda2; const char* Bt; size_t estride; int nN, nblk, G, c; const int* rowtok; const LAS unsigned char* blk_e;
    __device__ __forceinline__ bool unit(int i, Unit& u) const { int w; if (!pg8::xcd_remap(i, G, c, nblk * nN, w)) return false; pg8::grouped(w, nblk, nN, u.pm, u.pn); if (!GATHER) u.pm = nblk - 1 - u.pm;
        u.aux = (int)blk_e[u.pm]; return true; }
    __device__ __forceinline__ unsigned a_row(const Unit& u, int r) const { if (GATHER) return (unsigned)rowtok[u.pm * 256 + r] * lda2; else return (unsigned)(u.pm * 256 + r) * lda2; }
    __device__ __forceinline__ const char* b_tile(const Unit& u) const { return Bt + (size_t)u.aux * estride + (size_t)u.pn * 256 * ldb2; }
};

struct EpiP1 {
    static constexpr bool PERM = true;
    bf16_t* PA; bf16_t* PH; bf16_t* PHC;
    __device__ __forceinline__ void operator()(const f32x4 (&acc)[2][2][4][2], const Unit& u, int wr, int wc, int fr, int fq) const {
        const int row0 = u.pm * 256 + wr * 64 + fr;
        if (!u.aux && u.pn < 4) {
            const int col0 = u.pn * 256 + wc * 32 + 8 * fq;
#pragma unroll
            for (int ai = 0; ai < 2; ++ai)
#pragma unroll
                for (int m = 0; m < 4; ++m) { const int row = row0 + ai * 128 + m * 16, b = row >> 11, t = row & 2047;
#pragma unroll
                    for (int bj = 0; bj < 2; ++bj) { const int col = col0 + bj * 128, reim = col >> 9, c5 = col & 511, slab = c5 >> 4, half = (c5 >> 3) & 1;
                        const f32x4 v0 = acc[ai][bj][m][0] * W8_INV, v1 = acc[ai][bj][m][1] * W8_INV;
                        u32x4 w; w.x = cvt_pk_bf16(v0[0], v0[1]); w.y = cvt_pk_bf16(v0[2], v0[3]); w.z = cvt_pk_bf16(v1[0], v1[1]); w.w = cvt_pk_bf16(v1[2], v1[3]);
                        *(u32x4*)(PA + ((((size_t)(b * 32 + slab) * 2048 + t) * 2 + reim) * 16 + half * 8)) = w; } }
            return;
        }
        bf16_t* base = u.aux ? PHC : PH; const int ldc = 2048, colt = (u.pn - 4) * 256;
        const int col0 = colt + wc * 32 + 8 * fq;
#pragma unroll
        for (int ai = 0; ai < 2; ++ai)
#pragma unroll
            for (int m = 0; m < 4; ++m) { bf16_t* rowp = base + (size_t)(row0 + ai * 128 + m * 16) * ldc + col0;
#pragma unroll
                for (int bj = 0; bj < 2; ++bj) { const f32x4 v0 = acc[ai][bj][m][0] * W8_INV, v1 = acc[ai][bj][m][1] * W8_INV;
                    u32x4 w; w.x = cvt_pk_bf16(v0[0], v0[1]); w.y = cvt_pk_bf16(v0[2], v0[3]); w.z = cvt_pk_bf16(v1[0], v1[1]); w.w = cvt_pk_bf16(v1[2], v1[3]);
                    *(u32x4*)(rowp + bj * 128) = w; } }
    }
    __device__ __forceinline__ void mid(f32x4 (&)[2][2][4][2], const Unit&, int, int, int, int) const {}
};
struct EpiP2 {
    static constexpr bool PERM = true;
    bf16_t* PG; unsigned char* GATES;
    __device__ __forceinline__ void operator()(const f32x4 (&acc)[2][2][4][2], const Unit& u, int wr, int wc, int fr, int fq) const {
        const int row0 = u.pm * 256 + wr * 64 + fr;
        if (u.pn < 2) {
            const int col0 = u.pn * 256 + wc * 32 + 8 * fq;
#pragma unroll
            for (int ai = 0; ai < 2; ++ai)
#pragma unroll
                for (int m = 0; m < 4; ++m) { bf16_t* rowp = PG + (size_t)(row0 + ai * 128 + m * 16) * 512 + col0;
#pragma unroll
                    for (int bj = 0; bj < 2; ++bj) { f32x4 v0 = acc[ai][bj][m][0] * W8_INV, v1 = acc[ai][bj][m][1] * W8_INV;
#pragma unroll
                        for (int j = 0; j < 4; ++j) { v0[j] *= fast_sigmoid(v0[j]); v1[j] *= fast_sigmoid(v1[j]); }
                        u32x4 w; w.x = cvt_pk_bf16(v0[0], v0[1]); w.y = cvt_pk_bf16(v0[2], v0[3]); w.z = cvt_pk_bf16(v1[0], v1[1]); w.w = cvt_pk_bf16(v1[2], v1[3]);
                        *(u32x4*)(rowp + bj * 128) = w; } }
            return;
        }
        const int colt = (u.pn - 2) * 256 + wc * 32 + (fq >> 1) * 16;
#pragma unroll
        for (int ai = 0; ai < 2; ++ai)
#pragma unroll
            for (int bj = 0; bj < 2; ++bj) { u32x2 pk[4];
#pragma unroll
                for (int m = 0; m < 4; ++m) { f32x4 v0 = acc[ai][bj][m][0] * W8_INV, v1 = acc[ai][bj][m][1] * W8_INV;
#pragma unroll
                    for (int j = 0; j < 4; ++j) { v0[j] = fmaxf(fast_sigmoid(v0[j]) * 255.0f, 1.0f); v1[j] = fmaxf(fast_sigmoid(v1[j]) * 255.0f, 1.0f); }
                    pk[m] = (u32x2){pack4_u8(v0[0], v0[1], v0[2], v0[3]), pack4_u8(v1[0], v1[1], v1[2], v1[3])}; }
#pragma unroll
                for (int mp = 0; mp < 2; ++mp)
                    *(u32x4*)(GATES + (size_t)(row0 + ai * 128 + (2 * mp + (fq & 1)) * 16) * 2048 + colt + bj * 128) = widen16(pk[2 * mp], pk[2 * mp + 1]); }
    }
    __device__ __forceinline__ void mid(f32x4 (&)[2][2][4][2], const Unit&, int, int, int, int) const {}
};
struct EpiM1 {
    static constexpr bool PERM = true;
    const unsigned char* GATES; unsigned char* Mo;
    __device__ __forceinline__ void mid(f32x4 (&acc)[2][2][4][2], const Unit& u, int wr, int wc, int fr, int fq) const {
        int row0 = u.pm * 256 + wr * 64 + fr + (fq & 1) * 16, col0 = u.pn * 256 + wc * 32 + (fq >> 1) * 16;
        asm volatile("" : "+v"(row0), "+v"(col0));
#pragma unroll
        for (int ai = 0; ai < 2; ++ai) {
            u32x4 gf[2][2], gh[2][2];
#pragma unroll
            for (int mp = 0; mp < 2; ++mp) { const unsigned char* gp = GATES + (size_t)(row0 + ai * 128 + mp * 32) * 2048 + col0;
#pragma unroll
                for (int bj = 0; bj < 2; ++bj) { gf[mp][bj] = *(const u32x4*)(gp + bj * 128); gh[mp][bj] = *(const u32x4*)(gp + 1024 + bj * 128); } }
#pragma unroll
            for (int mp = 0; mp < 2; ++mp)
#pragma unroll
                for (int bj = 0; bj < 2; ++bj) { u32x2 f2[2], h2[2]; unwiden16(gf[mp][bj], f2[0], f2[1]); unwiden16(gh[mp][bj], h2[0], h2[1]);
#pragma unroll
                    for (int q = 0; q < 2; ++q) { const int m = 2 * mp + q;
                        const f32x4 fa = u8x4_to_f32(f2[q].x), fb = u8x4_to_f32(f2[q].y), ha = u8x4_to_f32(h2[q].x), hb = u8x4_to_f32(h2[q].y);
#pragma unroll
                        for (int j = 0; j < 4; ++j) { acc[ai][bj][m][0][j] *= fa[j] * __builtin_amdgcn_rcpf(ha[j]); acc[ai][bj][m][1][j] *= fb[j] * __builtin_amdgcn_rcpf(hb[j]); } } }
            asm volatile("" ::: "memory");
        }
    }
    __device__ __forceinline__ void operator()(const f32x4 (&acc)[2][2][4][2], const Unit& u, int wr, int wc, int fr, int fq) const {
        const int row0 = u.pm * 256 + wr * 64 + fr, col0 = u.pn * 256 + wc * 32 + (fq >> 1) * 16;
        const float sc = W8_INV * (1.0f / 255.0f);
#pragma unroll
        for (int ai = 0; ai < 2; ++ai) {
            u32x4 gh[2][2];
#pragma unroll
            for (int mp = 0; mp < 2; ++mp) { const unsigned char* gp = GATES + (size_t)(row0 + ai * 128 + (2 * mp + (fq & 1)) * 16) * 2048 + 1024 + col0;
#pragma unroll
                for (int bj = 0; bj < 2; ++bj) gh[mp][bj] = *(const u32x4*)(gp + bj * 128); }
#pragma unroll
            for (int bj = 0; bj < 2; ++bj) { u32x2 pk[4];
#pragma unroll
                for (int mp = 0; mp < 2; ++mp) { u32x2 h2[2]; unwiden16(gh[mp][bj], h2[0], h2[1]);
#pragma unroll
                    for (int q = 0; q < 2; ++q) { const int m = 2 * mp + q; const f32x4 ha = u8x4_to_f32(h2[q].x) * sc, hb = u8x4_to_f32(h2[q].y) * sc;
                        const f32x4 v0 = acc[ai][bj][m][0] * ha, v1 = acc[ai][bj][m][1] * hb;
                        pk[m] = (u32x2){cvt_pk4_fp8(v0[0], v0[1], v0[2], v0[3]), cvt_pk4_fp8(v1[0], v1[1], v1[2], v1[3])}; } }
#pragma unroll
                for (int mp = 0; mp < 2; ++mp)
                    *(u32x4*)(Mo + (size_t)(row0 + ai * 128 + (2 * mp + (fq & 1)) * 16) * 1024 + col0 + bj * 128) = widen16(pk[2 * mp], pk[2 * mp + 1]); }
            asm volatile("" ::: "memory");
        }
    }
};
struct EpiM2 {
    static constexpr bool PERM = true;
    const float* ada; bf16_t* V;
    __device__ __forceinline__ void operator()(const f32x4 (&acc)[2][2][4][2], const Unit& u, int wr, int wc, int fr, int fq) const {
        const int row0 = u.pm * 256 + wr * 64 + fr, col0 = u.pn * 256 + wc * 32 + 8 * fq;
        const float* g1 = ada + (size_t)(u.pm >> 3) * 6144 + 2048 + col0;
        f32x4 gv[2][2];
#pragma unroll
        for (int bj = 0; bj < 2; ++bj)
#pragma unroll
            for (int n = 0; n < 2; ++n) gv[bj][n] = *(const f32x4*)(g1 + bj * 128 + n * 4) * W8_INV;
#pragma unroll
        for (int ai = 0; ai < 2; ++ai)
#pragma unroll
            for (int m = 0; m < 4; ++m) { bf16_t* rowp = V + (size_t)(row0 + ai * 128 + m * 16) * 1024 + col0;
#pragma unroll
                for (int bj = 0; bj < 2; ++bj) { const f32x4 v0 = gv[bj][0] * acc[ai][bj][m][0], v1 = gv[bj][1] * acc[ai][bj][m][1];
                    u32x4 w; w.x = cvt_pk_bf16(v0[0], v0[1]); w.y = cvt_pk_bf16(v0[2], v0[3]); w.z = cvt_pk_bf16(v1[0], v1[1]); w.w = cvt_pk_bf16(v1[2], v1[3]);
                    *(u32x4*)(rowp + bj * 128) = w; } }
    }
    __device__ __forceinline__ void mid(f32x4 (&)[2][2][4][2], const Unit&, int, int, int, int) const {}
};
struct EpiGU {
    static constexpr bool PERM = true;
    const float* bgu; unsigned char* ACT;
    __device__ __forceinline__ void operator()(const f32x4 (&acc)[2][2][4][2], const Unit& u, int wr, int wc, int fr, int fq) const {
        const int row0 = u.pm * 256 + wr * 64 + fr, col0 = u.pn * 128 + wc * 32 + 8 * fq;
        const float* bp = bgu + (size_t)u.aux * 2048 + col0;
        const f32x4 bg0 = *(const f32x4*)(bp), bg1 = *(const f32x4*)(bp + 4), bu0 = *(const f32x4*)(bp + 1024), bu1 = *(const f32x4*)(bp + 1028);
#pragma unroll
        for (int ai = 0; ai < 2; ++ai) { u32x2 pk[4];
#pragma unroll
            for (int m = 0; m < 4; ++m) {
                f32x4 g0 = acc[ai][0][m][0] * W8_INV + bg0, g1 = acc[ai][0][m][1] * W8_INV + bg1, p0 = acc[ai][1][m][0] * W8_INV + bu0, p1 = acc[ai][1][m][1] * W8_INV + bu1;
#pragma unroll
                for (int j = 0; j < 4; ++j) {
                    float g = fminf(g0[j], 7.0f), p = fminf(fmaxf(p0[j], -7.0f), 7.0f); g0[j] = (p + 1.0f) * g * fast_sigmoid(1.702f * g);
                    g = fminf(g1[j], 7.0f); p = fminf(fmaxf(p1[j], -7.0f), 7.0f); g1[j] = (p + 1.0f) * g * fast_sigmoid(1.702f * g); }
                pk[m] = (u32x2){cvt_pk4_fp8(g0[0], g0[1], g0[2], g0[3]), cvt_pk4_fp8(g1[0], g1[1], g1[2], g1[3])}; }
#pragma unroll
            for (int mp = 0; mp < 2; ++mp)
                *(u32x4*)(ACT + (size_t)(row0 + ai * 128 + (2 * mp + (fq & 1)) * 16) * 1024 + u.pn * 128 + wc * 32 + (fq >> 1) * 16) = widen16(pk[2 * mp], pk[2 * mp + 1]); }
    }
    __device__ __forceinline__ void mid(f32x4 (&)[2][2][4][2], const Unit&, int, int, int, int) const {}
};
struct EpiDN {
    static constexpr bool PERM = true;
    const float* bdn; unsigned char* Y;
    __device__ __forceinline__ void operator()(const f32x4 (&acc)[2][2][4][2], const Unit& u, int wr, int wc, int fr, int fq) const {
        const int row0 = u.pm * 256 + wr * 64 + fr, col0 = u.pn * 256 + wc * 32 + 8 * fq;
        const float* bp = bdn + (size_t)u.aux * 1024 + col0;
        f32x4 bv[2][2];
#pragma unroll
        for (int bj = 0; bj < 2; ++bj)
#pragma unroll
            for (int n = 0; n < 2; ++n) bv[bj][n] = *(const f32x4*)(bp + bj * 128 + 4 * n);
#pragma unroll
        for (int ai = 0; ai < 2; ++ai)
#pragma unroll
            for (int bj = 0; bj < 2; ++bj) { u32x2 pk[4];
#pragma unroll
                for (int m = 0; m < 4; ++m) { const f32x4 v0 = acc[ai][bj][m][0] * W8_INV + bv[bj][0], v1 = acc[ai][bj][m][1] * W8_INV + bv[bj][1];
                    pk[m] = (u32x2){cvt_pk4_fp8(v0[0], v0[1], v0[2], v0[3]), cvt_pk4_fp8(v1[0], v1[1], v1[2], v1[3])}; }
#pragma unroll
                for (int mp = 0; mp < 2; ++mp)
                    *(u32x4*)(Y + (size_t)(row0 + ai * 128 + (2 * mp + (fq & 1)) * 16) * 1024 + u.pn * 256 + bj * 128 + wc * 32 + (fq >> 1) * 16) = widen16(pk[2 * mp], pk[2 * mp + 1]); }
    }
    __device__ __forceinline__ void mid(f32x4 (&)[2][2][4][2], const Unit&, int, int, int, int) const {}
};

struct Frame {
    LAS unsigned char* lds; int tid, lane, wave, G, c;
    const float* const* in; float* out; unsigned char* ws; unsigned* ctl;
};
enum { I_X = 0, I_C, I_CTX, I_CCTX, I_WADA, I_BADA, I_WIN, I_LBRAW, I_HGG, I_WFO, I_WHO, I_WO, I_LN1G, I_LN1B, I_WR, I_BR, I_WGU, I_BGU, I_WDN, I_BDN, I_LN2G, I_LN2B };

__device__ __forceinline__ float wave_sum(float v) {
#pragma unroll
    for (int o = 32; o >= 1; o >>= 1) v += __shfl_xor(v, o);
    return v;
}

__device__ __forceinline__ Frame fresh(const Frame& F) { Frame G = F; int t = threadIdx.x; asm volatile("" : "+v"(t)); G.tid = t; G.lane = t & 63; G.wave = __builtin_amdgcn_readfirstlane(t >> 6); return G; }

__device__ __forceinline__ void p0_ada(const Frame& F) {
    LAS float* cact = (LAS float*)F.lds;
    float* ada = (float*)(F.ws + WS_ADA);
    for (int cb = F.c; cb < 192; cb += F.G) {
        const int kg = F.tid >> 5, col = F.tid & 31, gcol = cb * 32 + col;
        float w[16][4];
#pragma unroll
        for (int i = 0; i < 16; ++i)
#pragma unroll
            for (int j = 0; j < 4; ++j) w[i][j] = F.in[I_WADA][(size_t)(4 * kg + 64 * i + j) * 6144 + gcol];
        f32x4 cv[17];
#pragma unroll
        for (int it = 0; it < 17; ++it) { const int q = F.tid + it * NTHR, bq = q >> 8, k4 = (q & 255) * 4; cv[it] = (f32x4){0.f, 0.f, 0.f, 0.f};
            if (q < 33 * 256) cv[it] = *(const f32x4*)(bq < 32 ? F.in[I_C] + bq * 1024 + k4 : F.in[I_CCTX] + k4); }
#pragma unroll
        for (int it = 0; it < 17; ++it) { const int q = F.tid + it * NTHR; f32x4 v = cv[it];
#pragma unroll
            for (int j = 0; j < 4; ++j) v[j] = v[j] * fast_sigmoid(v[j]);
            if (q < 33 * 256) *(LAS f32x4*)(cact + q * 4) = v; }
        __syncthreads();
        float acc[33];
#pragma unroll
        for (int bb = 0; bb < 33; ++bb) acc[bb] = 0.f;
#pragma unroll
        for (int i = 0; i < 16; ++i)
#pragma unroll
            for (int bb = 0; bb < 33; ++bb) { const f32x4 c4 = *(const LAS f32x4*)(cact + bb * 1024 + 4 * kg + 64 * i);
                acc[bb] += (c4[0] * w[i][0] + c4[1] * w[i][1]) + (c4[2] * w[i][2] + c4[3] * w[i][3]); }
        __syncthreads();
        LAS float* red = cact;
#pragma unroll
        for (int bb = 0; bb < 33; ++bb) red[(kg * 33 + bb) * 32 + col] = acc[bb];
        __syncthreads();
        for (int o = F.tid; o < 33 * 32; o += NTHR) { const int bb = o >> 5, cc = o & 31; float sum = 0.f;
#pragma unroll
            for (int g = 0; g < 16; ++g) sum += red[(g * 33 + bb) * 32 + cc];
            ada[(size_t)bb * 6144 + cb * 32 + cc] = sum + F.in[I_BADA][cb * 32 + cc]; }
        __syncthreads();
    }
}
__device__ __forceinline__ void p0_fold(const Frame& F) {
    LAS float* xr = (LAS float*)F.lds;
    LAS float* cs = xr + 2048;
    unsigned char* W1 = (unsigned char*)(F.ws + WS_WIN1T);
    if (F.tid < 128) { const float a = (float)F.tid * (1.0f / 128.0f); cs[F.tid] = __builtin_amdgcn_cosf(a); cs[128 + F.tid] = __builtin_amdgcn_sinf(a); }
    for (int kb = F.c; kb < 256; kb += F.G) {
        __syncthreads();
        for (int i = F.tid; i < 2048; i += NTHR) xr[i] = F.in[I_WIN][(size_t)(4 * kb + (i >> 9)) * 5120 + (i & 511)];
        __syncthreads();
        const int g = F.tid >> 7, j = F.tid & 127;
        float ac[4] = {0.f, 0.f, 0.f, 0.f}, as[4] = {0.f, 0.f, 0.f, 0.f};
        for (int d = 0; d < 128; ++d) { const int idx = (d * j) & 127; const float cv = cs[idx], sv = cs[128 + idx];
#pragma unroll
            for (int r = 0; r < 4; ++r) { const float xv = xr[r * 512 + g * 128 + d]; ac[r] += xv * cv; as[r] += xv * sv; } }
        const float sc = 0.08838834764831845f * W8_SCALE;
        *(unsigned*)(W1 + (size_t)(g * 128 + j) * 1024 + 4 * kb) = cvt_pk4_fp8(ac[0] * sc, ac[1] * sc, ac[2] * sc, ac[3] * sc);
        *(unsigned*)(W1 + (size_t)(512 + g * 128 + j) * 1024 + 4 * kb) = cvt_pk4_fp8(-as[0] * sc, -as[1] * sc, -as[2] * sc, -as[3] * sc);
    }
    __syncthreads();
}
struct CvJob { const float* src; int sld; unsigned char* dst; int f8; };
__device__ __forceinline__ CvJob cv_job(const Frame& F, int j) {
    CvJob J;
    if (j < 128) { const int kt = j >> 4, nt = j & 15; J.src = F.in[I_WIN] + (size_t)kt * 128 * 5120 + 512 + nt * 128; J.sld = 5120; J.dst = F.ws + WS_WIN1T + (size_t)(1024 + nt * 128) * 1024 + kt * 128; J.f8 = 1; }
    else if (j < 288) { const int q = j - 128, kt = q / 20, nt = q % 20; J.src = F.in[I_WIN] + (size_t)kt * 128 * 5120 + 2560 + nt * 128; J.sld = 5120; J.dst = F.ws + WS_WIN2T + (size_t)(nt * 128) * 1024 + kt * 128; J.f8 = 1; }
    else if (j < 320) { const int q = j - 288, kt = q >> 3, nt = q & 7; J.src = F.in[I_WFO] + (size_t)kt * 128 * 1024 + nt * 128; J.sld = 1024; J.dst = F.ws + WS_WMT + ((size_t)(nt * 128) * 1024 + kt * 128); J.f8 = 1; }
    else if (j < 352) { const int q = j - 320, kt = q >> 3, nt = q & 7; J.src = F.in[I_WHO] + (size_t)kt * 128 * 1024 + nt * 128; J.sld = 1024; J.dst = F.ws + WS_WMT + ((size_t)(nt * 128) * 1024 + 512 + kt * 128); J.f8 = 1; }
    else if (j < 416) { const int q = j - 352, kt = q >> 3, nt = q & 7; J.src = F.in[I_WO] + (size_t)kt * 128 * 1024 + nt * 128; J.sld = 1024; J.dst = F.ws + WS_WOT + ((size_t)(nt * 128) * 1024 + kt * 128); J.f8 = 1; }
    else if (j < 4512) { const int q = j - 416, e = q >> 7, r = q & 127, kt = r >> 4, jt = r & 15; J.src = F.in[I_WGU] + (size_t)e * 1024 * 2048 + (size_t)kt * 128 * 2048 + jt * 128; J.sld = 2048;
        J.dst = F.ws + WS_WGUT + (size_t)e * 2048 * 1024 + (size_t)((jt & 7) * 256 + (jt >> 3) * 128) * 1024 + kt * 128; J.f8 = 1; }
    else { const int q = j - 4512, e = q >> 6, r = q & 63, kt = r >> 3, nt = r & 7; J.src = F.in[I_WDN] + (size_t)e * 1024 * 1024 + (size_t)kt * 128 * 1024 + nt * 128; J.sld = 1024;
        J.dst = F.ws + WS_WDNT + (size_t)e * 1024 * 1024 + (size_t)(nt * 128) * 1024 + kt * 128; J.f8 = 1; }
    return J;
}
__device__ __forceinline__ void p0_convert(const Frame& F) {
    constexpr int NJ = 128 + 160 + 32 + 32 + 64 + 4096 + 2048;
    LAS float* tile = (LAS float*)F.lds;
    int j = F.c; if (j >= NJ) return;
    CvJob J = cv_job(F, j);
    f32x4 v[8];
#pragma unroll
    for (int i = 0; i < 8; ++i) { const int idx = F.tid + i * NTHR, r = idx >> 5, c4 = idx & 31; v[i] = *(const f32x4*)(J.src + (size_t)r * J.sld + c4 * 4); }
    for (;;) {
        const float sc = J.f8 ? W8_SCALE : 1.0f;
#pragma unroll
        for (int i = 0; i < 8; ++i) { const int idx = F.tid + i * NTHR, r = idx >> 5, c4 = idx & 31; LAS float* p = tile + r * 129 + c4 * 4; p[0] = v[i][0] * sc; p[1] = v[i][1] * sc; p[2] = v[i][2] * sc; p[3] = v[i][3] * sc; }
        __syncthreads();
        const CvJob Jc = J; const int jn = j + F.G; const bool more = jn < NJ;
        if (more) { J = cv_job(F, jn);
#pragma unroll
            for (int i = 0; i < 8; ++i) { const int idx = F.tid + i * NTHR, r = idx >> 5, c4 = idx & 31; v[i] = *(const f32x4*)(J.src + (size_t)r * J.sld + c4 * 4); } }
        if (Jc.f8) {
#pragma unroll
            for (int i = 0; i < 2; ++i) { const int idx = F.tid + i * NTHR, n = idx >> 3, kc = idx & 7; const LAS float* p = tile + (kc * 16) * 129 + n;
                u32x4 w; w.x = cvt_pk4_fp8(p[0], p[129], p[2 * 129], p[3 * 129]); w.y = cvt_pk4_fp8(p[4 * 129], p[5 * 129], p[6 * 129], p[7 * 129]);
                w.z = cvt_pk4_fp8(p[8 * 129], p[9 * 129], p[10 * 129], p[11 * 129]); w.w = cvt_pk4_fp8(p[12 * 129], p[13 * 129], p[14 * 129], p[15 * 129]);
                *(u32x4*)(Jc.dst + (size_t)n * 1024 + kc * 16) = w; }
        } else {
#pragma unroll
            for (int i = 0; i < 4; ++i) { const int idx = F.tid + i * NTHR, n = idx >> 4, kc = idx & 15; const LAS float* p = tile + (kc * 8) * 129 + n;
                u32x4 w; w.x = cvt_pk_bf16(p[0], p[129]); w.y = cvt_pk_bf16(p[2 * 129], p[3 * 129]); w.z = cvt_pk_bf16(p[4 * 129], p[5 * 129]); w.w = cvt_pk_bf16(p[6 * 129], p[7 * 129]);
                *(u32x4*)((bf16_t*)Jc.dst + (size_t)n * 1024 + kc * 8) = w; }
        }
        __syncthreads();
        if (!more) break;
        j = jn;
    }
}

__device__ __forceinline__ void p1_uprep(const Frame& F) {
    const float* ada = (const float*)(F.ws + WS_ADA);
    unsigned char* U = (unsigned char*)(F.ws + WS_U); unsigned char* Uc = (unsigned char*)(F.ws + WS_UC);
    const size_t NIT = (size_t)(T + TCX) * 128, stride = (size_t)F.G * NTHR;
    for (size_t base = (size_t)F.c * NTHR + F.tid; base < NIT; base += 4 * stride) {
        const int col = (int)(base & 127) * 8;
        f32x4 a0[4], a1[4], sh0[4], sh1[4], sc0[4], sc1[4]; unsigned char* dst[4]; bool ok[4];
#pragma unroll
        for (int u = 0; u < 4; ++u) {
            const size_t idx = base + (size_t)u * stride; ok[u] = idx < NIT;
            const int row = (int)((ok[u] ? idx : base) >> 7);
            const bool lat = row < T; const int b = lat ? (row >> 11) : 32;
            const float* src = lat ? F.in[I_X] + (size_t)row * 1024 + col : F.in[I_CTX] + (size_t)(row - T) * 1024 + col;
            dst[u] = lat ? U + (size_t)row * 1024 + col : Uc + (size_t)(row - T) * 1024 + col;
            a0[u] = *(const f32x4*)src; a1[u] = *(const f32x4*)(src + 4);
            const float* ap = ada + (size_t)b * 6144 + col;
            sh0[u] = *(const f32x4*)ap; sh1[u] = *(const f32x4*)(ap + 4); sc0[u] = *(const f32x4*)(ap + 1024); sc1[u] = *(const f32x4*)(ap + 1028);
        }
#pragma unroll
        for (int u = 0; u < 4; ++u) {
            const f32x4 r0 = a0[u] * (sc0[u] + 1.0f) + sh0[u], r1 = a1[u] * (sc1[u] + 1.0f) + sh1[u];
            if (ok[u]) *(u32x2*)dst[u] = (u32x2){cvt_pk4_fp8(r0[0], r0[1], r0[2], r0[3]), cvt_pk4_fp8(r1[0], r1[1], r1[2], r1[3])};
        }
    }
    int* rowtok = (int*)(F.ws + WS_ROWTOK);
    for (int i = F.c * NTHR + F.tid; i < NCH * ROWS_CH; i += F.G * NTHR) rowtok[i] = (i / ROWS_CH) * TCH;
}

__device__ __forceinline__ void p6_readout(const Frame& F) {
    const bf16_t* PH = (const bf16_t*)(F.ws + WS_PH); const bf16_t* PG = (const bf16_t*)(F.ws + WS_PG); unsigned char* Y = (unsigned char*)(F.ws + WS_Y);
    const int l8 = F.lane * 8;
    const f32x4 g0 = *(const f32x4*)(F.in[I_HGG] + l8), g1 = *(const f32x4*)(F.in[I_HGG] + l8 + 4);
    const int tstr = F.G * 8;
    for (int t0 = F.c * 8 + F.wave; t0 < T; t0 += 4 * tstr) {
        u32x4 av[4], bv[4], pv[4]; bool ok[4]; int tt[4];
#pragma unroll
        for (int u = 0; u < 4; ++u) { const int t = t0 + u * tstr; ok[u] = t < T; tt[u] = ok[u] ? t : t0;
            av[u] = *(const u32x4*)(PH + (size_t)tt[u] * 2048 + 512 + l8); bv[u] = *(const u32x4*)(PH + (size_t)tt[u] * 2048 + 1024 + l8); pv[u] = *(const u32x4*)(PG + (size_t)tt[u] * 512 + l8); }
#pragma unroll
        for (int u = 0; u < 4; ++u) {
            const u32x4 a = av[u], b = bv[u], p = pv[u];
            float o[8] = { bf_lo(a.x) + bf_lo(b.x), bf_hi(a.x) + bf_hi(b.x), bf_lo(a.y) + bf_lo(b.y), bf_hi(a.y) + bf_hi(b.y), bf_lo(a.z) + bf_lo(b.z), bf_hi(a.z) + bf_hi(b.z), bf_lo(a.w) + bf_lo(b.w), bf_hi(a.w) + bf_hi(b.w) };
            float ss = 0.f;
#pragma unroll
            for (int i = 0; i < 8; ++i) ss += o[i] * o[i];
            ss += __shfl_xor(ss, 1); ss += __shfl_xor(ss, 2); ss += __shfl_xor(ss, 4); ss += __shfl_xor(ss, 8);
            const float rs = __builtin_amdgcn_rsqf(ss * (1.0f / 128.0f) + RMS_EPS);
            const float sp[8] = { bf_lo(p.x), bf_hi(p.x), bf_lo(p.y), bf_hi(p.y), bf_lo(p.z), bf_hi(p.z), bf_lo(p.w), bf_hi(p.w) };
            if (ok[u]) *(u32x2*)(Y + (size_t)tt[u] * 1024 + 512 + l8) = (u32x2){cvt_pk4_fp8(o[0] * rs * g0[0] * sp[0], o[1] * rs * g0[1] * sp[1], o[2] * rs * g0[2] * sp[2], o[3] * rs * g0[3] * sp[3]), cvt_pk4_fp8(o[4] * rs * g1[0] * sp[4], o[5] * rs * g1[1] * sp[5], o[6] * rs * g1[2] * sp[6], o[7] * rs * g1[3] * sp[7])};
        }
    }
}

__device__ __forceinline__ void p9_ln1_router(const Frame& F, const bool dry) {
    LAS float* wrT = (LAS float*)F.lds;
    LAS float* lg = (LAS float*)(F.lds + 131072);
    LAS float* brs = (LAS float*)(F.lds + 131072 + 4096);
    LAS int* hist = (LAS int*)(F.lds + 131072 + 4096 + 128);
    for (int i = F.tid; i < 32768; i += NTHR) { const int k = i >> 5, e = i & 31; wrT[e * 1024 + k] = F.in[I_WR][i]; }
    if (F.tid < 32) brs[F.tid] = F.in[I_BR][F.tid];
    if (F.tid < NCH * 32) hist[F.tid] = 0;
    __syncthreads();
    const bf16_t* V = (const bf16_t*)F.out; bf16_t* X1 = (bf16_t*)(F.ws + WS_X1); unsigned char* U2 = (unsigned char*)(F.ws + WS_U); const float* ada = (const float*)(F.ws + WS_ADA);
    int* topi = (int*)(F.ws + WS_TOPI); float* topw = (float*)(F.ws + WS_TOPW);
    const int l4 = F.lane * 4;
    for (int gi = F.c * 8 + F.wave; gi < T / 4; gi += F.G * 8) {
        const int g = T / 4 - 1 - gi;
        const int t0 = g * 4, b = t0 >> 11;
        f32x4 xv[4][4];
#pragma unroll
        for (int tk = 0; tk < 4; ++tk) { u32x2 w[4]; const float* xp = F.in[I_X] + (size_t)(t0 + tk) * 1024 + l4; const bf16_t* vp = V + (size_t)(t0 + tk) * 1024 + l4;
#pragma unroll
            for (int j = 0; j < 4; ++j) { xv[tk][j] = *(const f32x4*)(xp + 256 * j); w[j] = *(const u32x2*)(vp + 256 * j); }
#pragma unroll
            for (int j = 0; j < 4; ++j) xv[tk][j] = xv[tk][j] * DN_ALPHA + (f32x4){bf_lo(w[j].x), bf_hi(w[j].x), bf_lo(w[j].y), bf_hi(w[j].y)};
            if (tk == 1) asm volatile("" ::: "memory"); }
        float mean[4], rstd[4];
#pragma unroll
        for (int tk = 0; tk < 4; ++tk) { float s = 0.f;
#pragma unroll
            for (int j = 0; j < 4; ++j) s += (xv[tk][j][0] + xv[tk][j][1]) + (xv[tk][j][2] + xv[tk][j][3]);
            s = wave_sum(s); mean[tk] = s * (1.0f / 1024.0f); float q = 0.f;
#pragma unroll
            for (int j = 0; j < 4; ++j) { const f32x4 d = xv[tk][j] - mean[tk]; q += (d[0] * d[0] + d[1] * d[1]) + (d[2] * d[2] + d[3] * d[3]); }
            q = wave_sum(q); rstd[tk] = __builtin_amdgcn_rsqf(q * (1.0f / 1024.0f) + LN_EPS); }
#pragma unroll
        for (int j = 0; j < 4; ++j) {
            int l4g = l4; asm volatile("" : "+v"(l4g));
            const int k = 256 * j + l4g;
            const f32x4 lg1 = *(const f32x4*)(F.in[I_LN1G] + k), lb1 = *(const f32x4*)(F.in[I_LN1B] + k);
            const f32x4 sh = *(const f32x4*)(ada + (size_t)b * 6144 + 3072 + k), sc = *(const f32x4*)(ada + (size_t)b * 6144 + 4096 + k);
#pragma unroll
            for (int tk = 0; tk < 4; ++tk) { const f32x4 x1 = (xv[tk][j] - mean[tk]) * rstd[tk] * lg1 + lb1;
                if (!dry) *(u32x2*)(X1 + (size_t)(t0 + tk) * 1024 + k) = (u32x2){cvt_pk_bf16(x1[0], x1[1]), cvt_pk_bf16(x1[2], x1[3])};
                const f32x4 u2 = x1 * (sc + 1.0f) + sh; xv[tk][j] = u2;
                if (!dry) *(unsigned*)(U2 + (size_t)(t0 + tk) * 1024 + k) = cvt_pk4_fp8(u2[0], u2[1], u2[2], u2[3]); } }
#pragma unroll 1
        for (int eq = 0; eq < 4; ++eq) {
            f32x2 acc2[4][8];
#pragma unroll
            for (int e = 0; e < 8; ++e) { acc2[0][e] = (f32x2){0.f, 0.f}; acc2[1][e] = (f32x2){0.f, 0.f}; acc2[2][e] = (f32x2){0.f, 0.f}; acc2[3][e] = (f32x2){0.f, 0.f};
#pragma unroll
                for (int j = 0; j < 4; ++j) { const f32x4 w4 = *(const LAS f32x4*)(wrT + (eq * 8 + e) * 1024 + 256 * j + l4); const f32x2 wlo = {w4[0], w4[1]}, whi = {w4[2], w4[3]};
#pragma unroll
                    for (int tk = 0; tk < 4; ++tk) { const f32x2 xlo = {xv[tk][j][0], xv[tk][j][1]}, xhi = {xv[tk][j][2], xv[tk][j][3]};
                        acc2[tk][e] = __builtin_elementwise_fma(xlo, wlo, acc2[tk][e]); acc2[tk][e] = __builtin_elementwise_fma(xhi, whi, acc2[tk][e]); } }
                if (e & 1) __builtin_amdgcn_sched_barrier(0); }
            float acc[4][8];
#pragma unroll
            for (int tk = 0; tk < 4; ++tk)
#pragma unroll
                for (int e = 0; e < 8; ++e) acc[tk][e] = acc2[tk][e][0] + acc2[tk][e][1];
#pragma unroll
            for (int tk = 0; tk < 4; ++tk) {
                float v0, v1, v2, v3;
                { const bool up = (F.lane & 32) != 0;
                  v0 = (up ? acc[tk][4] : acc[tk][0]) + __shfl_xor(up ? acc[tk][0] : acc[tk][4], 32);
                  v1 = (up ? acc[tk][5] : acc[tk][1]) + __shfl_xor(up ? acc[tk][1] : acc[tk][5], 32);
                  v2 = (up ? acc[tk][6] : acc[tk][2]) + __shfl_xor(up ? acc[tk][2] : acc[tk][6], 32);
                  v3 = (up ? acc[tk][7] : acc[tk][3]) + __shfl_xor(up ? acc[tk][3] : acc[tk][7], 32); }
                { const bool up = (F.lane & 16) != 0;
                  const float a0 = (up ? v2 : v0) + __shfl_xor(up ? v0 : v2, 16), a1 = (up ? v3 : v1) + __shfl_xor(up ? v1 : v3, 16); v0 = a0; v1 = a1; }
                { const bool up = (F.lane & 8) != 0; v0 = (up ? v1 : v0) + __shfl_xor(up ? v0 : v1, 8); }
                v0 += __shfl_xor(v0, 4); v0 += __shfl_xor(v0, 2); v0 += __shfl_xor(v0, 1);
                const int e = eq * 8 + ((F.lane >> 5) & 1) * 4 + ((F.lane >> 4) & 1) * 2 + ((F.lane >> 3) & 1);
                if ((F.lane & 7) == 0) lg[(F.wave * 4 + tk) * 32 + e] = v0 + brs[e];
            }
        }
        asm volatile("s_waitcnt lgkmcnt(0)" ::: "memory");
        if (F.lane < 4) {
            const LAS float* L = lg + (F.wave * 4 + F.lane) * 32;
            float b0 = -3.0e38f, b1 = -3.0e38f, b2 = -3.0e38f, b3 = -3.0e38f; int i0 = 0, i1 = 0, i2 = 0, i3 = 0;
            for (int e = 0; e < 32; ++e) { const float x = L[e];
                if (x > b3) { b3 = x; i3 = e;
                    if (b3 > b2) { float tf = b2; b2 = b3; b3 = tf; int ti = i2; i2 = i3; i3 = ti;
                        if (b2 > b1) { tf = b1; b1 = b2; b2 = tf; ti = i1; i1 = i2; i2 = ti;
                            if (b1 > b0) { tf = b0; b0 = b1; b1 = tf; ti = i0; i0 = i1; i1 = ti; } } } } }
            const float p1 = fast_exp(b1 - b0), p2 = fast_exp(b2 - b0), p3 = fast_exp(b3 - b0), inv = 1.0f / (1.0f + p1 + p2 + p3);
            const int t = t0 + F.lane;
            *(int4*)(topi + (size_t)t * 4) = make_int4(i0, i1, i2, i3);
            *(f32x4*)(topw + (size_t)t * 4) = (f32x4){inv, p1 * inv, p2 * inv, p3 * inv};
            const int ch = t / TCH;
            if (!dry) { atomicAdd((int*)(hist + ch * 32 + i0), 1); atomicAdd((int*)(hist + ch * 32 + i1), 1); atomicAdd((int*)(hist + ch * 32 + i2), 1); atomicAdd((int*)(hist + ch * 32 + i3), 1); }
        }
    }
    __syncthreads();
    { int t2 = threadIdx.x; asm volatile("" : "+v"(t2));
      if (t2 < NCH * 32) { const int h = hist[t2]; if (h && !dry) atomicAdd(F.ctl + CW_CNT + t2, (unsigned)h); } }
    __syncthreads();
}

__device__ __forceinline__ void p10_dispatch(const Frame& F) {
    LAS int* lcnt = (LAS int*)F.lds; LAS int* lbase = lcnt + 32; LAS int* pstart = lcnt + 64;
    const int* topi = (const int*)(F.ws + WS_TOPI); int* pos = (int*)(F.ws + WS_POS); int* rowtok = (int*)(F.ws + WS_ROWTOK);
    for (int s = F.c; s < T / 256; s += F.G) {
        const int ch = (s * 256) / TCH;
        __syncthreads();
        if (F.tid < 32) { lcnt[F.tid] = 0; int ps = 0; for (int e = 0; e < F.tid; ++e) { const int n = (int)__hip_atomic_load(F.ctl + CW_CNT + ch * 32 + e, __ATOMIC_RELAXED, __HIP_MEMORY_SCOPE_AGENT); ps += (n + 255) & ~255; } pstart[F.tid] = ps; }
        __syncthreads();
        int e2[2], r2[2];
#pragma unroll
        for (int i = 0; i < 2; ++i) { const int a = F.tid + i * NTHR; e2[i] = topi[(size_t)(s * 256) * 4 + a]; r2[i] = atomicAdd((int*)(lcnt + e2[i]), 1); }
        __syncthreads();
        if (F.tid < 32) lbase[F.tid] = (int)atomicAdd(F.ctl + CW_CUR + ch * 32 + F.tid, (unsigned)lcnt[F.tid]);
        __syncthreads();
#pragma unroll
        for (int i = 0; i < 2; ++i) { const int a = F.tid + i * NTHR, slot = pstart[e2[i]] + lbase[e2[i]] + r2[i];
            pos[(size_t)(s * 256) * 4 + a] = slot; rowtok[(size_t)ch * ROWS_CH + slot] = s * 256 + (a >> 2); }
    }
}
__device__ __forceinline__ int moe_blocks(const Frame& F, int ch, LAS unsigned char* blk_e) {
    LAS int* sh = (LAS int*)(blk_e + 1152);
    __syncthreads();
    if (F.tid < 32) {
        int start = 0, mine = 0;
        for (int e = 0; e < 32; ++e) { const int n = ((int)__hip_atomic_load(F.ctl + CW_CNT + ch * 32 + e, __ATOMIC_RELAXED, __HIP_MEMORY_SCOPE_AGENT) + 255) >> 8; if (e < F.tid) start += n; if (e == F.tid) mine = n; }
        for (int i = 0; i < mine; ++i) blk_e[start + i] = (unsigned char)F.tid;
        if (F.tid == 31) sh[0] = start + mine;
    }
    __syncthreads();
    return sh[0];
}

__device__ __forceinline__ void p13_combine_ln2(const Frame& F, int ch, const bool dry) {
    const unsigned char* YC = (const unsigned char*)(F.ws + WS_YCH); const int* pos = (const int*)(F.ws + WS_POS); const float* topw = (const float*)(F.ws + WS_TOPW);
    const float* ada = (const float*)(F.ws + WS_ADA); const bf16_t* X1 = (const bf16_t*)(F.ws + WS_X1); float* O = F.out;
    const int l8 = F.lane * 8;
    for (int t0 = ch * TCH + F.c * 8 + F.wave; t0 < (ch + 1) * TCH; t0 += 2 * F.G * 8) {
        int tt[2]; tt[0] = t0; tt[1] = t0 + F.G * 8; const bool two = tt[1] < (ch + 1) * TCH; if (!two) tt[1] = t0;
        f32x4 v[2][2][2];
#pragma unroll
        for (int q = 0; q < 2; ++q) { const int t = tt[q], b = t >> 11;
            const int4 ps = *(const int4*)(pos + (size_t)t * 4); const f32x4 tw = *(const f32x4*)(topw + (size_t)t * 4);
#pragma unroll
            for (int j = 0; j < 2; ++j) { const int k = 512 * j + l8;
                const u32x2 y0 = *(const u32x2*)(YC + (size_t)ps.x * 1024 + k), y1 = *(const u32x2*)(YC + (size_t)ps.y * 1024 + k), y2 = *(const u32x2*)(YC + (size_t)ps.z * 1024 + k), y3 = *(const u32x2*)(YC + (size_t)ps.w * 1024 + k);
                const u32x4 xw = *(const u32x4*)(X1 + (size_t)t * 1024 + k);
                const f32x4 g2a = *(const f32x4*)(ada + (size_t)b * 6144 + 5120 + k), g2b = *(const f32x4*)(ada + (size_t)b * 6144 + 5120 + k + 4);
                const f32x4 ffa = fp8x4_to_f32(y0.x) * tw[0] + fp8x4_to_f32(y1.x) * tw[1] + fp8x4_to_f32(y2.x) * tw[2] + fp8x4_to_f32(y3.x) * tw[3];
                const f32x4 ffb = fp8x4_to_f32(y0.y) * tw[0] + fp8x4_to_f32(y1.y) * tw[1] + fp8x4_to_f32(y2.y) * tw[2] + fp8x4_to_f32(y3.y) * tw[3];
                v[q][j][0] = (f32x4){bf_lo(xw.x), bf_hi(xw.x), bf_lo(xw.y), bf_hi(xw.y)} * DN_ALPHA + g2a * ffa;
                v[q][j][1] = (f32x4){bf_lo(xw.z), bf_hi(xw.z), bf_lo(xw.w), bf_hi(xw.w)} * DN_ALPHA + g2b * ffb; } }
#pragma unroll
        for (int q = 0; q < 2; ++q) { const int t = tt[q];
            float s = 0.f;
#pragma unroll
            for (int j = 0; j < 2; ++j)
#pragma unroll
                for (int h = 0; h < 2; ++h) s += (v[q][j][h][0] + v[q][j][h][1]) + (v[q][j][h][2] + v[q][j][h][3]);
            s = wave_sum(s); const float mean = s * (1.0f / 1024.0f); float qq = 0.f;
#pragma unroll
            for (int j = 0; j < 2; ++j)
#pragma unroll
                for (int h = 0; h < 2; ++h) { const f32x4 d = v[q][j][h] - mean; qq += (d[0] * d[0] + d[1] * d[1]) + (d[2] * d[2] + d[3] * d[3]); }
            qq = wave_sum(qq); const float rstd = __builtin_amdgcn_rsqf(qq * (1.0f / 1024.0f) + LN_EPS);
            if (q == 0 || two) {
#pragma unroll
                for (int j = 0; j < 2; ++j)
#pragma unroll
                    for (int h = 0; h < 2; ++h) { const int k = 512 * j + l8 + 4 * h; const f32x4 g = *(const f32x4*)(F.in[I_LN2G] + k), bb = *(const f32x4*)(F.in[I_LN2B] + k);
                        const f32x4 o4 = (v[q][j][h] - mean) * rstd * g + bb;
                        if (!dry) *(f32x4*)(O + (size_t)t * 1024 + k) = o4; else if (o4[0] == 1.2345e30f) O[0] = 1.f; } }
        }
    }
}

constexpr int SC_QD = 0, SC_KI = 17408, SC_KE = 34816, SC_VT = 53248, SC_SC = 71680, SC_ST = 80896, SC_GV = 115712, SC_CS = 116224;
__device__ __forceinline__ bf16x8 ldfrag(const LAS unsigned char* p) { return *(const LAS bf16x8*)p; }
__device__ __forceinline__ void p3_scan(const Frame& F, const bool dry) {
    LAS unsigned char* L = F.lds;
    const int tid = F.tid, w = F.wave, lane = F.lane, fr = lane & 15, fq = lane >> 4;
    const int d = tid & 127, qd = tid >> 7;
    bf16_t* PH = (bf16_t*)(F.ws + WS_PH); const bf16_t* PHC = (const bf16_t*)(F.ws + WS_PHC);
    for (int it = F.c; it < 256; it += F.G) {
        const int b = it >> 3, h = (it >> 1) & 3, dir = it & 1;
        const float r0 = F.in[I_LBRAW][dir * 512 + h * 128 + d], r1 = F.in[I_LBRAW][1024 + dir * 512 + h * 128 + d];
        const float lbv = fast_sigmoid(r0 - r1), oml = 1.0f - lbv;
        f32x4 Sacc[8];
#pragma unroll
        for (int i = 0; i < 8; ++i) Sacc[i] = (f32x4){0.f, 0.f, 0.f, 0.f};
        __syncthreads();
        for (int i = tid; i < 34816 / 4; i += NTHR) ((LAS unsigned*)(L + SC_ST))[i] = 0u;
        const int cq = h * 128 + d, cz = 512 + dir * 512 + h * 128 + d, cv = 1536 + h * 128 + d;
        bf16_t rq[16], rz[16], rv[16];
        {   const int n = dir ? 3 : 0; const bf16_t* base = PHC + (size_t)(b * 256 + 64 * n + 16 * qd) * 2048;
#pragma unroll
            for (int i = 0; i < 16; ++i) { rq[i] = base[(size_t)i * 2048 + cq]; rz[i] = base[(size_t)i * 2048 + cz]; rv[i] = base[(size_t)i * 2048 + cv]; } }
        for (int s = 0; s < 36; ++s) {
            const bool lat = s >= 4; const int n = lat ? (dir ? 31 - (s - 4) : (s - 4)) : (dir ? 3 - s : s);
            float kk[16], cum[16]; float run = 0.f;
#pragma unroll
            for (int i = 0; i < 16; ++i) { const float sg = fast_sigmoid(bf2f(rz[i])); kk[i] = oml * (1.0f - sg); cum[i] = fast_log(lbv + oml * sg); }
            if (dir == 0) {
#pragma unroll
                for (int i = 0; i < 16; ++i) { run += cum[i]; cum[i] = run; }
            } else {
#pragma unroll
                for (int i = 15; i >= 0; --i) { run += cum[i]; cum[i] = run; }
            }
            ((LAS float*)(L + SC_CS))[qd * 128 + d] = run;
            __syncthreads();
            {   const LAS float* cs = (const LAS float*)(L + SC_CS);
                const float c0 = cs[d], c1 = cs[128 + d], c2 = cs[256 + d], c3 = cs[384 + d], tot = (c0 + c1) + (c2 + c3);
                float off;
                if (dir == 0) off = (qd > 0 ? c0 : 0.f) + (qd > 1 ? c1 : 0.f) + (qd > 2 ? c2 : 0.f);
                else off = (qd < 3 ? c3 : 0.f) + (qd < 2 ? c2 : 0.f) + (qd < 1 ? c1 : 0.f);
                const float g = fast_exp(tot);
                if (qd == 0) ((LAS float*)(L + SC_GV))[d] = g;
                unsigned ke[8], vt[8];
#pragma unroll
                for (int i = 0; i < 16; i += 2) {
                    const float ca = cum[i] + off, cb = cum[i + 1] + off;
                    const float ea = fast_exp(ca), eb = fast_exp(cb), ia = __builtin_amdgcn_rcpf(ea), ib = __builtin_amdgcn_rcpf(eb);
                    const float qa = bf2f(rq[i]), qb = bf2f(rq[i + 1]);
                    const float qda = qa * fast_sigmoid(qa) * ea, qdb = qb * fast_sigmoid(qb) * eb;
                    const float kia = kk[i] * ia, kib = kk[i + 1] * ib;
                    const unsigned wa = cvt_pk_bf16(qda, kia), wb = cvt_pk_bf16(qdb, kib);
                    *(LAS bf16_t*)(L + SC_QD + (16 * qd + i) * 272 + d * 2) = (bf16_t)(wa & 0xffffu);
                    *(LAS bf16_t*)(L + SC_KI + (16 * qd + i) * 272 + d * 2) = (bf16_t)(wa >> 16);
                    *(LAS bf16_t*)(L + SC_QD + (16 * qd + i + 1) * 272 + d * 2) = (bf16_t)(wb & 0xffffu);
                    *(LAS bf16_t*)(L + SC_KI + (16 * qd + i + 1) * 272 + d * 2) = (bf16_t)(wb >> 16);
                    ke[i >> 1] = cvt_pk_bf16(kia * g, kib * g);
                    vt[i >> 1] = (unsigned)rv[i] | ((unsigned)rv[i + 1] << 16);
                }
                *(LAS u32x4*)(L + SC_KE + d * 144 + 32 * qd) = (u32x4){ke[0], ke[1], ke[2], ke[3]};
                *(LAS u32x4*)(L + SC_KE + d * 144 + 32 * qd + 16) = (u32x4){ke[4], ke[5], ke[6], ke[7]};
                *(LAS u32x4*)(L + SC_VT + d * 144 + 32 * qd) = (u32x4){vt[0], vt[1], vt[2], vt[3]};
                *(LAS u32x4*)(L + SC_VT + d * 144 + 32 * qd + 16) = (u32x4){vt[4], vt[5], vt[6], vt[7]};
            }
            if (s + 1 < 36) {
                const int s1 = s + 1; const bool lat1 = s1 >= 4; const int n1 = lat1 ? (dir ? 31 - (s1 - 4) : (s1 - 4)) : (dir ? 3 - s1 : s1);
                const bf16_t* base = lat1 ? (const bf16_t*)PH + (size_t)(b * 2048 + 64 * n1 + 16 * qd) * 2048 : PHC + (size_t)(b * 256 + 64 * n1 + 16 * qd) * 2048;
#pragma unroll
                for (int i = 0; i < 16; ++i) { rq[i] = base[(size_t)i * 2048 + cq]; rz[i] = base[(size_t)i * 2048 + cz]; rv[i] = base[(size_t)i * 2048 + cv]; }
            }
            __syncthreads();
            f32x4 oacc[4];
#pragma unroll
            for (int i = 0; i < 4; ++i) oacc[i] = (f32x4){0.f, 0.f, 0.f, 0.f};
            const int kb = fq * 16;
            if (lat) {
                const int ct = w >> 1, st0 = 2 * (w & 1);
#pragma unroll
                for (int j = 0; j < 2; ++j) { const int st = st0 + j; f32x4 sa = (f32x4){0.f, 0.f, 0.f, 0.f};
#pragma unroll
                    for (int ks = 0; ks < 4; ++ks) sa = __builtin_amdgcn_mfma_f32_16x16x32_bf16(ldfrag(L + SC_KI + (16 * st + fr) * 272 + ks * 64 + kb), ldfrag(L + SC_QD + (16 * ct + fr) * 272 + ks * 64 + kb), sa, 0, 0, 0);
                    const int cc = 16 * ct + fr, s0 = 16 * st + 4 * fq;
#pragma unroll
                    for (int i = 0; i < 4; ++i) { const bool keep = dir ? (s0 + i >= cc) : (s0 + i <= cc); sa[i] = keep ? sa[i] : 0.f; }
                    *(LAS u32x2*)(L + SC_SC + cc * 144 + s0 * 2) = (u32x2){cvt_pk_bf16(sa[0], sa[1]), cvt_pk_bf16(sa[2], sa[3])}; }
#pragma unroll
                for (int ct2 = 0; ct2 < 4; ++ct2)
#pragma unroll
                    for (int ks = 0; ks < 4; ++ks) oacc[ct2] = __builtin_amdgcn_mfma_f32_16x16x32_bf16(ldfrag(L + SC_ST + (16 * w + fr) * 272 + ks * 64 + kb), ldfrag(L + SC_QD + (16 * ct2 + fr) * 272 + ks * 64 + kb), oacc[ct2], 0, 0, 0);
            }
            {   const bf16x8 v0 = ldfrag(L + SC_VT + (16 * w + fr) * 144 + kb), v1 = ldfrag(L + SC_VT + (16 * w + fr) * 144 + 64 + kb);
#pragma unroll
                for (int dt = 0; dt < 8; ++dt) { const f32x4 gv = *(const LAS f32x4*)(L + SC_GV + (16 * dt + 4 * fq) * 4);
                    f32x4 a = Sacc[dt] * gv;
                    a = __builtin_amdgcn_mfma_f32_16x16x32_bf16(ldfrag(L + SC_KE + (16 * dt + fr) * 144 + kb), v0, a, 0, 0, 0);
                    a = __builtin_amdgcn_mfma_f32_16x16x32_bf16(ldfrag(L + SC_KE + (16 * dt + fr) * 144 + 64 + kb), v1, a, 0, 0, 0);
                    Sacc[dt] = a; } }
            __syncthreads();
#pragma unroll
            for (int dt = 0; dt < 8; ++dt) *(LAS u32x2*)(L + SC_ST + (16 * w + fr) * 272 + (16 * dt + 4 * fq) * 2) = (u32x2){cvt_pk_bf16(Sacc[dt][0], Sacc[dt][1]), cvt_pk_bf16(Sacc[dt][2], Sacc[dt][3])};
            if (lat) {
                const bf16x8 v0 = ldfrag(L + SC_VT + (16 * w + fr) * 144 + kb), v1 = ldfrag(L + SC_VT + (16 * w + fr) * 144 + 64 + kb);
                bf16_t* ob = PH + (size_t)(b * 2048 + 64 * n) * 2048 + 512 + dir * 512 + h * 128 + 16 * w + 4 * fq;
#pragma unroll
                for (int ct2 = 0; ct2 < 4; ++ct2) {
                    f32x4 a = oacc[ct2];
                    a = __builtin_amdgcn_mfma_f32_16x16x32_bf16(v0, ldfrag(L + SC_SC + (16 * ct2 + fr) * 144 + kb), a, 0, 0, 0);
                    a = __builtin_amdgcn_mfma_f32_16x16x32_bf16(v1, ldfrag(L + SC_SC + (16 * ct2 + fr) * 144 + 64 + kb), a, 0, 0, 0);
                    if (!dry) *(u32x2*)(ob + (size_t)(16 * ct2 + fr) * 2048) = (u32x2){cvt_pk_bf16(a[0], a[1]), cvt_pk_bf16(a[2], a[3])};
                    else if (a[0] == 1.2345e30f) ob[0] = 1; }
            }
        }
        __syncthreads();
    }
}

typedef short s16x4 __attribute__((ext_vector_type(4)));
__device__ __forceinline__ s16x4 tr_read(unsigned lds_addr) { s16x4 r; asm volatile("ds_read_b64_tr_b16 %0, %1\n\ts_waitcnt lgkmcnt(0)" : "=&v"(r) : "v"(lds_addr) : "memory"); return r; }
__device__ __forceinline__ void tr_read8(unsigned a0, unsigned a1, unsigned a2, unsigned a3, unsigned d, s16x4 (&r)[8]) {
    asm volatile("ds_read_b64_tr_b16 %0, %8\n\tds_read_b64_tr_b16 %1, %9\n\tds_read_b64_tr_b16 %2, %10\n\tds_read_b64_tr_b16 %3, %11\n\t"
                 "ds_read_b64_tr_b16 %4, %12\n\tds_read_b64_tr_b16 %5, %13\n\tds_read_b64_tr_b16 %6, %14\n\tds_read_b64_tr_b16 %7, %15\n\ts_waitcnt lgkmcnt(0)"
                 : "=&v"(r[0]), "=&v"(r[1]), "=&v"(r[2]), "=&v"(r[3]), "=&v"(r[4]), "=&v"(r[5]), "=&v"(r[6]), "=&v"(r[7])
                 : "v"(a0), "v"(a0 + d), "v"(a1), "v"(a1 + d), "v"(a2), "v"(a2 + d), "v"(a3), "v"(a3 + d) : "memory");
}
__device__ __forceinline__ void tr_read4(unsigned a0, unsigned a1, unsigned d, s16x4 (&r)[4]) {
    asm volatile("ds_read_b64_tr_b16 %0, %4\n\tds_read_b64_tr_b16 %1, %5\n\tds_read_b64_tr_b16 %2, %6\n\tds_read_b64_tr_b16 %3, %7\n\ts_waitcnt lgkmcnt(0)"
                 : "=&v"(r[0]), "=&v"(r[1]), "=&v"(r[2]), "=&v"(r[3]) : "v"(a0), "v"(a0 + d), "v"(a1), "v"(a1 + d) : "memory");
}
__device__ __forceinline__ bf16x8 cat4(s16x4 a, s16x4 b) { return (bf16x8){a[0], a[1], a[2], a[3], b[0], b[1], b[2], b[3]}; }
constexpr int FO_C = 131072, FO_S = 139264;
__device__ __forceinline__ void p4_fourier(const Frame& F) {
    LAS unsigned char* L = F.lds;
    const int tid = F.tid, w = F.wave, lane = F.lane, fr = lane & 15, fq = lane >> 4;
    const bf16_t* PA = (const bf16_t*)(F.ws + WS_PA); unsigned char* Y = (unsigned char*)(F.ws + WS_Y);
    __syncthreads();
    for (int i = tid; i < 4096; i += NTHR) { const int k2 = i >> 6, c = i & 63; const float a = (float)((k2 * c) & 63) * (1.0f / 64.0f);
        *(LAS bf16_t*)(L + FO_C + i * 2) = (bf16_t)(cvt_pk_bf16(__builtin_amdgcn_cosf(a) * 0.125f, 0.f) & 0xffffu);
        *(LAS bf16_t*)(L + FO_S + i * 2) = (bf16_t)(cvt_pk_bf16(__builtin_amdgcn_sinf(a) * 0.125f, 0.f) & 0xffffu); }
    bf16x8 Gf[2][2];
#pragma unroll
    for (int nt = 0; nt < 2; ++nt)
#pragma unroll
        for (int ks = 0; ks < 2; ++ks) { unsigned pk[4];
#pragma unroll
            for (int j = 0; j < 8; j += 2) { const int k1 = 16 * nt + fr, ra = 8 * fq + j, rb = ra + 1; const float aa = (float)((k1 * ra) & 31) * (1.0f / 32.0f), ab = (float)((k1 * rb) & 31) * (1.0f / 32.0f);
                const float va = (ks ? __builtin_amdgcn_sinf(aa) : __builtin_amdgcn_cosf(aa)) * 0.17677669529663687f, vb = (ks ? __builtin_amdgcn_sinf(ab) : __builtin_amdgcn_cosf(ab)) * 0.17677669529663687f;
                pk[j >> 1] = cvt_pk_bf16(va, vb); }
            u32x4 t4 = (u32x4){pk[0], pk[1], pk[2], pk[3]}; Gf[nt][ks] = *(bf16x8*)&t4; }
    const unsigned lbase = (unsigned)(size_t)L;
    for (int it = F.c; it < 1024; it += F.G) {
        const int xcd = it & 7, jj = it >> 3, slab = 4 * xcd + (jj & 3), b = jj >> 2;
        __syncthreads();
        {   const bf16_t* src = PA + (size_t)(b * 32 + slab) * 2048 * 32;
            u32x4 v[16];
#pragma unroll
            for (int n = 0; n < 16; ++n) v[n] = *(const u32x4*)(src + (size_t)(tid + NTHR * n) * 8);
#pragma unroll
            for (int n = 0; n < 16; ++n) *(LAS u32x4*)(L + (tid + NTHR * n) * 16) = v[n]; }
        __syncthreads();
#pragma unroll 1
        for (int rr = 0; rr < 4; ++rr) {
            const int r = w + 8 * rr;
            f32x4 acc[8];
#pragma unroll
            for (int i = 0; i < 8; ++i) acc[i] = (f32x4){0.f, 0.f, 0.f, 0.f};
            s16x4 tr[8];
            {   unsigned aa[4];
#pragma unroll
                for (int ks = 0; ks < 4; ++ks) { const int ri = ks >> 1, c0 = 32 * (ks & 1) + 8 * fq + (fr >> 2); aa[ks] = lbase + (unsigned)((r * 64 + c0) * 64 + ri * 32 + (fr & 3) * 8); }
                tr_read8(aa[0], aa[1], aa[2], aa[3], 4u * 64u, tr); }
#pragma unroll
            for (int ks = 0; ks < 4; ++ks) {
                const int ri = ks >> 1;
                const bf16x8 af = cat4(tr[2 * ks], tr[2 * ks + 1]);
#pragma unroll
                for (int nt = 0; nt < 8; ++nt) { const int ro = nt >> 2, k2 = 16 * (nt & 3) + fr;
                    u32x4 bw = *(const LAS u32x4*)(L + ((ro == ri) ? FO_C : FO_S) + (k2 * 64 + 32 * (ks & 1) + 8 * fq) * 2);
                    if (ro == 1 && ri == 0) { bw.x ^= 0x80008000u; bw.y ^= 0x80008000u; bw.z ^= 0x80008000u; bw.w ^= 0x80008000u; }
                    acc[nt] = __builtin_amdgcn_mfma_f32_16x16x32_bf16(af, *(bf16x8*)&bw, acc[nt], 0, 0, 0); }
            }
#pragma unroll
            for (int nt = 0; nt < 8; ++nt) { const int ro = nt >> 2, k2 = 16 * (nt & 3) + fr;
                *(LAS u32x2*)(L + (r * 64 + k2) * 64 + ro * 32 + fq * 8) = (u32x2){cvt_pk_bf16(acc[nt][0], acc[nt][1]), cvt_pk_bf16(acc[nt][2], acc[nt][3])}; }
        }
        __syncthreads();
#pragma unroll 1
        for (int kk = 0; kk < 8; ++kk) {
            const int k2 = 8 * w + kk;
            f32x4 a2[2] = {(f32x4){0.f, 0.f, 0.f, 0.f}, (f32x4){0.f, 0.f, 0.f, 0.f}};
            s16x4 t4[4];
            {   const int r0 = 8 * fq + (fr >> 2); const unsigned a0 = lbase + (unsigned)((r0 * 64 + k2) * 64 + (fr & 3) * 8);
                tr_read4(a0, a0 + 32u, 4u * 64u * 64u, t4); }
#pragma unroll
            for (int ks = 0; ks < 2; ++ks) {
                const bf16x8 af = cat4(t4[2 * ks], t4[2 * ks + 1]);
                a2[0] = __builtin_amdgcn_mfma_f32_16x16x32_bf16(af, Gf[0][ks], a2[0], 0, 0, 0);
                a2[1] = __builtin_amdgcn_mfma_f32_16x16x32_bf16(af, Gf[1][ks], a2[1], 0, 0, 0);
            }
#pragma unroll
            for (int nt = 0; nt < 2; ++nt) { const int k1 = 16 * nt + fr;
                *(unsigned*)(Y + (size_t)(b * 2048 + k1 * 64 + k2) * 1024 + slab * 16 + 4 * fq) = cvt_pk4_fp8(a2[nt][0], a2[nt][1], a2[nt][2], a2[nt][3]); }
        }
    }
    __syncthreads();
}

struct Args { const float* in[22]; float* out; unsigned char* ws; int ph_lo, ph_hi; };
constexpr int N_PHASES = 9 + 3 * NCH;

__global__ void __launch_bounds__(NTHR, 2) mega_fwd(Args args) {
    extern __shared__ __attribute__((aligned(16))) unsigned char lds_raw[];
    Frame F;
    F.lds = (LAS unsigned char*)lds_raw;
    F.tid = threadIdx.x; F.lane = F.tid & 63; F.wave = __builtin_amdgcn_readfirstlane(F.tid >> 6);
    F.G = gridDim.x; F.c = blockIdx.x;
    F.in = args.in;
    F.out = args.out; F.ws = args.ws; F.ctl = (unsigned*)(args.ws + WS_CTL);
    volatile LAS unsigned* misc = (volatile LAS unsigned*)(F.lds + LDS_MISC);
    if (F.tid < 4) misc[F.tid] = 0u;
    __syncthreads();
    XcdBarrier bar = xcd_barrier_post(F.ctl, misc);
    const int lo = args.ph_lo, hi = args.ph_hi;
#ifndef PHASE_MASK
#define PHASE_MASK 0xFFFFFFFFu
#endif
#define IN(k) ((((PHASE_MASK) >> (k)) & 1u) && lo <= (k) && (k) < hi)
#define SEAM(k) do { if (IN(k) && IN((k) + 1)) xcd_barrier(bar); } while (0)
#ifndef REP_MASK
#define REP_MASK 0u
#endif
#define REPS(b) ((((REP_MASK) >> (b)) & 1u) ? 2 : 1)
#define REPBAR(b, r) do { if ((((REP_MASK) >> (b)) & 1u) && (r) == 0) xcd_barrier(bar); } while (0)
    unsigned char* ws = F.ws;
    LAS unsigned char* blk_e = F.lds + LDS_MISC + 64;
#ifdef PR_A
    unsigned long long* stamps = (unsigned long long*)(ws + 980 * MiB);
#define STAMP(slot) do { if (F.tid == 0) stamps[(slot) * 256 + F.c] = __builtin_amdgcn_s_memrealtime(); } while (0)
#else
#define STAMP(slot) do { } while (0)
#endif
    STAMP(0);

    if (IN(0)) { for (int r = 0; r < REPS(0); ++r) { p0_ada(F); p0_fold(F); p0_convert(F); REPBAR(0, r); } }
    STAMP(1);
    SEAM(0);
    if (IN(1)) { for (int r = 0; r < REPS(1); ++r) { p1_uprep(F); REPBAR(1, r); } }
    STAMP(2);
    SEAM(1);
    if (IN(2)) {
        ProbP1 P{(const char*)(ws + WS_U), 8, 1024u, 1024u, (const char*)(ws + WS_WIN1T), (unsigned)(WS_UC - WS_U), F.G, F.c};
        EpiP1 E{(bf16_t*)(ws + WS_PA), (bf16_t*)(ws + WS_PH), (bf16_t*)(ws + WS_PHC)};
        for (int r = 0; r < REPS(2); ++r) { pg8::gemm_phase<ProbP1, EpiP1, true, false, true>(F.lds, P, E); REPBAR(2, r); }
    }
    STAMP(3);
    SEAM(2);
    if (IN(3)) {
#ifndef NO_FOURIER
        for (int r = 0; r < REPS(4); ++r) { p4_fourier(F); REPBAR(4, r); }
        STAMP(5);
#endif
#ifndef NO_SCAN
        for (int r = 0; r < REPS(3); ++r) { p3_scan(F, r + 1 < REPS(3)); REPBAR(3, r); }
        STAMP(4);
#endif
#ifndef NO_P2GEMM
        ProbDense P{(const char*)(ws + WS_U), 8, 1024u, 1024u, (const char*)(ws + WS_WIN2T), 256, 10, F.G, F.c, 0};
        EpiP2 E{(bf16_t*)(ws + WS_PG), (unsigned char*)F.out};
        for (int r = 0; r < REPS(5); ++r) { pg8::gemm_phase<ProbDense, EpiP2, true, false, true>(F.lds, P, E); REPBAR(5, r); }
#endif
    }
    STAMP(6);
    SEAM(3);
    if (IN(4)) { for (int r = 0; r < REPS(6); ++r) { p6_readout(F); REPBAR(6, r); } }
    STAMP(7);
    SEAM(4);
    if (IN(5)) {
        ProbDense P{(const char*)(ws + WS_Y), 8, 1024u, 1024u, (const char*)(ws + WS_WMT), 256, 4, F.G, F.c, 1};
        EpiM1 E{(const unsigned char*)F.out, (unsigned char*)(ws + WS_PA)};
        for (int r = 0; r < REPS(7); ++r) { pg8::gemm_phase<ProbDense, EpiM1, true, true, true>(F.lds, P, E); REPBAR(7, r); }
    }
    STAMP(8);
    SEAM(5);
    if (IN(6)) {
        ProbDense P{(const char*)(ws + WS_PA), 8, 1024u, 1024u, (const char*)(ws + WS_WOT), 256, 4, F.G, F.c, 0};
        EpiM2 E{(const float*)(ws + WS_ADA), (bf16_t*)F.out};
        for (int r = 0; r < REPS(8); ++r) { pg8::gemm_phase<ProbDense, EpiM2, true, false, true>(F.lds, P, E); REPBAR(8, r); }
    }
    STAMP(9);
    SEAM(6);
    if (IN(7)) { for (int r = 0; r < REPS(9); ++r) { p9_ln1_router(fresh(F), r + 1 < REPS(9)); REPBAR(9, r); } }
    STAMP(10);
    SEAM(7);
    if (IN(8)) { p10_dispatch(F); }
    STAMP(11);
    SEAM(8);
#pragma unroll
    for (int ch = 0; ch < NCH; ++ch) {
        if (IN(9 + 3 * ch)) {
            const int nblk = moe_blocks(F, ch, blk_e);
            ProbMoE<true> P{(const char*)(ws + WS_U), 8, 1024u, 1024u, (const char*)(ws + WS_WGUT), (size_t)2048 * 1024, 8, nblk, F.G, F.c, (const int*)(ws + WS_ROWTOK) + (size_t)ch * ROWS_CH, blk_e};
            EpiGU E{F.in[I_BGU], (unsigned char*)(ws + WS_ACT)};
#ifdef GU_DRY
            pg8::gemm_phase<ProbMoE<true>, EpiGU, true, false, true, GU_DRY>(F.lds, P, E); xcd_barrier(bar);
#endif
            for (int r = 0; r < (ch == 0 ? REPS(10) : 1); ++r) { pg8::gemm_phase<ProbMoE<true>, EpiGU, true, false, true>(F.lds, P, E); if (ch == 0) REPBAR(10, r); }
        }
        STAMP(12);
        SEAM(9 + 3 * ch);
        if (IN(10 + 3 * ch)) {
            const int nblk = moe_blocks(F, ch, blk_e);
            ProbMoE<false> P{(const char*)(ws + WS_ACT), 8, 1024u, 1024u, (const char*)(ws + WS_WDNT), (size_t)1024 * 1024, 4, nblk, F.G, F.c, nullptr, blk_e};
            EpiDN E{F.in[I_BDN], (unsigned char*)(ws + WS_YCH)};
            for (int r = 0; r < (ch == 0 ? REPS(11) : 1); ++r) { pg8::gemm_phase<ProbMoE<false>, EpiDN, true, false, true>(F.lds, P, E); if (ch == 0) REPBAR(11, r); }
        }
        STAMP(13);
        SEAM(10 + 3 * ch);
        if (IN(11 + 3 * ch)) { for (int r = 0; r < (ch == 0 ? REPS(12) : 1); ++r) { p13_combine_ln2(F, ch, ch == 0 && r + 1 < REPS(12)); if (ch == 0) REPBAR(12, r); } }
        STAMP(14);
        SEAM(11 + 3 * ch);
    }
#ifdef DBG_K
    xcd_barrier(bar);
    {
        const unsigned char* buf = (DBG_OUT) ? (const unsigned char*)F.out : (const unsigned char*)(ws + (size_t)(DBG_OFF));
        const size_t wpr = (size_t)(DBG_CW) / 4, nw = (size_t)(DBG_ROWS) * wpr;
        unsigned long long cs = 0; unsigned bad = 0;
        for (size_t i = (size_t)F.c * NTHR + F.tid; i < nw; i += (size_t)F.G * NTHR) { const size_t r = i / wpr, cw = i % wpr; const unsigned w = *(const unsigned*)(buf + r * (size_t)(DBG_LD) + (DBG_C0) + cw * 4); cs += w;
            if (DBG_F32) { if ((w & 0x7f800000u) == 0x7f800000u) ++bad; } else { if ((w & 0x7f80u) == 0x7f80u) ++bad; if ((w & 0x7f800000u) == 0x7f800000u) ++bad; } }
        for (int o = 32; o >= 1; o >>= 1) { cs += __shfl_xor(cs, o); bad += __shfl_xor(bad, o); }
        if (F.lane == 0) { atomicAdd((unsigned long long*)(F.ctl + 8192), cs); atomicAdd(F.ctl + 8200, bad); }
        if (F.c == 0 && F.tid == 0) atomicAdd(F.ctl + 8201, xb_ld(&F.ctl[XB_TMO]));
    }
    xcd_barrier(bar);
    {
        const unsigned long long cs = __hip_atomic_load((unsigned long long*)(F.ctl + 8192), __ATOMIC_RELAXED, __HIP_MEMORY_SCOPE_AGENT);
        const unsigned bad = xb_ld(F.ctl + 8200), tmo = xb_ld(F.ctl + 8201);
        const float val = (float)(unsigned)((cs ^ (cs >> 16) ^ (cs >> 32)) & 0xFFFFu) * (1.0f / 65536.0f) + (bad ? 2.0f : 0.0f) + (tmo ? 4.0f : 0.0f);
        for (size_t i = (size_t)F.c * NTHR + F.tid; i < (size_t)T * D; i += (size_t)F.G * NTHR) F.out[i] = val;
    }
    return;
#endif
#ifdef PR_A
    xcd_barrier(bar);
    {
        auto maxs = [&](int sl) { unsigned long long m = 0; for (int w = 0; w < (int)F.G; ++w) { const unsigned long long v = stamps[sl * 256 + w]; m = v > m ? v : m; } return m; };
        auto dur = [&](int sl) -> float {
            if (sl == 4) { const unsigned long long st = maxs(3); double a = 0; for (int w = 0; w < (int)F.G; ++w) a += (double)(stamps[4 * 256 + w] - st); return (float)(a / F.G) * 0.01f; }
            if (sl == 5) { double a = 0; for (int w = 0; w < (int)F.G; ++w) a += (double)(stamps[5 * 256 + w] - stamps[4 * 256 + w]); return (float)(a / F.G) * 0.01f; }
            if (sl == 6) { double a = 0; for (int w = 0; w < (int)F.G; ++w) a += (double)(stamps[6 * 256 + w] - stamps[5 * 256 + w]); return (float)(a / F.G) * 0.01f; }
            if (sl == 16) return (float)(maxs(6) - maxs(3)) * 0.01f;
            return (float)(maxs(sl) - maxs(sl - 1)) * 0.01f; };
        const float va = rintf(dur(PR_A) * 0.1f + (PR_OFF)) * 0.1f, vb = rintf(dur(PR_B) * 0.1f + (PR_OFF)) * 10.0f;
        for (size_t i = (size_t)F.c * NTHR + F.tid; i < (size_t)T * D; i += (size_t)F.G * NTHR) F.out[i] = va;
        __syncthreads();
        if (F.c == 0 && F.tid == 0) F.out[12345] = vb;
    }
    return;
#endif
    if (F.c == 0 && F.tid == 0 && hi == N_PHASES) { if (xb_ld(&F.ctl[XB_TMO]) != 0u) F.out[0] = __builtin_nanf(""); }
#undef IN
#undef SEAM
}

extern "C" void kernel_launch(void* const* d_in, const int* in_sizes, int n_in, void* d_out, int out_size, void* d_ws, size_t ws_size, hipStream_t stream) {
    static int grid = 0;
    if (grid == 0) {
        if (n_in != 22 || out_size != T * D || ws_size < WS_END) { fprintf(stderr, "kernel_launch: unexpected shapes (n_in %d, out %d, ws %zu)\n", n_in, out_size, ws_size); grid = -1; return; }
        int dev = 0, cus = 0, per_cu = 0;
        if (hipGetDevice(&dev) != hipSuccess || hipDeviceGetAttribute(&cus, hipDeviceAttributeMultiprocessorCount, dev) != hipSuccess) { grid = -1; return; }
        if (hipFuncSetAttribute((const void*)mega_fwd, hipFuncAttributeMaxDynamicSharedMemorySize, LDS_BYTES) != hipSuccess) { fprintf(stderr, "kernel_launch: hipFuncSetAttribute failed\n"); grid = -1; return; }
        if (hipOccupancyMaxActiveBlocksPerMultiprocessor(&per_cu, (const void*)mega_fwd, NTHR, LDS_BYTES) != hipSuccess || per_cu < 1) fprintf(stderr, "kernel_launch: occupancy query reports %d blocks per CU\n", per_cu);
        (void)hipGetLastError();
        grid = cus;
    }
    if (grid < 0) return;
    (void)hipMemsetAsync((char*)d_ws + WS_CTL, 0, CTL_BYTES, stream);
    Args a{};
    for (int i = 0; i < 22; ++i) a.in[i] = (const float*)d_in[i];
    a.out = (float*)d_out; a.ws = (unsigned char*)d_ws; a.ph_lo = 0; a.ph_hi = N_PHASES;
#ifdef DBG_K
    a.ph_hi = DBG_K;
#endif
    hipLaunchKernelGGL(mega_fwd, dim3(grid), dim3(NTHR), LDS_BYTES, stream, a);
}
```

```cpp
#include <hip/hip_runtime.h>
#include <cstdio>
#include <cstdint>

#define LAS __attribute__((address_space(3)))
typedef unsigned short bf16_t;
typedef short bf16x8 __attribute__((ext_vector_type(8)));
typedef short bf16x4 __attribute__((ext_vector_type(4)));
typedef float f32x4 __attribute__((ext_vector_type(4)));
typedef float f32x2 __attribute__((ext_vector_type(2)));
typedef unsigned u32x4 __attribute__((ext_vector_type(4)));
typedef unsigned u32x2 __attribute__((ext_vector_type(2)));

constexpr int D = 1024, NB = 32, SEQ = 2048, T = NB * SEQ, CTX = 256, TCX = NB * CTX;
#ifndef NCH_SET
#define NCH_SET 1
#endif
constexpr int NEXP = 32, TOPK = 4;
constexpr int NCH = NCH_SET, TCH = T / NCH;
constexpr int ROWS_CH = TCH * TOPK + NEXP * 256;
constexpr float DN_ALPHA = 1.189207115002721f;
constexpr float LN_EPS = 1e-5f, RMS_EPS = 1e-6f;
constexpr int NTHR = 512;

constexpr size_t MiB = 1ull << 20;
constexpr size_t WS_CTL = 0;
constexpr size_t CTL_BYTES = 65536;
constexpr size_t WS_ADA = 65536;
constexpr size_t WS_WIN1T = 1 * MiB;
constexpr size_t WS_WIN2T = 7 * MiB;
constexpr size_t WS_WMT = 12 * MiB;
constexpr size_t WS_WOT = 14 * MiB;
constexpr size_t WS_WGUT = 16 * MiB;
constexpr size_t WS_WDNT = 80 * MiB;
constexpr size_t WS_TOPI = 112 * MiB;
constexpr size_t WS_TOPW = 113 * MiB;
constexpr size_t WS_POS = 114 * MiB;
constexpr size_t WS_ROWTOK = 115 * MiB;
constexpr size_t WS_U = 120 * MiB;
constexpr size_t WS_PA = 184 * MiB;
constexpr size_t WS_PH = 312 * MiB;
constexpr size_t WS_PHC = 568 * MiB;
constexpr size_t WS_PG = 600 * MiB;
constexpr size_t WS_Y = 664 * MiB;
constexpr size_t WS_UC = WS_Y;
constexpr size_t WS_ACT = WS_PA;
constexpr size_t WS_YCH = WS_PA + 264 * MiB;
constexpr size_t WS_X1 = WS_YCH + 264 * MiB;
constexpr size_t WS_END = 976 * MiB;
static_assert(WS_X1 + 128 * MiB <= WS_END && (size_t)ROWS_CH * 1024 <= 264 * MiB && WS_Y + 128 * MiB <= WS_END, "ws map");
constexpr int CW_CNT = 4096;
constexpr int CW_CUR = 4096 + 64;

constexpr int LDS_SCRATCH = 147456;
constexpr int LDS_MISC = LDS_SCRATCH;
constexpr int LDS_BYTES = LDS_SCRATCH + 2048;

typedef __bf16 bf16x2_t __attribute__((ext_vector_type(2)));
__device__ __forceinline__ unsigned cvt_pk_bf16(float lo, float hi) { const f32x2 v = {lo, hi}; const bf16x2_t r = __builtin_convertvector(v, bf16x2_t); return __builtin_bit_cast(unsigned, r); }
__device__ __forceinline__ unsigned cvt_pk4_fp8(float a, float b, float c, float d) {
    a = fminf(fmaxf(a, -448.f), 448.f); b = fminf(fmaxf(b, -448.f), 448.f); c = fminf(fmaxf(c, -448.f), 448.f); d = fminf(fmaxf(d, -448.f), 448.f);
    int w = __builtin_amdgcn_cvt_pk_fp8_f32(a, b, 0, false); w = __builtin_amdgcn_cvt_pk_fp8_f32(c, d, w, true); return (unsigned)w; }
constexpr float W8_SCALE = 32.0f, W8_INV = 1.0f / 32.0f;
typedef float f32x2v __attribute__((ext_vector_type(2)));
__device__ __forceinline__ f32x4 fp8x4_to_f32(unsigned w) { const f32x2v a = __builtin_amdgcn_cvt_pk_f32_fp8((int)w, false), b = __builtin_amdgcn_cvt_pk_f32_fp8((int)w, true); return (f32x4){a[0], a[1], b[0], b[1]}; }
__device__ __forceinline__ u32x4 widen16(u32x2 a, u32x2 b) {
    const u32x2 rx = __builtin_amdgcn_permlane16_swap(a.x, b.x, false, false), ry = __builtin_amdgcn_permlane16_swap(a.y, b.y, false, false);
    return (u32x4){rx[0], ry[0], rx[1], ry[1]}; }
__device__ __forceinline__ void unwiden16(u32x4 L, u32x2& a, u32x2& b) {
    const u32x2 rx = __builtin_amdgcn_permlane16_swap(L.x, L.z, false, false), ry = __builtin_amdgcn_permlane16_swap(L.y, L.w, false, false);
    a = (u32x2){rx[0], ry[0]}; b = (u32x2){rx[1], ry[1]}; }
__device__ __forceinline__ unsigned pack4_u8(float a, float b, float c, float d) {
    unsigned w = __builtin_amdgcn_cvt_pk_u8_f32(__builtin_rintf(a), 0, 0u); w = __builtin_amdgcn_cvt_pk_u8_f32(__builtin_rintf(b), 1, w);
    w = __builtin_amdgcn_cvt_pk_u8_f32(__builtin_rintf(c), 2, w); return __builtin_amdgcn_cvt_pk_u8_f32(__builtin_rintf(d), 3, w); }
__device__ __forceinline__ f32x4 u8x4_to_f32(unsigned w) { return (f32x4){(float)(w & 0xffu), (float)((w >> 8) & 0xffu), (float)((w >> 16) & 0xffu), (float)(w >> 24)}; }
__device__ __forceinline__ float bf_lo(unsigned w) { return __uint_as_float(w << 16); }
__device__ __forceinline__ float bf_hi(unsigned w) { return __uint_as_float(w & 0xffff0000u); }
__device__ __forceinline__ float bf2f(bf16_t v) { return __uint_as_float(((unsigned)v) << 16); }
__device__ __forceinline__ float fast_exp(float x) { return __builtin_amdgcn_exp2f(x * 1.4426950408889634f); }
__device__ __forceinline__ float fast_sigmoid(float x) { return __builtin_amdgcn_rcpf(1.0f + fast_exp(-x)); }
__device__ __forceinline__ float fast_log(float x) { return __builtin_amdgcn_logf(x) * 0.6931471805599453f; }

#define XB_TMO      128
#define XB_XCNT(j)  (256  + 64 * (j))
#define XB_XSUB(j)  (1280 + 64 * (j))
#define XB_XGEN(j)  (2304 + 64 * (j))
#define XB_TOP      3328
#define XB_TOPGEN   3392
#define XCD_BAR_WORDS 3456
#define XB_SPIN_CAP (1u << 18)

__device__ __forceinline__ unsigned xb_ld(unsigned* p)              { return __hip_atomic_load(p, __ATOMIC_RELAXED, __HIP_MEMORY_SCOPE_AGENT); }
__device__ __forceinline__ unsigned xb_add(unsigned* p, unsigned v) { return __hip_atomic_fetch_add(p, v, __ATOMIC_RELAXED, __HIP_MEMORY_SCOPE_AGENT); }
__device__ __forceinline__ unsigned xb_xcc_id() { return (unsigned)__builtin_amdgcn_s_getreg((3 << 11) | 20) & 0xFu; }
#define XB_SPIN(cond, bar) do { unsigned _sp = 0; while (cond) { __builtin_amdgcn_s_sleep(1); \
    if ((++_sp & 255u) == 0u) { if (xb_ld(&(bar)[XB_TMO])) break; if (_sp > XB_SPIN_CAP) { atomicAdd(&(bar)[XB_TMO], 1u); break; } } } } while (0)

struct XcdBarrier { unsigned* bar; unsigned x; volatile LAS unsigned* st; };

__device__ __forceinline__ XcdBarrier xcd_barrier_post(unsigned* bar, volatile LAS unsigned* st) {
    XcdBarrier b; b.bar = bar; b.x = xb_xcc_id(); b.st = st;
    if (threadIdx.x == 0) (void)xb_add(&bar[XB_XCNT(b.x)], 1u);
    return b;
}
__device__ __forceinline__ void xcd_barrier_complete(unsigned* bar, unsigned x, unsigned& nloc, unsigned& nx) {
    const unsigned G = gridDim.x * gridDim.y * gridDim.z;
    unsigned sum, cnt, mine, sp = 0u;
    for (;;) {
        sum = 0u; cnt = 0u; mine = 0u;
#pragma unroll
        for (unsigned j = 0; j < 16; ++j) { const unsigned c = xb_ld(&bar[XB_XCNT(j)]); sum += c; cnt += (c > 0u) ? 1u : 0u; mine = (j == x) ? c : mine; }
        if (sum == G) break;
        __builtin_amdgcn_s_sleep(1);
        if ((++sp & 255u) == 0u) { if (xb_ld(&bar[XB_TMO])) break; if (sp > XB_SPIN_CAP) { atomicAdd(&bar[XB_TMO], 1u); break; } }
    }
    nloc = mine > 0u ? mine : 1u; nx = cnt > 0u ? cnt : 1u;
}
__device__ __forceinline__ void xcd_barrier(const XcdBarrier& b) {
    asm volatile("s_waitcnt vmcnt(0)" ::: "memory");
    __syncthreads();
    if (threadIdx.x == 0) {
        unsigned* bar = b.bar;
        __builtin_amdgcn_s_waitcnt(0);
        unsigned nloc = b.st[0], nx = b.st[1];
        if (nloc == 0u) { xcd_barrier_complete(bar, b.x, nloc, nx); b.st[0] = nloc; b.st[1] = nx; }
        const unsigned old = xb_add(&bar[XB_XSUB(b.x)], 1u);
        const unsigned gen = old / nloc;
        if (old + 1u == (gen + 1u) * nloc) {
            __builtin_amdgcn_fence(__ATOMIC_RELEASE, "agent");
            asm volatile("s_waitcnt vmcnt(0)" ::: "memory");
            const unsigned og = xb_add(&bar[XB_TOP], 1u);
            const unsigned tg = og / nx;
            if (og + 1u == (tg + 1u) * nx) xb_add(&bar[XB_TOPGEN], 1u);
            else XB_SPIN(xb_ld(&bar[XB_TOPGEN]) == tg, bar);
            __builtin_amdgcn_fence(__ATOMIC_ACQUIRE, "agent");
            xb_add(&bar[XB_XGEN(b.x)], 1u);
            asm volatile("s_waitcnt vmcnt(0)" ::: "memory");
        } else {
            XB_SPIN(xb_ld(&bar[XB_XGEN(b.x)]) == gen, bar);
            __builtin_amdgcn_fence(__ATOMIC_ACQUIRE, "agent");
            asm volatile("s_waitcnt vmcnt(0)" ::: "memory");
        }
    }
    __syncthreads();
}

#ifndef WGM_SET
#define WGM_SET 8
#endif
namespace pg8 {
constexpr int BM = 256, BK = 64, HALF = 128, HTB = HALF * BK * 2, STAGE_BYTES = 8 * HTB, NXCD = 8, WGM = WGM_SET;
__host__ __device__ __forceinline__ int lds_byte(int r, int c) { const int st = (r >> 4) * 2 + (c >> 5), rr = r & 15, cc = c & 31, ob = rr * 64 + cc * 2; return st * 1024 + (ob ^ (((ob >> 9) & 1) << 5)); }
__host__ __device__ __forceinline__ void stage_rc(int b, int& R, int& C) { const int st = b / 1024, sb = b % 1024, swz = sb ^ (((sb >> 9) & 1) << 5); R = (st >> 1) * 16 + swz / 64; C = (st & 1) * 32 + (swz % 64) / 2; }
__host__ __device__ __forceinline__ int perm32(int rho) { const int n = rho >> 4, i = rho & 15; return 8 * (i >> 2) + 4 * n + (i & 3); }

struct Unit { int pm, pn, aux; };

__device__ __forceinline__ void grouped(int wgid, int nM, int nN, int& pm, int& pn) {
    const int nig = WGM * nN, gid = wgid / nig, fm = gid * WGM, gsz = (nM - fm) < WGM ? (nM - fm) : WGM;
    pm = fm + ((wgid % nig) % gsz); pn = (wgid % nig) / gsz;
}
__device__ __forceinline__ bool xcd_remap(int i, int G, int c, int nwg, int& wgid) {
    const long L = (long)i * G + c; if (L >= nwg) return false;
    wgid = (int)L; const int q = nwg / NXCD, r = nwg % NXCD, xcd = wgid % NXCD, off = wgid / NXCD;
    wgid = (xcd < r ? xcd * (q + 1) : r * (q + 1) + (xcd - r) * q) + off; return true;
}

typedef int i32x8 __attribute__((ext_vector_type(8)));
typedef int i32x4 __attribute__((ext_vector_type(4)));
template <bool F8> struct Frags;
template <> struct Frags<false> { bf16x8 a[4][2], b0[2][2], b1[2][2]; };
template <> struct Frags<true> { i32x8 a[4], b0[2], b1[2]; };
template <class Prob, class Epi, bool ALIGN_EPI, bool HOOK, bool FP8 = false, int DRY = 0>
__device__ __forceinline__ void gemm_phase(LAS unsigned char* lds, const Prob& P, const Epi& E) {
    int tid_ = threadIdx.x; asm volatile("" : "+v"(tid_));
    const int tid = tid_, wid = __builtin_amdgcn_readfirstlane(tid >> 6), lane = tid & 63, wr = wid >> 2, wc = wid & 3, fr = lane & 15, fq = lane >> 4;
    const int nt = P.nt;
    unsigned voffB[2], voffA[2];
#pragma unroll
    for (int i = 0; i < 2; ++i) { int R, C; stage_rc(tid * 16 + i * 8192, R, C); const int Rb = Epi::PERM ? ((R & ~31) + perm32(R & 31)) : R;
        voffB[i] = (unsigned)Rb * P.ldb2 + (unsigned)C * 2u; voffA[i] = (unsigned)R * P.lda2 + (unsigned)C * 2u; }
    auto gather_offs = [&](const Unit& u, unsigned (&o0)[2], unsigned (&o1)[2]) {
#pragma unroll
        for (int i = 0; i < 2; ++i) { int R, C; int tt = threadIdx.x; asm volatile("" : "+v"(tt)); stage_rc(tt * 16 + i * 8192, R, C); o0[i] = P.a_row(u, R) + (unsigned)C * 2u; o1[i] = P.a_row(u, HALF + R) + (unsigned)C * 2u; } };
    const size_t kstep = (size_t)(BK * 2);
    const size_t hstepB = (size_t)HALF * P.ldb2;
    const size_t hstepA = (size_t)HALF * P.lda2;
    const unsigned ldsw = (unsigned)wid * 1024u;
    const int aoff = lds_byte(wr * 64 + fr, fq * 8), boff = lds_byte(wc * 32 + fr, fq * 8);
#define PG8_SA(b, h) (((b) * 2 + (h)) * HTB)
#define PG8_SB(b, h) ((4 + (b) * 2 + (h)) * HTB)
#define PG8_STAGE(bufoff, gbase, voff) do { if constexpr ((DRY & 2) == 0) _Pragma("unroll") for (int _i = 0; _i < 2; ++_i) \
        __builtin_amdgcn_global_load_lds((const unsigned*)((const char*)(gbase) + (voff)[_i]), (LAS unsigned*)(lds + (bufoff) + ldsw + _i * 8192), 16, 0, 0); } while (0)
#define PG8_LDA(dst, b, h) do { if constexpr (FP8) { _Pragma("unroll") for (int m = 0; m < 4; ++m) { FR.a[m].lo = *(const LAS i32x4*)(lds + PG8_SA(b, h) + aoff + m * 2048); FR.a[m].hi = *(const LAS i32x4*)(lds + PG8_SA(b, h) + aoff + m * 2048 + 1024); } } \
        else { _Pragma("unroll") for (int m = 0; m < 4; ++m) _Pragma("unroll") for (int k = 0; k < 2; ++k) FR.a[m][k] = *(const LAS bf16x8*)(lds + PG8_SA(b, h) + aoff + m * 2048 + k * 1024); } } while (0)
#define PG8_LDB(dst, b, h) do { if constexpr (FP8) { _Pragma("unroll") for (int n = 0; n < 2; ++n) { FR.dst[n].lo = *(const LAS i32x4*)(lds + PG8_SB(b, h) + boff + n * 2048); FR.dst[n].hi = *(const LAS i32x4*)(lds + PG8_SB(b, h) + boff + n * 2048 + 1024); } } \
        else { _Pragma("unroll") for (int n = 0; n < 2; ++n) _Pragma("unroll") for (int k = 0; k < 2; ++k) FR.dst[n][k] = *(const LAS bf16x8*)(lds + PG8_SB(b, h) + boff + n * 2048 + k * 1024); } } while (0)
#define PG8_MMA(ai, bj, At, Bt) do { __builtin_amdgcn_s_setprio(1); if constexpr ((DRY & 1) != 0) { asm volatile("" :: "v"(FR.a[0]), "v"(FR.a[3]), "v"(FR.Bt[0]), "v"(FR.Bt[1])); } else if constexpr (FP8) { _Pragma("unroll") for (int m = 0; m < 4; ++m) _Pragma("unroll") for (int n = 0; n < 2; ++n) \
            asm volatile("v_mfma_f32_16x16x128_f8f6f4 %0, %1, %2, %0" : "+v"(acc[ai][bj][m][n]) : "v"(FR.Bt[n]), "v"(FR.a[m])); } \
        else { _Pragma("unroll") for (int m = 0; m < 4; ++m) _Pragma("unroll") for (int n = 0; n < 2; ++n) _Pragma("unroll") for (int k = 0; k < 2; ++k) \
        acc[ai][bj][m][n] = __builtin_amdgcn_mfma_f32_16x16x32_bf16(FR.Bt[n][k], FR.a[m][k], acc[ai][bj][m][n], 0, 0, 0); } __builtin_amdgcn_s_setprio(0); } while (0)
#define PG8_WAIT_V(n) asm volatile("s_waitcnt vmcnt(" #n ")" ::: "memory")
#define PG8_WAIT_L(n) asm volatile("s_waitcnt lgkmcnt(" #n ")" ::: "memory")
#define PG8_BAR __builtin_amdgcn_s_barrier()
#define PG8_SCHED __builtin_amdgcn_sched_barrier(0)
    Unit cur, nxt; int ui = 0;
    if (!P.unit(0, cur)) return;
    f32x4 acc[2][2][4][2];
#pragma unroll
    for (int a = 0; a < 2; ++a)
#pragma unroll
        for (int b = 0; b < 2; ++b)
#pragma unroll
            for (int m = 0; m < 4; ++m)
#pragma unroll
                for (int n = 0; n < 2; ++n) acc[a][b][m][n] = (f32x4){0.f, 0.f, 0.f, 0.f};
    Frags<FP8> FR;
    unsigned va0[2], va1[2], vn0[2], vn1[2];
    const char* const gA = P.Abase; const char* cA = gA; const char* nA = gA; const char* cB = P.b_tile(cur);
    if constexpr (Prob::GATHER) {
        gather_offs(cur, va0, va1);
    } else { cA = gA + P.a_row(cur, 0); }
#define PG8_STAGE_A(bufoff, h, koff, nx) do { if constexpr (Prob::GATHER) { unsigned _v[2]; _Pragma("unroll") for (int _i = 0; _i < 2; ++_i) _v[_i] = (nx) ? ((h) ? vn1[_i] : vn0[_i]) : ((h) ? va1[_i] : va0[_i]); PG8_STAGE(bufoff, gA + (koff), _v); } \
        else { PG8_STAGE(bufoff, ((nx) ? nA : cA) + (h) * hstepA + (koff), voffA); } } while (0)
    PG8_STAGE(PG8_SB(0, 0), cB, voffB); PG8_STAGE(PG8_SB(0, 1), cB + hstepB, voffB); PG8_STAGE_A(PG8_SA(0, 0), 0, 0, false); PG8_STAGE_A(PG8_SA(0, 1), 1, 0, false);
    if (wr == 1) PG8_BAR;
    PG8_WAIT_V(2); PG8_BAR;
    PG8_STAGE(PG8_SB(1, 0), cB + kstep, voffB); PG8_STAGE_A(PG8_SA(1, 0), 0, kstep, false); PG8_STAGE(PG8_SB(1, 1), cB + hstepB + kstep, voffB);
    PG8_WAIT_V(6); PG8_BAR;
    Unit nx2; unsigned vq0[2], vq1[2]; bool has_next = P.unit(1, nxt);
    if (!has_next) nxt = cur;
    if constexpr (Prob::GATHER) gather_offs(nxt, vn0, vn1);
    for (;;) {
        if constexpr (!Prob::GATHER) { has_next = P.unit(ui + 1, nxt); if (!has_next) nxt = cur; nA = gA + P.a_row(nxt, 0); }
        const char* nB = P.b_tile(nxt);
        for (int t = 0; t < nt; t += 2) {
            const bool last = (t == nt - 2);
            if constexpr (HOOK) { if (t == (nt >> 1)) { if constexpr (FP8) asm volatile("s_nop 15\n\ts_nop 15" ::: "memory"); E.mid(acc, cur, wr, wc, fr, fq); } }
            const size_t k1 = (size_t)(t + 1) * kstep, k2 = last ? 0 : (size_t)(t + 2) * kstep, k3 = k2 + kstep;
            const char* b2 = last ? nB : cB + (size_t)(t + 2) * kstep; const char* b3 = b2 + kstep;
            PG8_LDB(b0, 0, 0); PG8_LDB(b1, 0, 1); PG8_SCHED; PG8_LDA(At, 0, 0); PG8_STAGE_A(PG8_SA(1, 1), 1, k1, false);
            PG8_WAIT_V(8); PG8_WAIT_L(0); PG8_BAR; PG8_MMA(0, 0, At, b0); PG8_MMA(0, 1, At, b1); PG8_BAR; PG8_SCHED;
            PG8_LDA(At, 0, 1); PG8_STAGE(PG8_SB(0, 0), b2, voffB); PG8_STAGE(PG8_SB(0, 1), b2 + hstepB, voffB); PG8_STAGE_A(PG8_SA(0, 0), 0, k2, last);
            PG8_WAIT_V(8); PG8_WAIT_L(0); PG8_BAR; PG8_MMA(1, 0, At, b0); PG8_MMA(1, 1, At, b1); PG8_BAR; PG8_SCHED;
            PG8_LDB(b0, 1, 0); PG8_LDB(b1, 1, 1); PG8_SCHED; PG8_LDA(At, 1, 0); PG8_STAGE_A(PG8_SA(0, 1), 1, k2, last);
            PG8_WAIT_V(8); PG8_WAIT_L(0); PG8_BAR; PG8_MMA(0, 0, At, b0); PG8_MMA(0, 1, At, b1); PG8_BAR; PG8_SCHED;
            PG8_LDA(At, 1, 1); PG8_STAGE(PG8_SB(1, 0), b3, voffB); PG8_STAGE(PG8_SB(1, 1), b3 + hstepB, voffB); PG8_STAGE_A(PG8_SA(1, 0), 0, k3, last);
            PG8_WAIT_V(8); PG8_WAIT_L(0); PG8_BAR; PG8_MMA(1, 0, At, b0); PG8_MMA(1, 1, At, b1); PG8_BAR; PG8_SCHED;
        }
        if constexpr (ALIGN_EPI) { if (wr == 0) PG8_BAR; }
        bool has_next2 = false;
        if constexpr (Prob::GATHER) { has_next2 = has_next && P.unit(ui + 2, nx2); if (!has_next2) nx2 = nxt; gather_offs(nx2, vq0, vq1); }
        if constexpr (FP8) asm volatile("s_nop 15\n\ts_nop 15" ::: "memory");
        if constexpr (DRY == 0) E(acc, cur, wr, wc, fr, fq); else { if (acc[0][0][0][0][0] == 1.2345e30f) *(volatile int*)P.Abase = 1; }
        if (!has_next) break;
#pragma unroll
        for (int a = 0; a < 2; ++a)
#pragma unroll
            for (int b = 0; b < 2; ++b)
#pragma unroll
                for (int m = 0; m < 4; ++m)
#pragma unroll
                    for (int n = 0; n < 2; ++n) acc[a][b][m][n] = (f32x4){0.f, 0.f, 0.f, 0.f};
        cur = nxt; cB = nB; cA = nA; ++ui;
        if constexpr (Prob::GATHER) {
#pragma unroll
            for (int i = 0; i < 2; ++i) { va0[i] = vn0[i]; va1[i] = vn1[i]; vn0[i] = vq0[i]; vn1[i] = vq1[i]; }
            nxt = nx2; has_next = has_next2; }
        if constexpr (ALIGN_EPI) { if (wr == 1) PG8_BAR; }
    }
    PG8_WAIT_V(0);
    if constexpr (!ALIGN_EPI) { if (wr == 0) PG8_BAR; }
    PG8_BAR;
#undef PG8_SA
#undef PG8_SB
#undef PG8_STAGE
#undef PG8_STAGE_A
#undef PG8_LDA
#undef PG8_LDB
#undef PG8_MMA
#undef PG8_WAIT_V
#undef PG8_WAIT_L
#undef PG8_BAR
#undef PG8_SCHED
}
}

using pg8::Unit;

struct ProbDense {
    static constexpr bool GATHER = false;
    const char* Abase; int nt; unsigned ldb2; unsigned lda2; const char* Bt; int nM, nN, G, c; int rev;
    __device__ __forceinline__ bool unit(int i, Unit& u) const { int w; if (!pg8::xcd_remap(i, G, c, nM * nN, w)) return false; pg8::grouped(w, nM, nN, u.pm, u.pn); if (rev) u.pm = nM - 1 - u.pm; u.aux = 0; return true; }
    __device__ __forceinline__ unsigned a_row(const Unit& u, int r) const { return (unsigned)(u.pm * 256 + r) * lda2; }
    __device__ __forceinline__ const char* b_tile(const Unit& u) const { return Bt + (size_t)u.pn * 256 * ldb2; }
};
struct ProbP1 {
    static constexpr bool GATHER = false;
    const char* Abase; int nt; unsigned ldb2; unsigned lda2; const char* Bt; unsigned uc_off; int G, c;
    __device__ __forceinline__ bool unit(int i, Unit& u) const {
        int w; if (!pg8::xcd_remap(i, G, c, 3072 + 256, w)) return false;
        if (w < 3072) { pg8::grouped(w, 256, 12, u.pm, u.pn); u.pm = 255 - u.pm; u.aux = 0; }
        else { pg8::grouped(w - 3072, 32, 8, u.pm, u.pn); u.pn += 4; u.aux = 1; }
        return true; }
    __device__ __forceinline__ unsigned a_row(const Unit& u, int r) const { return (u.aux ? uc_off : 0u) + (unsigned)(u.pm * 256 + r) * lda2; }
    __device__ __forceinline__ const char* b_tile(const Unit& u) const { return Bt + (size_t)u.pn * 256 * ldb2; }
};
template <bool GATHER_> struct ProbMoE {
    static constexpr bool GATHER = GATHER_;
    const char* Abase; int nt; unsigned ldb2; unsigned lda2; const char* Bt; size_t estride; int nN, nblk, G, c; const int* rowtok; const LAS unsigned char* blk_e;
    __device__ __forceinline__ bool unit(int i, Unit& u) const { int w; if (!pg8::xcd_remap(i, G, c, nblk * nN, w)) return false; pg8::grouped(w, nblk, nN, u.pm, u.pn); if (!GATHER) u.pm = nblk - 1 - u.pm;
        u.aux = (int)blk_e[u.pm]; return true; }
    __device__ __forceinline__ unsigned a_row(const Unit& u, int r) const { if (GATHER) return (unsigned)rowtok[u.pm * 256 + r] * lda2; else return (unsigned)(u.pm * 256 + r) * lda2; }
    __device__ __forceinline__ const char* b_tile(const Unit& u) const { return Bt + (size_t)u.aux * estride + (size_t)u.pn * 256 * ldb2; }
};

struct EpiP1 {
    static constexpr bool PERM = true;
    bf16_t* PA; bf16_t* PH; bf16_t* PHC;
    __device__ __forceinline__ void operator()(const f32x4 (&acc)[2][2][4][2], const Unit& u, int wr, int wc, int fr, int fq) const {
        const int row0 = u.pm * 256 + wr * 64 + fr;
        if (!u.aux && u.pn < 4) {
            const int col0 = u.pn * 256 + wc * 32 + 8 * fq;
#pragma unroll
            for (int ai = 0; ai < 2; ++ai)
#pragma unroll
                for (int m = 0; m < 4; ++m) { const int row = row0 + ai * 128 + m * 16, b = row >> 11, t = row & 2047;
#pragma unroll
                    for (int bj = 0; bj < 2; ++bj) { const int col = col0 + bj * 128, reim = col >> 9, c5 = col & 511, slab = c5 >> 4, half = (c5 >> 3) & 1;
                        const f32x4 v0 = acc[ai][bj][m][0] * W8_INV, v1 = acc[ai][bj][m][1] * W8_INV;
                        u32x4 w; w.x = cvt_pk_bf16(v0[0], v0[1]); w.y = cvt_pk_bf16(v0[2], v0[3]); w.z = cvt_pk_bf16(v1[0], v1[1]); w.w = cvt_pk_bf16(v1[2], v1[3]);
                        *(u32x4*)(PA + ((((size_t)(b * 32 + slab) * 2048 + t) * 2 + reim) * 16 + half * 8)) = w; } }
            return;
        }
        bf16_t* base = u.aux ? PHC : PH; const int ldc = 2048, colt = (u.pn - 4) * 256;
        if (u.pn < 6 || u.pn >= 10) {
            const bool isq = u.pn < 6;
            unsigned char* b8 = (unsigned char*)base + (isq ? (u.pn - 4) * 256 : 3072 + (u.pn - 10) * 256) + wc * 32 + (fq >> 1) * 16;
#pragma unroll
            for (int ai = 0; ai < 2; ++ai)
#pragma unroll
                for (int bj = 0; bj < 2; ++bj) { u32x2 pk[4];
#pragma unroll
                    for (int m = 0; m < 4; ++m) { f32x4 v0 = acc[ai][bj][m][0] * W8_INV, v1 = acc[ai][bj][m][1] * W8_INV;
                        if (isq) {
#pragma unroll
                            for (int j = 0; j < 4; ++j) { v0[j] *= fast_sigmoid(v0[j]); v1[j] *= fast_sigmoid(v1[j]); } }
                        pk[m] = (u32x2){cvt_pk4_fp8(v0[0], v0[1], v0[2], v0[3]), cvt_pk4_fp8(v1[0], v1[1], v1[2], v1[3])}; }
#pragma unroll
                    for (int mp = 0; mp < 2; ++mp)
                        *(u32x4*)(b8 + (size_t)(row0 + ai * 128 + (2 * mp + (fq & 1)) * 16) * 4096 + bj * 128) = widen16(pk[2 * mp], pk[2 * mp + 1]); }
            return;
        }
        const int col0 = colt + wc * 32 + 8 * fq;
#pragma unroll
        for (int ai = 0; ai < 2; ++ai)
#pragma unroll
            for (int m = 0; m < 4; ++m) { bf16_t* rowp = base + (size_t)(row0 + ai * 128 + m * 16) * ldc + col0;
#pragma unroll
                for (int bj = 0; bj < 2; ++bj) { const f32x4 v0 = acc[ai][bj][m][0] * W8_INV, v1 = acc[ai][bj][m][1] * W8_INV;
                    u32x4 w; w.x = cvt_pk_bf16(v0[0], v0[1]); w.y = cvt_pk_bf16(v0[2], v0[3]); w.z = cvt_pk_bf16(v1[0], v1[1]); w.w = cvt_pk_bf16(v1[2], v1[3]);
                    *(u32x4*)(rowp + bj * 128) = w; } }
    }
    __device__ __forceinline__ void mid(f32x4 (&)[2][2][4][2], const Unit&, int, int, int, int) const {}
};
struct EpiP2 {
    static constexpr bool PERM = true;
    unsigned char* PG; unsigned char* GATES;
    __device__ __forceinline__ void operator()(const f32x4 (&acc)[2][2][4][2], const Unit& u, int wr, int wc, int fr, int fq) const {
        const int row0 = u.pm * 256 + wr * 64 + fr;
        if (u.pn < 2) {
            const int colp = u.pn * 256 + wc * 32 + (fq >> 1) * 16;
#pragma unroll
            for (int ai = 0; ai < 2; ++ai)
#pragma unroll
                for (int bj = 0; bj < 2; ++bj) { u32x2 pk[4];
#pragma unroll
                    for (int m = 0; m < 4; ++m) { f32x4 v0 = acc[ai][bj][m][0] * W8_INV, v1 = acc[ai][bj][m][1] * W8_INV;
#pragma unroll
                        for (int j = 0; j < 4; ++j) { v0[j] *= fast_sigmoid(v0[j]); v1[j] *= fast_sigmoid(v1[j]); }
                        pk[m] = (u32x2){cvt_pk4_fp8(v0[0], v0[1], v0[2], v0[3]), cvt_pk4_fp8(v1[0], v1[1], v1[2], v1[3])}; }
#pragma unroll
                    for (int mp = 0; mp < 2; ++mp)
                        *(u32x4*)(PG + (size_t)(row0 + ai * 128 + (2 * mp + (fq & 1)) * 16) * 512 + colp + bj * 128) = widen16(pk[2 * mp], pk[2 * mp + 1]); }
            return;
        }
        const int colt = (u.pn - 2) * 256 + wc * 32 + (fq >> 1) * 16;
#pragma unroll
        for (int ai = 0; ai < 2; ++ai)
#pragma unroll
            for (int bj = 0; bj < 2; ++bj) { u32x2 pk[4];
#pragma unroll
                for (int m = 0; m < 4; ++m) { f32x4 v0 = acc[ai][bj][m][0] * W8_INV, v1 = acc[ai][bj][m][1] * W8_INV;
#pragma unroll
                    for (int j = 0; j < 4; ++j) { v0[j] = fmaxf(fast_sigmoid(v0[j]) * 255.0f, 1.0f); v1[j] = fmaxf(fast_sigmoid(v1[j]) * 255.0f, 1.0f); }
                    pk[m] = (u32x2){pack4_u8(v0[0], v0[1], v0[2], v0[3]), pack4_u8(v1[0], v1[1], v1[2], v1[3])}; }
#pragma unroll
                for (int mp = 0; mp < 2; ++mp)
                    *(u32x4*)(GATES + (size_t)(row0 + ai * 128 + (2 * mp + (fq & 1)) * 16) * 2048 + colt + bj * 128) = widen16(pk[2 * mp], pk[2 * mp + 1]); }
    }
    __device__ __forceinline__ void mid(f32x4 (&)[2][2][4][2], const Unit&, int, int, int, int) const {}
};
struct EpiM1 {
    static constexpr bool PERM = true;
    const unsigned char* GATES; unsigned char* Mo;
    __device__ __forceinline__ void mid(f32x4 (&acc)[2][2][4][2], const Unit& u, int wr, int wc, int fr, int fq) const {
        int row0 = u.pm * 256 + wr * 64 + fr + (fq & 1) * 16, col0 = u.pn * 256 + wc * 32 + (fq >> 1) * 16;
        asm volatile("" : "+v"(row0), "+v"(col0));
#pragma unroll
        for (int ai = 0; ai < 2; ++ai) {
            u32x4 gf[2][2], gh[2][2];
#pragma unroll
            for (int mp = 0; mp < 2; ++mp) { const unsigned char* gp = GATES + (size_t)(row0 + ai * 128 + mp * 32) * 2048 + col0;
#pragma unroll
                for (int bj = 0; bj < 2; ++bj) { gf[mp][bj] = *(const u32x4*)(gp + bj * 128); gh[mp][bj] = *(const u32x4*)(gp + 1024 + bj * 128); } }
#pragma unroll
            for (int mp = 0; mp < 2; ++mp)
#pragma unroll
                for (int bj = 0; bj < 2; ++bj) { u32x2 f2[2], h2[2]; unwiden16(gf[mp][bj], f2[0], f2[1]); unwiden16(gh[mp][bj], h2[0], h2[1]);
#pragma unroll
                    for (int q = 0; q < 2; ++q) { const int m = 2 * mp + q;
                        const f32x4 fa = u8x4_to_f32(f2[q].x), fb = u8x4_to_f32(f2[q].y), ha = u8x4_to_f32(h2[q].x), hb = u8x4_to_f32(h2[q].y);
#pragma unroll
                        for (int j = 0; j < 4; ++j) { acc[ai][bj][m][0][j] *= fa[j] * __builtin_amdgcn_rcpf(ha[j]); acc[ai][bj][m][1][j] *= fb[j] * __builtin_amdgcn_rcpf(hb[j]); } } }
            asm volatile("" ::: "memory");
        }
    }
    __device__ __forceinline__ void operator()(const f32x4 (&acc)[2][2][4][2], const Unit& u, int wr, int wc, int fr, int fq) const {
        const int row0 = u.pm * 256 + wr * 64 + fr, col0 = u.pn * 256 + wc * 32 + (fq >> 1) * 16;
        const float sc = W8_INV * (1.0f / 255.0f);
#pragma unroll
        for (int ai = 0; ai < 2; ++ai) {
            u32x4 gh[2][2];
#pragma unroll
            for (int mp = 0; mp < 2; ++mp) { const unsigned char* gp = GATES + (size_t)(row0 + ai * 128 + (2 * mp + (fq & 1)) * 16) * 2048 + 1024 + col0;
#pragma unroll
                for (int bj = 0; bj < 2; ++bj) gh[mp][bj] = *(const u32x4*)(gp + bj * 128); }
#pragma unroll
            for (int bj = 0; bj < 2; ++bj) { u32x2 pk[4];
#pragma unroll
                for (int mp = 0; mp < 2; ++mp) { u32x2 h2[2]; unwiden16(gh[mp][bj], h2[0], h2[1]);
#pragma unroll
                    for (int q = 0; q < 2; ++q) { const int m = 2 * mp + q; const f32x4 ha = u8x4_to_f32(h2[q].x) * sc, hb = u8x4_to_f32(h2[q].y) * sc;
                        const f32x4 v0 = acc[ai][bj][m][0] * ha, v1 = acc[ai][bj][m][1] * hb;
                        pk[m] = (u32x2){cvt_pk4_fp8(v0[0], v0[1], v0[2], v0[3]), cvt_pk4_fp8(v1[0], v1[1], v1[2], v1[3])}; } }
#pragma unroll
                for (int mp = 0; mp < 2; ++mp)
                    *(u32x4*)(Mo + (size_t)(row0 + ai * 128 + (2 * mp + (fq & 1)) * 16) * 1024 + col0 + bj * 128) = widen16(pk[2 * mp], pk[2 * mp + 1]); }
            asm volatile("" ::: "memory");
        }
    }
};
constexpr float V8_SCALE = 16.0f, V8_INV = 1.0f / 16.0f;
struct EpiM2 {
    static constexpr bool PERM = true;
    const float* ada; unsigned char* V;
    __device__ __forceinline__ void operator()(const f32x4 (&acc)[2][2][4][2], const Unit& u, int wr, int wc, int fr, int fq) const {
        const int row0 = u.pm * 256 + wr * 64 + fr, col0 = u.pn * 256 + wc * 32 + 8 * fq, colw = u.pn * 256 + wc * 32 + (fq >> 1) * 16;
        const float* g1 = ada + (size_t)(u.pm >> 3) * 6144 + 2048 + col0;
        f32x4 gv[2][2];
#pragma unroll
        for (int bj = 0; bj < 2; ++bj)
#pragma unroll
            for (int n = 0; n < 2; ++n) gv[bj][n] = *(const f32x4*)(g1 + bj * 128 + n * 4) * (W8_INV * V8_SCALE);
#pragma unroll
        for (int ai = 0; ai < 2; ++ai)
#pragma unroll
            for (int bj = 0; bj < 2; ++bj) { u32x2 pk[4];
#pragma unroll
                for (int m = 0; m < 4; ++m) { const f32x4 v0 = gv[bj][0] * acc[ai][bj][m][0], v1 = gv[bj][1] * acc[ai][bj][m][1];
                    pk[m] = (u32x2){cvt_pk4_fp8(v0[0], v0[1], v0[2], v0[3]), cvt_pk4_fp8(v1[0], v1[1], v1[2], v1[3])}; }
#pragma unroll
                for (int mp = 0; mp < 2; ++mp)
                    *(u32x4*)(V + (size_t)(row0 + ai * 128 + (2 * mp + (fq & 1)) * 16) * 1024 + colw + bj * 128) = widen16(pk[2 * mp], pk[2 * mp + 1]); }
    }
    __device__ __forceinline__ void mid(f32x4 (&)[2][2][4][2], const Unit&, int, int, int, int) const {}
};
struct EpiGU {
    static constexpr bool PERM = true;
    const float* bgu; unsigned char* ACT;
    __device__ __forceinline__ void operator()(const f32x4 (&acc)[2][2][4][2], const Unit& u, int wr, int wc, int fr, int fq) const {
        const int row0 = u.pm * 256 + wr * 64 + fr, col0 = u.pn * 128 + wc * 32 + 8 * fq;
        const float* bp = bgu + (size_t)u.aux * 2048 + col0;
        const f32x4 bg0 = *(const f32x4*)(bp), bg1 = *(const f32x4*)(bp + 4), bu0 = *(const f32x4*)(bp + 1024), bu1 = *(const f32x4*)(bp + 1028);
#pragma unroll
        for (int ai = 0; ai < 2; ++ai) { u32x2 pk[4];
#pragma unroll
            for (int m = 0; m < 4; ++m) {
                f32x4 g0 = acc[ai][0][m][0] * W8_INV + bg0, g1 = acc[ai][0][m][1] * W8_INV + bg1, p0 = acc[ai][1][m][0] * W8_INV + bu0, p1 = acc[ai][1][m][1] * W8_INV + bu1;
#pragma unroll
                for (int j = 0; j < 4; ++j) {
                    float g = fminf(g0[j], 7.0f), p = fminf(fmaxf(p0[j], -7.0f), 7.0f); g0[j] = (p + 1.0f) * g * fast_sigmoid(1.702f * g);
                    g = fminf(g1[j], 7.0f); p = fminf(fmaxf(p1[j], -7.0f), 7.0f); g1[j] = (p + 1.0f) * g * fast_sigmoid(1.702f * g); }
                pk[m] = (u32x2){cvt_pk4_fp8(g0[0], g0[1], g0[2], g0[3]), cvt_pk4_fp8(g1[0], g1[1], g1[2], g1[3])}; }
#pragma unroll
            for (int mp = 0; mp < 2; ++mp)
                *(u32x4*)(ACT + (size_t)(row0 + ai * 128 + (2 * mp + (fq & 1)) * 16) * 1024 + u.pn * 128 + wc * 32 + (fq >> 1) * 16) = widen16(pk[2 * mp], pk[2 * mp + 1]); }
    }
    __device__ __forceinline__ void mid(f32x4 (&)[2][2][4][2], const Unit&, int, int, int, int) const {}
};
struct EpiDN {
    static constexpr bool PERM = true;
    const float* bdn; unsigned char* Y;
    __device__ __forceinline__ void operator()(const f32x4 (&acc)[2][2][4][2], const Unit& u, int wr, int wc, int fr, int fq) const {
        const int row0 = u.pm * 256 + wr * 64 + fr, col0 = u.pn * 256 + wc * 32 + 8 * fq;
        const float* bp = bdn + (size_t)u.aux * 1024 + col0;
        f32x4 bv[2][2];
#pragma unroll
        for (int bj = 0; bj < 2; ++bj)
#pragma unroll
            for (int n = 0; n < 2; ++n) bv[bj][n] = *(const f32x4*)(bp + bj * 128 + 4 * n);
#pragma unroll
        for (int ai = 0; ai < 2; ++ai)
#pragma unroll
            for (int bj = 0; bj < 2; ++bj) { u32x2 pk[4];
#pragma unroll
                for (int m = 0; m < 4; ++m) { const f32x4 v0 = acc[ai][bj][m][0] * W8_INV + bv[bj][0], v1 = acc[ai][bj][m][1] * W8_INV + bv[bj][1];
                    pk[m] = (u32x2){cvt_pk4_fp8(v0[0], v0[1], v0[2], v0[3]), cvt_pk4_fp8(v1[0], v1[1], v1[2], v1[3])}; }
#pragma unroll
                for (int mp = 0; mp < 2; ++mp)
                    *(u32x4*)(Y + (size_t)(row0 + ai * 128 + (2 * mp + (fq & 1)) * 16) * 1024 + u.pn * 256 + bj * 128 + wc * 32 + (fq >> 1) * 16) = widen16(pk[2 * mp], pk[2 * mp + 1]); }
    }
    __device__ __forceinline__ void mid(f32x4 (&)[2][2][4][2], const Unit&, int, int, int, int) const {}
};

struct Frame {
    LAS unsigned char* lds; int tid, lane, wave, G, c;
    const float* const* in; float* out; unsigned char* ws; unsigned* ctl;
};
enum { I_X = 0, I_C, I_CTX, I_CCTX, I_WADA, I_BADA, I_WIN, I_LBRAW, I_HGG, I_WFO, I_WHO, I_WO, I_LN1G, I_LN1B, I_WR, I_BR, I_WGU, I_BGU, I_WDN, I_BDN, I_LN2G, I_LN2B };

__device__ __forceinline__ float wave_sum(float v) {
#pragma unroll
    for (int o = 32; o >= 1; o >>= 1) v += __shfl_xor(v, o);
    return v;
}

__device__ __forceinline__ Frame fresh(const Frame& F) { Frame G = F; int t = threadIdx.x; asm volatile("" : "+v"(t)); G.tid = t; G.lane = t & 63; G.wave = __builtin_amdgcn_readfirstlane(t >> 6); return G; }

__device__ __forceinline__ void p0_ada(const Frame& F) {
    LAS float* cact = (LAS float*)F.lds;
    float* ada = (float*)(F.ws + WS_ADA);
    for (int cb = F.c; cb < 192; cb += F.G) {
        const int kg = F.tid >> 5, col = F.tid & 31, gcol = cb * 32 + col;
        float w[16][4];
#pragma unroll
        for (int i = 0; i < 16; ++i)
#pragma unroll
            for (int j = 0; j < 4; ++j) w[i][j] = F.in[I_WADA][(size_t)(4 * kg + 64 * i + j) * 6144 + gcol];
        f32x4 cv[17];
#pragma unroll
        for (int it = 0; it < 17; ++it) { const int q = F.tid + it * NTHR, bq = q >> 8, k4 = (q & 255) * 4; cv[it] = (f32x4){0.f, 0.f, 0.f, 0.f};
            if (q < 33 * 256) cv[it] = *(const f32x4*)(bq < 32 ? F.in[I_C] + bq * 1024 + k4 : F.in[I_CCTX] + k4); }
#pragma unroll
        for (int it = 0; it < 17; ++it) { const int q = F.tid + it * NTHR; f32x4 v = cv[it];
#pragma unroll
            for (int j = 0; j < 4; ++j) v[j] = v[j] * fast_sigmoid(v[j]);
            if (q < 33 * 256) *(LAS f32x4*)(cact + q * 4) = v; }
        __syncthreads();
        float acc[33];
#pragma unroll
        for (int bb = 0; bb < 33; ++bb) acc[bb] = 0.f;
#pragma unroll
        for (int i = 0; i < 16; ++i)
#pragma unroll
            for (int bb = 0; bb < 33; ++bb) { const f32x4 c4 = *(const LAS f32x4*)(cact + bb * 1024 + 4 * kg + 64 * i);
                acc[bb] += (c4[0] * w[i][0] + c4[1] * w[i][1]) + (c4[2] * w[i][2] + c4[3] * w[i][3]); }
        __syncthreads();
        LAS float* red = cact;
#pragma unroll
        for (int bb = 0; bb < 33; ++bb) red[(kg * 33 + bb) * 32 + col] = acc[bb];
        __syncthreads();
        for (int o = F.tid; o < 33 * 32; o += NTHR) { const int bb = o >> 5, cc = o & 31; float sum = 0.f;
#pragma unroll
            for (int g = 0; g < 16; ++g) sum += red[(g * 33 + bb) * 32 + cc];
            ada[(size_t)bb * 6144 + cb * 32 + cc] = sum + F.in[I_BADA][cb * 32 + cc]; }
        __syncthreads();
    }
}
__device__ __forceinline__ void p0_fold(const Frame& F) {
    LAS float* xr = (LAS float*)F.lds;
    LAS float* cs = xr + 2048;
    unsigned char* W1 = (unsigned char*)(F.ws + WS_WIN1T);
    if (F.tid < 128) { const float a = (float)F.tid * (1.0f / 128.0f); cs[F.tid] = __builtin_amdgcn_cosf(a); cs[128 + F.tid] = __builtin_amdgcn_sinf(a); }
    for (int kb = F.c; kb < 256; kb += F.G) {
        __syncthreads();
        for (int i = F.tid; i < 2048; i += NTHR) xr[i] = F.in[I_WIN][(size_t)(4 * kb + (i >> 9)) * 5120 + (i & 511)];
        __syncthreads();
        const int g = F.tid >> 7, j = F.tid & 127;
        float ac[4] = {0.f, 0.f, 0.f, 0.f}, as[4] = {0.f, 0.f, 0.f, 0.f};
        for (int d = 0; d < 128; ++d) { const int idx = (d * j) & 127; const float cv = cs[idx], sv = cs[128 + idx];
#pragma unroll
            for (int r = 0; r < 4; ++r) { const float xv = xr[r * 512 + g * 128 + d]; ac[r] += xv * cv; as[r] += xv * sv; } }
        const float sc = 0.08838834764831845f * W8_SCALE;
        *(unsigned*)(W1 + (size_t)(g * 128 + j) * 1024 + 4 * kb) = cvt_pk4_fp8(ac[0] * sc, ac[1] * sc, ac[2] * sc, ac[3] * sc);
        *(unsigned*)(W1 + (size_t)(512 + g * 128 + j) * 1024 + 4 * kb) = cvt_pk4_fp8(-as[0] * sc, -as[1] * sc, -as[2] * sc, -as[3] * sc);
    }
    __syncthreads();
}
struct CvJob { const float* src; int sld; unsigned char* dst; int f8; };
__device__ __forceinline__ CvJob cv_job(const Frame& F, int j) {
    CvJob J;
    if (j < 128) { const int kt = j >> 4, nt = j & 15; J.src = F.in[I_WIN] + (size_t)kt * 128 * 5120 + 512 + nt * 128; J.sld = 5120; J.dst = F.ws + WS_WIN1T + (size_t)(1024 + nt * 128) * 1024 + kt * 128; J.f8 = 1; }
    else if (j < 288) { const int q = j - 128, kt = q / 20, nt = q % 20; J.src = F.in[I_WIN] + (size_t)kt * 128 * 5120 + 2560 + nt * 128; J.sld = 5120; J.dst = F.ws + WS_WIN2T + (size_t)(nt * 128) * 1024 + kt * 128; J.f8 = 1; }
    else if (j < 320) { const int q = j - 288, kt = q >> 3, nt = q & 7; J.src = F.in[I_WFO] + (size_t)kt * 128 * 1024 + nt * 128; J.sld = 1024; J.dst = F.ws + WS_WMT + ((size_t)(nt * 128) * 1024 + kt * 128); J.f8 = 1; }
    else if (j < 352) { const int q = j - 320, kt = q >> 3, nt = q & 7; J.src = F.in[I_WHO] + (size_t)kt * 128 * 1024 + nt * 128; J.sld = 1024; J.dst = F.ws + WS_WMT + ((size_t)(nt * 128) * 1024 + 512 + kt * 128); J.f8 = 1; }
    else if (j < 416) { const int q = j - 352, kt = q >> 3, nt = q & 7; J.src = F.in[I_WO] + (size_t)kt * 128 * 1024 + nt * 128; J.sld = 1024; J.dst = F.ws + WS_WOT + ((size_t)(nt * 128) * 1024 + kt * 128); J.f8 = 1; }
    else if (j < 4512) { const int q = j - 416, e = q >> 7, r = q & 127, kt = r >> 4, jt = r & 15; J.src = F.in[I_WGU] + (size_t)e * 1024 * 2048 + (size_t)kt * 128 * 2048 + jt * 128; J.sld = 2048;
        J.dst = F.ws + WS_WGUT + (size_t)e * 2048 * 1024 + (size_t)((jt & 7) * 256 + (jt >> 3) * 128) * 1024 + kt * 128; J.f8 = 1; }
    else { const int q = j - 4512, e = q >> 6, r = q & 63, kt = r >> 3, nt = r & 7; J.src = F.in[I_WDN] + (size_t)e * 1024 * 1024 + (size_t)kt * 128 * 1024 + nt * 128; J.sld = 1024;
        J.dst = F.ws + WS_WDNT + (size_t)e * 1024 * 1024 + (size_t)(nt * 128) * 1024 + kt * 128; J.f8 = 1; }
    return J;
}
__device__ __forceinline__ void p0_convert(const Frame& F) {
    constexpr int NJ = 128 + 160 + 32 + 32 + 64 + 4096 + 2048;
    LAS float* tile = (LAS float*)F.lds;
    int j = F.c; if (j >= NJ) return;
    CvJob J = cv_job(F, j);
    f32x4 v[8];
#pragma unroll
    for (int i = 0; i < 8; ++i) { const int idx = F.tid + i * NTHR, r = idx >> 5, c4 = idx & 31; v[i] = *(const f32x4*)(J.src + (size_t)r * J.sld + c4 * 4); }
    for (;;) {
        const float sc = J.f8 ? W8_SCALE : 1.0f;
#pragma unroll
        for (int i = 0; i < 8; ++i) { const int idx = F.tid + i * NTHR, r = idx >> 5, c4 = idx & 31; LAS float* p = tile + r * 129 + c4 * 4; p[0] = v[i][0] * sc; p[1] = v[i][1] * sc; p[2] = v[i][2] * sc; p[3] = v[i][3] * sc; }
        __syncthreads();
        const CvJob Jc = J; const int jn = j + F.G; const bool more = jn < NJ;
        if (more) { J = cv_job(F, jn);
#pragma unroll
            for (int i = 0; i < 8; ++i) { const int idx = F.tid + i * NTHR, r = idx >> 5, c4 = idx & 31; v[i] = *(const f32x4*)(J.src + (size_t)r * J.sld + c4 * 4); } }
        if (Jc.f8) {
#pragma unroll
            for (int i = 0; i < 2; ++i) { const int idx = F.tid + i * NTHR, n = idx >> 3, kc = idx & 7; const LAS float* p = tile + (kc * 16) * 129 + n;
                u32x4 w; w.x = cvt_pk4_fp8(p[0], p[129], p[2 * 129], p[3 * 129]); w.y = cvt_pk4_fp8(p[4 * 129], p[5 * 129], p[6 * 129], p[7 * 129]);
                w.z = cvt_pk4_fp8(p[8 * 129], p[9 * 129], p[10 * 129], p[11 * 129]); w.w = cvt_pk4_fp8(p[12 * 129], p[13 * 129], p[14 * 129], p[15 * 129]);
                *(u32x4*)(Jc.dst + (size_t)n * 1024 + kc * 16) = w; }
        } else {
#pragma unroll
            for (int i = 0; i < 4; ++i) { const int idx = F.tid + i * NTHR, n = idx >> 4, kc = idx & 15; const LAS float* p = tile + (kc * 8) * 129 + n;
                u32x4 w; w.x = cvt_pk_bf16(p[0], p[129]); w.y = cvt_pk_bf16(p[2 * 129], p[3 * 129]); w.z = cvt_pk_bf16(p[4 * 129], p[5 * 129]); w.w = cvt_pk_bf16(p[6 * 129], p[7 * 129]);
                *(u32x4*)((bf16_t*)Jc.dst + (size_t)n * 1024 + kc * 8) = w; }
        }
        __syncthreads();
        if (!more) break;
        j = jn;
    }
}

__device__ __forceinline__ void p1_uprep(const Frame& F) {
    const float* ada = (const float*)(F.ws + WS_ADA);
    unsigned char* U = (unsigned char*)(F.ws + WS_U); unsigned char* Uc = (unsigned char*)(F.ws + WS_UC);
    const size_t NIT = (size_t)(T + TCX) * 128, stride = (size_t)F.G * NTHR;
    for (size_t base = (size_t)F.c * NTHR + F.tid; base < NIT; base += 4 * stride) {
        const int col = (int)(base & 127) * 8;
        f32x4 a0[4], a1[4], sh0[4], sh1[4], sc0[4], sc1[4]; unsigned char* dst[4]; bool ok[4];
#pragma unroll
        for (int u = 0; u < 4; ++u) {
            const size_t idx = base + (size_t)u * stride; ok[u] = idx < NIT;
            const int row = (int)((ok[u] ? idx : base) >> 7);
            const bool lat = row < T; const int b = lat ? (row >> 11) : 32;
            const float* src = lat ? F.in[I_X] + (size_t)row * 1024 + col : F.in[I_CTX] + (size_t)(row - T) * 1024 + col;
            dst[u] = lat ? U + (size_t)row * 1024 + col : Uc + (size_t)(row - T) * 1024 + col;
            a0[u] = *(const f32x4*)src; a1[u] = *(const f32x4*)(src + 4);
            const float* ap = ada + (size_t)b * 6144 + col;
            sh0[u] = *(const f32x4*)ap; sh1[u] = *(const f32x4*)(ap + 4); sc0[u] = *(const f32x4*)(ap + 1024); sc1[u] = *(const f32x4*)(ap + 1028);
        }
#pragma unroll
        for (int u = 0; u < 4; ++u) {
            const f32x4 r0 = a0[u] * (sc0[u] + 1.0f) + sh0[u], r1 = a1[u] * (sc1[u] + 1.0f) + sh1[u];
            if (ok[u]) *(u32x2*)dst[u] = (u32x2){cvt_pk4_fp8(r0[0], r0[1], r0[2], r0[3]), cvt_pk4_fp8(r1[0], r1[1], r1[2], r1[3])};
        }
    }
    int* rowtok = (int*)(F.ws + WS_ROWTOK);
    for (int i = F.c * NTHR + F.tid; i < NCH * ROWS_CH; i += F.G * NTHR) rowtok[i] = (i / ROWS_CH) * TCH;
}

__device__ __forceinline__ void p6_readout(const Frame& F) {
    const bf16_t* PH = (const bf16_t*)(F.ws + WS_PH); const unsigned char* PG = (const unsigned char*)(F.ws + WS_PG); unsigned char* Y = (unsigned char*)(F.ws + WS_Y);
    const int l8 = F.lane * 8;
    const f32x4 g0 = *(const f32x4*)(F.in[I_HGG] + l8), g1 = *(const f32x4*)(F.in[I_HGG] + l8 + 4);
    const int tstr = F.G * 8;
    for (int t0 = F.c * 8 + F.wave; t0 < T; t0 += 4 * tstr) {
        u32x4 av[4], bv[4]; u32x2 pv[4]; bool ok[4]; int tt[4];
#pragma unroll
        for (int u = 0; u < 4; ++u) { const int t = t0 + u * tstr; ok[u] = t < T; tt[u] = ok[u] ? t : t0;
            av[u] = *(const u32x4*)(PH + (size_t)tt[u] * 2048 + 512 + l8); bv[u] = *(const u32x4*)(PH + (size_t)tt[u] * 2048 + 1024 + l8); pv[u] = *(const u32x2*)(PG + (size_t)tt[u] * 512 + l8); }
#pragma unroll
        for (int u = 0; u < 4; ++u) {
            const u32x4 a = av[u], b = bv[u]; const f32x4 pa = fp8x4_to_f32(pv[u].x), pb = fp8x4_to_f32(pv[u].y);
            float o[8] = { bf_lo(a.x) + bf_lo(b.x), bf_hi(a.x) + bf_hi(b.x), bf_lo(a.y) + bf_lo(b.y), bf_hi(a.y) + bf_hi(b.y), bf_lo(a.z) + bf_lo(b.z), bf_hi(a.z) + bf_hi(b.z), bf_lo(a.w) + bf_lo(b.w), bf_hi(a.w) + bf_hi(b.w) };
            float ss = 0.f;
#pragma unroll
            for (int i = 0; i < 8; ++i) ss += o[i] * o[i];
            ss += __shfl_xor(ss, 1); ss += __shfl_xor(ss, 2); ss += __shfl_xor(ss, 4); ss += __shfl_xor(ss, 8);
            const float rs = __builtin_amdgcn_rsqf(ss * (1.0f / 128.0f) + RMS_EPS);
            const float sp[8] = { pa[0], pa[1], pa[2], pa[3], pb[0], pb[1], pb[2], pb[3] };
            if (ok[u]) *(u32x2*)(Y + (size_t)tt[u] * 1024 + 512 + l8) = (u32x2){cvt_pk4_fp8(o[0] * rs * g0[0] * sp[0], o[1] * rs * g0[1] * sp[1], o[2] * rs * g0[2] * sp[2], o[3] * rs * g0[3] * sp[3]), cvt_pk4_fp8(o[4] * rs * g1[0] * sp[4], o[5] * rs * g1[1] * sp[5], o[6] * rs * g1[2] * sp[6], o[7] * rs * g1[3] * sp[7])};
        }
    }
}

__device__ __forceinline__ void p9_ln1_router(const Frame& F, const bool dry) {
    LAS float* wrT = (LAS float*)F.lds;
    LAS float* lg = (LAS float*)(F.lds + 131072);
    LAS float* brs = (LAS float*)(F.lds + 131072 + 4096);
    LAS int* hist = (LAS int*)(F.lds + 131072 + 4096 + 128);
    for (int i = F.tid; i < 32768; i += NTHR) { const int k = i >> 5, e = i & 31; wrT[e * 1024 + k] = F.in[I_WR][i]; }
    if (F.tid < 32) brs[F.tid] = F.in[I_BR][F.tid];
    if (F.tid < NCH * 32) hist[F.tid] = 0;
    __syncthreads();
    const unsigned char* V = (const unsigned char*)F.out; bf16_t* X1 = (bf16_t*)(F.ws + WS_X1); unsigned char* U2 = (unsigned char*)(F.ws + WS_U); const float* ada = (const float*)(F.ws + WS_ADA);
    int* topi = (int*)(F.ws + WS_TOPI); float* topw = (float*)(F.ws + WS_TOPW);
    const int l4 = F.lane * 4;
    for (int gi = F.c * 8 + F.wave; gi < T / 4; gi += F.G * 8) {
        const int g = T / 4 - 1 - gi;
        const int t0 = g * 4, b = t0 >> 11;
        f32x4 xv[4][4];
#pragma unroll
        for (int tk = 0; tk < 4; ++tk) { unsigned w[4]; const float* xp = F.in[I_X] + (size_t)(t0 + tk) * 1024 + l4; const unsigned char* vp = V + (size_t)(t0 + tk) * 1024 + l4;
#pragma unroll
            for (int j = 0; j < 4; ++j) { xv[tk][j] = *(const f32x4*)(xp + 256 * j); w[j] = *(const unsigned*)(vp + 256 * j); }
#pragma unroll
            for (int j = 0; j < 4; ++j) xv[tk][j] = xv[tk][j] * DN_ALPHA + fp8x4_to_f32(w[j]) * V8_INV;
            if (tk == 1) asm volatile("" ::: "memory"); }
        float mean[4], rstd[4];
#pragma unroll
        for (int tk = 0; tk < 4; ++tk) { float s = 0.f;
#pragma unroll
            for (int j = 0; j < 4; ++j) s += (xv[tk][j][0] + xv[tk][j][1]) + (xv[tk][j][2] + xv[tk][j][3]);
            s = wave_sum(s); mean[tk] = s * (1.0f / 1024.0f); float q = 0.f;
#pragma unroll
            for (int j = 0; j < 4; ++j) { const f32x4 d = xv[tk][j] - mean[tk]; q += (d[0] * d[0] + d[1] * d[1]) + (d[2] * d[2] + d[3] * d[3]); }
            q = wave_sum(q); rstd[tk] = __builtin_amdgcn_rsqf(q * (1.0f / 1024.0f) + LN_EPS); }
#pragma unroll
        for (int j = 0; j < 4; ++j) {
            int l4g = l4; asm volatile("" : "+v"(l4g));
            const int k = 256 * j + l4g;
            const f32x4 lg1 = *(const f32x4*)(F.in[I_LN1G] + k), lb1 = *(const f32x4*)(F.in[I_LN1B] + k);
            const f32x4 sh = *(const f32x4*)(ada + (size_t)b * 6144 + 3072 + k), sc = *(const f32x4*)(ada + (size_t)b * 6144 + 4096 + k);
#pragma unroll
            for (int tk = 0; tk < 4; ++tk) { const f32x4 x1 = (xv[tk][j] - mean[tk]) * rstd[tk] * lg1 + lb1;
                if (!dry) *(u32x2*)(X1 + (size_t)(t0 + tk) * 1024 + k) = (u32x2){cvt_pk_bf16(x1[0], x1[1]), cvt_pk_bf16(x1[2], x1[3])};
                const f32x4 u2 = x1 * (sc + 1.0f) + sh; xv[tk][j] = u2;
                if (!dry) *(unsigned*)(U2 + (size_t)(t0 + tk) * 1024 + k) = cvt_pk4_fp8(u2[0], u2[1], u2[2], u2[3]); } }
#pragma unroll 1
        for (int eq = 0; eq < 4; ++eq) {
            f32x2 acc2[4][8];
#pragma unroll
            for (int e = 0; e < 8; ++e) { acc2[0][e] = (f32x2){0.f, 0.f}; acc2[1][e] = (f32x2){0.f, 0.f}; acc2[2][e] = (f32x2){0.f, 0.f}; acc2[3][e] = (f32x2){0.f, 0.f};
#pragma unroll
                for (int j = 0; j < 4; ++j) { const f32x4 w4 = *(const LAS f32x4*)(wrT + (eq * 8 + e) * 1024 + 256 * j + l4); const f32x2 wlo = {w4[0], w4[1]}, whi = {w4[2], w4[3]};
#pragma unroll
                    for (int tk = 0; tk < 4; ++tk) { const f32x2 xlo = {xv[tk][j][0], xv[tk][j][1]}, xhi = {xv[tk][j][2], xv[tk][j][3]};
                        acc2[tk][e] = __builtin_elementwise_fma(xlo, wlo, acc2[tk][e]); acc2[tk][e] = __builtin_elementwise_fma(xhi, whi, acc2[tk][e]); } }
                if (e & 1) __builtin_amdgcn_sched_barrier(0); }
            float acc[4][8];
#pragma unroll
            for (int tk = 0; tk < 4; ++tk)
#pragma unroll
                for (int e = 0; e < 8; ++e) acc[tk][e] = acc2[tk][e][0] + acc2[tk][e][1];
#pragma unroll
            for (int tk = 0; tk < 4; ++tk) {
                float v0, v1, v2, v3;
                { const bool up = (F.lane & 32) != 0;
                  v0 = (up ? acc[tk][4] : acc[tk][0]) + __shfl_xor(up ? acc[tk][0] : acc[tk][4], 32);
                  v1 = (up ? acc[tk][5] : acc[tk][1]) + __shfl_xor(up ? acc[tk][1] : acc[tk][5], 32);
                  v2 = (up ? acc[tk][6] : acc[tk][2]) + __shfl_xor(up ? acc[tk][2] : acc[tk][6], 32);
                  v3 = (up ? acc[tk][7] : acc[tk][3]) + __shfl_xor(up ? acc[tk][3] : acc[tk][7], 32); }
                { const bool up = (F.lane & 16) != 0;
                  const float a0 = (up ? v2 : v0) + __shfl_xor(up ? v0 : v2, 16), a1 = (up ? v3 : v1) + __shfl_xor(up ? v1 : v3, 16); v0 = a0; v1 = a1; }
                { const bool up = (F.lane & 8) != 0; v0 = (up ? v1 : v0) + __shfl_xor(up ? v0 : v1, 8); }
                v0 += __shfl_xor(v0, 4); v0 += __shfl_xor(v0, 2); v0 += __shfl_xor(v0, 1);
                const int e = eq * 8 + ((F.lane >> 5) & 1) * 4 + ((F.lane >> 4) & 1) * 2 + ((F.lane >> 3) & 1);
                if ((F.lane & 7) == 0) lg[(F.wave * 4 + tk) * 32 + e] = v0 + brs[e];
            }
        }
        asm volatile("s_waitcnt lgkmcnt(0)" ::: "memory");
        if (F.lane < 4) {
            const LAS float* L = lg + (F.wave * 4 + F.lane) * 32;
            float b0 = -3.0e38f, b1 = -3.0e38f, b2 = -3.0e38f, b3 = -3.0e38f; int i0 = 0, i1 = 0, i2 = 0, i3 = 0;
            for (int e = 0; e < 32; ++e) { const float x = L[e];
                if (x > b3) { b3 = x; i3 = e;
                    if (b3 > b2) { float tf = b2; b2 = b3; b3 = tf; int ti = i2; i2 = i3; i3 = ti;
                        if (b2 > b1) { tf = b1; b1 = b2; b2 = tf; ti = i1; i1 = i2; i2 = ti;
                            if (b1 > b0) { tf = b0; b0 = b1; b1 = tf; ti = i0; i0 = i1; i1 = ti; } } } } }
            const float p1 = fast_exp(b1 - b0), p2 = fast_exp(b2 - b0), p3 = fast_exp(b3 - b0), inv = 1.0f / (1.0f + p1 + p2 + p3);
            const int t = t0 + F.lane;
            *(int4*)(topi + (size_t)t * 4) = make_int4(i0, i1, i2, i3);
            *(f32x4*)(topw + (size_t)t * 4) = (f32x4){inv, p1 * inv, p2 * inv, p3 * inv};
            const int ch = t / TCH;
            if (!dry) { atomicAdd((int*)(hist + ch * 32 + i0), 1); atomicAdd((int*)(hist + ch * 32 + i1), 1); atomicAdd((int*)(hist + ch * 32 + i2), 1); atomicAdd((int*)(hist + ch * 32 + i3), 1); }
        }
    }
    __syncthreads();
    { int t2 = threadIdx.x; asm volatile("" : "+v"(t2));
      if (t2 < NCH * 32) { const int h = hist[t2]; if (h && !dry) atomicAdd(F.ctl + CW_CNT + t2, (unsigned)h); } }
    __syncthreads();
}

__device__ __forceinline__ void p10_dispatch(const Frame& F) {
    LAS int* lcnt = (LAS int*)F.lds; LAS int* lbase = lcnt + 32; LAS int* pstart = lcnt + 64;
    const int* topi = (const int*)(F.ws + WS_TOPI); int* pos = (int*)(F.ws + WS_POS); int* rowtok = (int*)(F.ws + WS_ROWTOK);
    for (int s = F.c; s < T / 256; s += F.G) {
        const int ch = (s * 256) / TCH;
        __syncthreads();
        if (F.tid < 32) { lcnt[F.tid] = 0; int ps = 0; for (int e = 0; e < F.tid; ++e) { const int n = (int)__hip_atomic_load(F.ctl + CW_CNT + ch * 32 + e, __ATOMIC_RELAXED, __HIP_MEMORY_SCOPE_AGENT); ps += (n + 255) & ~255; } pstart[F.tid] = ps; }
        __syncthreads();
        int e2[2], r2[2];
#pragma unroll
        for (int i = 0; i < 2; ++i) { const int a = F.tid + i * NTHR; e2[i] = topi[(size_t)(s * 256) * 4 + a]; r2[i] = atomicAdd((int*)(lcnt + e2[i]), 1); }
        __syncthreads();
        if (F.tid < 32) lbase[F.tid] = (int)atomicAdd(F.ctl + CW_CUR + ch * 32 + F.tid, (unsigned)lcnt[F.tid]);
        __syncthreads();
#pragma unroll
        for (int i = 0; i < 2; ++i) { const int a = F.tid + i * NTHR, slot = pstart[e2[i]] + lbase[e2[i]] + r2[i];
            pos[(size_t)(s * 256) * 4 + a] = slot; rowtok[(size_t)ch * ROWS_CH + slot] = s * 256 + (a >> 2); }
    }
}
__device__ __forceinline__ int moe_blocks(const Frame& F, int ch, LAS unsigned char* blk_e) {
    LAS int* sh = (LAS int*)(blk_e + 1152);
    __syncthreads();
    if (F.tid < 32) {
        int start = 0, mine = 0;
        for (int e = 0; e < 32; ++e) { const int n = ((int)__hip_atomic_load(F.ctl + CW_CNT + ch * 32 + e, __ATOMIC_RELAXED, __HIP_MEMORY_SCOPE_AGENT) + 255) >> 8; if (e < F.tid) start += n; if (e == F.tid) mine = n; }
        for (int i = 0; i < mine; ++i) blk_e[start + i] = (unsigned char)F.tid;
        if (F.tid == 31) sh[0] = start + mine;
    }
    __syncthreads();
    return sh[0];
}

__device__ __forceinline__ void p13_combine_ln2(const Frame& F, int ch, const bool dry) {
    const unsigned char* YC = (const unsigned char*)(F.ws + WS_YCH); const int* pos = (const int*)(F.ws + WS_POS); const float* topw = (const float*)(F.ws + WS_TOPW);
    const float* ada = (const float*)(F.ws + WS_ADA); const bf16_t* X1 = (const bf16_t*)(F.ws + WS_X1); float* O = F.out;
    const int l8 = F.lane * 8;
    for (int t0 = ch * TCH + F.c * 8 + F.wave; t0 < (ch + 1) * TCH; t0 += 2 * F.G * 8) {
        int tt[2]; tt[0] = t0; tt[1] = t0 + F.G * 8; const bool two = tt[1] < (ch + 1) * TCH; if (!two) tt[1] = t0;
        f32x4 v[2][2][2];
#pragma unroll
        for (int q = 0; q < 2; ++q) { const int t = tt[q], b = t >> 11;
            const int4 ps = *(const int4*)(pos + (size_t)t * 4); const f32x4 tw = *(const f32x4*)(topw + (size_t)t * 4);
#pragma unroll
            for (int j = 0; j < 2; ++j) { const int k = 512 * j + l8;
                const u32x2 y0 = *(const u32x2*)(YC + (size_t)ps.x * 1024 + k), y1 = *(const u32x2*)(YC + (size_t)ps.y * 1024 + k), y2 = *(const u32x2*)(YC + (size_t)ps.z * 1024 + k), y3 = *(const u32x2*)(YC + (size_t)ps.w * 1024 + k);
                const u32x4 xw = *(const u32x4*)(X1 + (size_t)t * 1024 + k);
                const f32x4 g2a = *(const f32x4*)(ada + (size_t)b * 6144 + 5120 + k), g2b = *(const f32x4*)(ada + (size_t)b * 6144 + 5120 + k + 4);
                const f32x4 ffa = fp8x4_to_f32(y0.x) * tw[0] + fp8x4_to_f32(y1.x) * tw[1] + fp8x4_to_f32(y2.x) * tw[2] + fp8x4_to_f32(y3.x) * tw[3];
                const f32x4 ffb = fp8x4_to_f32(y0.y) * tw[0] + fp8x4_to_f32(y1.y) * tw[1] + fp8x4_to_f32(y2.y) * tw[2] + fp8x4_to_f32(y3.y) * tw[3];
                v[q][j][0] = (f32x4){bf_lo(xw.x), bf_hi(xw.x), bf_lo(xw.y), bf_hi(xw.y)} * DN_ALPHA + g2a * ffa;
                v[q][j][1] = (f32x4){bf_lo(xw.z), bf_hi(xw.z), bf_lo(xw.w), bf_hi(xw.w)} * DN_ALPHA + g2b * ffb; } }
#pragma unroll
        for (int q = 0; q < 2; ++q) { const int t = tt[q];
            float s = 0.f;
#pragma unroll
            for (int j = 0; j < 2; ++j)
#pragma unroll
                for (int h = 0; h < 2; ++h) s += (v[q][j][h][0] + v[q][j][h][1]) + (v[q][j][h][2] + v[q][j][h][3]);
            s = wave_sum(s); const float mean = s * (1.0f / 1024.0f); float qq = 0.f;
#pragma unroll
            for (int j = 0; j < 2; ++j)
#pragma unroll
                for (int h = 0; h < 2; ++h) { const f32x4 d = v[q][j][h] - mean; qq += (d[0] * d[0] + d[1] * d[1]) + (d[2] * d[2] + d[3] * d[3]); }
            qq = wave_sum(qq); const float rstd = __builtin_amdgcn_rsqf(qq * (1.0f / 1024.0f) + LN_EPS);
            if (q == 0 || two) {
#pragma unroll
                for (int j = 0; j < 2; ++j)
#pragma unroll
                    for (int h = 0; h < 2; ++h) { const int k = 512 * j + l8 + 4 * h; const f32x4 g = *(const f32x4*)(F.in[I_LN2G] + k), bb = *(const f32x4*)(F.in[I_LN2B] + k);
                        const f32x4 o4 = (v[q][j][h] - mean) * rstd * g + bb;
                        if (!dry) *(f32x4*)(O + (size_t)t * 1024 + k) = o4; else if (o4[0] == 1.2345e30f) O[0] = 1.f; } }
        }
    }
}

constexpr int SC_QD = 0, SC_KI = 17408, SC_KE = 34816, SC_VT = 53248, SC_SC = 71680, SC_ST = 80896, SC_GV = 115712, SC_CS = 116224;
__device__ __forceinline__ bf16x8 ldfrag(const LAS unsigned char* p) { return *(const LAS bf16x8*)p; }
__device__ __forceinline__ void p3_scan(const Frame& F, const bool dry) {
    LAS unsigned char* L = F.lds;
    const int tid = F.tid, w = F.wave, lane = F.lane, fr = lane & 15, fq = lane >> 4;
    const int d = tid & 127, qd = tid >> 7;
    bf16_t* PH = (bf16_t*)(F.ws + WS_PH); const bf16_t* PHC = (const bf16_t*)(F.ws + WS_PHC);
    for (int it = F.c; it < 256; it += F.G) {
        const int b = it >> 3, h = (it >> 1) & 3, dir = it & 1;
        const float r0 = F.in[I_LBRAW][dir * 512 + h * 128 + d], r1 = F.in[I_LBRAW][1024 + dir * 512 + h * 128 + d];
        const float lbv = fast_sigmoid(r0 - r1), oml = 1.0f - lbv;
        f32x4 Sacc[8];
#pragma unroll
        for (int i = 0; i < 8; ++i) Sacc[i] = (f32x4){0.f, 0.f, 0.f, 0.f};
        __syncthreads();
        for (int i = tid; i < 34816 / 4; i += NTHR) ((LAS unsigned*)(L + SC_ST))[i] = 0u;
        const int cq = h * 128 + d, cz = 512 + dir * 512 + h * 128 + d;
        unsigned char rq[16], rv[16]; bf16_t rz[16];
        {   const int n = dir ? 3 : 0; const bf16_t* base = PHC + (size_t)(b * 256 + 64 * n + 16 * qd) * 2048; const unsigned char* base8 = (const unsigned char*)base;
#pragma unroll
            for (int i = 0; i < 16; ++i) { rq[i] = base8[(size_t)i * 4096 + cq]; rz[i] = base[(size_t)i * 2048 + cz]; rv[i] = base8[(size_t)i * 4096 + 3072 + cq]; } }
        for (int s = 0; s < 36; ++s) {
            const bool lat = s >= 4; const int n = lat ? (dir ? 31 - (s - 4) : (s - 4)) : (dir ? 3 - s : s);
            float kk[16], cum[16]; float run = 0.f;
#pragma unroll
            for (int i = 0; i < 16; ++i) { const float sg = fast_sigmoid(bf2f(rz[i])); kk[i] = oml * (1.0f - sg); cum[i] = fast_log(lbv + oml * sg); }
            if (dir == 0) {
#pragma unroll
                for (int i = 0; i < 16; ++i) { run += cum[i]; cum[i] = run; }
            } else {
#pragma unroll
                for (int i = 15; i >= 0; --i) { run += cum[i]; cum[i] = run; }
            }
            ((LAS float*)(L + SC_CS))[qd * 128 + d] = run;
            __syncthreads();
            {   const LAS float* cs = (const LAS float*)(L + SC_CS);
                const float c0 = cs[d], c1 = cs[128 + d], c2 = cs[256 + d], c3 = cs[384 + d], tot = (c0 + c1) + (c2 + c3);
                float off;
                if (dir == 0) off = (qd > 0 ? c0 : 0.f) + (qd > 1 ? c1 : 0.f) + (qd > 2 ? c2 : 0.f);
                else off = (qd < 3 ? c3 : 0.f) + (qd < 2 ? c2 : 0.f) + (qd < 1 ? c1 : 0.f);
                const float g = fast_exp(tot);
                if (qd == 0) ((LAS float*)(L + SC_GV))[d] = g;
                unsigned ke[8], vt[8];
#pragma unroll
                for (int i = 0; i < 16; i += 2) {
                    const float ca = cum[i] + off, cb = cum[i + 1] + off;
                    const float ea = fast_exp(ca), eb = fast_exp(cb), ia = __builtin_amdgcn_rcpf(ea), ib = __builtin_amdgcn_rcpf(eb);
                    const float qda = __builtin_amdgcn_cvt_f32_fp8((int)rq[i], 0) * ea, qdb = __builtin_amdgcn_cvt_f32_fp8((int)rq[i + 1], 0) * eb;
                    const float kia = kk[i] * ia, kib = kk[i + 1] * ib;
                    const unsigned wa = cvt_pk_bf16(qda, kia), wb = cvt_pk_bf16(qdb, kib);
                    *(LAS bf16_t*)(L + SC_QD + (16 * qd + i) * 272 + d * 2) = (bf16_t)(wa & 0xffffu);
                    *(LAS bf16_t*)(L + SC_KI + (16 * qd + i) * 272 + d * 2) = (bf16_t)(wa >> 16);
                    *(LAS bf16_t*)(L + SC_QD + (16 * qd + i + 1) * 272 + d * 2) = (bf16_t)(wb & 0xffffu);
                    *(LAS bf16_t*)(L + SC_KI + (16 * qd + i + 1) * 272 + d * 2) = (bf16_t)(wb >> 16);
                    ke[i >> 1] = cvt_pk_bf16(kia * g, kib * g);
                    vt[i >> 1] = cvt_pk_bf16(__builtin_amdgcn_cvt_f32_fp8((int)rv[i], 0), __builtin_amdgcn_cvt_f32_fp8((int)rv[i + 1], 0));
                }
                *(LAS u32x4*)(L + SC_KE + d * 144 + 32 * qd) = (u32x4){ke[0], ke[1], ke[2], ke[3]};
                *(LAS u32x4*)(L + SC_KE + d * 144 + 32 * qd + 16) = (u32x4){ke[4], ke[5], ke[6], ke[7]};
                *(LAS u32x4*)(L + SC_VT + d * 144 + 32 * qd) = (u32x4){vt[0], vt[1], vt[2], vt[3]};
                *(LAS u32x4*)(L + SC_VT + d * 144 + 32 * qd + 16) = (u32x4){vt[4], vt[5], vt[6], vt[7]};
            }
            if (s + 1 < 36) {
                const int s1 = s + 1; const bool lat1 = s1 >= 4; const int n1 = lat1 ? (dir ? 31 - (s1 - 4) : (s1 - 4)) : (dir ? 3 - s1 : s1);
                const bf16_t* base = lat1 ? (const bf16_t*)PH + (size_t)(b * 2048 + 64 * n1 + 16 * qd) * 2048 : PHC + (size_t)(b * 256 + 64 * n1 + 16 * qd) * 2048;
                const unsigned char* base8 = (const unsigned char*)base;
#pragma unroll
                for (int i = 0; i < 16; ++i) { rq[i] = base8[(size_t)i * 4096 + cq]; rz[i] = base[(size_t)i * 2048 + cz]; rv[i] = base8[(size_t)i * 4096 + 3072 + cq]; }
            }
            __syncthreads();
            f32x4 oacc[4];
#pragma unroll
            for (int i = 0; i < 4; ++i) oacc[i] = (f32x4){0.f, 0.f, 0.f, 0.f};
            const int kb = fq * 16;
            if (lat) {
                const int ct = w >> 1, st0 = 2 * (w & 1);
#pragma unroll
                for (int j = 0; j < 2; ++j) { const int st = st0 + j; f32x4 sa = (f32x4){0.f, 0.f, 0.f, 0.f};
#pragma unroll
                    for (int ks = 0; ks < 4; ++ks) sa = __builtin_amdgcn_mfma_f32_16x16x32_bf16(ldfrag(L + SC_KI + (16 * st + fr) * 272 + ks * 64 + kb), ldfrag(L + SC_QD + (16 * ct + fr) * 272 + ks * 64 + kb), sa, 0, 0, 0);
                    const int cc = 16 * ct + fr, s0 = 16 * st + 4 * fq;
#pragma unroll
                    for (int i = 0; i < 4; ++i) { const bool keep = dir ? (s0 + i >= cc) : (s0 + i <= cc); sa[i] = keep ? sa[i] : 0.f; }
                    *(LAS u32x2*)(L + SC_SC + cc * 144 + s0 * 2) = (u32x2){cvt_pk_bf16(sa[0], sa[1]), cvt_pk_bf16(sa[2], sa[3])}; }
#pragma unroll
                for (int ct2 = 0; ct2 < 4; ++ct2)
#pragma unroll
                    for (int ks = 0; ks < 4; ++ks) oacc[ct2] = __builtin_amdgcn_mfma_f32_16x16x32_bf16(ldfrag(L + SC_ST + (16 * w + fr) * 272 + ks * 64 + kb), ldfrag(L + SC_QD + (16 * ct2 + fr) * 272 + ks * 64 + kb), oacc[ct2], 0, 0, 0);
            }
            {   const bf16x8 v0 = ldfrag(L + SC_VT + (16 * w + fr) * 144 + kb), v1 = ldfrag(L + SC_VT + (16 * w + fr) * 144 + 64 + kb);
#pragma unroll
                for (int dt = 0; dt < 8; ++dt) { const f32x4 gv = *(const LAS f32x4*)(L + SC_GV + (16 * dt + 4 * fq) * 4);
                    f32x4 a = Sacc[dt] * gv;
                    a = __builtin_amdgcn_mfma_f32_16x16x32_bf16(ldfrag(L + SC_KE + (16 * dt + fr) * 144 + kb), v0, a, 0, 0, 0);
                    a = __builtin_amdgcn_mfma_f32_16x16x32_bf16(ldfrag(L + SC_KE + (16 * dt + fr) * 144 + 64 + kb), v1, a, 0, 0, 0);
                    Sacc[dt] = a; } }
            __syncthreads();
#pragma unroll
            for (int dt = 0; dt < 8; ++dt) *(LAS u32x2*)(L + SC_ST + (16 * w + fr) * 272 + (16 * dt + 4 * fq) * 2) = (u32x2){cvt_pk_bf16(Sacc[dt][0], Sacc[dt][1]), cvt_pk_bf16(Sacc[dt][2], Sacc[dt][3])};
            if (lat) {
                const bf16x8 v0 = ldfrag(L + SC_VT + (16 * w + fr) * 144 + kb), v1 = ldfrag(L + SC_VT + (16 * w + fr) * 144 + 64 + kb);
                bf16_t* ob = PH + (size_t)(b * 2048 + 64 * n) * 2048 + 512 + dir * 512 + h * 128 + 16 * w + 4 * fq;
#pragma unroll
                for (int ct2 = 0; ct2 < 4; ++ct2) {
                    f32x4 a = oacc[ct2];
                    a = __builtin_amdgcn_mfma_f32_16x16x32_bf16(v0, ldfrag(L + SC_SC + (16 * ct2 + fr) * 144 + kb), a, 0, 0, 0);
                    a = __builtin_amdgcn_mfma_f32_16x16x32_bf16(v1, ldfrag(L + SC_SC + (16 * ct2 + fr) * 144 + 64 + kb), a, 0, 0, 0);
                    if (!dry) *(u32x2*)(ob + (size_t)(16 * ct2 + fr) * 2048) = (u32x2){cvt_pk_bf16(a[0], a[1]), cvt_pk_bf16(a[2], a[3])};
                    else if (a[0] == 1.2345e30f) ob[0] = 1; }
            }
        }
        __syncthreads();
    }
}

typedef short s16x4 __attribute__((ext_vector_type(4)));
__device__ __forceinline__ s16x4 tr_read(unsigned lds_addr) { s16x4 r; asm volatile("ds_read_b64_tr_b16 %0, %1\n\ts_waitcnt lgkmcnt(0)" : "=&v"(r) : "v"(lds_addr) : "memory"); return r; }
__device__ __forceinline__ void tr_read8(unsigned a0, unsigned a1, unsigned a2, unsigned a3, unsigned d, s16x4 (&r)[8]) {
    asm volatile("ds_read_b64_tr_b16 %0, %8\n\tds_read_b64_tr_b16 %1, %9\n\tds_read_b64_tr_b16 %2, %10\n\tds_read_b64_tr_b16 %3, %11\n\t"
                 "ds_read_b64_tr_b16 %4, %12\n\tds_read_b64_tr_b16 %5, %13\n\tds_read_b64_tr_b16 %6, %14\n\tds_read_b64_tr_b16 %7, %15\n\ts_waitcnt lgkmcnt(0)"
                 : "=&v"(r[0]), "=&v"(r[1]), "=&v"(r[2]), "=&v"(r[3]), "=&v"(r[4]), "=&v"(r[5]), "=&v"(r[6]), "=&v"(r[7])
                 : "v"(a0), "v"(a0 + d), "v"(a1), "v"(a1 + d), "v"(a2), "v"(a2 + d), "v"(a3), "v"(a3 + d) : "memory");
}
__device__ __forceinline__ void tr_read4(unsigned a0, unsigned a1, unsigned d, s16x4 (&r)[4]) {
    asm volatile("ds_read_b64_tr_b16 %0, %4\n\tds_read_b64_tr_b16 %1, %5\n\tds_read_b64_tr_b16 %2, %6\n\tds_read_b64_tr_b16 %3, %7\n\ts_waitcnt lgkmcnt(0)"
                 : "=&v"(r[0]), "=&v"(r[1]), "=&v"(r[2]), "=&v"(r[3]) : "v"(a0), "v"(a0 + d), "v"(a1), "v"(a1 + d) : "memory");
}
__device__ __forceinline__ bf16x8 cat4(s16x4 a, s16x4 b) { return (bf16x8){a[0], a[1], a[2], a[3], b[0], b[1], b[2], b[3]}; }
constexpr int FO_C = 131072, FO_S = 139264;
__device__ __forceinline__ void p4_fourier(const Frame& F) {
    LAS unsigned char* L = F.lds;
    const int tid = F.tid, w = F.wave, lane = F.lane, fr = lane & 15, fq = lane >> 4;
    const bf16_t* PA = (const bf16_t*)(F.ws + WS_PA); unsigned char* Y = (unsigned char*)(F.ws + WS_Y);
    __syncthreads();
    for (int i = tid; i < 4096; i += NTHR) { const int k2 = i >> 6, c = i & 63; const float a = (float)((k2 * c) & 63) * (1.0f / 64.0f);
        *(LAS bf16_t*)(L + FO_C + i * 2) = (bf16_t)(cvt_pk_bf16(__builtin_amdgcn_cosf(a) * 0.125f, 0.f) & 0xffffu);
        *(LAS bf16_t*)(L + FO_S + i * 2) = (bf16_t)(cvt_pk_bf16(__builtin_amdgcn_sinf(a) * 0.125f, 0.f) & 0xffffu); }
    bf16x8 Gf[2][2];
#pragma unroll
    for (int nt = 0; nt < 2; ++nt)
#pragma unroll
        for (int ks = 0; ks < 2; ++ks) { unsigned pk[4];
#pragma unroll
            for (int j = 0; j < 8; j += 2) { const int k1 = 16 * nt + fr, ra = 8 * fq + j, rb = ra + 1; const float aa = (float)((k1 * ra) & 31) * (1.0f / 32.0f), ab = (float)((k1 * rb) & 31) * (1.0f / 32.0f);
                const float va = (ks ? __builtin_amdgcn_sinf(aa) : __builtin_amdgcn_cosf(aa)) * 0.17677669529663687f, vb = (ks ? __builtin_amdgcn_sinf(ab) : __builtin_amdgcn_cosf(ab)) * 0.17677669529663687f;
                pk[j >> 1] = cvt_pk_bf16(va, vb); }
            u32x4 t4 = (u32x4){pk[0], pk[1], pk[2], pk[3]}; Gf[nt][ks] = *(bf16x8*)&t4; }
    const unsigned lbase = (unsigned)(size_t)L;
    for (int it = F.c; it < 1024; it += F.G) {
        const int xcd = it & 7, jj = it >> 3, slab = 4 * xcd + (jj & 3), b = jj >> 2;
        __syncthreads();
        {   const bf16_t* src = PA + (size_t)(b * 32 + slab) * 2048 * 32;
            u32x4 v[16];
#pragma unroll
            for (int n = 0; n < 16; ++n) v[n] = *(const u32x4*)(src + (size_t)(tid + NTHR * n) * 8);
#pragma unroll
            for (int n = 0; n < 16; ++n) *(LAS u32x4*)(L + (tid + NTHR * n) * 16) = v[n]; }
        __syncthreads();
#pragma unroll 1
        for (int rr = 0; rr < 4; ++rr) {
            const int r = w + 8 * rr;
            f32x4 acc[8];
#pragma unroll
            for (int i = 0; i < 8; ++i) acc[i] = (f32x4){0.f, 0.f, 0.f, 0.f};
            s16x4 tr[8];
            {   unsigned aa[4];
#pragma unroll
                for (int ks = 0; ks < 4; ++ks) { const int ri = ks >> 1, c0 = 32 * (ks & 1) + 8 * fq + (fr >> 2); aa[ks] = lbase + (unsigned)((r * 64 + c0) * 64 + ri * 32 + (fr & 3) * 8); }
                tr_read8(aa[0], aa[1], aa[2], aa[3], 4u * 64u, tr); }
#pragma unroll
            for (int ks = 0; ks < 4; ++ks) {
                const int ri = ks >> 1;
                const bf16x8 af = cat4(tr[2 * ks], tr[2 * ks + 1]);
#pragma unroll
                for (int nt = 0; nt < 8; ++nt) { const int ro = nt >> 2, k2 = 16 * (nt & 3) + fr;
                    u32x4 bw = *(const LAS u32x4*)(L + ((ro == ri) ? FO_C : FO_S) + (k2 * 64 + 32 * (ks & 1) + 8 * fq) * 2);
                    if (ro == 1 && ri == 0) { bw.x ^= 0x80008000u; bw.y ^= 0x80008000u; bw.z ^= 0x80008000u; bw.w ^= 0x80008000u; }
                    acc[nt] = __builtin_amdgcn_mfma_f32_16x16x32_bf16(af, *(bf16x8*)&bw, acc[nt], 0, 0, 0); }
            }
#pragma unroll
            for (int nt = 0; nt < 8; ++nt) { const int ro = nt >> 2, k2 = 16 * (nt & 3) + fr;
                *(LAS u32x2*)(L + (r * 64 + k2) * 64 + ro * 32 + fq * 8) = (u32x2){cvt_pk_bf16(acc[nt][0], acc[nt][1]), cvt_pk_bf16(acc[nt][2], acc[nt][3])}; }
        }
        __syncthreads();
#pragma unroll 1
        for (int kk = 0; kk < 8; ++kk) {
            const int k2 = 8 * w + kk;
            f32x4 a2[2] = {(f32x4){0.f, 0.f, 0.f, 0.f}, (f32x4){0.f, 0.f, 0.f, 0.f}};
            s16x4 t4[4];
            {   const int r0 = 8 * fq + (fr >> 2); const unsigned a0 = lbase + (unsigned)((r0 * 64 + k2) * 64 + (fr & 3) * 8);
                tr_read4(a0, a0 + 32u, 4u * 64u * 64u, t4); }
#pragma unroll
            for (int ks = 0; ks < 2; ++ks) {
                const bf16x8 af = cat4(t4[2 * ks], t4[2 * ks + 1]);
                a2[0] = __builtin_amdgcn_mfma_f32_16x16x32_bf16(af, Gf[0][ks], a2[0], 0, 0, 0);
                a2[1] = __builtin_amdgcn_mfma_f32_16x16x32_bf16(af, Gf[1][ks], a2[1], 0, 0, 0);
            }
#pragma unroll
            for (int nt = 0; nt < 2; ++nt) { const int k1 = 16 * nt + fr;
                *(unsigned*)(Y + (size_t)(b * 2048 + k1 * 64 + k2) * 1024 + slab * 16 + 4 * fq) = cvt_pk4_fp8(a2[nt][0], a2[nt][1], a2[nt][2], a2[nt][3]); }
        }
    }
    __syncthreads();
}

struct Args { const float* in[22]; float* out; unsigned char* ws; int ph_lo, ph_hi; };
constexpr int N_PHASES = 9 + 3 * NCH;

__global__ void __launch_bounds__(NTHR, 2) mega_fwd(Args args) {
    extern __shared__ __attribute__((aligned(16))) unsigned char lds_raw[];
    Frame F;
    F.lds = (LAS unsigned char*)lds_raw;
    F.tid = threadIdx.x; F.lane = F.tid & 63; F.wave = __builtin_amdgcn_readfirstlane(F.tid >> 6);
    F.G = gridDim.x; F.c = blockIdx.x;
    F.in = args.in;
    F.out = args.out; F.ws = args.ws; F.ctl = (unsigned*)(args.ws + WS_CTL);
    volatile LAS unsigned* misc = (volatile LAS unsigned*)(F.lds + LDS_MISC);
    if (F.tid < 4) misc[F.tid] = 0u;
    __syncthreads();
    XcdBarrier bar = xcd_barrier_post(F.ctl, misc);
    const int lo = args.ph_lo, hi = args.ph_hi;
#ifndef PHASE_MASK
#define PHASE_MASK 0xFFFFFFFFu
#endif
#define IN(k) ((((PHASE_MASK) >> (k)) & 1u) && lo <= (k) && (k) < hi)
#define SEAM(k) do { if (IN(k) && IN((k) + 1)) xcd_barrier(bar); } while (0)
#ifndef REP_MASK
#define REP_MASK 0u
#endif
#define REPS(b) ((((REP_MASK) >> (b)) & 1u) ? 2 : 1)
#define REPBAR(b, r) do { if ((((REP_MASK) >> (b)) & 1u) && (r) == 0) xcd_barrier(bar); } while (0)
    unsigned char* ws = F.ws;
    LAS unsigned char* blk_e = F.lds + LDS_MISC + 64;
#ifdef PR_A
    unsigned long long* stamps = (unsigned long long*)(ws + 980 * MiB);
#define STAMP(slot) do { if (F.tid == 0) stamps[(slot) * 256 + F.c] = __builtin_amdgcn_s_memrealtime(); } while (0)
#else
#define STAMP(slot) do { } while (0)
#endif
    STAMP(0);

    if (IN(0)) { for (int r = 0; r < REPS(0); ++r) { p0_ada(F); p0_fold(F); p0_convert(F); REPBAR(0, r); } }
    STAMP(1);
    SEAM(0);
    if (IN(1)) { for (int r = 0; r < REPS(1); ++r) { p1_uprep(F); REPBAR(1, r); } }
    STAMP(2);
    SEAM(1);
    if (IN(2)) {
        ProbP1 P{(const char*)(ws + WS_U), 8, 1024u, 1024u, (const char*)(ws + WS_WIN1T), (unsigned)(WS_UC - WS_U), F.G, F.c};
        EpiP1 E{(bf16_t*)(ws + WS_PA), (bf16_t*)(ws + WS_PH), (bf16_t*)(ws + WS_PHC)};
        for (int r = 0; r < REPS(2); ++r) { pg8::gemm_phase<ProbP1, EpiP1, true, false, true>(F.lds, P, E); REPBAR(2, r); }
    }
    STAMP(3);
    SEAM(2);
    if (IN(3)) {
#ifndef NO_FOURIER
        for (int r = 0; r < REPS(4); ++r) { p4_fourier(F); REPBAR(4, r); }
        STAMP(5);
#endif
#ifndef NO_SCAN
        for (int r = 0; r < REPS(3); ++r) { p3_scan(F, r + 1 < REPS(3)); REPBAR(3, r); }
        STAMP(4);
#endif
#ifndef NO_P2GEMM
        ProbDense P{(const char*)(ws + WS_U), 8, 1024u, 1024u, (const char*)(ws + WS_WIN2T), 256, 10, F.G, F.c, 0};
        EpiP2 E{(unsigned char*)(ws + WS_PG), (unsigned char*)F.out};
        for (int r = 0; r < REPS(5); ++r) { pg8::gemm_phase<ProbDense, EpiP2, true, false, true>(F.lds, P, E); REPBAR(5, r); }
#endif
    }
    STAMP(6);
    SEAM(3);
    if (IN(4)) { for (int r = 0; r < REPS(6); ++r) { p6_readout(F); REPBAR(6, r); } }
    STAMP(7);
    SEAM(4);
    if (IN(5)) {
        ProbDense P{(const char*)(ws + WS_Y), 8, 1024u, 1024u, (const char*)(ws + WS_WMT), 256, 4, F.G, F.c, 1};
        EpiM1 E{(const unsigned char*)F.out, (unsigned char*)(ws + WS_PA)};
        for (int r = 0; r < REPS(7); ++r) { pg8::gemm_phase<ProbDense, EpiM1, true, true, true>(F.lds, P, E); REPBAR(7, r); }
    }
    STAMP(8);
    SEAM(5);
    if (IN(6)) {
        ProbDense P{(const char*)(ws + WS_PA), 8, 1024u, 1024u, (const char*)(ws + WS_WOT), 256, 4, F.G, F.c, 0};
        EpiM2 E{(const float*)(ws + WS_ADA), (unsigned char*)F.out};
        for (int r = 0; r < REPS(8); ++r) { pg8::gemm_phase<ProbDense, EpiM2, true, false, true>(F.lds, P, E); REPBAR(8, r); }
    }
    STAMP(9);
    SEAM(6);
    if (IN(7)) { for (int r = 0; r < REPS(9); ++r) { p9_ln1_router(fresh(F), r + 1 < REPS(9)); REPBAR(9, r); } }
    STAMP(10);
    SEAM(7);
    if (IN(8)) { p10_dispatch(F); }
    STAMP(11);
    SEAM(8);
#pragma unroll
    for (int ch = 0; ch < NCH; ++ch) {
        if (IN(9 + 3 * ch)) {
            const int nblk = moe_blocks(F, ch, blk_e);
            ProbMoE<true> P{(const char*)(ws + WS_U), 8, 1024u, 1024u, (const char*)(ws + WS_WGUT), (size_t)2048 * 1024, 8, nblk, F.G, F.c, (const int*)(ws + WS_ROWTOK) + (size_t)ch * ROWS_CH, blk_e};
            EpiGU E{F.in[I_BGU], (unsigned char*)(ws + WS_ACT)};
#ifdef GU_DRY
            pg8::gemm_phase<ProbMoE<true>, EpiGU, true, false, true, GU_DRY>(F.lds, P, E); xcd_barrier(bar);
#endif
            for (int r = 0; r < (ch == 0 ? REPS(10) : 1); ++r) { pg8::gemm_phase<ProbMoE<true>, EpiGU, true, false, true>(F.lds, P, E); if (ch == 0) REPBAR(10, r); }
        }
        STAMP(12);
        SEAM(9 + 3 * ch);
        if (IN(10 + 3 * ch)) {
            const int nblk = moe_blocks(F, ch, blk_e);
            ProbMoE<false> P{(const char*)(ws + WS_ACT), 8, 1024u, 1024u, (const char*)(ws + WS_WDNT), (size_t)1024 * 1024, 4, nblk, F.G, F.c, nullptr, blk_e};
            EpiDN E{F.in[I_BDN], (unsigned char*)(ws + WS_YCH)};
            for (int r = 0; r < (ch == 0 ? REPS(11) : 1); ++r) { pg8::gemm_phase<ProbMoE<false>, EpiDN, true, false, true>(F.lds, P, E); if (ch == 0) REPBAR(11, r); }
        }
        STAMP(13);
        SEAM(10 + 3 * ch);
        if (IN(11 + 3 * ch)) { for (int r = 0; r < (ch == 0 ? REPS(12) : 1); ++r) { p13_combine_ln2(F, ch, ch == 0 && r + 1 < REPS(12)); if (ch == 0) REPBAR(12, r); } }
        STAMP(14);
        SEAM(11 + 3 * ch);
    }
#ifdef DBG_K
    xcd_barrier(bar);
    {
        const unsigned char* buf = (DBG_OUT) ? (const unsigned char*)F.out : (const unsigned char*)(ws + (size_t)(DBG_OFF));
        const size_t wpr = (size_t)(DBG_CW) / 4, nw = (size_t)(DBG_ROWS) * wpr;
        unsigned long long cs = 0; unsigned bad = 0;
        for (size_t i = (size_t)F.c * NTHR + F.tid; i < nw; i += (size_t)F.G * NTHR) { const size_t r = i / wpr, cw = i % wpr; const unsigned w = *(const unsigned*)(buf + r * (size_t)(DBG_LD) + (DBG_C0) + cw * 4); cs += w;
            if (DBG_F32) { if ((w & 0x7f800000u) == 0x7f800000u) ++bad; } else { if ((w & 0x7f80u) == 0x7f80u) ++bad; if ((w & 0x7f800000u) == 0x7f800000u) ++bad; } }
        for (int o = 32; o >= 1; o >>= 1) { cs += __shfl_xor(cs, o); bad += __shfl_xor(bad, o); }
        if (F.lane == 0) { atomicAdd((unsigned long long*)(F.ctl + 8192), cs); atomicAdd(F.ctl + 8200, bad); }
        if (F.c == 0 && F.tid == 0) atomicAdd(F.ctl + 8201, xb_ld(&F.ctl[XB_TMO]));
    }
    xcd_barrier(bar);
    {
        const unsigned long long cs = __hip_atomic_load((unsigned long long*)(F.ctl + 8192), __ATOMIC_RELAXED, __HIP_MEMORY_SCOPE_AGENT);
        const unsigned bad = xb_ld(F.ctl + 8200), tmo = xb_ld(F.ctl + 8201);
        const float val = (float)(unsigned)((cs ^ (cs >> 16) ^ (cs >> 32)) & 0xFFFFu) * (1.0f / 65536.0f) + (bad ? 2.0f : 0.0f) + (tmo ? 4.0f : 0.0f);
        for (size_t i = (size_t)F.c * NTHR + F.tid; i < (size_t)T * D; i += (size_t)F.G * NTHR) F.out[i] = val;
    }
    return;
#endif
#ifdef PR_A
    xcd_barrier(bar);
    {
        auto maxs = [&](int sl) { unsigned long long m = 0; for (int w = 0; w < (int)F.G; ++w) { const unsigned long long v = stamps[sl * 256 + w]; m = v > m ? v : m; } return m; };
        auto dur = [&](int sl) -> float {
            if (sl == 4) { const unsigned long long st = maxs(3); double a = 0; for (int w = 0; w < (int)F.G; ++w) a += (double)(stamps[4 * 256 + w] - st); return (float)(a / F.G) * 0.01f; }
            if (sl == 5) { double a = 0; for (int w = 0; w < (int)F.G; ++w) a += (double)(stamps[5 * 256 + w] - stamps[4 * 256 + w]); return (float)(a / F.G) * 0.01f; }
            if (sl == 6) { double a = 0; for (int w = 0; w < (int)F.G; ++w) a += (double)(stamps[6 * 256 + w] - stamps[5 * 256 + w]); return (float)(a / F.G) * 0.01f; }
            if (sl == 16) return (float)(maxs(6) - maxs(3)) * 0.01f;
            return (float)(maxs(sl) - maxs(sl - 1)) * 0.01f; };
        const float va = rintf(dur(PR_A) * 0.1f + (PR_OFF)) * 0.1f, vb = rintf(dur(PR_B) * 0.1f + (PR_OFF)) * 10.0f;
        for (size_t i = (size_t)F.c * NTHR + F.tid; i < (size_t)T * D; i += (size_t)F.G * NTHR) F.out[i] = va;
        __syncthreads();
        if (F.c == 0 && F.tid == 0) F.out[12345] = vb;
    }
    return;
#endif
    if (F.c == 0 && F.tid == 0 && hi == N_PHASES) { if (xb_ld(&F.ctl[XB_TMO]) != 0u) F.out[0] = __builtin_nanf(""); }
#undef IN
#undef SEAM
}

extern "C" void kernel_launch(void* const* d_in, const int* in_sizes, int n_in, void* d_out, int out_size, void* d_ws, size_t ws_size, hipStream_t stream) {
    static int grid = 0;
    if (grid == 0) {
        if (n_in != 22 || out_size != T * D || ws_size < WS_END) { fprintf(stderr, "kernel_launch: unexpected shapes (n_in %d, out %d, ws %zu)\n", n_in, out_size, ws_size); grid = -1; return; }
        int dev = 0, cus = 0, per_cu = 0;
        if (hipGetDevice(&dev) != hipSuccess || hipDeviceGetAttribute(&cus, hipDeviceAttributeMultiprocessorCount, dev) != hipSuccess) { grid = -1; return; }
        if (hipFuncSetAttribute((const void*)mega_fwd, hipFuncAttributeMaxDynamicSharedMemorySize, LDS_BYTES) != hipSuccess) { fprintf(stderr, "kernel_launch: hipFuncSetAttribute failed\n"); grid = -1; return; }
        if (hipOccupancyMaxActiveBlocksPerMultiprocessor(&per_cu, (const void*)mega_fwd, NTHR, LDS_BYTES) != hipSuccess || per_cu < 1) fprintf(stderr, "kernel_launch: occupancy query reports %d blocks per CU\n", per_cu);
        (void)hipGetLastError();
        grid = cus;
    }
    if (grid < 0) return;
    (void)hipMemsetAsync((char*)d_ws + WS_CTL, 0, CTL_BYTES, stream);
    Args a{};
    for (int i = 0; i < 22; ++i) a.in[i] = (const float*)d_in[i];
    a.out = (float*)d_out; a.ws = (unsigned char*)d_ws; a.ph_lo = 0; a.ph_hi = N_PHASES;
#ifdef DBG_K
    a.ph_hi = DBG_K;
#endif
    hipLaunchKernelGGL(mega_fwd, dim3(grid), dim3(NTHR), LDS_BYTES, stream, a);
}
```

```cpp
#include <hip/hip_runtime.h>
#include <cstdio>
#include <cstdint>

#define LAS __attribute__((address_space(3)))
typedef unsigned short bf16_t;
typedef short bf16x8 __attribute__((ext_vector_type(8)));
typedef short bf16x4 __attribute__((ext_vector_type(4)));
typedef float f32x4 __attribute__((ext_vector_type(4)));
typedef float f32x2 __attribute__((ext_vector_type(2)));
typedef unsigned u32x4 __attribute__((ext_vector_type(4)));
typedef unsigned u32x2 __attribute__((ext_vector_type(2)));

constexpr int D = 1024, NB = 32, SEQ = 2048, T = NB * SEQ, CTX = 256, TCX = NB * CTX;
#ifndef NCH_SET
#define NCH_SET 1
#endif
constexpr int NEXP = 32, TOPK = 4;
constexpr int NCH = NCH_SET, TCH = T / NCH;
constexpr int ROWS_CH = TCH * TOPK + NEXP * 256;
constexpr float DN_ALPHA = 1.189207115002721f;
constexpr float LN_EPS = 1e-5f, RMS_EPS = 1e-6f;
constexpr int NTHR = 512;

constexpr size_t MiB = 1ull << 20;
constexpr size_t WS_CTL = 0;
constexpr size_t CTL_BYTES = 65536;
constexpr size_t WS_ADA = 65536;
constexpr size_t WS_WIN1T = 1 * MiB;
constexpr size_t WS_WIN2T = 7 * MiB;
constexpr size_t WS_WMT = 12 * MiB;
constexpr size_t WS_WOT = 14 * MiB;
constexpr size_t WS_WGUT = 16 * MiB;
constexpr size_t WS_WDNT = 80 * MiB;
constexpr size_t WS_TOPI = 112 * MiB;
constexpr size_t WS_TOPW = 113 * MiB;
constexpr size_t WS_POS = 114 * MiB;
constexpr size_t WS_ROWTOK = 115 * MiB;
constexpr size_t WS_U = 120 * MiB;
constexpr size_t WS_PA = 184 * MiB;
constexpr size_t WS_PH = 312 * MiB;
constexpr size_t WS_PHC = 568 * MiB;
constexpr size_t WS_PG = 600 * MiB;
constexpr size_t WS_Y = 664 * MiB;
constexpr size_t WS_UC = WS_Y;
constexpr size_t WS_ACT = WS_PA;
constexpr size_t WS_YCH = WS_PA + 264 * MiB;
constexpr size_t WS_X1 = WS_YCH + 264 * MiB;
constexpr size_t WS_END = 976 * MiB;
static_assert(WS_X1 + 128 * MiB <= WS_END && (size_t)ROWS_CH * 1024 <= 264 * MiB && WS_Y + 128 * MiB <= WS_END, "ws map");
constexpr int CW_CNT = 4096;
constexpr int CW_CUR = 4096 + 64;

constexpr int LDS_SCRATCH = 155648;
constexpr int LDS_MISC = LDS_SCRATCH;
constexpr int LDS_BYTES = LDS_SCRATCH + 2048;

typedef __bf16 bf16x2_t __attribute__((ext_vector_type(2)));
__device__ __forceinline__ unsigned cvt_pk_bf16(float lo, float hi) { const f32x2 v = {lo, hi}; const bf16x2_t r = __builtin_convertvector(v, bf16x2_t); return __builtin_bit_cast(unsigned, r); }
__device__ __forceinline__ unsigned cvt_pk4_fp8(float a, float b, float c, float d) {
    a = fminf(fmaxf(a, -448.f), 448.f); b = fminf(fmaxf(b, -448.f), 448.f); c = fminf(fmaxf(c, -448.f), 448.f); d = fminf(fmaxf(d, -448.f), 448.f);
    int w = __builtin_amdgcn_cvt_pk_fp8_f32(a, b, 0, false); w = __builtin_amdgcn_cvt_pk_fp8_f32(c, d, w, true); return (unsigned)w; }
constexpr float W8_SCALE = 32.0f, W8_INV = 1.0f / 32.0f;
typedef float f32x2v __attribute__((ext_vector_type(2)));
__device__ __forceinline__ f32x4 fp8x4_to_f32(unsigned w) { const f32x2v a = __builtin_amdgcn_cvt_pk_f32_fp8((int)w, false), b = __builtin_amdgcn_cvt_pk_f32_fp8((int)w, true); return (f32x4){a[0], a[1], b[0], b[1]}; }
__device__ __forceinline__ u32x4 widen16(u32x2 a, u32x2 b) {
    const u32x2 rx = __builtin_amdgcn_permlane16_swap(a.x, b.x, false, false), ry = __builtin_amdgcn_permlane16_swap(a.y, b.y, false, false);
    return (u32x4){rx[0], ry[0], rx[1], ry[1]}; }
__device__ __forceinline__ void unwiden16(u32x4 L, u32x2& a, u32x2& b) {
    const u32x2 rx = __builtin_amdgcn_permlane16_swap(L.x, L.z, false, false), ry = __builtin_amdgcn_permlane16_swap(L.y, L.w, false, false);
    a = (u32x2){rx[0], ry[0]}; b = (u32x2){rx[1], ry[1]}; }
__device__ __forceinline__ unsigned pack4_u8(float a, float b, float c, float d) {
    unsigned w = __builtin_amdgcn_cvt_pk_u8_f32(__builtin_rintf(a), 0, 0u); w = __builtin_amdgcn_cvt_pk_u8_f32(__builtin_rintf(b), 1, w);
    w = __builtin_amdgcn_cvt_pk_u8_f32(__builtin_rintf(c), 2, w); return __builtin_amdgcn_cvt_pk_u8_f32(__builtin_rintf(d), 3, w); }
__device__ __forceinline__ f32x4 u8x4_to_f32(unsigned w) { return (f32x4){(float)(w & 0xffu), (float)((w >> 8) & 0xffu), (float)((w >> 16) & 0xffu), (float)(w >> 24)}; }
__device__ __forceinline__ float bf_lo(unsigned w) { return __uint_as_float(w << 16); }
__device__ __forceinline__ float bf_hi(unsigned w) { return __uint_as_float(w & 0xffff0000u); }
__device__ __forceinline__ float bf2f(bf16_t v) { return __uint_as_float(((unsigned)v) << 16); }
__device__ __forceinline__ float fast_exp(float x) { return __builtin_amdgcn_exp2f(x * 1.4426950408889634f); }
__device__ __forceinline__ float fast_sigmoid(float x) { return __builtin_amdgcn_rcpf(1.0f + fast_exp(-x)); }
__device__ __forceinline__ float fast_log(float x) { return __builtin_amdgcn_logf(x) * 0.6931471805599453f; }

#define XB_TMO      128
#define XB_XCNT(j)  (256  + 64 * (j))
#define XB_XSUB(j)  (1280 + 64 * (j))
#define XB_XGEN(j)  (2304 + 64 * (j))
#define XB_TOP      3328
#define XB_TOPGEN   3392
#define XCD_BAR_WORDS 3456
#define XB_SPIN_CAP (1u << 18)

__device__ __forceinline__ unsigned xb_ld(unsigned* p)              { return __hip_atomic_load(p, __ATOMIC_RELAXED, __HIP_MEMORY_SCOPE_AGENT); }
__device__ __forceinline__ unsigned xb_add(unsigned* p, unsigned v) { return __hip_atomic_fetch_add(p, v, __ATOMIC_RELAXED, __HIP_MEMORY_SCOPE_AGENT); }
__device__ __forceinline__ unsigned xb_xcc_id() { return (unsigned)__builtin_amdgcn_s_getreg((3 << 11) | 20) & 0xFu; }
#define XB_SPIN(cond, bar) do { unsigned _sp = 0; while (cond) { __builtin_amdgcn_s_sleep(1); \
    if ((++_sp & 255u) == 0u) { if (xb_ld(&(bar)[XB_TMO])) break; if (_sp > XB_SPIN_CAP) { atomicAdd(&(bar)[XB_TMO], 1u); break; } } } } while (0)

struct XcdBarrier { unsigned* bar; unsigned x; volatile LAS unsigned* st; };

__device__ __forceinline__ XcdBarrier xcd_barrier_post(unsigned* bar, volatile LAS unsigned* st) {
    XcdBarrier b; b.bar = bar; b.x = xb_xcc_id(); b.st = st;
    if (threadIdx.x == 0) (void)xb_add(&bar[XB_XCNT(b.x)], 1u);
    return b;
}
__device__ __forceinline__ void xcd_barrier_complete(unsigned* bar, unsigned x, unsigned& nloc, unsigned& nx) {
    const unsigned G = gridDim.x * gridDim.y * gridDim.z;
    unsigned sum, cnt, mine, sp = 0u;
    for (;;) {
        sum = 0u; cnt = 0u; mine = 0u;
#pragma unroll
        for (unsigned j = 0; j < 16; ++j) { const unsigned c = xb_ld(&bar[XB_XCNT(j)]); sum += c; cnt += (c > 0u) ? 1u : 0u; mine = (j == x) ? c : mine; }
        if (sum == G) break;
        __builtin_amdgcn_s_sleep(1);
        if ((++sp & 255u) == 0u) { if (xb_ld(&bar[XB_TMO])) break; if (sp > XB_SPIN_CAP) { atomicAdd(&bar[XB_TMO], 1u); break; } }
    }
    nloc = mine > 0u ? mine : 1u; nx = cnt > 0u ? cnt : 1u;
}
__device__ __forceinline__ void xcd_barrier(const XcdBarrier& b) {
    asm volatile("s_waitcnt vmcnt(0)" ::: "memory");
    __syncthreads();
    if (threadIdx.x == 0) {
        unsigned* bar = b.bar;
        __builtin_amdgcn_s_waitcnt(0);
        unsigned nloc = b.st[0], nx = b.st[1];
        if (nloc == 0u) { xcd_barrier_complete(bar, b.x, nloc, nx); b.st[0] = nloc; b.st[1] = nx; }
        const unsigned old = xb_add(&bar[XB_XSUB(b.x)], 1u);
        const unsigned gen = old / nloc;
        if (old + 1u == (gen + 1u) * nloc) {
            __builtin_amdgcn_fence(__ATOMIC_RELEASE, "agent");
            asm volatile("s_waitcnt vmcnt(0)" ::: "memory");
            const unsigned og = xb_add(&bar[XB_TOP], 1u);
            const unsigned tg = og / nx;
            if (og + 1u == (tg + 1u) * nx) xb_add(&bar[XB_TOPGEN], 1u);
            else XB_SPIN(xb_ld(&bar[XB_TOPGEN]) == tg, bar);
            __builtin_amdgcn_fence(__ATOMIC_ACQUIRE, "agent");
            xb_add(&bar[XB_XGEN(b.x)], 1u);
            asm volatile("s_waitcnt vmcnt(0)" ::: "memory");
        } else {
            XB_SPIN(xb_ld(&bar[XB_XGEN(b.x)]) == gen, bar);
            __builtin_amdgcn_fence(__ATOMIC_ACQUIRE, "agent");
            asm volatile("s_waitcnt vmcnt(0)" ::: "memory");
        }
    }
    __syncthreads();
}

#ifndef WGM_SET
#define WGM_SET 8
#endif
namespace pg8 {
constexpr int BM = 256, BK = 64, HALF = 128, HTB = HALF * BK * 2, STAGE_BYTES = 8 * HTB, NXCD = 8, WGM = WGM_SET;
__host__ __device__ __forceinline__ int lds_byte(int r, int c) { const int st = (r >> 4) * 2 + (c >> 5), rr = r & 15, cc = c & 31, ob = rr * 64 + cc * 2; return st * 1024 + (ob ^ (((ob >> 9) & 1) << 5)); }
__host__ __device__ __forceinline__ void stage_rc(int b, int& R, int& C) { const int st = b / 1024, sb = b % 1024, swz = sb ^ (((sb >> 9) & 1) << 5); R = (st >> 1) * 16 + swz / 64; C = (st & 1) * 32 + (swz % 64) / 2; }
__host__ __device__ __forceinline__ int perm32(int rho) { const int n = rho >> 4, i = rho & 15; return 8 * (i >> 2) + 4 * n + (i & 3); }

struct Unit { int pm, pn, aux; };

__device__ __forceinline__ void grouped(int wgid, int nM, int nN, int& pm, int& pn) {
    const int nig = WGM * nN, gid = wgid / nig, fm = gid * WGM, gsz = (nM - fm) < WGM ? (nM - fm) : WGM;
    pm = fm + ((wgid % nig) % gsz); pn = (wgid % nig) / gsz;
}
__device__ __forceinline__ bool xcd_remap(int i, int G, int c, int nwg, int& wgid) {
    const long L = (long)i * G + c; if (L >= nwg) return false;
    wgid = (int)L; const int q = nwg / NXCD, r = nwg % NXCD, xcd = wgid % NXCD, off = wgid / NXCD;
    wgid = (xcd < r ? xcd * (q + 1) : r * (q + 1) + (xcd - r) * q) + off; return true;
}

typedef int i32x8 __attribute__((ext_vector_type(8)));
typedef int i32x4 __attribute__((ext_vector_type(4)));
template <bool F8> struct Frags;
template <> struct Frags<false> { bf16x8 a[4][2], b0[2][2], b1[2][2]; };
template <> struct Frags<true> { i32x8 a[4], b0[2], b1[2]; };
template <class Prob, class Epi, bool ALIGN_EPI, bool HOOK, bool FP8 = false, int DRY = 0>
__device__ __forceinline__ void gemm_phase(LAS unsigned char* lds, const Prob& P, const Epi& E) {
    int tid_ = threadIdx.x; asm volatile("" : "+v"(tid_));
    const int tid = tid_, wid = __builtin_amdgcn_readfirstlane(tid >> 6), lane = tid & 63, wr = wid >> 2, wc = wid & 3, fr = lane & 15, fq = lane >> 4;
    const int nt = P.nt;
    unsigned voffB[2], voffA[2];
#pragma unroll
    for (int i = 0; i < 2; ++i) { int R, C; stage_rc(tid * 16 + i * 8192, R, C); const int Rb = Epi::PERM ? ((R & ~31) + perm32(R & 31)) : R;
        voffB[i] = (unsigned)Rb * P.ldb2 + (unsigned)C * 2u; voffA[i] = (unsigned)R * P.lda2 + (unsigned)C * 2u; }
    auto gather_offs = [&](const Unit& u, unsigned (&o0)[2], unsigned (&o1)[2]) {
#pragma unroll
        for (int i = 0; i < 2; ++i) { int R, C; int tt = threadIdx.x; asm volatile("" : "+v"(tt)); stage_rc(tt * 16 + i * 8192, R, C); o0[i] = P.a_row(u, R) + (unsigned)C * 2u; o1[i] = P.a_row(u, HALF + R) + (unsigned)C * 2u; } };
    const size_t kstep = (size_t)(BK * 2);
    const size_t hstepB = (size_t)HALF * P.ldb2;
    const size_t hstepA = (size_t)HALF * P.lda2;
    const unsigned ldsw = (unsigned)wid * 1024u;
    const int aoff = lds_byte(wr * 64 + fr, fq * 8), boff = lds_byte(wc * 32 + fr, fq * 8);
#define PG8_SA(b, h) (((b) * 2 + (h)) * HTB)
#define PG8_SB(b, h) ((4 + (b) * 2 + (h)) * HTB)
#define PG8_STAGE(bufoff, gbase, voff) do { if constexpr ((DRY & 2) == 0) _Pragma("unroll") for (int _i = 0; _i < 2; ++_i) \
        __builtin_amdgcn_global_load_lds((const unsigned*)((const char*)(gbase) + (voff)[_i]), (LAS unsigned*)(lds + (bufoff) + ldsw + _i * 8192), 16, 0, 0); } while (0)
#define PG8_LDA(dst, b, h) do { if constexpr (FP8) { _Pragma("unroll") for (int m = 0; m < 4; ++m) { FR.a[m].lo = *(const LAS i32x4*)(lds + PG8_SA(b, h) + aoff + m * 2048); FR.a[m].hi = *(const LAS i32x4*)(lds + PG8_SA(b, h) + aoff + m * 2048 + 1024); } } \
        else { _Pragma("unroll") for (int m = 0; m < 4; ++m) _Pragma("unroll") for (int k = 0; k < 2; ++k) FR.a[m][k] = *(const LAS bf16x8*)(lds + PG8_SA(b, h) + aoff + m * 2048 + k * 1024); } } while (0)
#define PG8_LDB(dst, b, h) do { if constexpr (FP8) { _Pragma("unroll") for (int n = 0; n < 2; ++n) { FR.dst[n].lo = *(const LAS i32x4*)(lds + PG8_SB(b, h) + boff + n * 2048); FR.dst[n].hi = *(const LAS i32x4*)(lds + PG8_SB(b, h) + boff + n * 2048 + 1024); } } \
        else { _Pragma("unroll") for (int n = 0; n < 2; ++n) _Pragma("unroll") for (int k = 0; k < 2; ++k) FR.dst[n][k] = *(const LAS bf16x8*)(lds + PG8_SB(b, h) + boff + n * 2048 + k * 1024); } } while (0)
#define PG8_MMA(ai, bj, At, Bt) do { __builtin_amdgcn_s_setprio(1); if constexpr ((DRY & 1) != 0) { asm volatile("" :: "v"(FR.a[0]), "v"(FR.a[3]), "v"(FR.Bt[0]), "v"(FR.Bt[1])); } else if constexpr (FP8) { _Pragma("unroll") for (int m = 0; m < 4; ++m) _Pragma("unroll") for (int n = 0; n < 2; ++n) \
            asm volatile("v_mfma_f32_16x16x128_f8f6f4 %0, %1, %2, %0" : "+v"(acc[ai][bj][m][n]) : "v"(FR.Bt[n]), "v"(FR.a[m])); } \
        else { _Pragma("unroll") for (int m = 0; m < 4; ++m) _Pragma("unroll") for (int n = 0; n < 2; ++n) _Pragma("unroll") for (int k = 0; k < 2; ++k) \
        acc[ai][bj][m][n] = __builtin_amdgcn_mfma_f32_16x16x32_bf16(FR.Bt[n][k], FR.a[m][k], acc[ai][bj][m][n], 0, 0, 0); } __builtin_amdgcn_s_setprio(0); } while (0)
#define PG8_WAIT_V(n) asm volatile("s_waitcnt vmcnt(" #n ")" ::: "memory")
#define PG8_WAIT_L(n) asm volatile("s_waitcnt lgkmcnt(" #n ")" ::: "memory")
#define PG8_BAR __builtin_amdgcn_s_barrier()
#define PG8_SCHED __builtin_amdgcn_sched_barrier(0)
    Unit cur, nxt; int ui = 0;
    if (!P.unit(0, cur)) return;
    f32x4 acc[2][2][4][2];
#pragma unroll
    for (int a = 0; a < 2; ++a)
#pragma unroll
        for (int b = 0; b < 2; ++b)
#pragma unroll
            for (int m = 0; m < 4; ++m)
#pragma unroll
                for (int n = 0; n < 2; ++n) acc[a][b][m][n] = (f32x4){0.f, 0.f, 0.f, 0.f};
    Frags<FP8> FR;
    unsigned va0[2], va1[2], vn0[2], vn1[2];
    const char* const gA = P.Abase; const char* cA = gA; const char* nA = gA; const char* cB = P.b_tile(cur);
    if constexpr (Prob::GATHER) {
        gather_offs(cur, va0, va1);
    } else { cA = gA + P.a_row(cur, 0); }
#define PG8_STAGE_A(bufoff, h, koff, nx) do { if constexpr (Prob::GATHER) { unsigned _v[2]; _Pragma("unroll") for (int _i = 0; _i < 2; ++_i) _v[_i] = (nx) ? ((h) ? vn1[_i] : vn0[_i]) : ((h) ? va1[_i] : va0[_i]); PG8_STAGE(bufoff, gA + (koff), _v); } \
        else { PG8_STAGE(bufoff, ((nx) ? nA : cA) + (h) * hstepA + (koff), voffA); } } while (0)
    PG8_STAGE(PG8_SB(0, 0), cB, voffB); PG8_STAGE(PG8_SB(0, 1), cB + hstepB, voffB); PG8_STAGE_A(PG8_SA(0, 0), 0, 0, false); PG8_STAGE_A(PG8_SA(0, 1), 1, 0, false);
    if (wr == 1) PG8_BAR;
    PG8_WAIT_V(2); PG8_BAR;
    PG8_STAGE(PG8_SB(1, 0), cB + kstep, voffB); PG8_STAGE_A(PG8_SA(1, 0), 0, kstep, false); PG8_STAGE(PG8_SB(1, 1), cB + hstepB + kstep, voffB);
    PG8_WAIT_V(6); PG8_BAR;
    Unit nx2; unsigned vq0[2], vq1[2]; bool has_next = P.unit(1, nxt);
    if (!has_next) nxt = cur;
    if constexpr (Prob::GATHER) gather_offs(nxt, vn0, vn1);
    for (;;) {
        if constexpr (!Prob::GATHER) { has_next = P.unit(ui + 1, nxt); if (!has_next) nxt = cur; nA = gA + P.a_row(nxt, 0); }
        const char* nB = P.b_tile(nxt);
        for (int t = 0; t < nt; t += 2) {
            const bool last = (t == nt - 2);
            if constexpr (HOOK) { if (t == (nt >> 1)) { if constexpr (FP8) asm volatile("s_nop 15\n\ts_nop 15" ::: "memory"); E.mid(acc, cur, wr, wc, fr, fq); } }
            const size_t k1 = (size_t)(t + 1) * kstep, k2 = last ? 0 : (size_t)(t + 2) * kstep, k3 = k2 + kstep;
            const char* b2 = last ? nB : cB + (size_t)(t + 2) * kstep; const char* b3 = b2 + kstep;
            PG8_LDB(b0, 0, 0); PG8_LDB(b1, 0, 1); PG8_SCHED; PG8_LDA(At, 0, 0); PG8_STAGE_A(PG8_SA(1, 1), 1, k1, false);
            PG8_WAIT_V(8); PG8_WAIT_L(0); PG8_BAR; PG8_MMA(0, 0, At, b0); PG8_MMA(0, 1, At, b1); PG8_BAR; PG8_SCHED;
            PG8_LDA(At, 0, 1); PG8_STAGE(PG8_SB(0, 0), b2, voffB); PG8_STAGE(PG8_SB(0, 1), b2 + hstepB, voffB); PG8_STAGE_A(PG8_SA(0, 0), 0, k2, last);
            PG8_WAIT_V(8); PG8_WAIT_L(0); PG8_BAR; PG8_MMA(1, 0, At, b0); PG8_MMA(1, 1, At, b1); PG8_BAR; PG8_SCHED;
            PG8_LDB(b0, 1, 0); PG8_LDB(b1, 1, 1); PG8_SCHED; PG8_LDA(At, 1, 0); PG8_STAGE_A(PG8_SA(0, 1), 1, k2, last);
            PG8_WAIT_V(8); PG8_WAIT_L(0); PG8_BAR; PG8_MMA(0, 0, At, b0); PG8_MMA(0, 1, At, b1); PG8_BAR; PG8_SCHED;
            PG8_LDA(At, 1, 1); PG8_STAGE(PG8_SB(1, 0), b3, voffB); PG8_STAGE(PG8_SB(1, 1), b3 + hstepB, voffB); PG8_STAGE_A(PG8_SA(1, 0), 0, k3, last);
            PG8_WAIT_V(8); PG8_WAIT_L(0); PG8_BAR; PG8_MMA(1, 0, At, b0); PG8_MMA(1, 1, At, b1); PG8_BAR; PG8_SCHED;
        }
        if constexpr (ALIGN_EPI) { if (wr == 0) PG8_BAR; }
        bool has_next2 = false;
        if constexpr (Prob::GATHER) { has_next2 = has_next && P.unit(ui + 2, nx2); if (!has_next2) nx2 = nxt; gather_offs(nx2, vq0, vq1); }
        if constexpr (FP8) asm volatile("s_nop 15\n\ts_nop 15" ::: "memory");
        if constexpr (DRY == 0) E(acc, cur, wr, wc, fr, fq); else { if (acc[0][0][0][0][0] == 1.2345e30f) *(volatile int*)P.Abase = 1; }
        if (!has_next) break;
#pragma unroll
        for (int a = 0; a < 2; ++a)
#pragma unroll
            for (int b = 0; b < 2; ++b)
#pragma unroll
                for (int m = 0; m < 4; ++m)
#pragma unroll
                    for (int n = 0; n < 2; ++n) acc[a][b][m][n] = (f32x4){0.f, 0.f, 0.f, 0.f};
        cur = nxt; cB = nB; cA = nA; ++ui;
        if constexpr (Prob::GATHER) {
#pragma unroll
            for (int i = 0; i < 2; ++i) { va0[i] = vn0[i]; va1[i] = vn1[i]; vn0[i] = vq0[i]; vn1[i] = vq1[i]; }
            nxt = nx2; has_next = has_next2; }
        if constexpr (ALIGN_EPI) { if (wr == 1) PG8_BAR; }
    }
    PG8_WAIT_V(0);
    if constexpr (!ALIGN_EPI) { if (wr == 0) PG8_BAR; }
    PG8_BAR;
#undef PG8_SA
#undef PG8_SB
#undef PG8_STAGE
#undef PG8_STAGE_A
#undef PG8_LDA
#undef PG8_LDB
#undef PG8_MMA
#undef PG8_WAIT_V
#undef PG8_WAIT_L
#undef PG8_BAR
#undef PG8_SCHED
}
}

using pg8::Unit;

struct ProbDense {
    static constexpr bool GATHER = false;
    const char* Abase; int nt; unsigned ldb2; unsigned lda2; const char* Bt; int nM, nN, G, c; int rev;
    __device__ __forceinline__ bool unit(int i, Unit& u) const { int w; if (!pg8::xcd_remap(i, G, c, nM * nN, w)) return false; pg8::grouped(w, nM, nN, u.pm, u.pn); if (rev) u.pm = nM - 1 - u.pm; u.aux = 0; return true; }
    __device__ __forceinline__ unsigned a_row(const Unit& u, int r) const { return (unsigned)(u.pm * 256 + r) * lda2; }
    __device__ __forceinline__ const char* b_tile(const Unit& u) const { return Bt + (size_t)u.pn * 256 * ldb2; }
};
struct ProbP1 {
    static constexpr bool GATHER = false;
    const char* Abase; int nt; unsigned ldb2; unsigned lda2; const char* Bt; unsigned uc_off; int G, c;
    __device__ __forceinline__ bool unit(int i, Unit& u) const {
        int w; if (!pg8::xcd_remap(i, G, c, 3072 + 256, w)) return false;
        if (w < 3072) { pg8::grouped(w, 256, 12, u.pm, u.pn); u.pm = 255 - u.pm; u.aux = 0; }
        else { pg8::grouped(w - 3072, 32, 8, u.pm, u.pn); u.pn += 4; u.aux = 1; }
        return true; }
    __device__ __forceinline__ unsigned a_row(const Unit& u, int r) const { return (u.aux ? uc_off : 0u) + (unsigned)(u.pm * 256 + r) * lda2; }
    __device__ __forceinline__ const char* b_tile(const Unit& u) const { return Bt + (size_t)u.pn * 256 * ldb2; }
};
template <bool GATHER_> struct ProbMoE {
    static constexpr bool GATHER = GATHER_;
    const char* Abase; int nt; unsigned ldb2; unsigned lda2; const char* Bt; size_t estride; int nN, nblk, G, c; const int* rowtok; const LAS unsigned char* blk_e;
    __device__ __forceinline__ bool unit(int i, Unit& u) const { int w; if (!pg8::xcd_remap(i, G, c, nblk * nN, w)) return false; pg8::grouped(w, nblk, nN, u.pm, u.pn); if (!GATHER) u.pm = nblk - 1 - u.pm;
        u.aux = (int)blk_e[u.pm]; return true; }
    __device__ __forceinline__ unsigned a_row(const Unit& u, int r) const { if (GATHER) return (unsigned)rowtok[u.pm * 256 + r] * lda2; else return (unsigned)(u.pm * 256 + r) * lda2; }
    __device__ __forceinline__ const char* b_tile(const Unit& u) const { return Bt + (size_t)u.aux * estride + (size_t)u.pn * 256 * ldb2; }
};

struct EpiP1 {
    static constexpr bool PERM = true;
    bf16_t* PA; bf16_t* PH; bf16_t* PHC;
    __device__ __forceinline__ void operator()(const f32x4 (&acc)[2][2][4][2], const Unit& u, int wr, int wc, int fr, int fq) const {
        const int row0 = u.pm * 256 + wr * 64 + fr;
        if (!u.aux && u.pn < 4) {
            const int col0 = u.pn * 256 + wc * 32 + 8 * fq;
#pragma unroll
            for (int ai = 0; ai < 2; ++ai)
#pragma unroll
                for (int m = 0; m < 4; ++m) { const int row = row0 + ai * 128 + m * 16, b = row >> 11, t = row & 2047;
#pragma unroll
                    for (int bj = 0; bj < 2; ++bj) { const int col = col0 + bj * 128, reim = col >> 9, c5 = col & 511, slab = c5 >> 4, half = (c5 >> 3) & 1;
                        const f32x4 v0 = acc[ai][bj][m][0] * W8_INV, v1 = acc[ai][bj][m][1] * W8_INV;
                        u32x4 w; w.x = cvt_pk_bf16(v0[0], v0[1]); w.y = cvt_pk_bf16(v0[2], v0[3]); w.z = cvt_pk_bf16(v1[0], v1[1]); w.w = cvt_pk_bf16(v1[2], v1[3]);
                        *(u32x4*)(PA + ((((size_t)(b * 32 + slab) * 2048 + t) * 2 + reim) * 16 + half * 8)) = w; } }
            return;
        }
        bf16_t* base = u.aux ? PHC : PH; const int ldc = 2048, colt = (u.pn - 4) * 256;
        if (u.pn < 6 || u.pn >= 10) {
            const bool isq = u.pn < 6;
            unsigned char* b8 = (unsigned char*)base + (isq ? (u.pn - 4) * 256 : 3072 + (u.pn - 10) * 256) + wc * 32 + (fq >> 1) * 16;
#pragma unroll
            for (int ai = 0; ai < 2; ++ai)
#pragma unroll
                for (int bj = 0; bj < 2; ++bj) { u32x2 pk[4];
#pragma unroll
                    for (int m = 0; m < 4; ++m) { f32x4 v0 = acc[ai][bj][m][0] * W8_INV, v1 = acc[ai][bj][m][1] * W8_INV;
                        if (isq) {
#pragma unroll
                            for (int j = 0; j < 4; ++j) { v0[j] *= fast_sigmoid(v0[j]); v1[j] *= fast_sigmoid(v1[j]); } }
                        pk[m] = (u32x2){cvt_pk4_fp8(v0[0], v0[1], v0[2], v0[3]), cvt_pk4_fp8(v1[0], v1[1], v1[2], v1[3])}; }
#pragma unroll
                    for (int mp = 0; mp < 2; ++mp)
                        *(u32x4*)(b8 + (size_t)(row0 + ai * 128 + (2 * mp + (fq & 1)) * 16) * 4096 + bj * 128) = widen16(pk[2 * mp], pk[2 * mp + 1]); }
            return;
        }
        const int col0 = colt + wc * 32 + 8 * fq;
#pragma unroll
        for (int ai = 0; ai < 2; ++ai)
#pragma unroll
            for (int m = 0; m < 4; ++m) { bf16_t* rowp = base + (size_t)(row0 + ai * 128 + m * 16) * ldc + col0;
#pragma unroll
                for (int bj = 0; bj < 2; ++bj) { const f32x4 v0 = acc[ai][bj][m][0] * W8_INV, v1 = acc[ai][bj][m][1] * W8_INV;
                    u32x4 w; w.x = cvt_pk_bf16(v0[0], v0[1]); w.y = cvt_pk_bf16(v0[2], v0[3]); w.z = cvt_pk_bf16(v1[0], v1[1]); w.w = cvt_pk_bf16(v1[2], v1[3]);
                    *(u32x4*)(rowp + bj * 128) = w; } }
    }
    __device__ __forceinline__ void mid(f32x4 (&)[2][2][4][2], const Unit&, int, int, int, int) const {}
};
struct EpiP2 {
    static constexpr bool PERM = true;
    unsigned char* PG; unsigned char* GATES;
    __device__ __forceinline__ void operator()(const f32x4 (&acc)[2][2][4][2], const Unit& u, int wr, int wc, int fr, int fq) const {
        const int row0 = u.pm * 256 + wr * 64 + fr;
        if (u.pn < 2) {
            const int colp = u.pn * 256 + wc * 32 + (fq >> 1) * 16;
#pragma unroll
            for (int ai = 0; ai < 2; ++ai)
#pragma unroll
                for (int bj = 0; bj < 2; ++bj) { u32x2 pk[4];
#pragma unroll
                    for (int m = 0; m < 4; ++m) { f32x4 v0 = acc[ai][bj][m][0] * W8_INV, v1 = acc[ai][bj][m][1] * W8_INV;
#pragma unroll
                        for (int j = 0; j < 4; ++j) { v0[j] *= fast_sigmoid(v0[j]); v1[j] *= fast_sigmoid(v1[j]); }
                        pk[m] = (u32x2){cvt_pk4_fp8(v0[0], v0[1], v0[2], v0[3]), cvt_pk4_fp8(v1[0], v1[1], v1[2], v1[3])}; }
#pragma unroll
                    for (int mp = 0; mp < 2; ++mp)
                        *(u32x4*)(PG + (size_t)(row0 + ai * 128 + (2 * mp + (fq & 1)) * 16) * 512 + colp + bj * 128) = widen16(pk[2 * mp], pk[2 * mp + 1]); }
            return;
        }
        const int colt = (u.pn - 2) * 256 + wc * 32 + (fq >> 1) * 16;
#pragma unroll
        for (int ai = 0; ai < 2; ++ai)
#pragma unroll
            for (int bj = 0; bj < 2; ++bj) { u32x2 pk[4];
#pragma unroll
                for (int m = 0; m < 4; ++m) { f32x4 v0 = acc[ai][bj][m][0] * W8_INV, v1 = acc[ai][bj][m][1] * W8_INV;
#pragma unroll
                    for (int j = 0; j < 4; ++j) { v0[j] = fmaxf(fast_sigmoid(v0[j]) * 255.0f, 1.0f); v1[j] = fmaxf(fast_sigmoid(v1[j]) * 255.0f, 1.0f); }
                    pk[m] = (u32x2){pack4_u8(v0[0], v0[1], v0[2], v0[3]), pack4_u8(v1[0], v1[1], v1[2], v1[3])}; }
#pragma unroll
                for (int mp = 0; mp < 2; ++mp)
                    *(u32x4*)(GATES + (size_t)(row0 + ai * 128 + (2 * mp + (fq & 1)) * 16) * 2048 + colt + bj * 128) = widen16(pk[2 * mp], pk[2 * mp + 1]); }
    }
    __device__ __forceinline__ void mid(f32x4 (&)[2][2][4][2], const Unit&, int, int, int, int) const {}
};
struct EpiM1 {
    static constexpr bool PERM = true;
    const unsigned char* GATES; unsigned char* Mo;
    __device__ __forceinline__ void mid(f32x4 (&acc)[2][2][4][2], const Unit& u, int wr, int wc, int fr, int fq) const {
        int row0 = u.pm * 256 + wr * 64 + fr + (fq & 1) * 16, col0 = u.pn * 256 + wc * 32 + (fq >> 1) * 16;
        asm volatile("" : "+v"(row0), "+v"(col0));
#pragma unroll
        for (int ai = 0; ai < 2; ++ai) {
            u32x4 gf[2][2], gh[2][2];
#pragma unroll
            for (int mp = 0; mp < 2; ++mp) { const unsigned char* gp = GATES + (size_t)(row0 + ai * 128 + mp * 32) * 2048 + col0;
#pragma unroll
                for (int bj = 0; bj < 2; ++bj) { gf[mp][bj] = *(const u32x4*)(gp + bj * 128); gh[mp][bj] = *(const u32x4*)(gp + 1024 + bj * 128); } }
#pragma unroll
            for (int mp = 0; mp < 2; ++mp)
#pragma unroll
                for (int bj = 0; bj < 2; ++bj) { u32x2 f2[2], h2[2]; unwiden16(gf[mp][bj], f2[0], f2[1]); unwiden16(gh[mp][bj], h2[0], h2[1]);
#pragma unroll
                    for (int q = 0; q < 2; ++q) { const int m = 2 * mp + q;
                        const f32x4 fa = u8x4_to_f32(f2[q].x), fb = u8x4_to_f32(f2[q].y), ha = u8x4_to_f32(h2[q].x), hb = u8x4_to_f32(h2[q].y);
#pragma unroll
                        for (int j = 0; j < 4; ++j) { acc[ai][bj][m][0][j] *= fa[j] * __builtin_amdgcn_rcpf(ha[j]); acc[ai][bj][m][1][j] *= fb[j] * __builtin_amdgcn_rcpf(hb[j]); } } }
            asm volatile("" ::: "memory");
        }
    }
    __device__ __forceinline__ void operator()(const f32x4 (&acc)[2][2][4][2], const Unit& u, int wr, int wc, int fr, int fq) const {
        const int row0 = u.pm * 256 + wr * 64 + fr, col0 = u.pn * 256 + wc * 32 + (fq >> 1) * 16;
        const float sc = W8_INV * (1.0f / 255.0f);
#pragma unroll
        for (int ai = 0; ai < 2; ++ai) {
            u32x4 gh[2][2];
#pragma unroll
            for (int mp = 0; mp < 2; ++mp) { const unsigned char* gp = GATES + (size_t)(row0 + ai * 128 + (2 * mp + (fq & 1)) * 16) * 2048 + 1024 + col0;
#pragma unroll
                for (int bj = 0; bj < 2; ++bj) gh[mp][bj] = *(const u32x4*)(gp + bj * 128); }
#pragma unroll
            for (int bj = 0; bj < 2; ++bj) { u32x2 pk[4];
#pragma unroll
                for (int mp = 0; mp < 2; ++mp) { u32x2 h2[2]; unwiden16(gh[mp][bj], h2[0], h2[1]);
#pragma unroll
                    for (int q = 0; q < 2; ++q) { const int m = 2 * mp + q; const f32x4 ha = u8x4_to_f32(h2[q].x) * sc, hb = u8x4_to_f32(h2[q].y) * sc;
                        const f32x4 v0 = acc[ai][bj][m][0] * ha, v1 = acc[ai][bj][m][1] * hb;
                        pk[m] = (u32x2){cvt_pk4_fp8(v0[0], v0[1], v0[2], v0[3]), cvt_pk4_fp8(v1[0], v1[1], v1[2], v1[3])}; } }
#pragma unroll
                for (int mp = 0; mp < 2; ++mp)
                    *(u32x4*)(Mo + (size_t)(row0 + ai * 128 + (2 * mp + (fq & 1)) * 16) * 1024 + col0 + bj * 128) = widen16(pk[2 * mp], pk[2 * mp + 1]); }
            asm volatile("" ::: "memory");
        }
    }
};
constexpr float V8_SCALE = 16.0f, V8_INV = 1.0f / 16.0f;
struct EpiM2 {
    static constexpr bool PERM = true;
    const float* ada; unsigned char* V;
    __device__ __forceinline__ void operator()(const f32x4 (&acc)[2][2][4][2], const Unit& u, int wr, int wc, int fr, int fq) const {
        const int row0 = u.pm * 256 + wr * 64 + fr, col0 = u.pn * 256 + wc * 32 + 8 * fq, colw = u.pn * 256 + wc * 32 + (fq >> 1) * 16;
        const float* g1 = ada + (size_t)(u.pm >> 3) * 6144 + 2048 + col0;
        f32x4 gv[2][2];
#pragma unroll
        for (int bj = 0; bj < 2; ++bj)
#pragma unroll
            for (int n = 0; n < 2; ++n) gv[bj][n] = *(const f32x4*)(g1 + bj * 128 + n * 4) * (W8_INV * V8_SCALE);
#pragma unroll
        for (int ai = 0; ai < 2; ++ai)
#pragma unroll
            for (int bj = 0; bj < 2; ++bj) { u32x2 pk[4];
#pragma unroll
                for (int m = 0; m < 4; ++m) { const f32x4 v0 = gv[bj][0] * acc[ai][bj][m][0], v1 = gv[bj][1] * acc[ai][bj][m][1];
                    pk[m] = (u32x2){cvt_pk4_fp8(v0[0], v0[1], v0[2], v0[3]), cvt_pk4_fp8(v1[0], v1[1], v1[2], v1[3])}; }
#pragma unroll
                for (int mp = 0; mp < 2; ++mp)
                    *(u32x4*)(V + (size_t)(row0 + ai * 128 + (2 * mp + (fq & 1)) * 16) * 1024 + colw + bj * 128) = widen16(pk[2 * mp], pk[2 * mp + 1]); }
    }
    __device__ __forceinline__ void mid(f32x4 (&)[2][2][4][2], const Unit&, int, int, int, int) const {}
};
struct EpiGU {
    static constexpr bool PERM = true;
    const float* bgu; unsigned char* ACT;
    __device__ __forceinline__ void operator()(const f32x4 (&acc)[2][2][4][2], const Unit& u, int wr, int wc, int fr, int fq) const {
        const int row0 = u.pm * 256 + wr * 64 + fr, col0 = u.pn * 128 + wc * 32 + 8 * fq;
        const float* bp = bgu + (size_t)u.aux * 2048 + col0;
        const f32x4 bg0 = *(const f32x4*)(bp), bg1 = *(const f32x4*)(bp + 4), bu0 = *(const f32x4*)(bp + 1024), bu1 = *(const f32x4*)(bp + 1028);
#pragma unroll
        for (int ai = 0; ai < 2; ++ai) { u32x2 pk[4];
#pragma unroll
            for (int m = 0; m < 4; ++m) {
                f32x4 g0 = acc[ai][0][m][0] * W8_INV + bg0, g1 = acc[ai][0][m][1] * W8_INV + bg1, p0 = acc[ai][1][m][0] * W8_INV + bu0, p1 = acc[ai][1][m][1] * W8_INV + bu1;
#pragma unroll
                for (int j = 0; j < 4; ++j) {
                    float g = fminf(g0[j], 7.0f), p = fminf(fmaxf(p0[j], -7.0f), 7.0f); g0[j] = (p + 1.0f) * g * fast_sigmoid(1.702f * g);
                    g = fminf(g1[j], 7.0f); p = fminf(fmaxf(p1[j], -7.0f), 7.0f); g1[j] = (p + 1.0f) * g * fast_sigmoid(1.702f * g); }
                pk[m] = (u32x2){cvt_pk4_fp8(g0[0], g0[1], g0[2], g0[3]), cvt_pk4_fp8(g1[0], g1[1], g1[2], g1[3])}; }
#pragma unroll
            for (int mp = 0; mp < 2; ++mp)
                *(u32x4*)(ACT + (size_t)(row0 + ai * 128 + (2 * mp + (fq & 1)) * 16) * 1024 + u.pn * 128 + wc * 32 + (fq >> 1) * 16) = widen16(pk[2 * mp], pk[2 * mp + 1]); }
    }
    __device__ __forceinline__ void mid(f32x4 (&)[2][2][4][2], const Unit&, int, int, int, int) const {}
};
struct EpiDN {
    static constexpr bool PERM = true;
    const float* bdn; unsigned char* Y;
    __device__ __forceinline__ void operator()(const f32x4 (&acc)[2][2][4][2], const Unit& u, int wr, int wc, int fr, int fq) const {
        const int row0 = u.pm * 256 + wr * 64 + fr, col0 = u.pn * 256 + wc * 32 + 8 * fq;
        const float* bp = bdn + (size_t)u.aux * 1024 + col0;
        f32x4 bv[2][2];
#pragma unroll
        for (int bj = 0; bj < 2; ++bj)
#pragma unroll
            for (int n = 0; n < 2; ++n) bv[bj][n] = *(const f32x4*)(bp + bj * 128 + 4 * n);
#pragma unroll
        for (int ai = 0; ai < 2; ++ai)
#pragma unroll
            for (int bj = 0; bj < 2; ++bj) { u32x2 pk[4];
#pragma unroll
                for (int m = 0; m < 4; ++m) { const f32x4 v0 = acc[ai][bj][m][0] * W8_INV + bv[bj][0], v1 = acc[ai][bj][m][1] * W8_INV + bv[bj][1];
                    pk[m] = (u32x2){cvt_pk4_fp8(v0[0], v0[1], v0[2], v0[3]), cvt_pk4_fp8(v1[0], v1[1], v1[2], v1[3])}; }
#pragma unroll
                for (int mp = 0; mp < 2; ++mp)
                    *(u32x4*)(Y + (size_t)(row0 + ai * 128 + (2 * mp + (fq & 1)) * 16) * 1024 + u.pn * 256 + bj * 128 + wc * 32 + (fq >> 1) * 16) = widen16(pk[2 * mp], pk[2 * mp + 1]); }
    }
    __device__ __forceinline__ void mid(f32x4 (&)[2][2][4][2], const Unit&, int, int, int, int) const {}
};

struct Frame {
    LAS unsigned char* lds; int tid, lane, wave, G, c;
    const float* const* in; float* out; unsigned char* ws; unsigned* ctl;
};
enum { I_X = 0, I_C, I_CTX, I_CCTX, I_WADA, I_BADA, I_WIN, I_LBRAW, I_HGG, I_WFO, I_WHO, I_WO, I_LN1G, I_LN1B, I_WR, I_BR, I_WGU, I_BGU, I_WDN, I_BDN, I_LN2G, I_LN2B };

__device__ __forceinline__ float wave_sum(float v) {
#pragma unroll
    for (int o = 32; o >= 1; o >>= 1) v += __shfl_xor(v, o);
    return v;
}

__device__ __forceinline__ Frame fresh(const Frame& F) { Frame G = F; int t = threadIdx.x; asm volatile("" : "+v"(t)); G.tid = t; G.lane = t & 63; G.wave = __builtin_amdgcn_readfirstlane(t >> 6); return G; }

__device__ __forceinline__ void p0_ada(const Frame& F) {
    LAS float* cact = (LAS float*)F.lds;
    float* ada = (float*)(F.ws + WS_ADA);
    for (int cb = F.c; cb < 192; cb += F.G) {
        const int kg = F.tid >> 5, col = F.tid & 31, gcol = cb * 32 + col;
        float w[16][4];
#pragma unroll
        for (int i = 0; i < 16; ++i)
#pragma unroll
            for (int j = 0; j < 4; ++j) w[i][j] = F.in[I_WADA][(size_t)(4 * kg + 64 * i + j) * 6144 + gcol];
        f32x4 cv[17];
#pragma unroll
        for (int it = 0; it < 17; ++it) { const int q = F.tid + it * NTHR, bq = q >> 8, k4 = (q & 255) * 4; cv[it] = (f32x4){0.f, 0.f, 0.f, 0.f};
            if (q < 33 * 256) cv[it] = *(const f32x4*)(bq < 32 ? F.in[I_C] + bq * 1024 + k4 : F.in[I_CCTX] + k4); }
#pragma unroll
        for (int it = 0; it < 17; ++it) { const int q = F.tid + it * NTHR; f32x4 v = cv[it];
#pragma unroll
            for (int j = 0; j < 4; ++j) v[j] = v[j] * fast_sigmoid(v[j]);
            if (q < 33 * 256) *(LAS f32x4*)(cact + q * 4) = v; }
        __syncthreads();
        float acc[33];
#pragma unroll
        for (int bb = 0; bb < 33; ++bb) acc[bb] = 0.f;
#pragma unroll
        for (int i = 0; i < 16; ++i)
#pragma unroll
            for (int bb = 0; bb < 33; ++bb) { const f32x4 c4 = *(const LAS f32x4*)(cact + bb * 1024 + 4 * kg + 64 * i);
                acc[bb] += (c4[0] * w[i][0] + c4[1] * w[i][1]) + (c4[2] * w[i][2] + c4[3] * w[i][3]); }
        __syncthreads();
        LAS float* red = cact;
#pragma unroll
        for (int bb = 0; bb < 33; ++bb) red[(kg * 33 + bb) * 32 + col] = acc[bb];
        __syncthreads();
        for (int o = F.tid; o < 33 * 32; o += NTHR) { const int bb = o >> 5, cc = o & 31; float sum = 0.f;
#pragma unroll
            for (int g = 0; g < 16; ++g) sum += red[(g * 33 + bb) * 32 + cc];
            ada[(size_t)bb * 6144 + cb * 32 + cc] = sum + F.in[I_BADA][cb * 32 + cc]; }
        __syncthreads();
    }
}
__device__ __forceinline__ void p0_fold(const Frame& F) {
    LAS float* xr = (LAS float*)F.lds;
    LAS float* cs = xr + 2048;
    unsigned char* W1 = (unsigned char*)(F.ws + WS_WIN1T);
    if (F.tid < 128) { const float a = (float)F.tid * (1.0f / 128.0f); cs[F.tid] = __builtin_amdgcn_cosf(a); cs[128 + F.tid] = __builtin_amdgcn_sinf(a); }
    for (int kb = F.c; kb < 256; kb += F.G) {
        __syncthreads();
        for (int i = F.tid; i < 2048; i += NTHR) xr[i] = F.in[I_WIN][(size_t)(4 * kb + (i >> 9)) * 5120 + (i & 511)];
        __syncthreads();
        const int g = F.tid >> 7, j = F.tid & 127;
        float ac[4] = {0.f, 0.f, 0.f, 0.f}, as[4] = {0.f, 0.f, 0.f, 0.f};
        for (int d = 0; d < 128; ++d) { const int idx = (d * j) & 127; const float cv = cs[idx], sv = cs[128 + idx];
#pragma unroll
            for (int r = 0; r < 4; ++r) { const float xv = xr[r * 512 + g * 128 + d]; ac[r] += xv * cv; as[r] += xv * sv; } }
        const float sc = 0.08838834764831845f * W8_SCALE;
        *(unsigned*)(W1 + (size_t)(g * 128 + j) * 1024 + 4 * kb) = cvt_pk4_fp8(ac[0] * sc, ac[1] * sc, ac[2] * sc, ac[3] * sc);
        *(unsigned*)(W1 + (size_t)(512 + g * 128 + j) * 1024 + 4 * kb) = cvt_pk4_fp8(-as[0] * sc, -as[1] * sc, -as[2] * sc, -as[3] * sc);
    }
    __syncthreads();
}
struct CvJob { const float* src; int sld; unsigned char* dst; int f8; };
__device__ __forceinline__ CvJob cv_job(const Frame& F, int j) {
    CvJob J;
    if (j < 128) { const int kt = j >> 4, nt = j & 15; J.src = F.in[I_WIN] + (size_t)kt * 128 * 5120 + 512 + nt * 128; J.sld = 5120; J.dst = F.ws + WS_WIN1T + (size_t)(1024 + nt * 128) * 1024 + kt * 128; J.f8 = 1; }
    else if (j < 288) { const int q = j - 128, kt = q / 20, nt = q % 20; J.src = F.in[I_WIN] + (size_t)kt * 128 * 5120 + 2560 + nt * 128; J.sld = 5120; J.dst = F.ws + WS_WIN2T + (size_t)(nt * 128) * 1024 + kt * 128; J.f8 = 1; }
    else if (j < 320) { const int q = j - 288, kt = q >> 3, nt = q & 7; J.src = F.in[I_WFO] + (size_t)kt * 128 * 1024 + nt * 128; J.sld = 1024; J.dst = F.ws + WS_WMT + ((size_t)(nt * 128) * 1024 + kt * 128); J.f8 = 1; }
    else if (j < 352) { const int q = j - 320, kt = q >> 3, nt = q & 7; J.src = F.in[I_WHO] + (size_t)kt * 128 * 1024 + nt * 128; J.sld = 1024; J.dst = F.ws + WS_WMT + ((size_t)(nt * 128) * 1024 + 512 + kt * 128); J.f8 = 1; }
    else if (j < 416) { const int q = j - 352, kt = q >> 3, nt = q & 7; J.src = F.in[I_WO] + (size_t)kt * 128 * 1024 + nt * 128; J.sld = 1024; J.dst = F.ws + WS_WOT + ((size_t)(nt * 128) * 1024 + kt * 128); J.f8 = 1; }
    else if (j < 4512) { const int q = j - 416, e = q >> 7, r = q & 127, kt = r >> 4, jt = r & 15; J.src = F.in[I_WGU] + (size_t)e * 1024 * 2048 + (size_t)kt * 128 * 2048 + jt * 128; J.sld = 2048;
        J.dst = F.ws + WS_WGUT + (size_t)e * 2048 * 1024 + (size_t)((jt & 7) * 256 + (jt >> 3) * 128) * 1024 + kt * 128; J.f8 = 1; }
    else { const int q = j - 4512, e = q >> 6, r = q & 63, kt = r >> 3, nt = r & 7; J.src = F.in[I_WDN] + (size_t)e * 1024 * 1024 + (size_t)kt * 128 * 1024 + nt * 128; J.sld = 1024;
        J.dst = F.ws + WS_WDNT + (size_t)e * 1024 * 1024 + (size_t)(nt * 128) * 1024 + kt * 128; J.f8 = 1; }
    return J;
}
__device__ __forceinline__ void p0_convert(const Frame& F) {
    constexpr int NJ = 128 + 160 + 32 + 32 + 64 + 4096 + 2048;
    LAS float* tile = (LAS float*)F.lds;
    int j = F.c; if (j >= NJ) return;
    CvJob J = cv_job(F, j);
    f32x4 v[8];
#pragma unroll
    for (int i = 0; i < 8; ++i) { const int idx = F.tid + i * NTHR, r = idx >> 5, c4 = idx & 31; v[i] = *(const f32x4*)(J.src + (size_t)r * J.sld + c4 * 4); }
    for (;;) {
        const float sc = J.f8 ? W8_SCALE : 1.0f;
#pragma unroll
        for (int i = 0; i < 8; ++i) { const int idx = F.tid + i * NTHR, r = idx >> 5, c4 = idx & 31; LAS float* p = tile + r * 129 + c4 * 4; p[0] = v[i][0] * sc; p[1] = v[i][1] * sc; p[2] = v[i][2] * sc; p[3] = v[i][3] * sc; }
        __syncthreads();
        const CvJob Jc = J; const int jn = j + F.G; const bool more = jn < NJ;
        if (more) { J = cv_job(F, jn);
#pragma unroll
            for (int i = 0; i < 8; ++i) { const int idx = F.tid + i * NTHR, r = idx >> 5, c4 = idx & 31; v[i] = *(const f32x4*)(J.src + (size_t)r * J.sld + c4 * 4); } }
        if (Jc.f8) {
#pragma unroll
            for (int i = 0; i < 2; ++i) { const int idx = F.tid + i * NTHR, n = idx >> 3, kc = idx & 7; const LAS float* p = tile + (kc * 16) * 129 + n;
                u32x4 w; w.x = cvt_pk4_fp8(p[0], p[129], p[2 * 129], p[3 * 129]); w.y = cvt_pk4_fp8(p[4 * 129], p[5 * 129], p[6 * 129], p[7 * 129]);
                w.z = cvt_pk4_fp8(p[8 * 129], p[9 * 129], p[10 * 129], p[11 * 129]); w.w = cvt_pk4_fp8(p[12 * 129], p[13 * 129], p[14 * 129], p[15 * 129]);
                *(u32x4*)(Jc.dst + (size_t)n * 1024 + kc * 16) = w; }
        } else {
#pragma unroll
            for (int i = 0; i < 4; ++i) { const int idx = F.tid + i * NTHR, n = idx >> 4, kc = idx & 15; const LAS float* p = tile + (kc * 8) * 129 + n;
                u32x4 w; w.x = cvt_pk_bf16(p[0], p[129]); w.y = cvt_pk_bf16(p[2 * 129], p[3 * 129]); w.z = cvt_pk_bf16(p[4 * 129], p[5 * 129]); w.w = cvt_pk_bf16(p[6 * 129], p[7 * 129]);
                *(u32x4*)((bf16_t*)Jc.dst + (size_t)n * 1024 + kc * 8) = w; }
        }
        __syncthreads();
        if (!more) break;
        j = jn;
    }
}

__device__ __forceinline__ void p1_uprep(const Frame& F) {
    const float* ada = (const float*)(F.ws + WS_ADA);
    unsigned char* U = (unsigned char*)(F.ws + WS_U); unsigned char* Uc = (unsigned char*)(F.ws + WS_UC);
    const size_t NIT = (size_t)(T + TCX) * 128, stride = (size_t)F.G * NTHR;
    for (size_t base = (size_t)F.c * NTHR + F.tid; base < NIT; base += 4 * stride) {
        const int col = (int)(base & 127) * 8;
        f32x4 a0[4], a1[4], sh0[4], sh1[4], sc0[4], sc1[4]; unsigned char* dst[4]; bool ok[4];
#pragma unroll
        for (int u = 0; u < 4; ++u) {
            const size_t idx = base + (size_t)u * stride; ok[u] = idx < NIT;
            const int row = (int)((ok[u] ? idx : base) >> 7);
            const bool lat = row < T; const int b = lat ? (row >> 11) : 32;
            const float* src = lat ? F.in[I_X] + (size_t)row * 1024 + col : F.in[I_CTX] + (size_t)(row - T) * 1024 + col;
            dst[u] = lat ? U + (size_t)row * 1024 + col : Uc + (size_t)(row - T) * 1024 + col;
            a0[u] = *(const f32x4*)src; a1[u] = *(const f32x4*)(src + 4);
            const float* ap = ada + (size_t)b * 6144 + col;
            sh0[u] = *(const f32x4*)ap; sh1[u] = *(const f32x4*)(ap + 4); sc0[u] = *(const f32x4*)(ap + 1024); sc1[u] = *(const f32x4*)(ap + 1028);
        }
#pragma unroll
        for (int u = 0; u < 4; ++u) {
            const f32x4 r0 = a0[u] * (sc0[u] + 1.0f) + sh0[u], r1 = a1[u] * (sc1[u] + 1.0f) + sh1[u];
            if (ok[u]) *(u32x2*)dst[u] = (u32x2){cvt_pk4_fp8(r0[0], r0[1], r0[2], r0[3]), cvt_pk4_fp8(r1[0], r1[1], r1[2], r1[3])};
        }
    }
    int* rowtok = (int*)(F.ws + WS_ROWTOK);
    for (int i = F.c * NTHR + F.tid; i < NCH * ROWS_CH; i += F.G * NTHR) rowtok[i] = (i / ROWS_CH) * TCH;
}

__device__ __forceinline__ void p6_readout(const Frame& F) {
    const bf16_t* PH = (const bf16_t*)(F.ws + WS_PH); const unsigned char* PG = (const unsigned char*)(F.ws + WS_PG); unsigned char* Y = (unsigned char*)(F.ws + WS_Y);
    const int l8 = F.lane * 8;
    const f32x4 g0 = *(const f32x4*)(F.in[I_HGG] + l8), g1 = *(const f32x4*)(F.in[I_HGG] + l8 + 4);
    const int tstr = F.G * 8;
    for (int t0 = F.c * 8 + F.wave; t0 < T; t0 += 4 * tstr) {
        u32x4 av[4], bv[4]; u32x2 pv[4]; bool ok[4]; int tt[4];
#pragma unroll
        for (int u = 0; u < 4; ++u) { const int t = t0 + u * tstr; ok[u] = t < T; tt[u] = ok[u] ? t : t0;
            av[u] = *(const u32x4*)(PH + (size_t)tt[u] * 2048 + 512 + l8); bv[u] = *(const u32x4*)(PH + (size_t)tt[u] * 2048 + 1024 + l8); pv[u] = *(const u32x2*)(PG + (size_t)tt[u] * 512 + l8); }
#pragma unroll
        for (int u = 0; u < 4; ++u) {
            const u32x4 a = av[u], b = bv[u]; const f32x4 pa = fp8x4_to_f32(pv[u].x), pb = fp8x4_to_f32(pv[u].y);
            float o[8] = { bf_lo(a.x) + bf_lo(b.x), bf_hi(a.x) + bf_hi(b.x), bf_lo(a.y) + bf_lo(b.y), bf_hi(a.y) + bf_hi(b.y), bf_lo(a.z) + bf_lo(b.z), bf_hi(a.z) + bf_hi(b.z), bf_lo(a.w) + bf_lo(b.w), bf_hi(a.w) + bf_hi(b.w) };
            float ss = 0.f;
#pragma unroll
            for (int i = 0; i < 8; ++i) ss += o[i] * o[i];
            ss += __shfl_xor(ss, 1); ss += __shfl_xor(ss, 2); ss += __shfl_xor(ss, 4); ss += __shfl_xor(ss, 8);
            const float rs = __builtin_amdgcn_rsqf(ss * (1.0f / 128.0f) + RMS_EPS);
            const float sp[8] = { pa[0], pa[1], pa[2], pa[3], pb[0], pb[1], pb[2], pb[3] };
            if (ok[u]) *(u32x2*)(Y + (size_t)tt[u] * 1024 + 512 + l8) = (u32x2){cvt_pk4_fp8(o[0] * rs * g0[0] * sp[0], o[1] * rs * g0[1] * sp[1], o[2] * rs * g0[2] * sp[2], o[3] * rs * g0[3] * sp[3]), cvt_pk4_fp8(o[4] * rs * g1[0] * sp[4], o[5] * rs * g1[1] * sp[5], o[6] * rs * g1[2] * sp[6], o[7] * rs * g1[3] * sp[7])};
        }
    }
}

constexpr int RW_STRIDE = 2080;
constexpr int RW_HI = 0, RW_LO = 32 * RW_STRIDE, RW_PAR = 64 * RW_STRIDE, RW_BR = RW_PAR + 16384, RW_HIST = RW_BR + 128;
__device__ __forceinline__ void p9_ln1_router(const Frame& F, const bool dry) {
    LAS unsigned char* L = F.lds;
    LAS float* par = (LAS float*)(L + RW_PAR); LAS float* brs = (LAS float*)(L + RW_BR); LAS int* hist = (LAS int*)(L + RW_HIST);
#pragma unroll 1
    for (int it = 0; it < 8; ++it) { const int item = F.tid + it * NTHR, e = item & 31, k8 = item >> 5;
        float w[8];
#pragma unroll
        for (int i = 0; i < 8; ++i) w[i] = F.in[I_WR][(k8 * 8 + i) * 32 + e];
        u32x4 hi, lo;
#pragma unroll
        for (int i = 0; i < 4; ++i) { const unsigned h = cvt_pk_bf16(w[2 * i], w[2 * i + 1]); hi[i] = h; lo[i] = cvt_pk_bf16(w[2 * i] - bf_lo(h), w[2 * i + 1] - bf_hi(h)); }
        *(LAS u32x4*)(L + RW_HI + e * RW_STRIDE + k8 * 16) = hi; *(LAS u32x4*)(L + RW_LO + e * RW_STRIDE + k8 * 16) = lo; }
    for (int i = F.tid; i < 2048; i += NTHR) par[i] = i < 1024 ? F.in[I_LN1G][i] : F.in[I_LN1B][i - 1024];
    if (F.tid < 32) brs[F.tid] = F.in[I_BR][F.tid];
    if (F.tid < NCH * 32) hist[F.tid] = 0;
    const unsigned char* V = (const unsigned char*)F.out; bf16_t* X1 = (bf16_t*)(F.ws + WS_X1); unsigned char* U2 = (unsigned char*)(F.ws + WS_U); const float* ada = (const float*)(F.ws + WS_ADA);
    int* topi = (int*)(F.ws + WS_TOPI); float* topw = (float*)(F.ws + WS_TOPW);
    for (int gb = F.c * 8; gb < T / 16; gb += F.G * 8) {
        const int g = T / 16 - 1 - (gb + F.wave), t0 = g * 16, b = (T / 16 - 1 - gb) >> 7;
        __syncthreads();
        { int tz = threadIdx.x; asm volatile("" : "+v"(tz));
          for (int i = tz; i < 2048; i += NTHR) par[2048 + i] = i < 1024 ? 1.0f + ada[(size_t)b * 6144 + 4096 + i] : ada[(size_t)b * 6144 + 3072 + (i - 1024)]; }
        __syncthreads();
        int l1 = threadIdx.x; asm volatile("" : "+v"(l1)); l1 &= 63;
        const float* xp = F.in[I_X] + (size_t)(t0 + (l1 & 15)) * 1024 + 8 * (l1 >> 4); const unsigned char* vp = V + (size_t)(t0 + (l1 & 15)) * 1024 + 8 * (l1 >> 4);
        unsigned tb[32][4]; float s1 = 0.f, s2 = 0.f, s1b = 0.f, s2b = 0.f;
#pragma unroll
        for (int c = 0; c < 16; ++c) {
            f32x4 xa[2], xb[2]; u32x2 vv[2];
#pragma unroll
            for (int q = 0; q < 2; ++q) { const int ks = 2 * c + q; xa[q] = *(const f32x4*)(xp + 32 * ks); xb[q] = *(const f32x4*)(xp + 32 * ks + 4); vv[q] = *(const u32x2*)(vp + 32 * ks); }
#pragma unroll
            for (int q = 0; q < 2; ++q) { const int ks = 2 * c + q;
                const f32x4 ta = xa[q] * DN_ALPHA + fp8x4_to_f32(vv[q].x) * V8_INV, tc = xb[q] * DN_ALPHA + fp8x4_to_f32(vv[q].y) * V8_INV;
#pragma unroll
                for (int j = 0; j < 4; ++j) { s1 += ta[j]; s1b += tc[j]; s2 = __builtin_fmaf(ta[j], ta[j], s2); s2b = __builtin_fmaf(tc[j], tc[j], s2b); }
                tb[ks][0] = cvt_pk_bf16(ta[0], ta[1]); tb[ks][1] = cvt_pk_bf16(ta[2], ta[3]); tb[ks][2] = cvt_pk_bf16(tc[0], tc[1]); tb[ks][3] = cvt_pk_bf16(tc[2], tc[3]); }
            asm volatile("" ::: "memory"); __builtin_amdgcn_sched_barrier(0);
        }
        s1 += s1b; s2 += s2b;
        {   int l4 = threadIdx.x; asm volatile("" : "+v"(l4)); l4 &= 63; const int b16 = (l4 ^ 16) << 2, b32 = (l4 ^ 32) << 2;
            s1 += __int_as_float(__builtin_amdgcn_ds_bpermute(b16, __float_as_int(s1))); s2 += __int_as_float(__builtin_amdgcn_ds_bpermute(b16, __float_as_int(s2)));
            s1 += __int_as_float(__builtin_amdgcn_ds_bpermute(b32, __float_as_int(s1))); s2 += __int_as_float(__builtin_amdgcn_ds_bpermute(b32, __float_as_int(s2))); }
        const float mean = s1 * (1.0f / 1024.0f), rstd = __builtin_amdgcn_rsqf(fmaxf(s2 * (1.0f / 1024.0f) - mean * mean, 0.f) + LN_EPS), nmr = -mean * rstd;
        f32x4 acc[2] = {(f32x4){0.f, 0.f, 0.f, 0.f}, (f32x4){0.f, 0.f, 0.f, 0.f}};
        int l2 = threadIdx.x; asm volatile("" : "+v"(l2)); l2 &= 63; const int fr = l2 & 15, fq = l2 >> 4;
        bf16_t* x1p = X1 + (size_t)(t0 + fr) * 1024 + 8 * fq; unsigned char* u2p = U2 + (size_t)(t0 + fr) * 1024 + 8 * fq;
#pragma unroll
        for (int ks = 0; ks < 32; ++ks) {
            const LAS float* pp = par + 32 * ks + 8 * fq;
            const f32x4 ta = {bf_lo(tb[ks][0]), bf_hi(tb[ks][0]), bf_lo(tb[ks][1]), bf_hi(tb[ks][1])}, tc = {bf_lo(tb[ks][2]), bf_hi(tb[ks][2]), bf_lo(tb[ks][3]), bf_hi(tb[ks][3])};
            f32x4 xa, xc, ua, uc;
            {   const f32x4 g0 = *(const LAS f32x4*)pp, b0 = *(const LAS f32x4*)(pp + 1024), c0 = *(const LAS f32x4*)(pp + 2048), h0 = *(const LAS f32x4*)(pp + 3072);
                xa = (ta * rstd + nmr) * g0 + b0; ua = xa * c0 + h0; }
            __builtin_amdgcn_sched_barrier(0);
            {   const f32x4 g1 = *(const LAS f32x4*)(pp + 4), b1 = *(const LAS f32x4*)(pp + 1028), c1 = *(const LAS f32x4*)(pp + 2052), h1 = *(const LAS f32x4*)(pp + 3076);
                xc = (tc * rstd + nmr) * g1 + b1; uc = xc * c1 + h1; }
            if (!dry) *(u32x4*)(x1p + 32 * ks) = (u32x4){cvt_pk_bf16(xa[0], xa[1]), cvt_pk_bf16(xa[2], xa[3]), cvt_pk_bf16(xc[0], xc[1]), cvt_pk_bf16(xc[2], xc[3])};
            if (!dry) *(u32x2*)(u2p + 32 * ks) = (u32x2){cvt_pk4_fp8(ua[0], ua[1], ua[2], ua[3]), cvt_pk4_fp8(uc[0], uc[1], uc[2], uc[3])};
            u32x4 hi = {cvt_pk_bf16(ua[0], ua[1]), cvt_pk_bf16(ua[2], ua[3]), cvt_pk_bf16(uc[0], uc[1]), cvt_pk_bf16(uc[2], uc[3])};
            u32x4 lo = {cvt_pk_bf16(ua[0] - bf_lo(hi[0]), ua[1] - bf_hi(hi[0])), cvt_pk_bf16(ua[2] - bf_lo(hi[1]), ua[3] - bf_hi(hi[1])), cvt_pk_bf16(uc[0] - bf_lo(hi[2]), uc[1] - bf_hi(hi[2])), cvt_pk_bf16(uc[2] - bf_lo(hi[3]), uc[3] - bf_hi(hi[3]))};
            const bf16x8 uh = *(bf16x8*)&hi, ul = *(bf16x8*)&lo;
#pragma unroll
            for (int et = 0; et < 2; ++et) {
                const bf16x8 wh = *(const LAS bf16x8*)(L + RW_HI + (16 * et + fr) * RW_STRIDE + ks * 64 + fq * 16), wl = *(const LAS bf16x8*)(L + RW_LO + (16 * et + fr) * RW_STRIDE + ks * 64 + fq * 16);
                acc[et] = __builtin_amdgcn_mfma_f32_16x16x32_bf16(wh, uh, acc[et], 0, 0, 0);
                acc[et] = __builtin_amdgcn_mfma_f32_16x16x32_bf16(wh, ul, acc[et], 0, 0, 0);
                acc[et] = __builtin_amdgcn_mfma_f32_16x16x32_bf16(wl, uh, acc[et], 0, 0, 0);
                __builtin_amdgcn_sched_barrier(0); }
        }
        int l3 = threadIdx.x; asm volatile("" : "+v"(l3)); l3 &= 63; const int fq3 = l3 >> 4, t = t0 + (l3 & 15), a16 = (l3 ^ 16) << 2, a32 = (l3 ^ 32) << 2;
        float lv[8]; int li[8];
#pragma unroll
        for (int i = 0; i < 4; ++i) { li[i] = 4 * fq3 + i; li[4 + i] = 16 + 4 * fq3 + i; lv[i] = acc[0][i] + brs[4 * fq3 + i]; lv[4 + i] = acc[1][i] + brs[16 + 4 * fq3 + i]; }
        float tv[4]; int ti[4];
#pragma unroll
        for (int r = 0; r < 4; ++r) {
            float bv = lv[0]; int bi = li[0];
#pragma unroll
            for (int i = 1; i < 8; ++i) { const bool gt = lv[i] > bv; bv = gt ? lv[i] : bv; bi = gt ? li[i] : bi; }
#pragma unroll
            for (int o = 0; o < 2; ++o) { const int ad = o ? a32 : a16; const float ov = __int_as_float(__builtin_amdgcn_ds_bpermute(ad, __float_as_int(bv))); const int oi = __builtin_amdgcn_ds_bpermute(ad, bi); const bool tk = ov > bv || (ov == bv && oi < bi); bv = tk ? ov : bv; bi = tk ? oi : bi; }
            tv[r] = bv; ti[r] = bi;
#pragma unroll
            for (int i = 0; i < 8; ++i) lv[i] = (li[i] == bi) ? -3.0e38f : lv[i];
        }
        if (fq3 == 0) {
            const float p1 = fast_exp(tv[1] - tv[0]), p2 = fast_exp(tv[2] - tv[0]), p3 = fast_exp(tv[3] - tv[0]), inv = 1.0f / (1.0f + p1 + p2 + p3);
            *(int4*)(topi + (size_t)t * 4) = make_int4(ti[0], ti[1], ti[2], ti[3]);
            *(f32x4*)(topw + (size_t)t * 4) = (f32x4){inv, p1 * inv, p2 * inv, p3 * inv};
            const int ch = t / TCH;
            if (!dry) { atomicAdd((int*)(hist + ch * 32 + ti[0]), 1); atomicAdd((int*)(hist + ch * 32 + ti[1]), 1); atomicAdd((int*)(hist + ch * 32 + ti[2]), 1); atomicAdd((int*)(hist + ch * 32 + ti[3]), 1); }
        }
    }
    __syncthreads();
    { int t2 = threadIdx.x; asm volatile("" : "+v"(t2));
      if (t2 < NCH * 32) { const int h = hist[t2]; if (h && !dry) atomicAdd(F.ctl + CW_CNT + t2, (unsigned)h); } }
    __syncthreads();
}

__device__ __forceinline__ void p10_dispatch(const Frame& F) {
    LAS int* lcnt = (LAS int*)F.lds; LAS int* lbase = lcnt + 32; LAS int* pstart = lcnt + 64;
    const int* topi = (const int*)(F.ws + WS_TOPI); int* pos = (int*)(F.ws + WS_POS); int* rowtok = (int*)(F.ws + WS_ROWTOK);
    for (int s = F.c; s < T / 256; s += F.G) {
        const int ch = (s * 256) / TCH;
        __syncthreads();
        if (F.tid < 32) { lcnt[F.tid] = 0; int ps = 0; for (int e = 0; e < F.tid; ++e) { const int n = (int)__hip_atomic_load(F.ctl + CW_CNT + ch * 32 + e, __ATOMIC_RELAXED, __HIP_MEMORY_SCOPE_AGENT); ps += (n + 255) & ~255; } pstart[F.tid] = ps; }
        __syncthreads();
        int e2[2], r2[2];
#pragma unroll
        for (int i = 0; i < 2; ++i) { const int a = F.tid + i * NTHR; e2[i] = topi[(size_t)(s * 256) * 4 + a]; r2[i] = atomicAdd((int*)(lcnt + e2[i]), 1); }
        __syncthreads();
        if (F.tid < 32) lbase[F.tid] = (int)atomicAdd(F.ctl + CW_CUR + ch * 32 + F.tid, (unsigned)lcnt[F.tid]);
        __syncthreads();
#pragma unroll
        for (int i = 0; i < 2; ++i) { const int a = F.tid + i * NTHR, slot = pstart[e2[i]] + lbase[e2[i]] + r2[i];
            pos[(size_t)(s * 256) * 4 + a] = slot; rowtok[(size_t)ch * ROWS_CH + slot] = s * 256 + (a >> 2); }
    }
}
__device__ __forceinline__ int moe_blocks(const Frame& F, int ch, LAS unsigned char* blk_e) {
    LAS int* sh = (LAS int*)(blk_e + 1152);
    __syncthreads();
    if (F.tid < 32) {
        int start = 0, mine = 0;
        for (int e = 0; e < 32; ++e) { const int n = ((int)__hip_atomic_load(F.ctl + CW_CNT + ch * 32 + e, __ATOMIC_RELAXED, __HIP_MEMORY_SCOPE_AGENT) + 255) >> 8; if (e < F.tid) start += n; if (e == F.tid) mine = n; }
        for (int i = 0; i < mine; ++i) blk_e[start + i] = (unsigned char)F.tid;
        if (F.tid == 31) sh[0] = start + mine;
    }
    __syncthreads();
    return sh[0];
}

__device__ __forceinline__ void p13_combine_ln2(const Frame& F, int ch, const bool dry) {
    const unsigned char* YC = (const unsigned char*)(F.ws + WS_YCH); const int* pos = (const int*)(F.ws + WS_POS); const float* topw = (const float*)(F.ws + WS_TOPW);
    const float* ada = (const float*)(F.ws + WS_ADA); const bf16_t* X1 = (const bf16_t*)(F.ws + WS_X1); float* O = F.out;
    const int l8 = F.lane * 8;
    for (int t0 = ch * TCH + F.c * 8 + F.wave; t0 < (ch + 1) * TCH; t0 += 2 * F.G * 8) {
        int tt[2]; tt[0] = t0; tt[1] = t0 + F.G * 8; const bool two = tt[1] < (ch + 1) * TCH; if (!two) tt[1] = t0;
        f32x4 v[2][2][2];
#pragma unroll
        for (int q = 0; q < 2; ++q) { const int t = tt[q], b = t >> 11;
            const int4 ps = *(const int4*)(pos + (size_t)t * 4); const f32x4 tw = *(const f32x4*)(topw + (size_t)t * 4);
#pragma unroll
            for (int j = 0; j < 2; ++j) { const int k = 512 * j + l8;
                const u32x2 y0 = *(const u32x2*)(YC + (size_t)ps.x * 1024 + k), y1 = *(const u32x2*)(YC + (size_t)ps.y * 1024 + k), y2 = *(const u32x2*)(YC + (size_t)ps.z * 1024 + k), y3 = *(const u32x2*)(YC + (size_t)ps.w * 1024 + k);
                const u32x4 xw = *(const u32x4*)(X1 + (size_t)t * 1024 + k);
                const f32x4 g2a = *(const f32x4*)(ada + (size_t)b * 6144 + 5120 + k), g2b = *(const f32x4*)(ada + (size_t)b * 6144 + 5120 + k + 4);
                const f32x4 ffa = fp8x4_to_f32(y0.x) * tw[0] + fp8x4_to_f32(y1.x) * tw[1] + fp8x4_to_f32(y2.x) * tw[2] + fp8x4_to_f32(y3.x) * tw[3];
                const f32x4 ffb = fp8x4_to_f32(y0.y) * tw[0] + fp8x4_to_f32(y1.y) * tw[1] + fp8x4_to_f32(y2.y) * tw[2] + fp8x4_to_f32(y3.y) * tw[3];
                v[q][j][0] = (f32x4){bf_lo(xw.x), bf_hi(xw.x), bf_lo(xw.y), bf_hi(xw.y)} * DN_ALPHA + g2a * ffa;
                v[q][j][1] = (f32x4){bf_lo(xw.z), bf_hi(xw.z), bf_lo(xw.w), bf_hi(xw.w)} * DN_ALPHA + g2b * ffb; } }
#pragma unroll
        for (int q = 0; q < 2; ++q) { const int t = tt[q];
            float s = 0.f;
#pragma unroll
            for (int j = 0; j < 2; ++j)
#pragma unroll
                for (int h = 0; h < 2; ++h) s += (v[q][j][h][0] + v[q][j][h][1]) + (v[q][j][h][2] + v[q][j][h][3]);
            s = wave_sum(s); const float mean = s * (1.0f / 1024.0f); float qq = 0.f;
#pragma unroll
            for (int j = 0; j < 2; ++j)
#pragma unroll
                for (int h = 0; h < 2; ++h) { const f32x4 d = v[q][j][h] - mean; qq += (d[0] * d[0] + d[1] * d[1]) + (d[2] * d[2] + d[3] * d[3]); }
            qq = wave_sum(qq); const float rstd = __builtin_amdgcn_rsqf(qq * (1.0f / 1024.0f) + LN_EPS);
            if (q == 0 || two) {
#pragma unroll
                for (int j = 0; j < 2; ++j)
#pragma unroll
                    for (int h = 0; h < 2; ++h) { const int k = 512 * j + l8 + 4 * h; const f32x4 g = *(const f32x4*)(F.in[I_LN2G] + k), bb = *(const f32x4*)(F.in[I_LN2B] + k);
                        const f32x4 o4 = (v[q][j][h] - mean) * rstd * g + bb;
                        if (!dry) *(f32x4*)(O + (size_t)t * 1024 + k) = o4; else if (o4[0] == 1.2345e30f) O[0] = 1.f; } }
        }
    }
}

constexpr int SC_QD = 0, SC_KI = 17408, SC_KE = 34816, SC_VT = 53248, SC_SC = 71680, SC_ST = 80896, SC_GV = 115712, SC_CS = 116224;
__device__ __forceinline__ bf16x8 ldfrag(const LAS unsigned char* p) { return *(const LAS bf16x8*)p; }
__device__ __forceinline__ void p3_scan(const Frame& F, const bool dry) {
    LAS unsigned char* L = F.lds;
    const int tid = F.tid, w = F.wave, lane = F.lane, fr = lane & 15, fq = lane >> 4;
    const int d = tid & 127, qd = tid >> 7;
    bf16_t* PH = (bf16_t*)(F.ws + WS_PH); const bf16_t* PHC = (const bf16_t*)(F.ws + WS_PHC);
    for (int it = F.c; it < 256; it += F.G) {
        const int b = it >> 3, h = (it >> 1) & 3, dir = it & 1;
        const float r0 = F.in[I_LBRAW][dir * 512 + h * 128 + d], r1 = F.in[I_LBRAW][1024 + dir * 512 + h * 128 + d];
        const float lbv = fast_sigmoid(r0 - r1), oml = 1.0f - lbv;
        f32x4 Sacc[8];
#pragma unroll
        for (int i = 0; i < 8; ++i) Sacc[i] = (f32x4){0.f, 0.f, 0.f, 0.f};
        __syncthreads();
        for (int i = tid; i < 34816 / 4; i += NTHR) ((LAS unsigned*)(L + SC_ST))[i] = 0u;
        const int cq = h * 128 + d, cz = 512 + dir * 512 + h * 128 + d;
        unsigned char rq[16], rv[16]; bf16_t rz[16];
        {   const int n = dir ? 3 : 0; const bf16_t* base = PHC + (size_t)(b * 256 + 64 * n + 16 * qd) * 2048; const unsigned char* base8 = (const unsigned char*)base;
#pragma unroll
            for (int i = 0; i < 16; ++i) { rq[i] = base8[(size_t)i * 4096 + cq]; rz[i] = base[(size_t)i * 2048 + cz]; rv[i] = base8[(size_t)i * 4096 + 3072 + cq]; } }
        for (int s = 0; s < 36; ++s) {
            const bool lat = s >= 4; const int n = lat ? (dir ? 31 - (s - 4) : (s - 4)) : (dir ? 3 - s : s);
            float kk[16], cum[16]; float run = 0.f;
#pragma unroll
            for (int i = 0; i < 16; ++i) { const float sg = fast_sigmoid(bf2f(rz[i])); kk[i] = oml * (1.0f - sg); cum[i] = lbv + oml * sg; }
            run = 1.0f;
            if (dir == 0) {
#pragma unroll
                for (int i = 0; i < 16; ++i) { run *= cum[i]; cum[i] = run; }
            } else {
#pragma unroll
                for (int i = 15; i >= 0; --i) { run *= cum[i]; cum[i] = run; }
            }
            ((LAS float*)(L + SC_CS))[qd * 128 + d] = run;
            __syncthreads();
            {   const LAS float* cs = (const LAS float*)(L + SC_CS);
                const float c0 = cs[d], c1 = cs[128 + d], c2 = cs[256 + d], c3 = cs[384 + d], tot = (c0 * c1) * (c2 * c3);
                float off;
                if (dir == 0) off = (qd > 0 ? c0 : 1.f) * (qd > 1 ? c1 : 1.f) * (qd > 2 ? c2 : 1.f);
                else off = (qd < 3 ? c3 : 1.f) * (qd < 2 ? c2 : 1.f) * (qd < 1 ? c1 : 1.f);
                const float g = tot;
                if (qd == 0) ((LAS float*)(L + SC_GV))[d] = g;
                unsigned ke[8], vt[8];
#pragma unroll
                for (int i = 0; i < 16; i += 2) {
                    const float ea = cum[i] * off, eb = cum[i + 1] * off, ia = __builtin_amdgcn_rcpf(ea), ib = __builtin_amdgcn_rcpf(eb);
                    const float qda = __builtin_amdgcn_cvt_f32_fp8((int)rq[i], 0) * ea, qdb = __builtin_amdgcn_cvt_f32_fp8((int)rq[i + 1], 0) * eb;
                    const float kia = kk[i] * ia, kib = kk[i + 1] * ib;
                    const unsigned wa = cvt_pk_bf16(qda, kia), wb = cvt_pk_bf16(qdb, kib);
                    *(LAS bf16_t*)(L + SC_QD + (16 * qd + i) * 272 + d * 2) = (bf16_t)(wa & 0xffffu);
                    *(LAS bf16_t*)(L + SC_KI + (16 * qd + i) * 272 + d * 2) = (bf16_t)(wa >> 16);
                    *(LAS bf16_t*)(L + SC_QD + (16 * qd + i + 1) * 272 + d * 2) = (bf16_t)(wb & 0xffffu);
                    *(LAS bf16_t*)(L + SC_KI + (16 * qd + i + 1) * 272 + d * 2) = (bf16_t)(wb >> 16);
                    ke[i >> 1] = cvt_pk_bf16(kia * g, kib * g);
                    vt[i >> 1] = cvt_pk_bf16(__builtin_amdgcn_cvt_f32_fp8((int)rv[i], 0), __builtin_amdgcn_cvt_f32_fp8((int)rv[i + 1], 0));
                }
                *(LAS u32x4*)(L + SC_KE + d * 144 + 32 * qd) = (u32x4){ke[0], ke[1], ke[2], ke[3]};
                *(LAS u32x4*)(L + SC_KE + d * 144 + 32 * qd + 16) = (u32x4){ke[4], ke[5], ke[6], ke[7]};
                *(LAS u32x4*)(L + SC_VT + d * 144 + 32 * qd) = (u32x4){vt[0], vt[1], vt[2], vt[3]};
                *(LAS u32x4*)(L + SC_VT + d * 144 + 32 * qd + 16) = (u32x4){vt[4], vt[5], vt[6], vt[7]};
            }
            if (s + 1 < 36) {
                const int s1 = s + 1; const bool lat1 = s1 >= 4; const int n1 = lat1 ? (dir ? 31 - (s1 - 4) : (s1 - 4)) : (dir ? 3 - s1 : s1);
                const bf16_t* base = lat1 ? (const bf16_t*)PH + (size_t)(b * 2048 + 64 * n1 + 16 * qd) * 2048 : PHC + (size_t)(b * 256 + 64 * n1 + 16 * qd) * 2048;
                const unsigned char* base8 = (const unsigned char*)base;
#pragma unroll
                for (int i = 0; i < 16; ++i) { rq[i] = base8[(size_t)i * 4096 + cq]; rz[i] = base[(size_t)i * 2048 + cz]; rv[i] = base8[(size_t)i * 4096 + 3072 + cq]; }
            }
            __syncthreads();
            f32x4 oacc[4];
#pragma unroll
            for (int i = 0; i < 4; ++i) oacc[i] = (f32x4){0.f, 0.f, 0.f, 0.f};
            const int kb = fq * 16;
            if (lat) {
                const int ct = w >> 1, st0 = 2 * (w & 1);
#pragma unroll
                for (int j = 0; j < 2; ++j) { const int st = st0 + j; f32x4 sa = (f32x4){0.f, 0.f, 0.f, 0.f};
#pragma unroll
                    for (int ks = 0; ks < 4; ++ks) sa = __builtin_amdgcn_mfma_f32_16x16x32_bf16(ldfrag(L + SC_KI + (16 * st + fr) * 272 + ks * 64 + kb), ldfrag(L + SC_QD + (16 * ct + fr) * 272 + ks * 64 + kb), sa, 0, 0, 0);
                    const int cc = 16 * ct + fr, s0 = 16 * st + 4 * fq;
#pragma unroll
                    for (int i = 0; i < 4; ++i) { const bool keep = dir ? (s0 + i >= cc) : (s0 + i <= cc); sa[i] = keep ? sa[i] : 0.f; }
                    *(LAS u32x2*)(L + SC_SC + cc * 144 + s0 * 2) = (u32x2){cvt_pk_bf16(sa[0], sa[1]), cvt_pk_bf16(sa[2], sa[3])}; }
#pragma unroll
                for (int ct2 = 0; ct2 < 4; ++ct2)
#pragma unroll
                    for (int ks = 0; ks < 4; ++ks) oacc[ct2] = __builtin_amdgcn_mfma_f32_16x16x32_bf16(ldfrag(L + SC_ST + (16 * w + fr) * 272 + ks * 64 + kb), ldfrag(L + SC_QD + (16 * ct2 + fr) * 272 + ks * 64 + kb), oacc[ct2], 0, 0, 0);
            }
            {   const bf16x8 v0 = ldfrag(L + SC_VT + (16 * w + fr) * 144 + kb), v1 = ldfrag(L + SC_VT + (16 * w + fr) * 144 + 64 + kb);
#pragma unroll
                for (int dt = 0; dt < 8; ++dt) { const f32x4 gv = *(const LAS f32x4*)(L + SC_GV + (16 * dt + 4 * fq) * 4);
                    f32x4 a = Sacc[dt] * gv;
                    a = __builtin_amdgcn_mfma_f32_16x16x32_bf16(ldfrag(L + SC_KE + (16 * dt + fr) * 144 + kb), v0, a, 0, 0, 0);
                    a = __builtin_amdgcn_mfma_f32_16x16x32_bf16(ldfrag(L + SC_KE + (16 * dt + fr) * 144 + 64 + kb), v1, a, 0, 0, 0);
                    Sacc[dt] = a; } }
            __syncthreads();
#pragma unroll
            for (int dt = 0; dt < 8; ++dt) *(LAS u32x2*)(L + SC_ST + (16 * w + fr) * 272 + (16 * dt + 4 * fq) * 2) = (u32x2){cvt_pk_bf16(Sacc[dt][0], Sacc[dt][1]), cvt_pk_bf16(Sacc[dt][2], Sacc[dt][3])};
            if (lat) {
                const bf16x8 v0 = ldfrag(L + SC_VT + (16 * w + fr) * 144 + kb), v1 = ldfrag(L + SC_VT + (16 * w + fr) * 144 + 64 + kb);
                bf16_t* ob = PH + (size_t)(b * 2048 + 64 * n) * 2048 + 512 + dir * 512 + h * 128 + 16 * w + 4 * fq;
#pragma unroll
                for (int ct2 = 0; ct2 < 4; ++ct2) {
                    f32x4 a = oacc[ct2];
                    a = __builtin_amdgcn_mfma_f32_16x16x32_bf16(v0, ldfrag(L + SC_SC + (16 * ct2 + fr) * 144 + kb), a, 0, 0, 0);
                    a = __builtin_amdgcn_mfma_f32_16x16x32_bf16(v1, ldfrag(L + SC_SC + (16 * ct2 + fr) * 144 + 64 + kb), a, 0, 0, 0);
                    if (!dry) *(u32x2*)(ob + (size_t)(16 * ct2 + fr) * 2048) = (u32x2){cvt_pk_bf16(a[0], a[1]), cvt_pk_bf16(a[2], a[3])};
                    else if (a[0] == 1.2345e30f) ob[0] = 1; }
            }
        }
        __syncthreads();
    }
}

typedef short s16x4 __attribute__((ext_vector_type(4)));
__device__ __forceinline__ s16x4 tr_read(unsigned lds_addr) { s16x4 r; asm volatile("ds_read_b64_tr_b16 %0, %1\n\ts_waitcnt lgkmcnt(0)" : "=&v"(r) : "v"(lds_addr) : "memory"); return r; }
__device__ __forceinline__ void tr_read8(unsigned a0, unsigned a1, unsigned a2, unsigned a3, unsigned d, s16x4 (&r)[8]) {
    asm volatile("ds_read_b64_tr_b16 %0, %8\n\tds_read_b64_tr_b16 %1, %9\n\tds_read_b64_tr_b16 %2, %10\n\tds_read_b64_tr_b16 %3, %11\n\t"
                 "ds_read_b64_tr_b16 %4, %12\n\tds_read_b64_tr_b16 %5, %13\n\tds_read_b64_tr_b16 %6, %14\n\tds_read_b64_tr_b16 %7, %15\n\ts_waitcnt lgkmcnt(0)"
                 : "=&v"(r[0]), "=&v"(r[1]), "=&v"(r[2]), "=&v"(r[3]), "=&v"(r[4]), "=&v"(r[5]), "=&v"(r[6]), "=&v"(r[7])
                 : "v"(a0), "v"(a0 + d), "v"(a1), "v"(a1 + d), "v"(a2), "v"(a2 + d), "v"(a3), "v"(a3 + d) : "memory");
}
__device__ __forceinline__ void tr_read4(unsigned a0, unsigned a1, unsigned d, s16x4 (&r)[4]) {
    asm volatile("ds_read_b64_tr_b16 %0, %4\n\tds_read_b64_tr_b16 %1, %5\n\tds_read_b64_tr_b16 %2, %6\n\tds_read_b64_tr_b16 %3, %7\n\ts_waitcnt lgkmcnt(0)"
                 : "=&v"(r[0]), "=&v"(r[1]), "=&v"(r[2]), "=&v"(r[3]) : "v"(a0), "v"(a0 + d), "v"(a1), "v"(a1 + d) : "memory");
}
__device__ __forceinline__ bf16x8 cat4(s16x4 a, s16x4 b) { return (bf16x8){a[0], a[1], a[2], a[3], b[0], b[1], b[2], b[3]}; }
constexpr int FO_C = 131072, FO_S = 139264;
__device__ __forceinline__ void p4_fourier(const Frame& F) {
    LAS unsigned char* L = F.lds;
    const int tid = F.tid, w = F.wave, lane = F.lane, fr = lane & 15, fq = lane >> 4;
    const bf16_t* PA = (const bf16_t*)(F.ws + WS_PA); unsigned char* Y = (unsigned char*)(F.ws + WS_Y);
    __syncthreads();
    for (int i = tid; i < 4096; i += NTHR) { const int k2 = i >> 6, c = i & 63; const float a = (float)((k2 * c) & 63) * (1.0f / 64.0f);
        *(LAS bf16_t*)(L + FO_C + i * 2) = (bf16_t)(cvt_pk_bf16(__builtin_amdgcn_cosf(a) * 0.125f, 0.f) & 0xffffu);
        *(LAS bf16_t*)(L + FO_S + i * 2) = (bf16_t)(cvt_pk_bf16(__builtin_amdgcn_sinf(a) * 0.125f, 0.f) & 0xffffu); }
    bf16x8 Gf[2][2];
#pragma unroll
    for (int nt = 0; nt < 2; ++nt)
#pragma unroll
        for (int ks = 0; ks < 2; ++ks) { unsigned pk[4];
#pragma unroll
            for (int j = 0; j < 8; j += 2) { const int k1 = 16 * nt + fr, ra = 8 * fq + j, rb = ra + 1; const float aa = (float)((k1 * ra) & 31) * (1.0f / 32.0f), ab = (float)((k1 * rb) & 31) * (1.0f / 32.0f);
                const float va = (ks ? __builtin_amdgcn_sinf(aa) : __builtin_amdgcn_cosf(aa)) * 0.17677669529663687f, vb = (ks ? __builtin_amdgcn_sinf(ab) : __builtin_amdgcn_cosf(ab)) * 0.17677669529663687f;
                pk[j >> 1] = cvt_pk_bf16(va, vb); }
            u32x4 t4 = (u32x4){pk[0], pk[1], pk[2], pk[3]}; Gf[nt][ks] = *(bf16x8*)&t4; }
    const unsigned lbase = (unsigned)(size_t)L;
    for (int it = F.c; it < 1024; it += F.G) {
        const int xcd = it & 7, jj = it >> 3, slab = 4 * xcd + (jj & 3), b = jj >> 2;
        __syncthreads();
        {   const bf16_t* src = PA + (size_t)(b * 32 + slab) * 2048 * 32;
            u32x4 v[16];
#pragma unroll
            for (int n = 0; n < 16; ++n) v[n] = *(const u32x4*)(src + (size_t)(tid + NTHR * n) * 8);
#pragma unroll
            for (int n = 0; n < 16; ++n) *(LAS u32x4*)(L + (tid + NTHR * n) * 16) = v[n]; }
        __syncthreads();
#pragma unroll 1
        for (int rr = 0; rr < 4; ++rr) {
            const int r = w + 8 * rr;
            f32x4 acc[8];
#pragma unroll
            for (int i = 0; i < 8; ++i) acc[i] = (f32x4){0.f, 0.f, 0.f, 0.f};
            s16x4 tr[8];
            {   unsigned aa[4];
#pragma unroll
                for (int ks = 0; ks < 4; ++ks) { const int ri = ks >> 1, c0 = 32 * (ks & 1) + 8 * fq + (fr >> 2); aa[ks] = lbase + (unsigned)((r * 64 + c0) * 64 + ri * 32 + (fr & 3) * 8); }
                tr_read8(aa[0], aa[1], aa[2], aa[3], 4u * 64u, tr); }
#pragma unroll
            for (int ks = 0; ks < 4; ++ks) {
                const int ri = ks >> 1;
                const bf16x8 af = cat4(tr[2 * ks], tr[2 * ks + 1]);
#pragma unroll
                for (int nt = 0; nt < 8; ++nt) { const int ro = nt >> 2, k2 = 16 * (nt & 3) + fr;
                    u32x4 bw = *(const LAS u32x4*)(L + ((ro == ri) ? FO_C : FO_S) + (k2 * 64 + 32 * (ks & 1) + 8 * fq) * 2);
                    if (ro == 1 && ri == 0) { bw.x ^= 0x80008000u; bw.y ^= 0x80008000u; bw.z ^= 0x80008000u; bw.w ^= 0x80008000u; }
                    acc[nt] = __builtin_amdgcn_mfma_f32_16x16x32_bf16(af, *(bf16x8*)&bw, acc[nt], 0, 0, 0); }
            }
#pragma unroll
            for (int nt = 0; nt < 8; ++nt) { const int ro = nt >> 2, k2 = 16 * (nt & 3) + fr;
                *(LAS u32x2*)(L + (r * 64 + k2) * 64 + ro * 32 + fq * 8) = (u32x2){cvt_pk_bf16(acc[nt][0], acc[nt][1]), cvt_pk_bf16(acc[nt][2], acc[nt][3])}; }
        }
        __syncthreads();
#pragma unroll 1
        for (int kk = 0; kk < 8; ++kk) {
            const int k2 = 8 * w + kk;
            f32x4 a2[2] = {(f32x4){0.f, 0.f, 0.f, 0.f}, (f32x4){0.f, 0.f, 0.f, 0.f}};
            s16x4 t4[4];
            {   const int r0 = 8 * fq + (fr >> 2); const unsigned a0 = lbase + (unsigned)((r0 * 64 + k2) * 64 + (fr & 3) * 8);
                tr_read4(a0, a0 + 32u, 4u * 64u * 64u, t4); }
#pragma unroll
            for (int ks = 0; ks < 2; ++ks) {
                const bf16x8 af = cat4(t4[2 * ks], t4[2 * ks + 1]);
                a2[0] = __builtin_amdgcn_mfma_f32_16x16x32_bf16(af, Gf[0][ks], a2[0], 0, 0, 0);
                a2[1] = __builtin_amdgcn_mfma_f32_16x16x32_bf16(af, Gf[1][ks], a2[1], 0, 0, 0);
            }
#pragma unroll
            for (int nt = 0; nt < 2; ++nt) { const int k1 = 16 * nt + fr;
                *(unsigned*)(Y + (size_t)(b * 2048 + k1 * 64 + k2) * 1024 + slab * 16 + 4 * fq) = cvt_pk4_fp8(a2[nt][0], a2[nt][1], a2[nt][2], a2[nt][3]); }
        }
    }
    __syncthreads();
}

struct Args { const float* in[22]; float* out; unsigned char* ws; int ph_lo, ph_hi; };
constexpr int N_PHASES = 9 + 3 * NCH;

__global__ void __launch_bounds__(NTHR, 2) mega_fwd(Args args) {
    extern __shared__ __attribute__((aligned(16))) unsigned char lds_raw[];
    Frame F;
    F.lds = (LAS unsigned char*)lds_raw;
    F.tid = threadIdx.x; F.lane = F.tid & 63; F.wave = __builtin_amdgcn_readfirstlane(F.tid >> 6);
    F.G = gridDim.x; F.c = blockIdx.x;
    F.in = args.in;
    F.out = args.out; F.ws = args.ws; F.ctl = (unsigned*)(args.ws + WS_CTL);
    volatile LAS unsigned* misc = (volatile LAS unsigned*)(F.lds + LDS_MISC);
    if (F.tid < 4) misc[F.tid] = 0u;
    __syncthreads();
    XcdBarrier bar = xcd_barrier_post(F.ctl, misc);
    const int lo = args.ph_lo, hi = args.ph_hi;
#ifndef PHASE_MASK
#define PHASE_MASK 0xFFFFFFFFu
#endif
#define IN(k) ((((PHASE_MASK) >> (k)) & 1u) && lo <= (k) && (k) < hi)
#define SEAM(k) do { if (IN(k) && IN((k) + 1)) xcd_barrier(bar); } while (0)
#ifndef REP_MASK
#define REP_MASK 0u
#endif
#define REPS(b) ((((REP_MASK) >> (b)) & 1u) ? 2 : 1)
#define REPBAR(b, r) do { if ((((REP_MASK) >> (b)) & 1u) && (r) == 0) xcd_barrier(bar); } while (0)
    unsigned char* ws = F.ws;
    LAS unsigned char* blk_e = F.lds + LDS_MISC + 64;
#ifdef PR_A
    unsigned long long* stamps = (unsigned long long*)(ws + 980 * MiB);
#define STAMP(slot) do { if (F.tid == 0) stamps[(slot) * 256 + F.c] = __builtin_amdgcn_s_memrealtime(); } while (0)
#else
#define STAMP(slot) do { } while (0)
#endif
    STAMP(0);

    if (IN(0)) { for (int r = 0; r < REPS(0); ++r) { p0_ada(F); p0_fold(F); p0_convert(F); REPBAR(0, r); } }
    STAMP(1);
    SEAM(0);
    if (IN(1)) { for (int r = 0; r < REPS(1); ++r) { p1_uprep(F); REPBAR(1, r); } }
    STAMP(2);
    SEAM(1);
    if (IN(2)) {
        ProbP1 P{(const char*)(ws + WS_U), 8, 1024u, 1024u, (const char*)(ws + WS_WIN1T), (unsigned)(WS_UC - WS_U), F.G, F.c};
        EpiP1 E{(bf16_t*)(ws + WS_PA), (bf16_t*)(ws + WS_PH), (bf16_t*)(ws + WS_PHC)};
        for (int r = 0; r < REPS(2); ++r) { pg8::gemm_phase<ProbP1, EpiP1, true, false, true>(F.lds, P, E); REPBAR(2, r); }
    }
    STAMP(3);
    SEAM(2);
    if (IN(3)) {
#ifndef NO_FOURIER
        for (int r = 0; r < REPS(4); ++r) { p4_fourier(F); REPBAR(4, r); }
        STAMP(5);
#endif
#ifndef NO_SCAN
        for (int r = 0; r < REPS(3); ++r) { p3_scan(F, r + 1 < REPS(3)); REPBAR(3, r); }
        STAMP(4);
#endif
#ifndef NO_P2GEMM
        ProbDense P{(const char*)(ws + WS_U), 8, 1024u, 1024u, (const char*)(ws + WS_WIN2T), 256, 10, F.G, F.c, 0};
        EpiP2 E{(unsigned char*)(ws + WS_PG), (unsigned char*)F.out};
        for (int r = 0; r < REPS(5); ++r) { pg8::gemm_phase<ProbDense, EpiP2, true, false, true>(F.lds, P, E); REPBAR(5, r); }
#endif
    }
    STAMP(6);
    SEAM(3);
    if (IN(4)) { for (int r = 0; r < REPS(6); ++r) { p6_readout(F); REPBAR(6, r); } }
    STAMP(7);
    SEAM(4);
    if (IN(5)) {
        ProbDense P{(const char*)(ws + WS_Y), 8, 1024u, 1024u, (const char*)(ws + WS_WMT), 256, 4, F.G, F.c, 1};
        EpiM1 E{(const unsigned char*)F.out, (unsigned char*)(ws + WS_PA)};
        for (int r = 0; r < REPS(7); ++r) { pg8::gemm_phase<ProbDense, EpiM1, true, true, true>(F.lds, P, E); REPBAR(7, r); }
    }
    STAMP(8);
    SEAM(5);
    if (IN(6)) {
        ProbDense P{(const char*)(ws + WS_PA), 8, 1024u, 1024u, (const char*)(ws + WS_WOT), 256, 4, F.G, F.c, 0};
        EpiM2 E{(const float*)(ws + WS_ADA), (unsigned char*)F.out};
        for (int r = 0; r < REPS(8); ++r) { pg8::gemm_phase<ProbDense, EpiM2, true, false, true>(F.lds, P, E); REPBAR(8, r); }
    }
    STAMP(9);
    SEAM(6);
    if (IN(7)) { for (int r = 0; r < REPS(9); ++r) { p9_ln1_router(fresh(F), r + 1 < REPS(9)); REPBAR(9, r); } }
    STAMP(10);
    SEAM(7);
    if (IN(8)) { p10_dispatch(F); }
    STAMP(11);
    SEAM(8);
#pragma unroll
    for (int ch = 0; ch < NCH; ++ch) {
        if (IN(9 + 3 * ch)) {
            const int nblk = moe_blocks(F, ch, blk_e);
            ProbMoE<true> P{(const char*)(ws + WS_U), 8, 1024u, 1024u, (const char*)(ws + WS_WGUT), (size_t)2048 * 1024, 8, nblk, F.G, F.c, (const int*)(ws + WS_ROWTOK) + (size_t)ch * ROWS_CH, blk_e};
            EpiGU E{F.in[I_BGU], (unsigned char*)(ws + WS_ACT)};
#ifdef GU_DRY
            pg8::gemm_phase<ProbMoE<true>, EpiGU, true, false, true, GU_DRY>(F.lds, P, E); xcd_barrier(bar);
#endif
            for (int r = 0; r < (ch == 0 ? REPS(10) : 1); ++r) { pg8::gemm_phase<ProbMoE<true>, EpiGU, true, false, true>(F.lds, P, E); if (ch == 0) REPBAR(10, r); }
        }
        STAMP(12);
        SEAM(9 + 3 * ch);
        if (IN(10 + 3 * ch)) {
            const int nblk = moe_blocks(F, ch, blk_e);
            ProbMoE<false> P{(const char*)(ws + WS_ACT), 8, 1024u, 1024u, (const char*)(ws + WS_WDNT), (size_t)1024 * 1024, 4, nblk, F.G, F.c, nullptr, blk_e};
            EpiDN E{F.in[I_BDN], (unsigned char*)(ws + WS_YCH)};
            for (int r = 0; r < (ch == 0 ? REPS(11) : 1); ++r) { pg8::gemm_phase<ProbMoE<false>, EpiDN, true, false, true>(F.lds, P, E); if (ch == 0) REPBAR(11, r); }
        }
        STAMP(13);
        SEAM(10 + 3 * ch);
        if (IN(11 + 3 * ch)) { for (int r = 0; r < (ch == 0 ? REPS(12) : 1); ++r) { p13_combine_ln2(F, ch, ch == 0 && r + 1 < REPS(12)); if (ch == 0) REPBAR(12, r); } }
        STAMP(14);
        SEAM(11 + 3 * ch);
    }
#ifdef DBG_K
    xcd_barrier(bar);
    {
        const unsigned char* buf = (DBG_OUT) ? (const unsigned char*)F.out : (const unsigned char*)(ws + (size_t)(DBG_OFF));
        const size_t wpr = (size_t)(DBG_CW) / 4, nw = (size_t)(DBG_ROWS) * wpr;
        unsigned long long cs = 0; unsigned bad = 0;
        for (size_t i = (size_t)F.c * NTHR + F.tid; i < nw; i += (size_t)F.G * NTHR) { const size_t r = i / wpr, cw = i % wpr; const unsigned w = *(const unsigned*)(buf + r * (size_t)(DBG_LD) + (DBG_C0) + cw * 4); cs += w;
            if (DBG_F32) { if ((w & 0x7f800000u) == 0x7f800000u) ++bad; } else { if ((w & 0x7f80u) == 0x7f80u) ++bad; if ((w & 0x7f800000u) == 0x7f800000u) ++bad; } }
        for (int o = 32; o >= 1; o >>= 1) { cs += __shfl_xor(cs, o); bad += __shfl_xor(bad, o); }
        if (F.lane == 0) { atomicAdd((unsigned long long*)(F.ctl + 8192), cs); atomicAdd(F.ctl + 8200, bad); }
        if (F.c == 0 && F.tid == 0) atomicAdd(F.ctl + 8201, xb_ld(&F.ctl[XB_TMO]));
    }
    xcd_barrier(bar);
    {
        const unsigned long long cs = __hip_atomic_load((unsigned long long*)(F.ctl + 8192), __ATOMIC_RELAXED, __HIP_MEMORY_SCOPE_AGENT);
        const unsigned bad = xb_ld(F.ctl + 8200), tmo = xb_ld(F.ctl + 8201);
        const float val = (float)(unsigned)((cs ^ (cs >> 16) ^ (cs >> 32)) & 0xFFFFu) * (1.0f / 65536.0f) + (bad ? 2.0f : 0.0f) + (tmo ? 4.0f : 0.0f);
        for (size_t i = (size_t)F.c * NTHR + F.tid; i < (size_t)T * D; i += (size_t)F.G * NTHR) F.out[i] = val;
    }
    return;
#endif
#ifdef PR_A
    xcd_barrier(bar);
    {
        auto maxs = [&](int sl) { unsigned long long m = 0; for (int w = 0; w < (int)F.G; ++w) { const unsigned long long v = stamps[sl * 256 + w]; m = v > m ? v : m; } return m; };
        auto dur = [&](int sl) -> float {
            if (sl == 4) { const unsigned long long st = maxs(3); double a = 0; for (int w = 0; w < (int)F.G; ++w) a += (double)(stamps[4 * 256 + w] - st); return (float)(a / F.G) * 0.01f; }
            if (sl == 5) { double a = 0; for (int w = 0; w < (int)F.G; ++w) a += (double)(stamps[5 * 256 + w] - stamps[4 * 256 + w]); return (float)(a / F.G) * 0.01f; }
            if (sl == 6) { double a = 0; for (int w = 0; w < (int)F.G; ++w) a += (double)(stamps[6 * 256 + w] - stamps[5 * 256 + w]); return (float)(a / F.G) * 0.01f; }
            if (sl == 16) return (float)(maxs(6) - maxs(3)) * 0.01f;
            return (float)(maxs(sl) - maxs(sl - 1)) * 0.01f; };
        const float va = rintf(dur(PR_A) * 0.1f + (PR_OFF)) * 0.1f, vb = rintf(dur(PR_B) * 0.1f + (PR_OFF)) * 10.0f;
        for (size_t i = (size_t)F.c * NTHR + F.tid; i < (size_t)T * D; i += (size_t)F.G * NTHR) F.out[i] = va;
        __syncthreads();
        if (F.c == 0 && F.tid == 0) F.out[12345] = vb;
    }
    return;
#endif
    if (F.c == 0 && F.tid == 0 && hi == N_PHASES) { if (xb_ld(&F.ctl[XB_TMO]) != 0u) F.out[0] = __builtin_nanf(""); }
#undef IN
#undef SEAM
}

extern "C" void kernel_launch(void* const* d_in, const int* in_sizes, int n_in, void* d_out, int out_size, void* d_ws, size_t ws_size, hipStream_t stream) {
    static int grid = 0;
    if (grid == 0) {
        if (n_in != 22 || out_size != T * D || ws_size < WS_END) { fprintf(stderr, "kernel_launch: unexpected shapes (n_in %d, out %d, ws %zu)\n", n_in, out_size, ws_size); grid = -1; return; }
        int dev = 0, cus = 0, per_cu = 0;
        if (hipGetDevice(&dev) != hipSuccess || hipDeviceGetAttribute(&cus, hipDeviceAttributeMultiprocessorCount, dev) != hipSuccess) { grid = -1; return; }
        if (hipFuncSetAttribute((const void*)mega_fwd, hipFuncAttributeMaxDynamicSharedMemorySize, LDS_BYTES) != hipSuccess) { fprintf(stderr, "kernel_launch: hipFuncSetAttribute failed\n"); grid = -1; return; }
        if (hipOccupancyMaxActiveBlocksPerMultiprocessor(&per_cu, (const void*)mega_fwd, NTHR, LDS_BYTES) != hipSuccess || per_cu < 1) fprintf(stderr, "kernel_launch: occupancy query reports %d blocks per CU\n", per_cu);
        (void)hipGetLastError();
        grid = cus;
    }
    if (grid < 0) return;
    (void)hipMemsetAsync((char*)d_ws + WS_CTL, 0, CTL_BYTES, stream);
    Args a{};
    for (int i = 0; i < 22; ++i) a.in[i] = (const float*)d_in[i];
    a.out = (float*)d_out; a.ws = (unsigned char*)d_ws; a.ph_lo = 0; a.ph_hi = N_PHASES;
#ifdef DBG_K
    a.ph_hi = DBG_K;
#endif
    hipLaunchKernelGGL(mega_fwd, dim3(grid), dim3(NTHR), LDS_BYTES, stream, a);
}
```

```cpp
#include <hip/hip_runtime.h>
#include <cstdio>
#include <cstdint>

#define LAS __attribute__((address_space(3)))
typedef unsigned short bf16_t;
typedef short bf16x8 __attribute__((ext_vector_type(8)));
typedef short bf16x4 __attribute__((ext_vector_type(4)));
typedef float f32x4 __attribute__((ext_vector_type(4)));
typedef float f32x2 __attribute__((ext_vector_type(2)));
typedef unsigned u32x4 __attribute__((ext_vector_type(4)));
typedef unsigned u32x2 __attribute__((ext_vector_type(2)));

constexpr int D = 1024, NB = 32, SEQ = 2048, T = NB * SEQ, CTX = 256, TCX = NB * CTX;
#ifndef NCH_SET
#define NCH_SET 1
#endif
constexpr int NEXP = 32, TOPK = 4;
constexpr int NCH = NCH_SET, TCH = T / NCH;
constexpr int ROWS_CH = TCH * TOPK + NEXP * 256;
constexpr float DN_ALPHA = 1.189207115002721f;
constexpr float LN_EPS = 1e-5f, RMS_EPS = 1e-6f;
constexpr int NTHR = 512;

constexpr size_t MiB = 1ull << 20;
constexpr size_t WS_CTL = 0;
constexpr size_t CTL_BYTES = 65536;
constexpr size_t WS_ADA = 65536;
constexpr size_t WS_WIN1T = 1 * MiB;
constexpr size_t WS_WIN2T = 7 * MiB;
constexpr size_t WS_WMT = 12 * MiB;
constexpr size_t WS_WOT = 14 * MiB;
constexpr size_t WS_WGUT = 16 * MiB;
constexpr size_t WS_WDNT = 80 * MiB;
constexpr size_t WS_TOPI = 112 * MiB;
constexpr size_t WS_TOPW = 113 * MiB;
constexpr size_t WS_POS = 114 * MiB;
constexpr size_t WS_ROWTOK = 115 * MiB;
constexpr size_t WS_U = 120 * MiB;
constexpr size_t WS_PA = 184 * MiB;
constexpr size_t WS_PH = 312 * MiB;
constexpr size_t WS_PHC = 568 * MiB;
constexpr size_t WS_PG = 600 * MiB;
constexpr size_t WS_Y = 664 * MiB;
constexpr size_t WS_UC = WS_Y;
constexpr size_t WS_ACT = WS_PA;
constexpr size_t WS_YCH = WS_PA + 264 * MiB;
constexpr size_t WS_X1 = WS_YCH + 264 * MiB;
constexpr size_t WS_END = 976 * MiB;
static_assert(WS_X1 + 128 * MiB <= WS_END && (size_t)ROWS_CH * 1024 <= 264 * MiB && WS_Y + 128 * MiB <= WS_END, "ws map");
constexpr int CW_CNT = 4096;
constexpr int CW_CUR = 4096 + 64;

constexpr int LDS_SCRATCH = 155648;
constexpr int LDS_MISC = LDS_SCRATCH;
constexpr int LDS_BYTES = LDS_SCRATCH + 2048;

typedef __bf16 bf16x2_t __attribute__((ext_vector_type(2)));
__device__ __forceinline__ unsigned cvt_pk_bf16(float lo, float hi) { const f32x2 v = {lo, hi}; const bf16x2_t r = __builtin_convertvector(v, bf16x2_t); return __builtin_bit_cast(unsigned, r); }
__device__ __forceinline__ unsigned cvt_pk4_fp8(float a, float b, float c, float d) {
    a = fminf(fmaxf(a, -448.f), 448.f); b = fminf(fmaxf(b, -448.f), 448.f); c = fminf(fmaxf(c, -448.f), 448.f); d = fminf(fmaxf(d, -448.f), 448.f);
    int w = __builtin_amdgcn_cvt_pk_fp8_f32(a, b, 0, false); w = __builtin_amdgcn_cvt_pk_fp8_f32(c, d, w, true); return (unsigned)w; }
constexpr float W8_SCALE = 32.0f, W8_INV = 1.0f / 32.0f;
typedef float f32x2v __attribute__((ext_vector_type(2)));
__device__ __forceinline__ f32x4 fp8x4_to_f32(unsigned w) { const f32x2v a = __builtin_amdgcn_cvt_pk_f32_fp8((int)w, false), b = __builtin_amdgcn_cvt_pk_f32_fp8((int)w, true); return (f32x4){a[0], a[1], b[0], b[1]}; }
__device__ __forceinline__ u32x4 widen16(u32x2 a, u32x2 b) {
    const u32x2 rx = __builtin_amdgcn_permlane16_swap(a.x, b.x, false, false), ry = __builtin_amdgcn_permlane16_swap(a.y, b.y, false, false);
    return (u32x4){rx[0], ry[0], rx[1], ry[1]}; }
__device__ __forceinline__ void unwiden16(u32x4 L, u32x2& a, u32x2& b) {
    const u32x2 rx = __builtin_amdgcn_permlane16_swap(L.x, L.z, false, false), ry = __builtin_amdgcn_permlane16_swap(L.y, L.w, false, false);
    a = (u32x2){rx[0], ry[0]}; b = (u32x2){rx[1], ry[1]}; }
__device__ __forceinline__ unsigned pack4_u8(float a, float b, float c, float d) {
    unsigned w = __builtin_amdgcn_cvt_pk_u8_f32(__builtin_rintf(a), 0, 0u); w = __builtin_amdgcn_cvt_pk_u8_f32(__builtin_rintf(b), 1, w);
    w = __builtin_amdgcn_cvt_pk_u8_f32(__builtin_rintf(c), 2, w); return __builtin_amdgcn_cvt_pk_u8_f32(__builtin_rintf(d), 3, w); }
__device__ __forceinline__ f32x4 u8x4_to_f32(unsigned w) { return (f32x4){(float)(w & 0xffu), (float)((w >> 8) & 0xffu), (float)((w >> 16) & 0xffu), (float)(w >> 24)}; }
__device__ __forceinline__ float bf_lo(unsigned w) { return __uint_as_float(w << 16); }
__device__ __forceinline__ float bf_hi(unsigned w) { return __uint_as_float(w & 0xffff0000u); }
__device__ __forceinline__ float bf2f(bf16_t v) { return __uint_as_float(((unsigned)v) << 16); }
__device__ __forceinline__ float fast_exp(float x) { return __builtin_amdgcn_exp2f(x * 1.4426950408889634f); }
__device__ __forceinline__ float fast_sigmoid(float x) { return __builtin_amdgcn_rcpf(1.0f + fast_exp(-x)); }
__device__ __forceinline__ float fast_log(float x) { return __builtin_amdgcn_logf(x) * 0.6931471805599453f; }

#define XB_TMO      128
#define XB_XCNT(j)  (256  + 64 * (j))
#define XB_XSUB(j)  (1280 + 64 * (j))
#define XB_XGEN(j)  (2304 + 64 * (j))
#define XB_TOP      3328
#define XB_TOPGEN   3392
#define XCD_BAR_WORDS 3456
#define XB_SPIN_CAP (1u << 18)

__device__ __forceinline__ unsigned xb_ld(unsigned* p)              { return __hip_atomic_load(p, __ATOMIC_RELAXED, __HIP_MEMORY_SCOPE_AGENT); }
__device__ __forceinline__ unsigned xb_add(unsigned* p, unsigned v) { return __hip_atomic_fetch_add(p, v, __ATOMIC_RELAXED, __HIP_MEMORY_SCOPE_AGENT); }
__device__ __forceinline__ unsigned xb_xcc_id() { return (unsigned)__builtin_amdgcn_s_getreg((3 << 11) | 20) & 0xFu; }
#define XB_SPIN(cond, bar) do { unsigned _sp = 0; while (cond) { __builtin_amdgcn_s_sleep(1); \
    if ((++_sp & 255u) == 0u) { if (xb_ld(&(bar)[XB_TMO])) break; if (_sp > XB_SPIN_CAP) { atomicAdd(&(bar)[XB_TMO], 1u); break; } } } } while (0)

struct XcdBarrier { unsigned* bar; unsigned x; volatile LAS unsigned* st; };

__device__ __forceinline__ XcdBarrier xcd_barrier_post(unsigned* bar, volatile LAS unsigned* st) {
    XcdBarrier b; b.bar = bar; b.x = xb_xcc_id(); b.st = st;
    if (threadIdx.x == 0) (void)xb_add(&bar[XB_XCNT(b.x)], 1u);
    return b;
}
__device__ __forceinline__ void xcd_barrier_complete(unsigned* bar, unsigned x, unsigned& nloc, unsigned& nx) {
    const unsigned G = gridDim.x * gridDim.y * gridDim.z;
    unsigned sum, cnt, mine, sp = 0u;
    for (;;) {
        sum = 0u; cnt = 0u; mine = 0u;
#pragma unroll
        for (unsigned j = 0; j < 16; ++j) { const unsigned c = xb_ld(&bar[XB_XCNT(j)]); sum += c; cnt += (c > 0u) ? 1u : 0u; mine = (j == x) ? c : mine; }
        if (sum == G) break;
        __builtin_amdgcn_s_sleep(1);
        if ((++sp & 255u) == 0u) { if (xb_ld(&bar[XB_TMO])) break; if (sp > XB_SPIN_CAP) { atomicAdd(&bar[XB_TMO], 1u); break; } }
    }
    nloc = mine > 0u ? mine : 1u; nx = cnt > 0u ? cnt : 1u;
}
__device__ __forceinline__ void xcd_barrier(const XcdBarrier& b) {
    asm volatile("s_waitcnt vmcnt(0)" ::: "memory");
    __syncthreads();
    if (threadIdx.x == 0) {
        unsigned* bar = b.bar;
        __builtin_amdgcn_s_waitcnt(0);
        unsigned nloc = b.st[0], nx = b.st[1];
        if (nloc == 0u) { xcd_barrier_complete(bar, b.x, nloc, nx); b.st[0] = nloc; b.st[1] = nx; }
        const unsigned old = xb_add(&bar[XB_XSUB(b.x)], 1u);
        const unsigned gen = old / nloc;
        if (old + 1u == (gen + 1u) * nloc) {
            __builtin_amdgcn_fence(__ATOMIC_RELEASE, "agent");
            asm volatile("s_waitcnt vmcnt(0)" ::: "memory");
            const unsigned og = xb_add(&bar[XB_TOP], 1u);
            const unsigned tg = og / nx;
            if (og + 1u == (tg + 1u) * nx) xb_add(&bar[XB_TOPGEN], 1u);
            else XB_SPIN(xb_ld(&bar[XB_TOPGEN]) == tg, bar);
            __builtin_amdgcn_fence(__ATOMIC_ACQUIRE, "agent");
            xb_add(&bar[XB_XGEN(b.x)], 1u);
            asm volatile("s_waitcnt vmcnt(0)" ::: "memory");
        } else {
            XB_SPIN(xb_ld(&bar[XB_XGEN(b.x)]) == gen, bar);
            __builtin_amdgcn_fence(__ATOMIC_ACQUIRE, "agent");
            asm volatile("s_waitcnt vmcnt(0)" ::: "memory");
        }
    }
    __syncthreads();
}

#ifndef WGM_SET
#define WGM_SET 8
#endif
namespace pg8 {
constexpr int BM = 256, BK = 64, HALF = 128, HTB = HALF * BK * 2, STAGE_BYTES = 8 * HTB, NXCD = 8, WGM = WGM_SET;
__host__ __device__ __forceinline__ int lds_byte(int r, int c) { const int st = (r >> 4) * 2 + (c >> 5), rr = r & 15, cc = c & 31, ob = rr * 64 + cc * 2; return st * 1024 + (ob ^ (((ob >> 9) & 1) << 5)); }
__host__ __device__ __forceinline__ void stage_rc(int b, int& R, int& C) { const int st = b / 1024, sb = b % 1024, swz = sb ^ (((sb >> 9) & 1) << 5); R = (st >> 1) * 16 + swz / 64; C = (st & 1) * 32 + (swz % 64) / 2; }
__host__ __device__ __forceinline__ int perm32(int rho) { const int n = rho >> 4, i = rho & 15; return 8 * (i >> 2) + 4 * n + (i & 3); }

struct Unit { int pm, pn, aux; };

__device__ __forceinline__ void grouped(int wgid, int nM, int nN, int& pm, int& pn) {
    const int nig = WGM * nN, gid = wgid / nig, fm = gid * WGM, gsz = (nM - fm) < WGM ? (nM - fm) : WGM;
    pm = fm + ((wgid % nig) % gsz); pn = (wgid % nig) / gsz;
}
__device__ __forceinline__ bool xcd_remap(int i, int G, int c, int nwg, int& wgid) {
    const long L = (long)i * G + c; if (L >= nwg) return false;
    wgid = (int)L; const int q = nwg / NXCD, r = nwg % NXCD, xcd = wgid % NXCD, off = wgid / NXCD;
    wgid = (xcd < r ? xcd * (q + 1) : r * (q + 1) + (xcd - r) * q) + off; return true;
}

typedef int i32x8 __attribute__((ext_vector_type(8)));
typedef int i32x4 __attribute__((ext_vector_type(4)));
template <bool F8> struct Frags;
template <> struct Frags<false> { bf16x8 a[4][2], b0[2][2], b1[2][2]; };
template <> struct Frags<true> { i32x8 a[4], b0[2], b1[2]; };
template <class Prob, class Epi, bool ALIGN_EPI, bool HOOK, bool FP8 = false, int DRY = 0>
__device__ __forceinline__ void gemm_phase(LAS unsigned char* lds, const Prob& P, const Epi& E) {
    int tid_ = threadIdx.x; asm volatile("" : "+v"(tid_));
    const int tid = tid_, wid = __builtin_amdgcn_readfirstlane(tid >> 6), lane = tid & 63, wr = wid >> 2, wc = wid & 3, fr = lane & 15, fq = lane >> 4;
    const int nt = P.nt;
    unsigned voffB[2], voffA[2];
#pragma unroll
    for (int i = 0; i < 2; ++i) { int R, C; stage_rc(tid * 16 + i * 8192, R, C); const int Rb = Epi::PERM ? ((R & ~31) + perm32(R & 31)) : R;
        voffB[i] = (unsigned)Rb * P.ldb2 + (unsigned)C * 2u; voffA[i] = (unsigned)R * P.lda2 + (unsigned)C * 2u; }
    auto gather_offs = [&](const Unit& u, unsigned (&o0)[2], unsigned (&o1)[2]) {
#pragma unroll
        for (int i = 0; i < 2; ++i) { int R, C; int tt = threadIdx.x; asm volatile("" : "+v"(tt)); stage_rc(tt * 16 + i * 8192, R, C); o0[i] = P.a_row(u, R) + (unsigned)C * 2u; o1[i] = P.a_row(u, HALF + R) + (unsigned)C * 2u; } };
    const size_t kstep = (size_t)(BK * 2);
    const size_t hstepB = (size_t)HALF * P.ldb2;
    const size_t hstepA = (size_t)HALF * P.lda2;
    const unsigned ldsw = (unsigned)wid * 1024u;
    const int aoff = lds_byte(wr * 64 + fr, fq * 8), boff = lds_byte(wc * 32 + fr, fq * 8);
#define PG8_SA(b, h) (((b) * 2 + (h)) * HTB)
#define PG8_SB(b, h) ((4 + (b) * 2 + (h)) * HTB)
#define PG8_STAGE(bufoff, gbase, voff) do { if constexpr ((DRY & 2) == 0) _Pragma("unroll") for (int _i = 0; _i < 2; ++_i) \
        __builtin_amdgcn_global_load_lds((const unsigned*)((const char*)(gbase) + (voff)[_i]), (LAS unsigned*)(lds + (bufoff) + ldsw + _i * 8192), 16, 0, 0); } while (0)
#define PG8_LDA(dst, b, h) do { if constexpr (FP8) { _Pragma("unroll") for (int m = 0; m < 4; ++m) { FR.a[m].lo = *(const LAS i32x4*)(lds + PG8_SA(b, h) + aoff + m * 2048); FR.a[m].hi = *(const LAS i32x4*)(lds + PG8_SA(b, h) + aoff + m * 2048 + 1024); } } \
        else { _Pragma("unroll") for (int m = 0; m < 4; ++m) _Pragma("unroll") for (int k = 0; k < 2; ++k) FR.a[m][k] = *(const LAS bf16x8*)(lds + PG8_SA(b, h) + aoff + m * 2048 + k * 1024); } } while (0)
#define PG8_LDB(dst, b, h) do { if constexpr (FP8) { _Pragma("unroll") for (int n = 0; n < 2; ++n) { FR.dst[n].lo = *(const LAS i32x4*)(lds + PG8_SB(b, h) + boff + n * 2048); FR.dst[n].hi = *(const LAS i32x4*)(lds + PG8_SB(b, h) + boff + n * 2048 + 1024); } } \
        else { _Pragma("unroll") for (int n = 0; n < 2; ++n) _Pragma("unroll") for (int k = 0; k < 2; ++k) FR.dst[n][k] = *(const LAS bf16x8*)(lds + PG8_SB(b, h) + boff + n * 2048 + k * 1024); } } while (0)
#define PG8_MMA(ai, bj, At, Bt) do { __builtin_amdgcn_s_setprio(1); if constexpr ((DRY & 1) != 0) { asm volatile("" :: "v"(FR.a[0]), "v"(FR.a[3]), "v"(FR.Bt[0]), "v"(FR.Bt[1])); } else if constexpr (FP8) { _Pragma("unroll") for (int m = 0; m < 4; ++m) _Pragma("unroll") for (int n = 0; n < 2; ++n) \
            asm volatile("v_mfma_f32_16x16x128_f8f6f4 %0, %1, %2, %0" : "+v"(acc[ai][bj][m][n]) : "v"(FR.Bt[n]), "v"(FR.a[m])); } \
        else { _Pragma("unroll") for (int m = 0; m < 4; ++m) _Pragma("unroll") for (int n = 0; n < 2; ++n) _Pragma("unroll") for (int k = 0; k < 2; ++k) \
        acc[ai][bj][m][n] = __builtin_amdgcn_mfma_f32_16x16x32_bf16(FR.Bt[n][k], FR.a[m][k], acc[ai][bj][m][n], 0, 0, 0); } __builtin_amdgcn_s_setprio(0); } while (0)
#define PG8_WAIT_V(n) asm volatile("s_waitcnt vmcnt(" #n ")" ::: "memory")
#define PG8_WAIT_L(n) asm volatile("s_waitcnt lgkmcnt(" #n ")" ::: "memory")
#define PG8_BAR __builtin_amdgcn_s_barrier()
#define PG8_SCHED __builtin_amdgcn_sched_barrier(0)
    Unit cur, nxt; int ui = 0;
    if (!P.unit(0, cur)) return;
    f32x4 acc[2][2][4][2];
#pragma unroll
    for (int a = 0; a < 2; ++a)
#pragma unroll
        for (int b = 0; b < 2; ++b)
#pragma unroll
            for (int m = 0; m < 4; ++m)
#pragma unroll
                for (int n = 0; n < 2; ++n) acc[a][b][m][n] = (f32x4){0.f, 0.f, 0.f, 0.f};
    Frags<FP8> FR;
    unsigned va0[2], va1[2], vn0[2], vn1[2];
    const char* const gA = P.Abase; const char* cA = gA; const char* nA = gA; const char* cB = P.b_tile(cur);
    if constexpr (Prob::GATHER) {
        gather_offs(cur, va0, va1);
    } else { cA = gA + P.a_row(cur, 0); }
#define PG8_STAGE_A(bufoff, h, koff, nx) do { if constexpr (Prob::GATHER) { unsigned _v[2]; _Pragma("unroll") for (int _i = 0; _i < 2; ++_i) _v[_i] = (nx) ? ((h) ? vn1[_i] : vn0[_i]) : ((h) ? va1[_i] : va0[_i]); PG8_STAGE(bufoff, gA + (koff), _v); } \
        else { PG8_STAGE(bufoff, ((nx) ? nA : cA) + (h) * hstepA + (koff), voffA); } } while (0)
    PG8_STAGE(PG8_SB(0, 0), cB, voffB); PG8_STAGE(PG8_SB(0, 1), cB + hstepB, voffB); PG8_STAGE_A(PG8_SA(0, 0), 0, 0, false); PG8_STAGE_A(PG8_SA(0, 1), 1, 0, false);
    if (wr == 1) PG8_BAR;
    PG8_WAIT_V(2); PG8_BAR;
    PG8_STAGE(PG8_SB(1, 0), cB + kstep, voffB); PG8_STAGE_A(PG8_SA(1, 0), 0, kstep, false); PG8_STAGE(PG8_SB(1, 1), cB + hstepB + kstep, voffB);
    PG8_WAIT_V(6); PG8_BAR;
    Unit nx2; unsigned vq0[2], vq1[2]; bool has_next = P.unit(1, nxt);
    if (!has_next) nxt = cur;
    if constexpr (Prob::GATHER) gather_offs(nxt, vn0, vn1);
    for (;;) {
        if constexpr (!Prob::GATHER) { has_next = P.unit(ui + 1, nxt); if (!has_next) nxt = cur; nA = gA + P.a_row(nxt, 0); }
        const char* nB = P.b_tile(nxt);
        for (int t = 0; t < nt; t += 2) {
            const bool last = (t == nt - 2);
            if constexpr (HOOK) { if (t == (nt >> 1)) { if constexpr (FP8) asm volatile("s_nop 15\n\ts_nop 15" ::: "memory"); E.mid(acc, cur, wr, wc, fr, fq); } }
            const size_t k1 = (size_t)(t + 1) * kstep, k2 = last ? 0 : (size_t)(t + 2) * kstep, k3 = k2 + kstep;
            const char* b2 = last ? nB : cB + (size_t)(t + 2) * kstep; const char* b3 = b2 + kstep;
            PG8_LDB(b0, 0, 0); PG8_LDB(b1, 0, 1); PG8_SCHED; PG8_LDA(At, 0, 0); PG8_STAGE_A(PG8_SA(1, 1), 1, k1, false);
            PG8_WAIT_V(8); PG8_WAIT_L(0); PG8_BAR; PG8_MMA(0, 0, At, b0); PG8_MMA(0, 1, At, b1); PG8_BAR; PG8_SCHED;
            PG8_LDA(At, 0, 1); PG8_STAGE(PG8_SB(0, 0), b2, voffB); PG8_STAGE(PG8_SB(0, 1), b2 + hstepB, voffB); PG8_STAGE_A(PG8_SA(0, 0), 0, k2, last);
            PG8_WAIT_V(8); PG8_WAIT_L(0); PG8_BAR; PG8_MMA(1, 0, At, b0); PG8_MMA(1, 1, At, b1); PG8_BAR; PG8_SCHED;
            PG8_LDB(b0, 1, 0); PG8_LDB(b1, 1, 1); PG8_SCHED; PG8_LDA(At, 1, 0); PG8_STAGE_A(PG8_SA(0, 1), 1, k2, last);
            PG8_WAIT_V(8); PG8_WAIT_L(0); PG8_BAR; PG8_MMA(0, 0, At, b0); PG8_MMA(0, 1, At, b1); PG8_BAR; PG8_SCHED;
            PG8_LDA(At, 1, 1); PG8_STAGE(PG8_SB(1, 0), b3, voffB); PG8_STAGE(PG8_SB(1, 1), b3 + hstepB, voffB); PG8_STAGE_A(PG8_SA(1, 0), 0, k3, last);
            PG8_WAIT_V(8); PG8_WAIT_L(0); PG8_BAR; PG8_MMA(1, 0, At, b0); PG8_MMA(1, 1, At, b1); PG8_BAR; PG8_SCHED;
        }
        if constexpr (ALIGN_EPI) { if (wr == 0) PG8_BAR; }
        bool has_next2 = false;
        if constexpr (Prob::GATHER) { has_next2 = has_next && P.unit(ui + 2, nx2); if (!has_next2) nx2 = nxt; gather_offs(nx2, vq0, vq1); }
        if constexpr (FP8) asm volatile("s_nop 15\n\ts_nop 15" ::: "memory");
        if constexpr (DRY == 0) E(acc, cur, wr, wc, fr, fq); else { if (acc[0][0][0][0][0] == 1.2345e30f) *(volatile int*)P.Abase = 1; }
        if (!has_next) break;
#pragma unroll
        for (int a = 0; a < 2; ++a)
#pragma unroll
            for (int b = 0; b < 2; ++b)
#pragma unroll
                for (int m = 0; m < 4; ++m)
#pragma unroll
                    for (int n = 0; n < 2; ++n) acc[a][b][m][n] = (f32x4){0.f, 0.f, 0.f, 0.f};
        cur = nxt; cB = nB; cA = nA; ++ui;
        if constexpr (Prob::GATHER) {
#pragma unroll
            for (int i = 0; i < 2; ++i) { va0[i] = vn0[i]; va1[i] = vn1[i]; vn0[i] = vq0[i]; vn1[i] = vq1[i]; }
            nxt = nx2; has_next = has_next2; }
        if constexpr (ALIGN_EPI) { if (wr == 1) PG8_BAR; }
    }
    PG8_WAIT_V(0);
    if constexpr (!ALIGN_EPI) { if (wr == 0) PG8_BAR; }
    PG8_BAR;
#undef PG8_SA
#undef PG8_SB
#undef PG8_STAGE
#undef PG8_STAGE_A
#undef PG8_LDA
#undef PG8_LDB
#undef PG8_MMA
#undef PG8_WAIT_V
#undef PG8_WAIT_L
#undef PG8_BAR
#undef PG8_SCHED
}
}

using pg8::Unit;

struct ProbDense {
    static constexpr bool GATHER = false;
    const char* Abase; int nt; unsigned ldb2; unsigned lda2; const char* Bt; int nM, nN, G, c; int rev;
    __device__ __forceinline__ bool unit(int i, Unit& u) const { int w; if (!pg8::xcd_remap(i, G, c, nM * nN, w)) return false; pg8::grouped(w, nM, nN, u.pm, u.pn); if (rev) u.pm = nM - 1 - u.pm; u.aux = 0; return true; }
    __device__ __forceinline__ unsigned a_row(const Unit& u, int r) const { return (unsigned)(u.pm * 256 + r) * lda2; }
    __device__ __forceinline__ const char* b_tile(const Unit& u) const { return Bt + (size_t)u.pn * 256 * ldb2; }
};
struct ProbP1 {
    static constexpr bool GATHER = false;
    const char* Abase; int nt; unsigned ldb2; unsigned lda2; const char* Bt; unsigned uc_off; int G, c;
    __device__ __forceinline__ bool unit(int i, Unit& u) const {
        int w; if (!pg8::xcd_remap(i, G, c, 3072 + 256, w)) return false;
        if (w < 3072) { pg8::grouped(w, 256, 12, u.pm, u.pn); u.pm = 255 - u.pm; u.aux = 0; }
        else { pg8::grouped(w - 3072, 32, 8, u.pm, u.pn); u.pn += 4; u.aux = 1; }
        return true; }
    __device__ __forceinline__ unsigned a_row(const Unit& u, int r) const { return (u.aux ? uc_off : 0u) + (unsigned)(u.pm * 256 + r) * lda2; }
    __device__ __forceinline__ const char* b_tile(const Unit& u) const { return Bt + (size_t)u.pn * 256 * ldb2; }
};
template <bool GATHER_> struct ProbMoE {
    static constexpr bool GATHER = GATHER_;
    const char* Abase; int nt; unsigned ldb2; unsigned lda2; const char* Bt; size_t estride; int nN, nblk, G, c; const int* rowtok; const LAS unsigned char* blk_e;
    __device__ __forceinline__ bool unit(int i, Unit& u) const { int w; if (!pg8::xcd_remap(i, G, c, nblk * nN, w)) return false; pg8::grouped(w, nblk, nN, u.pm, u.pn); if (!GATHER) u.pm = nblk - 1 - u.pm;
        u.aux = (int)blk_e[u.pm]; return true; }
    __device__ __forceinline__ unsigned a_row(const Unit& u, int r) const { if (GATHER) return (unsigned)rowtok[u.pm * 256 + r] * lda2; else return (unsigned)(u.pm * 256 + r) * lda2; }
    __device__ __forceinline__ const char* b_tile(const Unit& u) const { return Bt + (size_t)u.aux * estride + (size_t)u.pn * 256 * ldb2; }
};

struct EpiP1 {
    static constexpr bool PERM = true;
    bf16_t* PA; bf16_t* PH; bf16_t* PHC;
    __device__ __forceinline__ void operator()(const f32x4 (&acc)[2][2][4][2], const Unit& u, int wr, int wc, int fr, int fq) const {
        const int row0 = u.pm * 256 + wr * 64 + fr;
        if (!u.aux && u.pn < 4) {
            unsigned char* PA8 = (unsigned char*)PA;
#pragma unroll
            for (int ai = 0; ai < 2; ++ai)
#pragma unroll
                for (int bj = 0; bj < 2; ++bj) { u32x2 pk[4];
#pragma unroll
                    for (int m = 0; m < 4; ++m) { const f32x4 v0 = acc[ai][bj][m][0] * W8_INV, v1 = acc[ai][bj][m][1] * W8_INV;
                        pk[m] = (u32x2){cvt_pk4_fp8(v0[0], v0[1], v0[2], v0[3]), cvt_pk4_fp8(v1[0], v1[1], v1[2], v1[3])}; }
                    const int col = u.pn * 256 + bj * 128 + wc * 32 + (fq >> 1) * 16, reim = col >> 9, slab = (col & 511) >> 4;
#pragma unroll
                    for (int mp = 0; mp < 2; ++mp) { const int row = row0 + ai * 128 + (2 * mp + (fq & 1)) * 16, b = row >> 11, t = row & 2047;
                        *(u32x4*)(PA8 + ((((size_t)(b * 32 + slab) * 2048 + t) * 2 + reim) * 16)) = widen16(pk[2 * mp], pk[2 * mp + 1]); } }
            return;
        }
        bf16_t* base = u.aux ? PHC : PH; const int ldc = 2048, colt = (u.pn - 4) * 256;
        if (u.pn < 6 || u.pn >= 10) {
            const bool isq = u.pn < 6;
            unsigned char* b8 = (unsigned char*)base + (isq ? (u.pn - 4) * 256 : 3072 + (u.pn - 10) * 256) + wc * 32 + (fq >> 1) * 16;
#pragma unroll
            for (int ai = 0; ai < 2; ++ai)
#pragma unroll
                for (int bj = 0; bj < 2; ++bj) { u32x2 pk[4];
#pragma unroll
                    for (int m = 0; m < 4; ++m) { f32x4 v0 = acc[ai][bj][m][0] * W8_INV, v1 = acc[ai][bj][m][1] * W8_INV;
                        if (isq) {
#pragma unroll
                            for (int j = 0; j < 4; ++j) { v0[j] *= fast_sigmoid(v0[j]); v1[j] *= fast_sigmoid(v1[j]); } }
                        pk[m] = (u32x2){cvt_pk4_fp8(v0[0], v0[1], v0[2], v0[3]), cvt_pk4_fp8(v1[0], v1[1], v1[2], v1[3])}; }
#pragma unroll
                    for (int mp = 0; mp < 2; ++mp)
                        *(u32x4*)(b8 + (size_t)(row0 + ai * 128 + (2 * mp + (fq & 1)) * 16) * 4096 + bj * 128) = widen16(pk[2 * mp], pk[2 * mp + 1]); }
            return;
        }
        const int col0 = colt + wc * 32 + 8 * fq;
#pragma unroll
        for (int ai = 0; ai < 2; ++ai)
#pragma unroll
            for (int m = 0; m < 4; ++m) { bf16_t* rowp = base + (size_t)(row0 + ai * 128 + m * 16) * ldc + col0;
#pragma unroll
                for (int bj = 0; bj < 2; ++bj) { const f32x4 v0 = acc[ai][bj][m][0] * W8_INV, v1 = acc[ai][bj][m][1] * W8_INV;
                    u32x4 w; w.x = cvt_pk_bf16(v0[0], v0[1]); w.y = cvt_pk_bf16(v0[2], v0[3]); w.z = cvt_pk_bf16(v1[0], v1[1]); w.w = cvt_pk_bf16(v1[2], v1[3]);
                    *(u32x4*)(rowp + bj * 128) = w; } }
    }
    __device__ __forceinline__ void mid(f32x4 (&)[2][2][4][2], const Unit&, int, int, int, int) const {}
};
struct EpiP2 {
    static constexpr bool PERM = true;
    unsigned char* PG; unsigned char* GATES;
    __device__ __forceinline__ void operator()(const f32x4 (&acc)[2][2][4][2], const Unit& u, int wr, int wc, int fr, int fq) const {
        const int row0 = u.pm * 256 + wr * 64 + fr;
        if (u.pn < 2) {
            const int colp = u.pn * 256 + wc * 32 + (fq >> 1) * 16;
#pragma unroll
            for (int ai = 0; ai < 2; ++ai)
#pragma unroll
                for (int bj = 0; bj < 2; ++bj) { u32x2 pk[4];
#pragma unroll
                    for (int m = 0; m < 4; ++m) { f32x4 v0 = acc[ai][bj][m][0] * W8_INV, v1 = acc[ai][bj][m][1] * W8_INV;
#pragma unroll
                        for (int j = 0; j < 4; ++j) { v0[j] *= fast_sigmoid(v0[j]); v1[j] *= fast_sigmoid(v1[j]); }
                        pk[m] = (u32x2){cvt_pk4_fp8(v0[0], v0[1], v0[2], v0[3]), cvt_pk4_fp8(v1[0], v1[1], v1[2], v1[3])}; }
#pragma unroll
                    for (int mp = 0; mp < 2; ++mp)
                        *(u32x4*)(PG + (size_t)(row0 + ai * 128 + (2 * mp + (fq & 1)) * 16) * 512 + colp + bj * 128) = widen16(pk[2 * mp], pk[2 * mp + 1]); }
            return;
        }
        const int colt = (u.pn - 2) * 256 + wc * 32 + (fq >> 1) * 16;
#pragma unroll
        for (int ai = 0; ai < 2; ++ai)
#pragma unroll
            for (int bj = 0; bj < 2; ++bj) { u32x2 pk[4];
#pragma unroll
                for (int m = 0; m < 4; ++m) { f32x4 v0 = acc[ai][bj][m][0] * W8_INV, v1 = acc[ai][bj][m][1] * W8_INV;
#pragma unroll
                    for (int j = 0; j < 4; ++j) { v0[j] = fmaxf(fast_sigmoid(v0[j]) * 255.0f, 1.0f); v1[j] = fmaxf(fast_sigmoid(v1[j]) * 255.0f, 1.0f); }
                    pk[m] = (u32x2){pack4_u8(v0[0], v0[1], v0[2], v0[3]), pack4_u8(v1[0], v1[1], v1[2], v1[3])}; }
#pragma unroll
                for (int mp = 0; mp < 2; ++mp)
                    *(u32x4*)(GATES + (size_t)(row0 + ai * 128 + (2 * mp + (fq & 1)) * 16) * 2048 + colt + bj * 128) = widen16(pk[2 * mp], pk[2 * mp + 1]); }
    }
    __device__ __forceinline__ void mid(f32x4 (&)[2][2][4][2], const Unit&, int, int, int, int) const {}
};
struct EpiM1 {
    static constexpr bool PERM = true;
    const unsigned char* GATES; unsigned char* Mo;
    __device__ __forceinline__ void mid(f32x4 (&acc)[2][2][4][2], const Unit& u, int wr, int wc, int fr, int fq) const {
        int row0 = u.pm * 256 + wr * 64 + fr + (fq & 1) * 16, col0 = u.pn * 256 + wc * 32 + (fq >> 1) * 16;
        asm volatile("" : "+v"(row0), "+v"(col0));
#pragma unroll
        for (int ai = 0; ai < 2; ++ai) {
            u32x4 gf[2][2], gh[2][2];
#pragma unroll
            for (int mp = 0; mp < 2; ++mp) { const unsigned char* gp = GATES + (size_t)(row0 + ai * 128 + mp * 32) * 2048 + col0;
#pragma unroll
                for (int bj = 0; bj < 2; ++bj) { gf[mp][bj] = *(const u32x4*)(gp + bj * 128); gh[mp][bj] = *(const u32x4*)(gp + 1024 + bj * 128); } }
#pragma unroll
            for (int mp = 0; mp < 2; ++mp)
#pragma unroll
                for (int bj = 0; bj < 2; ++bj) { u32x2 f2[2], h2[2]; unwiden16(gf[mp][bj], f2[0], f2[1]); unwiden16(gh[mp][bj], h2[0], h2[1]);
#pragma unroll
                    for (int q = 0; q < 2; ++q) { const int m = 2 * mp + q;
                        const f32x4 fa = u8x4_to_f32(f2[q].x), fb = u8x4_to_f32(f2[q].y), ha = u8x4_to_f32(h2[q].x), hb = u8x4_to_f32(h2[q].y);
#pragma unroll
                        for (int j = 0; j < 4; ++j) { acc[ai][bj][m][0][j] *= fa[j] * __builtin_amdgcn_rcpf(ha[j]); acc[ai][bj][m][1][j] *= fb[j] * __builtin_amdgcn_rcpf(hb[j]); } } }
            asm volatile("" ::: "memory");
        }
    }
    __device__ __forceinline__ void operator()(const f32x4 (&acc)[2][2][4][2], const Unit& u, int wr, int wc, int fr, int fq) const {
        const int row0 = u.pm * 256 + wr * 64 + fr, col0 = u.pn * 256 + wc * 32 + (fq >> 1) * 16;
        const float sc = W8_INV * (1.0f / 255.0f);
#pragma unroll
        for (int ai = 0; ai < 2; ++ai) {
            u32x4 gh[2][2];
#pragma unroll
            for (int mp = 0; mp < 2; ++mp) { const unsigned char* gp = GATES + (size_t)(row0 + ai * 128 + (2 * mp + (fq & 1)) * 16) * 2048 + 1024 + col0;
#pragma unroll
                for (int bj = 0; bj < 2; ++bj) gh[mp][bj] = *(const u32x4*)(gp + bj * 128); }
#pragma unroll
            for (int bj = 0; bj < 2; ++bj) { u32x2 pk[4];
#pragma unroll
                for (int mp = 0; mp < 2; ++mp) { u32x2 h2[2]; unwiden16(gh[mp][bj], h2[0], h2[1]);
#pragma unroll
                    for (int q = 0; q < 2; ++q) { const int m = 2 * mp + q; const f32x4 ha = u8x4_to_f32(h2[q].x) * sc, hb = u8x4_to_f32(h2[q].y) * sc;
                        const f32x4 v0 = acc[ai][bj][m][0] * ha, v1 = acc[ai][bj][m][1] * hb;
                        pk[m] = (u32x2){cvt_pk4_fp8(v0[0], v0[1], v0[2], v0[3]), cvt_pk4_fp8(v1[0], v1[1], v1[2], v1[3])}; } }
#pragma unroll
                for (int mp = 0; mp < 2; ++mp)
                    *(u32x4*)(Mo + (size_t)(row0 + ai * 128 + (2 * mp + (fq & 1)) * 16) * 1024 + col0 + bj * 128) = widen16(pk[2 * mp], pk[2 * mp + 1]); }
            asm volatile("" ::: "memory");
        }
    }
};
constexpr float V8_SCALE = 16.0f, V8_INV = 1.0f / 16.0f;
struct EpiM2 {
    static constexpr bool PERM = true;
    const float* ada; unsigned char* V;
    __device__ __forceinline__ void operator()(const f32x4 (&acc)[2][2][4][2], const Unit& u, int wr, int wc, int fr, int fq) const {
        const int row0 = u.pm * 256 + wr * 64 + fr, col0 = u.pn * 256 + wc * 32 + 8 * fq, colw = u.pn * 256 + wc * 32 + (fq >> 1) * 16;
        const float* g1 = ada + (size_t)(u.pm >> 3) * 6144 + 2048 + col0;
        f32x4 gv[2][2];
#pragma unroll
        for (int bj = 0; bj < 2; ++bj)
#pragma unroll
            for (int n = 0; n < 2; ++n) gv[bj][n] = *(const f32x4*)(g1 + bj * 128 + n * 4) * (W8_INV * V8_SCALE);
#pragma unroll
        for (int ai = 0; ai < 2; ++ai)
#pragma unroll
            for (int bj = 0; bj < 2; ++bj) { u32x2 pk[4];
#pragma unroll
                for (int m = 0; m < 4; ++m) { const f32x4 v0 = gv[bj][0] * acc[ai][bj][m][0], v1 = gv[bj][1] * acc[ai][bj][m][1];
                    pk[m] = (u32x2){cvt_pk4_fp8(v0[0], v0[1], v0[2], v0[3]), cvt_pk4_fp8(v1[0], v1[1], v1[2], v1[3])}; }
#pragma unroll
                for (int mp = 0; mp < 2; ++mp)
                    *(u32x4*)(V + (size_t)(row0 + ai * 128 + (2 * mp + (fq & 1)) * 16) * 1024 + colw + bj * 128) = widen16(pk[2 * mp], pk[2 * mp + 1]); }
    }
    __device__ __forceinline__ void mid(f32x4 (&)[2][2][4][2], const Unit&, int, int, int, int) const {}
};
struct EpiGU {
    static constexpr bool PERM = true;
    const float* bgu; unsigned char* ACT;
    __device__ __forceinline__ void operator()(const f32x4 (&acc)[2][2][4][2], const Unit& u, int wr, int wc, int fr, int fq) const {
        const int row0 = u.pm * 256 + wr * 64 + fr, col0 = u.pn * 128 + wc * 32 + 8 * fq;
        const float* bp = bgu + (size_t)u.aux * 2048 + col0;
        const f32x4 bg0 = *(const f32x4*)(bp), bg1 = *(const f32x4*)(bp + 4), bu0 = *(const f32x4*)(bp + 1024), bu1 = *(const f32x4*)(bp + 1028);
#pragma unroll
        for (int ai = 0; ai < 2; ++ai) { u32x2 pk[4];
#pragma unroll
            for (int m = 0; m < 4; ++m) {
                f32x4 g0 = acc[ai][0][m][0] * W8_INV + bg0, g1 = acc[ai][0][m][1] * W8_INV + bg1, p0 = acc[ai][1][m][0] * W8_INV + bu0, p1 = acc[ai][1][m][1] * W8_INV + bu1;
#pragma unroll
                for (int j = 0; j < 4; ++j) {
                    float g = fminf(g0[j], 7.0f), p = fminf(fmaxf(p0[j], -7.0f), 7.0f); g0[j] = (p + 1.0f) * g * fast_sigmoid(1.702f * g);
                    g = fminf(g1[j], 7.0f); p = fminf(fmaxf(p1[j], -7.0f), 7.0f); g1[j] = (p + 1.0f) * g * fast_sigmoid(1.702f * g); }
                pk[m] = (u32x2){cvt_pk4_fp8(g0[0], g0[1], g0[2], g0[3]), cvt_pk4_fp8(g1[0], g1[1], g1[2], g1[3])}; }
#pragma unroll
            for (int mp = 0; mp < 2; ++mp)
                *(u32x4*)(ACT + (size_t)(row0 + ai * 128 + (2 * mp + (fq & 1)) * 16) * 1024 + u.pn * 128 + wc * 32 + (fq >> 1) * 16) = widen16(pk[2 * mp], pk[2 * mp + 1]); }
    }
    __device__ __forceinline__ void mid(f32x4 (&)[2][2][4][2], const Unit&, int, int, int, int) const {}
};
struct EpiDN {
    static constexpr bool PERM = true;
    const float* bdn; unsigned char* Y;
    __device__ __forceinline__ void operator()(const f32x4 (&acc)[2][2][4][2], const Unit& u, int wr, int wc, int fr, int fq) const {
        const int row0 = u.pm * 256 + wr * 64 + fr, col0 = u.pn * 256 + wc * 32 + 8 * fq;
        const float* bp = bdn + (size_t)u.aux * 1024 + col0;
        f32x4 bv[2][2];
#pragma unroll
        for (int bj = 0; bj < 2; ++bj)
#pragma unroll
            for (int n = 0; n < 2; ++n) bv[bj][n] = *(const f32x4*)(bp + bj * 128 + 4 * n);
#pragma unroll
        for (int ai = 0; ai < 2; ++ai)
#pragma unroll
            for (int bj = 0; bj < 2; ++bj) { u32x2 pk[4];
#pragma unroll
                for (int m = 0; m < 4; ++m) { const f32x4 v0 = acc[ai][bj][m][0] * W8_INV + bv[bj][0], v1 = acc[ai][bj][m][1] * W8_INV + bv[bj][1];
                    pk[m] = (u32x2){cvt_pk4_fp8(v0[0], v0[1], v0[2], v0[3]), cvt_pk4_fp8(v1[0], v1[1], v1[2], v1[3])}; }
#pragma unroll
                for (int mp = 0; mp < 2; ++mp)
                    *(u32x4*)(Y + (size_t)(row0 + ai * 128 + (2 * mp + (fq & 1)) * 16) * 1024 + u.pn * 256 + bj * 128 + wc * 32 + (fq >> 1) * 16) = widen16(pk[2 * mp], pk[2 * mp + 1]); }
    }
    __device__ __forceinline__ void mid(f32x4 (&)[2][2][4][2], const Unit&, int, int, int, int) const {}
};

struct Frame {
    LAS unsigned char* lds; int tid, lane, wave, G, c;
    const float* const* in; float* out; unsigned char* ws; unsigned* ctl;
};
enum { I_X = 0, I_C, I_CTX, I_CCTX, I_WADA, I_BADA, I_WIN, I_LBRAW, I_HGG, I_WFO, I_WHO, I_WO, I_LN1G, I_LN1B, I_WR, I_BR, I_WGU, I_BGU, I_WDN, I_BDN, I_LN2G, I_LN2B };

__device__ __forceinline__ float wave_sum(float v) {
#pragma unroll
    for (int o = 32; o >= 1; o >>= 1) v += __shfl_xor(v, o);
    return v;
}

__device__ __forceinline__ Frame fresh(const Frame& F) { Frame G = F; int t = threadIdx.x; asm volatile("" : "+v"(t)); G.tid = t; G.lane = t & 63; G.wave = __builtin_amdgcn_readfirstlane(t >> 6); return G; }

__device__ __forceinline__ void p0_ada(const Frame& F) {
    LAS float* cact = (LAS float*)F.lds;
    float* ada = (float*)(F.ws + WS_ADA);
    for (int cb = F.c; cb < 192; cb += F.G) {
        const int kg = F.tid >> 5, col = F.tid & 31, gcol = cb * 32 + col;
        float w[16][4];
#pragma unroll
        for (int i = 0; i < 16; ++i)
#pragma unroll
            for (int j = 0; j < 4; ++j) w[i][j] = F.in[I_WADA][(size_t)(4 * kg + 64 * i + j) * 6144 + gcol];
        f32x4 cv[17];
#pragma unroll
        for (int it = 0; it < 17; ++it) { const int q = F.tid + it * NTHR, bq = q >> 8, k4 = (q & 255) * 4; cv[it] = (f32x4){0.f, 0.f, 0.f, 0.f};
            if (q < 33 * 256) cv[it] = *(const f32x4*)(bq < 32 ? F.in[I_C] + bq * 1024 + k4 : F.in[I_CCTX] + k4); }
#pragma unroll
        for (int it = 0; it < 17; ++it) { const int q = F.tid + it * NTHR; f32x4 v = cv[it];
#pragma unroll
            for (int j = 0; j < 4; ++j) v[j] = v[j] * fast_sigmoid(v[j]);
            if (q < 33 * 256) *(LAS f32x4*)(cact + q * 4) = v; }
        __syncthreads();
        float acc[33];
#pragma unroll
        for (int bb = 0; bb < 33; ++bb) acc[bb] = 0.f;
#pragma unroll
        for (int i = 0; i < 16; ++i)
#pragma unroll
            for (int bb = 0; bb < 33; ++bb) { const f32x4 c4 = *(const LAS f32x4*)(cact + bb * 1024 + 4 * kg + 64 * i);
                acc[bb] += (c4[0] * w[i][0] + c4[1] * w[i][1]) + (c4[2] * w[i][2] + c4[3] * w[i][3]); }
        __syncthreads();
        LAS float* red = cact;
#pragma unroll
        for (int bb = 0; bb < 33; ++bb) red[(kg * 33 + bb) * 32 + col] = acc[bb];
        __syncthreads();
        for (int o = F.tid; o < 33 * 32; o += NTHR) { const int bb = o >> 5, cc = o & 31; float sum = 0.f;
#pragma unroll
            for (int g = 0; g < 16; ++g) sum += red[(g * 33 + bb) * 32 + cc];
            ada[(size_t)bb * 6144 + cb * 32 + cc] = sum + F.in[I_BADA][cb * 32 + cc]; }
        __syncthreads();
    }
}
__device__ __forceinline__ void p0_fold(const Frame& F) {
    LAS float* xr = (LAS float*)F.lds;
    LAS float* cs = xr + 2048;
    unsigned char* W1 = (unsigned char*)(F.ws + WS_WIN1T);
    if (F.tid < 128) { const float a = (float)F.tid * (1.0f / 128.0f); cs[F.tid] = __builtin_amdgcn_cosf(a); cs[128 + F.tid] = __builtin_amdgcn_sinf(a); }
    for (int kb = F.c; kb < 256; kb += F.G) {
        __syncthreads();
        for (int i = F.tid; i < 2048; i += NTHR) xr[i] = F.in[I_WIN][(size_t)(4 * kb + (i >> 9)) * 5120 + (i & 511)];
        __syncthreads();
        const int g = F.tid >> 7, j = F.tid & 127;
        float ac[4] = {0.f, 0.f, 0.f, 0.f}, as[4] = {0.f, 0.f, 0.f, 0.f};
        for (int d = 0; d < 128; ++d) { const int idx = (d * j) & 127; const float cv = cs[idx], sv = cs[128 + idx];
#pragma unroll
            for (int r = 0; r < 4; ++r) { const float xv = xr[r * 512 + g * 128 + d]; ac[r] += xv * cv; as[r] += xv * sv; } }
        const float sc = 0.08838834764831845f * W8_SCALE;
        *(unsigned*)(W1 + (size_t)(g * 128 + j) * 1024 + 4 * kb) = cvt_pk4_fp8(ac[0] * sc, ac[1] * sc, ac[2] * sc, ac[3] * sc);
        *(unsigned*)(W1 + (size_t)(512 + g * 128 + j) * 1024 + 4 * kb) = cvt_pk4_fp8(-as[0] * sc, -as[1] * sc, -as[2] * sc, -as[3] * sc);
    }
    __syncthreads();
}
struct CvJob { const float* src; int sld; unsigned char* dst; int f8; };
__device__ __forceinline__ CvJob cv_job(const Frame& F, int j) {
    CvJob J;
    if (j < 128) { const int kt = j >> 4, nt = j & 15; J.src = F.in[I_WIN] + (size_t)kt * 128 * 5120 + 512 + nt * 128; J.sld = 5120; J.dst = F.ws + WS_WIN1T + (size_t)(1024 + nt * 128) * 1024 + kt * 128; J.f8 = 1; }
    else if (j < 288) { const int q = j - 128, kt = q / 20, nt = q % 20; J.src = F.in[I_WIN] + (size_t)kt * 128 * 5120 + 2560 + nt * 128; J.sld = 5120; J.dst = F.ws + WS_WIN2T + (size_t)(nt * 128) * 1024 + kt * 128; J.f8 = 1; }
    else if (j < 320) { const int q = j - 288, kt = q >> 3, nt = q & 7; J.src = F.in[I_WFO] + (size_t)kt * 128 * 1024 + nt * 128; J.sld = 1024; J.dst = F.ws + WS_WMT + ((size_t)(nt * 128) * 1024 + kt * 128); J.f8 = 1; }
    else if (j < 352) { const int q = j - 320, kt = q >> 3, nt = q & 7; J.src = F.in[I_WHO] + (size_t)kt * 128 * 1024 + nt * 128; J.sld = 1024; J.dst = F.ws + WS_WMT + ((size_t)(nt * 128) * 1024 + 512 + kt * 128); J.f8 = 1; }
    else if (j < 416) { const int q = j - 352, kt = q >> 3, nt = q & 7; J.src = F.in[I_WO] + (size_t)kt * 128 * 1024 + nt * 128; J.sld = 1024; J.dst = F.ws + WS_WOT + ((size_t)(nt * 128) * 1024 + kt * 128); J.f8 = 1; }
    else if (j < 4512) { const int q = j - 416, e = q >> 7, r = q & 127, kt = r >> 4, jt = r & 15; J.src = F.in[I_WGU] + (size_t)e * 1024 * 2048 + (size_t)kt * 128 * 2048 + jt * 128; J.sld = 2048;
        J.dst = F.ws + WS_WGUT + (size_t)e * 2048 * 1024 + (size_t)((jt & 7) * 256 + (jt >> 3) * 128) * 1024 + kt * 128; J.f8 = 1; }
    else { const int q = j - 4512, e = q >> 6, r = q & 63, kt = r >> 3, nt = r & 7; J.src = F.in[I_WDN] + (size_t)e * 1024 * 1024 + (size_t)kt * 128 * 1024 + nt * 128; J.sld = 1024;
        J.dst = F.ws + WS_WDNT + (size_t)e * 1024 * 1024 + (size_t)(nt * 128) * 1024 + kt * 128; J.f8 = 1; }
    return J;
}
__device__ __forceinline__ void p0_convert(const Frame& F) {
    constexpr int NJ = 128 + 160 + 32 + 32 + 64 + 4096 + 2048;
    LAS float* tile = (LAS float*)F.lds;
    int j = F.c; if (j >= NJ) return;
    CvJob J = cv_job(F, j);
    f32x4 v[8];
#pragma unroll
    for (int i = 0; i < 8; ++i) { const int idx = F.tid + i * NTHR, r = idx >> 5, c4 = idx & 31; v[i] = *(const f32x4*)(J.src + (size_t)r * J.sld + c4 * 4); }
    for (;;) {
        const float sc = J.f8 ? W8_SCALE : 1.0f;
#pragma unroll
        for (int i = 0; i < 8; ++i) { const int idx = F.tid + i * NTHR, r = idx >> 5, c4 = idx & 31; LAS float* p = tile + r * 129 + c4 * 4; p[0] = v[i][0] * sc; p[1] = v[i][1] * sc; p[2] = v[i][2] * sc; p[3] = v[i][3] * sc; }
        __syncthreads();
        const CvJob Jc = J; const int jn = j + F.G; const bool more = jn < NJ;
        if (more) { J = cv_job(F, jn);
#pragma unroll
            for (int i = 0; i < 8; ++i) { const int idx = F.tid + i * NTHR, r = idx >> 5, c4 = idx & 31; v[i] = *(const f32x4*)(J.src + (size_t)r * J.sld + c4 * 4); } }
        if (Jc.f8) {
#pragma unroll
            for (int i = 0; i < 2; ++i) { const int idx = F.tid + i * NTHR, n = idx >> 3, kc = idx & 7; const LAS float* p = tile + (kc * 16) * 129 + n;
                u32x4 w; w.x = cvt_pk4_fp8(p[0], p[129], p[2 * 129], p[3 * 129]); w.y = cvt_pk4_fp8(p[4 * 129], p[5 * 129], p[6 * 129], p[7 * 129]);
                w.z = cvt_pk4_fp8(p[8 * 129], p[9 * 129], p[10 * 129], p[11 * 129]); w.w = cvt_pk4_fp8(p[12 * 129], p[13 * 129], p[14 * 129], p[15 * 129]);
                *(u32x4*)(Jc.dst + (size_t)n * 1024 + kc * 16) = w; }
        } else {
#pragma unroll
            for (int i = 0; i < 4; ++i) { const int idx = F.tid + i * NTHR, n = idx >> 4, kc = idx & 15; const LAS float* p = tile + (kc * 8) * 129 + n;
                u32x4 w; w.x = cvt_pk_bf16(p[0], p[129]); w.y = cvt_pk_bf16(p[2 * 129], p[3 * 129]); w.z = cvt_pk_bf16(p[4 * 129], p[5 * 129]); w.w = cvt_pk_bf16(p[6 * 129], p[7 * 129]);
                *(u32x4*)((bf16_t*)Jc.dst + (size_t)n * 1024 + kc * 8) = w; }
        }
        __syncthreads();
        if (!more) break;
        j = jn;
    }
}

__device__ __forceinline__ void p1_uprep(const Frame& F) {
    const float* ada = (const float*)(F.ws + WS_ADA);
    unsigned char* U = (unsigned char*)(F.ws + WS_U); unsigned char* Uc = (unsigned char*)(F.ws + WS_UC);
    const size_t NIT = (size_t)(T + TCX) * 128, stride = (size_t)F.G * NTHR;
    for (size_t base = (size_t)F.c * NTHR + F.tid; base < NIT; base += 4 * stride) {
        const int col = (int)(base & 127) * 8;
        f32x4 a0[4], a1[4], sh0[4], sh1[4], sc0[4], sc1[4]; unsigned char* dst[4]; bool ok[4];
#pragma unroll
        for (int u = 0; u < 4; ++u) {
            const size_t idx = base + (size_t)u * stride; ok[u] = idx < NIT;
            const int row = (int)((ok[u] ? idx : base) >> 7);
            const bool lat = row < T; const int b = lat ? (row >> 11) : 32;
            const float* src = lat ? F.in[I_X] + (size_t)row * 1024 + col : F.in[I_CTX] + (size_t)(row - T) * 1024 + col;
            dst[u] = lat ? U + (size_t)row * 1024 + col : Uc + (size_t)(row - T) * 1024 + col;
            a0[u] = *(const f32x4*)src; a1[u] = *(const f32x4*)(src + 4);
            const float* ap = ada + (size_t)b * 6144 + col;
            sh0[u] = *(const f32x4*)ap; sh1[u] = *(const f32x4*)(ap + 4); sc0[u] = *(const f32x4*)(ap + 1024); sc1[u] = *(const f32x4*)(ap + 1028);
        }
#pragma unroll
        for (int u = 0; u < 4; ++u) {
            const f32x4 r0 = a0[u] * (sc0[u] + 1.0f) + sh0[u], r1 = a1[u] * (sc1[u] + 1.0f) + sh1[u];
            if (ok[u]) *(u32x2*)dst[u] = (u32x2){cvt_pk4_fp8(r0[0], r0[1], r0[2], r0[3]), cvt_pk4_fp8(r1[0], r1[1], r1[2], r1[3])};
        }
    }
    int* rowtok = (int*)(F.ws + WS_ROWTOK);
    for (int i = F.c * NTHR + F.tid; i < NCH * ROWS_CH; i += F.G * NTHR) rowtok[i] = (i / ROWS_CH) * TCH;
}

__device__ __forceinline__ void p6_readout(const Frame& F) {
    const bf16_t* PH = (const bf16_t*)(F.ws + WS_PH); const unsigned char* PG = (const unsigned char*)(F.ws + WS_PG); unsigned char* Y = (unsigned char*)(F.ws + WS_Y);
    const int l8 = F.lane * 8;
    const f32x4 g0 = *(const f32x4*)(F.in[I_HGG] + l8), g1 = *(const f32x4*)(F.in[I_HGG] + l8 + 4);
    const int tstr = F.G * 8;
    for (int t0 = F.c * 8 + F.wave; t0 < T; t0 += 4 * tstr) {
        u32x4 av[4], bv[4]; u32x2 pv[4]; bool ok[4]; int tt[4];
#pragma unroll
        for (int u = 0; u < 4; ++u) { const int t = t0 + u * tstr; ok[u] = t < T; tt[u] = ok[u] ? t : t0;
            av[u] = *(const u32x4*)(PH + (size_t)tt[u] * 2048 + 512 + l8); bv[u] = *(const u32x4*)(PH + (size_t)tt[u] * 2048 + 1024 + l8); pv[u] = *(const u32x2*)(PG + (size_t)tt[u] * 512 + l8); }
#pragma unroll
        for (int u = 0; u < 4; ++u) {
            const u32x4 a = av[u], b = bv[u]; const f32x4 pa = fp8x4_to_f32(pv[u].x), pb = fp8x4_to_f32(pv[u].y);
            float o[8] = { bf_lo(a.x) + bf_lo(b.x), bf_hi(a.x) + bf_hi(b.x), bf_lo(a.y) + bf_lo(b.y), bf_hi(a.y) + bf_hi(b.y), bf_lo(a.z) + bf_lo(b.z), bf_hi(a.z) + bf_hi(b.z), bf_lo(a.w) + bf_lo(b.w), bf_hi(a.w) + bf_hi(b.w) };
            float ss = 0.f;
#pragma unroll
            for (int i = 0; i < 8; ++i) ss += o[i] * o[i];
            ss += __shfl_xor(ss, 1); ss += __shfl_xor(ss, 2); ss += __shfl_xor(ss, 4); ss += __shfl_xor(ss, 8);
            const float rs = __builtin_amdgcn_rsqf(ss * (1.0f / 128.0f) + RMS_EPS);
            const float sp[8] = { pa[0], pa[1], pa[2], pa[3], pb[0], pb[1], pb[2], pb[3] };
            if (ok[u]) *(u32x2*)(Y + (size_t)tt[u] * 1024 + 512 + l8) = (u32x2){cvt_pk4_fp8(o[0] * rs * g0[0] * sp[0], o[1] * rs * g0[1] * sp[1], o[2] * rs * g0[2] * sp[2], o[3] * rs * g0[3] * sp[3]), cvt_pk4_fp8(o[4] * rs * g1[0] * sp[4], o[5] * rs * g1[1] * sp[5], o[6] * rs * g1[2] * sp[6], o[7] * rs * g1[3] * sp[7])};
        }
    }
}

constexpr int RW_STRIDE = 2080;
constexpr int RW_HI = 0, RW_LO = 32 * RW_STRIDE, RW_PAR = 64 * RW_STRIDE, RW_BR = RW_PAR + 16384, RW_HIST = RW_BR + 128;
__device__ __forceinline__ void p9_ln1_router(const Frame& F, const bool dry) {
    LAS unsigned char* L = F.lds;
    LAS float* par = (LAS float*)(L + RW_PAR); LAS float* brs = (LAS float*)(L + RW_BR); LAS int* hist = (LAS int*)(L + RW_HIST);
#pragma unroll 1
    for (int it = 0; it < 8; ++it) { const int item = F.tid + it * NTHR, e = item & 31, k8 = item >> 5;
        float w[8];
#pragma unroll
        for (int i = 0; i < 8; ++i) w[i] = F.in[I_WR][(k8 * 8 + i) * 32 + e];
        u32x4 hi, lo;
#pragma unroll
        for (int i = 0; i < 4; ++i) { const unsigned h = cvt_pk_bf16(w[2 * i], w[2 * i + 1]); hi[i] = h; lo[i] = cvt_pk_bf16(w[2 * i] - bf_lo(h), w[2 * i + 1] - bf_hi(h)); }
        *(LAS u32x4*)(L + RW_HI + e * RW_STRIDE + k8 * 16) = hi; *(LAS u32x4*)(L + RW_LO + e * RW_STRIDE + k8 * 16) = lo; }
    for (int i = F.tid; i < 2048; i += NTHR) par[i] = i < 1024 ? F.in[I_LN1G][i] : F.in[I_LN1B][i - 1024];
    if (F.tid < 32) brs[F.tid] = F.in[I_BR][F.tid];
    if (F.tid < NCH * 32) hist[F.tid] = 0;
    const unsigned char* V = (const unsigned char*)F.out; bf16_t* X1 = (bf16_t*)(F.ws + WS_X1); unsigned char* U2 = (unsigned char*)(F.ws + WS_U); const float* ada = (const float*)(F.ws + WS_ADA);
    int* topi = (int*)(F.ws + WS_TOPI); float* topw = (float*)(F.ws + WS_TOPW);
    for (int gb = F.c * 8; gb < T / 16; gb += F.G * 8) {
        const int g = T / 16 - 1 - (gb + F.wave), t0 = g * 16, b = (T / 16 - 1 - gb) >> 7;
        __syncthreads();
        { int tz = threadIdx.x; asm volatile("" : "+v"(tz));
          for (int i = tz; i < 2048; i += NTHR) par[2048 + i] = i < 1024 ? 1.0f + ada[(size_t)b * 6144 + 4096 + i] : ada[(size_t)b * 6144 + 3072 + (i - 1024)]; }
        __syncthreads();
        int l1 = threadIdx.x; asm volatile("" : "+v"(l1)); l1 &= 63;
        const float* xp = F.in[I_X] + (size_t)(t0 + (l1 & 15)) * 1024 + 8 * (l1 >> 4); const unsigned char* vp = V + (size_t)(t0 + (l1 & 15)) * 1024 + 8 * (l1 >> 4);
        unsigned tb[32][4]; float s1 = 0.f, s2 = 0.f, s1b = 0.f, s2b = 0.f;
#pragma unroll
        for (int c = 0; c < 16; ++c) {
            f32x4 xa[2], xb[2]; u32x2 vv[2];
#pragma unroll
            for (int q = 0; q < 2; ++q) { const int ks = 2 * c + q; xa[q] = *(const f32x4*)(xp + 32 * ks); xb[q] = *(const f32x4*)(xp + 32 * ks + 4); vv[q] = *(const u32x2*)(vp + 32 * ks); }
#pragma unroll
            for (int q = 0; q < 2; ++q) { const int ks = 2 * c + q;
                const f32x4 ta = xa[q] * DN_ALPHA + fp8x4_to_f32(vv[q].x) * V8_INV, tc = xb[q] * DN_ALPHA + fp8x4_to_f32(vv[q].y) * V8_INV;
#pragma unroll
                for (int j = 0; j < 4; ++j) { s1 += ta[j]; s1b += tc[j]; s2 = __builtin_fmaf(ta[j], ta[j], s2); s2b = __builtin_fmaf(tc[j], tc[j], s2b); }
                tb[ks][0] = cvt_pk_bf16(ta[0], ta[1]); tb[ks][1] = cvt_pk_bf16(ta[2], ta[3]); tb[ks][2] = cvt_pk_bf16(tc[0], tc[1]); tb[ks][3] = cvt_pk_bf16(tc[2], tc[3]); }
            asm volatile("" ::: "memory"); __builtin_amdgcn_sched_barrier(0);
        }
        s1 += s1b; s2 += s2b;
        {   int l4 = threadIdx.x; asm volatile("" : "+v"(l4)); l4 &= 63; const int b16 = (l4 ^ 16) << 2, b32 = (l4 ^ 32) << 2;
            s1 += __int_as_float(__builtin_amdgcn_ds_bpermute(b16, __float_as_int(s1))); s2 += __int_as_float(__builtin_amdgcn_ds_bpermute(b16, __float_as_int(s2)));
            s1 += __int_as_float(__builtin_amdgcn_ds_bpermute(b32, __float_as_int(s1))); s2 += __int_as_float(__builtin_amdgcn_ds_bpermute(b32, __float_as_int(s2))); }
        const float mean = s1 * (1.0f / 1024.0f), rstd = __builtin_amdgcn_rsqf(fmaxf(s2 * (1.0f / 1024.0f) - mean * mean, 0.f) + LN_EPS), nmr = -mean * rstd;
        f32x4 acc[2] = {(f32x4){0.f, 0.f, 0.f, 0.f}, (f32x4){0.f, 0.f, 0.f, 0.f}};
        int l2 = threadIdx.x; asm volatile("" : "+v"(l2)); l2 &= 63; const int fr = l2 & 15, fq = l2 >> 4;
        bf16_t* x1p = X1 + (size_t)(t0 + fr) * 1024 + 8 * fq; unsigned char* u2p = U2 + (size_t)(t0 + fr) * 1024 + 8 * fq;
#pragma unroll
        for (int ks = 0; ks < 32; ++ks) {
            const LAS float* pp = par + 32 * ks + 8 * fq;
            const f32x4 ta = {bf_lo(tb[ks][0]), bf_hi(tb[ks][0]), bf_lo(tb[ks][1]), bf_hi(tb[ks][1])}, tc = {bf_lo(tb[ks][2]), bf_hi(tb[ks][2]), bf_lo(tb[ks][3]), bf_hi(tb[ks][3])};
            f32x4 xa, xc, ua, uc;
            {   const f32x4 g0 = *(const LAS f32x4*)pp, b0 = *(const LAS f32x4*)(pp + 1024), c0 = *(const LAS f32x4*)(pp + 2048), h0 = *(const LAS f32x4*)(pp + 3072);
                xa = (ta * rstd + nmr) * g0 + b0; ua = xa * c0 + h0; }
            __builtin_amdgcn_sched_barrier(0);
            {   const f32x4 g1 = *(const LAS f32x4*)(pp + 4), b1 = *(const LAS f32x4*)(pp + 1028), c1 = *(const LAS f32x4*)(pp + 2052), h1 = *(const LAS f32x4*)(pp + 3076);
                xc = (tc * rstd + nmr) * g1 + b1; uc = xc * c1 + h1; }
            if (!dry) *(u32x4*)(x1p + 32 * ks) = (u32x4){cvt_pk_bf16(xa[0], xa[1]), cvt_pk_bf16(xa[2], xa[3]), cvt_pk_bf16(xc[0], xc[1]), cvt_pk_bf16(xc[2], xc[3])};
            if (!dry) *(u32x2*)(u2p + 32 * ks) = (u32x2){cvt_pk4_fp8(ua[0], ua[1], ua[2], ua[3]), cvt_pk4_fp8(uc[0], uc[1], uc[2], uc[3])};
            u32x4 hi = {cvt_pk_bf16(ua[0], ua[1]), cvt_pk_bf16(ua[2], ua[3]), cvt_pk_bf16(uc[0], uc[1]), cvt_pk_bf16(uc[2], uc[3])};
            u32x4 lo = {cvt_pk_bf16(ua[0] - bf_lo(hi[0]), ua[1] - bf_hi(hi[0])), cvt_pk_bf16(ua[2] - bf_lo(hi[1]), ua[3] - bf_hi(hi[1])), cvt_pk_bf16(uc[0] - bf_lo(hi[2]), uc[1] - bf_hi(hi[2])), cvt_pk_bf16(uc[2] - bf_lo(hi[3]), uc[3] - bf_hi(hi[3]))};
            const bf16x8 uh = *(bf16x8*)&hi, ul = *(bf16x8*)&lo;
#pragma unroll
            for (int et = 0; et < 2; ++et) {
                const bf16x8 wh = *(const LAS bf16x8*)(L + RW_HI + (16 * et + fr) * RW_STRIDE + ks * 64 + fq * 16), wl = *(const LAS bf16x8*)(L + RW_LO + (16 * et + fr) * RW_STRIDE + ks * 64 + fq * 16);
                acc[et] = __builtin_amdgcn_mfma_f32_16x16x32_bf16(wh, uh, acc[et], 0, 0, 0);
                acc[et] = __builtin_amdgcn_mfma_f32_16x16x32_bf16(wh, ul, acc[et], 0, 0, 0);
                acc[et] = __builtin_amdgcn_mfma_f32_16x16x32_bf16(wl, uh, acc[et], 0, 0, 0);
                __builtin_amdgcn_sched_barrier(0); }
        }
        int l3 = threadIdx.x; asm volatile("" : "+v"(l3)); l3 &= 63; const int fq3 = l3 >> 4, t = t0 + (l3 & 15), a16 = (l3 ^ 16) << 2, a32 = (l3 ^ 32) << 2;
        float lv[8]; int li[8];
#pragma unroll
        for (int i = 0; i < 4; ++i) { li[i] = 4 * fq3 + i; li[4 + i] = 16 + 4 * fq3 + i; lv[i] = acc[0][i] + brs[4 * fq3 + i]; lv[4 + i] = acc[1][i] + brs[16 + 4 * fq3 + i]; }
        float tv[4]; int ti[4];
#pragma unroll
        for (int r = 0; r < 4; ++r) {
            float bv = lv[0]; int bi = li[0];
#pragma unroll
            for (int i = 1; i < 8; ++i) { const bool gt = lv[i] > bv; bv = gt ? lv[i] : bv; bi = gt ? li[i] : bi; }
#pragma unroll
            for (int o = 0; o < 2; ++o) { const int ad = o ? a32 : a16; const float ov = __int_as_float(__builtin_amdgcn_ds_bpermute(ad, __float_as_int(bv))); const int oi = __builtin_amdgcn_ds_bpermute(ad, bi); const bool tk = ov > bv || (ov == bv && oi < bi); bv = tk ? ov : bv; bi = tk ? oi : bi; }
            tv[r] = bv; ti[r] = bi;
#pragma unroll
            for (int i = 0; i < 8; ++i) lv[i] = (li[i] == bi) ? -3.0e38f : lv[i];
        }
        if (fq3 == 0) {
            const float p1 = fast_exp(tv[1] - tv[0]), p2 = fast_exp(tv[2] - tv[0]), p3 = fast_exp(tv[3] - tv[0]), inv = 1.0f / (1.0f + p1 + p2 + p3);
            *(int4*)(topi + (size_t)t * 4) = make_int4(ti[0], ti[1], ti[2], ti[3]);
            *(f32x4*)(topw + (size_t)t * 4) = (f32x4){inv, p1 * inv, p2 * inv, p3 * inv};
            const int ch = t / TCH;
            if (!dry) { atomicAdd((int*)(hist + ch * 32 + ti[0]), 1); atomicAdd((int*)(hist + ch * 32 + ti[1]), 1); atomicAdd((int*)(hist + ch * 32 + ti[2]), 1); atomicAdd((int*)(hist + ch * 32 + ti[3]), 1); }
        }
    }
    __syncthreads();
    { int t2 = threadIdx.x; asm volatile("" : "+v"(t2));
      if (t2 < NCH * 32) { const int h = hist[t2]; if (h && !dry) atomicAdd(F.ctl + CW_CNT + t2, (unsigned)h); } }
    __syncthreads();
}

__device__ __forceinline__ void p10_dispatch(const Frame& F) {
    LAS int* lcnt = (LAS int*)F.lds; LAS int* lbase = lcnt + 32; LAS int* pstart = lcnt + 64;
    const int* topi = (const int*)(F.ws + WS_TOPI); int* pos = (int*)(F.ws + WS_POS); int* rowtok = (int*)(F.ws + WS_ROWTOK);
    for (int s = F.c; s < T / 256; s += F.G) {
        const int ch = (s * 256) / TCH;
        __syncthreads();
        if (F.tid < 32) { lcnt[F.tid] = 0; int ps = 0; for (int e = 0; e < F.tid; ++e) { const int n = (int)__hip_atomic_load(F.ctl + CW_CNT + ch * 32 + e, __ATOMIC_RELAXED, __HIP_MEMORY_SCOPE_AGENT); ps += (n + 255) & ~255; } pstart[F.tid] = ps; }
        __syncthreads();
        int e2[2], r2[2];
#pragma unroll
        for (int i = 0; i < 2; ++i) { const int a = F.tid + i * NTHR; e2[i] = topi[(size_t)(s * 256) * 4 + a]; r2[i] = atomicAdd((int*)(lcnt + e2[i]), 1); }
        __syncthreads();
        if (F.tid < 32) lbase[F.tid] = (int)atomicAdd(F.ctl + CW_CUR + ch * 32 + F.tid, (unsigned)lcnt[F.tid]);
        __syncthreads();
#pragma unroll
        for (int i = 0; i < 2; ++i) { const int a = F.tid + i * NTHR, slot = pstart[e2[i]] + lbase[e2[i]] + r2[i];
            pos[(size_t)(s * 256) * 4 + a] = slot; rowtok[(size_t)ch * ROWS_CH + slot] = s * 256 + (a >> 2); }
    }
}
__device__ __forceinline__ int moe_blocks(const Frame& F, int ch, LAS unsigned char* blk_e) {
    LAS int* sh = (LAS int*)(blk_e + 1152);
    __syncthreads();
    if (F.tid < 32) {
        int start = 0, mine = 0;
        for (int e = 0; e < 32; ++e) { const int n = ((int)__hip_atomic_load(F.ctl + CW_CNT + ch * 32 + e, __ATOMIC_RELAXED, __HIP_MEMORY_SCOPE_AGENT) + 255) >> 8; if (e < F.tid) start += n; if (e == F.tid) mine = n; }
        for (int i = 0; i < mine; ++i) blk_e[start + i] = (unsigned char)F.tid;
        if (F.tid == 31) sh[0] = start + mine;
    }
    __syncthreads();
    return sh[0];
}

__device__ __forceinline__ void p13_combine_ln2(const Frame& F, int ch, const bool dry) {
    const unsigned char* YC = (const unsigned char*)(F.ws + WS_YCH); const int* pos = (const int*)(F.ws + WS_POS); const float* topw = (const float*)(F.ws + WS_TOPW);
    const float* ada = (const float*)(F.ws + WS_ADA); const bf16_t* X1 = (const bf16_t*)(F.ws + WS_X1); float* O = F.out;
    const int l8 = F.lane * 8;
    for (int t0 = ch * TCH + F.c * 8 + F.wave; t0 < (ch + 1) * TCH; t0 += 2 * F.G * 8) {
        int tt[2]; tt[0] = t0; tt[1] = t0 + F.G * 8; const bool two = tt[1] < (ch + 1) * TCH; if (!two) tt[1] = t0;
        f32x4 v[2][2][2];
#pragma unroll
        for (int q = 0; q < 2; ++q) { const int t = tt[q], b = t >> 11;
            const int4 ps = *(const int4*)(pos + (size_t)t * 4); const f32x4 tw = *(const f32x4*)(topw + (size_t)t * 4);
#pragma unroll
            for (int j = 0; j < 2; ++j) { const int k = 512 * j + l8;
                const u32x2 y0 = *(const u32x2*)(YC + (size_t)ps.x * 1024 + k), y1 = *(const u32x2*)(YC + (size_t)ps.y * 1024 + k), y2 = *(const u32x2*)(YC + (size_t)ps.z * 1024 + k), y3 = *(const u32x2*)(YC + (size_t)ps.w * 1024 + k);
                const u32x4 xw = *(const u32x4*)(X1 + (size_t)t * 1024 + k);
                const f32x4 g2a = *(const f32x4*)(ada + (size_t)b * 6144 + 5120 + k), g2b = *(const f32x4*)(ada + (size_t)b * 6144 + 5120 + k + 4);
                const f32x4 ffa = fp8x4_to_f32(y0.x) * tw[0] + fp8x4_to_f32(y1.x) * tw[1] + fp8x4_to_f32(y2.x) * tw[2] + fp8x4_to_f32(y3.x) * tw[3];
                const f32x4 ffb = fp8x4_to_f32(y0.y) * tw[0] + fp8x4_to_f32(y1.y) * tw[1] + fp8x4_to_f32(y2.y) * tw[2] + fp8x4_to_f32(y3.y) * tw[3];
                v[q][j][0] = (f32x4){bf_lo(xw.x), bf_hi(xw.x), bf_lo(xw.y), bf_hi(xw.y)} * DN_ALPHA + g2a * ffa;
                v[q][j][1] = (f32x4){bf_lo(xw.z), bf_hi(xw.z), bf_lo(xw.w), bf_hi(xw.w)} * DN_ALPHA + g2b * ffb; } }
#pragma unroll
        for (int q = 0; q < 2; ++q) { const int t = tt[q];
            float s = 0.f;
#pragma unroll
            for (int j = 0; j < 2; ++j)
#pragma unroll
                for (int h = 0; h < 2; ++h) s += (v[q][j][h][0] + v[q][j][h][1]) + (v[q][j][h][2] + v[q][j][h][3]);
            s = wave_sum(s); const float mean = s * (1.0f / 1024.0f); float qq = 0.f;
#pragma unroll
            for (int j = 0; j < 2; ++j)
#pragma unroll
                for (int h = 0; h < 2; ++h) { const f32x4 d = v[q][j][h] - mean; qq += (d[0] * d[0] + d[1] * d[1]) + (d[2] * d[2] + d[3] * d[3]); }
            qq = wave_sum(qq); const float rstd = __builtin_amdgcn_rsqf(qq * (1.0f / 1024.0f) + LN_EPS);
            if (q == 0 || two) {
#pragma unroll
                for (int j = 0; j < 2; ++j)
#pragma unroll
                    for (int h = 0; h < 2; ++h) { const int k = 512 * j + l8 + 4 * h; const f32x4 g = *(const f32x4*)(F.in[I_LN2G] + k), bb = *(const f32x4*)(F.in[I_LN2B] + k);
                        const f32x4 o4 = (v[q][j][h] - mean) * rstd * g + bb;
                        if (!dry) *(f32x4*)(O + (size_t)t * 1024 + k) = o4; else if (o4[0] == 1.2345e30f) O[0] = 1.f; } }
        }
    }
}

constexpr int SC_QD = 0, SC_KI = 17408, SC_KE = 34816, SC_VT = 53248, SC_SC = 71680, SC_ST = 80896, SC_GV = 115712, SC_CS = 116224;
__device__ __forceinline__ bf16x8 ldfrag(const LAS unsigned char* p) { return *(const LAS bf16x8*)p; }
__device__ __forceinline__ void p3_scan(const Frame& F, const bool dry) {
    LAS unsigned char* L = F.lds;
    const int tid = F.tid, w = F.wave, lane = F.lane, fr = lane & 15, fq = lane >> 4;
    const int d = tid & 127, qd = __builtin_amdgcn_readfirstlane(tid >> 7);
    bf16_t* PH = (bf16_t*)(F.ws + WS_PH); const bf16_t* PHC = (const bf16_t*)(F.ws + WS_PHC);
    for (int it = F.c; it < 256; it += F.G) {
        const int b = it >> 3, h = (it >> 1) & 3, dir = it & 1;
        const float r0 = F.in[I_LBRAW][dir * 512 + h * 128 + d], r1 = F.in[I_LBRAW][1024 + dir * 512 + h * 128 + d];
        const float lbv = fast_sigmoid(r0 - r1), oml = 1.0f - lbv;
        f32x4 Sacc[8];
#pragma unroll
        for (int i = 0; i < 8; ++i) Sacc[i] = (f32x4){0.f, 0.f, 0.f, 0.f};
        __syncthreads();
        for (int i = tid; i < 34816 / 4; i += NTHR) ((LAS unsigned*)(L + SC_ST))[i] = 0u;
        const int cq = h * 128 + d, cz = 512 + dir * 512 + h * 128 + d;
        unsigned char rq[16], rv[16]; bf16_t rz[16];
        {   const int n = dir ? 3 : 0; const bf16_t* base = PHC + (size_t)(b * 256 + 64 * n + 16 * qd) * 2048; const unsigned char* base8 = (const unsigned char*)base;
#pragma unroll
            for (int i = 0; i < 16; ++i) { rq[i] = base8[(size_t)i * 4096 + cq]; rz[i] = base[(size_t)i * 2048 + cz]; rv[i] = base8[(size_t)i * 4096 + 3072 + cq]; } }
        for (int s = 0; s < 36; ++s) {
            const bool lat = s >= 4; const int n = lat ? (dir ? 31 - (s - 4) : (s - 4)) : (dir ? 3 - s : s);
            float kk[16], cum[16]; float run = 0.f;
#pragma unroll
            for (int i = 0; i < 16; ++i) { const float sg = fast_sigmoid(bf2f(rz[i])); kk[i] = oml * (1.0f - sg); cum[i] = lbv + oml * sg; }
            run = 1.0f;
            if (dir == 0) {
#pragma unroll
                for (int i = 0; i < 16; ++i) { run *= cum[i]; cum[i] = run; }
            } else {
#pragma unroll
                for (int i = 15; i >= 0; --i) { run *= cum[i]; cum[i] = run; }
            }
            ((LAS float*)(L + SC_CS))[qd * 128 + d] = run;
            __syncthreads();
            {   const LAS float* cs = (const LAS float*)(L + SC_CS);
                const float c0 = cs[d], c1 = cs[128 + d], c2 = cs[256 + d], c3 = cs[384 + d], tot = (c0 * c1) * (c2 * c3);
                float off;
                if (dir == 0) off = (qd > 0 ? c0 : 1.f) * (qd > 1 ? c1 : 1.f) * (qd > 2 ? c2 : 1.f);
                else off = (qd < 3 ? c3 : 1.f) * (qd < 2 ? c2 : 1.f) * (qd < 1 ? c1 : 1.f);
                const float g = tot;
                if (qd == 0) ((LAS float*)(L + SC_GV))[d] = g;
                unsigned ke[8], vt[8];
#pragma unroll
                for (int i = 0; i < 16; i += 2) {
                    const float ea = cum[i] * off, eb = cum[i + 1] * off, ia = __builtin_amdgcn_rcpf(ea), ib = __builtin_amdgcn_rcpf(eb);
                    const float qda = __builtin_amdgcn_cvt_f32_fp8((int)rq[i], 0) * ea, qdb = __builtin_amdgcn_cvt_f32_fp8((int)rq[i + 1], 0) * eb;
                    const float kia = kk[i] * ia, kib = kk[i + 1] * ib;
                    const unsigned wa = cvt_pk_bf16(qda, kia), wb = cvt_pk_bf16(qdb, kib);
                    *(LAS bf16_t*)(L + SC_QD + (16 * qd + i) * 272 + d * 2) = (bf16_t)(wa & 0xffffu);
                    *(LAS bf16_t*)(L + SC_KI + (16 * qd + i) * 272 + d * 2) = (bf16_t)(wa >> 16);
                    *(LAS bf16_t*)(L + SC_QD + (16 * qd + i + 1) * 272 + d * 2) = (bf16_t)(wb & 0xffffu);
                    *(LAS bf16_t*)(L + SC_KI + (16 * qd + i + 1) * 272 + d * 2) = (bf16_t)(wb >> 16);
                    ke[i >> 1] = cvt_pk_bf16(kia * g, kib * g);
                    vt[i >> 1] = cvt_pk_bf16(__builtin_amdgcn_cvt_f32_fp8((int)rv[i], 0), __builtin_amdgcn_cvt_f32_fp8((int)rv[i + 1], 0));
                }
                *(LAS u32x4*)(L + SC_KE + d * 144 + 32 * qd) = (u32x4){ke[0], ke[1], ke[2], ke[3]};
                *(LAS u32x4*)(L + SC_KE + d * 144 + 32 * qd + 16) = (u32x4){ke[4], ke[5], ke[6], ke[7]};
                *(LAS u32x4*)(L + SC_VT + d * 144 + 32 * qd) = (u32x4){vt[0], vt[1], vt[2], vt[3]};
                *(LAS u32x4*)(L + SC_VT + d * 144 + 32 * qd + 16) = (u32x4){vt[4], vt[5], vt[6], vt[7]};
            }
            if (s + 1 < 36) {
                const int s1 = s + 1; const bool lat1 = s1 >= 4; const int n1 = lat1 ? (dir ? 31 - (s1 - 4) : (s1 - 4)) : (dir ? 3 - s1 : s1);
                const bf16_t* base = lat1 ? (const bf16_t*)PH + (size_t)(b * 2048 + 64 * n1 + 16 * qd) * 2048 : PHC + (size_t)(b * 256 + 64 * n1 + 16 * qd) * 2048;
                const unsigned char* base8 = (const unsigned char*)base;
#pragma unroll
                for (int i = 0; i < 16; ++i) { rq[i] = base8[(size_t)i * 4096 + cq]; rz[i] = base[(size_t)i * 2048 + cz]; rv[i] = base8[(size_t)i * 4096 + 3072 + cq]; }
            }
            __syncthreads();
            f32x4 oacc[4];
#pragma unroll
            for (int i = 0; i < 4; ++i) oacc[i] = (f32x4){0.f, 0.f, 0.f, 0.f};
            const int kb = fq * 16;
            if (lat) {
                const int ct = w >> 1, st0 = 2 * (w & 1);
#pragma unroll
                for (int j = 0; j < 2; ++j) { const int st = st0 + j; f32x4 sa = (f32x4){0.f, 0.f, 0.f, 0.f};
#pragma unroll
                    for (int ks = 0; ks < 4; ++ks) sa = __builtin_amdgcn_mfma_f32_16x16x32_bf16(ldfrag(L + SC_KI + (16 * st + fr) * 272 + ks * 64 + kb), ldfrag(L + SC_QD + (16 * ct + fr) * 272 + ks * 64 + kb), sa, 0, 0, 0);
                    const int cc = 16 * ct + fr, s0 = 16 * st + 4 * fq;
#pragma unroll
                    for (int i = 0; i < 4; ++i) { const bool keep = dir ? (s0 + i >= cc) : (s0 + i <= cc); sa[i] = keep ? sa[i] : 0.f; }
                    *(LAS u32x2*)(L + SC_SC + cc * 144 + s0 * 2) = (u32x2){cvt_pk_bf16(sa[0], sa[1]), cvt_pk_bf16(sa[2], sa[3])}; }
#pragma unroll
                for (int ct2 = 0; ct2 < 4; ++ct2)
#pragma unroll
                    for (int ks = 0; ks < 4; ++ks) oacc[ct2] = __builtin_amdgcn_mfma_f32_16x16x32_bf16(ldfrag(L + SC_ST + (16 * w + fr) * 272 + ks * 64 + kb), ldfrag(L + SC_QD + (16 * ct2 + fr) * 272 + ks * 64 + kb), oacc[ct2], 0, 0, 0);
            }
            {   const bf16x8 v0 = ldfrag(L + SC_VT + (16 * w + fr) * 144 + kb), v1 = ldfrag(L + SC_VT + (16 * w + fr) * 144 + 64 + kb);
#pragma unroll
                for (int dt = 0; dt < 8; ++dt) { const f32x4 gv = *(const LAS f32x4*)(L + SC_GV + (16 * dt + 4 * fq) * 4);
                    f32x4 a = Sacc[dt] * gv;
                    a = __builtin_amdgcn_mfma_f32_16x16x32_bf16(ldfrag(L + SC_KE + (16 * dt + fr) * 144 + kb), v0, a, 0, 0, 0);
                    a = __builtin_amdgcn_mfma_f32_16x16x32_bf16(ldfrag(L + SC_KE + (16 * dt + fr) * 144 + 64 + kb), v1, a, 0, 0, 0);
                    Sacc[dt] = a; } }
            __syncthreads();
#pragma unroll
            for (int dt = 0; dt < 8; ++dt) *(LAS u32x2*)(L + SC_ST + (16 * w + fr) * 272 + (16 * dt + 4 * fq) * 2) = (u32x2){cvt_pk_bf16(Sacc[dt][0], Sacc[dt][1]), cvt_pk_bf16(Sacc[dt][2], Sacc[dt][3])};
            if (lat) {
                const bf16x8 v0 = ldfrag(L + SC_VT + (16 * w + fr) * 144 + kb), v1 = ldfrag(L + SC_VT + (16 * w + fr) * 144 + 64 + kb);
                bf16_t* ob = PH + (size_t)(b * 2048 + 64 * n) * 2048 + 512 + dir * 512 + h * 128 + 16 * w + 4 * fq;
#pragma unroll
                for (int ct2 = 0; ct2 < 4; ++ct2) {
                    f32x4 a = oacc[ct2];
                    a = __builtin_amdgcn_mfma_f32_16x16x32_bf16(v0, ldfrag(L + SC_SC + (16 * ct2 + fr) * 144 + kb), a, 0, 0, 0);
                    a = __builtin_amdgcn_mfma_f32_16x16x32_bf16(v1, ldfrag(L + SC_SC + (16 * ct2 + fr) * 144 + 64 + kb), a, 0, 0, 0);
                    if (!dry) *(u32x2*)(ob + (size_t)(16 * ct2 + fr) * 2048) = (u32x2){cvt_pk_bf16(a[0], a[1]), cvt_pk_bf16(a[2], a[3])};
                    else if (a[0] == 1.2345e30f) ob[0] = 1; }
            }
        }
        __syncthreads();
    }
}

typedef short s16x4 __attribute__((ext_vector_type(4)));
__device__ __forceinline__ s16x4 tr_read(unsigned lds_addr) { s16x4 r; asm volatile("ds_read_b64_tr_b16 %0, %1\n\ts_waitcnt lgkmcnt(0)" : "=&v"(r) : "v"(lds_addr) : "memory"); return r; }
__device__ __forceinline__ void tr_read8(unsigned a0, unsigned a1, unsigned a2, unsigned a3, unsigned d, s16x4 (&r)[8]) {
    asm volatile("ds_read_b64_tr_b16 %0, %8\n\tds_read_b64_tr_b16 %1, %9\n\tds_read_b64_tr_b16 %2, %10\n\tds_read_b64_tr_b16 %3, %11\n\t"
                 "ds_read_b64_tr_b16 %4, %12\n\tds_read_b64_tr_b16 %5, %13\n\tds_read_b64_tr_b16 %6, %14\n\tds_read_b64_tr_b16 %7, %15\n\ts_waitcnt lgkmcnt(0)"
                 : "=&v"(r[0]), "=&v"(r[1]), "=&v"(r[2]), "=&v"(r[3]), "=&v"(r[4]), "=&v"(r[5]), "=&v"(r[6]), "=&v"(r[7])
                 : "v"(a0), "v"(a0 + d), "v"(a1), "v"(a1 + d), "v"(a2), "v"(a2 + d), "v"(a3), "v"(a3 + d) : "memory");
}
__device__ __forceinline__ void tr_read4(unsigned a0, unsigned a1, unsigned d, s16x4 (&r)[4]) {
    asm volatile("ds_read_b64_tr_b16 %0, %4\n\tds_read_b64_tr_b16 %1, %5\n\tds_read_b64_tr_b16 %2, %6\n\tds_read_b64_tr_b16 %3, %7\n\ts_waitcnt lgkmcnt(0)"
                 : "=&v"(r[0]), "=&v"(r[1]), "=&v"(r[2]), "=&v"(r[3]) : "v"(a0), "v"(a0 + d), "v"(a1), "v"(a1 + d) : "memory");
}
__device__ __forceinline__ bf16x8 cat4(s16x4 a, s16x4 b) { return (bf16x8){a[0], a[1], a[2], a[3], b[0], b[1], b[2], b[3]}; }
constexpr int FO_C = 131072, FO_S = 139264;
__device__ __forceinline__ void p4_fourier(const Frame& F) {
    LAS unsigned char* L = F.lds;
    const int tid = F.tid, w = F.wave, lane = F.lane, fr = lane & 15, fq = lane >> 4;
    const bf16_t* PA = (const bf16_t*)(F.ws + WS_PA); unsigned char* Y = (unsigned char*)(F.ws + WS_Y);
    __syncthreads();
    for (int i = tid; i < 4096; i += NTHR) { const int k2 = i >> 6, c = i & 63; const float a = (float)((k2 * c) & 63) * (1.0f / 64.0f);
        *(LAS bf16_t*)(L + FO_C + i * 2) = (bf16_t)(cvt_pk_bf16(__builtin_amdgcn_cosf(a) * 0.125f, 0.f) & 0xffffu);
        *(LAS bf16_t*)(L + FO_S + i * 2) = (bf16_t)(cvt_pk_bf16(__builtin_amdgcn_sinf(a) * 0.125f, 0.f) & 0xffffu); }
    bf16x8 Gf[2][2];
#pragma unroll
    for (int nt = 0; nt < 2; ++nt)
#pragma unroll
        for (int ks = 0; ks < 2; ++ks) { unsigned pk[4];
#pragma unroll
            for (int j = 0; j < 8; j += 2) { const int k1 = 16 * nt + fr, ra = 8 * fq + j, rb = ra + 1; const float aa = (float)((k1 * ra) & 31) * (1.0f / 32.0f), ab = (float)((k1 * rb) & 31) * (1.0f / 32.0f);
                const float va = (ks ? __builtin_amdgcn_sinf(aa) : __builtin_amdgcn_cosf(aa)) * 0.17677669529663687f, vb = (ks ? __builtin_amdgcn_sinf(ab) : __builtin_amdgcn_cosf(ab)) * 0.17677669529663687f;
                pk[j >> 1] = cvt_pk_bf16(va, vb); }
            u32x4 t4 = (u32x4){pk[0], pk[1], pk[2], pk[3]}; Gf[nt][ks] = *(bf16x8*)&t4; }
    const unsigned lbase = (unsigned)(size_t)L;
    u32x4 pv[8];
    if (F.c < 1024) { const int it = F.c, xcd = it & 7, jj = it >> 3, slab = 4 * xcd + (jj & 3), b = jj >> 2; const unsigned char* src = (const unsigned char*)PA + (size_t)(b * 32 + slab) * 65536;
#pragma unroll
        for (int n = 0; n < 8; ++n) pv[n] = *(const u32x4*)(src + (size_t)(tid + NTHR * n) * 16); }
    for (int it = F.c; it < 1024; it += F.G) {
        const int xcd = it & 7, jj = it >> 3, slab = 4 * xcd + (jj & 3), b = jj >> 2;
        __syncthreads();
#pragma unroll
        for (int n = 0; n < 8; ++n) {
            const u32x4 w = pv[n]; u32x4 lo, hi;
            { const f32x4 a = fp8x4_to_f32(w.x), c = fp8x4_to_f32(w.y); lo = (u32x4){cvt_pk_bf16(a[0], a[1]), cvt_pk_bf16(a[2], a[3]), cvt_pk_bf16(c[0], c[1]), cvt_pk_bf16(c[2], c[3])}; }
            { const f32x4 a = fp8x4_to_f32(w.z), c = fp8x4_to_f32(w.w); hi = (u32x4){cvt_pk_bf16(a[0], a[1]), cvt_pk_bf16(a[2], a[3]), cvt_pk_bf16(c[0], c[1]), cvt_pk_bf16(c[2], c[3])}; }
            *(LAS u32x4*)(L + (tid + NTHR * n) * 32) = lo; *(LAS u32x4*)(L + (tid + NTHR * n) * 32 + 16) = hi; }
        __syncthreads();
        if (it + F.G < 1024) { const int it1 = it + F.G, xcd1 = it1 & 7, jj1 = it1 >> 3, slab1 = 4 * xcd1 + (jj1 & 3), b1 = jj1 >> 2; const unsigned char* src = (const unsigned char*)PA + (size_t)(b1 * 32 + slab1) * 65536;
#pragma unroll
            for (int n = 0; n < 8; ++n) pv[n] = *(const u32x4*)(src + (size_t)(tid + NTHR * n) * 16); }
#pragma unroll 1
        for (int rr = 0; rr < 4; ++rr) {
            const int r = w + 8 * rr;
            f32x4 acc[8];
#pragma unroll
            for (int i = 0; i < 8; ++i) acc[i] = (f32x4){0.f, 0.f, 0.f, 0.f};
            s16x4 tr[8];
            {   unsigned aa[4];
#pragma unroll
                for (int ks = 0; ks < 4; ++ks) { const int ri = ks >> 1, c0 = 32 * (ks & 1) + 8 * fq + (fr >> 2); aa[ks] = lbase + (unsigned)((r * 64 + c0) * 64 + ri * 32 + (fr & 3) * 8); }
                tr_read8(aa[0], aa[1], aa[2], aa[3], 4u * 64u, tr); }
#pragma unroll
            for (int ks = 0; ks < 4; ++ks) {
                const int ri = ks >> 1;
                const bf16x8 af = cat4(tr[2 * ks], tr[2 * ks + 1]);
#pragma unroll
                for (int nt = 0; nt < 8; ++nt) { const int ro = nt >> 2, k2 = 16 * (nt & 3) + fr;
                    u32x4 bw = *(const LAS u32x4*)(L + ((ro == ri) ? FO_C : FO_S) + (k2 * 64 + 32 * (ks & 1) + 8 * fq) * 2);
                    if (ro == 1 && ri == 0) { bw.x ^= 0x80008000u; bw.y ^= 0x80008000u; bw.z ^= 0x80008000u; bw.w ^= 0x80008000u; }
                    acc[nt] = __builtin_amdgcn_mfma_f32_16x16x32_bf16(af, *(bf16x8*)&bw, acc[nt], 0, 0, 0); }
            }
#pragma unroll
            for (int nt = 0; nt < 8; ++nt) { const int ro = nt >> 2, k2 = 16 * (nt & 3) + fr;
                *(LAS u32x2*)(L + (r * 64 + k2) * 64 + ro * 32 + fq * 8) = (u32x2){cvt_pk_bf16(acc[nt][0], acc[nt][1]), cvt_pk_bf16(acc[nt][2], acc[nt][3])}; }
        }
        __syncthreads();
#pragma unroll 1
        for (int kk = 0; kk < 8; ++kk) {
            const int k2 = 8 * w + kk;
            f32x4 a2[2] = {(f32x4){0.f, 0.f, 0.f, 0.f}, (f32x4){0.f, 0.f, 0.f, 0.f}};
            s16x4 t4[4];
            {   const int r0 = 8 * fq + (fr >> 2); const unsigned a0 = lbase + (unsigned)((r0 * 64 + k2) * 64 + (fr & 3) * 8);
                tr_read4(a0, a0 + 32u, 4u * 64u * 64u, t4); }
#pragma unroll
            for (int ks = 0; ks < 2; ++ks) {
                const bf16x8 af = cat4(t4[2 * ks], t4[2 * ks + 1]);
                a2[0] = __builtin_amdgcn_mfma_f32_16x16x32_bf16(af, Gf[0][ks], a2[0], 0, 0, 0);
                a2[1] = __builtin_amdgcn_mfma_f32_16x16x32_bf16(af, Gf[1][ks], a2[1], 0, 0, 0);
            }
#pragma unroll
            for (int nt = 0; nt < 2; ++nt) { const int k1 = 16 * nt + fr;
                *(unsigned*)(Y + (size_t)(b * 2048 + k1 * 64 + k2) * 1024 + slab * 16 + 4 * fq) = cvt_pk4_fp8(a2[nt][0], a2[nt][1], a2[nt][2], a2[nt][3]); }
        }
    }
    __syncthreads();
}

struct Args { const float* in[22]; float* out; unsigned char* ws; int ph_lo, ph_hi; };
constexpr int N_PHASES = 9 + 3 * NCH;

__global__ void __launch_bounds__(NTHR, 2) mega_fwd(Args args) {
    extern __shared__ __attribute__((aligned(16))) unsigned char lds_raw[];
    Frame F;
    F.lds = (LAS unsigned char*)lds_raw;
    F.tid = threadIdx.x; F.lane = F.tid & 63; F.wave = __builtin_amdgcn_readfirstlane(F.tid >> 6);
    F.G = gridDim.x; F.c = blockIdx.x;
    F.in = args.in;
    F.out = args.out; F.ws = args.ws; F.ctl = (unsigned*)(args.ws + WS_CTL);
    volatile LAS unsigned* misc = (volatile LAS unsigned*)(F.lds + LDS_MISC);
    if (F.tid < 4) misc[F.tid] = 0u;
    __syncthreads();
    XcdBarrier bar = xcd_barrier_post(F.ctl, misc);
    const int lo = args.ph_lo, hi = args.ph_hi;
#ifndef PHASE_MASK
#define PHASE_MASK 0xFFFFFFFFu
#endif
#define IN(k) ((((PHASE_MASK) >> (k)) & 1u) && lo <= (k) && (k) < hi)
#define SEAM(k) do { if (IN(k) && IN((k) + 1)) xcd_barrier(bar); } while (0)
#ifndef REP_MASK
#define REP_MASK 0u
#endif
#define REPS(b) ((((REP_MASK) >> (b)) & 1u) ? 2 : 1)
#define REPBAR(b, r) do { if ((((REP_MASK) >> (b)) & 1u) && (r) == 0) xcd_barrier(bar); } while (0)
    unsigned char* ws = F.ws;
    LAS unsigned char* blk_e = F.lds + LDS_MISC + 64;
#ifdef PR_A
    unsigned long long* stamps = (unsigned long long*)(ws + 980 * MiB);
#define STAMP(slot) do { if (F.tid == 0) stamps[(slot) * 256 + F.c] = __builtin_amdgcn_s_memrealtime(); } while (0)
#else
#define STAMP(slot) do { } while (0)
#endif
    STAMP(0);

    if (IN(0)) { for (int r = 0; r < REPS(0); ++r) { p0_ada(F); p0_fold(F); p0_convert(F); REPBAR(0, r); } }
    STAMP(1);
    SEAM(0);
    if (IN(1)) { for (int r = 0; r < REPS(1); ++r) { p1_uprep(F); REPBAR(1, r); } }
    STAMP(2);
    SEAM(1);
    if (IN(2)) {
        ProbP1 P{(const char*)(ws + WS_U), 8, 1024u, 1024u, (const char*)(ws + WS_WIN1T), (unsigned)(WS_UC - WS_U), F.G, F.c};
        EpiP1 E{(bf16_t*)(ws + WS_PA), (bf16_t*)(ws + WS_PH), (bf16_t*)(ws + WS_PHC)};
        for (int r = 0; r < REPS(2); ++r) { pg8::gemm_phase<ProbP1, EpiP1, true, false, true>(F.lds, P, E); REPBAR(2, r); }
    }
    STAMP(3);
    SEAM(2);
    if (IN(3)) {
#ifndef NO_FOURIER
        for (int r = 0; r < REPS(4); ++r) { p4_fourier(F); REPBAR(4, r); }
        STAMP(5);
#endif
#ifndef NO_SCAN
        for (int r = 0; r < REPS(3); ++r) { p3_scan(F, r + 1 < REPS(3)); REPBAR(3, r); }
        STAMP(4);
#endif
#ifndef NO_P2GEMM
        ProbDense P{(const char*)(ws + WS_U), 8, 1024u, 1024u, (const char*)(ws + WS_WIN2T), 256, 10, F.G, F.c, 0};
        EpiP2 E{(unsigned char*)(ws + WS_PG), (unsigned char*)F.out};
        for (int r = 0; r < REPS(5); ++r) { pg8::gemm_phase<ProbDense, EpiP2, true, false, true>(F.lds, P, E); REPBAR(5, r); }
#endif
    }
    STAMP(6);
    SEAM(3);
    if (IN(4)) { for (int r = 0; r < REPS(6); ++r) { p6_readout(F); REPBAR(6, r); } }
    STAMP(7);
    SEAM(4);
    if (IN(5)) {
        ProbDense P{(const char*)(ws + WS_Y), 8, 1024u, 1024u, (const char*)(ws + WS_WMT), 256, 4, F.G, F.c, 1};
        EpiM1 E{(const unsigned char*)F.out, (unsigned char*)(ws + WS_PA)};
        for (int r = 0; r < REPS(7); ++r) { pg8::gemm_phase<ProbDense, EpiM1, true, true, true>(F.lds, P, E); REPBAR(7, r); }
    }
    STAMP(8);
    SEAM(5);
    if (IN(6)) {
        ProbDense P{(const char*)(ws + WS_PA), 8, 1024u, 1024u, (const char*)(ws + WS_WOT), 256, 4, F.G, F.c, 0};
        EpiM2 E{(const float*)(ws + WS_ADA), (unsigned char*)F.out};
        for (int r = 0; r < REPS(8); ++r) { pg8::gemm_phase<ProbDense, EpiM2, true, false, true>(F.lds, P, E); REPBAR(8, r); }
    }
    STAMP(9);
    SEAM(6);
    if (IN(7)) { for (int r = 0; r < REPS(9); ++r) { p9_ln1_router(fresh(F), r + 1 < REPS(9)); REPBAR(9, r); } }
    STAMP(10);
    SEAM(7);
    if (IN(8)) { p10_dispatch(F); }
    STAMP(11);
    SEAM(8);
#pragma unroll
    for (int ch = 0; ch < NCH; ++ch) {
        if (IN(9 + 3 * ch)) {
            const int nblk = moe_blocks(F, ch, blk_e);
            ProbMoE<true> P{(const char*)(ws + WS_U), 8, 1024u, 1024u, (const char*)(ws + WS_WGUT), (size_t)2048 * 1024, 8, nblk, F.G, F.c, (const int*)(ws + WS_ROWTOK) + (size_t)ch * ROWS_CH, blk_e};
            EpiGU E{F.in[I_BGU], (unsigned char*)(ws + WS_ACT)};
#ifdef GU_DRY
            pg8::gemm_phase<ProbMoE<true>, EpiGU, true, false, true, GU_DRY>(F.lds, P, E); xcd_barrier(bar);
#endif
            for (int r = 0; r < (ch == 0 ? REPS(10) : 1); ++r) { pg8::gemm_phase<ProbMoE<true>, EpiGU, true, false, true>(F.lds, P, E); if (ch == 0) REPBAR(10, r); }
        }
        STAMP(12);
        SEAM(9 + 3 * ch);
        if (IN(10 + 3 * ch)) {
            const int nblk = moe_blocks(F, ch, blk_e);
            ProbMoE<false> P{(const char*)(ws + WS_ACT), 8, 1024u, 1024u, (const char*)(ws + WS_WDNT), (size_t)1024 * 1024, 4, nblk, F.G, F.c, nullptr, blk_e};
            EpiDN E{F.in[I_BDN], (unsigned char*)(ws + WS_YCH)};
            for (int r = 0; r < (ch == 0 ? REPS(11) : 1); ++r) { pg8::gemm_phase<ProbMoE<false>, EpiDN, true, false, true>(F.lds, P, E); if (ch == 0) REPBAR(11, r); }
        }
        STAMP(13);
        SEAM(10 + 3 * ch);
        if (IN(11 + 3 * ch)) { for (int r = 0; r < (ch == 0 ? REPS(12) : 1); ++r) { p13_combine_ln2(F, ch, ch == 0 && r + 1 < REPS(12)); if (ch == 0) REPBAR(12, r); } }
        STAMP(14);
        SEAM(11 + 3 * ch);
    }
#ifdef DBG_K
    xcd_barrier(bar);
    {
        const unsigned char* buf = (DBG_OUT) ? (const unsigned char*)F.out : (const unsigned char*)(ws + (size_t)(DBG_OFF));
        const size_t wpr = (size_t)(DBG_CW) / 4, nw = (size_t)(DBG_ROWS) * wpr;
        unsigned long long cs = 0; unsigned bad = 0;
        for (size_t i = (size_t)F.c * NTHR + F.tid; i < nw; i += (size_t)F.G * NTHR) { const size_t r = i / wpr, cw = i % wpr; const unsigned w = *(const unsigned*)(buf + r * (size_t)(DBG_LD) + (DBG_C0) + cw * 4); cs += w;
            if (DBG_F32) { if ((w & 0x7f800000u) == 0x7f800000u) ++bad; } else { if ((w & 0x7f80u) == 0x7f80u) ++bad; if ((w & 0x7f800000u) == 0x7f800000u) ++bad; } }
        for (int o = 32; o >= 1; o >>= 1) { cs += __shfl_xor(cs, o); bad += __shfl_xor(bad, o); }
        if (F.lane == 0) { atomicAdd((unsigned long long*)(F.ctl + 8192), cs); atomicAdd(F.ctl + 8200, bad); }
        if (F.c == 0 && F.tid == 0) atomicAdd(F.ctl + 8201, xb_ld(&F.ctl[XB_TMO]));
    }
    xcd_barrier(bar);
    {
        const unsigned long long cs = __hip_atomic_load((unsigned long long*)(F.ctl + 8192), __ATOMIC_RELAXED, __HIP_MEMORY_SCOPE_AGENT);
        const unsigned bad = xb_ld(F.ctl + 8200), tmo = xb_ld(F.ctl + 8201);
        const float val = (float)(unsigned)((cs ^ (cs >> 16) ^ (cs >> 32)) & 0xFFFFu) * (1.0f / 65536.0f) + (bad ? 2.0f : 0.0f) + (tmo ? 4.0f : 0.0f);
        for (size_t i = (size_t)F.c * NTHR + F.tid; i < (size_t)T * D; i += (size_t)F.G * NTHR) F.out[i] = val;
    }
    return;
#endif
#ifdef PR_A
    xcd_barrier(bar);
    {
        auto maxs = [&](int sl) { unsigned long long m = 0; for (int w = 0; w < (int)F.G; ++w) { const unsigned long long v = stamps[sl * 256 + w]; m = v > m ? v : m; } return m; };
        auto dur = [&](int sl) -> float {
            if (sl == 4) { const unsigned long long st = maxs(3); double a = 0; for (int w = 0; w < (int)F.G; ++w) a += (double)(stamps[4 * 256 + w] - st); return (float)(a / F.G) * 0.01f; }
            if (sl == 5) { double a = 0; for (int w = 0; w < (int)F.G; ++w) a += (double)(stamps[5 * 256 + w] - stamps[4 * 256 + w]); return (float)(a / F.G) * 0.01f; }
            if (sl == 6) { double a = 0; for (int w = 0; w < (int)F.G; ++w) a += (double)(stamps[6 * 256 + w] - stamps[5 * 256 + w]); return (float)(a / F.G) * 0.01f; }
            if (sl == 16) return (float)(maxs(6) - maxs(3)) * 0.01f;
            return (float)(maxs(sl) - maxs(sl - 1)) * 0.01f; };
        const float va = rintf(dur(PR_A) * 0.1f + (PR_OFF)) * 0.1f, vb = rintf(dur(PR_B) * 0.1f + (PR_OFF)) * 10.0f;
        for (size_t i = (size_t)F.c * NTHR + F.tid; i < (size_t)T * D; i += (size_t)F.G * NTHR) F.out[i] = va;
        __syncthreads();
        if (F.c == 0 && F.tid == 0) F.out[12345] = vb;
    }
    return;
#endif
    if (F.c == 0 && F.tid == 0 && hi == N_PHASES) { if (xb_ld(&F.ctl[XB_TMO]) != 0u) F.out[0] = __builtin_nanf(""); }
#undef IN
#undef SEAM
}

extern "C" void kernel_launch(void* const* d_in, const int* in_sizes, int n_in, void* d_out, int out_size, void* d_ws, size_t ws_size, hipStream_t stream) {
    static int grid = 0;
    if (grid == 0) {
        if (n_in != 22 || out_size != T * D || ws_size < WS_END) { fprintf(stderr, "kernel_launch: unexpected shapes (n_in %d, out %d, ws %zu)\n", n_in, out_size, ws_size); grid = -1; return; }
        int dev = 0, cus = 0, per_cu = 0;
        if (hipGetDevice(&dev) != hipSuccess || hipDeviceGetAttribute(&cus, hipDeviceAttributeMultiprocessorCount, dev) != hipSuccess) { grid = -1; return; }
        if (hipFuncSetAttribute((const void*)mega_fwd, hipFuncAttributeMaxDynamicSharedMemorySize, LDS_BYTES) != hipSuccess) { fprintf(stderr, "kernel_launch: hipFuncSetAttribute failed\n"); grid = -1; return; }
        if (hipOccupancyMaxActiveBlocksPerMultiprocessor(&per_cu, (const void*)mega_fwd, NTHR, LDS_BYTES) != hipSuccess || per_cu < 1) fprintf(stderr, "kernel_launch: occupancy query reports %d blocks per CU\n", per_cu);
        (void)hipGetLastError();
        grid = cus;
    }
    if (grid < 0) return;
    (void)hipMemsetAsync((char*)d_ws + WS_CTL, 0, CTL_BYTES, stream);
    Args a{};
    for (int i = 0; i < 22; ++i) a.in[i] = (const float*)d_in[i];
    a.out = (float*)d_out; a.ws = (unsigned char*)d_ws; a.ph_lo = 0; a.ph_hi = N_PHASES;
#ifdef DBG_K
    a.ph_hi = DBG_K;
#endif
    hipLaunchKernelGGL(mega_fwd, dim3(grid), dim3(NTHR), LDS_BYTES, stream, a);
}
```

```cpp
#include <hip/hip_runtime.h>
#include <cstdio>
#include <cstdint>

#define LAS __attribute__((address_space(3)))
typedef unsigned short bf16_t;
typedef short bf16x8 __attribute__((ext_vector_type(8)));
typedef short bf16x4 __attribute__((ext_vector_type(4)));
typedef float f32x4 __attribute__((ext_vector_type(4)));
typedef float f32x2 __attribute__((ext_vector_type(2)));
typedef unsigned u32x4 __attribute__((ext_vector_type(4)));
typedef unsigned u32x2 __attribute__((ext_vector_type(2)));

constexpr int D = 1024, NB = 32, SEQ = 2048, T = NB * SEQ, CTX = 256, TCX = NB * CTX;
#ifndef NCH_SET
#define NCH_SET 1
#endif
constexpr int NEXP = 32, TOPK = 4;
constexpr int NCH = NCH_SET, TCH = T / NCH;
constexpr int ROWS_CH = TCH * TOPK + NEXP * 256;
constexpr float DN_ALPHA = 1.189207115002721f;
constexpr float LN_EPS = 1e-5f, RMS_EPS = 1e-6f;
constexpr int NTHR = 512;

constexpr size_t MiB = 1ull << 20;
constexpr size_t WS_CTL = 0;
constexpr size_t CTL_BYTES = 65536;
constexpr size_t WS_ADA = 65536;
constexpr size_t WS_WIN1T = 1 * MiB;
constexpr size_t WS_WIN2T = 7 * MiB;
constexpr size_t WS_WMT = 12 * MiB;
constexpr size_t WS_WOT = 14 * MiB;
constexpr size_t WS_WGUT = 16 * MiB;
constexpr size_t WS_WDNT = 80 * MiB;
constexpr size_t WS_TOPI = 112 * MiB;
constexpr size_t WS_TOPW = 113 * MiB;
constexpr size_t WS_POS = 114 * MiB;
constexpr size_t WS_ROWTOK = 115 * MiB;
constexpr size_t WS_U = 120 * MiB;
constexpr size_t WS_PA = 184 * MiB;
constexpr size_t WS_PH = 312 * MiB;
constexpr size_t WS_PHC = 568 * MiB;
constexpr size_t WS_PG = 600 * MiB;
constexpr size_t WS_Y = 664 * MiB;
constexpr size_t WS_UC = WS_Y;
constexpr size_t WS_ACT = WS_PA;
constexpr size_t WS_YCH = WS_PA + 264 * MiB;
constexpr size_t WS_X1 = WS_YCH + 264 * MiB;
constexpr size_t WS_END = 976 * MiB;
static_assert(WS_X1 + 128 * MiB <= WS_END && (size_t)ROWS_CH * 1024 <= 264 * MiB && WS_Y + 128 * MiB <= WS_END, "ws map");
constexpr int CW_CNT = 4096;
constexpr int CW_CUR = 4096 + 64;

constexpr int LDS_SCRATCH = 155648;
constexpr int LDS_MISC = LDS_SCRATCH;
constexpr int LDS_BYTES = LDS_SCRATCH + 2048;

typedef __bf16 bf16x2_t __attribute__((ext_vector_type(2)));
__device__ __forceinline__ unsigned cvt_pk_bf16(float lo, float hi) { const f32x2 v = {lo, hi}; const bf16x2_t r = __builtin_convertvector(v, bf16x2_t); return __builtin_bit_cast(unsigned, r); }
__device__ __forceinline__ unsigned cvt_pk4_fp8(float a, float b, float c, float d) {
    a = fminf(fmaxf(a, -448.f), 448.f); b = fminf(fmaxf(b, -448.f), 448.f); c = fminf(fmaxf(c, -448.f), 448.f); d = fminf(fmaxf(d, -448.f), 448.f);
    int w = __builtin_amdgcn_cvt_pk_fp8_f32(a, b, 0, false); w = __builtin_amdgcn_cvt_pk_fp8_f32(c, d, w, true); return (unsigned)w; }
constexpr float W8_SCALE = 32.0f, W8_INV = 1.0f / 32.0f;
typedef float f32x2v __attribute__((ext_vector_type(2)));
__device__ __forceinline__ f32x4 fp8x4_to_f32(unsigned w) { const f32x2v a = __builtin_amdgcn_cvt_pk_f32_fp8((int)w, false), b = __builtin_amdgcn_cvt_pk_f32_fp8((int)w, true); return (f32x4){a[0], a[1], b[0], b[1]}; }
__device__ __forceinline__ u32x4 widen16(u32x2 a, u32x2 b) {
    const u32x2 rx = __builtin_amdgcn_permlane16_swap(a.x, b.x, false, false), ry = __builtin_amdgcn_permlane16_swap(a.y, b.y, false, false);
    return (u32x4){rx[0], ry[0], rx[1], ry[1]}; }
__device__ __forceinline__ void unwiden16(u32x4 L, u32x2& a, u32x2& b) {
    const u32x2 rx = __builtin_amdgcn_permlane16_swap(L.x, L.z, false, false), ry = __builtin_amdgcn_permlane16_swap(L.y, L.w, false, false);
    a = (u32x2){rx[0], ry[0]}; b = (u32x2){rx[1], ry[1]}; }
__device__ __forceinline__ unsigned pack4_u8(float a, float b, float c, float d) {
    unsigned w = __builtin_amdgcn_cvt_pk_u8_f32(__builtin_rintf(a), 0, 0u); w = __builtin_amdgcn_cvt_pk_u8_f32(__builtin_rintf(b), 1, w);
    w = __builtin_amdgcn_cvt_pk_u8_f32(__builtin_rintf(c), 2, w); return __builtin_amdgcn_cvt_pk_u8_f32(__builtin_rintf(d), 3, w); }
__device__ __forceinline__ f32x4 u8x4_to_f32(unsigned w) { return (f32x4){(float)(w & 0xffu), (float)((w >> 8) & 0xffu), (float)((w >> 16) & 0xffu), (float)(w >> 24)}; }
__device__ __forceinline__ float bf_lo(unsigned w) { return __uint_as_float(w << 16); }
__device__ __forceinline__ float bf_hi(unsigned w) { return __uint_as_float(w & 0xffff0000u); }
__device__ __forceinline__ float bf2f(bf16_t v) { return __uint_as_float(((unsigned)v) << 16); }
__device__ __forceinline__ float fast_exp(float x) { return __builtin_amdgcn_exp2f(x * 1.4426950408889634f); }
__device__ __forceinline__ float fast_sigmoid(float x) { return __builtin_amdgcn_rcpf(1.0f + fast_exp(-x)); }
__device__ __forceinline__ float fast_log(float x) { return __builtin_amdgcn_logf(x) * 0.6931471805599453f; }

#define XB_TMO      128
#define XB_XCNT(j)  (256  + 64 * (j))
#define XB_XSUB(j)  (1280 + 64 * (j))
#define XB_XGEN(j)  (2304 + 64 * (j))
#define XB_TOP      3328
#define XB_TOPGEN   3392
#define XCD_BAR_WORDS 3456
#define XB_SPIN_CAP (1u << 18)

__device__ __forceinline__ unsigned xb_ld(unsigned* p)              { return __hip_atomic_load(p, __ATOMIC_RELAXED, __HIP_MEMORY_SCOPE_AGENT); }
__device__ __forceinline__ unsigned xb_add(unsigned* p, unsigned v) { return __hip_atomic_fetch_add(p, v, __ATOMIC_RELAXED, __HIP_MEMORY_SCOPE_AGENT); }
__device__ __forceinline__ unsigned xb_xcc_id() { return (unsigned)__builtin_amdgcn_s_getreg((3 << 11) | 20) & 0xFu; }
#define XB_SPIN(cond, bar) do { unsigned _sp = 0; while (cond) { __builtin_amdgcn_s_sleep(1); \
    if ((++_sp & 255u) == 0u) { if (xb_ld(&(bar)[XB_TMO])) break; if (_sp > XB_SPIN_CAP) { atomicAdd(&(bar)[XB_TMO], 1u); break; } } } } while (0)

struct XcdBarrier { unsigned* bar; unsigned x; volatile LAS unsigned* st; };

__device__ __forceinline__ XcdBarrier xcd_barrier_post(unsigned* bar, volatile LAS unsigned* st) {
    XcdBarrier b; b.bar = bar; b.x = xb_xcc_id(); b.st = st;
    if (threadIdx.x == 0) (void)xb_add(&bar[XB_XCNT(b.x)], 1u);
    return b;
}
__device__ __forceinline__ void xcd_barrier_complete(unsigned* bar, unsigned x, unsigned& nloc, unsigned& nx) {
    const unsigned G = gridDim.x * gridDim.y * gridDim.z;
    unsigned sum, cnt, mine, sp = 0u;
    for (;;) {
        sum = 0u; cnt = 0u; mine = 0u;
#pragma unroll
        for (unsigned j = 0; j < 16; ++j) { const unsigned c = xb_ld(&bar[XB_XCNT(j)]); sum += c; cnt += (c > 0u) ? 1u : 0u; mine = (j == x) ? c : mine; }
        if (sum == G) break;
        __builtin_amdgcn_s_sleep(1);
        if ((++sp & 255u) == 0u) { if (xb_ld(&bar[XB_TMO])) break; if (sp > XB_SPIN_CAP) { atomicAdd(&bar[XB_TMO], 1u); break; } }
    }
    nloc = mine > 0u ? mine : 1u; nx = cnt > 0u ? cnt : 1u;
}
__device__ __forceinline__ void xcd_barrier(const XcdBarrier& b) {
    asm volatile("s_waitcnt vmcnt(0)" ::: "memory");
    __syncthreads();
    if (threadIdx.x == 0) {
        unsigned* bar = b.bar;
        __builtin_amdgcn_s_waitcnt(0);
        unsigned nloc = b.st[0], nx = b.st[1];
        if (nloc == 0u) { xcd_barrier_complete(bar, b.x, nloc, nx); b.st[0] = nloc; b.st[1] = nx; }
        const unsigned old = xb_add(&bar[XB_XSUB(b.x)], 1u);
        const unsigned gen = old / nloc;
        if (old + 1u == (gen + 1u) * nloc) {
            __builtin_amdgcn_fence(__ATOMIC_RELEASE, "agent");
            asm volatile("s_waitcnt vmcnt(0)" ::: "memory");
            const unsigned og = xb_add(&bar[XB_TOP], 1u);
            const unsigned tg = og / nx;
            if (og + 1u == (tg + 1u) * nx) xb_add(&bar[XB_TOPGEN], 1u);
            else XB_SPIN(xb_ld(&bar[XB_TOPGEN]) == tg, bar);
            __builtin_amdgcn_fence(__ATOMIC_ACQUIRE, "agent");
            xb_add(&bar[XB_XGEN(b.x)], 1u);
            asm volatile("s_waitcnt vmcnt(0)" ::: "memory");
        } else {
            XB_SPIN(xb_ld(&bar[XB_XGEN(b.x)]) == gen, bar);
            __builtin_amdgcn_fence(__ATOMIC_ACQUIRE, "agent");
            asm volatile("s_waitcnt vmcnt(0)" ::: "memory");
        }
    }
    __syncthreads();
}

#ifndef WGM_SET
#define WGM_SET 8
#endif
namespace pg8 {
constexpr int BM = 256, BK = 64, HALF = 128, HTB = HALF * BK * 2, STAGE_BYTES = 8 * HTB, NXCD = 8, WGM = WGM_SET;
__host__ __device__ __forceinline__ int lds_byte(int r, int c) { const int st = (r >> 4) * 2 + (c >> 5), rr = r & 15, cc = c & 31, ob = rr * 64 + cc * 2; return st * 1024 + (ob ^ (((ob >> 9) & 1) << 5)); }
__host__ __device__ __forceinline__ void stage_rc(int b, int& R, int& C) { const int st = b / 1024, sb = b % 1024, swz = sb ^ (((sb >> 9) & 1) << 5); R = (st >> 1) * 16 + swz / 64; C = (st & 1) * 32 + (swz % 64) / 2; }
__host__ __device__ __forceinline__ int perm32(int rho) { const int n = rho >> 4, i = rho & 15; return 8 * (i >> 2) + 4 * n + (i & 3); }

struct Unit { int pm, pn, aux; };

__device__ __forceinline__ void grouped(int wgid, int nM, int nN, int& pm, int& pn) {
    const int nig = WGM * nN, gid = wgid / nig, fm = gid * WGM, gsz = (nM - fm) < WGM ? (nM - fm) : WGM;
    pm = fm + ((wgid % nig) % gsz); pn = (wgid % nig) / gsz;
}
__device__ __forceinline__ bool xcd_remap(int i, int G, int c, int nwg, int& wgid) {
    const long L = (long)i * G + c; if (L >= nwg) return false;
    wgid = (int)L; const int q = nwg / NXCD, r = nwg % NXCD, xcd = wgid % NXCD, off = wgid / NXCD;
    wgid = (xcd < r ? xcd * (q + 1) : r * (q + 1) + (xcd - r) * q) + off; return true;
}

typedef int i32x8 __attribute__((ext_vector_type(8)));
typedef int i32x4 __attribute__((ext_vector_type(4)));
template <bool F8> struct Frags;
template <> struct Frags<false> { bf16x8 a[4][2], b0[2][2], b1[2][2]; };
template <> struct Frags<true> { i32x8 a[4], b0[2], b1[2]; };
template <class Prob, class Epi, bool ALIGN_EPI, bool HOOK, bool FP8 = false, int DRY = 0>
__device__ __forceinline__ void gemm_phase(LAS unsigned char* lds, const Prob& P, const Epi& E) {
    int tid_ = threadIdx.x; asm volatile("" : "+v"(tid_));
    const int tid = tid_, wid = __builtin_amdgcn_readfirstlane(tid >> 6), lane = tid & 63, wr = wid >> 2, wc = wid & 3, fr = lane & 15, fq = lane >> 4;
    const int nt = P.nt;
    unsigned voffB[2], voffA[2];
#pragma unroll
    for (int i = 0; i < 2; ++i) { int R, C; stage_rc(tid * 16 + i * 8192, R, C); const int Rb = Epi::PERM ? ((R & ~31) + perm32(R & 31)) : R;
        voffB[i] = (unsigned)Rb * P.ldb2 + (unsigned)C * 2u; voffA[i] = (unsigned)R * P.lda2 + (unsigned)C * 2u; }
    auto gather_offs = [&](const Unit& u, unsigned (&o0)[2], unsigned (&o1)[2]) {
#pragma unroll
        for (int i = 0; i < 2; ++i) { int R, C; int tt = threadIdx.x; asm volatile("" : "+v"(tt)); stage_rc(tt * 16 + i * 8192, R, C); o0[i] = P.a_row(u, R) + (unsigned)C * 2u; o1[i] = P.a_row(u, HALF + R) + (unsigned)C * 2u; } };
    const size_t kstep = (size_t)(BK * 2);
    const size_t hstepB = (size_t)HALF * P.ldb2;
    const size_t hstepA = (size_t)HALF * P.lda2;
    const unsigned ldsw = (unsigned)wid * 1024u;
    const int aoff = lds_byte(wr * 64 + fr, fq * 8), boff = lds_byte(wc * 32 + fr, fq * 8);
#define PG8_SA(b, h) (((b) * 2 + (h)) * HTB)
#define PG8_SB(b, h) ((4 + (b) * 2 + (h)) * HTB)
#define PG8_STAGE(bufoff, gbase, voff) do { if constexpr ((DRY & 2) == 0) _Pragma("unroll") for (int _i = 0; _i < 2; ++_i) \
        __builtin_amdgcn_global_load_lds((const unsigned*)((const char*)(gbase) + (voff)[_i]), (LAS unsigned*)(lds + (bufoff) + ldsw + _i * 8192), 16, 0, 0); } while (0)
#define PG8_LDA(dst, b, h) do { if constexpr (FP8) { _Pragma("unroll") for (int m = 0; m < 4; ++m) { FR.a[m].lo = *(const LAS i32x4*)(lds + PG8_SA(b, h) + aoff + m * 2048); FR.a[m].hi = *(const LAS i32x4*)(lds + PG8_SA(b, h) + aoff + m * 2048 + 1024); } } \
        else { _Pragma("unroll") for (int m = 0; m < 4; ++m) _Pragma("unroll") for (int k = 0; k < 2; ++k) FR.a[m][k] = *(const LAS bf16x8*)(lds + PG8_SA(b, h) + aoff + m * 2048 + k * 1024); } } while (0)
#define PG8_LDB(dst, b, h) do { if constexpr (FP8) { _Pragma("unroll") for (int n = 0; n < 2; ++n) { FR.dst[n].lo = *(const LAS i32x4*)(lds + PG8_SB(b, h) + boff + n * 2048); FR.dst[n].hi = *(const LAS i32x4*)(lds + PG8_SB(b, h) + boff + n * 2048 + 1024); } } \
        else { _Pragma("unroll") for (int n = 0; n < 2; ++n) _Pragma("unroll") for (int k = 0; k < 2; ++k) FR.dst[n][k] = *(const LAS bf16x8*)(lds + PG8_SB(b, h) + boff + n * 2048 + k * 1024); } } while (0)
#define PG8_MMA(ai, bj, At, Bt) do { __builtin_amdgcn_s_setprio(1); if constexpr ((DRY & 1) != 0) { asm volatile("" :: "v"(FR.a[0]), "v"(FR.a[3]), "v"(FR.Bt[0]), "v"(FR.Bt[1])); } else if constexpr (FP8) { _Pragma("unroll") for (int m = 0; m < 4; ++m) _Pragma("unroll") for (int n = 0; n < 2; ++n) \
            asm volatile("v_mfma_f32_16x16x128_f8f6f4 %0, %1, %2, %0" : "+v"(acc[ai][bj][m][n]) : "v"(FR.Bt[n]), "v"(FR.a[m])); } \
        else { _Pragma("unroll") for (int m = 0; m < 4; ++m) _Pragma("unroll") for (int n = 0; n < 2; ++n) _Pragma("unroll") for (int k = 0; k < 2; ++k) \
        acc[ai][bj][m][n] = __builtin_amdgcn_mfma_f32_16x16x32_bf16(FR.Bt[n][k], FR.a[m][k], acc[ai][bj][m][n], 0, 0, 0); } __builtin_amdgcn_s_setprio(0); } while (0)
#define PG8_WAIT_V(n) asm volatile("s_waitcnt vmcnt(" #n ")" ::: "memory")
#define PG8_WAIT_L(n) asm volatile("s_waitcnt lgkmcnt(" #n ")" ::: "memory")
#define PG8_BAR __builtin_amdgcn_s_barrier()
#define PG8_SCHED __builtin_amdgcn_sched_barrier(0)
    Unit cur, nxt; int ui = 0;
    if (!P.unit(0, cur)) return;
    f32x4 acc[2][2][4][2];
#pragma unroll
    for (int a = 0; a < 2; ++a)
#pragma unroll
        for (int b = 0; b < 2; ++b)
#pragma unroll
            for (int m = 0; m < 4; ++m)
#pragma unroll
                for (int n = 0; n < 2; ++n) acc[a][b][m][n] = (f32x4){0.f, 0.f, 0.f, 0.f};
    Frags<FP8> FR;
    unsigned va0[2], va1[2], vn0[2], vn1[2];
    const char* const gA = P.Abase; const char* cA = gA; const char* nA = gA; const char* cB = P.b_tile(cur);
    if constexpr (Prob::GATHER) {
        gather_offs(cur, va0, va1);
    } else { cA = gA + P.a_row(cur, 0); }
#define PG8_STAGE_A(bufoff, h, koff, nx) do { if constexpr (Prob::GATHER) { unsigned _v[2]; _Pragma("unroll") for (int _i = 0; _i < 2; ++_i) _v[_i] = (nx) ? ((h) ? vn1[_i] : vn0[_i]) : ((h) ? va1[_i] : va0[_i]); PG8_STAGE(bufoff, gA + (koff), _v); } \
        else { PG8_STAGE(bufoff, ((nx) ? nA : cA) + (h) * hstepA + (koff), voffA); } } while (0)
    PG8_STAGE(PG8_SB(0, 0), cB, voffB); PG8_STAGE(PG8_SB(0, 1), cB + hstepB, voffB); PG8_STAGE_A(PG8_SA(0, 0), 0, 0, false); PG8_STAGE_A(PG8_SA(0, 1), 1, 0, false);
    if (wr == 1) PG8_BAR;
    PG8_WAIT_V(2); PG8_BAR;
    PG8_STAGE(PG8_SB(1, 0), cB + kstep, voffB); PG8_STAGE_A(PG8_SA(1, 0), 0, kstep, false); PG8_STAGE(PG8_SB(1, 1), cB + hstepB + kstep, voffB);
    PG8_WAIT_V(6); PG8_BAR;
    Unit nx2; unsigned vq0[2], vq1[2]; bool has_next = P.unit(1, nxt);
    if (!has_next) nxt = cur;
    if constexpr (Prob::GATHER) gather_offs(nxt, vn0, vn1);
    for (;;) {
        if constexpr (!Prob::GATHER) { has_next = P.unit(ui + 1, nxt); if (!has_next) nxt = cur; nA = gA + P.a_row(nxt, 0); }
        const char* nB = P.b_tile(nxt);
        for (int t = 0; t < nt; t += 2) {
            const bool last = (t == nt - 2);
            if constexpr (HOOK) { if (t == (nt >> 1)) { if constexpr (FP8) asm volatile("s_nop 15\n\ts_nop 15" ::: "memory"); E.mid(acc, cur, wr, wc, fr, fq); } }
            const size_t k1 = (size_t)(t + 1) * kstep, k2 = last ? 0 : (size_t)(t + 2) * kstep, k3 = k2 + kstep;
            const char* b2 = last ? nB : cB + (size_t)(t + 2) * kstep; const char* b3 = b2 + kstep;
            PG8_LDB(b0, 0, 0); PG8_LDB(b1, 0, 1); PG8_SCHED; PG8_LDA(At, 0, 0); PG8_STAGE_A(PG8_SA(1, 1), 1, k1, false);
            PG8_WAIT_V(8); PG8_WAIT_L(0); PG8_BAR; PG8_MMA(0, 0, At, b0); PG8_MMA(0, 1, At, b1); PG8_BAR; PG8_SCHED;
            PG8_LDA(At, 0, 1); PG8_STAGE(PG8_SB(0, 0), b2, voffB); PG8_STAGE(PG8_SB(0, 1), b2 + hstepB, voffB); PG8_STAGE_A(PG8_SA(0, 0), 0, k2, last);
            PG8_WAIT_V(8); PG8_WAIT_L(0); PG8_BAR; PG8_MMA(1, 0, At, b0); PG8_MMA(1, 1, At, b1); PG8_BAR; PG8_SCHED;
            PG8_LDB(b0, 1, 0); PG8_LDB(b1, 1, 1); PG8_SCHED; PG8_LDA(At, 1, 0); PG8_STAGE_A(PG8_SA(0, 1), 1, k2, last);
            PG8_WAIT_V(8); PG8_WAIT_L(0); PG8_BAR; PG8_MMA(0, 0, At, b0); PG8_MMA(0, 1, At, b1); PG8_BAR; PG8_SCHED;
            PG8_LDA(At, 1, 1); PG8_STAGE(PG8_SB(1, 0), b3, voffB); PG8_STAGE(PG8_SB(1, 1), b3 + hstepB, voffB); PG8_STAGE_A(PG8_SA(1, 0), 0, k3, last);
            PG8_WAIT_V(8); PG8_WAIT_L(0); PG8_BAR; PG8_MMA(1, 0, At, b0); PG8_MMA(1, 1, At, b1); PG8_BAR; PG8_SCHED;
        }
        if constexpr (ALIGN_EPI) { if (wr == 0) PG8_BAR; }
        bool has_next2 = false;
        if constexpr (Prob::GATHER) { has_next2 = has_next && P.unit(ui + 2, nx2); if (!has_next2) nx2 = nxt; gather_offs(nx2, vq0, vq1); }
        if constexpr (FP8) asm volatile("s_nop 15\n\ts_nop 15" ::: "memory");
        if constexpr (DRY == 0) E(acc, cur, wr, wc, fr, fq); else { if (acc[0][0][0][0][0] == 1.2345e30f) *(volatile int*)P.Abase = 1; }
        if (!has_next) break;
#pragma unroll
        for (int a = 0; a < 2; ++a)
#pragma unroll
            for (int b = 0; b < 2; ++b)
#pragma unroll
                for (int m = 0; m < 4; ++m)
#pragma unroll
                    for (int n = 0; n < 2; ++n) acc[a][b][m][n] = (f32x4){0.f, 0.f, 0.f, 0.f};
        cur = nxt; cB = nB; cA = nA; ++ui;
        if constexpr (Prob::GATHER) {
#pragma unroll
            for (int i = 0; i < 2; ++i) { va0[i] = vn0[i]; va1[i] = vn1[i]; vn0[i] = vq0[i]; vn1[i] = vq1[i]; }
            nxt = nx2; has_next = has_next2; }
        if constexpr (ALIGN_EPI) { if (wr == 1) PG8_BAR; }
    }
    PG8_WAIT_V(0);
    if constexpr (!ALIGN_EPI) { if (wr == 0) PG8_BAR; }
    PG8_BAR;
#undef PG8_SA
#undef PG8_SB
#undef PG8_STAGE
#undef PG8_STAGE_A
#undef PG8_LDA
#undef PG8_LDB
#undef PG8_MMA
#undef PG8_WAIT_V
#undef PG8_WAIT_L
#undef PG8_BAR
#undef PG8_SCHED
}
}

using pg8::Unit;

struct ProbDense {
    static constexpr bool GATHER = false;
    const char* Abase; int nt; unsigned ldb2; unsigned lda2; const char* Bt; int nM, nN, G, c; int rev;
    __device__ __forceinline__ bool unit(int i, Unit& u) const { int w; if (!pg8::xcd_remap(i, G, c, nM * nN, w)) return false; pg8::grouped(w, nM, nN, u.pm, u.pn); if (rev) u.pm = nM - 1 - u.pm; u.aux = 0; return true; }
    __device__ __forceinline__ unsigned a_row(const Unit& u, int r) const { return (unsigned)(u.pm * 256 + r) * lda2; }
    __device__ __forceinline__ const char* b_tile(const Unit& u) const { return Bt + (size_t)u.pn * 256 * ldb2; }
};
struct ProbP1 {
    static constexpr bool GATHER = false;
    const char* Abase; int nt; unsigned ldb2; unsigned lda2; const char* Bt; unsigned uc_off; int G, c;
    __device__ __forceinline__ bool unit(int i, Unit& u) const {
        int w; if (!pg8::xcd_remap(i, G, c, 3072 + 256, w)) return false;
        if (w < 3072) { pg8::grouped(w, 256, 12, u.pm, u.pn); u.pm = 255 - u.pm; u.aux = 0; }
        else { pg8::grouped(w - 3072, 32, 8, u.pm, u.pn); u.pn += 4; u.aux = 1; }
        return true; }
    __device__ __forceinline__ unsigned a_row(const Unit& u, int r) const { return (u.aux ? uc_off : 0u) + (unsigned)(u.pm * 256 + r) * lda2; }
    __device__ __forceinline__ const char* b_tile(const Unit& u) const { return Bt + (size_t)u.pn * 256 * ldb2; }
};
template <bool GATHER_> struct ProbMoE {
    static constexpr bool GATHER = GATHER_;
    const char* Abase; int nt; unsigned ldb2; unsigned lda2; const char* Bt; size_t estride; int nN, nblk, G, c; const int* rowtok; const LAS unsigned char* blk_e;
    __device__ __forceinline__ bool unit(int i, Unit& u) const { int w; if (!pg8::xcd_remap(i, G, c, nblk * nN, w)) return false; pg8::grouped(w, nblk, nN, u.pm, u.pn); if (!GATHER) u.pm = nblk - 1 - u.pm;
        u.aux = (int)blk_e[u.pm]; return true; }
    __device__ __forceinline__ unsigned a_row(const Unit& u, int r) const { if (GATHER) return (unsigned)rowtok[u.pm * 256 + r] * lda2; else return (unsigned)(u.pm * 256 + r) * lda2; }
    __device__ __forceinline__ const char* b_tile(const Unit& u) const { return Bt + (size_t)u.aux * estride + (size_t)u.pn * 256 * ldb2; }
};

struct EpiP1 {
    static constexpr bool PERM = true;
    bf16_t* PA; bf16_t* PH; bf16_t* PHC;
    __device__ __forceinline__ void operator()(const f32x4 (&acc)[2][2][4][2], const Unit& u, int wr, int wc, int fr, int fq) const {
        const int row0 = u.pm * 256 + wr * 64 + fr;
        if (!u.aux && u.pn < 4) {
            unsigned char* PA8 = (unsigned char*)PA;
#pragma unroll
            for (int ai = 0; ai < 2; ++ai)
#pragma unroll
                for (int bj = 0; bj < 2; ++bj) { u32x2 pk[4];
#pragma unroll
                    for (int m = 0; m < 4; ++m) { const f32x4 v0 = acc[ai][bj][m][0] * W8_INV, v1 = acc[ai][bj][m][1] * W8_INV;
                        pk[m] = (u32x2){cvt_pk4_fp8(v0[0], v0[1], v0[2], v0[3]), cvt_pk4_fp8(v1[0], v1[1], v1[2], v1[3])}; }
                    const int col = u.pn * 256 + bj * 128 + wc * 32 + (fq >> 1) * 16, reim = col >> 9, slab = (col & 511) >> 4;
#pragma unroll
                    for (int mp = 0; mp < 2; ++mp) { const int row = row0 + ai * 128 + (2 * mp + (fq & 1)) * 16, b = row >> 11, t = row & 2047;
                        *(u32x4*)(PA8 + ((((size_t)(b * 32 + slab) * 2048 + t) * 2 + reim) * 16)) = widen16(pk[2 * mp], pk[2 * mp + 1]); } }
            return;
        }
        bf16_t* base = u.aux ? PHC : PH; const int ldc = 2048, colt = (u.pn - 4) * 256;
        {
            const int kind = u.pn < 6 ? 0 : (u.pn < 8 ? 1 : (u.pn < 10 ? 2 : 3));
            const int reg = kind == 0 ? (u.pn - 4) * 256 : kind == 1 ? 512 + (u.pn - 6) * 256 : kind == 2 ? 3584 + (u.pn - 8) * 256 : 3072 + (u.pn - 10) * 256;
            unsigned char* b8 = (unsigned char*)base + reg + wc * 32 + (fq >> 1) * 16;
#pragma unroll
            for (int ai = 0; ai < 2; ++ai)
#pragma unroll
                for (int bj = 0; bj < 2; ++bj) { u32x2 pk[4];
#pragma unroll
                    for (int m = 0; m < 4; ++m) { f32x4 v0 = acc[ai][bj][m][0] * W8_INV, v1 = acc[ai][bj][m][1] * W8_INV;
                        if (kind == 0) {
#pragma unroll
                            for (int j = 0; j < 4; ++j) { v0[j] *= fast_sigmoid(v0[j]); v1[j] *= fast_sigmoid(v1[j]); } }
                        if (kind == 1 || kind == 2) {
#pragma unroll
                            for (int j = 0; j < 4; ++j) { v0[j] = fast_sigmoid(v0[j]) * 255.0f; v1[j] = fast_sigmoid(v1[j]) * 255.0f; }
                            pk[m] = (u32x2){pack4_u8(v0[0], v0[1], v0[2], v0[3]), pack4_u8(v1[0], v1[1], v1[2], v1[3])};
                        } else pk[m] = (u32x2){cvt_pk4_fp8(v0[0], v0[1], v0[2], v0[3]), cvt_pk4_fp8(v1[0], v1[1], v1[2], v1[3])}; }
#pragma unroll
                    for (int mp = 0; mp < 2; ++mp)
                        *(u32x4*)(b8 + (size_t)(row0 + ai * 128 + (2 * mp + (fq & 1)) * 16) * 4096 + bj * 128) = widen16(pk[2 * mp], pk[2 * mp + 1]); }
        }
    }
    __device__ __forceinline__ void mid(f32x4 (&)[2][2][4][2], const Unit&, int, int, int, int) const {}
};
struct EpiP2 {
    static constexpr bool PERM = true;
    unsigned char* PG; unsigned char* GATES;
    __device__ __forceinline__ void operator()(const f32x4 (&acc)[2][2][4][2], const Unit& u, int wr, int wc, int fr, int fq) const {
        const int row0 = u.pm * 256 + wr * 64 + fr;
        if (u.pn < 2) {
            const int colp = u.pn * 256 + wc * 32 + (fq >> 1) * 16;
#pragma unroll
            for (int ai = 0; ai < 2; ++ai)
#pragma unroll
                for (int bj = 0; bj < 2; ++bj) { u32x2 pk[4];
#pragma unroll
                    for (int m = 0; m < 4; ++m) { f32x4 v0 = acc[ai][bj][m][0] * W8_INV, v1 = acc[ai][bj][m][1] * W8_INV;
#pragma unroll
                        for (int j = 0; j < 4; ++j) { v0[j] *= fast_sigmoid(v0[j]); v1[j] *= fast_sigmoid(v1[j]); }
                        pk[m] = (u32x2){cvt_pk4_fp8(v0[0], v0[1], v0[2], v0[3]), cvt_pk4_fp8(v1[0], v1[1], v1[2], v1[3])}; }
#pragma unroll
                    for (int mp = 0; mp < 2; ++mp)
                        *(u32x4*)(PG + (size_t)(row0 + ai * 128 + (2 * mp + (fq & 1)) * 16) * 512 + colp + bj * 128) = widen16(pk[2 * mp], pk[2 * mp + 1]); }
            return;
        }
        const int colt = (u.pn - 2) * 256 + wc * 32 + (fq >> 1) * 16;
#pragma unroll
        for (int ai = 0; ai < 2; ++ai)
#pragma unroll
            for (int bj = 0; bj < 2; ++bj) { u32x2 pk[4];
#pragma unroll
                for (int m = 0; m < 4; ++m) { f32x4 v0 = acc[ai][bj][m][0] * W8_INV, v1 = acc[ai][bj][m][1] * W8_INV;
#pragma unroll
                    for (int j = 0; j < 4; ++j) { v0[j] = fmaxf(fast_sigmoid(v0[j]) * 255.0f, 1.0f); v1[j] = fmaxf(fast_sigmoid(v1[j]) * 255.0f, 1.0f); }
                    pk[m] = (u32x2){pack4_u8(v0[0], v0[1], v0[2], v0[3]), pack4_u8(v1[0], v1[1], v1[2], v1[3])}; }
#pragma unroll
                for (int mp = 0; mp < 2; ++mp)
                    *(u32x4*)(GATES + (size_t)(row0 + ai * 128 + (2 * mp + (fq & 1)) * 16) * 2048 + colt + bj * 128) = widen16(pk[2 * mp], pk[2 * mp + 1]); }
    }
    __device__ __forceinline__ void mid(f32x4 (&)[2][2][4][2], const Unit&, int, int, int, int) const {}
};
struct EpiM1 {
    static constexpr bool PERM = true;
    const unsigned char* GATES; unsigned char* Mo;
    __device__ __forceinline__ void mid(f32x4 (&acc)[2][2][4][2], const Unit& u, int wr, int wc, int fr, int fq) const {
        int row0 = u.pm * 256 + wr * 64 + fr + (fq & 1) * 16, col0 = u.pn * 256 + wc * 32 + (fq >> 1) * 16;
        asm volatile("" : "+v"(row0), "+v"(col0));
#pragma unroll
        for (int ai = 0; ai < 2; ++ai) {
            u32x4 gf[2][2], gh[2][2];
#pragma unroll
            for (int mp = 0; mp < 2; ++mp) { const unsigned char* gp = GATES + (size_t)(row0 + ai * 128 + mp * 32) * 2048 + col0;
#pragma unroll
                for (int bj = 0; bj < 2; ++bj) { gf[mp][bj] = *(const u32x4*)(gp + bj * 128); gh[mp][bj] = *(const u32x4*)(gp + 1024 + bj * 128); } }
#pragma unroll
            for (int mp = 0; mp < 2; ++mp)
#pragma unroll
                for (int bj = 0; bj < 2; ++bj) { u32x2 f2[2], h2[2]; unwiden16(gf[mp][bj], f2[0], f2[1]); unwiden16(gh[mp][bj], h2[0], h2[1]);
#pragma unroll
                    for (int q = 0; q < 2; ++q) { const int m = 2 * mp + q;
                        const f32x4 fa = u8x4_to_f32(f2[q].x), fb = u8x4_to_f32(f2[q].y), ha = u8x4_to_f32(h2[q].x), hb = u8x4_to_f32(h2[q].y);
#pragma unroll
                        for (int j = 0; j < 4; ++j) { acc[ai][bj][m][0][j] *= fa[j] * __builtin_amdgcn_rcpf(ha[j]); acc[ai][bj][m][1][j] *= fb[j] * __builtin_amdgcn_rcpf(hb[j]); } } }
            asm volatile("" ::: "memory");
        }
    }
    __device__ __forceinline__ void operator()(const f32x4 (&acc)[2][2][4][2], const Unit& u, int wr, int wc, int fr, int fq) const {
        const int row0 = u.pm * 256 + wr * 64 + fr, col0 = u.pn * 256 + wc * 32 + (fq >> 1) * 16;
        const float sc = W8_INV * (1.0f / 255.0f);
#pragma unroll
        for (int ai = 0; ai < 2; ++ai) {
            u32x4 gh[2][2];
#pragma unroll
            for (int mp = 0; mp < 2; ++mp) { const unsigned char* gp = GATES + (size_t)(row0 + ai * 128 + (2 * mp + (fq & 1)) * 16) * 2048 + 1024 + col0;
#pragma unroll
                for (int bj = 0; bj < 2; ++bj) gh[mp][bj] = *(const u32x4*)(gp + bj * 128); }
#pragma unroll
            for (int bj = 0; bj < 2; ++bj) { u32x2 pk[4];
#pragma unroll
                for (int mp = 0; mp < 2; ++mp) { u32x2 h2[2]; unwiden16(gh[mp][bj], h2[0], h2[1]);
#pragma unroll
                    for (int q = 0; q < 2; ++q) { const int m = 2 * mp + q; const f32x4 ha = u8x4_to_f32(h2[q].x) * sc, hb = u8x4_to_f32(h2[q].y) * sc;
                        const f32x4 v0 = acc[ai][bj][m][0] * ha, v1 = acc[ai][bj][m][1] * hb;
                        pk[m] = (u32x2){cvt_pk4_fp8(v0[0], v0[1], v0[2], v0[3]), cvt_pk4_fp8(v1[0], v1[1], v1[2], v1[3])}; } }
#pragma unroll
                for (int mp = 0; mp < 2; ++mp)
                    *(u32x4*)(Mo + (size_t)(row0 + ai * 128 + (2 * mp + (fq & 1)) * 16) * 1024 + col0 + bj * 128) = widen16(pk[2 * mp], pk[2 * mp + 1]); }
            asm volatile("" ::: "memory");
        }
    }
};
constexpr float V8_SCALE = 16.0f, V8_INV = 1.0f / 16.0f;
struct EpiM2 {
    static constexpr bool PERM = true;
    const float* ada; unsigned char* V;
    __device__ __forceinline__ void operator()(const f32x4 (&acc)[2][2][4][2], const Unit& u, int wr, int wc, int fr, int fq) const {
        const int row0 = u.pm * 256 + wr * 64 + fr, col0 = u.pn * 256 + wc * 32 + 8 * fq, colw = u.pn * 256 + wc * 32 + (fq >> 1) * 16;
        const float* g1 = ada + (size_t)(u.pm >> 3) * 6144 + 2048 + col0;
        f32x4 gv[2][2];
#pragma unroll
        for (int bj = 0; bj < 2; ++bj)
#pragma unroll
            for (int n = 0; n < 2; ++n) gv[bj][n] = *(const f32x4*)(g1 + bj * 128 + n * 4) * (W8_INV * V8_SCALE);
#pragma unroll
        for (int ai = 0; ai < 2; ++ai)
#pragma unroll
            for (int bj = 0; bj < 2; ++bj) { u32x2 pk[4];
#pragma unroll
                for (int m = 0; m < 4; ++m) { const f32x4 v0 = gv[bj][0] * acc[ai][bj][m][0], v1 = gv[bj][1] * acc[ai][bj][m][1];
                    pk[m] = (u32x2){cvt_pk4_fp8(v0[0], v0[1], v0[2], v0[3]), cvt_pk4_fp8(v1[0], v1[1], v1[2], v1[3])}; }
#pragma unroll
                for (int mp = 0; mp < 2; ++mp)
                    *(u32x4*)(V + (size_t)(row0 + ai * 128 + (2 * mp + (fq & 1)) * 16) * 1024 + colw + bj * 128) = widen16(pk[2 * mp], pk[2 * mp + 1]); }
    }
    __device__ __forceinline__ void mid(f32x4 (&)[2][2][4][2], const Unit&, int, int, int, int) const {}
};
struct EpiGU {
    static constexpr bool PERM = true;
    const float* bgu; unsigned char* ACT;
    __device__ __forceinline__ void operator()(const f32x4 (&acc)[2][2][4][2], const Unit& u, int wr, int wc, int fr, int fq) const {
        const int row0 = u.pm * 256 + wr * 64 + fr, col0 = u.pn * 128 + wc * 32 + 8 * fq;
        const float* bp = bgu + (size_t)u.aux * 2048 + col0;
        const f32x4 bg0 = *(const f32x4*)(bp), bg1 = *(const f32x4*)(bp + 4), bu0 = *(const f32x4*)(bp + 1024), bu1 = *(const f32x4*)(bp + 1028);
#pragma unroll
        for (int ai = 0; ai < 2; ++ai) { u32x2 pk[4];
#pragma unroll
            for (int m = 0; m < 4; ++m) {
                f32x4 g0 = acc[ai][0][m][0] * W8_INV + bg0, g1 = acc[ai][0][m][1] * W8_INV + bg1, p0 = acc[ai][1][m][0] * W8_INV + bu0, p1 = acc[ai][1][m][1] * W8_INV + bu1;
#pragma unroll
                for (int j = 0; j < 4; ++j) {
                    float g = fminf(g0[j], 7.0f), p = fminf(fmaxf(p0[j], -7.0f), 7.0f); g0[j] = (p + 1.0f) * g * fast_sigmoid(1.702f * g);
                    g = fminf(g1[j], 7.0f); p = fminf(fmaxf(p1[j], -7.0f), 7.0f); g1[j] = (p + 1.0f) * g * fast_sigmoid(1.702f * g); }
                pk[m] = (u32x2){cvt_pk4_fp8(g0[0], g0[1], g0[2], g0[3]), cvt_pk4_fp8(g1[0], g1[1], g1[2], g1[3])}; }
#pragma unroll
            for (int mp = 0; mp < 2; ++mp)
                *(u32x4*)(ACT + (size_t)(row0 + ai * 128 + (2 * mp + (fq & 1)) * 16) * 1024 + u.pn * 128 + wc * 32 + (fq >> 1) * 16) = widen16(pk[2 * mp], pk[2 * mp + 1]); }
    }
    __device__ __forceinline__ void mid(f32x4 (&)[2][2][4][2], const Unit&, int, int, int, int) const {}
};
struct EpiDN {
    static constexpr bool PERM = true;
    const float* bdn; unsigned char* Y;
    __device__ __forceinline__ void operator()(const f32x4 (&acc)[2][2][4][2], const Unit& u, int wr, int wc, int fr, int fq) const {
        const int row0 = u.pm * 256 + wr * 64 + fr, col0 = u.pn * 256 + wc * 32 + 8 * fq;
        const float* bp = bdn + (size_t)u.aux * 1024 + col0;
        f32x4 bv[2][2];
#pragma unroll
        for (int bj = 0; bj < 2; ++bj)
#pragma unroll
            for (int n = 0; n < 2; ++n) bv[bj][n] = *(const f32x4*)(bp + bj * 128 + 4 * n);
#pragma unroll
        for (int ai = 0; ai < 2; ++ai)
#pragma unroll
            for (int bj = 0; bj < 2; ++bj) { u32x2 pk[4];
#pragma unroll
                for (int m = 0; m < 4; ++m) { const f32x4 v0 = acc[ai][bj][m][0] * W8_INV + bv[bj][0], v1 = acc[ai][bj][m][1] * W8_INV + bv[bj][1];
                    pk[m] = (u32x2){cvt_pk4_fp8(v0[0], v0[1], v0[2], v0[3]), cvt_pk4_fp8(v1[0], v1[1], v1[2], v1[3])}; }
#pragma unroll
                for (int mp = 0; mp < 2; ++mp)
                    *(u32x4*)(Y + (size_t)(row0 + ai * 128 + (2 * mp + (fq & 1)) * 16) * 1024 + u.pn * 256 + bj * 128 + wc * 32 + (fq >> 1) * 16) = widen16(pk[2 * mp], pk[2 * mp + 1]); }
    }
    __device__ __forceinline__ void mid(f32x4 (&)[2][2][4][2], const Unit&, int, int, int, int) const {}
};

struct Frame {
    LAS unsigned char* lds; int tid, lane, wave, G, c;
    const float* const* in; float* out; unsigned char* ws; unsigned* ctl;
};
enum { I_X = 0, I_C, I_CTX, I_CCTX, I_WADA, I_BADA, I_WIN, I_LBRAW, I_HGG, I_WFO, I_WHO, I_WO, I_LN1G, I_LN1B, I_WR, I_BR, I_WGU, I_BGU, I_WDN, I_BDN, I_LN2G, I_LN2B };

__device__ __forceinline__ float wave_sum(float v) {
#pragma unroll
    for (int o = 32; o >= 1; o >>= 1) v += __shfl_xor(v, o);
    return v;
}

__device__ __forceinline__ Frame fresh(const Frame& F) { Frame G = F; int t = threadIdx.x; asm volatile("" : "+v"(t)); G.tid = t; G.lane = t & 63; G.wave = __builtin_amdgcn_readfirstlane(t >> 6); return G; }

__device__ __forceinline__ void p0_ada(const Frame& F) {
    LAS float* cact = (LAS float*)F.lds;
    float* ada = (float*)(F.ws + WS_ADA);
    for (int cb = F.c; cb < 192; cb += F.G) {
        const int kg = F.tid >> 5, col = F.tid & 31, gcol = cb * 32 + col;
        float w[16][4];
#pragma unroll
        for (int i = 0; i < 16; ++i)
#pragma unroll
            for (int j = 0; j < 4; ++j) w[i][j] = F.in[I_WADA][(size_t)(4 * kg + 64 * i + j) * 6144 + gcol];
        f32x4 cv[17];
#pragma unroll
        for (int it = 0; it < 17; ++it) { const int q = F.tid + it * NTHR, bq = q >> 8, k4 = (q & 255) * 4; cv[it] = (f32x4){0.f, 0.f, 0.f, 0.f};
            if (q < 33 * 256) cv[it] = *(const f32x4*)(bq < 32 ? F.in[I_C] + bq * 1024 + k4 : F.in[I_CCTX] + k4); }
#pragma unroll
        for (int it = 0; it < 17; ++it) { const int q = F.tid + it * NTHR; f32x4 v = cv[it];
#pragma unroll
            for (int j = 0; j < 4; ++j) v[j] = v[j] * fast_sigmoid(v[j]);
            if (q < 33 * 256) *(LAS f32x4*)(cact + q * 4) = v; }
        __syncthreads();
        float acc[33];
#pragma unroll
        for (int bb = 0; bb < 33; ++bb) acc[bb] = 0.f;
#pragma unroll
        for (int i = 0; i < 16; ++i)
#pragma unroll
            for (int bb = 0; bb < 33; ++bb) { const f32x4 c4 = *(const LAS f32x4*)(cact + bb * 1024 + 4 * kg + 64 * i);
                acc[bb] += (c4[0] * w[i][0] + c4[1] * w[i][1]) + (c4[2] * w[i][2] + c4[3] * w[i][3]); }
        __syncthreads();
        LAS float* red = cact;
#pragma unroll
        for (int bb = 0; bb < 33; ++bb) red[(kg * 33 + bb) * 32 + col] = acc[bb];
        __syncthreads();
        for (int o = F.tid; o < 33 * 32; o += NTHR) { const int bb = o >> 5, cc = o & 31; float sum = 0.f;
#pragma unroll
            for (int g = 0; g < 16; ++g) sum += red[(g * 33 + bb) * 32 + cc];
            ada[(size_t)bb * 6144 + cb * 32 + cc] = sum + F.in[I_BADA][cb * 32 + cc]; }
        __syncthreads();
    }
}
__device__ __forceinline__ void p0_fold(const Frame& F) {
    LAS float* xr = (LAS float*)F.lds;
    LAS float* cs = xr + 2048;
    unsigned char* W1 = (unsigned char*)(F.ws + WS_WIN1T);
    if (F.tid < 128) { const float a = (float)F.tid * (1.0f / 128.0f); cs[F.tid] = __builtin_amdgcn_cosf(a); cs[128 + F.tid] = __builtin_amdgcn_sinf(a); }
    for (int kb = F.c; kb < 256; kb += F.G) {
        __syncthreads();
        for (int i = F.tid; i < 2048; i += NTHR) xr[i] = F.in[I_WIN][(size_t)(4 * kb + (i >> 9)) * 5120 + (i & 511)];
        __syncthreads();
        const int g = F.tid >> 7, j = F.tid & 127;
        float ac[4] = {0.f, 0.f, 0.f, 0.f}, as[4] = {0.f, 0.f, 0.f, 0.f};
        for (int d = 0; d < 128; ++d) { const int idx = (d * j) & 127; const float cv = cs[idx], sv = cs[128 + idx];
#pragma unroll
            for (int r = 0; r < 4; ++r) { const float xv = xr[r * 512 + g * 128 + d]; ac[r] += xv * cv; as[r] += xv * sv; } }
        const float sc = 0.08838834764831845f * W8_SCALE;
        *(unsigned*)(W1 + (size_t)(g * 128 + j) * 1024 + 4 * kb) = cvt_pk4_fp8(ac[0] * sc, ac[1] * sc, ac[2] * sc, ac[3] * sc);
        *(unsigned*)(W1 + (size_t)(512 + g * 128 + j) * 1024 + 4 * kb) = cvt_pk4_fp8(-as[0] * sc, -as[1] * sc, -as[2] * sc, -as[3] * sc);
    }
    __syncthreads();
}
struct CvJob { const float* src; int sld; unsigned char* dst; int f8; };
__device__ __forceinline__ CvJob cv_job(const Frame& F, int j) {
    CvJob J;
    if (j < 128) { const int kt = j >> 4, nt = j & 15; J.src = F.in[I_WIN] + (size_t)kt * 128 * 5120 + 512 + nt * 128; J.sld = 5120; J.dst = F.ws + WS_WIN1T + (size_t)(1024 + nt * 128) * 1024 + kt * 128; J.f8 = 1; }
    else if (j < 288) { const int q = j - 128, kt = q / 20, nt = q % 20; J.src = F.in[I_WIN] + (size_t)kt * 128 * 5120 + 2560 + nt * 128; J.sld = 5120; J.dst = F.ws + WS_WIN2T + (size_t)(nt * 128) * 1024 + kt * 128; J.f8 = 1; }
    else if (j < 320) { const int q = j - 288, kt = q >> 3, nt = q & 7; J.src = F.in[I_WFO] + (size_t)kt * 128 * 1024 + nt * 128; J.sld = 1024; J.dst = F.ws + WS_WMT + ((size_t)(nt * 128) * 1024 + kt * 128); J.f8 = 1; }
    else if (j < 352) { const int q = j - 320, kt = q >> 3, nt = q & 7; J.src = F.in[I_WHO] + (size_t)kt * 128 * 1024 + nt * 128; J.sld = 1024; J.dst = F.ws + WS_WMT + ((size_t)(nt * 128) * 1024 + 512 + kt * 128); J.f8 = 1; }
    else if (j < 416) { const int q = j - 352, kt = q >> 3, nt = q & 7; J.src = F.in[I_WO] + (size_t)kt * 128 * 1024 + nt * 128; J.sld = 1024; J.dst = F.ws + WS_WOT + ((size_t)(nt * 128) * 1024 + kt * 128); J.f8 = 1; }
    else if (j < 4512) { const int q = j - 416, e = q >> 7, r = q & 127, kt = r >> 4, jt = r & 15; J.src = F.in[I_WGU] + (size_t)e * 1024 * 2048 + (size_t)kt * 128 * 2048 + jt * 128; J.sld = 2048;
        J.dst = F.ws + WS_WGUT + (size_t)e * 2048 * 1024 + (size_t)((jt & 7) * 256 + (jt >> 3) * 128) * 1024 + kt * 128; J.f8 = 1; }
    else { const int q = j - 4512, e = q >> 6, r = q & 63, kt = r >> 3, nt = r & 7; J.src = F.in[I_WDN] + (size_t)e * 1024 * 1024 + (size_t)kt * 128 * 1024 + nt * 128; J.sld = 1024;
        J.dst = F.ws + WS_WDNT + (size_t)e * 1024 * 1024 + (size_t)(nt * 128) * 1024 + kt * 128; J.f8 = 1; }
    return J;
}
__device__ __forceinline__ void p0_convert(const Frame& F) {
    constexpr int NJ = 128 + 160 + 32 + 32 + 64 + 4096 + 2048;
    LAS float* tile = (LAS float*)F.lds;
    int j = F.c; if (j >= NJ) return;
    CvJob J = cv_job(F, j);
    f32x4 v[8];
#pragma unroll
    for (int i = 0; i < 8; ++i) { const int idx = F.tid + i * NTHR, r = idx >> 5, c4 = idx & 31; v[i] = *(const f32x4*)(J.src + (size_t)r * J.sld + c4 * 4); }
    for (;;) {
        const float sc = J.f8 ? W8_SCALE : 1.0f;
#pragma unroll
        for (int i = 0; i < 8; ++i) { const int idx = F.tid + i * NTHR, r = idx >> 5, c4 = idx & 31; LAS float* p = tile + r * 129 + c4 * 4; p[0] = v[i][0] * sc; p[1] = v[i][1] * sc; p[2] = v[i][2] * sc; p[3] = v[i][3] * sc; }
        __syncthreads();
        const CvJob Jc = J; const int jn = j + F.G; const bool more = jn < NJ;
        if (more) { J = cv_job(F, jn);
#pragma unroll
            for (int i = 0; i < 8; ++i) { const int idx = F.tid + i * NTHR, r = idx >> 5, c4 = idx & 31; v[i] = *(const f32x4*)(J.src + (size_t)r * J.sld + c4 * 4); } }
        if (Jc.f8) {
#pragma unroll
            for (int i = 0; i < 2; ++i) { const int idx = F.tid + i * NTHR, n = idx >> 3, kc = idx & 7; const LAS float* p = tile + (kc * 16) * 129 + n;
                u32x4 w; w.x = cvt_pk4_fp8(p[0], p[129], p[2 * 129], p[3 * 129]); w.y = cvt_pk4_fp8(p[4 * 129], p[5 * 129], p[6 * 129], p[7 * 129]);
                w.z = cvt_pk4_fp8(p[8 * 129], p[9 * 129], p[10 * 129], p[11 * 129]); w.w = cvt_pk4_fp8(p[12 * 129], p[13 * 129], p[14 * 129], p[15 * 129]);
                *(u32x4*)(Jc.dst + (size_t)n * 1024 + kc * 16) = w; }
        } else {
#pragma unroll
            for (int i = 0; i < 4; ++i) { const int idx = F.tid + i * NTHR, n = idx >> 4, kc = idx & 15; const LAS float* p = tile + (kc * 8) * 129 + n;
                u32x4 w; w.x = cvt_pk_bf16(p[0], p[129]); w.y = cvt_pk_bf16(p[2 * 129], p[3 * 129]); w.z = cvt_pk_bf16(p[4 * 129], p[5 * 129]); w.w = cvt_pk_bf16(p[6 * 129], p[7 * 129]);
                *(u32x4*)((bf16_t*)Jc.dst + (size_t)n * 1024 + kc * 8) = w; }
        }
        __syncthreads();
        if (!more) break;
        j = jn;
    }
}

__device__ __forceinline__ void p1_uprep(const Frame& F) {
    const float* ada = (const float*)(F.ws + WS_ADA);
    unsigned char* U = (unsigned char*)(F.ws + WS_U); unsigned char* Uc = (unsigned char*)(F.ws + WS_UC);
    const size_t NIT = (size_t)(T + TCX) * 128, stride = (size_t)F.G * NTHR;
    for (size_t base = (size_t)F.c * NTHR + F.tid; base < NIT; base += 4 * stride) {
        const int col = (int)(base & 127) * 8;
        f32x4 a0[4], a1[4], sh0[4], sh1[4], sc0[4], sc1[4]; unsigned char* dst[4]; bool ok[4];
#pragma unroll
        for (int u = 0; u < 4; ++u) {
            const size_t idx = base + (size_t)u * stride; ok[u] = idx < NIT;
            const int row = (int)((ok[u] ? idx : base) >> 7);
            const bool lat = row < T; const int b = lat ? (row >> 11) : 32;
            const float* src = lat ? F.in[I_X] + (size_t)row * 1024 + col : F.in[I_CTX] + (size_t)(row - T) * 1024 + col;
            dst[u] = lat ? U + (size_t)row * 1024 + col : Uc + (size_t)(row - T) * 1024 + col;
            a0[u] = *(const f32x4*)src; a1[u] = *(const f32x4*)(src + 4);
            const float* ap = ada + (size_t)b * 6144 + col;
            sh0[u] = *(const f32x4*)ap; sh1[u] = *(const f32x4*)(ap + 4); sc0[u] = *(const f32x4*)(ap + 1024); sc1[u] = *(const f32x4*)(ap + 1028);
        }
#pragma unroll
        for (int u = 0; u < 4; ++u) {
            const f32x4 r0 = a0[u] * (sc0[u] + 1.0f) + sh0[u], r1 = a1[u] * (sc1[u] + 1.0f) + sh1[u];
            if (ok[u]) *(u32x2*)dst[u] = (u32x2){cvt_pk4_fp8(r0[0], r0[1], r0[2], r0[3]), cvt_pk4_fp8(r1[0], r1[1], r1[2], r1[3])};
        }
    }
    int* rowtok = (int*)(F.ws + WS_ROWTOK);
    for (int i = F.c * NTHR + F.tid; i < NCH * ROWS_CH; i += F.G * NTHR) rowtok[i] = (i / ROWS_CH) * TCH;
}

__device__ __forceinline__ void p6_readout(const Frame& F) {
    const bf16_t* PH = (const bf16_t*)(F.ws + WS_PH); const unsigned char* PG = (const unsigned char*)(F.ws + WS_PG); unsigned char* Y = (unsigned char*)(F.ws + WS_Y);
    const int l8 = F.lane * 8;
    const f32x4 g0 = *(const f32x4*)(F.in[I_HGG] + l8), g1 = *(const f32x4*)(F.in[I_HGG] + l8 + 4);
    const int tstr = F.G * 8;
    for (int t0 = F.c * 8 + F.wave; t0 < T; t0 += 4 * tstr) {
        u32x4 av[4], bv[4]; u32x2 pv[4]; bool ok[4]; int tt[4];
#pragma unroll
        for (int u = 0; u < 4; ++u) { const int t = t0 + u * tstr; ok[u] = t < T; tt[u] = ok[u] ? t : t0;
            av[u] = *(const u32x4*)(PH + (size_t)tt[u] * 2048 + 512 + l8); bv[u] = *(const u32x4*)(PH + (size_t)tt[u] * 2048 + 1024 + l8); pv[u] = *(const u32x2*)(PG + (size_t)tt[u] * 512 + l8); }
#pragma unroll
        for (int u = 0; u < 4; ++u) {
            const u32x4 a = av[u], b = bv[u]; const f32x4 pa = fp8x4_to_f32(pv[u].x), pb = fp8x4_to_f32(pv[u].y);
            float o[8] = { bf_lo(a.x) + bf_lo(b.x), bf_hi(a.x) + bf_hi(b.x), bf_lo(a.y) + bf_lo(b.y), bf_hi(a.y) + bf_hi(b.y), bf_lo(a.z) + bf_lo(b.z), bf_hi(a.z) + bf_hi(b.z), bf_lo(a.w) + bf_lo(b.w), bf_hi(a.w) + bf_hi(b.w) };
            float ss = 0.f;
#pragma unroll
            for (int i = 0; i < 8; ++i) ss += o[i] * o[i];
            ss += __shfl_xor(ss, 1); ss += __shfl_xor(ss, 2); ss += __shfl_xor(ss, 4); ss += __shfl_xor(ss, 8);
            const float rs = __builtin_amdgcn_rsqf(ss * (1.0f / 128.0f) + RMS_EPS);
            const float sp[8] = { pa[0], pa[1], pa[2], pa[3], pb[0], pb[1], pb[2], pb[3] };
            if (ok[u]) *(u32x2*)(Y + (size_t)tt[u] * 1024 + 512 + l8) = (u32x2){cvt_pk4_fp8(o[0] * rs * g0[0] * sp[0], o[1] * rs * g0[1] * sp[1], o[2] * rs * g0[2] * sp[2], o[3] * rs * g0[3] * sp[3]), cvt_pk4_fp8(o[4] * rs * g1[0] * sp[4], o[5] * rs * g1[1] * sp[5], o[6] * rs * g1[2] * sp[6], o[7] * rs * g1[3] * sp[7])};
        }
    }
}

constexpr int RW_STRIDE = 2080;
constexpr int RW_HI = 0, RW_LO = 32 * RW_STRIDE, RW_PAR = 64 * RW_STRIDE, RW_BR = RW_PAR + 16384, RW_HIST = RW_BR + 128;
__device__ __forceinline__ void p9_ln1_router(const Frame& F, const bool dry) {
    LAS unsigned char* L = F.lds;
    LAS float* par = (LAS float*)(L + RW_PAR); LAS float* brs = (LAS float*)(L + RW_BR); LAS int* hist = (LAS int*)(L + RW_HIST);
#pragma unroll 1
    for (int it = 0; it < 8; ++it) { const int item = F.tid + it * NTHR, e = item & 31, k8 = item >> 5;
        float w[8];
#pragma unroll
        for (int i = 0; i < 8; ++i) w[i] = F.in[I_WR][(k8 * 8 + i) * 32 + e];
        u32x4 hi, lo;
#pragma unroll
        for (int i = 0; i < 4; ++i) { const unsigned h = cvt_pk_bf16(w[2 * i], w[2 * i + 1]); hi[i] = h; lo[i] = cvt_pk_bf16(w[2 * i] - bf_lo(h), w[2 * i + 1] - bf_hi(h)); }
        *(LAS u32x4*)(L + RW_HI + e * RW_STRIDE + k8 * 16) = hi; *(LAS u32x4*)(L + RW_LO + e * RW_STRIDE + k8 * 16) = lo; }
    for (int i = F.tid; i < 2048; i += NTHR) par[i] = i < 1024 ? F.in[I_LN1G][i] : F.in[I_LN1B][i - 1024];
    if (F.tid < 32) brs[F.tid] = F.in[I_BR][F.tid];
    if (F.tid < NCH * 32) hist[F.tid] = 0;
    const unsigned char* V = (const unsigned char*)F.out; bf16_t* X1 = (bf16_t*)(F.ws + WS_X1); unsigned char* U2 = (unsigned char*)(F.ws + WS_U); const float* ada = (const float*)(F.ws + WS_ADA);
    int* topi = (int*)(F.ws + WS_TOPI); float* topw = (float*)(F.ws + WS_TOPW);
    for (int gb = F.c * 8; gb < T / 16; gb += F.G * 8) {
        const int g = T / 16 - 1 - (gb + F.wave), t0 = g * 16, b = (T / 16 - 1 - gb) >> 7;
        __syncthreads();
        { int tz = threadIdx.x; asm volatile("" : "+v"(tz));
          for (int i = tz; i < 2048; i += NTHR) par[2048 + i] = i < 1024 ? 1.0f + ada[(size_t)b * 6144 + 4096 + i] : ada[(size_t)b * 6144 + 3072 + (i - 1024)]; }
        __syncthreads();
        int l1 = threadIdx.x; asm volatile("" : "+v"(l1)); l1 &= 63;
        const float* xp = F.in[I_X] + (size_t)(t0 + (l1 & 15)) * 1024 + 8 * (l1 >> 4); const unsigned char* vp = V + (size_t)(t0 + (l1 & 15)) * 1024 + 8 * (l1 >> 4);
        unsigned tb[32][4]; float s1 = 0.f, s2 = 0.f, s1b = 0.f, s2b = 0.f;
#pragma unroll
        for (int c = 0; c < 16; ++c) {
            f32x4 xa[2], xb[2]; u32x2 vv[2];
#pragma unroll
            for (int q = 0; q < 2; ++q) { const int ks = 2 * c + q; xa[q] = *(const f32x4*)(xp + 32 * ks); xb[q] = *(const f32x4*)(xp + 32 * ks + 4); vv[q] = *(const u32x2*)(vp + 32 * ks); }
#pragma unroll
            for (int q = 0; q < 2; ++q) { const int ks = 2 * c + q;
                const f32x4 ta = xa[q] * DN_ALPHA + fp8x4_to_f32(vv[q].x) * V8_INV, tc = xb[q] * DN_ALPHA + fp8x4_to_f32(vv[q].y) * V8_INV;
#pragma unroll
                for (int j = 0; j < 4; ++j) { s1 += ta[j]; s1b += tc[j]; s2 = __builtin_fmaf(ta[j], ta[j], s2); s2b = __builtin_fmaf(tc[j], tc[j], s2b); }
                tb[ks][0] = cvt_pk_bf16(ta[0], ta[1]); tb[ks][1] = cvt_pk_bf16(ta[2], ta[3]); tb[ks][2] = cvt_pk_bf16(tc[0], tc[1]); tb[ks][3] = cvt_pk_bf16(tc[2], tc[3]); }
            asm volatile("" ::: "memory"); __builtin_amdgcn_sched_barrier(0);
        }
        s1 += s1b; s2 += s2b;
        {   int l4 = threadIdx.x; asm volatile("" : "+v"(l4)); l4 &= 63; const int b16 = (l4 ^ 16) << 2, b32 = (l4 ^ 32) << 2;
            s1 += __int_as_float(__builtin_amdgcn_ds_bpermute(b16, __float_as_int(s1))); s2 += __int_as_float(__builtin_amdgcn_ds_bpermute(b16, __float_as_int(s2)));
            s1 += __int_as_float(__builtin_amdgcn_ds_bpermute(b32, __float_as_int(s1))); s2 += __int_as_float(__builtin_amdgcn_ds_bpermute(b32, __float_as_int(s2))); }
        const float mean = s1 * (1.0f / 1024.0f), rstd = __builtin_amdgcn_rsqf(fmaxf(s2 * (1.0f / 1024.0f) - mean * mean, 0.f) + LN_EPS), nmr = -mean * rstd;
        f32x4 acc[2] = {(f32x4){0.f, 0.f, 0.f, 0.f}, (f32x4){0.f, 0.f, 0.f, 0.f}};
        int l2 = threadIdx.x; asm volatile("" : "+v"(l2)); l2 &= 63; const int fr = l2 & 15, fq = l2 >> 4;
        bf16_t* x1p = X1 + (size_t)(t0 + fr) * 1024 + 8 * fq; unsigned char* u2p = U2 + (size_t)(t0 + fr) * 1024 + 8 * fq;
#pragma unroll
        for (int ks = 0; ks < 32; ++ks) {
            const LAS float* pp = par + 32 * ks + 8 * fq;
            const f32x4 ta = {bf_lo(tb[ks][0]), bf_hi(tb[ks][0]), bf_lo(tb[ks][1]), bf_hi(tb[ks][1])}, tc = {bf_lo(tb[ks][2]), bf_hi(tb[ks][2]), bf_lo(tb[ks][3]), bf_hi(tb[ks][3])};
            f32x4 xa, xc, ua, uc;
            {   const f32x4 g0 = *(const LAS f32x4*)pp, b0 = *(const LAS f32x4*)(pp + 1024), c0 = *(const LAS f32x4*)(pp + 2048), h0 = *(const LAS f32x4*)(pp + 3072);
                xa = (ta * rstd + nmr) * g0 + b0; ua = xa * c0 + h0; }
            __builtin_amdgcn_sched_barrier(0);
            {   const f32x4 g1 = *(const LAS f32x4*)(pp + 4), b1 = *(const LAS f32x4*)(pp + 1028), c1 = *(const LAS f32x4*)(pp + 2052), h1 = *(const LAS f32x4*)(pp + 3076);
                xc = (tc * rstd + nmr) * g1 + b1; uc = xc * c1 + h1; }
            if (!dry) *(u32x4*)(x1p + 32 * ks) = (u32x4){cvt_pk_bf16(xa[0], xa[1]), cvt_pk_bf16(xa[2], xa[3]), cvt_pk_bf16(xc[0], xc[1]), cvt_pk_bf16(xc[2], xc[3])};
            if (!dry) *(u32x2*)(u2p + 32 * ks) = (u32x2){cvt_pk4_fp8(ua[0], ua[1], ua[2], ua[3]), cvt_pk4_fp8(uc[0], uc[1], uc[2], uc[3])};
            u32x4 hi = {cvt_pk_bf16(ua[0], ua[1]), cvt_pk_bf16(ua[2], ua[3]), cvt_pk_bf16(uc[0], uc[1]), cvt_pk_bf16(uc[2], uc[3])};
            u32x4 lo = {cvt_pk_bf16(ua[0] - bf_lo(hi[0]), ua[1] - bf_hi(hi[0])), cvt_pk_bf16(ua[2] - bf_lo(hi[1]), ua[3] - bf_hi(hi[1])), cvt_pk_bf16(uc[0] - bf_lo(hi[2]), uc[1] - bf_hi(hi[2])), cvt_pk_bf16(uc[2] - bf_lo(hi[3]), uc[3] - bf_hi(hi[3]))};
            const bf16x8 uh = *(bf16x8*)&hi, ul = *(bf16x8*)&lo;
#pragma unroll
            for (int et = 0; et < 2; ++et) {
                const bf16x8 wh = *(const LAS bf16x8*)(L + RW_HI + (16 * et + fr) * RW_STRIDE + ks * 64 + fq * 16), wl = *(const LAS bf16x8*)(L + RW_LO + (16 * et + fr) * RW_STRIDE + ks * 64 + fq * 16);
                acc[et] = __builtin_amdgcn_mfma_f32_16x16x32_bf16(wh, uh, acc[et], 0, 0, 0);
                acc[et] = __builtin_amdgcn_mfma_f32_16x16x32_bf16(wh, ul, acc[et], 0, 0, 0);
                acc[et] = __builtin_amdgcn_mfma_f32_16x16x32_bf16(wl, uh, acc[et], 0, 0, 0);
                __builtin_amdgcn_sched_barrier(0); }
        }
        int l3 = threadIdx.x; asm volatile("" : "+v"(l3)); l3 &= 63; const int fq3 = l3 >> 4, t = t0 + (l3 & 15), a16 = (l3 ^ 16) << 2, a32 = (l3 ^ 32) << 2;
        float lv[8]; int li[8];
#pragma unroll
        for (int i = 0; i < 4; ++i) { li[i] = 4 * fq3 + i; li[4 + i] = 16 + 4 * fq3 + i; lv[i] = acc[0][i] + brs[4 * fq3 + i]; lv[4 + i] = acc[1][i] + brs[16 + 4 * fq3 + i]; }
        float tv[4]; int ti[4];
#pragma unroll
        for (int r = 0; r < 4; ++r) {
            float bv = lv[0]; int bi = li[0];
#pragma unroll
            for (int i = 1; i < 8; ++i) { const bool gt = lv[i] > bv; bv = gt ? lv[i] : bv; bi = gt ? li[i] : bi; }
#pragma unroll
            for (int o = 0; o < 2; ++o) { const int ad = o ? a32 : a16; const float ov = __int_as_float(__builtin_amdgcn_ds_bpermute(ad, __float_as_int(bv))); const int oi = __builtin_amdgcn_ds_bpermute(ad, bi); const bool tk = ov > bv || (ov == bv && oi < bi); bv = tk ? ov : bv; bi = tk ? oi : bi; }
            tv[r] = bv; ti[r] = bi;
#pragma unroll
            for (int i = 0; i < 8; ++i) lv[i] = (li[i] == bi) ? -3.0e38f : lv[i];
        }
        if (fq3 == 0) {
            const float p1 = fast_exp(tv[1] - tv[0]), p2 = fast_exp(tv[2] - tv[0]), p3 = fast_exp(tv[3] - tv[0]), inv = 1.0f / (1.0f + p1 + p2 + p3);
            *(int4*)(topi + (size_t)t * 4) = make_int4(ti[0], ti[1], ti[2], ti[3]);
            *(f32x4*)(topw + (size_t)t * 4) = (f32x4){inv, p1 * inv, p2 * inv, p3 * inv};
            const int ch = t / TCH;
            if (!dry) { atomicAdd((int*)(hist + ch * 32 + ti[0]), 1); atomicAdd((int*)(hist + ch * 32 + ti[1]), 1); atomicAdd((int*)(hist + ch * 32 + ti[2]), 1); atomicAdd((int*)(hist + ch * 32 + ti[3]), 1); }
        }
    }
    __syncthreads();
    { int t2 = threadIdx.x; asm volatile("" : "+v"(t2));
      if (t2 < NCH * 32) { const int h = hist[t2]; if (h && !dry) atomicAdd(F.ctl + CW_CNT + t2, (unsigned)h); } }
    __syncthreads();
}

__device__ __forceinline__ void p10_dispatch(const Frame& F) {
    LAS int* lcnt = (LAS int*)F.lds; LAS int* lbase = lcnt + 32; LAS int* pstart = lcnt + 64;
    const int* topi = (const int*)(F.ws + WS_TOPI); int* pos = (int*)(F.ws + WS_POS); int* rowtok = (int*)(F.ws + WS_ROWTOK);
    for (int s = F.c; s < T / 256; s += F.G) {
        const int ch = (s * 256) / TCH;
        __syncthreads();
        if (F.tid < 32) { lcnt[F.tid] = 0; int ps = 0; for (int e = 0; e < F.tid; ++e) { const int n = (int)__hip_atomic_load(F.ctl + CW_CNT + ch * 32 + e, __ATOMIC_RELAXED, __HIP_MEMORY_SCOPE_AGENT); ps += (n + 255) & ~255; } pstart[F.tid] = ps; }
        __syncthreads();
        int e2[2], r2[2];
#pragma unroll
        for (int i = 0; i < 2; ++i) { const int a = F.tid + i * NTHR; e2[i] = topi[(size_t)(s * 256) * 4 + a]; r2[i] = atomicAdd((int*)(lcnt + e2[i]), 1); }
        __syncthreads();
        if (F.tid < 32) lbase[F.tid] = (int)atomicAdd(F.ctl + CW_CUR + ch * 32 + F.tid, (unsigned)lcnt[F.tid]);
        __syncthreads();
#pragma unroll
        for (int i = 0; i < 2; ++i) { const int a = F.tid + i * NTHR, slot = pstart[e2[i]] + lbase[e2[i]] + r2[i];
            pos[(size_t)(s * 256) * 4 + a] = slot; rowtok[(size_t)ch * ROWS_CH + slot] = s * 256 + (a >> 2); }
    }
}
__device__ __forceinline__ int moe_blocks(const Frame& F, int ch, LAS unsigned char* blk_e) {
    LAS int* sh = (LAS int*)(blk_e + 1152);
    __syncthreads();
    if (F.tid < 32) {
        int start = 0, mine = 0;
        for (int e = 0; e < 32; ++e) { const int n = ((int)__hip_atomic_load(F.ctl + CW_CNT + ch * 32 + e, __ATOMIC_RELAXED, __HIP_MEMORY_SCOPE_AGENT) + 255) >> 8; if (e < F.tid) start += n; if (e == F.tid) mine = n; }
        for (int i = 0; i < mine; ++i) blk_e[start + i] = (unsigned char)F.tid;
        if (F.tid == 31) sh[0] = start + mine;
    }
    __syncthreads();
    return sh[0];
}

__device__ __forceinline__ void p13_combine_ln2(const Frame& F, int ch, const bool dry) {
    const unsigned char* YC = (const unsigned char*)(F.ws + WS_YCH); const int* pos = (const int*)(F.ws + WS_POS); const float* topw = (const float*)(F.ws + WS_TOPW);
    const float* ada = (const float*)(F.ws + WS_ADA); const bf16_t* X1 = (const bf16_t*)(F.ws + WS_X1); float* O = F.out;
    const int l8 = F.lane * 8;
    for (int t0 = ch * TCH + F.c * 8 + F.wave; t0 < (ch + 1) * TCH; t0 += 2 * F.G * 8) {
        int tt[2]; tt[0] = t0; tt[1] = t0 + F.G * 8; const bool two = tt[1] < (ch + 1) * TCH; if (!two) tt[1] = t0;
        f32x4 v[2][2][2];
#pragma unroll
        for (int q = 0; q < 2; ++q) { const int t = tt[q], b = t >> 11;
            const int4 ps = *(const int4*)(pos + (size_t)t * 4); const f32x4 tw = *(const f32x4*)(topw + (size_t)t * 4);
#pragma unroll
            for (int j = 0; j < 2; ++j) { const int k = 512 * j + l8;
                const u32x2 y0 = *(const u32x2*)(YC + (size_t)ps.x * 1024 + k), y1 = *(const u32x2*)(YC + (size_t)ps.y * 1024 + k), y2 = *(const u32x2*)(YC + (size_t)ps.z * 1024 + k), y3 = *(const u32x2*)(YC + (size_t)ps.w * 1024 + k);
                const u32x4 xw = *(const u32x4*)(X1 + (size_t)t * 1024 + k);
                const f32x4 g2a = *(const f32x4*)(ada + (size_t)b * 6144 + 5120 + k), g2b = *(const f32x4*)(ada + (size_t)b * 6144 + 5120 + k + 4);
                const f32x4 ffa = fp8x4_to_f32(y0.x) * tw[0] + fp8x4_to_f32(y1.x) * tw[1] + fp8x4_to_f32(y2.x) * tw[2] + fp8x4_to_f32(y3.x) * tw[3];
                const f32x4 ffb = fp8x4_to_f32(y0.y) * tw[0] + fp8x4_to_f32(y1.y) * tw[1] + fp8x4_to_f32(y2.y) * tw[2] + fp8x4_to_f32(y3.y) * tw[3];
                v[q][j][0] = (f32x4){bf_lo(xw.x), bf_hi(xw.x), bf_lo(xw.y), bf_hi(xw.y)} * DN_ALPHA + g2a * ffa;
                v[q][j][1] = (f32x4){bf_lo(xw.z), bf_hi(xw.z), bf_lo(xw.w), bf_hi(xw.w)} * DN_ALPHA + g2b * ffb; } }
#pragma unroll
        for (int q = 0; q < 2; ++q) { const int t = tt[q];
            float s = 0.f;
#pragma unroll
            for (int j = 0; j < 2; ++j)
#pragma unroll
                for (int h = 0; h < 2; ++h) s += (v[q][j][h][0] + v[q][j][h][1]) + (v[q][j][h][2] + v[q][j][h][3]);
            s = wave_sum(s); const float mean = s * (1.0f / 1024.0f); float qq = 0.f;
#pragma unroll
            for (int j = 0; j < 2; ++j)
#pragma unroll
                for (int h = 0; h < 2; ++h) { const f32x4 d = v[q][j][h] - mean; qq += (d[0] * d[0] + d[1] * d[1]) + (d[2] * d[2] + d[3] * d[3]); }
            qq = wave_sum(qq); const float rstd = __builtin_amdgcn_rsqf(qq * (1.0f / 1024.0f) + LN_EPS);
            if (q == 0 || two) {
#pragma unroll
                for (int j = 0; j < 2; ++j)
#pragma unroll
                    for (int h = 0; h < 2; ++h) { const int k = 512 * j + l8 + 4 * h; const f32x4 g = *(const f32x4*)(F.in[I_LN2G] + k), bb = *(const f32x4*)(F.in[I_LN2B] + k);
                        const f32x4 o4 = (v[q][j][h] - mean) * rstd * g + bb;
                        if (!dry) *(f32x4*)(O + (size_t)t * 1024 + k) = o4; else if (o4[0] == 1.2345e30f) O[0] = 1.f; } }
        }
    }
}

constexpr int SC_QD = 0, SC_KI = 17408, SC_KE = 34816, SC_VT = 53248, SC_SC = 71680, SC_ST = 80896, SC_GV = 115712, SC_CS = 116224;
__device__ __forceinline__ bf16x8 ldfrag(const LAS unsigned char* p) { return *(const LAS bf16x8*)p; }
__device__ __forceinline__ void p3_scan(const Frame& F, const bool dry) {
    LAS unsigned char* L = F.lds;
    const int tid = F.tid, w = F.wave, lane = F.lane, fr = lane & 15, fq = lane >> 4;
    const int d = tid & 127, qd = __builtin_amdgcn_readfirstlane(tid >> 7);
    bf16_t* PH = (bf16_t*)(F.ws + WS_PH); const bf16_t* PHC = (const bf16_t*)(F.ws + WS_PHC);
    for (int it = F.c; it < 256; it += F.G) {
        const int b = it >> 3, h = (it >> 1) & 3, dir = it & 1;
        const float r0 = F.in[I_LBRAW][dir * 512 + h * 128 + d], r1 = F.in[I_LBRAW][1024 + dir * 512 + h * 128 + d];
        const float lbv = fast_sigmoid(r0 - r1), oml = 1.0f - lbv;
        f32x4 Sacc[8];
#pragma unroll
        for (int i = 0; i < 8; ++i) Sacc[i] = (f32x4){0.f, 0.f, 0.f, 0.f};
        __syncthreads();
        for (int i = tid; i < 34816 / 4; i += NTHR) ((LAS unsigned*)(L + SC_ST))[i] = 0u;
        const int cq = h * 128 + d, cz = (dir ? 3584 : 512) + h * 128 + d;
        unsigned char rq[16], rv[16], rz[16];
        {   const int n = dir ? 3 : 0; const bf16_t* base = PHC + (size_t)(b * 256 + 64 * n + 16 * qd) * 2048; const unsigned char* base8 = (const unsigned char*)base;
#pragma unroll
            for (int i = 0; i < 16; ++i) { rq[i] = base8[(size_t)i * 4096 + cq]; rz[i] = base8[(size_t)i * 4096 + cz]; rv[i] = base8[(size_t)i * 4096 + 3072 + cq]; } }
        for (int s = 0; s < 36; ++s) {
            const bool lat = s >= 4; const int n = lat ? (dir ? 31 - (s - 4) : (s - 4)) : (dir ? 3 - s : s);
            float kk[16], cum[16]; float run = 0.f;
#pragma unroll
            for (int i = 0; i < 16; ++i) { const float sg = (float)rz[i] * (1.0f / 255.0f); kk[i] = oml * (1.0f - sg); cum[i] = lbv + oml * sg; }
            run = 1.0f;
            if (dir == 0) {
#pragma unroll
                for (int i = 0; i < 16; ++i) { run *= cum[i]; cum[i] = run; }
            } else {
#pragma unroll
                for (int i = 15; i >= 0; --i) { run *= cum[i]; cum[i] = run; }
            }
            ((LAS float*)(L + SC_CS))[qd * 128 + d] = run;
            __syncthreads();
            {   const LAS float* cs = (const LAS float*)(L + SC_CS);
                const float c0 = cs[d], c1 = cs[128 + d], c2 = cs[256 + d], c3 = cs[384 + d], tot = (c0 * c1) * (c2 * c3);
                float off;
                if (dir == 0) off = (qd > 0 ? c0 : 1.f) * (qd > 1 ? c1 : 1.f) * (qd > 2 ? c2 : 1.f);
                else off = (qd < 3 ? c3 : 1.f) * (qd < 2 ? c2 : 1.f) * (qd < 1 ? c1 : 1.f);
                const float g = tot;
                if (qd == 0) ((LAS float*)(L + SC_GV))[d] = g;
                unsigned ke[8], vt[8];
#pragma unroll
                for (int i = 0; i < 16; i += 2) {
                    const float ea = cum[i] * off, eb = cum[i + 1] * off, ia = __builtin_amdgcn_rcpf(ea), ib = __builtin_amdgcn_rcpf(eb);
                    const float qda = __builtin_amdgcn_cvt_f32_fp8((int)rq[i], 0) * ea, qdb = __builtin_amdgcn_cvt_f32_fp8((int)rq[i + 1], 0) * eb;
                    const float kia = kk[i] * ia, kib = kk[i + 1] * ib;
                    const unsigned wa = cvt_pk_bf16(qda, kia), wb = cvt_pk_bf16(qdb, kib);
                    *(LAS bf16_t*)(L + SC_QD + (16 * qd + i) * 272 + d * 2) = (bf16_t)(wa & 0xffffu);
                    *(LAS bf16_t*)(L + SC_KI + (16 * qd + i) * 272 + d * 2) = (bf16_t)(wa >> 16);
                    *(LAS bf16_t*)(L + SC_QD + (16 * qd + i + 1) * 272 + d * 2) = (bf16_t)(wb & 0xffffu);
                    *(LAS bf16_t*)(L + SC_KI + (16 * qd + i + 1) * 272 + d * 2) = (bf16_t)(wb >> 16);
                    ke[i >> 1] = cvt_pk_bf16(kia * g, kib * g);
                    vt[i >> 1] = cvt_pk_bf16(__builtin_amdgcn_cvt_f32_fp8((int)rv[i], 0), __builtin_amdgcn_cvt_f32_fp8((int)rv[i + 1], 0));
                }
                *(LAS u32x4*)(L + SC_KE + d * 144 + 32 * qd) = (u32x4){ke[0], ke[1], ke[2], ke[3]};
                *(LAS u32x4*)(L + SC_KE + d * 144 + 32 * qd + 16) = (u32x4){ke[4], ke[5], ke[6], ke[7]};
                *(LAS u32x4*)(L + SC_VT + d * 144 + 32 * qd) = (u32x4){vt[0], vt[1], vt[2], vt[3]};
                *(LAS u32x4*)(L + SC_VT + d * 144 + 32 * qd + 16) = (u32x4){vt[4], vt[5], vt[6], vt[7]};
            }
            if (s + 1 < 36) {
                const int s1 = s + 1; const bool lat1 = s1 >= 4; const int n1 = lat1 ? (dir ? 31 - (s1 - 4) : (s1 - 4)) : (dir ? 3 - s1 : s1);
                const bf16_t* base = lat1 ? (const bf16_t*)PH + (size_t)(b * 2048 + 64 * n1 + 16 * qd) * 2048 : PHC + (size_t)(b * 256 + 64 * n1 + 16 * qd) * 2048;
                const unsigned char* base8 = (const unsigned char*)base;
#pragma unroll
                for (int i = 0; i < 16; ++i) { rq[i] = base8[(size_t)i * 4096 + cq]; rz[i] = base8[(size_t)i * 4096 + cz]; rv[i] = base8[(size_t)i * 4096 + 3072 + cq]; }
            }
            __syncthreads();
            f32x4 oacc[4];
#pragma unroll
            for (int i = 0; i < 4; ++i) oacc[i] = (f32x4){0.f, 0.f, 0.f, 0.f};
            const int kb = fq * 16;
            if (lat) {
                const int ct = w >> 1, st0 = 2 * (w & 1);
#pragma unroll
                for (int j = 0; j < 2; ++j) { const int st = st0 + j; f32x4 sa = (f32x4){0.f, 0.f, 0.f, 0.f};
#pragma unroll
                    for (int ks = 0; ks < 4; ++ks) sa = __builtin_amdgcn_mfma_f32_16x16x32_bf16(ldfrag(L + SC_KI + (16 * st + fr) * 272 + ks * 64 + kb), ldfrag(L + SC_QD + (16 * ct + fr) * 272 + ks * 64 + kb), sa, 0, 0, 0);
                    const int cc = 16 * ct + fr, s0 = 16 * st + 4 * fq;
#pragma unroll
                    for (int i = 0; i < 4; ++i) { const bool keep = dir ? (s0 + i >= cc) : (s0 + i <= cc); sa[i] = keep ? sa[i] : 0.f; }
                    *(LAS u32x2*)(L + SC_SC + cc * 144 + s0 * 2) = (u32x2){cvt_pk_bf16(sa[0], sa[1]), cvt_pk_bf16(sa[2], sa[3])}; }
#pragma unroll
                for (int ct2 = 0; ct2 < 4; ++ct2)
#pragma unroll
                    for (int ks = 0; ks < 4; ++ks) oacc[ct2] = __builtin_amdgcn_mfma_f32_16x16x32_bf16(ldfrag(L + SC_ST + (16 * w + fr) * 272 + ks * 64 + kb), ldfrag(L + SC_QD + (16 * ct2 + fr) * 272 + ks * 64 + kb), oacc[ct2], 0, 0, 0);
            }
            {   const bf16x8 v0 = ldfrag(L + SC_VT + (16 * w + fr) * 144 + kb), v1 = ldfrag(L + SC_VT + (16 * w + fr) * 144 + 64 + kb);
#pragma unroll
                for (int dt = 0; dt < 8; ++dt) { const f32x4 gv = *(const LAS f32x4*)(L + SC_GV + (16 * dt + 4 * fq) * 4);
                    f32x4 a = Sacc[dt] * gv;
                    a = __builtin_amdgcn_mfma_f32_16x16x32_bf16(ldfrag(L + SC_KE + (16 * dt + fr) * 144 + kb), v0, a, 0, 0, 0);
                    a = __builtin_amdgcn_mfma_f32_16x16x32_bf16(ldfrag(L + SC_KE + (16 * dt + fr) * 144 + 64 + kb), v1, a, 0, 0, 0);
                    Sacc[dt] = a; } }
            __syncthreads();
#pragma unroll
            for (int dt = 0; dt < 8; ++dt) *(LAS u32x2*)(L + SC_ST + (16 * w + fr) * 272 + (16 * dt + 4 * fq) * 2) = (u32x2){cvt_pk_bf16(Sacc[dt][0], Sacc[dt][1]), cvt_pk_bf16(Sacc[dt][2], Sacc[dt][3])};
            if (lat) {
                const bf16x8 v0 = ldfrag(L + SC_VT + (16 * w + fr) * 144 + kb), v1 = ldfrag(L + SC_VT + (16 * w + fr) * 144 + 64 + kb);
                bf16_t* ob = PH + (size_t)(b * 2048 + 64 * n) * 2048 + 512 + dir * 512 + h * 128 + 16 * w + 4 * fq;
#pragma unroll
                for (int ct2 = 0; ct2 < 4; ++ct2) {
                    f32x4 a = oacc[ct2];
                    a = __builtin_amdgcn_mfma_f32_16x16x32_bf16(v0, ldfrag(L + SC_SC + (16 * ct2 + fr) * 144 + kb), a, 0, 0, 0);
                    a = __builtin_amdgcn_mfma_f32_16x16x32_bf16(v1, ldfrag(L + SC_SC + (16 * ct2 + fr) * 144 + 64 + kb), a, 0, 0, 0);
                    if (!dry) *(u32x2*)(ob + (size_t)(16 * ct2 + fr) * 2048) = (u32x2){cvt_pk_bf16(a[0], a[1]), cvt_pk_bf16(a[2], a[3])};
                    else if (a[0] == 1.2345e30f) ob[0] = 1; }
            }
        }
        __syncthreads();
    }
}

typedef short s16x4 __attribute__((ext_vector_type(4)));
__device__ __forceinline__ s16x4 tr_read(unsigned lds_addr) { s16x4 r; asm volatile("ds_read_b64_tr_b16 %0, %1\n\ts_waitcnt lgkmcnt(0)" : "=&v"(r) : "v"(lds_addr) : "memory"); return r; }
__device__ __forceinline__ void tr_read8(unsigned a0, unsigned a1, unsigned a2, unsigned a3, unsigned d, s16x4 (&r)[8]) {
    asm volatile("ds_read_b64_tr_b16 %0, %8\n\tds_read_b64_tr_b16 %1, %9\n\tds_read_b64_tr_b16 %2, %10\n\tds_read_b64_tr_b16 %3, %11\n\t"
                 "ds_read_b64_tr_b16 %4, %12\n\tds_read_b64_tr_b16 %5, %13\n\tds_read_b64_tr_b16 %6, %14\n\tds_read_b64_tr_b16 %7, %15\n\ts_waitcnt lgkmcnt(0)"
                 : "=&v"(r[0]), "=&v"(r[1]), "=&v"(r[2]), "=&v"(r[3]), "=&v"(r[4]), "=&v"(r[5]), "=&v"(r[6]), "=&v"(r[7])
                 : "v"(a0), "v"(a0 + d), "v"(a1), "v"(a1 + d), "v"(a2), "v"(a2 + d), "v"(a3), "v"(a3 + d) : "memory");
}
__device__ __forceinline__ void tr_read4(unsigned a0, unsigned a1, unsigned d, s16x4 (&r)[4]) {
    asm volatile("ds_read_b64_tr_b16 %0, %4\n\tds_read_b64_tr_b16 %1, %5\n\tds_read_b64_tr_b16 %2, %6\n\tds_read_b64_tr_b16 %3, %7\n\ts_waitcnt lgkmcnt(0)"
                 : "=&v"(r[0]), "=&v"(r[1]), "=&v"(r[2]), "=&v"(r[3]) : "v"(a0), "v"(a0 + d), "v"(a1), "v"(a1 + d) : "memory");
}
__device__ __forceinline__ bf16x8 cat4(s16x4 a, s16x4 b) { return (bf16x8){a[0], a[1], a[2], a[3], b[0], b[1], b[2], b[3]}; }
constexpr int FO_C = 131072, FO_S = 139264;
__device__ __forceinline__ void p4_fourier(const Frame& F) {
    LAS unsigned char* L = F.lds;
    const int tid = F.tid, w = F.wave, lane = F.lane, fr = lane & 15, fq = lane >> 4;
    const bf16_t* PA = (const bf16_t*)(F.ws + WS_PA); unsigned char* Y = (unsigned char*)(F.ws + WS_Y);
    __syncthreads();
    for (int i = tid; i < 4096; i += NTHR) { const int k2 = i >> 6, c = i & 63; const float a = (float)((k2 * c) & 63) * (1.0f / 64.0f);
        *(LAS bf16_t*)(L + FO_C + i * 2) = (bf16_t)(cvt_pk_bf16(__builtin_amdgcn_cosf(a) * 0.125f, 0.f) & 0xffffu);
        *(LAS bf16_t*)(L + FO_S + i * 2) = (bf16_t)(cvt_pk_bf16(__builtin_amdgcn_sinf(a) * 0.125f, 0.f) & 0xffffu); }
    bf16x8 Gf[2][2];
#pragma unroll
    for (int nt = 0; nt < 2; ++nt)
#pragma unroll
        for (int ks = 0; ks < 2; ++ks) { unsigned pk[4];
#pragma unroll
            for (int j = 0; j < 8; j += 2) { const int k1 = 16 * nt + fr, ra = 8 * fq + j, rb = ra + 1; const float aa = (float)((k1 * ra) & 31) * (1.0f / 32.0f), ab = (float)((k1 * rb) & 31) * (1.0f / 32.0f);
                const float va = (ks ? __builtin_amdgcn_sinf(aa) : __builtin_amdgcn_cosf(aa)) * 0.17677669529663687f, vb = (ks ? __builtin_amdgcn_sinf(ab) : __builtin_amdgcn_cosf(ab)) * 0.17677669529663687f;
                pk[j >> 1] = cvt_pk_bf16(va, vb); }
            u32x4 t4 = (u32x4){pk[0], pk[1], pk[2], pk[3]}; Gf[nt][ks] = *(bf16x8*)&t4; }
    const unsigned lbase = (unsigned)(size_t)L;
    u32x4 pv[8];
    if (F.c < 1024) { const int it = F.c, xcd = it & 7, jj = it >> 3, slab = 4 * xcd + (jj & 3), b = jj >> 2; const unsigned char* src = (const unsigned char*)PA + (size_t)(b * 32 + slab) * 65536;
#pragma unroll
        for (int n = 0; n < 8; ++n) pv[n] = *(const u32x4*)(src + (size_t)(tid + NTHR * n) * 16); }
    for (int it = F.c; it < 1024; it += F.G) {
        const int xcd = it & 7, jj = it >> 3, slab = 4 * xcd + (jj & 3), b = jj >> 2;
        __syncthreads();
#pragma unroll
        for (int n = 0; n < 8; ++n) {
            const u32x4 w = pv[n]; u32x4 lo, hi;
            { const f32x4 a = fp8x4_to_f32(w.x), c = fp8x4_to_f32(w.y); lo = (u32x4){cvt_pk_bf16(a[0], a[1]), cvt_pk_bf16(a[2], a[3]), cvt_pk_bf16(c[0], c[1]), cvt_pk_bf16(c[2], c[3])}; }
            { const f32x4 a = fp8x4_to_f32(w.z), c = fp8x4_to_f32(w.w); hi = (u32x4){cvt_pk_bf16(a[0], a[1]), cvt_pk_bf16(a[2], a[3]), cvt_pk_bf16(c[0], c[1]), cvt_pk_bf16(c[2], c[3])}; }
            *(LAS u32x4*)(L + (tid + NTHR * n) * 32) = lo; *(LAS u32x4*)(L + (tid + NTHR * n) * 32 + 16) = hi; }
        __syncthreads();
        if (it + F.G < 1024) { const int it1 = it + F.G, xcd1 = it1 & 7, jj1 = it1 >> 3, slab1 = 4 * xcd1 + (jj1 & 3), b1 = jj1 >> 2; const unsigned char* src = (const unsigned char*)PA + (size_t)(b1 * 32 + slab1) * 65536;
#pragma unroll
            for (int n = 0; n < 8; ++n) pv[n] = *(const u32x4*)(src + (size_t)(tid + NTHR * n) * 16); }
#pragma unroll 1
        for (int rr = 0; rr < 4; ++rr) {
            const int r = w + 8 * rr;
            f32x4 acc[8];
#pragma unroll
            for (int i = 0; i < 8; ++i) acc[i] = (f32x4){0.f, 0.f, 0.f, 0.f};
            s16x4 tr[8];
            {   unsigned aa[4];
#pragma unroll
                for (int ks = 0; ks < 4; ++ks) { const int ri = ks >> 1, c0 = 32 * (ks & 1) + 8 * fq + (fr >> 2); aa[ks] = lbase + (unsigned)((r * 64 + c0) * 64 + ri * 32 + (fr & 3) * 8); }
                tr_read8(aa[0], aa[1], aa[2], aa[3], 4u * 64u, tr); }
#pragma unroll
            for (int ks = 0; ks < 4; ++ks) {
                const int ri = ks >> 1;
                const bf16x8 af = cat4(tr[2 * ks], tr[2 * ks + 1]);
#pragma unroll
                for (int nt = 0; nt < 8; ++nt) { const int ro = nt >> 2, k2 = 16 * (nt & 3) + fr;
                    u32x4 bw = *(const LAS u32x4*)(L + ((ro == ri) ? FO_C : FO_S) + (k2 * 64 + 32 * (ks & 1) + 8 * fq) * 2);
                    if (ro == 1 && ri == 0) { bw.x ^= 0x80008000u; bw.y ^= 0x80008000u; bw.z ^= 0x80008000u; bw.w ^= 0x80008000u; }
                    acc[nt] = __builtin_amdgcn_mfma_f32_16x16x32_bf16(af, *(bf16x8*)&bw, acc[nt], 0, 0, 0); }
            }
#pragma unroll
            for (int nt = 0; nt < 8; ++nt) { const int ro = nt >> 2, k2 = 16 * (nt & 3) + fr;
                *(LAS u32x2*)(L + (r * 64 + k2) * 64 + ro * 32 + fq * 8) = (u32x2){cvt_pk_bf16(acc[nt][0], acc[nt][1]), cvt_pk_bf16(acc[nt][2], acc[nt][3])}; }
        }
        __syncthreads();
#pragma unroll 1
        for (int kk = 0; kk < 8; ++kk) {
            const int k2 = 8 * w + kk;
            f32x4 a2[2] = {(f32x4){0.f, 0.f, 0.f, 0.f}, (f32x4){0.f, 0.f, 0.f, 0.f}};
            s16x4 t4[4];
            {   const int r0 = 8 * fq + (fr >> 2); const unsigned a0 = lbase + (unsigned)((r0 * 64 + k2) * 64 + (fr & 3) * 8);
                tr_read4(a0, a0 + 32u, 4u * 64u * 64u, t4); }
#pragma unroll
            for (int ks = 0; ks < 2; ++ks) {
                const bf16x8 af = cat4(t4[2 * ks], t4[2 * ks + 1]);
                a2[0] = __builtin_amdgcn_mfma_f32_16x16x32_bf16(af, Gf[0][ks], a2[0], 0, 0, 0);
                a2[1] = __builtin_amdgcn_mfma_f32_16x16x32_bf16(af, Gf[1][ks], a2[1], 0, 0, 0);
            }
#pragma unroll
            for (int nt = 0; nt < 2; ++nt) { const int k1 = 16 * nt + fr;
                *(unsigned*)(Y + (size_t)(b * 2048 + k1 * 64 + k2) * 1024 + slab * 16 + 4 * fq) = cvt_pk4_fp8(a2[nt][0], a2[nt][1], a2[nt][2], a2[nt][3]); }
        }
    }
    __syncthreads();
}

struct Args { const float* in[22]; float* out; unsigned char* ws; int ph_lo, ph_hi; };
constexpr int N_PHASES = 9 + 3 * NCH;

__global__ void __launch_bounds__(NTHR, 2) mega_fwd(Args args) {
    extern __shared__ __attribute__((aligned(16))) unsigned char lds_raw[];
    Frame F;
    F.lds = (LAS unsigned char*)lds_raw;
    F.tid = threadIdx.x; F.lane = F.tid & 63; F.wave = __builtin_amdgcn_readfirstlane(F.tid >> 6);
    F.G = gridDim.x; F.c = blockIdx.x;
    F.in = args.in;
    F.out = args.out; F.ws = args.ws; F.ctl = (unsigned*)(args.ws + WS_CTL);
    volatile LAS unsigned* misc = (volatile LAS unsigned*)(F.lds + LDS_MISC);
    if (F.tid < 4) misc[F.tid] = 0u;
    __syncthreads();
    XcdBarrier bar = xcd_barrier_post(F.ctl, misc);
    const int lo = args.ph_lo, hi = args.ph_hi;
#ifndef PHASE_MASK
#define PHASE_MASK 0xFFFFFFFFu
#endif
#define IN(k) ((((PHASE_MASK) >> (k)) & 1u) && lo <= (k) && (k) < hi)
#define SEAM(k) do { if (IN(k) && IN((k) + 1)) xcd_barrier(bar); } while (0)
#ifndef REP_MASK
#define REP_MASK 0u
#endif
#define REPS(b) ((((REP_MASK) >> (b)) & 1u) ? 2 : 1)
#define REPBAR(b, r) do { if ((((REP_MASK) >> (b)) & 1u) && (r) == 0) xcd_barrier(bar); } while (0)
    unsigned char* ws = F.ws;
    LAS unsigned char* blk_e = F.lds + LDS_MISC + 64;
#ifdef PR_A
    unsigned long long* stamps = (unsigned long long*)(ws + 980 * MiB);
#define STAMP(slot) do { if (F.tid == 0) stamps[(slot) * 256 + F.c] = __builtin_amdgcn_s_memrealtime(); } while (0)
#else
#define STAMP(slot) do { } while (0)
#endif
    STAMP(0);

    if (IN(0)) { for (int r = 0; r < REPS(0); ++r) { p0_ada(F); p0_fold(F); p0_convert(F); REPBAR(0, r); } }
    STAMP(1);
    SEAM(0);
    if (IN(1)) { for (int r = 0; r < REPS(1); ++r) { p1_uprep(F); REPBAR(1, r); } }
    STAMP(2);
    SEAM(1);
    if (IN(2)) {
        ProbP1 P{(const char*)(ws + WS_U), 8, 1024u, 1024u, (const char*)(ws + WS_WIN1T), (unsigned)(WS_UC - WS_U), F.G, F.c};
        EpiP1 E{(bf16_t*)(ws + WS_PA), (bf16_t*)(ws + WS_PH), (bf16_t*)(ws + WS_PHC)};
        for (int r = 0; r < REPS(2); ++r) { pg8::gemm_phase<ProbP1, EpiP1, true, false, true>(F.lds, P, E); REPBAR(2, r); }
    }
    STAMP(3);
    SEAM(2);
    if (IN(3)) {
#ifndef NO_FOURIER
        for (int r = 0; r < REPS(4); ++r) { p4_fourier(F); REPBAR(4, r); }
        STAMP(5);
#endif
#ifndef NO_SCAN
        for (int r = 0; r < REPS(3); ++r) { p3_scan(F, r + 1 < REPS(3)); REPBAR(3, r); }
        STAMP(4);
#endif
#ifndef NO_P2GEMM
        ProbDense P{(const char*)(ws + WS_U), 8, 1024u, 1024u, (const char*)(ws + WS_WIN2T), 256, 10, F.G, F.c, 0};
        EpiP2 E{(unsigned char*)(ws + WS_PG), (unsigned char*)F.out};
        for (int r = 0; r < REPS(5); ++r) { pg8::gemm_phase<ProbDense, EpiP2, true, false, true>(F.lds, P, E); REPBAR(5, r); }
#endif
    }
    STAMP(6);
    SEAM(3);
    if (IN(4)) { for (int r = 0; r < REPS(6); ++r) { p6_readout(F); REPBAR(6, r); } }
    STAMP(7);
    SEAM(4);
    if (IN(5)) {
        ProbDense P{(const char*)(ws + WS_Y), 8, 1024u, 1024u, (const char*)(ws + WS_WMT), 256, 4, F.G, F.c, 1};
        EpiM1 E{(const unsigned char*)F.out, (unsigned char*)(ws + WS_PA)};
        for (int r = 0; r < REPS(7); ++r) { pg8::gemm_phase<ProbDense, EpiM1, true, true, true>(F.lds, P, E); REPBAR(7, r); }
    }
    STAMP(8);
    SEAM(5);
    if (IN(6)) {
        ProbDense P{(const char*)(ws + WS_PA), 8, 1024u, 1024u, (const char*)(ws + WS_WOT), 256, 4, F.G, F.c, 0};
        EpiM2 E{(const float*)(ws + WS_ADA), (unsigned char*)F.out};
        for (int r = 0; r < REPS(8); ++r) { pg8::gemm_phase<ProbDense, EpiM2, true, false, true>(F.lds, P, E); REPBAR(8, r); }
    }
    STAMP(9);
    SEAM(6);
    if (IN(7)) { for (int r = 0; r < REPS(9); ++r) { p9_ln1_router(fresh(F), r + 1 < REPS(9)); REPBAR(9, r); } }
    STAMP(10);
    SEAM(7);
    if (IN(8)) { p10_dispatch(F); }
    STAMP(11);
    SEAM(8);
#pragma unroll
    for (int ch = 0; ch < NCH; ++ch) {
        if (IN(9 + 3 * ch)) {
            const int nblk = moe_blocks(F, ch, blk_e);
            ProbMoE<true> P{(const char*)(ws + WS_U), 8, 1024u, 1024u, (const char*)(ws + WS_WGUT), (size_t)2048 * 1024, 8, nblk, F.G, F.c, (const int*)(ws + WS_ROWTOK) + (size_t)ch * ROWS_CH, blk_e};
            EpiGU E{F.in[I_BGU], (unsigned char*)(ws + WS_ACT)};
#ifdef GU_DRY
            pg8::gemm_phase<ProbMoE<true>, EpiGU, true, false, true, GU_DRY>(F.lds, P, E); xcd_barrier(bar);
#endif
            for (int r = 0; r < (ch == 0 ? REPS(10) : 1); ++r) { pg8::gemm_phase<ProbMoE<true>, EpiGU, true, false, true>(F.lds, P, E); if (ch == 0) REPBAR(10, r); }
        }
        STAMP(12);
        SEAM(9 + 3 * ch);
        if (IN(10 + 3 * ch)) {
            const int nblk = moe_blocks(F, ch, blk_e);
            ProbMoE<false> P{(const char*)(ws + WS_ACT), 8, 1024u, 1024u, (const char*)(ws + WS_WDNT), (size_t)1024 * 1024, 4, nblk, F.G, F.c, nullptr, blk_e};
            EpiDN E{F.in[I_BDN], (unsigned char*)(ws + WS_YCH)};
            for (int r = 0; r < (ch == 0 ? REPS(11) : 1); ++r) { pg8::gemm_phase<ProbMoE<false>, EpiDN, true, false, true>(F.lds, P, E); if (ch == 0) REPBAR(11, r); }
        }
        STAMP(13);
        SEAM(10 + 3 * ch);
        if (IN(11 + 3 * ch)) { for (int r = 0; r < (ch == 0 ? REPS(12) : 1); ++r) { p13_combine_ln2(F, ch, ch == 0 && r + 1 < REPS(12)); if (ch == 0) REPBAR(12, r); } }
        STAMP(14);
        SEAM(11 + 3 * ch);
    }
#ifdef DBG_K
    xcd_barrier(bar);
    {
        const unsigned char* buf = (DBG_OUT) ? (const unsigned char*)F.out : (const unsigned char*)(ws + (size_t)(DBG_OFF));
        const size_t wpr = (size_t)(DBG_CW) / 4, nw = (size_t)(DBG_ROWS) * wpr;
        unsigned long long cs = 0; unsigned bad = 0;
        for (size_t i = (size_t)F.c * NTHR + F.tid; i < nw; i += (size_t)F.G * NTHR) { const size_t r = i / wpr, cw = i % wpr; const unsigned w = *(const unsigned*)(buf + r * (size_t)(DBG_LD) + (DBG_C0) + cw * 4); cs += w;
            if (DBG_F32) { if ((w & 0x7f800000u) == 0x7f800000u) ++bad; } else { if ((w & 0x7f80u) == 0x7f80u) ++bad; if ((w & 0x7f800000u) == 0x7f800000u) ++bad; } }
        for (int o = 32; o >= 1; o >>= 1) { cs += __shfl_xor(cs, o); bad += __shfl_xor(bad, o); }
        if (F.lane == 0) { atomicAdd((unsigned long long*)(F.ctl + 8192), cs); atomicAdd(F.ctl + 8200, bad); }
        if (F.c == 0 && F.tid == 0) atomicAdd(F.ctl + 8201, xb_ld(&F.ctl[XB_TMO]));
    }
    xcd_barrier(bar);
    {
        const unsigned long long cs = __hip_atomic_load((unsigned long long*)(F.ctl + 8192), __ATOMIC_RELAXED, __HIP_MEMORY_SCOPE_AGENT);
        const unsigned bad = xb_ld(F.ctl + 8200), tmo = xb_ld(F.ctl + 8201);
        const float val = (float)(unsigned)((cs ^ (cs >> 16) ^ (cs >> 32)) & 0xFFFFu) * (1.0f / 65536.0f) + (bad ? 2.0f : 0.0f) + (tmo ? 4.0f : 0.0f);
        for (size_t i = (size_t)F.c * NTHR + F.tid; i < (size_t)T * D; i += (size_t)F.G * NTHR) F.out[i] = val;
    }
    return;
#endif
#ifdef PR_A
    xcd_barrier(bar);
    {
        auto maxs = [&](int sl) { unsigned long long m = 0; for (int w = 0; w < (int)F.G; ++w) { const unsigned long long v = stamps[sl * 256 + w]; m = v > m ? v : m; } return m; };
        auto dur = [&](int sl) -> float {
            if (sl == 4) { const unsigned long long st = maxs(3); double a = 0; for (int w = 0; w < (int)F.G; ++w) a += (double)(stamps[4 * 256 + w] - st); return (float)(a / F.G) * 0.01f; }
            if (sl == 5) { double a = 0; for (int w = 0; w < (int)F.G; ++w) a += (double)(stamps[5 * 256 + w] - stamps[4 * 256 + w]); return (float)(a / F.G) * 0.01f; }
            if (sl == 6) { double a = 0; for (int w = 0; w < (int)F.G; ++w) a += (double)(stamps[6 * 256 + w] - stamps[5 * 256 + w]); return (float)(a / F.G) * 0.01f; }
            if (sl == 16) return (float)(maxs(6) - maxs(3)) * 0.01f;
            return (float)(maxs(sl) - maxs(sl - 1)) * 0.01f; };
        const float va = rintf(dur(PR_A) * 0.1f + (PR_OFF)) * 0.1f, vb = rintf(dur(PR_B) * 0.1f + (PR_OFF)) * 10.0f;
        for (size_t i = (size_t)F.c * NTHR + F.tid; i < (size_t)T * D; i += (size_t)F.G * NTHR) F.out[i] = va;
        __syncthreads();
        if (F.c == 0 && F.tid == 0) F.out[12345] = vb;
    }
    return;
#endif
    if (F.c == 0 && F.tid == 0 && hi == N_PHASES) { if (xb_ld(&F.ctl[XB_TMO]) != 0u) F.out[0] = __builtin_nanf(""); }
#undef IN
#undef SEAM
}

extern "C" void kernel_launch(void* const* d_in, const int* in_sizes, int n_in, void* d_out, int out_size, void* d_ws, size_t ws_size, hipStream_t stream) {
    static int grid = 0;
    if (grid == 0) {
        if (n_in != 22 || out_size != T * D || ws_size < WS_END) { fprintf(stderr, "kernel_launch: unexpected shapes (n_in %d, out %d, ws %zu)\n", n_in, out_size, ws_size); grid = -1; return; }
        int dev = 0, cus = 0, per_cu = 0;
        if (hipGetDevice(&dev) != hipSuccess || hipDeviceGetAttribute(&cus, hipDeviceAttributeMultiprocessorCount, dev) != hipSuccess) { grid = -1; return; }
        if (hipFuncSetAttribute((const void*)mega_fwd, hipFuncAttributeMaxDynamicSharedMemorySize, LDS_BYTES) != hipSuccess) { fprintf(stderr, "kernel_launch: hipFuncSetAttribute failed\n"); grid = -1; return; }
        if (hipOccupancyMaxActiveBlocksPerMultiprocessor(&per_cu, (const void*)mega_fwd, NTHR, LDS_BYTES) != hipSuccess || per_cu < 1) fprintf(stderr, "kernel_launch: occupancy query reports %d blocks per CU\n", per_cu);
        (void)hipGetLastError();
        grid = cus;
    }
    if (grid < 0) return;
    (void)hipMemsetAsync((char*)d_ws + WS_CTL, 0, CTL_BYTES, stream);
    Args a{};
    for (int i = 0; i < 22; ++i) a.in[i] = (const float*)d_in[i];
    a.out = (float*)d_out; a.ws = (unsigned char*)d_ws; a.ph_lo = 0; a.ph_hi = N_PHASES;
#ifdef DBG_K
    a.ph_hi = DBG_K;
#endif
    hipLaunchKernelGGL(mega_fwd, dim3(grid), dim3(NTHR), LDS_BYTES, stream, a);
}
```

```cpp
#include <hip/hip_runtime.h>
#include <cstdio>
#include <cstdint>

#define LAS __attribute__((address_space(3)))
typedef unsigned short bf16_t;
typedef short bf16x8 __attribute__((ext_vector_type(8)));
typedef short bf16x4 __attribute__((ext_vector_type(4)));
typedef float f32x4 __attribute__((ext_vector_type(4)));
typedef float f32x2 __attribute__((ext_vector_type(2)));
typedef unsigned u32x4 __attribute__((ext_vector_type(4)));
typedef unsigned u32x2 __attribute__((ext_vector_type(2)));

constexpr int D = 1024, NB = 32, SEQ = 2048, T = NB * SEQ, CTX = 256, TCX = NB * CTX;
#ifndef NCH_SET
#define NCH_SET 1
#endif
constexpr int NEXP = 32, TOPK = 4;
constexpr int NCH = NCH_SET, TCH = T / NCH;
constexpr int ROWS_CH = TCH * TOPK + NEXP * 256;
constexpr float DN_ALPHA = 1.189207115002721f;
constexpr float LN_EPS = 1e-5f, RMS_EPS = 1e-6f;
constexpr int NTHR = 512;

constexpr size_t MiB = 1ull << 20;
constexpr size_t WS_CTL = 0;
constexpr size_t CTL_BYTES = 65536;
constexpr size_t WS_ADA = 65536;
constexpr size_t WS_WIN1T = 1 * MiB;
constexpr size_t WS_WIN2T = 7 * MiB;
constexpr size_t WS_WMT = 12 * MiB;
constexpr size_t WS_WOT = 14 * MiB;
constexpr size_t WS_WGUT = 16 * MiB;
constexpr size_t WS_WDNT = 80 * MiB;
constexpr size_t WS_TOPI = 112 * MiB;
constexpr size_t WS_TOPW = 113 * MiB;
constexpr size_t WS_POS = 114 * MiB;
constexpr size_t WS_ROWTOK = 115 * MiB;
constexpr size_t WS_U = 120 * MiB;
constexpr size_t WS_PA = 184 * MiB;
constexpr size_t WS_PH = 312 * MiB;
constexpr size_t WS_PHC = 568 * MiB;
constexpr size_t WS_PG = 600 * MiB;
constexpr size_t WS_Y = 664 * MiB;
constexpr size_t WS_UC = WS_Y;
constexpr size_t WS_ACT = WS_PA;
constexpr size_t WS_YCH = WS_PA + 264 * MiB;
constexpr size_t WS_X1 = WS_YCH + 264 * MiB;
constexpr size_t WS_END = 976 * MiB;
static_assert(WS_X1 + 128 * MiB <= WS_END && (size_t)ROWS_CH * 1024 <= 264 * MiB && WS_Y + 128 * MiB <= WS_END, "ws map");
constexpr int CW_CNT = 4096;
constexpr int CW_CUR = 4096 + 64;

constexpr int LDS_SCRATCH = 155648;
constexpr int LDS_MISC = LDS_SCRATCH;
constexpr int LDS_BYTES = LDS_SCRATCH + 2048;

typedef __bf16 bf16x2_t __attribute__((ext_vector_type(2)));
__device__ __forceinline__ unsigned cvt_pk_bf16(float lo, float hi) { const f32x2 v = {lo, hi}; const bf16x2_t r = __builtin_convertvector(v, bf16x2_t); return __builtin_bit_cast(unsigned, r); }
__device__ __forceinline__ unsigned cvt_pk4_fp8(float a, float b, float c, float d) {
    a = fminf(fmaxf(a, -448.f), 448.f); b = fminf(fmaxf(b, -448.f), 448.f); c = fminf(fmaxf(c, -448.f), 448.f); d = fminf(fmaxf(d, -448.f), 448.f);
    int w = __builtin_amdgcn_cvt_pk_fp8_f32(a, b, 0, false); w = __builtin_amdgcn_cvt_pk_fp8_f32(c, d, w, true); return (unsigned)w; }
constexpr float W8_SCALE = 32.0f, W8_INV = 1.0f / 32.0f;
typedef float f32x2v __attribute__((ext_vector_type(2)));
__device__ __forceinline__ f32x4 fp8x4_to_f32(unsigned w) { const f32x2v a = __builtin_amdgcn_cvt_pk_f32_fp8((int)w, false), b = __builtin_amdgcn_cvt_pk_f32_fp8((int)w, true); return (f32x4){a[0], a[1], b[0], b[1]}; }
__device__ __forceinline__ u32x4 widen16(u32x2 a, u32x2 b) {
    const u32x2 rx = __builtin_amdgcn_permlane16_swap(a.x, b.x, false, false), ry = __builtin_amdgcn_permlane16_swap(a.y, b.y, false, false);
    return (u32x4){rx[0], ry[0], rx[1], ry[1]}; }
__device__ __forceinline__ void unwiden16(u32x4 L, u32x2& a, u32x2& b) {
    const u32x2 rx = __builtin_amdgcn_permlane16_swap(L.x, L.z, false, false), ry = __builtin_amdgcn_permlane16_swap(L.y, L.w, false, false);
    a = (u32x2){rx[0], ry[0]}; b = (u32x2){rx[1], ry[1]}; }
__device__ __forceinline__ unsigned pack4_u8(float a, float b, float c, float d) {
    unsigned w = __builtin_amdgcn_cvt_pk_u8_f32(__builtin_rintf(a), 0, 0u); w = __builtin_amdgcn_cvt_pk_u8_f32(__builtin_rintf(b), 1, w);
    w = __builtin_amdgcn_cvt_pk_u8_f32(__builtin_rintf(c), 2, w); return __builtin_amdgcn_cvt_pk_u8_f32(__builtin_rintf(d), 3, w); }
__device__ __forceinline__ f32x4 u8x4_to_f32(unsigned w) { return (f32x4){(float)(w & 0xffu), (float)((w >> 8) & 0xffu), (float)((w >> 16) & 0xffu), (float)(w >> 24)}; }
__device__ __forceinline__ float bf_lo(unsigned w) { return __uint_as_float(w << 16); }
__device__ __forceinline__ float bf_hi(unsigned w) { return __uint_as_float(w & 0xffff0000u); }
__device__ __forceinline__ float bf2f(bf16_t v) { return __uint_as_float(((unsigned)v) << 16); }
__device__ __forceinline__ float fast_exp(float x) { return __builtin_amdgcn_exp2f(x * 1.4426950408889634f); }
__device__ __forceinline__ float fast_sigmoid(float x) { return __builtin_amdgcn_rcpf(1.0f + fast_exp(-x)); }
__device__ __forceinline__ float fast_log(float x) { return __builtin_amdgcn_logf(x) * 0.6931471805599453f; }

#define XB_TMO      128
#define XB_XCNT(j)  (256  + 64 * (j))
#define XB_XSUB(j)  (1280 + 64 * (j))
#define XB_XGEN(j)  (2304 + 64 * (j))
#define XB_TOP      3328
#define XB_TOPGEN   3392
#define XCD_BAR_WORDS 3456
#define XB_SPIN_CAP (1u << 18)

__device__ __forceinline__ unsigned xb_ld(unsigned* p)              { return __hip_atomic_load(p, __ATOMIC_RELAXED, __HIP_MEMORY_SCOPE_AGENT); }
__device__ __forceinline__ unsigned xb_add(unsigned* p, unsigned v) { return __hip_atomic_fetch_add(p, v, __ATOMIC_RELAXED, __HIP_MEMORY_SCOPE_AGENT); }
__device__ __forceinline__ unsigned xb_xcc_id() { return (unsigned)__builtin_amdgcn_s_getreg((3 << 11) | 20) & 0xFu; }
#define XB_SPIN(cond, bar) do { unsigned _sp = 0; while (cond) { __builtin_amdgcn_s_sleep(1); \
    if ((++_sp & 255u) == 0u) { if (xb_ld(&(bar)[XB_TMO])) break; if (_sp > XB_SPIN_CAP) { atomicAdd(&(bar)[XB_TMO], 1u); break; } } } } while (0)

struct XcdBarrier { unsigned* bar; unsigned x; volatile LAS unsigned* st; };

__device__ __forceinline__ XcdBarrier xcd_barrier_post(unsigned* bar, volatile LAS unsigned* st) {
    XcdBarrier b; b.bar = bar; b.x = xb_xcc_id(); b.st = st;
    if (threadIdx.x == 0) (void)xb_add(&bar[XB_XCNT(b.x)], 1u);
    return b;
}
__device__ __forceinline__ void xcd_barrier_complete(unsigned* bar, unsigned x, unsigned& nloc, unsigned& nx) {
    const unsigned G = gridDim.x * gridDim.y * gridDim.z;
    unsigned sum, cnt, mine, sp = 0u;
    for (;;) {
        sum = 0u; cnt = 0u; mine = 0u;
#pragma unroll
        for (unsigned j = 0; j < 16; ++j) { const unsigned c = xb_ld(&bar[XB_XCNT(j)]); sum += c; cnt += (c > 0u) ? 1u : 0u; mine = (j == x) ? c : mine; }
        if (sum == G) break;
        __builtin_amdgcn_s_sleep(1);
        if ((++sp & 255u) == 0u) { if (xb_ld(&bar[XB_TMO])) break; if (sp > XB_SPIN_CAP) { atomicAdd(&bar[XB_TMO], 1u); break; } }
    }
    nloc = mine > 0u ? mine : 1u; nx = cnt > 0u ? cnt : 1u;
}
__device__ __forceinline__ void xcd_barrier(const XcdBarrier& b) {
    asm volatile("s_waitcnt vmcnt(0)" ::: "memory");
    __syncthreads();
    if (threadIdx.x == 0) {
        unsigned* bar = b.bar;
        __builtin_amdgcn_s_waitcnt(0);
        unsigned nloc = b.st[0], nx = b.st[1];
        if (nloc == 0u) { xcd_barrier_complete(bar, b.x, nloc, nx); b.st[0] = nloc; b.st[1] = nx; }
        const unsigned old = xb_add(&bar[XB_XSUB(b.x)], 1u);
        const unsigned gen = old / nloc;
        if (old + 1u == (gen + 1u) * nloc) {
            __builtin_amdgcn_fence(__ATOMIC_RELEASE, "agent");
            asm volatile("s_waitcnt vmcnt(0)" ::: "memory");
            const unsigned og = xb_add(&bar[XB_TOP], 1u);
            const unsigned tg = og / nx;
            if (og + 1u == (tg + 1u) * nx) xb_add(&bar[XB_TOPGEN], 1u);
            else XB_SPIN(xb_ld(&bar[XB_TOPGEN]) == tg, bar);
            __builtin_amdgcn_fence(__ATOMIC_ACQUIRE, "agent");
            xb_add(&bar[XB_XGEN(b.x)], 1u);
            asm volatile("s_waitcnt vmcnt(0)" ::: "memory");
        } else {
            XB_SPIN(xb_ld(&bar[XB_XGEN(b.x)]) == gen, bar);
            __builtin_amdgcn_fence(__ATOMIC_ACQUIRE, "agent");
            asm volatile("s_waitcnt vmcnt(0)" ::: "memory");
        }
    }
    __syncthreads();
}

#ifndef WGM_SET
#define WGM_SET 8
#endif
namespace pg8 {
constexpr int BM = 256, BK = 64, HALF = 128, HTB = HALF * BK * 2, STAGE_BYTES = 8 * HTB, NXCD = 8, WGM = WGM_SET;
__host__ __device__ __forceinline__ int lds_byte(int r, int c) { const int st = (r >> 4) * 2 + (c >> 5), rr = r & 15, cc = c & 31, ob = rr * 64 + cc * 2; return st * 1024 + (ob ^ (((ob >> 9) & 1) << 5)); }
__host__ __device__ __forceinline__ void stage_rc(int b, int& R, int& C) { const int st = b / 1024, sb = b % 1024, swz = sb ^ (((sb >> 9) & 1) << 5); R = (st >> 1) * 16 + swz / 64; C = (st & 1) * 32 + (swz % 64) / 2; }
__host__ __device__ __forceinline__ int perm32(int rho) { const int n = rho >> 4, i = rho & 15; return 8 * (i >> 2) + 4 * n + (i & 3); }

struct Unit { int pm, pn, aux; };

__device__ __forceinline__ void grouped(int wgid, int nM, int nN, int& pm, int& pn) {
    const int nig = WGM * nN, gid = wgid / nig, fm = gid * WGM, gsz = (nM - fm) < WGM ? (nM - fm) : WGM;
    pm = fm + ((wgid % nig) % gsz); pn = (wgid % nig) / gsz;
}
__device__ __forceinline__ bool xcd_remap(int i, int G, int c, int nwg, int& wgid) {
    const long L = (long)i * G + c; if (L >= nwg) return false;
    wgid = (int)L; const int q = nwg / NXCD, r = nwg % NXCD, xcd = wgid % NXCD, off = wgid / NXCD;
    wgid = (xcd < r ? xcd * (q + 1) : r * (q + 1) + (xcd - r) * q) + off; return true;
}

typedef int i32x8 __attribute__((ext_vector_type(8)));
typedef int i32x4 __attribute__((ext_vector_type(4)));
template <bool F8> struct Frags;
template <> struct Frags<false> { bf16x8 a[4][2], b0[2][2], b1[2][2]; };
template <> struct Frags<true> { i32x8 a[4], b0[2], b1[2]; };
template <class Prob, class Epi, bool ALIGN_EPI, bool HOOK, bool FP8 = false, int DRY = 0>
__device__ __forceinline__ void gemm_phase(LAS unsigned char* lds, const Prob& P, const Epi& E) {
    int tid_ = threadIdx.x; asm volatile("" : "+v"(tid_));
    const int tid = tid_, wid = __builtin_amdgcn_readfirstlane(tid >> 6), lane = tid & 63, wr = wid >> 2, wc = wid & 3, fr = lane & 15, fq = lane >> 4;
    const int nt = P.nt;
    unsigned voffB[2], voffA[2];
#pragma unroll
    for (int i = 0; i < 2; ++i) { int R, C; stage_rc(tid * 16 + i * 8192, R, C); const int Rb = Epi::PERM ? ((R & ~31) + perm32(R & 31)) : R;
        voffB[i] = (unsigned)Rb * P.ldb2 + (unsigned)C * 2u; voffA[i] = (unsigned)R * P.lda2 + (unsigned)C * 2u; }
    auto gather_offs = [&](const Unit& u, unsigned (&o0)[2], unsigned (&o1)[2]) {
#pragma unroll
        for (int i = 0; i < 2; ++i) { int R, C; int tt = threadIdx.x; asm volatile("" : "+v"(tt)); stage_rc(tt * 16 + i * 8192, R, C); o0[i] = P.a_row(u, R) + (unsigned)C * 2u; o1[i] = P.a_row(u, HALF + R) + (unsigned)C * 2u; } };
    const size_t kstep = (size_t)(BK * 2);
    const size_t hstepB = (size_t)HALF * P.ldb2;
    const size_t hstepA = (size_t)HALF * P.lda2;
    const unsigned ldsw = (unsigned)wid * 1024u;
    const int aoff = lds_byte(wr * 64 + fr, fq * 8), boff = lds_byte(wc * 32 + fr, fq * 8);
#define PG8_SA(b, h) (((b) * 2 + (h)) * HTB)
#define PG8_SB(b, h) ((4 + (b) * 2 + (h)) * HTB)
#define PG8_STAGE(bufoff, gbase, voff) do { if constexpr ((DRY & 2) == 0) _Pragma("unroll") for (int _i = 0; _i < 2; ++_i) \
        __builtin_amdgcn_global_load_lds((const unsigned*)((const char*)(gbase) + (voff)[_i]), (LAS unsigned*)(lds + (bufoff) + ldsw + _i * 8192), 16, 0, 0); } while (0)
#define PG8_LDA(dst, b, h) do { if constexpr (FP8) { _Pragma("unroll") for (int m = 0; m < 4; ++m) { FR.a[m].lo = *(const LAS i32x4*)(lds + PG8_SA(b, h) + aoff + m * 2048); FR.a[m].hi = *(const LAS i32x4*)(lds + PG8_SA(b, h) + aoff + m * 2048 + 1024); } } \
        else { _Pragma("unroll") for (int m = 0; m < 4; ++m) _Pragma("unroll") for (int k = 0; k < 2; ++k) FR.a[m][k] = *(const LAS bf16x8*)(lds + PG8_SA(b, h) + aoff + m * 2048 + k * 1024); } } while (0)
#define PG8_LDB(dst, b, h) do { if constexpr (FP8) { _Pragma("unroll") for (int n = 0; n < 2; ++n) { FR.dst[n].lo = *(const LAS i32x4*)(lds + PG8_SB(b, h) + boff + n * 2048); FR.dst[n].hi = *(const LAS i32x4*)(lds + PG8_SB(b, h) + boff + n * 2048 + 1024); } } \
        else { _Pragma("unroll") for (int n = 0; n < 2; ++n) _Pragma("unroll") for (int k = 0; k < 2; ++k) FR.dst[n][k] = *(const LAS bf16x8*)(lds + PG8_SB(b, h) + boff + n * 2048 + k * 1024); } } while (0)
#define PG8_MMA(ai, bj, At, Bt) do { __builtin_amdgcn_s_setprio(1); if constexpr ((DRY & 1) != 0) { asm volatile("" :: "v"(FR.a[0]), "v"(FR.a[3]), "v"(FR.Bt[0]), "v"(FR.Bt[1])); } else if constexpr (FP8) { _Pragma("unroll") for (int m = 0; m < 4; ++m) _Pragma("unroll") for (int n = 0; n < 2; ++n) \
            asm volatile("v_mfma_f32_16x16x128_f8f6f4 %0, %1, %2, %0" : "+v"(acc[ai][bj][m][n]) : "v"(FR.Bt[n]), "v"(FR.a[m])); } \
        else { _Pragma("unroll") for (int m = 0; m < 4; ++m) _Pragma("unroll") for (int n = 0; n < 2; ++n) _Pragma("unroll") for (int k = 0; k < 2; ++k) \
        acc[ai][bj][m][n] = __builtin_amdgcn_mfma_f32_16x16x32_bf16(FR.Bt[n][k], FR.a[m][k], acc[ai][bj][m][n], 0, 0, 0); } __builtin_amdgcn_s_setprio(0); } while (0)
#define PG8_WAIT_V(n) asm volatile("s_waitcnt vmcnt(" #n ")" ::: "memory")
#define PG8_WAIT_L(n) asm volatile("s_waitcnt lgkmcnt(" #n ")" ::: "memory")
#define PG8_BAR __builtin_amdgcn_s_barrier()
#define PG8_SCHED __builtin_amdgcn_sched_barrier(0)
    Unit cur, nxt; int ui = 0;
    if (!P.unit(0, cur)) return;
    f32x4 acc[2][2][4][2];
#pragma unroll
    for (int a = 0; a < 2; ++a)
#pragma unroll
        for (int b = 0; b < 2; ++b)
#pragma unroll
            for (int m = 0; m < 4; ++m)
#pragma unroll
                for (int n = 0; n < 2; ++n) acc[a][b][m][n] = (f32x4){0.f, 0.f, 0.f, 0.f};
    Frags<FP8> FR;
    unsigned va0[2], va1[2], vn0[2], vn1[2];
    const char* const gA = P.Abase; const char* cA = gA; const char* nA = gA; const char* cB = P.b_tile(cur);
    if constexpr (Prob::GATHER) {
        gather_offs(cur, va0, va1);
    } else { cA = gA + P.a_row(cur, 0); }
#define PG8_STAGE_A(bufoff, h, koff, nx) do { if constexpr (Prob::GATHER) { unsigned _v[2]; _Pragma("unroll") for (int _i = 0; _i < 2; ++_i) _v[_i] = (nx) ? ((h) ? vn1[_i] : vn0[_i]) : ((h) ? va1[_i] : va0[_i]); PG8_STAGE(bufoff, gA + (koff), _v); } \
        else { PG8_STAGE(bufoff, ((nx) ? nA : cA) + (h) * hstepA + (koff), voffA); } } while (0)
    PG8_STAGE(PG8_SB(0, 0), cB, voffB); PG8_STAGE(PG8_SB(0, 1), cB + hstepB, voffB); PG8_STAGE_A(PG8_SA(0, 0), 0, 0, false); PG8_STAGE_A(PG8_SA(0, 1), 1, 0, false);
    if (wr == 1) PG8_BAR;
    PG8_WAIT_V(2); PG8_BAR;
    PG8_STAGE(PG8_SB(1, 0), cB + kstep, voffB); PG8_STAGE_A(PG8_SA(1, 0), 0, kstep, false); PG8_STAGE(PG8_SB(1, 1), cB + hstepB + kstep, voffB);
    PG8_WAIT_V(6); PG8_BAR;
    Unit nx2; unsigned vq0[2], vq1[2]; bool has_next = P.unit(1, nxt);
    if (!has_next) nxt = cur;
    if constexpr (Prob::GATHER) gather_offs(nxt, vn0, vn1);
    for (;;) {
        if constexpr (!Prob::GATHER) { has_next = P.unit(ui + 1, nxt); if (!has_next) nxt = cur; nA = gA + P.a_row(nxt, 0); }
        const char* nB = P.b_tile(nxt);
        for (int t = 0; t < nt; t += 2) {
            const bool last = (t == nt - 2);
            if constexpr (HOOK) { if (t == (nt >> 1)) { if constexpr (FP8) asm volatile("s_nop 15\n\ts_nop 15" ::: "memory"); E.mid(acc, cur, wr, wc, fr, fq); } }
            const size_t k1 = (size_t)(t + 1) * kstep, k2 = last ? 0 : (size_t)(t + 2) * kstep, k3 = k2 + kstep;
            const char* b2 = last ? nB : cB + (size_t)(t + 2) * kstep; const char* b3 = b2 + kstep;
            PG8_LDB(b0, 0, 0); PG8_LDB(b1, 0, 1); PG8_SCHED; PG8_LDA(At, 0, 0); PG8_STAGE_A(PG8_SA(1, 1), 1, k1, false);
            PG8_WAIT_V(8); PG8_WAIT_L(0); PG8_BAR; PG8_MMA(0, 0, At, b0); PG8_MMA(0, 1, At, b1); PG8_BAR; PG8_SCHED;
            PG8_LDA(At, 0, 1); PG8_STAGE(PG8_SB(0, 0), b2, voffB); PG8_STAGE(PG8_SB(0, 1), b2 + hstepB, voffB); PG8_STAGE_A(PG8_SA(0, 0), 0, k2, last);
            PG8_WAIT_V(8); PG8_WAIT_L(0); PG8_BAR; PG8_MMA(1, 0, At, b0); PG8_MMA(1, 1, At, b1); PG8_BAR; PG8_SCHED;
            PG8_LDB(b0, 1, 0); PG8_LDB(b1, 1, 1); PG8_SCHED; PG8_LDA(At, 1, 0); PG8_STAGE_A(PG8_SA(0, 1), 1, k2, last);
            PG8_WAIT_V(8); PG8_WAIT_L(0); PG8_BAR; PG8_MMA(0, 0, At, b0); PG8_MMA(0, 1, At, b1); PG8_BAR; PG8_SCHED;
            PG8_LDA(At, 1, 1); PG8_STAGE(PG8_SB(1, 0), b3, voffB); PG8_STAGE(PG8_SB(1, 1), b3 + hstepB, voffB); PG8_STAGE_A(PG8_SA(1, 0), 0, k3, last);
            PG8_WAIT_V(8); PG8_WAIT_L(0); PG8_BAR; PG8_MMA(1, 0, At, b0); PG8_MMA(1, 1, At, b1); PG8_BAR; PG8_SCHED;
        }
        if constexpr (ALIGN_EPI) { if (wr == 0) PG8_BAR; }
        bool has_next2 = false;
        if constexpr (Prob::GATHER) { has_next2 = has_next && P.unit(ui + 2, nx2); if (!has_next2) nx2 = nxt; gather_offs(nx2, vq0, vq1); }
        if constexpr (FP8) asm volatile("s_nop 15\n\ts_nop 15" ::: "memory");
        if constexpr (DRY == 0) E(acc, cur, wr, wc, fr, fq); else { if (acc[0][0][0][0][0] == 1.2345e30f) *(volatile int*)P.Abase = 1; }
        if (!has_next) break;
#pragma unroll
        for (int a = 0; a < 2; ++a)
#pragma unroll
            for (int b = 0; b < 2; ++b)
#pragma unroll
                for (int m = 0; m < 4; ++m)
#pragma unroll
                    for (int n = 0; n < 2; ++n) acc[a][b][m][n] = (f32x4){0.f, 0.f, 0.f, 0.f};
        cur = nxt; cB = nB; cA = nA; ++ui;
        if constexpr (Prob::GATHER) {
#pragma unroll
            for (int i = 0; i < 2; ++i) { va0[i] = vn0[i]; va1[i] = vn1[i]; vn0[i] = vq0[i]; vn1[i] = vq1[i]; }
            nxt = nx2; has_next = has_next2; }
        if constexpr (ALIGN_EPI) { if (wr == 1) PG8_BAR; }
    }
    PG8_WAIT_V(0);
    if constexpr (!ALIGN_EPI) { if (wr == 0) PG8_BAR; }
    PG8_BAR;
#undef PG8_SA
#undef PG8_SB
#undef PG8_STAGE
#undef PG8_STAGE_A
#undef PG8_LDA
#undef PG8_LDB
#undef PG8_MMA
#undef PG8_WAIT_V
#undef PG8_WAIT_L
#undef PG8_BAR
#undef PG8_SCHED
}
}

using pg8::Unit;

struct ProbDense {
    static constexpr bool GATHER = false;
    const char* Abase; int nt; unsigned ldb2; unsigned lda2; const char* Bt; int nM, nN, G, c; int rev;
    __device__ __forceinline__ bool unit(int i, Unit& u) const { int w; if (!pg8::xcd_remap(i, G, c, nM * nN, w)) return false; pg8::grouped(w, nM, nN, u.pm, u.pn); if (rev) u.pm = nM - 1 - u.pm; u.aux = 0; return true; }
    __device__ __forceinline__ unsigned a_row(const Unit& u, int r) const { return (unsigned)(u.pm * 256 + r) * lda2; }
    __device__ __forceinline__ const char* b_tile(const Unit& u) const { return Bt + (size_t)u.pn * 256 * ldb2; }
};
struct ProbP1 {
    static constexpr bool GATHER = false;
    const char* Abase; int nt; unsigned ldb2; unsigned lda2; const char* Bt; unsigned uc_off; int G, c;
    __device__ __forceinline__ bool unit(int i, Unit& u) const {
        int w; if (!pg8::xcd_remap(i, G, c, 3072 + 256, w)) return false;
        if (w < 3072) { pg8::grouped(w, 256, 12, u.pm, u.pn); u.pm = 255 - u.pm; u.aux = 0; }
        else { pg8::grouped(w - 3072, 32, 8, u.pm, u.pn); u.pn += 4; u.aux = 1; }
        return true; }
    __device__ __forceinline__ unsigned a_row(const Unit& u, int r) const { return (u.aux ? uc_off : 0u) + (unsigned)(u.pm * 256 + r) * lda2; }
    __device__ __forceinline__ const char* b_tile(const Unit& u) const { return Bt + (size_t)u.pn * 256 * ldb2; }
};
template <bool GATHER_> struct ProbMoE {
    static constexpr bool GATHER = GATHER_;
    const char* Abase; int nt; unsigned ldb2; unsigned lda2; const char* Bt; size_t estride; int nN, nblk, G, c; const int* rowtok; const LAS unsigned char* blk_e;
    __device__ __forceinline__ bool unit(int i, Unit& u) const { int w; if (!pg8::xcd_remap(i, G, c, nblk * nN, w)) return false; pg8::grouped(w, nblk, nN, u.pm, u.pn); if (!GATHER) u.pm = nblk - 1 - u.pm;
        u.aux = (int)blk_e[u.pm]; return true; }
    __device__ __forceinline__ unsigned a_row(const Unit& u, int r) const { if (GATHER) return (unsigned)rowtok[u.pm * 256 + r] * lda2; else return (unsigned)(u.pm * 256 + r) * lda2; }
    __device__ __forceinline__ const char* b_tile(const Unit& u) const { return Bt + (size_t)u.aux * estride + (size_t)u.pn * 256 * ldb2; }
};

struct EpiP1 {
    static constexpr bool PERM = true;
    bf16_t* PA; bf16_t* PH; bf16_t* PHC;
    __device__ __forceinline__ void operator()(const f32x4 (&acc)[2][2][4][2], const Unit& u, int wr, int wc, int fr, int fq) const {
        const int row0 = u.pm * 256 + wr * 64 + fr;
        if (!u.aux && u.pn < 4) {
            unsigned char* PA8 = (unsigned char*)PA;
#pragma unroll
            for (int ai = 0; ai < 2; ++ai)
#pragma unroll
                for (int bj = 0; bj < 2; ++bj) { u32x2 pk[4];
#pragma unroll
                    for (int m = 0; m < 4; ++m) { const f32x4 v0 = acc[ai][bj][m][0] * W8_INV, v1 = acc[ai][bj][m][1] * W8_INV;
                        pk[m] = (u32x2){cvt_pk4_fp8(v0[0], v0[1], v0[2], v0[3]), cvt_pk4_fp8(v1[0], v1[1], v1[2], v1[3])}; }
                    const int col = u.pn * 256 + bj * 128 + wc * 32 + (fq >> 1) * 16, reim = col >> 9, slab = (col & 511) >> 4;
#pragma unroll
                    for (int mp = 0; mp < 2; ++mp) { const int row = row0 + ai * 128 + (2 * mp + (fq & 1)) * 16, b = row >> 11, t = row & 2047;
                        *(u32x4*)(PA8 + ((((size_t)(b * 32 + slab) * 2048 + t) * 2 + reim) * 16)) = widen16(pk[2 * mp], pk[2 * mp + 1]); } }
            return;
        }
        bf16_t* base = u.aux ? PHC : PH; const int ldc = 2048, colt = (u.pn - 4) * 256;
        {
            const int kind = u.pn < 6 ? 0 : (u.pn < 8 ? 1 : (u.pn < 10 ? 2 : 3));
            const int reg = kind == 0 ? (u.pn - 4) * 256 : kind == 1 ? 512 + (u.pn - 6) * 256 : kind == 2 ? 3584 + (u.pn - 8) * 256 : 3072 + (u.pn - 10) * 256;
            unsigned char* b8 = (unsigned char*)base + reg + wc * 32 + (fq >> 1) * 16;
#pragma unroll
            for (int ai = 0; ai < 2; ++ai)
#pragma unroll
                for (int bj = 0; bj < 2; ++bj) { u32x2 pk[4];
#pragma unroll
                    for (int m = 0; m < 4; ++m) { f32x4 v0 = acc[ai][bj][m][0] * W8_INV, v1 = acc[ai][bj][m][1] * W8_INV;
                        if (kind == 0) {
#pragma unroll
                            for (int j = 0; j < 4; ++j) { v0[j] *= fast_sigmoid(v0[j]); v1[j] *= fast_sigmoid(v1[j]); } }
                        if (kind == 1 || kind == 2) {
#pragma unroll
                            for (int j = 0; j < 4; ++j) { v0[j] = fast_sigmoid(v0[j]) * 255.0f; v1[j] = fast_sigmoid(v1[j]) * 255.0f; }
                            pk[m] = (u32x2){pack4_u8(v0[0], v0[1], v0[2], v0[3]), pack4_u8(v1[0], v1[1], v1[2], v1[3])};
                        } else pk[m] = (u32x2){cvt_pk4_fp8(v0[0], v0[1], v0[2], v0[3]), cvt_pk4_fp8(v1[0], v1[1], v1[2], v1[3])}; }
#pragma unroll
                    for (int mp = 0; mp < 2; ++mp)
                        *(u32x4*)(b8 + (size_t)(row0 + ai * 128 + (2 * mp + (fq & 1)) * 16) * 4096 + bj * 128) = widen16(pk[2 * mp], pk[2 * mp + 1]); }
        }
    }
    __device__ __forceinline__ void mid(f32x4 (&)[2][2][4][2], const Unit&, int, int, int, int) const {}
};
struct EpiP2 {
    static constexpr bool PERM = true;
    unsigned char* PG; unsigned char* GATES;
    __device__ __forceinline__ void operator()(const f32x4 (&acc)[2][2][4][2], const Unit& u, int wr, int wc, int fr, int fq) const {
        const int row0 = u.pm * 256 + wr * 64 + fr;
        if (u.pn < 2) {
            const int colp = u.pn * 256 + wc * 32 + (fq >> 1) * 16;
#pragma unroll
            for (int ai = 0; ai < 2; ++ai)
#pragma unroll
                for (int bj = 0; bj < 2; ++bj) { u32x2 pk[4];
#pragma unroll
                    for (int m = 0; m < 4; ++m) { f32x4 v0 = acc[ai][bj][m][0] * W8_INV, v1 = acc[ai][bj][m][1] * W8_INV;
#pragma unroll
                        for (int j = 0; j < 4; ++j) { v0[j] *= fast_sigmoid(v0[j]); v1[j] *= fast_sigmoid(v1[j]); }
                        pk[m] = (u32x2){cvt_pk4_fp8(v0[0], v0[1], v0[2], v0[3]), cvt_pk4_fp8(v1[0], v1[1], v1[2], v1[3])}; }
#pragma unroll
                    for (int mp = 0; mp < 2; ++mp)
                        *(u32x4*)(PG + (size_t)(row0 + ai * 128 + (2 * mp + (fq & 1)) * 16) * 512 + colp + bj * 128) = widen16(pk[2 * mp], pk[2 * mp + 1]); }
            return;
        }
        const int colt = (u.pn - 2) * 256 + wc * 32 + (fq >> 1) * 16;
#pragma unroll
        for (int ai = 0; ai < 2; ++ai)
#pragma unroll
            for (int bj = 0; bj < 2; ++bj) { u32x2 pk[4];
#pragma unroll
                for (int m = 0; m < 4; ++m) { f32x4 v0 = acc[ai][bj][m][0] * W8_INV, v1 = acc[ai][bj][m][1] * W8_INV;
#pragma unroll
                    for (int j = 0; j < 4; ++j) { v0[j] = fmaxf(fast_sigmoid(v0[j]) * 255.0f, 1.0f); v1[j] = fmaxf(fast_sigmoid(v1[j]) * 255.0f, 1.0f); }
                    pk[m] = (u32x2){pack4_u8(v0[0], v0[1], v0[2], v0[3]), pack4_u8(v1[0], v1[1], v1[2], v1[3])}; }
#pragma unroll
                for (int mp = 0; mp < 2; ++mp)
                    *(u32x4*)(GATES + (size_t)(row0 + ai * 128 + (2 * mp + (fq & 1)) * 16) * 2048 + colt + bj * 128) = widen16(pk[2 * mp], pk[2 * mp + 1]); }
    }
    __device__ __forceinline__ void mid(f32x4 (&)[2][2][4][2], const Unit&, int, int, int, int) const {}
};
struct EpiM1 {
    static constexpr bool PERM = true;
    const unsigned char* GATES; unsigned char* Mo;
    __device__ __forceinline__ void mid(f32x4 (&acc)[2][2][4][2], const Unit& u, int wr, int wc, int fr, int fq) const {
        int row0 = u.pm * 256 + wr * 64 + fr + (fq & 1) * 16, col0 = u.pn * 256 + wc * 32 + (fq >> 1) * 16;
        asm volatile("" : "+v"(row0), "+v"(col0));
        u32x4 gf[2][2][2], gh[2][2][2];
#pragma unroll
        for (int ai = 0; ai < 2; ++ai)
#pragma unroll
            for (int mp = 0; mp < 2; ++mp) { const unsigned char* gp = GATES + (size_t)(row0 + ai * 128 + mp * 32) * 2048 + col0;
#pragma unroll
                for (int bj = 0; bj < 2; ++bj) { gf[ai][mp][bj] = *(const u32x4*)(gp + bj * 128); gh[ai][mp][bj] = *(const u32x4*)(gp + 1024 + bj * 128); } }
#pragma unroll
        for (int ai = 0; ai < 2; ++ai) {
#pragma unroll
            for (int mp = 0; mp < 2; ++mp)
#pragma unroll
                for (int bj = 0; bj < 2; ++bj) { u32x2 f2[2], h2[2]; unwiden16(gf[ai][mp][bj], f2[0], f2[1]); unwiden16(gh[ai][mp][bj], h2[0], h2[1]);
#pragma unroll
                    for (int q = 0; q < 2; ++q) { const int m = 2 * mp + q;
                        const f32x4 fa = u8x4_to_f32(f2[q].x), fb = u8x4_to_f32(f2[q].y), ha = u8x4_to_f32(h2[q].x), hb = u8x4_to_f32(h2[q].y);
#pragma unroll
                        for (int j = 0; j < 4; ++j) { acc[ai][bj][m][0][j] *= fa[j] * __builtin_amdgcn_rcpf(ha[j]); acc[ai][bj][m][1][j] *= fb[j] * __builtin_amdgcn_rcpf(hb[j]); } } }
        }
        asm volatile("" ::: "memory");
    }
    __device__ __forceinline__ void operator()(const f32x4 (&acc)[2][2][4][2], const Unit& u, int wr, int wc, int fr, int fq) const {
        const int row0 = u.pm * 256 + wr * 64 + fr, col0 = u.pn * 256 + wc * 32 + (fq >> 1) * 16;
        const float sc = W8_INV * (1.0f / 255.0f);
        u32x4 gh[2][2][2];
#pragma unroll
        for (int ai = 0; ai < 2; ++ai)
#pragma unroll
            for (int mp = 0; mp < 2; ++mp) { const unsigned char* gp = GATES + (size_t)(row0 + ai * 128 + (2 * mp + (fq & 1)) * 16) * 2048 + 1024 + col0;
#pragma unroll
                for (int bj = 0; bj < 2; ++bj) gh[ai][mp][bj] = *(const u32x4*)(gp + bj * 128); }
#pragma unroll
        for (int ai = 0; ai < 2; ++ai) {
#pragma unroll
            for (int bj = 0; bj < 2; ++bj) { u32x2 pk[4];
#pragma unroll
                for (int mp = 0; mp < 2; ++mp) { u32x2 h2[2]; unwiden16(gh[ai][mp][bj], h2[0], h2[1]);
#pragma unroll
                    for (int q = 0; q < 2; ++q) { const int m = 2 * mp + q; const f32x4 ha = u8x4_to_f32(h2[q].x) * sc, hb = u8x4_to_f32(h2[q].y) * sc;
                        const f32x4 v0 = acc[ai][bj][m][0] * ha, v1 = acc[ai][bj][m][1] * hb;
                        pk[m] = (u32x2){cvt_pk4_fp8(v0[0], v0[1], v0[2], v0[3]), cvt_pk4_fp8(v1[0], v1[1], v1[2], v1[3])}; } }
#pragma unroll
                for (int mp = 0; mp < 2; ++mp)
                    *(u32x4*)(Mo + (size_t)(row0 + ai * 128 + (2 * mp + (fq & 1)) * 16) * 1024 + col0 + bj * 128) = widen16(pk[2 * mp], pk[2 * mp + 1]); }
        }
    }
};
constexpr float V8_SCALE = 16.0f, V8_INV = 1.0f / 16.0f;
struct EpiM2 {
    static constexpr bool PERM = true;
    const float* ada; unsigned char* V;
    __device__ __forceinline__ void operator()(const f32x4 (&acc)[2][2][4][2], const Unit& u, int wr, int wc, int fr, int fq) const {
        const int row0 = u.pm * 256 + wr * 64 + fr, col0 = u.pn * 256 + wc * 32 + 8 * fq, colw = u.pn * 256 + wc * 32 + (fq >> 1) * 16;
        const float* g1 = ada + (size_t)(u.pm >> 3) * 6144 + 2048 + col0;
        f32x4 gv[2][2];
#pragma unroll
        for (int bj = 0; bj < 2; ++bj)
#pragma unroll
            for (int n = 0; n < 2; ++n) gv[bj][n] = *(const f32x4*)(g1 + bj * 128 + n * 4) * (W8_INV * V8_SCALE);
#pragma unroll
        for (int ai = 0; ai < 2; ++ai)
#pragma unroll
            for (int bj = 0; bj < 2; ++bj) { u32x2 pk[4];
#pragma unroll
                for (int m = 0; m < 4; ++m) { const f32x4 v0 = gv[bj][0] * acc[ai][bj][m][0], v1 = gv[bj][1] * acc[ai][bj][m][1];
                    pk[m] = (u32x2){cvt_pk4_fp8(v0[0], v0[1], v0[2], v0[3]), cvt_pk4_fp8(v1[0], v1[1], v1[2], v1[3])}; }
#pragma unroll
                for (int mp = 0; mp < 2; ++mp)
                    *(u32x4*)(V + (size_t)(row0 + ai * 128 + (2 * mp + (fq & 1)) * 16) * 1024 + colw + bj * 128) = widen16(pk[2 * mp], pk[2 * mp + 1]); }
    }
    __device__ __forceinline__ void mid(f32x4 (&)[2][2][4][2], const Unit&, int, int, int, int) const {}
};
struct EpiGU {
    static constexpr bool PERM = true;
    const float* bgu; unsigned char* ACT;
    __device__ __forceinline__ void operator()(const f32x4 (&acc)[2][2][4][2], const Unit& u, int wr, int wc, int fr, int fq) const {
        const int row0 = u.pm * 256 + wr * 64 + fr, col0 = u.pn * 128 + wc * 32 + 8 * fq;
        const float* bp = bgu + (size_t)u.aux * 2048 + col0;
        const f32x4 bg0 = *(const f32x4*)(bp), bg1 = *(const f32x4*)(bp + 4), bu0 = *(const f32x4*)(bp + 1024), bu1 = *(const f32x4*)(bp + 1028);
#pragma unroll
        for (int ai = 0; ai < 2; ++ai) { u32x2 pk[4];
#pragma unroll
            for (int m = 0; m < 4; ++m) {
                f32x4 g0 = acc[ai][0][m][0] * W8_INV + bg0, g1 = acc[ai][0][m][1] * W8_INV + bg1, p0 = acc[ai][1][m][0] * W8_INV + bu0, p1 = acc[ai][1][m][1] * W8_INV + bu1;
#pragma unroll
                for (int j = 0; j < 4; ++j) {
                    float g = fminf(g0[j], 7.0f), p = fminf(fmaxf(p0[j], -7.0f), 7.0f); g0[j] = (p + 1.0f) * g * fast_sigmoid(1.702f * g);
                    g = fminf(g1[j], 7.0f); p = fminf(fmaxf(p1[j], -7.0f), 7.0f); g1[j] = (p + 1.0f) * g * fast_sigmoid(1.702f * g); }
                pk[m] = (u32x2){cvt_pk4_fp8(g0[0], g0[1], g0[2], g0[3]), cvt_pk4_fp8(g1[0], g1[1], g1[2], g1[3])}; }
#pragma unroll
            for (int mp = 0; mp < 2; ++mp)
                *(u32x4*)(ACT + (size_t)(row0 + ai * 128 + (2 * mp + (fq & 1)) * 16) * 1024 + u.pn * 128 + wc * 32 + (fq >> 1) * 16) = widen16(pk[2 * mp], pk[2 * mp + 1]); }
    }
    __device__ __forceinline__ void mid(f32x4 (&)[2][2][4][2], const Unit&, int, int, int, int) const {}
};
struct EpiDN {
    static constexpr bool PERM = true;
    const float* bdn; unsigned char* Y;
    __device__ __forceinline__ void operator()(const f32x4 (&acc)[2][2][4][2], const Unit& u, int wr, int wc, int fr, int fq) const {
        const int row0 = u.pm * 256 + wr * 64 + fr, col0 = u.pn * 256 + wc * 32 + 8 * fq;
        const float* bp = bdn + (size_t)u.aux * 1024 + col0;
        f32x4 bv[2][2];
#pragma unroll
        for (int bj = 0; bj < 2; ++bj)
#pragma unroll
            for (int n = 0; n < 2; ++n) bv[bj][n] = *(const f32x4*)(bp + bj * 128 + 4 * n);
#pragma unroll
        for (int ai = 0; ai < 2; ++ai)
#pragma unroll
            for (int bj = 0; bj < 2; ++bj) { u32x2 pk[4];
#pragma unroll
                for (int m = 0; m < 4; ++m) { const f32x4 v0 = acc[ai][bj][m][0] * W8_INV + bv[bj][0], v1 = acc[ai][bj][m][1] * W8_INV + bv[bj][1];
                    pk[m] = (u32x2){cvt_pk4_fp8(v0[0], v0[1], v0[2], v0[3]), cvt_pk4_fp8(v1[0], v1[1], v1[2], v1[3])}; }
#pragma unroll
                for (int mp = 0; mp < 2; ++mp)
                    *(u32x4*)(Y + (size_t)(row0 + ai * 128 + (2 * mp + (fq & 1)) * 16) * 1024 + u.pn * 256 + bj * 128 + wc * 32 + (fq >> 1) * 16) = widen16(pk[2 * mp], pk[2 * mp + 1]); }
    }
    __device__ __forceinline__ void mid(f32x4 (&)[2][2][4][2], const Unit&, int, int, int, int) const {}
};

struct Frame {
    LAS unsigned char* lds; int tid, lane, wave, G, c;
    const float* const* in; float* out; unsigned char* ws; unsigned* ctl;
};
enum { I_X = 0, I_C, I_CTX, I_CCTX, I_WADA, I_BADA, I_WIN, I_LBRAW, I_HGG, I_WFO, I_WHO, I_WO, I_LN1G, I_LN1B, I_WR, I_BR, I_WGU, I_BGU, I_WDN, I_BDN, I_LN2G, I_LN2B };

__device__ __forceinline__ float wave_sum(float v) {
#pragma unroll
    for (int o = 32; o >= 1; o >>= 1) v += __shfl_xor(v, o);
    return v;
}

__device__ __forceinline__ Frame fresh(const Frame& F) { Frame G = F; int t = threadIdx.x; asm volatile("" : "+v"(t)); G.tid = t; G.lane = t & 63; G.wave = __builtin_amdgcn_readfirstlane(t >> 6); return G; }

__device__ __forceinline__ void p0_ada(const Frame& F) {
    LAS float* cact = (LAS float*)F.lds;
    float* ada = (float*)(F.ws + WS_ADA);
    for (int cb = F.c; cb < 192; cb += F.G) {
        const int kg = F.tid >> 5, col = F.tid & 31, gcol = cb * 32 + col;
        float w[16][4];
#pragma unroll
        for (int i = 0; i < 16; ++i)
#pragma unroll
            for (int j = 0; j < 4; ++j) w[i][j] = F.in[I_WADA][(size_t)(4 * kg + 64 * i + j) * 6144 + gcol];
        f32x4 cv[17];
#pragma unroll
        for (int it = 0; it < 17; ++it) { const int q = F.tid + it * NTHR, bq = q >> 8, k4 = (q & 255) * 4; cv[it] = (f32x4){0.f, 0.f, 0.f, 0.f};
            if (q < 33 * 256) cv[it] = *(const f32x4*)(bq < 32 ? F.in[I_C] + bq * 1024 + k4 : F.in[I_CCTX] + k4); }
#pragma unroll
        for (int it = 0; it < 17; ++it) { const int q = F.tid + it * NTHR; f32x4 v = cv[it];
#pragma unroll
            for (int j = 0; j < 4; ++j) v[j] = v[j] * fast_sigmoid(v[j]);
            if (q < 33 * 256) *(LAS f32x4*)(cact + q * 4) = v; }
        __syncthreads();
        float acc[33];
#pragma unroll
        for (int bb = 0; bb < 33; ++bb) acc[bb] = 0.f;
#pragma unroll
        for (int i = 0; i < 16; ++i)
#pragma unroll
            for (int bb = 0; bb < 33; ++bb) { const f32x4 c4 = *(const LAS f32x4*)(cact + bb * 1024 + 4 * kg + 64 * i);
                acc[bb] += (c4[0] * w[i][0] + c4[1] * w[i][1]) + (c4[2] * w[i][2] + c4[3] * w[i][3]); }
        __syncthreads();
        LAS float* red = cact;
#pragma unroll
        for (int bb = 0; bb < 33; ++bb) red[(kg * 33 + bb) * 32 + col] = acc[bb];
        __syncthreads();
        for (int o = F.tid; o < 33 * 32; o += NTHR) { const int bb = o >> 5, cc = o & 31; float sum = 0.f;
#pragma unroll
            for (int g = 0; g < 16; ++g) sum += red[(g * 33 + bb) * 32 + cc];
            ada[(size_t)bb * 6144 + cb * 32 + cc] = sum + F.in[I_BADA][cb * 32 + cc]; }
        __syncthreads();
    }
}
__device__ __forceinline__ void p0_fold(const Frame& F) {
    LAS float* xr = (LAS float*)F.lds;
    LAS float* cs = xr + 2048;
    unsigned char* W1 = (unsigned char*)(F.ws + WS_WIN1T);
    if (F.tid < 128) { const float a = (float)F.tid * (1.0f / 128.0f); cs[F.tid] = __builtin_amdgcn_cosf(a); cs[128 + F.tid] = __builtin_amdgcn_sinf(a); }
    for (int kb = F.c; kb < 256; kb += F.G) {
        __syncthreads();
        for (int i = F.tid; i < 2048; i += NTHR) xr[i] = F.in[I_WIN][(size_t)(4 * kb + (i >> 9)) * 5120 + (i & 511)];
        __syncthreads();
        const int g = F.tid >> 7, j = F.tid & 127;
        float ac[4] = {0.f, 0.f, 0.f, 0.f}, as[4] = {0.f, 0.f, 0.f, 0.f};
        for (int d = 0; d < 128; ++d) { const int idx = (d * j) & 127; const float cv = cs[idx], sv = cs[128 + idx];
#pragma unroll
            for (int r = 0; r < 4; ++r) { const float xv = xr[r * 512 + g * 128 + d]; ac[r] += xv * cv; as[r] += xv * sv; } }
        const float sc = 0.08838834764831845f * W8_SCALE;
        *(unsigned*)(W1 + (size_t)(g * 128 + j) * 1024 + 4 * kb) = cvt_pk4_fp8(ac[0] * sc, ac[1] * sc, ac[2] * sc, ac[3] * sc);
        *(unsigned*)(W1 + (size_t)(512 + g * 128 + j) * 1024 + 4 * kb) = cvt_pk4_fp8(-as[0] * sc, -as[1] * sc, -as[2] * sc, -as[3] * sc);
    }
    __syncthreads();
}
struct CvJob { const float* src; int sld; unsigned char* dst; int f8; };
__device__ __forceinline__ CvJob cv_job(const Frame& F, int j) {
    CvJob J;
    if (j < 128) { const int kt = j >> 4, nt = j & 15; J.src = F.in[I_WIN] + (size_t)kt * 128 * 5120 + 512 + nt * 128; J.sld = 5120; J.dst = F.ws + WS_WIN1T + (size_t)(1024 + nt * 128) * 1024 + kt * 128; J.f8 = 1; }
    else if (j < 288) { const int q = j - 128, kt = q / 20, nt = q % 20; J.src = F.in[I_WIN] + (size_t)kt * 128 * 5120 + 2560 + nt * 128; J.sld = 5120; J.dst = F.ws + WS_WIN2T + (size_t)(nt * 128) * 1024 + kt * 128; J.f8 = 1; }
    else if (j < 320) { const int q = j - 288, kt = q >> 3, nt = q & 7; J.src = F.in[I_WFO] + (size_t)kt * 128 * 1024 + nt * 128; J.sld = 1024; J.dst = F.ws + WS_WMT + ((size_t)(nt * 128) * 1024 + kt * 128); J.f8 = 1; }
    else if (j < 352) { const int q = j - 320, kt = q >> 3, nt = q & 7; J.src = F.in[I_WHO] + (size_t)kt * 128 * 1024 + nt * 128; J.sld = 1024; J.dst = F.ws + WS_WMT + ((size_t)(nt * 128) * 1024 + 512 + kt * 128); J.f8 = 1; }
    else if (j < 416) { const int q = j - 352, kt = q >> 3, nt = q & 7; J.src = F.in[I_WO] + (size_t)kt * 128 * 1024 + nt * 128; J.sld = 1024; J.dst = F.ws + WS_WOT + ((size_t)(nt * 128) * 1024 + kt * 128); J.f8 = 1; }
    else if (j < 4512) { const int q = j - 416, e = q >> 7, r = q & 127, kt = r >> 4, jt = r & 15; J.src = F.in[I_WGU] + (size_t)e * 1024 * 2048 + (size_t)kt * 128 * 2048 + jt * 128; J.sld = 2048;
        J.dst = F.ws + WS_WGUT + (size_t)e * 2048 * 1024 + (size_t)((jt & 7) * 256 + (jt >> 3) * 128) * 1024 + kt * 128; J.f8 = 1; }
    else { const int q = j - 4512, e = q >> 6, r = q & 63, kt = r >> 3, nt = r & 7; J.src = F.in[I_WDN] + (size_t)e * 1024 * 1024 + (size_t)kt * 128 * 1024 + nt * 128; J.sld = 1024;
        J.dst = F.ws + WS_WDNT + (size_t)e * 1024 * 1024 + (size_t)(nt * 128) * 1024 + kt * 128; J.f8 = 1; }
    return J;
}
__device__ __forceinline__ void p0_convert(const Frame& F) {
    constexpr int NJ = 128 + 160 + 32 + 32 + 64 + 4096 + 2048;
    LAS float* tile = (LAS float*)F.lds;
    int j = F.c; if (j >= NJ) return;
    CvJob J = cv_job(F, j);
    f32x4 v[8];
#pragma unroll
    for (int i = 0; i < 8; ++i) { const int idx = F.tid + i * NTHR, r = idx >> 5, c4 = idx & 31; v[i] = *(const f32x4*)(J.src + (size_t)r * J.sld + c4 * 4); }
    for (;;) {
        const float sc = J.f8 ? W8_SCALE : 1.0f;
#pragma unroll
        for (int i = 0; i < 8; ++i) { const int idx = F.tid + i * NTHR, r = idx >> 5, c4 = idx & 31; LAS float* p = tile + r * 129 + c4 * 4; p[0] = v[i][0] * sc; p[1] = v[i][1] * sc; p[2] = v[i][2] * sc; p[3] = v[i][3] * sc; }
        __syncthreads();
        const CvJob Jc = J; const int jn = j + F.G; const bool more = jn < NJ;
        if (more) { J = cv_job(F, jn);
#pragma unroll
            for (int i = 0; i < 8; ++i) { const int idx = F.tid + i * NTHR, r = idx >> 5, c4 = idx & 31; v[i] = *(const f32x4*)(J.src + (size_t)r * J.sld + c4 * 4); } }
        if (Jc.f8) {
#pragma unroll
            for (int i = 0; i < 2; ++i) { const int idx = F.tid + i * NTHR, n = idx >> 3, kc = idx & 7; const LAS float* p = tile + (kc * 16) * 129 + n;
                u32x4 w; w.x = cvt_pk4_fp8(p[0], p[129], p[2 * 129], p[3 * 129]); w.y = cvt_pk4_fp8(p[4 * 129], p[5 * 129], p[6 * 129], p[7 * 129]);
                w.z = cvt_pk4_fp8(p[8 * 129], p[9 * 129], p[10 * 129], p[11 * 129]); w.w = cvt_pk4_fp8(p[12 * 129], p[13 * 129], p[14 * 129], p[15 * 129]);
                *(u32x4*)(Jc.dst + (size_t)n * 1024 + kc * 16) = w; }
        } else {
#pragma unroll
            for (int i = 0; i < 4; ++i) { const int idx = F.tid + i * NTHR, n = idx >> 4, kc = idx & 15; const LAS float* p = tile + (kc * 8) * 129 + n;
                u32x4 w; w.x = cvt_pk_bf16(p[0], p[129]); w.y = cvt_pk_bf16(p[2 * 129], p[3 * 129]); w.z = cvt_pk_bf16(p[4 * 129], p[5 * 129]); w.w = cvt_pk_bf16(p[6 * 129], p[7 * 129]);
                *(u32x4*)((bf16_t*)Jc.dst + (size_t)n * 1024 + kc * 8) = w; }
        }
        __syncthreads();
        if (!more) break;
        j = jn;
    }
}

__device__ __forceinline__ void p1_uprep(const Frame& F) {
    const float* ada = (const float*)(F.ws + WS_ADA);
    unsigned char* U = (unsigned char*)(F.ws + WS_U); unsigned char* Uc = (unsigned char*)(F.ws + WS_UC);
    const size_t NIT = (size_t)(T + TCX) * 128, stride = (size_t)F.G * NTHR;
    for (size_t base = (size_t)F.c * NTHR + F.tid; base < NIT; base += 4 * stride) {
        const int col = (int)(base & 127) * 8;
        f32x4 a0[4], a1[4], sh0[4], sh1[4], sc0[4], sc1[4]; unsigned char* dst[4]; bool ok[4];
#pragma unroll
        for (int u = 0; u < 4; ++u) {
            const size_t idx = base + (size_t)u * stride; ok[u] = idx < NIT;
            const int row = (int)((ok[u] ? idx : base) >> 7);
            const bool lat = row < T; const int b = lat ? (row >> 11) : 32;
            const float* src = lat ? F.in[I_X] + (size_t)row * 1024 + col : F.in[I_CTX] + (size_t)(row - T) * 1024 + col;
            dst[u] = lat ? U + (size_t)row * 1024 + col : Uc + (size_t)(row - T) * 1024 + col;
            a0[u] = *(const f32x4*)src; a1[u] = *(const f32x4*)(src + 4);
            const float* ap = ada + (size_t)b * 6144 + col;
            sh0[u] = *(const f32x4*)ap; sh1[u] = *(const f32x4*)(ap + 4); sc0[u] = *(const f32x4*)(ap + 1024); sc1[u] = *(const f32x4*)(ap + 1028);
        }
#pragma unroll
        for (int u = 0; u < 4; ++u) {
            const f32x4 r0 = a0[u] * (sc0[u] + 1.0f) + sh0[u], r1 = a1[u] * (sc1[u] + 1.0f) + sh1[u];
            if (ok[u]) *(u32x2*)dst[u] = (u32x2){cvt_pk4_fp8(r0[0], r0[1], r0[2], r0[3]), cvt_pk4_fp8(r1[0], r1[1], r1[2], r1[3])};
        }
    }
    int* rowtok = (int*)(F.ws + WS_ROWTOK);
    for (int i = F.c * NTHR + F.tid; i < NCH * ROWS_CH; i += F.G * NTHR) rowtok[i] = (i / ROWS_CH) * TCH;
}

__device__ __forceinline__ void p6_readout(const Frame& F) {
    const bf16_t* PH = (const bf16_t*)(F.ws + WS_PH); const unsigned char* PG = (const unsigned char*)(F.ws + WS_PG); unsigned char* Y = (unsigned char*)(F.ws + WS_Y);
    const int l8 = F.lane * 8;
    const f32x4 g0 = *(const f32x4*)(F.in[I_HGG] + l8), g1 = *(const f32x4*)(F.in[I_HGG] + l8 + 4);
    const int tstr = F.G * 8;
    for (int t0 = F.c * 8 + F.wave; t0 < T; t0 += 4 * tstr) {
        u32x2 av[4], bv[4], pv[4]; bool ok[4]; int tt[4];
#pragma unroll
        for (int u = 0; u < 4; ++u) { const int t = t0 + u * tstr; ok[u] = t < T; tt[u] = ok[u] ? t : t0;
            av[u] = *(const u32x2*)((const unsigned char*)PH + (size_t)tt[u] * 4096 + 1024 + l8); bv[u] = *(const u32x2*)((const unsigned char*)PH + (size_t)tt[u] * 4096 + 2048 + l8); pv[u] = *(const u32x2*)(PG + (size_t)tt[u] * 512 + l8); }
#pragma unroll
        for (int u = 0; u < 4; ++u) {
            const f32x4 pa = fp8x4_to_f32(pv[u].x), pb = fp8x4_to_f32(pv[u].y);
            const f32x4 oa = fp8x4_to_f32(av[u].x) + fp8x4_to_f32(bv[u].x), oc = fp8x4_to_f32(av[u].y) + fp8x4_to_f32(bv[u].y);
            float o[8] = { oa[0], oa[1], oa[2], oa[3], oc[0], oc[1], oc[2], oc[3] };
            float ss = 0.f;
#pragma unroll
            for (int i = 0; i < 8; ++i) ss += o[i] * o[i];
            ss += __shfl_xor(ss, 1); ss += __shfl_xor(ss, 2); ss += __shfl_xor(ss, 4); ss += __shfl_xor(ss, 8);
            const float rs = __builtin_amdgcn_rsqf(ss * (1.0f / 128.0f) + RMS_EPS);
            const float sp[8] = { pa[0], pa[1], pa[2], pa[3], pb[0], pb[1], pb[2], pb[3] };
            if (ok[u]) *(u32x2*)(Y + (size_t)tt[u] * 1024 + 512 + l8) = (u32x2){cvt_pk4_fp8(o[0] * rs * g0[0] * sp[0], o[1] * rs * g0[1] * sp[1], o[2] * rs * g0[2] * sp[2], o[3] * rs * g0[3] * sp[3]), cvt_pk4_fp8(o[4] * rs * g1[0] * sp[4], o[5] * rs * g1[1] * sp[5], o[6] * rs * g1[2] * sp[6], o[7] * rs * g1[3] * sp[7])};
        }
    }
}

constexpr int RW_STRIDE = 2080;
constexpr int RW_HI = 0, RW_LO = 32 * RW_STRIDE, RW_PAR = 64 * RW_STRIDE, RW_BR = RW_PAR + 16384, RW_HIST = RW_BR + 128;
__device__ __forceinline__ void p9_ln1_router(const Frame& F, const bool dry) {
    LAS unsigned char* L = F.lds;
    LAS float* par = (LAS float*)(L + RW_PAR); LAS float* brs = (LAS float*)(L + RW_BR); LAS int* hist = (LAS int*)(L + RW_HIST);
#pragma unroll 1
    for (int it = 0; it < 8; ++it) { const int item = F.tid + it * NTHR, e = item & 31, k8 = item >> 5;
        float w[8];
#pragma unroll
        for (int i = 0; i < 8; ++i) w[i] = F.in[I_WR][(k8 * 8 + i) * 32 + e];
        u32x4 hi, lo;
#pragma unroll
        for (int i = 0; i < 4; ++i) { const unsigned h = cvt_pk_bf16(w[2 * i], w[2 * i + 1]); hi[i] = h; lo[i] = cvt_pk_bf16(w[2 * i] - bf_lo(h), w[2 * i + 1] - bf_hi(h)); }
        *(LAS u32x4*)(L + RW_HI + e * RW_STRIDE + k8 * 16) = hi; *(LAS u32x4*)(L + RW_LO + e * RW_STRIDE + k8 * 16) = lo; }
    for (int i = F.tid; i < 2048; i += NTHR) par[i] = i < 1024 ? F.in[I_LN1G][i] : F.in[I_LN1B][i - 1024];
    if (F.tid < 32) brs[F.tid] = F.in[I_BR][F.tid];
    if (F.tid < NCH * 32) hist[F.tid] = 0;
    const unsigned char* V = (const unsigned char*)F.out; bf16_t* X1 = (bf16_t*)(F.ws + WS_X1); unsigned char* U2 = (unsigned char*)(F.ws + WS_U); const float* ada = (const float*)(F.ws + WS_ADA);
    int* topi = (int*)(F.ws + WS_TOPI); float* topw = (float*)(F.ws + WS_TOPW);
    for (int gb = F.c * 8; gb < T / 16; gb += F.G * 8) {
        const int g = T / 16 - 1 - (gb + F.wave), t0 = g * 16, b = (T / 16 - 1 - gb) >> 7;
        __syncthreads();
        { int tz = threadIdx.x; asm volatile("" : "+v"(tz));
          for (int i = tz; i < 2048; i += NTHR) par[2048 + i] = i < 1024 ? 1.0f + ada[(size_t)b * 6144 + 4096 + i] : ada[(size_t)b * 6144 + 3072 + (i - 1024)]; }
        __syncthreads();
        int l1 = threadIdx.x; asm volatile("" : "+v"(l1)); l1 &= 63;
        const float* xp = F.in[I_X] + (size_t)(t0 + (l1 & 15)) * 1024 + 8 * (l1 >> 4); const unsigned char* vp = V + (size_t)(t0 + (l1 & 15)) * 1024 + 8 * (l1 >> 4);
        unsigned tb[32][4]; float s1 = 0.f, s2 = 0.f, s1b = 0.f, s2b = 0.f;
#pragma unroll
        for (int c = 0; c < 16; ++c) {
            f32x4 xa[2], xb[2]; u32x2 vv[2];
#pragma unroll
            for (int q = 0; q < 2; ++q) { const int ks = 2 * c + q; xa[q] = *(const f32x4*)(xp + 32 * ks); xb[q] = *(const f32x4*)(xp + 32 * ks + 4); vv[q] = *(const u32x2*)(vp + 32 * ks); }
#pragma unroll
            for (int q = 0; q < 2; ++q) { const int ks = 2 * c + q;
                const f32x4 ta = xa[q] * DN_ALPHA + fp8x4_to_f32(vv[q].x) * V8_INV, tc = xb[q] * DN_ALPHA + fp8x4_to_f32(vv[q].y) * V8_INV;
#pragma unroll
                for (int j = 0; j < 4; ++j) { s1 += ta[j]; s1b += tc[j]; s2 = __builtin_fmaf(ta[j], ta[j], s2); s2b = __builtin_fmaf(tc[j], tc[j], s2b); }
                tb[ks][0] = cvt_pk_bf16(ta[0], ta[1]); tb[ks][1] = cvt_pk_bf16(ta[2], ta[3]); tb[ks][2] = cvt_pk_bf16(tc[0], tc[1]); tb[ks][3] = cvt_pk_bf16(tc[2], tc[3]); }
            asm volatile("" ::: "memory"); __builtin_amdgcn_sched_barrier(0);
        }
        s1 += s1b; s2 += s2b;
        {   int l4 = threadIdx.x; asm volatile("" : "+v"(l4)); l4 &= 63; const int b16 = (l4 ^ 16) << 2, b32 = (l4 ^ 32) << 2;
            s1 += __int_as_float(__builtin_amdgcn_ds_bpermute(b16, __float_as_int(s1))); s2 += __int_as_float(__builtin_amdgcn_ds_bpermute(b16, __float_as_int(s2)));
            s1 += __int_as_float(__builtin_amdgcn_ds_bpermute(b32, __float_as_int(s1))); s2 += __int_as_float(__builtin_amdgcn_ds_bpermute(b32, __float_as_int(s2))); }
        const float mean = s1 * (1.0f / 1024.0f), rstd = __builtin_amdgcn_rsqf(fmaxf(s2 * (1.0f / 1024.0f) - mean * mean, 0.f) + LN_EPS), nmr = -mean * rstd;
        f32x4 acc[2] = {(f32x4){0.f, 0.f, 0.f, 0.f}, (f32x4){0.f, 0.f, 0.f, 0.f}};
        int l2 = threadIdx.x; asm volatile("" : "+v"(l2)); l2 &= 63; const int fr = l2 & 15, fq = l2 >> 4;
        bf16_t* x1p = X1 + (size_t)(t0 + fr) * 1024 + 8 * fq; unsigned char* u2p = U2 + (size_t)(t0 + fr) * 1024 + 8 * fq;
#pragma unroll
        for (int ks = 0; ks < 32; ++ks) {
            const LAS float* pp = par + 32 * ks + 8 * fq;
            const f32x4 ta = {bf_lo(tb[ks][0]), bf_hi(tb[ks][0]), bf_lo(tb[ks][1]), bf_hi(tb[ks][1])}, tc = {bf_lo(tb[ks][2]), bf_hi(tb[ks][2]), bf_lo(tb[ks][3]), bf_hi(tb[ks][3])};
            f32x4 xa, xc, ua, uc;
            {   const f32x4 g0 = *(const LAS f32x4*)pp, b0 = *(const LAS f32x4*)(pp + 1024), c0 = *(const LAS f32x4*)(pp + 2048), h0 = *(const LAS f32x4*)(pp + 3072);
                xa = (ta * rstd + nmr) * g0 + b0; ua = xa * c0 + h0; }
            __builtin_amdgcn_sched_barrier(0);
            {   const f32x4 g1 = *(const LAS f32x4*)(pp + 4), b1 = *(const LAS f32x4*)(pp + 1028), c1 = *(const LAS f32x4*)(pp + 2052), h1 = *(const LAS f32x4*)(pp + 3076);
                xc = (tc * rstd + nmr) * g1 + b1; uc = xc * c1 + h1; }
            if (!dry) *(u32x4*)(x1p + 32 * ks) = (u32x4){cvt_pk_bf16(xa[0], xa[1]), cvt_pk_bf16(xa[2], xa[3]), cvt_pk_bf16(xc[0], xc[1]), cvt_pk_bf16(xc[2], xc[3])};
            if (!dry) *(u32x2*)(u2p + 32 * ks) = (u32x2){cvt_pk4_fp8(ua[0], ua[1], ua[2], ua[3]), cvt_pk4_fp8(uc[0], uc[1], uc[2], uc[3])};
            u32x4 hi = {cvt_pk_bf16(ua[0], ua[1]), cvt_pk_bf16(ua[2], ua[3]), cvt_pk_bf16(uc[0], uc[1]), cvt_pk_bf16(uc[2], uc[3])};
            u32x4 lo = {cvt_pk_bf16(ua[0] - bf_lo(hi[0]), ua[1] - bf_hi(hi[0])), cvt_pk_bf16(ua[2] - bf_lo(hi[1]), ua[3] - bf_hi(hi[1])), cvt_pk_bf16(uc[0] - bf_lo(hi[2]), uc[1] - bf_hi(hi[2])), cvt_pk_bf16(uc[2] - bf_lo(hi[3]), uc[3] - bf_hi(hi[3]))};
            const bf16x8 uh = *(bf16x8*)&hi, ul = *(bf16x8*)&lo;
#pragma unroll
            for (int et = 0; et < 2; ++et) {
                const bf16x8 wh = *(const LAS bf16x8*)(L + RW_HI + (16 * et + fr) * RW_STRIDE + ks * 64 + fq * 16), wl = *(const LAS bf16x8*)(L + RW_LO + (16 * et + fr) * RW_STRIDE + ks * 64 + fq * 16);
                acc[et] = __builtin_amdgcn_mfma_f32_16x16x32_bf16(wh, uh, acc[et], 0, 0, 0);
                acc[et] = __builtin_amdgcn_mfma_f32_16x16x32_bf16(wh, ul, acc[et], 0, 0, 0);
                acc[et] = __builtin_amdgcn_mfma_f32_16x16x32_bf16(wl, uh, acc[et], 0, 0, 0);
                __builtin_amdgcn_sched_barrier(0); }
        }
        int l3 = threadIdx.x; asm volatile("" : "+v"(l3)); l3 &= 63; const int fq3 = l3 >> 4, t = t0 + (l3 & 15), a16 = (l3 ^ 16) << 2, a32 = (l3 ^ 32) << 2;
        float lv[8]; int li[8];
#pragma unroll
        for (int i = 0; i < 4; ++i) { li[i] = 4 * fq3 + i; li[4 + i] = 16 + 4 * fq3 + i; lv[i] = acc[0][i] + brs[4 * fq3 + i]; lv[4 + i] = acc[1][i] + brs[16 + 4 * fq3 + i]; }
        float tv[4]; int ti[4];
#pragma unroll
        for (int r = 0; r < 4; ++r) {
            float bv = lv[0]; int bi = li[0];
#pragma unroll
            for (int i = 1; i < 8; ++i) { const bool gt = lv[i] > bv; bv = gt ? lv[i] : bv; bi = gt ? li[i] : bi; }
#pragma unroll
            for (int o = 0; o < 2; ++o) { const int ad = o ? a32 : a16; const float ov = __int_as_float(__builtin_amdgcn_ds_bpermute(ad, __float_as_int(bv))); const int oi = __builtin_amdgcn_ds_bpermute(ad, bi); const bool tk = ov > bv || (ov == bv && oi < bi); bv = tk ? ov : bv; bi = tk ? oi : bi; }
            tv[r] = bv; ti[r] = bi;
#pragma unroll
            for (int i = 0; i < 8; ++i) lv[i] = (li[i] == bi) ? -3.0e38f : lv[i];
        }
        if (fq3 == 0) {
            const float p1 = fast_exp(tv[1] - tv[0]), p2 = fast_exp(tv[2] - tv[0]), p3 = fast_exp(tv[3] - tv[0]), inv = 1.0f / (1.0f + p1 + p2 + p3);
            *(int4*)(topi + (size_t)t * 4) = make_int4(ti[0], ti[1], ti[2], ti[3]);
            *(f32x4*)(topw + (size_t)t * 4) = (f32x4){inv, p1 * inv, p2 * inv, p3 * inv};
            const int ch = t / TCH;
            if (!dry) { atomicAdd((int*)(hist + ch * 32 + ti[0]), 1); atomicAdd((int*)(hist + ch * 32 + ti[1]), 1); atomicAdd((int*)(hist + ch * 32 + ti[2]), 1); atomicAdd((int*)(hist + ch * 32 + ti[3]), 1); }
        }
    }
    __syncthreads();
    { int t2 = threadIdx.x; asm volatile("" : "+v"(t2));
      if (t2 < NCH * 32) { const int h = hist[t2]; if (h && !dry) atomicAdd(F.ctl + CW_CNT + t2, (unsigned)h); } }
    __syncthreads();
}

__device__ __forceinline__ void p10_dispatch(const Frame& F) {
    LAS int* lcnt = (LAS int*)F.lds; LAS int* lbase = lcnt + 32; LAS int* pstart = lcnt + 64;
    const int* topi = (const int*)(F.ws + WS_TOPI); int* pos = (int*)(F.ws + WS_POS); int* rowtok = (int*)(F.ws + WS_ROWTOK);
    for (int s = F.c; s < T / 256; s += F.G) {
        const int ch = (s * 256) / TCH;
        __syncthreads();
        if (F.tid < 32) { lcnt[F.tid] = 0; int ps = 0; for (int e = 0; e < F.tid; ++e) { const int n = (int)__hip_atomic_load(F.ctl + CW_CNT + ch * 32 + e, __ATOMIC_RELAXED, __HIP_MEMORY_SCOPE_AGENT); ps += (n + 255) & ~255; } pstart[F.tid] = ps; }
        __syncthreads();
        int e2[2], r2[2];
#pragma unroll
        for (int i = 0; i < 2; ++i) { const int a = F.tid + i * NTHR; e2[i] = topi[(size_t)(s * 256) * 4 + a]; r2[i] = atomicAdd((int*)(lcnt + e2[i]), 1); }
        __syncthreads();
        if (F.tid < 32) lbase[F.tid] = (int)atomicAdd(F.ctl + CW_CUR + ch * 32 + F.tid, (unsigned)lcnt[F.tid]);
        __syncthreads();
#pragma unroll
        for (int i = 0; i < 2; ++i) { const int a = F.tid + i * NTHR, slot = pstart[e2[i]] + lbase[e2[i]] + r2[i];
            pos[(size_t)(s * 256) * 4 + a] = slot; rowtok[(size_t)ch * ROWS_CH + slot] = s * 256 + (a >> 2); }
    }
}
__device__ __forceinline__ int moe_blocks(const Frame& F, int ch, LAS unsigned char* blk_e) {
    LAS int* sh = (LAS int*)(blk_e + 1152);
    __syncthreads();
    if (F.tid < 32) {
        int start = 0, mine = 0;
        for (int e = 0; e < 32; ++e) { const int n = ((int)__hip_atomic_load(F.ctl + CW_CNT + ch * 32 + e, __ATOMIC_RELAXED, __HIP_MEMORY_SCOPE_AGENT) + 255) >> 8; if (e < F.tid) start += n; if (e == F.tid) mine = n; }
        for (int i = 0; i < mine; ++i) blk_e[start + i] = (unsigned char)F.tid;
        if (F.tid == 31) sh[0] = start + mine;
    }
    __syncthreads();
    return sh[0];
}

__device__ __forceinline__ void p13_combine_ln2(const Frame& F, int ch, const bool dry) {
    const unsigned char* YC = (const unsigned char*)(F.ws + WS_YCH); const int* pos = (const int*)(F.ws + WS_POS); const float* topw = (const float*)(F.ws + WS_TOPW);
    const float* ada = (const float*)(F.ws + WS_ADA); const bf16_t* X1 = (const bf16_t*)(F.ws + WS_X1); float* O = F.out;
    const int l8 = F.lane * 8;
    for (int t0 = ch * TCH + F.c * 8 + F.wave; t0 < (ch + 1) * TCH; t0 += 2 * F.G * 8) {
        int tt[2]; tt[0] = t0; tt[1] = t0 + F.G * 8; const bool two = tt[1] < (ch + 1) * TCH; if (!two) tt[1] = t0;
        f32x4 v[2][2][2];
#pragma unroll
        for (int q = 0; q < 2; ++q) { const int t = tt[q], b = t >> 11;
            const int4 ps = *(const int4*)(pos + (size_t)t * 4); const f32x4 tw = *(const f32x4*)(topw + (size_t)t * 4);
#pragma unroll
            for (int j = 0; j < 2; ++j) { const int k = 512 * j + l8;
                const u32x2 y0 = *(const u32x2*)(YC + (size_t)ps.x * 1024 + k), y1 = *(const u32x2*)(YC + (size_t)ps.y * 1024 + k), y2 = *(const u32x2*)(YC + (size_t)ps.z * 1024 + k), y3 = *(const u32x2*)(YC + (size_t)ps.w * 1024 + k);
                const u32x4 xw = *(const u32x4*)(X1 + (size_t)t * 1024 + k);
                const f32x4 g2a = *(const f32x4*)(ada + (size_t)b * 6144 + 5120 + k), g2b = *(const f32x4*)(ada + (size_t)b * 6144 + 5120 + k + 4);
                const f32x4 ffa = fp8x4_to_f32(y0.x) * tw[0] + fp8x4_to_f32(y1.x) * tw[1] + fp8x4_to_f32(y2.x) * tw[2] + fp8x4_to_f32(y3.x) * tw[3];
                const f32x4 ffb = fp8x4_to_f32(y0.y) * tw[0] + fp8x4_to_f32(y1.y) * tw[1] + fp8x4_to_f32(y2.y) * tw[2] + fp8x4_to_f32(y3.y) * tw[3];
                v[q][j][0] = (f32x4){bf_lo(xw.x), bf_hi(xw.x), bf_lo(xw.y), bf_hi(xw.y)} * DN_ALPHA + g2a * ffa;
                v[q][j][1] = (f32x4){bf_lo(xw.z), bf_hi(xw.z), bf_lo(xw.w), bf_hi(xw.w)} * DN_ALPHA + g2b * ffb; } }
#pragma unroll
        for (int q = 0; q < 2; ++q) { const int t = tt[q];
            float s = 0.f;
#pragma unroll
            for (int j = 0; j < 2; ++j)
#pragma unroll
                for (int h = 0; h < 2; ++h) s += (v[q][j][h][0] + v[q][j][h][1]) + (v[q][j][h][2] + v[q][j][h][3]);
            s = wave_sum(s); const float mean = s * (1.0f / 1024.0f); float qq = 0.f;
#pragma unroll
            for (int j = 0; j < 2; ++j)
#pragma unroll
                for (int h = 0; h < 2; ++h) { const f32x4 d = v[q][j][h] - mean; qq += (d[0] * d[0] + d[1] * d[1]) + (d[2] * d[2] + d[3] * d[3]); }
            qq = wave_sum(qq); const float rstd = __builtin_amdgcn_rsqf(qq * (1.0f / 1024.0f) + LN_EPS);
            if (q == 0 || two) {
#pragma unroll
                for (int j = 0; j < 2; ++j)
#pragma unroll
                    for (int h = 0; h < 2; ++h) { const int k = 512 * j + l8 + 4 * h; const f32x4 g = *(const f32x4*)(F.in[I_LN2G] + k), bb = *(const f32x4*)(F.in[I_LN2B] + k);
                        const f32x4 o4 = (v[q][j][h] - mean) * rstd * g + bb;
                        if (!dry) *(f32x4*)(O + (size_t)t * 1024 + k) = o4; else if (o4[0] == 1.2345e30f) O[0] = 1.f; } }
        }
    }
}

constexpr int SC_QD = 0, SC_KI = 17408, SC_KE = 34816, SC_VT = 53248, SC_SC = 71680, SC_ST = 80896, SC_GV = 115712, SC_CS = 116224;
__device__ __forceinline__ bf16x8 ldfrag(const LAS unsigned char* p) { return *(const LAS bf16x8*)p; }
__device__ __forceinline__ void p3_scan(const Frame& F, const bool dry) {
    LAS unsigned char* L = F.lds;
    const int tid = F.tid, w = F.wave, lane = F.lane, fr = lane & 15, fq = lane >> 4;
    const int d = tid & 127, qd = __builtin_amdgcn_readfirstlane(tid >> 7);
    bf16_t* PH = (bf16_t*)(F.ws + WS_PH); const bf16_t* PHC = (const bf16_t*)(F.ws + WS_PHC);
    for (int it = F.c; it < 256; it += F.G) {
        const int b = it >> 3, h = (it >> 1) & 3, dir = it & 1;
        const float r0 = F.in[I_LBRAW][dir * 512 + h * 128 + d], r1 = F.in[I_LBRAW][1024 + dir * 512 + h * 128 + d];
        const float lbv = fast_sigmoid(r0 - r1), oml = 1.0f - lbv;
        f32x4 Sacc[8];
#pragma unroll
        for (int i = 0; i < 8; ++i) Sacc[i] = (f32x4){0.f, 0.f, 0.f, 0.f};
        __syncthreads();
        for (int i = tid; i < 34816 / 4; i += NTHR) ((LAS unsigned*)(L + SC_ST))[i] = 0u;
        const int cq = h * 128 + d, cz = (dir ? 3584 : 512) + h * 128 + d;
        unsigned char rq[16], rv[16], rz[16];
        {   const int n = dir ? 3 : 0; const bf16_t* base = PHC + (size_t)(b * 256 + 64 * n + 16 * qd) * 2048; const unsigned char* base8 = (const unsigned char*)base;
#pragma unroll
            for (int i = 0; i < 16; ++i) { rq[i] = base8[(size_t)i * 4096 + cq]; rz[i] = base8[(size_t)i * 4096 + cz]; rv[i] = base8[(size_t)i * 4096 + 3072 + cq]; } }
        for (int s = 0; s < 36; ++s) {
            const bool lat = s >= 4; const int n = lat ? (dir ? 31 - (s - 4) : (s - 4)) : (dir ? 3 - s : s);
            float kk[16], cum[16]; float run = 0.f;
#pragma unroll
            for (int i = 0; i < 16; ++i) { const float sg = (float)rz[i] * (1.0f / 255.0f); kk[i] = oml * (1.0f - sg); cum[i] = lbv + oml * sg; }
            run = 1.0f;
            if (dir == 0) {
#pragma unroll
                for (int i = 0; i < 16; ++i) { run *= cum[i]; cum[i] = run; }
            } else {
#pragma unroll
                for (int i = 15; i >= 0; --i) { run *= cum[i]; cum[i] = run; }
            }
            ((LAS float*)(L + SC_CS))[qd * 128 + d] = run;
            __syncthreads();
            {   const LAS float* cs = (const LAS float*)(L + SC_CS);
                const float c0 = cs[d], c1 = cs[128 + d], c2 = cs[256 + d], c3 = cs[384 + d], tot = (c0 * c1) * (c2 * c3);
                float off;
                if (dir == 0) off = (qd > 0 ? c0 : 1.f) * (qd > 1 ? c1 : 1.f) * (qd > 2 ? c2 : 1.f);
                else off = (qd < 3 ? c3 : 1.f) * (qd < 2 ? c2 : 1.f) * (qd < 1 ? c1 : 1.f);
                const float g = tot;
                if (qd == 0) ((LAS float*)(L + SC_GV))[d] = g;
                unsigned ke[8], vt[8];
#pragma unroll
                for (int i = 0; i < 16; i += 2) {
                    const float ea = cum[i] * off, eb = cum[i + 1] * off, ia = __builtin_amdgcn_rcpf(ea), ib = __builtin_amdgcn_rcpf(eb);
                    const float qda = __builtin_amdgcn_cvt_f32_fp8((int)rq[i], 0) * ea, qdb = __builtin_amdgcn_cvt_f32_fp8((int)rq[i + 1], 0) * eb;
                    const float kia = kk[i] * ia, kib = kk[i + 1] * ib;
                    const unsigned wa = cvt_pk_bf16(qda, kia), wb = cvt_pk_bf16(qdb, kib);
                    *(LAS bf16_t*)(L + SC_QD + (16 * qd + i) * 272 + d * 2) = (bf16_t)(wa & 0xffffu);
                    *(LAS bf16_t*)(L + SC_KI + (16 * qd + i) * 272 + d * 2) = (bf16_t)(wa >> 16);
                    *(LAS bf16_t*)(L + SC_QD + (16 * qd + i + 1) * 272 + d * 2) = (bf16_t)(wb & 0xffffu);
                    *(LAS bf16_t*)(L + SC_KI + (16 * qd + i + 1) * 272 + d * 2) = (bf16_t)(wb >> 16);
                    ke[i >> 1] = cvt_pk_bf16(kia * g, kib * g);
                    vt[i >> 1] = cvt_pk_bf16(__builtin_amdgcn_cvt_f32_fp8((int)rv[i], 0), __builtin_amdgcn_cvt_f32_fp8((int)rv[i + 1], 0));
                }
                *(LAS u32x4*)(L + SC_KE + d * 144 + 32 * qd) = (u32x4){ke[0], ke[1], ke[2], ke[3]};
                *(LAS u32x4*)(L + SC_KE + d * 144 + 32 * qd + 16) = (u32x4){ke[4], ke[5], ke[6], ke[7]};
                *(LAS u32x4*)(L + SC_VT + d * 144 + 32 * qd) = (u32x4){vt[0], vt[1], vt[2], vt[3]};
                *(LAS u32x4*)(L + SC_VT + d * 144 + 32 * qd + 16) = (u32x4){vt[4], vt[5], vt[6], vt[7]};
            }
            if (s + 1 < 36) {
                const int s1 = s + 1; const bool lat1 = s1 >= 4; const int n1 = lat1 ? (dir ? 31 - (s1 - 4) : (s1 - 4)) : (dir ? 3 - s1 : s1);
                const bf16_t* base = lat1 ? (const bf16_t*)PH + (size_t)(b * 2048 + 64 * n1 + 16 * qd) * 2048 : PHC + (size_t)(b * 256 + 64 * n1 + 16 * qd) * 2048;
                const unsigned char* base8 = (const unsigned char*)base;
#pragma unroll
                for (int i = 0; i < 16; ++i) { rq[i] = base8[(size_t)i * 4096 + cq]; rz[i] = base8[(size_t)i * 4096 + cz]; rv[i] = base8[(size_t)i * 4096 + 3072 + cq]; }
            }
            __syncthreads();
            f32x4 oacc[4];
#pragma unroll
            for (int i = 0; i < 4; ++i) oacc[i] = (f32x4){0.f, 0.f, 0.f, 0.f};
            const int kb = fq * 16;
            if (lat) {
                const int ct = w >> 1, st0 = 2 * (w & 1);
#pragma unroll
                for (int j = 0; j < 2; ++j) { const int st = st0 + j; f32x4 sa = (f32x4){0.f, 0.f, 0.f, 0.f};
#pragma unroll
                    for (int ks = 0; ks < 4; ++ks) sa = __builtin_amdgcn_mfma_f32_16x16x32_bf16(ldfrag(L + SC_KI + (16 * st + fr) * 272 + ks * 64 + kb), ldfrag(L + SC_QD + (16 * ct + fr) * 272 + ks * 64 + kb), sa, 0, 0, 0);
                    const int cc = 16 * ct + fr, s0 = 16 * st + 4 * fq;
#pragma unroll
                    for (int i = 0; i < 4; ++i) { const bool keep = dir ? (s0 + i >= cc) : (s0 + i <= cc); sa[i] = keep ? sa[i] : 0.f; }
                    *(LAS u32x2*)(L + SC_SC + cc * 144 + s0 * 2) = (u32x2){cvt_pk_bf16(sa[0], sa[1]), cvt_pk_bf16(sa[2], sa[3])}; }
#pragma unroll
                for (int ct2 = 0; ct2 < 4; ++ct2)
#pragma unroll
                    for (int ks = 0; ks < 4; ++ks) oacc[ct2] = __builtin_amdgcn_mfma_f32_16x16x32_bf16(ldfrag(L + SC_ST + (16 * w + fr) * 272 + ks * 64 + kb), ldfrag(L + SC_QD + (16 * ct2 + fr) * 272 + ks * 64 + kb), oacc[ct2], 0, 0, 0);
            }
            {   const bf16x8 v0 = ldfrag(L + SC_VT + (16 * w + fr) * 144 + kb), v1 = ldfrag(L + SC_VT + (16 * w + fr) * 144 + 64 + kb);
#pragma unroll
                for (int dt = 0; dt < 8; ++dt) { const f32x4 gv = *(const LAS f32x4*)(L + SC_GV + (16 * dt + 4 * fq) * 4);
                    f32x4 a = Sacc[dt] * gv;
                    a = __builtin_amdgcn_mfma_f32_16x16x32_bf16(ldfrag(L + SC_KE + (16 * dt + fr) * 144 + kb), v0, a, 0, 0, 0);
                    a = __builtin_amdgcn_mfma_f32_16x16x32_bf16(ldfrag(L + SC_KE + (16 * dt + fr) * 144 + 64 + kb), v1, a, 0, 0, 0);
                    Sacc[dt] = a; } }
            __syncthreads();
#pragma unroll
            for (int dt = 0; dt < 8; ++dt) *(LAS u32x2*)(L + SC_ST + (16 * w + fr) * 272 + (16 * dt + 4 * fq) * 2) = (u32x2){cvt_pk_bf16(Sacc[dt][0], Sacc[dt][1]), cvt_pk_bf16(Sacc[dt][2], Sacc[dt][3])};
            if (lat) {
                const bf16x8 v0 = ldfrag(L + SC_VT + (16 * w + fr) * 144 + kb), v1 = ldfrag(L + SC_VT + (16 * w + fr) * 144 + 64 + kb);
                unsigned char* ob = (unsigned char*)PH + (size_t)(b * 2048 + 64 * n) * 4096 + 1024 + dir * 1024 + h * 128 + 16 * w + 4 * fq;
#pragma unroll
                for (int ct2 = 0; ct2 < 4; ++ct2) {
                    f32x4 a = oacc[ct2];
                    a = __builtin_amdgcn_mfma_f32_16x16x32_bf16(v0, ldfrag(L + SC_SC + (16 * ct2 + fr) * 144 + kb), a, 0, 0, 0);
                    a = __builtin_amdgcn_mfma_f32_16x16x32_bf16(v1, ldfrag(L + SC_SC + (16 * ct2 + fr) * 144 + 64 + kb), a, 0, 0, 0);
                    if (!dry) *(unsigned*)(ob + (size_t)(16 * ct2 + fr) * 4096) = cvt_pk4_fp8(a[0], a[1], a[2], a[3]);
                    else if (a[0] == 1.2345e30f) ob[0] = 1; }
            }
        }
        __syncthreads();
    }
}

typedef short s16x4 __attribute__((ext_vector_type(4)));
__device__ __forceinline__ s16x4 tr_read(unsigned lds_addr) { s16x4 r; asm volatile("ds_read_b64_tr_b16 %0, %1\n\ts_waitcnt lgkmcnt(0)" : "=&v"(r) : "v"(lds_addr) : "memory"); return r; }
__device__ __forceinline__ void tr_read8(unsigned a0, unsigned a1, unsigned a2, unsigned a3, unsigned d, s16x4 (&r)[8]) {
    asm volatile("ds_read_b64_tr_b16 %0, %8\n\tds_read_b64_tr_b16 %1, %9\n\tds_read_b64_tr_b16 %2, %10\n\tds_read_b64_tr_b16 %3, %11\n\t"
                 "ds_read_b64_tr_b16 %4, %12\n\tds_read_b64_tr_b16 %5, %13\n\tds_read_b64_tr_b16 %6, %14\n\tds_read_b64_tr_b16 %7, %15\n\ts_waitcnt lgkmcnt(0)"
                 : "=&v"(r[0]), "=&v"(r[1]), "=&v"(r[2]), "=&v"(r[3]), "=&v"(r[4]), "=&v"(r[5]), "=&v"(r[6]), "=&v"(r[7])
                 : "v"(a0), "v"(a0 + d), "v"(a1), "v"(a1 + d), "v"(a2), "v"(a2 + d), "v"(a3), "v"(a3 + d) : "memory");
}
__device__ __forceinline__ void tr_read4(unsigned a0, unsigned a1, unsigned d, s16x4 (&r)[4]) {
    asm volatile("ds_read_b64_tr_b16 %0, %4\n\tds_read_b64_tr_b16 %1, %5\n\tds_read_b64_tr_b16 %2, %6\n\tds_read_b64_tr_b16 %3, %7\n\ts_waitcnt lgkmcnt(0)"
                 : "=&v"(r[0]), "=&v"(r[1]), "=&v"(r[2]), "=&v"(r[3]) : "v"(a0), "v"(a0 + d), "v"(a1), "v"(a1 + d) : "memory");
}
__device__ __forceinline__ bf16x8 cat4(s16x4 a, s16x4 b) { return (bf16x8){a[0], a[1], a[2], a[3], b[0], b[1], b[2], b[3]}; }
constexpr int FO_C = 131072, FO_S = 139264;
__device__ __forceinline__ void p4_fourier(const Frame& F) {
    LAS unsigned char* L = F.lds;
    const int tid = F.tid, w = F.wave, lane = F.lane, fr = lane & 15, fq = lane >> 4;
    const bf16_t* PA = (const bf16_t*)(F.ws + WS_PA); unsigned char* Y = (unsigned char*)(F.ws + WS_Y);
    __syncthreads();
    for (int i = tid; i < 4096; i += NTHR) { const int k2 = i >> 6, c = i & 63; const float a = (float)((k2 * c) & 63) * (1.0f / 64.0f);
        *(LAS bf16_t*)(L + FO_C + i * 2) = (bf16_t)(cvt_pk_bf16(__builtin_amdgcn_cosf(a) * 0.125f, 0.f) & 0xffffu);
        *(LAS bf16_t*)(L + FO_S + i * 2) = (bf16_t)(cvt_pk_bf16(__builtin_amdgcn_sinf(a) * 0.125f, 0.f) & 0xffffu); }
    bf16x8 Gf[2][2];
#pragma unroll
    for (int nt = 0; nt < 2; ++nt)
#pragma unroll
        for (int ks = 0; ks < 2; ++ks) { unsigned pk[4];
#pragma unroll
            for (int j = 0; j < 8; j += 2) { const int k1 = 16 * nt + fr, ra = 8 * fq + j, rb = ra + 1; const float aa = (float)((k1 * ra) & 31) * (1.0f / 32.0f), ab = (float)((k1 * rb) & 31) * (1.0f / 32.0f);
                const float va = (ks ? __builtin_amdgcn_sinf(aa) : __builtin_amdgcn_cosf(aa)) * 0.17677669529663687f, vb = (ks ? __builtin_amdgcn_sinf(ab) : __builtin_amdgcn_cosf(ab)) * 0.17677669529663687f;
                pk[j >> 1] = cvt_pk_bf16(va, vb); }
            u32x4 t4 = (u32x4){pk[0], pk[1], pk[2], pk[3]}; Gf[nt][ks] = *(bf16x8*)&t4; }
    const unsigned lbase = (unsigned)(size_t)L;
    u32x4 pv[8];
    if (F.c < 1024) { const int it = F.c, xcd = it & 7, jj = it >> 3, slab = 4 * xcd + (jj & 3), b = jj >> 2; const unsigned char* src = (const unsigned char*)PA + (size_t)(b * 32 + slab) * 65536;
#pragma unroll
        for (int n = 0; n < 8; ++n) pv[n] = *(const u32x4*)(src + (size_t)(tid + NTHR * n) * 16); }
    for (int it = F.c; it < 1024; it += F.G) {
        const int xcd = it & 7, jj = it >> 3, slab = 4 * xcd + (jj & 3), b = jj >> 2;
        __syncthreads();
#pragma unroll
        for (int n = 0; n < 8; ++n) {
            const u32x4 w = pv[n]; u32x4 lo, hi;
            { const f32x4 a = fp8x4_to_f32(w.x), c = fp8x4_to_f32(w.y); lo = (u32x4){cvt_pk_bf16(a[0], a[1]), cvt_pk_bf16(a[2], a[3]), cvt_pk_bf16(c[0], c[1]), cvt_pk_bf16(c[2], c[3])}; }
            { const f32x4 a = fp8x4_to_f32(w.z), c = fp8x4_to_f32(w.w); hi = (u32x4){cvt_pk_bf16(a[0], a[1]), cvt_pk_bf16(a[2], a[3]), cvt_pk_bf16(c[0], c[1]), cvt_pk_bf16(c[2], c[3])}; }
            *(LAS u32x4*)(L + (tid + NTHR * n) * 32) = lo; *(LAS u32x4*)(L + (tid + NTHR * n) * 32 + 16) = hi; }
        __syncthreads();
        if (it + F.G < 1024) { const int it1 = it + F.G, xcd1 = it1 & 7, jj1 = it1 >> 3, slab1 = 4 * xcd1 + (jj1 & 3), b1 = jj1 >> 2; const unsigned char* src = (const unsigned char*)PA + (size_t)(b1 * 32 + slab1) * 65536;
#pragma unroll
            for (int n = 0; n < 8; ++n) pv[n] = *(const u32x4*)(src + (size_t)(tid + NTHR * n) * 16); }
#pragma unroll 1
        for (int rr = 0; rr < 4; ++rr) {
            const int r = w + 8 * rr;
            f32x4 acc[8];
#pragma unroll
            for (int i = 0; i < 8; ++i) acc[i] = (f32x4){0.f, 0.f, 0.f, 0.f};
            s16x4 tr[8];
            {   unsigned aa[4];
#pragma unroll
                for (int ks = 0; ks < 4; ++ks) { const int ri = ks >> 1, c0 = 32 * (ks & 1) + 8 * fq + (fr >> 2); aa[ks] = lbase + (unsigned)((r * 64 + c0) * 64 + ri * 32 + (fr & 3) * 8); }
                tr_read8(aa[0], aa[1], aa[2], aa[3], 4u * 64u, tr); }
#pragma unroll
            for (int ks = 0; ks < 4; ++ks) {
                const int ri = ks >> 1;
                const bf16x8 af = cat4(tr[2 * ks], tr[2 * ks + 1]);
#pragma unroll
                for (int nt = 0; nt < 8; ++nt) { const int ro = nt >> 2, k2 = 16 * (nt & 3) + fr;
                    u32x4 bw = *(const LAS u32x4*)(L + ((ro == ri) ? FO_C : FO_S) + (k2 * 64 + 32 * (ks & 1) + 8 * fq) * 2);
                    if (ro == 1 && ri == 0) { bw.x ^= 0x80008000u; bw.y ^= 0x80008000u; bw.z ^= 0x80008000u; bw.w ^= 0x80008000u; }
                    acc[nt] = __builtin_amdgcn_mfma_f32_16x16x32_bf16(af, *(bf16x8*)&bw, acc[nt], 0, 0, 0); }
            }
#pragma unroll
            for (int nt = 0; nt < 8; ++nt) { const int ro = nt >> 2, k2 = 16 * (nt & 3) + fr;
                *(LAS u32x2*)(L + (r * 64 + k2) * 64 + ro * 32 + fq * 8) = (u32x2){cvt_pk_bf16(acc[nt][0], acc[nt][1]), cvt_pk_bf16(acc[nt][2], acc[nt][3])}; }
        }
        __syncthreads();
#pragma unroll 1
        for (int kk = 0; kk < 8; ++kk) {
            const int k2 = 8 * w + kk;
            f32x4 a2[2] = {(f32x4){0.f, 0.f, 0.f, 0.f}, (f32x4){0.f, 0.f, 0.f, 0.f}};
            s16x4 t4[4];
            {   const int r0 = 8 * fq + (fr >> 2); const unsigned a0 = lbase + (unsigned)((r0 * 64 + k2) * 64 + (fr & 3) * 8);
                tr_read4(a0, a0 + 32u, 4u * 64u * 64u, t4); }
#pragma unroll
            for (int ks = 0; ks < 2; ++ks) {
                const bf16x8 af = cat4(t4[2 * ks], t4[2 * ks + 1]);
                a2[0] = __builtin_amdgcn_mfma_f32_16x16x32_bf16(af, Gf[0][ks], a2[0], 0, 0, 0);
                a2[1] = __builtin_amdgcn_mfma_f32_16x16x32_bf16(af, Gf[1][ks], a2[1], 0, 0, 0);
            }
#pragma unroll
            for (int nt = 0; nt < 2; ++nt) { const int k1 = 16 * nt + fr;
                *(unsigned*)(Y + (size_t)(b * 2048 + k1 * 64 + k2) * 1024 + slab * 16 + 4 * fq) = cvt_pk4_fp8(a2[nt][0], a2[nt][1], a2[nt][2], a2[nt][3]); }
        }
    }
    __syncthreads();
}

struct Args { const float* in[22]; float* out; unsigned char* ws; int ph_lo, ph_hi; };
constexpr int N_PHASES = 9 + 3 * NCH;

__global__ void __launch_bounds__(NTHR, 2) mega_fwd(Args args) {
    extern __shared__ __attribute__((aligned(16))) unsigned char lds_raw[];
    Frame F;
    F.lds = (LAS unsigned char*)lds_raw;
    F.tid = threadIdx.x; F.lane = F.tid & 63; F.wave = __builtin_amdgcn_readfirstlane(F.tid >> 6);
    F.G = gridDim.x; F.c = blockIdx.x;
    F.in = args.in;
    F.out = args.out; F.ws = args.ws; F.ctl = (unsigned*)(args.ws + WS_CTL);
    volatile LAS unsigned* misc = (volatile LAS unsigned*)(F.lds + LDS_MISC);
    if (F.tid < 4) misc[F.tid] = 0u;
    __syncthreads();
    XcdBarrier bar = xcd_barrier_post(F.ctl, misc);
    const int lo = args.ph_lo, hi = args.ph_hi;
#ifndef PHASE_MASK
#define PHASE_MASK 0xFFFFFFFFu
#endif
#define IN(k) ((((PHASE_MASK) >> (k)) & 1u) && lo <= (k) && (k) < hi)
#define SEAM(k) do { if (IN(k) && IN((k) + 1)) xcd_barrier(bar); } while (0)
#ifndef REP_MASK
#define REP_MASK 0u
#endif
#define REPS(b) ((((REP_MASK) >> (b)) & 1u) ? 2 : 1)
#define REPBAR(b, r) do { if ((((REP_MASK) >> (b)) & 1u) && (r) == 0) xcd_barrier(bar); } while (0)
    unsigned char* ws = F.ws;
    LAS unsigned char* blk_e = F.lds + LDS_MISC + 64;
#ifdef PR_A
    unsigned long long* stamps = (unsigned long long*)(ws + 980 * MiB);
#define STAMP(slot) do { if (F.tid == 0) stamps[(slot) * 256 + F.c] = __builtin_amdgcn_s_memrealtime(); } while (0)
#else
#define STAMP(slot) do { } while (0)
#endif
    STAMP(0);

    if (IN(0)) { for (int r = 0; r < REPS(0); ++r) { p0_ada(F); p0_fold(F); p0_convert(F); REPBAR(0, r); } }
    STAMP(1);
    SEAM(0);
    if (IN(1)) { for (int r = 0; r < REPS(1); ++r) { p1_uprep(F); REPBAR(1, r); } }
    STAMP(2);
    SEAM(1);
    if (IN(2)) {
        ProbP1 P{(const char*)(ws + WS_U), 8, 1024u, 1024u, (const char*)(ws + WS_WIN1T), (unsigned)(WS_UC - WS_U), F.G, F.c};
        EpiP1 E{(bf16_t*)(ws + WS_PA), (bf16_t*)(ws + WS_PH), (bf16_t*)(ws + WS_PHC)};
        for (int r = 0; r < REPS(2); ++r) { pg8::gemm_phase<ProbP1, EpiP1, true, false, true>(F.lds, P, E); REPBAR(2, r); }
    }
    STAMP(3);
    SEAM(2);
    if (IN(3)) {
#ifndef NO_FOURIER
        for (int r = 0; r < REPS(4); ++r) { p4_fourier(F); REPBAR(4, r); }
        STAMP(5);
#endif
#ifndef NO_SCAN
        for (int r = 0; r < REPS(3); ++r) { p3_scan(F, r + 1 < REPS(3)); REPBAR(3, r); }
        STAMP(4);
#endif
#ifndef NO_P2GEMM
        ProbDense P{(const char*)(ws + WS_U), 8, 1024u, 1024u, (const char*)(ws + WS_WIN2T), 256, 10, F.G, F.c, 0};
        EpiP2 E{(unsigned char*)(ws + WS_PG), (unsigned char*)F.out};
        for (int r = 0; r < REPS(5); ++r) { pg8::gemm_phase<ProbDense, EpiP2, true, false, true>(F.lds, P, E); REPBAR(5, r); }
#endif
    }
    STAMP(6);
    SEAM(3);
    if (IN(4)) { for (int r = 0; r < REPS(6); ++r) { p6_readout(F); REPBAR(6, r); } }
    STAMP(7);
    SEAM(4);
    if (IN(5)) {
        ProbDense P{(const char*)(ws + WS_Y), 8, 1024u, 1024u, (const char*)(ws + WS_WMT), 256, 4, F.G, F.c, 1};
        EpiM1 E{(const unsigned char*)F.out, (unsigned char*)(ws + WS_PA)};
        for (int r = 0; r < REPS(7); ++r) { pg8::gemm_phase<ProbDense, EpiM1, true, true, true>(F.lds, P, E); REPBAR(7, r); }
    }
    STAMP(8);
    SEAM(5);
    if (IN(6)) {
        ProbDense P{(const char*)(ws + WS_PA), 8, 1024u, 1024u, (const char*)(ws + WS_WOT), 256, 4, F.G, F.c, 0};
        EpiM2 E{(const float*)(ws + WS_ADA), (unsigned char*)F.out};
        for (int r = 0; r < REPS(8); ++r) { pg8::gemm_phase<ProbDense, EpiM2, true, false, true>(F.lds, P, E); REPBAR(8, r); }
    }
    STAMP(9);
    SEAM(6);
    if (IN(7)) { for (int r = 0; r < REPS(9); ++r) { p9_ln1_router(fresh(F), r + 1 < REPS(9)); REPBAR(9, r); } }
    STAMP(10);
    SEAM(7);
    if (IN(8)) { p10_dispatch(F); }
    STAMP(11);
    SEAM(8);
#pragma unroll
    for (int ch = 0; ch < NCH; ++ch) {
        if (IN(9 + 3 * ch)) {
            const int nblk = moe_blocks(F, ch, blk_e);
            ProbMoE<true> P{(const char*)(ws + WS_U), 8, 1024u, 1024u, (const char*)(ws + WS_WGUT), (size_t)2048 * 1024, 8, nblk, F.G, F.c, (const int*)(ws + WS_ROWTOK) + (size_t)ch * ROWS_CH, blk_e};
            EpiGU E{F.in[I_BGU], (unsigned char*)(ws + WS_ACT)};
#ifdef GU_DRY
            pg8::gemm_phase<ProbMoE<true>, EpiGU, true, false, true, GU_DRY>(F.lds, P, E); xcd_barrier(bar);
#endif
            for (int r = 0; r < (ch == 0 ? REPS(10) : 1); ++r) { pg8::gemm_phase<ProbMoE<true>, EpiGU, true, false, true>(F.lds, P, E); if (ch == 0) REPBAR(10, r); }
        }
        STAMP(12);
        SEAM(9 + 3 * ch);
        if (IN(10 + 3 * ch)) {
            const int nblk = moe_blocks(F, ch, blk_e);
            ProbMoE<false> P{(const char*)(ws + WS_ACT), 8, 1024u, 1024u, (const char*)(ws + WS_WDNT), (size_t)1024 * 1024, 4, nblk, F.G, F.c, nullptr, blk_e};
            EpiDN E{F.in[I_BDN], (unsigned char*)(ws + WS_YCH)};
            for (int r = 0; r < (ch == 0 ? REPS(11) : 1); ++r) { pg8::gemm_phase<ProbMoE<false>, EpiDN, true, false, true>(F.lds, P, E); if (ch == 0) REPBAR(11, r); }
        }
        STAMP(13);
        SEAM(10 + 3 * ch);
        if (IN(11 + 3 * ch)) { for (int r = 0; r < (ch == 0 ? REPS(12) : 1); ++r) { p13_combine_ln2(F, ch, ch == 0 && r + 1 < REPS(12)); if (ch == 0) REPBAR(12, r); } }
        STAMP(14);
        SEAM(11 + 3 * ch);
    }
#ifdef DBG_K
    xcd_barrier(bar);
    {
        const unsigned char* buf = (DBG_OUT) ? (const unsigned char*)F.out : (const unsigned char*)(ws + (size_t)(DBG_OFF));
        const size_t wpr = (size_t)(DBG_CW) / 4, nw = (size_t)(DBG_ROWS) * wpr;
        unsigned long long cs = 0; unsigned bad = 0;
        for (size_t i = (size_t)F.c * NTHR + F.tid; i < nw; i += (size_t)F.G * NTHR) { const size_t r = i / wpr, cw = i % wpr; const unsigned w = *(const unsigned*)(buf + r * (size_t)(DBG_LD) + (DBG_C0) + cw * 4); cs += w;
            if (DBG_F32) { if ((w & 0x7f800000u) == 0x7f800000u) ++bad; } else { if ((w & 0x7f80u) == 0x7f80u) ++bad; if ((w & 0x7f800000u) == 0x7f800000u) ++bad; } }
        for (int o = 32; o >= 1; o >>= 1) { cs += __shfl_xor(cs, o); bad += __shfl_xor(bad, o); }
        if (F.lane == 0) { atomicAdd((unsigned long long*)(F.ctl + 8192), cs); atomicAdd(F.ctl + 8200, bad); }
        if (F.c == 0 && F.tid == 0) atomicAdd(F.ctl + 8201, xb_ld(&F.ctl[XB_TMO]));
    }
    xcd_barrier(bar);
    {
        const unsigned long long cs = __hip_atomic_load((unsigned long long*)(F.ctl + 8192), __ATOMIC_RELAXED, __HIP_MEMORY_SCOPE_AGENT);
        const unsigned bad = xb_ld(F.ctl + 8200), tmo = xb_ld(F.ctl + 8201);
        const float val = (float)(unsigned)((cs ^ (cs >> 16) ^ (cs >> 32)) & 0xFFFFu) * (1.0f / 65536.0f) + (bad ? 2.0f : 0.0f) + (tmo ? 4.0f : 0.0f);
        for (size_t i = (size_t)F.c * NTHR + F.tid; i < (size_t)T * D; i += (size_t)F.G * NTHR) F.out[i] = val;
    }
    return;
#endif
#ifdef PR_A
    xcd_barrier(bar);
    {
        auto maxs = [&](int sl) { unsigned long long m = 0; for (int w = 0; w < (int)F.G; ++w) { const unsigned long long v = stamps[sl * 256 + w]; m = v > m ? v : m; } return m; };
        auto dur = [&](int sl) -> float {
            if (sl == 4) { const unsigned long long st = maxs(3); double a = 0; for (int w = 0; w < (int)F.G; ++w) a += (double)(stamps[4 * 256 + w] - st); return (float)(a / F.G) * 0.01f; }
            if (sl == 5) { double a = 0; for (int w = 0; w < (int)F.G; ++w) a += (double)(stamps[5 * 256 + w] - stamps[4 * 256 + w]); return (float)(a / F.G) * 0.01f; }
            if (sl == 6) { double a = 0; for (int w = 0; w < (int)F.G; ++w) a += (double)(stamps[6 * 256 + w] - stamps[5 * 256 + w]); return (float)(a / F.G) * 0.01f; }
            if (sl == 16) return (float)(maxs(6) - maxs(3)) * 0.01f;
            return (float)(maxs(sl) - maxs(sl - 1)) * 0.01f; };
        const float va = rintf(dur(PR_A) * 0.1f + (PR_OFF)) * 0.1f, vb = rintf(dur(PR_B) * 0.1f + (PR_OFF)) * 10.0f;
        for (size_t i = (size_t)F.c * NTHR + F.tid; i < (size_t)T * D; i += (size_t)F.G * NTHR) F.out[i] = va;
        __syncthreads();
        if (F.c == 0 && F.tid == 0) F.out[12345] = vb;
    }
    return;
#endif
    if (F.c == 0 && F.tid == 0 && hi == N_PHASES) { if (xb_ld(&F.ctl[XB_TMO]) != 0u) F.out[0] = __builtin_nanf(""); }
#undef IN
#undef SEAM
}

extern "C" void kernel_launch(void* const* d_in, const int* in_sizes, int n_in, void* d_out, int out_size, void* d_ws, size_t ws_size, hipStream_t stream) {
    static int grid = 0;
    if (grid == 0) {
        if (n_in != 22 || out_size != T * D || ws_size < WS_END) { fprintf(stderr, "kernel_launch: unexpected shapes (n_in %d, out %d, ws %zu)\n", n_in, out_size, ws_size); grid = -1; return; }
        int dev = 0, cus = 0, per_cu = 0;
        if (hipGetDevice(&dev) != hipSuccess || hipDeviceGetAttribute(&cus, hipDeviceAttributeMultiprocessorCount, dev) != hipSuccess) { grid = -1; return; }
        if (hipFuncSetAttribute((const void*)mega_fwd, hipFuncAttributeMaxDynamicSharedMemorySize, LDS_BYTES) != hipSuccess) { fprintf(stderr, "kernel_launch: hipFuncSetAttribute failed\n"); grid = -1; return; }
        if (hipOccupancyMaxActiveBlocksPerMultiprocessor(&per_cu, (const void*)mega_fwd, NTHR, LDS_BYTES) != hipSuccess || per_cu < 1) fprintf(stderr, "kernel_launch: occupancy query reports %d blocks per CU\n", per_cu);
        (void)hipGetLastError();
        grid = cus;
    }
    if (grid < 0) return;
    (void)hipMemsetAsync((char*)d_ws + WS_CTL, 0, CTL_BYTES, stream);
    Args a{};
    for (int i = 0; i < 22; ++i) a.in[i] = (const float*)d_in[i];
    a.out = (float*)d_out; a.ws = (unsigned char*)d_ws; a.ph_lo = 0; a.ph_hi = N_PHASES;
#ifdef DBG_K
    a.ph_hi = DBG_K;
#endif
    hipLaunchKernelGGL(mega_fwd, dim3(grid), dim3(NTHR), LDS_BYTES, stream, a);
}
```

```cpp
#include <hip/hip_runtime.h>
#include <cstdio>
#include <cstdint>

#define LAS __attribute__((address_space(3)))
typedef unsigned short bf16_t;
typedef short bf16x8 __attribute__((ext_vector_type(8)));
typedef short bf16x4 __attribute__((ext_vector_type(4)));
typedef float f32x4 __attribute__((ext_vector_type(4)));
typedef float f32x2 __attribute__((ext_vector_type(2)));
typedef unsigned u32x4 __attribute__((ext_vector_type(4)));
typedef unsigned u32x2 __attribute__((ext_vector_type(2)));

constexpr int D = 1024, NB = 32, SEQ = 2048, T = NB * SEQ, CTX = 256, TCX = NB * CTX;
#ifndef NCH_SET
#define NCH_SET 1
#endif
constexpr int NEXP = 32, TOPK = 4;
constexpr int NCH = NCH_SET, TCH = T / NCH;
constexpr int ROWS_CH = TCH * TOPK + NEXP * 256;
constexpr float DN_ALPHA = 1.189207115002721f;
constexpr float LN_EPS = 1e-5f, RMS_EPS = 1e-6f;
constexpr int NTHR = 512;

constexpr size_t MiB = 1ull << 20;
constexpr size_t WS_CTL = 0;
constexpr size_t CTL_BYTES = 65536;
constexpr size_t WS_ADA = 65536;
constexpr size_t WS_WIN1T = 1 * MiB;
constexpr size_t WS_WIN2T = 7 * MiB;
constexpr size_t WS_WMT = 12 * MiB;
constexpr size_t WS_WOT = 14 * MiB;
constexpr size_t WS_WGUT = 16 * MiB;
constexpr size_t WS_WDNT = 80 * MiB;
constexpr size_t WS_TOPI = 112 * MiB;
constexpr size_t WS_TOPW = 113 * MiB;
constexpr size_t WS_POS = 114 * MiB;
constexpr size_t WS_ROWTOK = 115 * MiB;
constexpr size_t WS_U = 120 * MiB;
constexpr size_t WS_PA = 184 * MiB;
constexpr size_t WS_PH = 312 * MiB;
constexpr size_t WS_PHC = 568 * MiB;
constexpr size_t WS_PG = 600 * MiB;
constexpr size_t WS_Y = 664 * MiB;
constexpr size_t WS_UC = WS_Y;
constexpr size_t WS_ACT = WS_PA;
constexpr size_t WS_YCH = WS_PA + 264 * MiB;
constexpr size_t WS_X1 = WS_YCH + 264 * MiB;
constexpr size_t WS_END = 976 * MiB;
static_assert(WS_X1 + 128 * MiB <= WS_END && (size_t)ROWS_CH * 1024 <= 264 * MiB && WS_Y + 128 * MiB <= WS_END, "ws map");
constexpr int CW_CNT = 4096;
constexpr int CW_CUR = 4096 + 64;

constexpr int LDS_SCRATCH = 155648;
constexpr int LDS_MISC = LDS_SCRATCH;
constexpr int LDS_BYTES = LDS_SCRATCH + 2048;

typedef __bf16 bf16x2_t __attribute__((ext_vector_type(2)));
__device__ __forceinline__ unsigned cvt_pk_bf16(float lo, float hi) { const f32x2 v = {lo, hi}; const bf16x2_t r = __builtin_convertvector(v, bf16x2_t); return __builtin_bit_cast(unsigned, r); }
__device__ __forceinline__ unsigned cvt_pk4_fp8(float a, float b, float c, float d) {
    a = fminf(fmaxf(a, -448.f), 448.f); b = fminf(fmaxf(b, -448.f), 448.f); c = fminf(fmaxf(c, -448.f), 448.f); d = fminf(fmaxf(d, -448.f), 448.f);
    int w = __builtin_amdgcn_cvt_pk_fp8_f32(a, b, 0, false); w = __builtin_amdgcn_cvt_pk_fp8_f32(c, d, w, true); return (unsigned)w; }
constexpr float W8_SCALE = 32.0f, W8_INV = 1.0f / 32.0f;
typedef float f32x2v __attribute__((ext_vector_type(2)));
__device__ __forceinline__ f32x4 fp8x4_to_f32(unsigned w) { const f32x2v a = __builtin_amdgcn_cvt_pk_f32_fp8((int)w, false), b = __builtin_amdgcn_cvt_pk_f32_fp8((int)w, true); return (f32x4){a[0], a[1], b[0], b[1]}; }
__device__ __forceinline__ u32x4 widen16(u32x2 a, u32x2 b) {
    const u32x2 rx = __builtin_amdgcn_permlane16_swap(a.x, b.x, false, false), ry = __builtin_amdgcn_permlane16_swap(a.y, b.y, false, false);
    return (u32x4){rx[0], ry[0], rx[1], ry[1]}; }
__device__ __forceinline__ void unwiden16(u32x4 L, u32x2& a, u32x2& b) {
    const u32x2 rx = __builtin_amdgcn_permlane16_swap(L.x, L.z, false, false), ry = __builtin_amdgcn_permlane16_swap(L.y, L.w, false, false);
    a = (u32x2){rx[0], ry[0]}; b = (u32x2){rx[1], ry[1]}; }
__device__ __forceinline__ unsigned pack4_u8(float a, float b, float c, float d) {
    unsigned w = __builtin_amdgcn_cvt_pk_u8_f32(__builtin_rintf(a), 0, 0u); w = __builtin_amdgcn_cvt_pk_u8_f32(__builtin_rintf(b), 1, w);
    w = __builtin_amdgcn_cvt_pk_u8_f32(__builtin_rintf(c), 2, w); return __builtin_amdgcn_cvt_pk_u8_f32(__builtin_rintf(d), 3, w); }
__device__ __forceinline__ f32x4 u8x4_to_f32(unsigned w) { return (f32x4){(float)(w & 0xffu), (float)((w >> 8) & 0xffu), (float)((w >> 16) & 0xffu), (float)(w >> 24)}; }
__device__ __forceinline__ float bf_lo(unsigned w) { return __uint_as_float(w << 16); }
__device__ __forceinline__ float bf_hi(unsigned w) { return __uint_as_float(w & 0xffff0000u); }
__device__ __forceinline__ float bf2f(bf16_t v) { return __uint_as_float(((unsigned)v) << 16); }
__device__ __forceinline__ float fast_exp(float x) { return __builtin_amdgcn_exp2f(x * 1.4426950408889634f); }
__device__ __forceinline__ float fast_sigmoid(float x) { return __builtin_amdgcn_rcpf(1.0f + fast_exp(-x)); }
__device__ __forceinline__ float fast_log(float x) { return __builtin_amdgcn_logf(x) * 0.6931471805599453f; }

#define XB_TMO      128
#define XB_XCNT(j)  (256  + 64 * (j))
#define XB_XSUB(j)  (1280 + 64 * (j))
#define XB_XGEN(j)  (2304 + 64 * (j))
#define XB_TOP      3328
#define XB_TOPGEN   3392
#define XCD_BAR_WORDS 3456
#define XB_SPIN_CAP (1u << 18)

__device__ __forceinline__ unsigned xb_ld(unsigned* p)              { return __hip_atomic_load(p, __ATOMIC_RELAXED, __HIP_MEMORY_SCOPE_AGENT); }
__device__ __forceinline__ unsigned xb_add(unsigned* p, unsigned v) { return __hip_atomic_fetch_add(p, v, __ATOMIC_RELAXED, __HIP_MEMORY_SCOPE_AGENT); }
__device__ __forceinline__ unsigned xb_xcc_id() { return (unsigned)__builtin_amdgcn_s_getreg((3 << 11) | 20) & 0xFu; }
#define XB_SPIN(cond, bar) do { unsigned _sp = 0; while (cond) { __builtin_amdgcn_s_sleep(1); \
    if ((++_sp & 255u) == 0u) { if (xb_ld(&(bar)[XB_TMO])) break; if (_sp > XB_SPIN_CAP) { atomicAdd(&(bar)[XB_TMO], 1u); break; } } } } while (0)

struct XcdBarrier { unsigned* bar; unsigned x; volatile LAS unsigned* st; };

__device__ __forceinline__ XcdBarrier xcd_barrier_post(unsigned* bar, volatile LAS unsigned* st) {
    XcdBarrier b; b.bar = bar; b.x = xb_xcc_id(); b.st = st;
    if (threadIdx.x == 0) (void)xb_add(&bar[XB_XCNT(b.x)], 1u);
    return b;
}
__device__ __forceinline__ void xcd_barrier_complete(unsigned* bar, unsigned x, unsigned& nloc, unsigned& nx) {
    const unsigned G = gridDim.x * gridDim.y * gridDim.z;
    unsigned sum, cnt, mine, sp = 0u;
    for (;;) {
        sum = 0u; cnt = 0u; mine = 0u;
#pragma unroll
        for (unsigned j = 0; j < 16; ++j) { const unsigned c = xb_ld(&bar[XB_XCNT(j)]); sum += c; cnt += (c > 0u) ? 1u : 0u; mine = (j == x) ? c : mine; }
        if (sum == G) break;
        __builtin_amdgcn_s_sleep(1);
        if ((++sp & 255u) == 0u) { if (xb_ld(&bar[XB_TMO])) break; if (sp > XB_SPIN_CAP) { atomicAdd(&bar[XB_TMO], 1u); break; } }
    }
    nloc = mine > 0u ? mine : 1u; nx = cnt > 0u ? cnt : 1u;
}
__device__ __forceinline__ void xcd_barrier(const XcdBarrier& b) {
    asm volatile("s_waitcnt vmcnt(0)" ::: "memory");
    __syncthreads();
    if (threadIdx.x == 0) {
        unsigned* bar = b.bar;
        __builtin_amdgcn_s_waitcnt(0);
        unsigned nloc = b.st[0], nx = b.st[1];
        if (nloc == 0u) { xcd_barrier_complete(bar, b.x, nloc, nx); b.st[0] = nloc; b.st[1] = nx; }
        const unsigned old = xb_add(&bar[XB_XSUB(b.x)], 1u);
        const unsigned gen = old / nloc;
        if (old + 1u == (gen + 1u) * nloc) {
            __builtin_amdgcn_fence(__ATOMIC_RELEASE, "agent");
            asm volatile("s_waitcnt vmcnt(0)" ::: "memory");
            const unsigned og = xb_add(&bar[XB_TOP], 1u);
            const unsigned tg = og / nx;
            if (og + 1u == (tg + 1u) * nx) xb_add(&bar[XB_TOPGEN], 1u);
            else XB_SPIN(xb_ld(&bar[XB_TOPGEN]) == tg, bar);
            __builtin_amdgcn_fence(__ATOMIC_ACQUIRE, "agent");
            xb_add(&bar[XB_XGEN(b.x)], 1u);
            asm volatile("s_waitcnt vmcnt(0)" ::: "memory");
        } else {
            XB_SPIN(xb_ld(&bar[XB_XGEN(b.x)]) == gen, bar);
            __builtin_amdgcn_fence(__ATOMIC_ACQUIRE, "agent");
            asm volatile("s_waitcnt vmcnt(0)" ::: "memory");
        }
    }
    __syncthreads();
}

#ifndef WGM_SET
#define WGM_SET 8
#endif
namespace pg8 {
constexpr int BM = 256, BK = 64, HALF = 128, HTB = HALF * BK * 2, STAGE_BYTES = 8 * HTB, NXCD = 8, WGM = WGM_SET;
__host__ __device__ __forceinline__ int lds_byte(int r, int c) { const int st = (r >> 4) * 2 + (c >> 5), rr = r & 15, cc = c & 31, ob = rr * 64 + cc * 2; return st * 1024 + (ob ^ (((ob >> 9) & 1) << 5)); }
__host__ __device__ __forceinline__ void stage_rc(int b, int& R, int& C) { const int st = b / 1024, sb = b % 1024, swz = sb ^ (((sb >> 9) & 1) << 5); R = (st >> 1) * 16 + swz / 64; C = (st & 1) * 32 + (swz % 64) / 2; }
__host__ __device__ __forceinline__ int perm32(int rho) { const int n = rho >> 4, i = rho & 15; return 8 * (i >> 2) + 4 * n + (i & 3); }

struct Unit { int pm, pn, aux; };

__device__ __forceinline__ void grouped(int wgid, int nM, int nN, int& pm, int& pn) {
    const int nig = WGM * nN, gid = wgid / nig, fm = gid * WGM, gsz = (nM - fm) < WGM ? (nM - fm) : WGM;
    pm = fm + ((wgid % nig) % gsz); pn = (wgid % nig) / gsz;
}
__device__ __forceinline__ bool xcd_remap(int i, int G, int c, int nwg, int& wgid) {
    const long L = (long)i * G + c; if (L >= nwg) return false;
    wgid = (int)L; const int q = nwg / NXCD, r = nwg % NXCD, xcd = wgid % NXCD, off = wgid / NXCD;
    wgid = (xcd < r ? xcd * (q + 1) : r * (q + 1) + (xcd - r) * q) + off; return true;
}

typedef int i32x8 __attribute__((ext_vector_type(8)));
typedef int i32x4 __attribute__((ext_vector_type(4)));
template <bool F8> struct Frags;
template <> struct Frags<false> { bf16x8 a[4][2], b0[2][2], b1[2][2]; };
template <> struct Frags<true> { i32x8 a[4], b0[2], b1[2]; };
template <class Prob, class Epi, bool ALIGN_EPI, bool HOOK, bool FP8 = false, int DRY = 0>
__device__ __forceinline__ void gemm_phase(LAS unsigned char* lds, const Prob& P, const Epi& E) {
    int tid_ = threadIdx.x; asm volatile("" : "+v"(tid_));
    const int tid = tid_, wid = __builtin_amdgcn_readfirstlane(tid >> 6), lane = tid & 63, wr = wid >> 2, wc = wid & 3, fr = lane & 15, fq = lane >> 4;
    const int nt = P.nt;
    unsigned voffB[2], voffA[2];
#pragma unroll
    for (int i = 0; i < 2; ++i) { int R, C; stage_rc(tid * 16 + i * 8192, R, C); const int Rb = Epi::PERM ? ((R & ~31) + perm32(R & 31)) : R;
        voffB[i] = (unsigned)Rb * P.ldb2 + (unsigned)C * 2u; voffA[i] = (unsigned)R * P.lda2 + (unsigned)C * 2u; }
    auto gather_offs = [&](const Unit& u, unsigned (&o0)[2], unsigned (&o1)[2]) {
#pragma unroll
        for (int i = 0; i < 2; ++i) { int R, C; int tt = threadIdx.x; asm volatile("" : "+v"(tt)); stage_rc(tt * 16 + i * 8192, R, C); o0[i] = P.a_row(u, R) + (unsigned)C * 2u; o1[i] = P.a_row(u, HALF + R) + (unsigned)C * 2u; } };
    const size_t kstep = (size_t)(BK * 2);
    const size_t hstepB = (size_t)HALF * P.ldb2;
    const size_t hstepA = (size_t)HALF * P.lda2;
    const unsigned ldsw = (unsigned)wid * 1024u;
    const int aoff = lds_byte(wr * 64 + fr, fq * 8), boff = lds_byte(wc * 32 + fr, fq * 8);
#define PG8_SA(b, h) (((b) * 2 + (h)) * HTB)
#define PG8_SB(b, h) ((4 + (b) * 2 + (h)) * HTB)
#define PG8_STAGE(bufoff, gbase, voff) do { if constexpr ((DRY & 2) == 0) _Pragma("unroll") for (int _i = 0; _i < 2; ++_i) \
        __builtin_amdgcn_global_load_lds((const unsigned*)((const char*)(gbase) + (voff)[_i]), (LAS unsigned*)(lds + (bufoff) + ldsw + _i * 8192), 16, 0, 0); } while (0)
#define PG8_LDA(dst, b, h) do { if constexpr (FP8) { _Pragma("unroll") for (int m = 0; m < 4; ++m) { FR.a[m].lo = *(const LAS i32x4*)(lds + PG8_SA(b, h) + aoff + m * 2048); FR.a[m].hi = *(const LAS i32x4*)(lds + PG8_SA(b, h) + aoff + m * 2048 + 1024); } } \
        else { _Pragma("unroll") for (int m = 0; m < 4; ++m) _Pragma("unroll") for (int k = 0; k < 2; ++k) FR.a[m][k] = *(const LAS bf16x8*)(lds + PG8_SA(b, h) + aoff + m * 2048 + k * 1024); } } while (0)
#define PG8_LDB(dst, b, h) do { if constexpr (FP8) { _Pragma("unroll") for (int n = 0; n < 2; ++n) { FR.dst[n].lo = *(const LAS i32x4*)(lds + PG8_SB(b, h) + boff + n * 2048); FR.dst[n].hi = *(const LAS i32x4*)(lds + PG8_SB(b, h) + boff + n * 2048 + 1024); } } \
        else { _Pragma("unroll") for (int n = 0; n < 2; ++n) _Pragma("unroll") for (int k = 0; k < 2; ++k) FR.dst[n][k] = *(const LAS bf16x8*)(lds + PG8_SB(b, h) + boff + n * 2048 + k * 1024); } } while (0)
#define PG8_MMA(ai, bj, At, Bt) do { __builtin_amdgcn_s_setprio(1); if constexpr ((DRY & 1) != 0) { asm volatile("" :: "v"(FR.a[0]), "v"(FR.a[3]), "v"(FR.Bt[0]), "v"(FR.Bt[1])); } else if constexpr (FP8) { _Pragma("unroll") for (int m = 0; m < 4; ++m) _Pragma("unroll") for (int n = 0; n < 2; ++n) \
            asm volatile("v_mfma_f32_16x16x128_f8f6f4 %0, %1, %2, %0" : "+v"(acc[ai][bj][m][n]) : "v"(FR.Bt[n]), "v"(FR.a[m])); } \
        else { _Pragma("unroll") for (int m = 0; m < 4; ++m) _Pragma("unroll") for (int n = 0; n < 2; ++n) _Pragma("unroll") for (int k = 0; k < 2; ++k) \
        acc[ai][bj][m][n] = __builtin_amdgcn_mfma_f32_16x16x32_bf16(FR.Bt[n][k], FR.a[m][k], acc[ai][bj][m][n], 0, 0, 0); } __builtin_amdgcn_s_setprio(0); } while (0)
#define PG8_WAIT_V(n) asm volatile("s_waitcnt vmcnt(" #n ")" ::: "memory")
#define PG8_WAIT_L(n) asm volatile("s_waitcnt lgkmcnt(" #n ")" ::: "memory")
#define PG8_BAR __builtin_amdgcn_s_barrier()
#define PG8_SCHED __builtin_amdgcn_sched_barrier(0)
    Unit cur, nxt; int ui = 0;
    if (!P.unit(0, cur)) return;
    f32x4 acc[2][2][4][2];
#pragma unroll
    for (int a = 0; a < 2; ++a)
#pragma unroll
        for (int b = 0; b < 2; ++b)
#pragma unroll
            for (int m = 0; m < 4; ++m)
#pragma unroll
                for (int n = 0; n < 2; ++n) acc[a][b][m][n] = (f32x4){0.f, 0.f, 0.f, 0.f};
    Frags<FP8> FR;
    unsigned va0[2], va1[2], vn0[2], vn1[2];
    const char* const gA = P.Abase; const char* cA = gA; const char* nA = gA; const char* cB = P.b_tile(cur);
    if constexpr (Prob::GATHER) {
        gather_offs(cur, va0, va1);
    } else { cA = gA + P.a_row(cur, 0); }
#define PG8_STAGE_A(bufoff, h, koff, nx) do { if constexpr (Prob::GATHER) { unsigned _v[2]; _Pragma("unroll") for (int _i = 0; _i < 2; ++_i) _v[_i] = (nx) ? ((h) ? vn1[_i] : vn0[_i]) : ((h) ? va1[_i] : va0[_i]); PG8_STAGE(bufoff, gA + (koff), _v); } \
        else { PG8_STAGE(bufoff, ((nx) ? nA : cA) + (h) * hstepA + (koff), voffA); } } while (0)
    PG8_STAGE(PG8_SB(0, 0), cB, voffB); PG8_STAGE(PG8_SB(0, 1), cB + hstepB, voffB); PG8_STAGE_A(PG8_SA(0, 0), 0, 0, false); PG8_STAGE_A(PG8_SA(0, 1), 1, 0, false);
    if (wr == 1) PG8_BAR;
    PG8_WAIT_V(2); PG8_BAR;
    PG8_STAGE(PG8_SB(1, 0), cB + kstep, voffB); PG8_STAGE_A(PG8_SA(1, 0), 0, kstep, false); PG8_STAGE(PG8_SB(1, 1), cB + hstepB + kstep, voffB);
    PG8_WAIT_V(6); PG8_BAR;
    Unit nx2; unsigned vq0[2], vq1[2]; bool has_next = P.unit(1, nxt);
    if (!has_next) nxt = cur;
    if constexpr (Prob::GATHER) gather_offs(nxt, vn0, vn1);
    for (;;) {
        if constexpr (!Prob::GATHER) { has_next = P.unit(ui + 1, nxt); if (!has_next) nxt = cur; nA = gA + P.a_row(nxt, 0); }
        const char* nB = P.b_tile(nxt);
        for (int t = 0; t < nt; t += 2) {
            const bool last = (t == nt - 2);
            if constexpr (HOOK) { if (t == (nt >> 1)) { if constexpr (FP8) asm volatile("s_nop 15\n\ts_nop 15" ::: "memory"); E.mid(acc, cur, wr, wc, fr, fq); } }
            const size_t k1 = (size_t)(t + 1) * kstep, k2 = last ? 0 : (size_t)(t + 2) * kstep, k3 = k2 + kstep;
            const char* b2 = last ? nB : cB + (size_t)(t + 2) * kstep; const char* b3 = b2 + kstep;
            PG8_LDB(b0, 0, 0); PG8_LDB(b1, 0, 1); PG8_SCHED; PG8_LDA(At, 0, 0); PG8_STAGE_A(PG8_SA(1, 1), 1, k1, false);
            PG8_WAIT_V(8); PG8_WAIT_L(0); PG8_BAR; PG8_MMA(0, 0, At, b0); PG8_MMA(0, 1, At, b1); PG8_BAR; PG8_SCHED;
            PG8_LDA(At, 0, 1); PG8_STAGE(PG8_SB(0, 0), b2, voffB); PG8_STAGE(PG8_SB(0, 1), b2 + hstepB, voffB); PG8_STAGE_A(PG8_SA(0, 0), 0, k2, last);
            PG8_WAIT_V(8); PG8_WAIT_L(0); PG8_BAR; PG8_MMA(1, 0, At, b0); PG8_MMA(1, 1, At, b1); PG8_BAR; PG8_SCHED;
            PG8_LDB(b0, 1, 0); PG8_LDB(b1, 1, 1); PG8_SCHED; PG8_LDA(At, 1, 0); PG8_STAGE_A(PG8_SA(0, 1), 1, k2, last);
            PG8_WAIT_V(8); PG8_WAIT_L(0); PG8_BAR; PG8_MMA(0, 0, At, b0); PG8_MMA(0, 1, At, b1); PG8_BAR; PG8_SCHED;
            PG8_LDA(At, 1, 1); PG8_STAGE(PG8_SB(1, 0), b3, voffB); PG8_STAGE(PG8_SB(1, 1), b3 + hstepB, voffB); PG8_STAGE_A(PG8_SA(1, 0), 0, k3, last);
            PG8_WAIT_V(8); PG8_WAIT_L(0); PG8_BAR; PG8_MMA(1, 0, At, b0); PG8_MMA(1, 1, At, b1); PG8_BAR; PG8_SCHED;
        }
        if constexpr (ALIGN_EPI) { if (wr == 0) PG8_BAR; }
        bool has_next2 = false;
        if constexpr (Prob::GATHER) { has_next2 = has_next && P.unit(ui + 2, nx2); if (!has_next2) nx2 = nxt; gather_offs(nx2, vq0, vq1); }
        if constexpr (FP8) asm volatile("s_nop 15\n\ts_nop 15" ::: "memory");
        if constexpr (DRY == 0) E(acc, cur, wr, wc, fr, fq); else { if (acc[0][0][0][0][0] == 1.2345e30f) *(volatile int*)P.Abase = 1; }
        if (!has_next) break;
#pragma unroll
        for (int a = 0; a < 2; ++a)
#pragma unroll
            for (int b = 0; b < 2; ++b)
#pragma unroll
                for (int m = 0; m < 4; ++m)
#pragma unroll
                    for (int n = 0; n < 2; ++n) acc[a][b][m][n] = (f32x4){0.f, 0.f, 0.f, 0.f};
        cur = nxt; cB = nB; cA = nA; ++ui;
        if constexpr (Prob::GATHER) {
#pragma unroll
            for (int i = 0; i < 2; ++i) { va0[i] = vn0[i]; va1[i] = vn1[i]; vn0[i] = vq0[i]; vn1[i] = vq1[i]; }
            nxt = nx2; has_next = has_next2; }
        if constexpr (ALIGN_EPI) { if (wr == 1) PG8_BAR; }
    }
    PG8_WAIT_V(0);
    if constexpr (!ALIGN_EPI) { if (wr == 0) PG8_BAR; }
    PG8_BAR;
#undef PG8_SA
#undef PG8_SB
#undef PG8_STAGE
#undef PG8_STAGE_A
#undef PG8_LDA
#undef PG8_LDB
#undef PG8_MMA
#undef PG8_WAIT_V
#undef PG8_WAIT_L
#undef PG8_BAR
#undef PG8_SCHED
}
}

using pg8::Unit;

struct ProbDense {
    static constexpr bool GATHER = false;
    const char* Abase; int nt; unsigned ldb2; unsigned lda2; const char* Bt; int nM, nN, G, c; int rev;
    __device__ __forceinline__ bool unit(int i, Unit& u) const { int w; if (!pg8::xcd_remap(i, G, c, nM * nN, w)) return false; pg8::grouped(w, nM, nN, u.pm, u.pn); if (rev) u.pm = nM - 1 - u.pm; u.aux = 0; return true; }
    __device__ __forceinline__ unsigned a_row(const Unit& u, int r) const { return (unsigned)(u.pm * 256 + r) * lda2; }
    __device__ __forceinline__ const char* b_tile(const Unit& u) const { return Bt + (size_t)u.pn * 256 * ldb2; }
};
struct ProbP1 {
    static constexpr bool GATHER = false;
    const char* Abase; int nt; unsigned ldb2; unsigned lda2; const char* Bt; unsigned uc_off; int G, c;
    __device__ __forceinline__ bool unit(int i, Unit& u) const {
        int w; if (!pg8::xcd_remap(i, G, c, 3072 + 256, w)) return false;
        if (w < 3072) { pg8::grouped(w, 256, 12, u.pm, u.pn); u.pm = 255 - u.pm; u.aux = 0; }
        else { pg8::grouped(w - 3072, 32, 8, u.pm, u.pn); u.pn += 4; u.aux = 1; }
        return true; }
    __device__ __forceinline__ unsigned a_row(const Unit& u, int r) const { return (u.aux ? uc_off : 0u) + (unsigned)(u.pm * 256 + r) * lda2; }
    __device__ __forceinline__ const char* b_tile(const Unit& u) const { return Bt + (size_t)u.pn * 256 * ldb2; }
};
template <bool GATHER_> struct ProbMoE {
    static constexpr bool GATHER = GATHER_;
    const char* Abase; int nt; unsigned ldb2; unsigned lda2; const char* Bt; size_t estride; int nN, nblk, G, c; const int* rowtok; const LAS unsigned char* blk_e;
    __device__ __forceinline__ bool unit(int i, Unit& u) const { int w; if (!pg8::xcd_remap(i, G, c, nblk * nN, w)) return false; pg8::grouped(w, nblk, nN, u.pm, u.pn); if (!GATHER) u.pm = nblk - 1 - u.pm;
        u.aux = (int)blk_e[u.pm]; return true; }
    __device__ __forceinline__ unsigned a_row(const Unit& u, int r) const { if (GATHER) return (unsigned)rowtok[u.pm * 256 + r] * lda2; else return (unsigned)(u.pm * 256 + r) * lda2; }
    __device__ __forceinline__ const char* b_tile(const Unit& u) const { return Bt + (size_t)u.aux * estride + (size_t)u.pn * 256 * ldb2; }
};

struct EpiP1 {
    static constexpr bool PERM = true;
    bf16_t* PA; bf16_t* PH; bf16_t* PHC;
    __device__ __forceinline__ void operator()(const f32x4 (&acc)[2][2][4][2], const Unit& u, int wr, int wc, int fr, int fq) const {
        const int row0 = u.pm * 256 + wr * 64 + fr;
        if (!u.aux && u.pn < 4) {
            unsigned char* PA8 = (unsigned char*)PA;
#pragma unroll
            for (int ai = 0; ai < 2; ++ai)
#pragma unroll
                for (int bj = 0; bj < 2; ++bj) { u32x2 pk[4];
#pragma unroll
                    for (int m = 0; m < 4; ++m) { const f32x4 v0 = acc[ai][bj][m][0] * W8_INV, v1 = acc[ai][bj][m][1] * W8_INV;
                        pk[m] = (u32x2){cvt_pk4_fp8(v0[0], v0[1], v0[2], v0[3]), cvt_pk4_fp8(v1[0], v1[1], v1[2], v1[3])}; }
                    const int col = u.pn * 256 + bj * 128 + wc * 32 + (fq >> 1) * 16, reim = col >> 9, slab = (col & 511) >> 4;
#pragma unroll
                    for (int mp = 0; mp < 2; ++mp) { const int row = row0 + ai * 128 + (2 * mp + (fq & 1)) * 16, b = row >> 11, t = row & 2047;
                        *(u32x4*)(PA8 + ((((size_t)(b * 32 + slab) * 2048 + t) * 2 + reim) * 16)) = widen16(pk[2 * mp], pk[2 * mp + 1]); } }
            return;
        }
        bf16_t* base = u.aux ? PHC : PH; const int ldc = 2048, colt = (u.pn - 4) * 256;
        {
            const int kind = u.pn < 6 ? 0 : (u.pn < 8 ? 1 : (u.pn < 10 ? 2 : 3));
            const int reg = kind == 0 ? (u.pn - 4) * 256 : kind == 1 ? 512 + (u.pn - 6) * 256 : kind == 2 ? 3584 + (u.pn - 8) * 256 : 3072 + (u.pn - 10) * 256;
            unsigned char* b8 = (unsigned char*)base + reg + wc * 32 + (fq >> 1) * 16;
#pragma unroll
            for (int ai = 0; ai < 2; ++ai)
#pragma unroll
                for (int bj = 0; bj < 2; ++bj) { u32x2 pk[4];
#pragma unroll
                    for (int m = 0; m < 4; ++m) { f32x4 v0 = acc[ai][bj][m][0] * W8_INV, v1 = acc[ai][bj][m][1] * W8_INV;
                        if (kind == 0) {
#pragma unroll
                            for (int j = 0; j < 4; ++j) { v0[j] *= fast_sigmoid(v0[j]); v1[j] *= fast_sigmoid(v1[j]); } }
                        if (kind == 1 || kind == 2) {
#pragma unroll
                            for (int j = 0; j < 4; ++j) { v0[j] = fast_sigmoid(v0[j]) * 255.0f; v1[j] = fast_sigmoid(v1[j]) * 255.0f; }
                            pk[m] = (u32x2){pack4_u8(v0[0], v0[1], v0[2], v0[3]), pack4_u8(v1[0], v1[1], v1[2], v1[3])};
                        } else pk[m] = (u32x2){cvt_pk4_fp8(v0[0], v0[1], v0[2], v0[3]), cvt_pk4_fp8(v1[0], v1[1], v1[2], v1[3])}; }
#pragma unroll
                    for (int mp = 0; mp < 2; ++mp)
                        *(u32x4*)(b8 + (size_t)(row0 + ai * 128 + (2 * mp + (fq & 1)) * 16) * 4096 + bj * 128) = widen16(pk[2 * mp], pk[2 * mp + 1]); }
        }
    }
    __device__ __forceinline__ void mid(f32x4 (&)[2][2][4][2], const Unit&, int, int, int, int) const {}
};
struct EpiP2 {
    static constexpr bool PERM = true;
    unsigned char* PG; unsigned char* GATES;
    __device__ __forceinline__ void operator()(const f32x4 (&acc)[2][2][4][2], const Unit& u, int wr, int wc, int fr, int fq) const {
        const int row0 = u.pm * 256 + wr * 64 + fr;
        if (u.pn < 2) {
            const int colp = u.pn * 256 + wc * 32 + (fq >> 1) * 16;
#pragma unroll
            for (int ai = 0; ai < 2; ++ai)
#pragma unroll
                for (int bj = 0; bj < 2; ++bj) { u32x2 pk[4];
#pragma unroll
                    for (int m = 0; m < 4; ++m) { f32x4 v0 = acc[ai][bj][m][0] * W8_INV, v1 = acc[ai][bj][m][1] * W8_INV;
#pragma unroll
                        for (int j = 0; j < 4; ++j) { v0[j] *= fast_sigmoid(v0[j]); v1[j] *= fast_sigmoid(v1[j]); }
                        pk[m] = (u32x2){cvt_pk4_fp8(v0[0], v0[1], v0[2], v0[3]), cvt_pk4_fp8(v1[0], v1[1], v1[2], v1[3])}; }
#pragma unroll
                    for (int mp = 0; mp < 2; ++mp)
                        *(u32x4*)(PG + (size_t)(row0 + ai * 128 + (2 * mp + (fq & 1)) * 16) * 512 + colp + bj * 128) = widen16(pk[2 * mp], pk[2 * mp + 1]); }
            return;
        }
        const int colt = (u.pn - 2) * 256 + wc * 32 + (fq >> 1) * 16;
#pragma unroll
        for (int ai = 0; ai < 2; ++ai)
#pragma unroll
            for (int bj = 0; bj < 2; ++bj) { u32x2 pk[4];
#pragma unroll
                for (int m = 0; m < 4; ++m) { f32x4 v0 = acc[ai][bj][m][0] * W8_INV, v1 = acc[ai][bj][m][1] * W8_INV;
#pragma unroll
                    for (int j = 0; j < 4; ++j) { v0[j] = fmaxf(fast_sigmoid(v0[j]) * 255.0f, 1.0f); v1[j] = fmaxf(fast_sigmoid(v1[j]) * 255.0f, 1.0f); }
                    pk[m] = (u32x2){pack4_u8(v0[0], v0[1], v0[2], v0[3]), pack4_u8(v1[0], v1[1], v1[2], v1[3])}; }
#pragma unroll
                for (int mp = 0; mp < 2; ++mp)
                    *(u32x4*)(GATES + (size_t)(row0 + ai * 128 + (2 * mp + (fq & 1)) * 16) * 2048 + colt + bj * 128) = widen16(pk[2 * mp], pk[2 * mp + 1]); }
    }
    __device__ __forceinline__ void mid(f32x4 (&)[2][2][4][2], const Unit&, int, int, int, int) const {}
};
struct EpiM1 {
    static constexpr bool PERM = true;
    const unsigned char* GATES; unsigned char* Mo;
    __device__ __forceinline__ void mid(f32x4 (&acc)[2][2][4][2], const Unit& u, int wr, int wc, int fr, int fq) const {
        int row0 = u.pm * 256 + wr * 64 + fr + (fq & 1) * 16, col0 = u.pn * 256 + wc * 32 + (fq >> 1) * 16;
        asm volatile("" : "+v"(row0), "+v"(col0));
        u32x4 gf[2][2][2], gh[2][2][2];
#pragma unroll
        for (int ai = 0; ai < 2; ++ai)
#pragma unroll
            for (int mp = 0; mp < 2; ++mp) { const unsigned char* gp = GATES + (size_t)(row0 + ai * 128 + mp * 32) * 2048 + col0;
#pragma unroll
                for (int bj = 0; bj < 2; ++bj) { gf[ai][mp][bj] = *(const u32x4*)(gp + bj * 128); gh[ai][mp][bj] = *(const u32x4*)(gp + 1024 + bj * 128); } }
#pragma unroll
        for (int ai = 0; ai < 2; ++ai) {
#pragma unroll
            for (int mp = 0; mp < 2; ++mp)
#pragma unroll
                for (int bj = 0; bj < 2; ++bj) { u32x2 f2[2], h2[2]; unwiden16(gf[ai][mp][bj], f2[0], f2[1]); unwiden16(gh[ai][mp][bj], h2[0], h2[1]);
#pragma unroll
                    for (int q = 0; q < 2; ++q) { const int m = 2 * mp + q;
                        const f32x4 fa = u8x4_to_f32(f2[q].x), fb = u8x4_to_f32(f2[q].y), ha = u8x4_to_f32(h2[q].x), hb = u8x4_to_f32(h2[q].y);
#pragma unroll
                        for (int j = 0; j < 4; ++j) { acc[ai][bj][m][0][j] *= fa[j] * __builtin_amdgcn_rcpf(ha[j]); acc[ai][bj][m][1][j] *= fb[j] * __builtin_amdgcn_rcpf(hb[j]); } } }
        }
        asm volatile("" ::: "memory");
    }
    __device__ __forceinline__ void operator()(const f32x4 (&acc)[2][2][4][2], const Unit& u, int wr, int wc, int fr, int fq) const {
        const int row0 = u.pm * 256 + wr * 64 + fr, col0 = u.pn * 256 + wc * 32 + (fq >> 1) * 16;
        const float sc = W8_INV * (1.0f / 255.0f);
        u32x4 gh[2][2][2];
#pragma unroll
        for (int ai = 0; ai < 2; ++ai)
#pragma unroll
            for (int mp = 0; mp < 2; ++mp) { const unsigned char* gp = GATES + (size_t)(row0 + ai * 128 + (2 * mp + (fq & 1)) * 16) * 2048 + 1024 + col0;
#pragma unroll
                for (int bj = 0; bj < 2; ++bj) gh[ai][mp][bj] = *(const u32x4*)(gp + bj * 128); }
#pragma unroll
        for (int ai = 0; ai < 2; ++ai) {
#pragma unroll
            for (int bj = 0; bj < 2; ++bj) { u32x2 pk[4];
#pragma unroll
                for (int mp = 0; mp < 2; ++mp) { u32x2 h2[2]; unwiden16(gh[ai][mp][bj], h2[0], h2[1]);
#pragma unroll
                    for (int q = 0; q < 2; ++q) { const int m = 2 * mp + q; const f32x4 ha = u8x4_to_f32(h2[q].x) * sc, hb = u8x4_to_f32(h2[q].y) * sc;
                        const f32x4 v0 = acc[ai][bj][m][0] * ha, v1 = acc[ai][bj][m][1] * hb;
                        pk[m] = (u32x2){cvt_pk4_fp8(v0[0], v0[1], v0[2], v0[3]), cvt_pk4_fp8(v1[0], v1[1], v1[2], v1[3])}; } }
#pragma unroll
                for (int mp = 0; mp < 2; ++mp)
                    *(u32x4*)(Mo + (size_t)(row0 + ai * 128 + (2 * mp + (fq & 1)) * 16) * 1024 + col0 + bj * 128) = widen16(pk[2 * mp], pk[2 * mp + 1]); }
        }
    }
};
constexpr float V8_SCALE = 16.0f, V8_INV = 1.0f / 16.0f;
struct EpiM2 {
    static constexpr bool PERM = true;
    const float* ada; unsigned char* V;
    __device__ __forceinline__ void operator()(const f32x4 (&acc)[2][2][4][2], const Unit& u, int wr, int wc, int fr, int fq) const {
        const int row0 = u.pm * 256 + wr * 64 + fr, col0 = u.pn * 256 + wc * 32 + 8 * fq, colw = u.pn * 256 + wc * 32 + (fq >> 1) * 16;
        const float* g1 = ada + (size_t)(u.pm >> 3) * 6144 + 2048 + col0;
        f32x4 gv[2][2];
#pragma unroll
        for (int bj = 0; bj < 2; ++bj)
#pragma unroll
            for (int n = 0; n < 2; ++n) gv[bj][n] = *(const f32x4*)(g1 + bj * 128 + n * 4) * (W8_INV * V8_SCALE);
#pragma unroll
        for (int ai = 0; ai < 2; ++ai)
#pragma unroll
            for (int bj = 0; bj < 2; ++bj) { u32x2 pk[4];
#pragma unroll
                for (int m = 0; m < 4; ++m) { const f32x4 v0 = gv[bj][0] * acc[ai][bj][m][0], v1 = gv[bj][1] * acc[ai][bj][m][1];
                    pk[m] = (u32x2){cvt_pk4_fp8(v0[0], v0[1], v0[2], v0[3]), cvt_pk4_fp8(v1[0], v1[1], v1[2], v1[3])}; }
#pragma unroll
                for (int mp = 0; mp < 2; ++mp)
                    *(u32x4*)(V + (size_t)(row0 + ai * 128 + (2 * mp + (fq & 1)) * 16) * 1024 + colw + bj * 128) = widen16(pk[2 * mp], pk[2 * mp + 1]); }
    }
    __device__ __forceinline__ void mid(f32x4 (&)[2][2][4][2], const Unit&, int, int, int, int) const {}
};
struct EpiGU {
    static constexpr bool PERM = true;
    const float* bgu; unsigned char* ACT;
    __device__ __forceinline__ void operator()(const f32x4 (&acc)[2][2][4][2], const Unit& u, int wr, int wc, int fr, int fq) const {
        const int row0 = u.pm * 256 + wr * 64 + fr, col0 = u.pn * 128 + wc * 32 + 8 * fq;
        const float* bp = bgu + (size_t)u.aux * 2048 + col0;
        const f32x4 bg0 = *(const f32x4*)(bp), bg1 = *(const f32x4*)(bp + 4), bu0 = *(const f32x4*)(bp + 1024), bu1 = *(const f32x4*)(bp + 1028);
#pragma unroll
        for (int ai = 0; ai < 2; ++ai) { u32x2 pk[4];
#pragma unroll
            for (int m = 0; m < 4; ++m) {
                f32x4 g0 = acc[ai][0][m][0] * W8_INV + bg0, g1 = acc[ai][0][m][1] * W8_INV + bg1, p0 = acc[ai][1][m][0] * W8_INV + bu0, p1 = acc[ai][1][m][1] * W8_INV + bu1;
#pragma unroll
                for (int j = 0; j < 4; ++j) {
                    float g = fminf(g0[j], 7.0f), p = fminf(fmaxf(p0[j], -7.0f), 7.0f); g0[j] = (p + 1.0f) * g * fast_sigmoid(1.702f * g);
                    g = fminf(g1[j], 7.0f); p = fminf(fmaxf(p1[j], -7.0f), 7.0f); g1[j] = (p + 1.0f) * g * fast_sigmoid(1.702f * g); }
                pk[m] = (u32x2){cvt_pk4_fp8(g0[0], g0[1], g0[2], g0[3]), cvt_pk4_fp8(g1[0], g1[1], g1[2], g1[3])}; }
#pragma unroll
            for (int mp = 0; mp < 2; ++mp)
                *(u32x4*)(ACT + (size_t)(row0 + ai * 128 + (2 * mp + (fq & 1)) * 16) * 1024 + u.pn * 128 + wc * 32 + (fq >> 1) * 16) = widen16(pk[2 * mp], pk[2 * mp + 1]); }
    }
    __device__ __forceinline__ void mid(f32x4 (&)[2][2][4][2], const Unit&, int, int, int, int) const {}
};
struct EpiDN {
    static constexpr bool PERM = true;
    const float* bdn; unsigned char* Y;
    __device__ __forceinline__ void operator()(const f32x4 (&acc)[2][2][4][2], const Unit& u, int wr, int wc, int fr, int fq) const {
        const int row0 = u.pm * 256 + wr * 64 + fr, col0 = u.pn * 256 + wc * 32 + 8 * fq;
        const float* bp = bdn + (size_t)u.aux * 1024 + col0;
        f32x4 bv[2][2];
#pragma unroll
        for (int bj = 0; bj < 2; ++bj)
#pragma unroll
            for (int n = 0; n < 2; ++n) bv[bj][n] = *(const f32x4*)(bp + bj * 128 + 4 * n);
#pragma unroll
        for (int ai = 0; ai < 2; ++ai)
#pragma unroll
            for (int bj = 0; bj < 2; ++bj) { u32x2 pk[4];
#pragma unroll
                for (int m = 0; m < 4; ++m) { const f32x4 v0 = acc[ai][bj][m][0] * W8_INV + bv[bj][0], v1 = acc[ai][bj][m][1] * W8_INV + bv[bj][1];
                    pk[m] = (u32x2){cvt_pk4_fp8(v0[0], v0[1], v0[2], v0[3]), cvt_pk4_fp8(v1[0], v1[1], v1[2], v1[3])}; }
#pragma unroll
                for (int mp = 0; mp < 2; ++mp)
                    *(u32x4*)(Y + (size_t)(row0 + ai * 128 + (2 * mp + (fq & 1)) * 16) * 1024 + u.pn * 256 + bj * 128 + wc * 32 + (fq >> 1) * 16) = widen16(pk[2 * mp], pk[2 * mp + 1]); }
    }
    __device__ __forceinline__ void mid(f32x4 (&)[2][2][4][2], const Unit&, int, int, int, int) const {}
};

struct Frame {
    LAS unsigned char* lds; int tid, lane, wave, G, c;
    const float* const* in; float* out; unsigned char* ws; unsigned* ctl;
};
enum { I_X = 0, I_C, I_CTX, I_CCTX, I_WADA, I_BADA, I_WIN, I_LBRAW, I_HGG, I_WFO, I_WHO, I_WO, I_LN1G, I_LN1B, I_WR, I_BR, I_WGU, I_BGU, I_WDN, I_BDN, I_LN2G, I_LN2B };

__device__ __forceinline__ float wave_sum(float v) {
#pragma unroll
    for (int o = 32; o >= 1; o >>= 1) v += __shfl_xor(v, o);
    return v;
}

__device__ __forceinline__ Frame fresh(const Frame& F) { Frame G = F; int t = threadIdx.x; asm volatile("" : "+v"(t)); G.tid = t; G.lane = t & 63; G.wave = __builtin_amdgcn_readfirstlane(t >> 6); return G; }

__device__ __forceinline__ void p0_ada(const Frame& F) {
    LAS float* cact = (LAS float*)F.lds;
    float* ada = (float*)(F.ws + WS_ADA);
    for (int cb = F.c; cb < 192; cb += F.G) {
        const int kg = F.tid >> 5, col = F.tid & 31, gcol = cb * 32 + col;
        float w[16][4];
#pragma unroll
        for (int i = 0; i < 16; ++i)
#pragma unroll
            for (int j = 0; j < 4; ++j) w[i][j] = F.in[I_WADA][(size_t)(4 * kg + 64 * i + j) * 6144 + gcol];
        f32x4 cv[17];
#pragma unroll
        for (int it = 0; it < 17; ++it) { const int q = F.tid + it * NTHR, bq = q >> 8, k4 = (q & 255) * 4; cv[it] = (f32x4){0.f, 0.f, 0.f, 0.f};
            if (q < 33 * 256) cv[it] = *(const f32x4*)(bq < 32 ? F.in[I_C] + bq * 1024 + k4 : F.in[I_CCTX] + k4); }
#pragma unroll
        for (int it = 0; it < 17; ++it) { const int q = F.tid + it * NTHR; f32x4 v = cv[it];
#pragma unroll
            for (int j = 0; j < 4; ++j) v[j] = v[j] * fast_sigmoid(v[j]);
            if (q < 33 * 256) *(LAS f32x4*)(cact + q * 4) = v; }
        __syncthreads();
        float acc[33];
#pragma unroll
        for (int bb = 0; bb < 33; ++bb) acc[bb] = 0.f;
#pragma unroll
        for (int i = 0; i < 16; ++i)
#pragma unroll
            for (int bb = 0; bb < 33; ++bb) { const f32x4 c4 = *(const LAS f32x4*)(cact + bb * 1024 + 4 * kg + 64 * i);
                acc[bb] += (c4[0] * w[i][0] + c4[1] * w[i][1]) + (c4[2] * w[i][2] + c4[3] * w[i][3]); }
        __syncthreads();
        LAS float* red = cact;
#pragma unroll
        for (int bb = 0; bb < 33; ++bb) red[(kg * 33 + bb) * 32 + col] = acc[bb];
        __syncthreads();
        for (int o = F.tid; o < 33 * 32; o += NTHR) { const int bb = o >> 5, cc = o & 31; float sum = 0.f;
#pragma unroll
            for (int g = 0; g < 16; ++g) sum += red[(g * 33 + bb) * 32 + cc];
            ada[(size_t)bb * 6144 + cb * 32 + cc] = sum + F.in[I_BADA][cb * 32 + cc]; }
        __syncthreads();
    }
}
__device__ __forceinline__ void p0_fold(const Frame& F) {
    LAS float* xr = (LAS float*)F.lds;
    LAS float* cs = xr + 2048;
    unsigned char* W1 = (unsigned char*)(F.ws + WS_WIN1T);
    if (F.tid < 128) { const float a = (float)F.tid * (1.0f / 128.0f); cs[F.tid] = __builtin_amdgcn_cosf(a); cs[128 + F.tid] = __builtin_amdgcn_sinf(a); }
    for (int kb = F.c; kb < 256; kb += F.G) {
        __syncthreads();
        for (int i = F.tid; i < 2048; i += NTHR) xr[i] = F.in[I_WIN][(size_t)(4 * kb + (i >> 9)) * 5120 + (i & 511)];
        __syncthreads();
        const int g = F.tid >> 7, j = F.tid & 127;
        float ac[4] = {0.f, 0.f, 0.f, 0.f}, as[4] = {0.f, 0.f, 0.f, 0.f};
        for (int d = 0; d < 128; ++d) { const int idx = (d * j) & 127; const float cv = cs[idx], sv = cs[128 + idx];
#pragma unroll
            for (int r = 0; r < 4; ++r) { const float xv = xr[r * 512 + g * 128 + d]; ac[r] += xv * cv; as[r] += xv * sv; } }
        const float sc = 0.08838834764831845f * W8_SCALE;
        *(unsigned*)(W1 + (size_t)(g * 128 + j) * 1024 + 4 * kb) = cvt_pk4_fp8(ac[0] * sc, ac[1] * sc, ac[2] * sc, ac[3] * sc);
        *(unsigned*)(W1 + (size_t)(512 + g * 128 + j) * 1024 + 4 * kb) = cvt_pk4_fp8(-as[0] * sc, -as[1] * sc, -as[2] * sc, -as[3] * sc);
    }
    __syncthreads();
}
struct CvJob { const float* src; int sld; unsigned char* dst; int f8; };
__device__ __forceinline__ CvJob cv_job(const Frame& F, int j) {
    CvJob J;
    if (j < 128) { const int kt = j >> 4, nt = j & 15; J.src = F.in[I_WIN] + (size_t)kt * 128 * 5120 + 512 + nt * 128; J.sld = 5120; J.dst = F.ws + WS_WIN1T + (size_t)(1024 + nt * 128) * 1024 + kt * 128; J.f8 = 1; }
    else if (j < 288) { const int q = j - 128, kt = q / 20, nt = q % 20; J.src = F.in[I_WIN] + (size_t)kt * 128 * 5120 + 2560 + nt * 128; J.sld = 5120; J.dst = F.ws + WS_WIN2T + (size_t)(nt * 128) * 1024 + kt * 128; J.f8 = 1; }
    else if (j < 320) { const int q = j - 288, kt = q >> 3, nt = q & 7; J.src = F.in[I_WFO] + (size_t)kt * 128 * 1024 + nt * 128; J.sld = 1024; J.dst = F.ws + WS_WMT + ((size_t)(nt * 128) * 1024 + kt * 128); J.f8 = 1; }
    else if (j < 352) { const int q = j - 320, kt = q >> 3, nt = q & 7; J.src = F.in[I_WHO] + (size_t)kt * 128 * 1024 + nt * 128; J.sld = 1024; J.dst = F.ws + WS_WMT + ((size_t)(nt * 128) * 1024 + 512 + kt * 128); J.f8 = 1; }
    else if (j < 416) { const int q = j - 352, kt = q >> 3, nt = q & 7; J.src = F.in[I_WO] + (size_t)kt * 128 * 1024 + nt * 128; J.sld = 1024; J.dst = F.ws + WS_WOT + ((size_t)(nt * 128) * 1024 + kt * 128); J.f8 = 1; }
    else if (j < 4512) { const int q = j - 416, e = q >> 7, r = q & 127, kt = r >> 4, jt = r & 15; J.src = F.in[I_WGU] + (size_t)e * 1024 * 2048 + (size_t)kt * 128 * 2048 + jt * 128; J.sld = 2048;
        J.dst = F.ws + WS_WGUT + (size_t)e * 2048 * 1024 + (size_t)((jt & 7) * 256 + (jt >> 3) * 128) * 1024 + kt * 128; J.f8 = 1; }
    else { const int q = j - 4512, e = q >> 6, r = q & 63, kt = r >> 3, nt = r & 7; J.src = F.in[I_WDN] + (size_t)e * 1024 * 1024 + (size_t)kt * 128 * 1024 + nt * 128; J.sld = 1024;
        J.dst = F.ws + WS_WDNT + (size_t)e * 1024 * 1024 + (size_t)(nt * 128) * 1024 + kt * 128; J.f8 = 1; }
    return J;
}
__device__ __forceinline__ void p0_convert(const Frame& F) {
    constexpr int NJ = 128 + 160 + 32 + 32 + 64 + 4096 + 2048;
    LAS float* tile0 = (LAS float*)F.lds; LAS float* tile1 = tile0 + 128 * 129;
    const int j0 = F.c; if (j0 >= NJ) return;
    f32x4 va[8], vb[8];
#define CV_LOAD(dst, jj) do { const CvJob Jl = cv_job(F, (jj)); _Pragma("unroll") for (int i = 0; i < 8; ++i) { const int idx = F.tid + i * NTHR, r = idx >> 5, c4 = idx & 31; dst[i] = *(const f32x4*)(Jl.src + (size_t)r * Jl.sld + c4 * 4); } } while (0)
#define CV_STEP(reg, tile, jj) do { \
        _Pragma("unroll") for (int i = 0; i < 8; ++i) { const int idx = F.tid + i * NTHR, r = idx >> 5, c4 = idx & 31; LAS float* p = tile + r * 129 + c4 * 4; p[0] = reg[i][0] * W8_SCALE; p[1] = reg[i][1] * W8_SCALE; p[2] = reg[i][2] * W8_SCALE; p[3] = reg[i][3] * W8_SCALE; } \
        __syncthreads(); \
        const CvJob Jc = cv_job(F, (jj)); \
        if ((jj) + 2 * F.G < NJ) CV_LOAD(reg, (jj) + 2 * F.G); \
        _Pragma("unroll") for (int i = 0; i < 2; ++i) { const int idx = F.tid + i * NTHR, n = idx >> 3, kc = idx & 7; const LAS float* p = tile + (kc * 16) * 129 + n; \
            u32x4 w; w.x = cvt_pk4_fp8(p[0], p[129], p[2 * 129], p[3 * 129]); w.y = cvt_pk4_fp8(p[4 * 129], p[5 * 129], p[6 * 129], p[7 * 129]); \
            w.z = cvt_pk4_fp8(p[8 * 129], p[9 * 129], p[10 * 129], p[11 * 129]); w.w = cvt_pk4_fp8(p[12 * 129], p[13 * 129], p[14 * 129], p[15 * 129]); \
            *(u32x4*)(Jc.dst + (size_t)n * 1024 + kc * 16) = w; } } while (0)
    CV_LOAD(va, j0);
    if (j0 + F.G < NJ) CV_LOAD(vb, j0 + F.G);
    for (int j = j0; j < NJ; j += 2 * F.G) {
        CV_STEP(va, tile0, j);
        if (j + F.G < NJ) CV_STEP(vb, tile1, j + F.G);
    }
    __syncthreads();
#undef CV_LOAD
#undef CV_STEP
}

__device__ __forceinline__ void p1_uprep(const Frame& F) {
    const float* ada = (const float*)(F.ws + WS_ADA);
    unsigned char* U = (unsigned char*)(F.ws + WS_U); unsigned char* Uc = (unsigned char*)(F.ws + WS_UC);
    const size_t NIT = (size_t)(T + TCX) * 128, stride = (size_t)F.G * NTHR;
    for (size_t base = (size_t)F.c * NTHR + F.tid; base < NIT; base += 4 * stride) {
        const int col = (int)(base & 127) * 8;
        f32x4 a0[4], a1[4], sh0[4], sh1[4], sc0[4], sc1[4]; unsigned char* dst[4]; bool ok[4];
#pragma unroll
        for (int u = 0; u < 4; ++u) {
            const size_t idx = base + (size_t)u * stride; ok[u] = idx < NIT;
            const int row = (int)((ok[u] ? idx : base) >> 7);
            const bool lat = row < T; const int b = lat ? (row >> 11) : 32;
            const float* src = lat ? F.in[I_X] + (size_t)row * 1024 + col : F.in[I_CTX] + (size_t)(row - T) * 1024 + col;
            dst[u] = lat ? U + (size_t)row * 1024 + col : Uc + (size_t)(row - T) * 1024 + col;
            a0[u] = *(const f32x4*)src; a1[u] = *(const f32x4*)(src + 4);
            const float* ap = ada + (size_t)b * 6144 + col;
            sh0[u] = *(const f32x4*)ap; sh1[u] = *(const f32x4*)(ap + 4); sc0[u] = *(const f32x4*)(ap + 1024); sc1[u] = *(const f32x4*)(ap + 1028);
        }
#pragma unroll
        for (int u = 0; u < 4; ++u) {
            const f32x4 r0 = a0[u] * (sc0[u] + 1.0f) + sh0[u], r1 = a1[u] * (sc1[u] + 1.0f) + sh1[u];
            if (ok[u]) *(u32x2*)dst[u] = (u32x2){cvt_pk4_fp8(r0[0], r0[1], r0[2], r0[3]), cvt_pk4_fp8(r1[0], r1[1], r1[2], r1[3])};
        }
    }
    int* rowtok = (int*)(F.ws + WS_ROWTOK);
    for (int i = F.c * NTHR + F.tid; i < NCH * ROWS_CH; i += F.G * NTHR) rowtok[i] = (i / ROWS_CH) * TCH;
}

__device__ __forceinline__ void p6_readout(const Frame& F) {
    const bf16_t* PH = (const bf16_t*)(F.ws + WS_PH); const unsigned char* PG = (const unsigned char*)(F.ws + WS_PG); unsigned char* Y = (unsigned char*)(F.ws + WS_Y);
    const int l8 = F.lane * 8;
    const f32x4 g0 = *(const f32x4*)(F.in[I_HGG] + l8), g1 = *(const f32x4*)(F.in[I_HGG] + l8 + 4);
    const int tstr = F.G * 8;
    for (int t0 = F.c * 8 + F.wave; t0 < T; t0 += 4 * tstr) {
        u32x2 av[4], bv[4], pv[4]; bool ok[4]; int tt[4];
#pragma unroll
        for (int u = 0; u < 4; ++u) { const int t = t0 + u * tstr; ok[u] = t < T; tt[u] = ok[u] ? t : t0;
            av[u] = *(const u32x2*)((const unsigned char*)PH + (size_t)tt[u] * 4096 + 1024 + l8); bv[u] = *(const u32x2*)((const unsigned char*)PH + (size_t)tt[u] * 4096 + 2048 + l8); pv[u] = *(const u32x2*)(PG + (size_t)tt[u] * 512 + l8); }
#pragma unroll
        for (int u = 0; u < 4; ++u) {
            const f32x4 pa = fp8x4_to_f32(pv[u].x), pb = fp8x4_to_f32(pv[u].y);
            const f32x4 oa = fp8x4_to_f32(av[u].x) + fp8x4_to_f32(bv[u].x), oc = fp8x4_to_f32(av[u].y) + fp8x4_to_f32(bv[u].y);
            float o[8] = { oa[0], oa[1], oa[2], oa[3], oc[0], oc[1], oc[2], oc[3] };
            float ss = 0.f;
#pragma unroll
            for (int i = 0; i < 8; ++i) ss += o[i] * o[i];
            ss += __shfl_xor(ss, 1); ss += __shfl_xor(ss, 2); ss += __shfl_xor(ss, 4); ss += __shfl_xor(ss, 8);
            const float rs = __builtin_amdgcn_rsqf(ss * (1.0f / 128.0f) + RMS_EPS);
            const float sp[8] = { pa[0], pa[1], pa[2], pa[3], pb[0], pb[1], pb[2], pb[3] };
            if (ok[u]) *(u32x2*)(Y + (size_t)tt[u] * 1024 + 512 + l8) = (u32x2){cvt_pk4_fp8(o[0] * rs * g0[0] * sp[0], o[1] * rs * g0[1] * sp[1], o[2] * rs * g0[2] * sp[2], o[3] * rs * g0[3] * sp[3]), cvt_pk4_fp8(o[4] * rs * g1[0] * sp[4], o[5] * rs * g1[1] * sp[5], o[6] * rs * g1[2] * sp[6], o[7] * rs * g1[3] * sp[7])};
        }
    }
}

constexpr int RW_STRIDE = 2080;
constexpr int RW_HI = 0, RW_LO = 32 * RW_STRIDE, RW_PAR = 64 * RW_STRIDE, RW_BR = RW_PAR + 16384, RW_HIST = RW_BR + 128;
__device__ __forceinline__ void p9_ln1_router(const Frame& F, const bool dry) {
    LAS unsigned char* L = F.lds;
    LAS float* par = (LAS float*)(L + RW_PAR); LAS float* brs = (LAS float*)(L + RW_BR); LAS int* hist = (LAS int*)(L + RW_HIST);
#pragma unroll 1
    for (int it = 0; it < 8; ++it) { const int item = F.tid + it * NTHR, e = item & 31, k8 = item >> 5;
        float w[8];
#pragma unroll
        for (int i = 0; i < 8; ++i) w[i] = F.in[I_WR][(k8 * 8 + i) * 32 + e];
        u32x4 hi, lo;
#pragma unroll
        for (int i = 0; i < 4; ++i) { const unsigned h = cvt_pk_bf16(w[2 * i], w[2 * i + 1]); hi[i] = h; lo[i] = cvt_pk_bf16(w[2 * i] - bf_lo(h), w[2 * i + 1] - bf_hi(h)); }
        *(LAS u32x4*)(L + RW_HI + e * RW_STRIDE + k8 * 16) = hi; *(LAS u32x4*)(L + RW_LO + e * RW_STRIDE + k8 * 16) = lo; }
    for (int i = F.tid; i < 2048; i += NTHR) par[i] = i < 1024 ? F.in[I_LN1G][i] : F.in[I_LN1B][i - 1024];
    if (F.tid < 32) brs[F.tid] = F.in[I_BR][F.tid];
    if (F.tid < NCH * 32) hist[F.tid] = 0;
    const unsigned char* V = (const unsigned char*)F.out; bf16_t* X1 = (bf16_t*)(F.ws + WS_X1); unsigned char* U2 = (unsigned char*)(F.ws + WS_U); const float* ada = (const float*)(F.ws + WS_ADA);
    int* topi = (int*)(F.ws + WS_TOPI); float* topw = (float*)(F.ws + WS_TOPW);
    for (int gb = F.c * 8; gb < T / 16; gb += F.G * 8) {
        const int g = T / 16 - 1 - (gb + F.wave), t0 = g * 16, b = (T / 16 - 1 - gb) >> 7;
        __syncthreads();
        { int tz = threadIdx.x; asm volatile("" : "+v"(tz));
          for (int i = tz; i < 2048; i += NTHR) par[2048 + i] = i < 1024 ? 1.0f + ada[(size_t)b * 6144 + 4096 + i] : ada[(size_t)b * 6144 + 3072 + (i - 1024)]; }
        __syncthreads();
        int l1 = threadIdx.x; asm volatile("" : "+v"(l1)); l1 &= 63;
        const float* xp = F.in[I_X] + (size_t)(t0 + (l1 & 15)) * 1024 + 8 * (l1 >> 4); const unsigned char* vp = V + (size_t)(t0 + (l1 & 15)) * 1024 + 8 * (l1 >> 4);
        unsigned tb[32][4]; float s1 = 0.f, s2 = 0.f, s1b = 0.f, s2b = 0.f;
#pragma unroll
        for (int c = 0; c < 16; ++c) {
            f32x4 xa[2], xb[2]; u32x2 vv[2];
#pragma unroll
            for (int q = 0; q < 2; ++q) { const int ks = 2 * c + q; xa[q] = *(const f32x4*)(xp + 32 * ks); xb[q] = *(const f32x4*)(xp + 32 * ks + 4); vv[q] = *(const u32x2*)(vp + 32 * ks); }
#pragma unroll
            for (int q = 0; q < 2; ++q) { const int ks = 2 * c + q;
                const f32x4 ta = xa[q] * DN_ALPHA + fp8x4_to_f32(vv[q].x) * V8_INV, tc = xb[q] * DN_ALPHA + fp8x4_to_f32(vv[q].y) * V8_INV;
#pragma unroll
                for (int j = 0; j < 4; ++j) { s1 += ta[j]; s1b += tc[j]; s2 = __builtin_fmaf(ta[j], ta[j], s2); s2b = __builtin_fmaf(tc[j], tc[j], s2b); }
                tb[ks][0] = cvt_pk_bf16(ta[0], ta[1]); tb[ks][1] = cvt_pk_bf16(ta[2], ta[3]); tb[ks][2] = cvt_pk_bf16(tc[0], tc[1]); tb[ks][3] = cvt_pk_bf16(tc[2], tc[3]); }
            asm volatile("" ::: "memory"); __builtin_amdgcn_sched_barrier(0);
        }
        s1 += s1b; s2 += s2b;
        {   int l4 = threadIdx.x; asm volatile("" : "+v"(l4)); l4 &= 63; const int b16 = (l4 ^ 16) << 2, b32 = (l4 ^ 32) << 2;
            s1 += __int_as_float(__builtin_amdgcn_ds_bpermute(b16, __float_as_int(s1))); s2 += __int_as_float(__builtin_amdgcn_ds_bpermute(b16, __float_as_int(s2)));
            s1 += __int_as_float(__builtin_amdgcn_ds_bpermute(b32, __float_as_int(s1))); s2 += __int_as_float(__builtin_amdgcn_ds_bpermute(b32, __float_as_int(s2))); }
        const float mean = s1 * (1.0f / 1024.0f), rstd = __builtin_amdgcn_rsqf(fmaxf(s2 * (1.0f / 1024.0f) - mean * mean, 0.f) + LN_EPS), nmr = -mean * rstd;
        f32x4 acc[2] = {(f32x4){0.f, 0.f, 0.f, 0.f}, (f32x4){0.f, 0.f, 0.f, 0.f}};
        int l2 = threadIdx.x; asm volatile("" : "+v"(l2)); l2 &= 63; const int fr = l2 & 15, fq = l2 >> 4;
        bf16_t* x1p = X1 + (size_t)(t0 + fr) * 1024 + 8 * fq; unsigned char* u2p = U2 + (size_t)(t0 + fr) * 1024 + 8 * fq;
#pragma unroll
        for (int ks = 0; ks < 32; ++ks) {
            const LAS float* pp = par + 32 * ks + 8 * fq;
            const f32x4 ta = {bf_lo(tb[ks][0]), bf_hi(tb[ks][0]), bf_lo(tb[ks][1]), bf_hi(tb[ks][1])}, tc = {bf_lo(tb[ks][2]), bf_hi(tb[ks][2]), bf_lo(tb[ks][3]), bf_hi(tb[ks][3])};
            f32x4 xa, xc, ua, uc;
            {   const f32x4 g0 = *(const LAS f32x4*)pp, b0 = *(const LAS f32x4*)(pp + 1024), c0 = *(const LAS f32x4*)(pp + 2048), h0 = *(const LAS f32x4*)(pp + 3072);
                xa = (ta * rstd + nmr) * g0 + b0; ua = xa * c0 + h0; }
            __builtin_amdgcn_sched_barrier(0);
            {   const f32x4 g1 = *(const LAS f32x4*)(pp + 4), b1 = *(const LAS f32x4*)(pp + 1028), c1 = *(const LAS f32x4*)(pp + 2052), h1 = *(const LAS f32x4*)(pp + 3076);
                xc = (tc * rstd + nmr) * g1 + b1; uc = xc * c1 + h1; }
            if (!dry) *(u32x4*)(x1p + 32 * ks) = (u32x4){cvt_pk_bf16(xa[0], xa[1]), cvt_pk_bf16(xa[2], xa[3]), cvt_pk_bf16(xc[0], xc[1]), cvt_pk_bf16(xc[2], xc[3])};
            if (!dry) *(u32x2*)(u2p + 32 * ks) = (u32x2){cvt_pk4_fp8(ua[0], ua[1], ua[2], ua[3]), cvt_pk4_fp8(uc[0], uc[1], uc[2], uc[3])};
            u32x4 hi = {cvt_pk_bf16(ua[0], ua[1]), cvt_pk_bf16(ua[2], ua[3]), cvt_pk_bf16(uc[0], uc[1]), cvt_pk_bf16(uc[2], uc[3])};
            u32x4 lo = {cvt_pk_bf16(ua[0] - bf_lo(hi[0]), ua[1] - bf_hi(hi[0])), cvt_pk_bf16(ua[2] - bf_lo(hi[1]), ua[3] - bf_hi(hi[1])), cvt_pk_bf16(uc[0] - bf_lo(hi[2]), uc[1] - bf_hi(hi[2])), cvt_pk_bf16(uc[2] - bf_lo(hi[3]), uc[3] - bf_hi(hi[3]))};
            const bf16x8 uh = *(bf16x8*)&hi, ul = *(bf16x8*)&lo;
#pragma unroll
            for (int et = 0; et < 2; ++et) {
                const bf16x8 wh = *(const LAS bf16x8*)(L + RW_HI + (16 * et + fr) * RW_STRIDE + ks * 64 + fq * 16), wl = *(const LAS bf16x8*)(L + RW_LO + (16 * et + fr) * RW_STRIDE + ks * 64 + fq * 16);
                acc[et] = __builtin_amdgcn_mfma_f32_16x16x32_bf16(wh, uh, acc[et], 0, 0, 0);
                acc[et] = __builtin_amdgcn_mfma_f32_16x16x32_bf16(wh, ul, acc[et], 0, 0, 0);
                acc[et] = __builtin_amdgcn_mfma_f32_16x16x32_bf16(wl, uh, acc[et], 0, 0, 0);
                __builtin_amdgcn_sched_barrier(0); }
        }
        int l3 = threadIdx.x; asm volatile("" : "+v"(l3)); l3 &= 63; const int fq3 = l3 >> 4, t = t0 + (l3 & 15), a16 = (l3 ^ 16) << 2, a32 = (l3 ^ 32) << 2;
        float lv[8]; int li[8];
#pragma unroll
        for (int i = 0; i < 4; ++i) { li[i] = 4 * fq3 + i; li[4 + i] = 16 + 4 * fq3 + i; lv[i] = acc[0][i] + brs[4 * fq3 + i]; lv[4 + i] = acc[1][i] + brs[16 + 4 * fq3 + i]; }
        float tv[4]; int ti[4];
#pragma unroll
        for (int r = 0; r < 4; ++r) {
            float bv = lv[0]; int bi = li[0];
#pragma unroll
            for (int i = 1; i < 8; ++i) { const bool gt = lv[i] > bv; bv = gt ? lv[i] : bv; bi = gt ? li[i] : bi; }
#pragma unroll
            for (int o = 0; o < 2; ++o) { const int ad = o ? a32 : a16; const float ov = __int_as_float(__builtin_amdgcn_ds_bpermute(ad, __float_as_int(bv))); const int oi = __builtin_amdgcn_ds_bpermute(ad, bi); const bool tk = ov > bv || (ov == bv && oi < bi); bv = tk ? ov : bv; bi = tk ? oi : bi; }
            tv[r] = bv; ti[r] = bi;
#pragma unroll
            for (int i = 0; i < 8; ++i) lv[i] = (li[i] == bi) ? -3.0e38f : lv[i];
        }
        if (fq3 == 0) {
            const float p1 = fast_exp(tv[1] - tv[0]), p2 = fast_exp(tv[2] - tv[0]), p3 = fast_exp(tv[3] - tv[0]), inv = 1.0f / (1.0f + p1 + p2 + p3);
            *(int4*)(topi + (size_t)t * 4) = make_int4(ti[0], ti[1], ti[2], ti[3]);
            *(f32x4*)(topw + (size_t)t * 4) = (f32x4){inv, p1 * inv, p2 * inv, p3 * inv};
            const int ch = t / TCH;
            if (!dry) { atomicAdd((int*)(hist + ch * 32 + ti[0]), 1); atomicAdd((int*)(hist + ch * 32 + ti[1]), 1); atomicAdd((int*)(hist + ch * 32 + ti[2]), 1); atomicAdd((int*)(hist + ch * 32 + ti[3]), 1); }
        }
    }
    __syncthreads();
    { int t2 = threadIdx.x; asm volatile("" : "+v"(t2));
      if (t2 < NCH * 32) { const int h = hist[t2]; if (h && !dry) atomicAdd(F.ctl + CW_CNT + t2, (unsigned)h); } }
    __syncthreads();
}

__device__ __forceinline__ void p10_dispatch(const Frame& F) {
    LAS int* lcnt = (LAS int*)F.lds; LAS int* lbase = lcnt + 32; LAS int* pstart = lcnt + 64;
    const int* topi = (const int*)(F.ws + WS_TOPI); int* pos = (int*)(F.ws + WS_POS); int* rowtok = (int*)(F.ws + WS_ROWTOK);
    for (int s = F.c; s < T / 256; s += F.G) {
        const int ch = (s * 256) / TCH;
        __syncthreads();
        if (F.tid < 32) { lcnt[F.tid] = 0; int ps = 0; for (int e = 0; e < F.tid; ++e) { const int n = (int)__hip_atomic_load(F.ctl + CW_CNT + ch * 32 + e, __ATOMIC_RELAXED, __HIP_MEMORY_SCOPE_AGENT); ps += (n + 255) & ~255; } pstart[F.tid] = ps; }
        __syncthreads();
        int e2[2], r2[2];
#pragma unroll
        for (int i = 0; i < 2; ++i) { const int a = F.tid + i * NTHR; e2[i] = topi[(size_t)(s * 256) * 4 + a]; r2[i] = atomicAdd((int*)(lcnt + e2[i]), 1); }
        __syncthreads();
        if (F.tid < 32) lbase[F.tid] = (int)atomicAdd(F.ctl + CW_CUR + ch * 32 + F.tid, (unsigned)lcnt[F.tid]);
        __syncthreads();
#pragma unroll
        for (int i = 0; i < 2; ++i) { const int a = F.tid + i * NTHR, slot = pstart[e2[i]] + lbase[e2[i]] + r2[i];
            pos[(size_t)(s * 256) * 4 + a] = slot; rowtok[(size_t)ch * ROWS_CH + slot] = s * 256 + (a >> 2); }
    }
}
__device__ __forceinline__ int moe_blocks(const Frame& F, int ch, LAS unsigned char* blk_e) {
    LAS int* sh = (LAS int*)(blk_e + 1152);
    __syncthreads();
    if (F.tid < 32) {
        int start = 0, mine = 0;
        for (int e = 0; e < 32; ++e) { const int n = ((int)__hip_atomic_load(F.ctl + CW_CNT + ch * 32 + e, __ATOMIC_RELAXED, __HIP_MEMORY_SCOPE_AGENT) + 255) >> 8; if (e < F.tid) start += n; if (e == F.tid) mine = n; }
        for (int i = 0; i < mine; ++i) blk_e[start + i] = (unsigned char)F.tid;
        if (F.tid == 31) sh[0] = start + mine;
    }
    __syncthreads();
    return sh[0];
}

__device__ __forceinline__ void p13_combine_ln2(const Frame& F, int ch, const bool dry) {
    const unsigned char* YC = (const unsigned char*)(F.ws + WS_YCH); const int* pos = (const int*)(F.ws + WS_POS); const float* topw = (const float*)(F.ws + WS_TOPW);
    const float* ada = (const float*)(F.ws + WS_ADA); const bf16_t* X1 = (const bf16_t*)(F.ws + WS_X1); float* O = F.out;
    const int l8 = F.lane * 8;
    for (int t0 = ch * TCH + F.c * 8 + F.wave; t0 < (ch + 1) * TCH; t0 += 2 * F.G * 8) {
        int tt[2]; tt[0] = t0; tt[1] = t0 + F.G * 8; const bool two = tt[1] < (ch + 1) * TCH; if (!two) tt[1] = t0;
        f32x4 v[2][2][2];
#pragma unroll
        for (int q = 0; q < 2; ++q) { const int t = tt[q], b = t >> 11;
            const int4 ps = *(const int4*)(pos + (size_t)t * 4); const f32x4 tw = *(const f32x4*)(topw + (size_t)t * 4);
#pragma unroll
            for (int j = 0; j < 2; ++j) { const int k = 512 * j + l8;
                const u32x2 y0 = *(const u32x2*)(YC + (size_t)ps.x * 1024 + k), y1 = *(const u32x2*)(YC + (size_t)ps.y * 1024 + k), y2 = *(const u32x2*)(YC + (size_t)ps.z * 1024 + k), y3 = *(const u32x2*)(YC + (size_t)ps.w * 1024 + k);
                const u32x4 xw = *(const u32x4*)(X1 + (size_t)t * 1024 + k);
                const f32x4 g2a = *(const f32x4*)(ada + (size_t)b * 6144 + 5120 + k), g2b = *(const f32x4*)(ada + (size_t)b * 6144 + 5120 + k + 4);
                const f32x4 ffa = fp8x4_to_f32(y0.x) * tw[0] + fp8x4_to_f32(y1.x) * tw[1] + fp8x4_to_f32(y2.x) * tw[2] + fp8x4_to_f32(y3.x) * tw[3];
                const f32x4 ffb = fp8x4_to_f32(y0.y) * tw[0] + fp8x4_to_f32(y1.y) * tw[1] + fp8x4_to_f32(y2.y) * tw[2] + fp8x4_to_f32(y3.y) * tw[3];
                v[q][j][0] = (f32x4){bf_lo(xw.x), bf_hi(xw.x), bf_lo(xw.y), bf_hi(xw.y)} * DN_ALPHA + g2a * ffa;
                v[q][j][1] = (f32x4){bf_lo(xw.z), bf_hi(xw.z), bf_lo(xw.w), bf_hi(xw.w)} * DN_ALPHA + g2b * ffb; } }
#pragma unroll
        for (int q = 0; q < 2; ++q) { const int t = tt[q];
            float s = 0.f;
#pragma unroll
            for (int j = 0; j < 2; ++j)
#pragma unroll
                for (int h = 0; h < 2; ++h) s += (v[q][j][h][0] + v[q][j][h][1]) + (v[q][j][h][2] + v[q][j][h][3]);
            s = wave_sum(s); const float mean = s * (1.0f / 1024.0f); float qq = 0.f;
#pragma unroll
            for (int j = 0; j < 2; ++j)
#pragma unroll
                for (int h = 0; h < 2; ++h) { const f32x4 d = v[q][j][h] - mean; qq += (d[0] * d[0] + d[1] * d[1]) + (d[2] * d[2] + d[3] * d[3]); }
            qq = wave_sum(qq); const float rstd = __builtin_amdgcn_rsqf(qq * (1.0f / 1024.0f) + LN_EPS);
            if (q == 0 || two) {
#pragma unroll
                for (int j = 0; j < 2; ++j)
#pragma unroll
                    for (int h = 0; h < 2; ++h) { const int k = 512 * j + l8 + 4 * h; const f32x4 g = *(const f32x4*)(F.in[I_LN2G] + k), bb = *(const f32x4*)(F.in[I_LN2B] + k);
                        const f32x4 o4 = (v[q][j][h] - mean) * rstd * g + bb;
                        if (!dry) *(f32x4*)(O + (size_t)t * 1024 + k) = o4; else if (o4[0] == 1.2345e30f) O[0] = 1.f; } }
        }
    }
}

constexpr int SC_QD = 0, SC_KI = 17408, SC_KE = 34816, SC_VT = 53248, SC_SC = 71680, SC_ST = 80896, SC_GV = 115712, SC_CS = 116224;
__device__ __forceinline__ bf16x8 ldfrag(const LAS unsigned char* p) { return *(const LAS bf16x8*)p; }
__device__ __forceinline__ void p3_scan(const Frame& F, const bool dry) {
    LAS unsigned char* L = F.lds;
    const int tid = F.tid, w = F.wave, lane = F.lane, fr = lane & 15, fq = lane >> 4;
    const int d = tid & 127, qd = __builtin_amdgcn_readfirstlane(tid >> 7);
    bf16_t* PH = (bf16_t*)(F.ws + WS_PH); const bf16_t* PHC = (const bf16_t*)(F.ws + WS_PHC);
    for (int it = F.c; it < 256; it += F.G) {
        const int b = it >> 3, h = (it >> 1) & 3, dir = it & 1;
        const float r0 = F.in[I_LBRAW][dir * 512 + h * 128 + d], r1 = F.in[I_LBRAW][1024 + dir * 512 + h * 128 + d];
        const float lbv = fast_sigmoid(r0 - r1), oml = 1.0f - lbv;
        f32x4 Sacc[8];
#pragma unroll
        for (int i = 0; i < 8; ++i) Sacc[i] = (f32x4){0.f, 0.f, 0.f, 0.f};
        __syncthreads();
        for (int i = tid; i < 34816 / 4; i += NTHR) ((LAS unsigned*)(L + SC_ST))[i] = 0u;
        const int cq = h * 128 + d, cz = (dir ? 3584 : 512) + h * 128 + d;
        unsigned char rq[16], rv[16], rz[16];
        {   const int n = dir ? 3 : 0; const bf16_t* base = PHC + (size_t)(b * 256 + 64 * n + 16 * qd) * 2048; const unsigned char* base8 = (const unsigned char*)base;
#pragma unroll
            for (int i = 0; i < 16; ++i) { rq[i] = base8[(size_t)i * 4096 + cq]; rz[i] = base8[(size_t)i * 4096 + cz]; rv[i] = base8[(size_t)i * 4096 + 3072 + cq]; } }
        for (int s = 0; s < 36; ++s) {
            const bool lat = s >= 4; const int n = lat ? (dir ? 31 - (s - 4) : (s - 4)) : (dir ? 3 - s : s);
            float kk[16], cum[16]; float run = 0.f;
#pragma unroll
            for (int i = 0; i < 16; ++i) { const float sg = (float)rz[i] * (1.0f / 255.0f); kk[i] = oml * (1.0f - sg); cum[i] = lbv + oml * sg; }
            run = 1.0f;
            if (dir == 0) {
#pragma unroll
                for (int i = 0; i < 16; ++i) { run *= cum[i]; cum[i] = run; }
            } else {
#pragma unroll
                for (int i = 15; i >= 0; --i) { run *= cum[i]; cum[i] = run; }
            }
            ((LAS float*)(L + SC_CS))[qd * 128 + d] = run;
            __syncthreads();
            {   const LAS float* cs = (const LAS float*)(L + SC_CS);
                const float c0 = cs[d], c1 = cs[128 + d], c2 = cs[256 + d], c3 = cs[384 + d], tot = (c0 * c1) * (c2 * c3);
                float off;
                if (dir == 0) off = (qd > 0 ? c0 : 1.f) * (qd > 1 ? c1 : 1.f) * (qd > 2 ? c2 : 1.f);
                else off = (qd < 3 ? c3 : 1.f) * (qd < 2 ? c2 : 1.f) * (qd < 1 ? c1 : 1.f);
                const float g = tot;
                if (qd == 0) ((LAS float*)(L + SC_GV))[d] = g;
                unsigned ke[8], vt[8];
#pragma unroll
                for (int i = 0; i < 16; i += 2) {
                    const float ea = cum[i] * off, eb = cum[i + 1] * off, ia = __builtin_amdgcn_rcpf(ea), ib = __builtin_amdgcn_rcpf(eb);
                    const float qda = __builtin_amdgcn_cvt_f32_fp8((int)rq[i], 0) * ea, qdb = __builtin_amdgcn_cvt_f32_fp8((int)rq[i + 1], 0) * eb;
                    const float kia = kk[i] * ia, kib = kk[i + 1] * ib;
                    const unsigned wa = cvt_pk_bf16(qda, kia), wb = cvt_pk_bf16(qdb, kib);
                    *(LAS bf16_t*)(L + SC_QD + (16 * qd + i) * 272 + d * 2) = (bf16_t)(wa & 0xffffu);
                    *(LAS bf16_t*)(L + SC_KI + (16 * qd + i) * 272 + d * 2) = (bf16_t)(wa >> 16);
                    *(LAS bf16_t*)(L + SC_QD + (16 * qd + i + 1) * 272 + d * 2) = (bf16_t)(wb & 0xffffu);
                    *(LAS bf16_t*)(L + SC_KI + (16 * qd + i + 1) * 272 + d * 2) = (bf16_t)(wb >> 16);
                    ke[i >> 1] = cvt_pk_bf16(kia * g, kib * g);
                    vt[i >> 1] = cvt_pk_bf16(__builtin_amdgcn_cvt_f32_fp8((int)rv[i], 0), __builtin_amdgcn_cvt_f32_fp8((int)rv[i + 1], 0));
                }
                *(LAS u32x4*)(L + SC_KE + d * 144 + 32 * qd) = (u32x4){ke[0], ke[1], ke[2], ke[3]};
                *(LAS u32x4*)(L + SC_KE + d * 144 + 32 * qd + 16) = (u32x4){ke[4], ke[5], ke[6], ke[7]};
                *(LAS u32x4*)(L + SC_VT + d * 144 + 32 * qd) = (u32x4){vt[0], vt[1], vt[2], vt[3]};
                *(LAS u32x4*)(L + SC_VT + d * 144 + 32 * qd + 16) = (u32x4){vt[4], vt[5], vt[6], vt[7]};
            }
            if (s + 1 < 36) {
                const int s1 = s + 1; const bool lat1 = s1 >= 4; const int n1 = lat1 ? (dir ? 31 - (s1 - 4) : (s1 - 4)) : (dir ? 3 - s1 : s1);
                const bf16_t* base = lat1 ? (const bf16_t*)PH + (size_t)(b * 2048 + 64 * n1 + 16 * qd) * 2048 : PHC + (size_t)(b * 256 + 64 * n1 + 16 * qd) * 2048;
                const unsigned char* base8 = (const unsigned char*)base;
#pragma unroll
                for (int i = 0; i < 16; ++i) { rq[i] = base8[(size_t)i * 4096 + cq]; rz[i] = base8[(size_t)i * 4096 + cz]; rv[i] = base8[(size_t)i * 4096 + 3072 + cq]; }
            }
            __syncthreads();
            f32x4 oacc[4];
#pragma unroll
            for (int i = 0; i < 4; ++i) oacc[i] = (f32x4){0.f, 0.f, 0.f, 0.f};
            const int kb = fq * 16;
            if (lat) {
                const int ct = w >> 1, st0 = 2 * (w & 1);
#pragma unroll
                for (int j = 0; j < 2; ++j) { const int st = st0 + j; f32x4 sa = (f32x4){0.f, 0.f, 0.f, 0.f};
#pragma unroll
                    for (int ks = 0; ks < 4; ++ks) sa = __builtin_amdgcn_mfma_f32_16x16x32_bf16(ldfrag(L + SC_KI + (16 * st + fr) * 272 + ks * 64 + kb), ldfrag(L + SC_QD + (16 * ct + fr) * 272 + ks * 64 + kb), sa, 0, 0, 0);
                    const int cc = 16 * ct + fr, s0 = 16 * st + 4 * fq;
#pragma unroll
                    for (int i = 0; i < 4; ++i) { const bool keep = dir ? (s0 + i >= cc) : (s0 + i <= cc); sa[i] = keep ? sa[i] : 0.f; }
                    *(LAS u32x2*)(L + SC_SC + cc * 144 + s0 * 2) = (u32x2){cvt_pk_bf16(sa[0], sa[1]), cvt_pk_bf16(sa[2], sa[3])}; }
#pragma unroll
                for (int ct2 = 0; ct2 < 4; ++ct2)
#pragma unroll
                    for (int ks = 0; ks < 4; ++ks) oacc[ct2] = __builtin_amdgcn_mfma_f32_16x16x32_bf16(ldfrag(L + SC_ST + (16 * w + fr) * 272 + ks * 64 + kb), ldfrag(L + SC_QD + (16 * ct2 + fr) * 272 + ks * 64 + kb), oacc[ct2], 0, 0, 0);
            }
            {   const bf16x8 v0 = ldfrag(L + SC_VT + (16 * w + fr) * 144 + kb), v1 = ldfrag(L + SC_VT + (16 * w + fr) * 144 + 64 + kb);
#pragma unroll
                for (int dt = 0; dt < 8; ++dt) { const f32x4 gv = *(const LAS f32x4*)(L + SC_GV + (16 * dt + 4 * fq) * 4);
                    f32x4 a = Sacc[dt] * gv;
                    a = __builtin_amdgcn_mfma_f32_16x16x32_bf16(ldfrag(L + SC_KE + (16 * dt + fr) * 144 + kb), v0, a, 0, 0, 0);
                    a = __builtin_amdgcn_mfma_f32_16x16x32_bf16(ldfrag(L + SC_KE + (16 * dt + fr) * 144 + 64 + kb), v1, a, 0, 0, 0);
                    Sacc[dt] = a; } }
            __syncthreads();
#pragma unroll
            for (int dt = 0; dt < 8; ++dt) *(LAS u32x2*)(L + SC_ST + (16 * w + fr) * 272 + (16 * dt + 4 * fq) * 2) = (u32x2){cvt_pk_bf16(Sacc[dt][0], Sacc[dt][1]), cvt_pk_bf16(Sacc[dt][2], Sacc[dt][3])};
            if (lat) {
                const bf16x8 v0 = ldfrag(L + SC_VT + (16 * w + fr) * 144 + kb), v1 = ldfrag(L + SC_VT + (16 * w + fr) * 144 + 64 + kb);
                unsigned char* ob = (unsigned char*)PH + (size_t)(b * 2048 + 64 * n) * 4096 + 1024 + dir * 1024 + h * 128 + 16 * w + 4 * fq;
#pragma unroll
                for (int ct2 = 0; ct2 < 4; ++ct2) {
                    f32x4 a = oacc[ct2];
                    a = __builtin_amdgcn_mfma_f32_16x16x32_bf16(v0, ldfrag(L + SC_SC + (16 * ct2 + fr) * 144 + kb), a, 0, 0, 0);
                    a = __builtin_amdgcn_mfma_f32_16x16x32_bf16(v1, ldfrag(L + SC_SC + (16 * ct2 + fr) * 144 + 64 + kb), a, 0, 0, 0);
                    if (!dry) *(unsigned*)(ob + (size_t)(16 * ct2 + fr) * 4096) = cvt_pk4_fp8(a[0], a[1], a[2], a[3]);
                    else if (a[0] == 1.2345e30f) ob[0] = 1; }
            }
        }
        __syncthreads();
    }
}

typedef short s16x4 __attribute__((ext_vector_type(4)));
__device__ __forceinline__ s16x4 tr_read(unsigned lds_addr) { s16x4 r; asm volatile("ds_read_b64_tr_b16 %0, %1\n\ts_waitcnt lgkmcnt(0)" : "=&v"(r) : "v"(lds_addr) : "memory"); return r; }
__device__ __forceinline__ void tr_read8(unsigned a0, unsigned a1, unsigned a2, unsigned a3, unsigned d, s16x4 (&r)[8]) {
    asm volatile("ds_read_b64_tr_b16 %0, %8\n\tds_read_b64_tr_b16 %1, %9\n\tds_read_b64_tr_b16 %2, %10\n\tds_read_b64_tr_b16 %3, %11\n\t"
                 "ds_read_b64_tr_b16 %4, %12\n\tds_read_b64_tr_b16 %5, %13\n\tds_read_b64_tr_b16 %6, %14\n\tds_read_b64_tr_b16 %7, %15\n\ts_waitcnt lgkmcnt(0)"
                 : "=&v"(r[0]), "=&v"(r[1]), "=&v"(r[2]), "=&v"(r[3]), "=&v"(r[4]), "=&v"(r[5]), "=&v"(r[6]), "=&v"(r[7])
                 : "v"(a0), "v"(a0 + d), "v"(a1), "v"(a1 + d), "v"(a2), "v"(a2 + d), "v"(a3), "v"(a3 + d) : "memory");
}
__device__ __forceinline__ void tr_read4(unsigned a0, unsigned a1, unsigned d, s16x4 (&r)[4]) {
    asm volatile("ds_read_b64_tr_b16 %0, %4\n\tds_read_b64_tr_b16 %1, %5\n\tds_read_b64_tr_b16 %2, %6\n\tds_read_b64_tr_b16 %3, %7\n\ts_waitcnt lgkmcnt(0)"
                 : "=&v"(r[0]), "=&v"(r[1]), "=&v"(r[2]), "=&v"(r[3]) : "v"(a0), "v"(a0 + d), "v"(a1), "v"(a1 + d) : "memory");
}
__device__ __forceinline__ bf16x8 cat4(s16x4 a, s16x4 b) { return (bf16x8){a[0], a[1], a[2], a[3], b[0], b[1], b[2], b[3]}; }
constexpr int FO_C = 131072, FO_S = 139264;
__device__ __forceinline__ void p4_fourier(const Frame& F) {
    LAS unsigned char* L = F.lds;
    const int tid = F.tid, w = F.wave, lane = F.lane, fr = lane & 15, fq = lane >> 4;
    const bf16_t* PA = (const bf16_t*)(F.ws + WS_PA); unsigned char* Y = (unsigned char*)(F.ws + WS_Y);
    __syncthreads();
    for (int i = tid; i < 4096; i += NTHR) { const int k2 = i >> 6, c = i & 63; const float a = (float)((k2 * c) & 63) * (1.0f / 64.0f);
        *(LAS bf16_t*)(L + FO_C + i * 2) = (bf16_t)(cvt_pk_bf16(__builtin_amdgcn_cosf(a) * 0.125f, 0.f) & 0xffffu);
        *(LAS bf16_t*)(L + FO_S + i * 2) = (bf16_t)(cvt_pk_bf16(__builtin_amdgcn_sinf(a) * 0.125f, 0.f) & 0xffffu); }
    bf16x8 Gf[2][2];
#pragma unroll
    for (int nt = 0; nt < 2; ++nt)
#pragma unroll
        for (int ks = 0; ks < 2; ++ks) { unsigned pk[4];
#pragma unroll
            for (int j = 0; j < 8; j += 2) { const int k1 = 16 * nt + fr, ra = 8 * fq + j, rb = ra + 1; const float aa = (float)((k1 * ra) & 31) * (1.0f / 32.0f), ab = (float)((k1 * rb) & 31) * (1.0f / 32.0f);
                const float va = (ks ? __builtin_amdgcn_sinf(aa) : __builtin_amdgcn_cosf(aa)) * 0.17677669529663687f, vb = (ks ? __builtin_amdgcn_sinf(ab) : __builtin_amdgcn_cosf(ab)) * 0.17677669529663687f;
                pk[j >> 1] = cvt_pk_bf16(va, vb); }
            u32x4 t4 = (u32x4){pk[0], pk[1], pk[2], pk[3]}; Gf[nt][ks] = *(bf16x8*)&t4; }
    const unsigned lbase = (unsigned)(size_t)L;
    u32x4 pv[8];
    if (F.c < 1024) { const int it = F.c, xcd = it & 7, jj = it >> 3, slab = 4 * xcd + (jj & 3), b = jj >> 2; const unsigned char* src = (const unsigned char*)PA + (size_t)(b * 32 + slab) * 65536;
#pragma unroll
        for (int n = 0; n < 8; ++n) pv[n] = *(const u32x4*)(src + (size_t)(tid + NTHR * n) * 16); }
    for (int it = F.c; it < 1024; it += F.G) {
        const int xcd = it & 7, jj = it >> 3, slab = 4 * xcd + (jj & 3), b = jj >> 2;
        __syncthreads();
#pragma unroll
        for (int n = 0; n < 8; ++n) {
            const u32x4 w = pv[n]; u32x4 lo, hi;
            { const f32x4 a = fp8x4_to_f32(w.x), c = fp8x4_to_f32(w.y); lo = (u32x4){cvt_pk_bf16(a[0], a[1]), cvt_pk_bf16(a[2], a[3]), cvt_pk_bf16(c[0], c[1]), cvt_pk_bf16(c[2], c[3])}; }
            { const f32x4 a = fp8x4_to_f32(w.z), c = fp8x4_to_f32(w.w); hi = (u32x4){cvt_pk_bf16(a[0], a[1]), cvt_pk_bf16(a[2], a[3]), cvt_pk_bf16(c[0], c[1]), cvt_pk_bf16(c[2], c[3])}; }
            *(LAS u32x4*)(L + (tid + NTHR * n) * 32) = lo; *(LAS u32x4*)(L + (tid + NTHR * n) * 32 + 16) = hi; }
        __syncthreads();
        if (it + F.G < 1024) { const int it1 = it + F.G, xcd1 = it1 & 7, jj1 = it1 >> 3, slab1 = 4 * xcd1 + (jj1 & 3), b1 = jj1 >> 2; const unsigned char* src = (const unsigned char*)PA + (size_t)(b1 * 32 + slab1) * 65536;
#pragma unroll
            for (int n = 0; n < 8; ++n) pv[n] = *(const u32x4*)(src + (size_t)(tid + NTHR * n) * 16); }
#pragma unroll 1
        for (int rr = 0; rr < 4; ++rr) {
            const int r = w + 8 * rr;
            f32x4 acc[8];
#pragma unroll
            for (int i = 0; i < 8; ++i) acc[i] = (f32x4){0.f, 0.f, 0.f, 0.f};
            s16x4 tr[8];
            {   unsigned aa[4];
#pragma unroll
                for (int ks = 0; ks < 4; ++ks) { const int ri = ks >> 1, c0 = 32 * (ks & 1) + 8 * fq + (fr >> 2); aa[ks] = lbase + (unsigned)((r * 64 + c0) * 64 + ri * 32 + (fr & 3) * 8); }
                tr_read8(aa[0], aa[1], aa[2], aa[3], 4u * 64u, tr); }
#pragma unroll
            for (int ks = 0; ks < 4; ++ks) {
                const int ri = ks >> 1;
                const bf16x8 af = cat4(tr[2 * ks], tr[2 * ks + 1]);
#pragma unroll
                for (int nt = 0; nt < 8; ++nt) { const int ro = nt >> 2, k2 = 16 * (nt & 3) + fr;
                    u32x4 bw = *(const LAS u32x4*)(L + ((ro == ri) ? FO_C : FO_S) + (k2 * 64 + 32 * (ks & 1) + 8 * fq) * 2);
                    if (ro == 1 && ri == 0) { bw.x ^= 0x80008000u; bw.y ^= 0x80008000u; bw.z ^= 0x80008000u; bw.w ^= 0x80008000u; }
                    acc[nt] = __builtin_amdgcn_mfma_f32_16x16x32_bf16(af, *(bf16x8*)&bw, acc[nt], 0, 0, 0); }
            }
#pragma unroll
            for (int nt = 0; nt < 8; ++nt) { const int ro = nt >> 2, k2 = 16 * (nt & 3) + fr;
                *(LAS u32x2*)(L + (r * 64 + k2) * 64 + ro * 32 + fq * 8) = (u32x2){cvt_pk_bf16(acc[nt][0], acc[nt][1]), cvt_pk_bf16(acc[nt][2], acc[nt][3])}; }
        }
        __syncthreads();
#pragma unroll 1
        for (int kk = 0; kk < 8; ++kk) {
            const int k2 = 8 * w + kk;
            f32x4 a2[2] = {(f32x4){0.f, 0.f, 0.f, 0.f}, (f32x4){0.f, 0.f, 0.f, 0.f}};
            s16x4 t4[4];
            {   const int r0 = 8 * fq + (fr >> 2); const unsigned a0 = lbase + (unsigned)((r0 * 64 + k2) * 64 + (fr & 3) * 8);
                tr_read4(a0, a0 + 32u, 4u * 64u * 64u, t4); }
#pragma unroll
            for (int ks = 0; ks < 2; ++ks) {
                const bf16x8 af = cat4(t4[2 * ks], t4[2 * ks + 1]);
                a2[0] = __builtin_amdgcn_mfma_f32_16x16x32_bf16(af, Gf[0][ks], a2[0], 0, 0, 0);
                a2[1] = __builtin_amdgcn_mfma_f32_16x16x32_bf16(af, Gf[1][ks], a2[1], 0, 0, 0);
            }
#pragma unroll
            for (int nt = 0; nt < 2; ++nt) { const int k1 = 16 * nt + fr;
                *(unsigned*)(Y + (size_t)(b * 2048 + k1 * 64 + k2) * 1024 + slab * 16 + 4 * fq) = cvt_pk4_fp8(a2[nt][0], a2[nt][1], a2[nt][2], a2[nt][3]); }
        }
    }
    __syncthreads();
}

struct Args { const float* in[22]; float* out; unsigned char* ws; int ph_lo, ph_hi; };
constexpr int N_PHASES = 9 + 3 * NCH;

__global__ void __launch_bounds__(NTHR, 2) mega_fwd(Args args) {
    extern __shared__ __attribute__((aligned(16))) unsigned char lds_raw[];
    Frame F;
    F.lds = (LAS unsigned char*)lds_raw;
    F.tid = threadIdx.x; F.lane = F.tid & 63; F.wave = __builtin_amdgcn_readfirstlane(F.tid >> 6);
    F.G = gridDim.x; F.c = blockIdx.x;
    F.in = args.in;
    F.out = args.out; F.ws = args.ws; F.ctl = (unsigned*)(args.ws + WS_CTL);
    volatile LAS unsigned* misc = (volatile LAS unsigned*)(F.lds + LDS_MISC);
    if (F.tid < 4) misc[F.tid] = 0u;
    __syncthreads();
    XcdBarrier bar = xcd_barrier_post(F.ctl, misc);
    const int lo = args.ph_lo, hi = args.ph_hi;
#ifndef PHASE_MASK
#define PHASE_MASK 0xFFFFFFFFu
#endif
#define IN(k) ((((PHASE_MASK) >> (k)) & 1u) && lo <= (k) && (k) < hi)
#define SEAM(k) do { if (IN(k) && IN((k) + 1)) xcd_barrier(bar); } while (0)
#ifndef REP_MASK
#define REP_MASK 0u
#endif
#define REPS(b) ((((REP_MASK) >> (b)) & 1u) ? 2 : 1)
#define REPBAR(b, r) do { if ((((REP_MASK) >> (b)) & 1u) && (r) == 0) xcd_barrier(bar); } while (0)
    unsigned char* ws = F.ws;
    LAS unsigned char* blk_e = F.lds + LDS_MISC + 64;
#ifdef PR_A
    unsigned long long* stamps = (unsigned long long*)(ws + 980 * MiB);
#define STAMP(slot) do { if (F.tid == 0) stamps[(slot) * 256 + F.c] = __builtin_amdgcn_s_memrealtime(); } while (0)
#else
#define STAMP(slot) do { } while (0)
#endif
    STAMP(0);

    if (IN(0)) { for (int r = 0; r < REPS(0); ++r) { p0_ada(F); p0_fold(F); p0_convert(F); REPBAR(0, r); } }
    STAMP(1);
    SEAM(0);
    if (IN(1)) { for (int r = 0; r < REPS(1); ++r) { p1_uprep(F); REPBAR(1, r); } }
    STAMP(2);
    SEAM(1);
    if (IN(2)) {
        ProbP1 P{(const char*)(ws + WS_U), 8, 1024u, 1024u, (const char*)(ws + WS_WIN1T), (unsigned)(WS_UC - WS_U), F.G, F.c};
        EpiP1 E{(bf16_t*)(ws + WS_PA), (bf16_t*)(ws + WS_PH), (bf16_t*)(ws + WS_PHC)};
        for (int r = 0; r < REPS(2); ++r) { pg8::gemm_phase<ProbP1, EpiP1, true, false, true>(F.lds, P, E); REPBAR(2, r); }
    }
    STAMP(3);
    SEAM(2);
    if (IN(3)) {
#ifndef NO_FOURIER
        for (int r = 0; r < REPS(4); ++r) { p4_fourier(F); REPBAR(4, r); }
        STAMP(5);
#endif
#ifndef NO_SCAN
        for (int r = 0; r < REPS(3); ++r) { p3_scan(F, r + 1 < REPS(3)); REPBAR(3, r); }
        STAMP(4);
#endif
#ifndef NO_P2GEMM
        ProbDense P{(const char*)(ws + WS_U), 8, 1024u, 1024u, (const char*)(ws + WS_WIN2T), 256, 10, F.G, F.c, 0};
        EpiP2 E{(unsigned char*)(ws + WS_PG), (unsigned char*)F.out};
        for (int r = 0; r < REPS(5); ++r) { pg8::gemm_phase<ProbDense, EpiP2, true, false, true>(F.lds, P, E); REPBAR(5, r); }
#endif
    }
    STAMP(6);
    SEAM(3);
    if (IN(4)) { for (int r = 0; r < REPS(6); ++r) { p6_readout(F); REPBAR(6, r); } }
    STAMP(7);
    SEAM(4);
    if (IN(5)) {
        ProbDense P{(const char*)(ws + WS_Y), 8, 1024u, 1024u, (const char*)(ws + WS_WMT), 256, 4, F.G, F.c, 1};
        EpiM1 E{(const unsigned char*)F.out, (unsigned char*)(ws + WS_PA)};
        for (int r = 0; r < REPS(7); ++r) { pg8::gemm_phase<ProbDense, EpiM1, true, true, true>(F.lds, P, E); REPBAR(7, r); }
    }
    STAMP(8);
    SEAM(5);
    if (IN(6)) {
        ProbDense P{(const char*)(ws + WS_PA), 8, 1024u, 1024u, (const char*)(ws + WS_WOT), 256, 4, F.G, F.c, 0};
        EpiM2 E{(const float*)(ws + WS_ADA), (unsigned char*)F.out};
        for (int r = 0; r < REPS(8); ++r) { pg8::gemm_phase<ProbDense, EpiM2, true, false, true>(F.lds, P, E); REPBAR(8, r); }
    }
    STAMP(9);
    SEAM(6);
    if (IN(7)) { for (int r = 0; r < REPS(9); ++r) { p9_ln1_router(fresh(F), r + 1 < REPS(9)); REPBAR(9, r); } }
    STAMP(10);
    SEAM(7);
    if (IN(8)) { p10_dispatch(F); }
    STAMP(11);
    SEAM(8);
#pragma unroll
    for (int ch = 0; ch < NCH; ++ch) {
        if (IN(9 + 3 * ch)) {
            const int nblk = moe_blocks(F, ch, blk_e);
            ProbMoE<true> P{(const char*)(ws + WS_U), 8, 1024u, 1024u, (const char*)(ws + WS_WGUT), (size_t)2048 * 1024, 8, nblk, F.G, F.c, (const int*)(ws + WS_ROWTOK) + (size_t)ch * ROWS_CH, blk_e};
            EpiGU E{F.in[I_BGU], (unsigned char*)(ws + WS_ACT)};
#ifdef GU_DRY
            pg8::gemm_phase<ProbMoE<true>, EpiGU, true, false, true, GU_DRY>(F.lds, P, E); xcd_barrier(bar);
#endif
            for (int r = 0; r < (ch == 0 ? REPS(10) : 1); ++r) { pg8::gemm_phase<ProbMoE<true>, EpiGU, true, false, true>(F.lds, P, E); if (ch == 0) REPBAR(10, r); }
        }
        STAMP(12);
        SEAM(9 + 3 * ch);
        if (IN(10 + 3 * ch)) {
            const int nblk = moe_blocks(F, ch, blk_e);
            ProbMoE<false> P{(const char*)(ws + WS_ACT), 8, 1024u, 1024u, (const char*)(ws + WS_WDNT), (size_t)1024 * 1024, 4, nblk, F.G, F.c, nullptr, blk_e};
            EpiDN E{F.in[I_BDN], (unsigned char*)(ws + WS_YCH)};
            for (int r = 0; r < (ch == 0 ? REPS(11) : 1); ++r) { pg8::gemm_phase<ProbMoE<false>, EpiDN, true, false, true>(F.lds, P, E); if (ch == 0) REPBAR(11, r); }
        }
        STAMP(13);
        SEAM(10 + 3 * ch);
        if (IN(11 + 3 * ch)) { for (int r = 0; r < (ch == 0 ? REPS(12) : 1); ++r) { p13_combine_ln2(F, ch, ch == 0 && r + 1 < REPS(12)); if (ch == 0) REPBAR(12, r); } }
        STAMP(14);
        SEAM(11 + 3 * ch);
    }
#ifdef DBG_K
    xcd_barrier(bar);
    {
        const unsigned char* buf = (DBG_OUT) ? (const unsigned char*)F.out : (const unsigned char*)(ws + (size_t)(DBG_OFF));
        const size_t wpr = (size_t)(DBG_CW) / 4, nw = (size_t)(DBG_ROWS) * wpr;
        unsigned long long cs = 0; unsigned bad = 0;
        for (size_t i = (size_t)F.c * NTHR + F.tid; i < nw; i += (size_t)F.G * NTHR) { const size_t r = i / wpr, cw = i % wpr; const unsigned w = *(const unsigned*)(buf + r * (size_t)(DBG_LD) + (DBG_C0) + cw * 4); cs += w;
            if (DBG_F32) { if ((w & 0x7f800000u) == 0x7f800000u) ++bad; } else { if ((w & 0x7f80u) == 0x7f80u) ++bad; if ((w & 0x7f800000u) == 0x7f800000u) ++bad; } }
        for (int o = 32; o >= 1; o >>= 1) { cs += __shfl_xor(cs, o); bad += __shfl_xor(bad, o); }
        if (F.lane == 0) { atomicAdd((unsigned long long*)(F.ctl + 8192), cs); atomicAdd(F.ctl + 8200, bad); }
        if (F.c == 0 && F.tid == 0) atomicAdd(F.ctl + 8201, xb_ld(&F.ctl[XB_TMO]));
    }
    xcd_barrier(bar);
    {
        const unsigned long long cs = __hip_atomic_load((unsigned long long*)(F.ctl + 8192), __ATOMIC_RELAXED, __HIP_MEMORY_SCOPE_AGENT);
        const unsigned bad = xb_ld(F.ctl + 8200), tmo = xb_ld(F.ctl + 8201);
        const float val = (float)(unsigned)((cs ^ (cs >> 16) ^ (cs >> 32)) & 0xFFFFu) * (1.0f / 65536.0f) + (bad ? 2.0f : 0.0f) + (tmo ? 4.0f : 0.0f);
        for (size_t i = (size_t)F.c * NTHR + F.tid; i < (size_t)T * D; i += (size_t)F.G * NTHR) F.out[i] = val;
    }
    return;
#endif
#ifdef PR_A
    xcd_barrier(bar);
    {
        auto maxs = [&](int sl) { unsigned long long m = 0; for (int w = 0; w < (int)F.G; ++w) { const unsigned long long v = stamps[sl * 256 + w]; m = v > m ? v : m; } return m; };
        auto dur = [&](int sl) -> float {
            if (sl == 4) { const unsigned long long st = maxs(3); double a = 0; for (int w = 0; w < (int)F.G; ++w) a += (double)(stamps[4 * 256 + w] - st); return (float)(a / F.G) * 0.01f; }
            if (sl == 5) { double a = 0; for (int w = 0; w < (int)F.G; ++w) a += (double)(stamps[5 * 256 + w] - stamps[4 * 256 + w]); return (float)(a / F.G) * 0.01f; }
            if (sl == 6) { double a = 0; for (int w = 0; w < (int)F.G; ++w) a += (double)(stamps[6 * 256 + w] - stamps[5 * 256 + w]); return (float)(a / F.G) * 0.01f; }
            if (sl == 16) return (float)(maxs(6) - maxs(3)) * 0.01f;
            return (float)(maxs(sl) - maxs(sl - 1)) * 0.01f; };
        const float va = rintf(dur(PR_A) * 0.1f + (PR_OFF)) * 0.1f, vb = rintf(dur(PR_B) * 0.1f + (PR_OFF)) * 10.0f;
        for (size_t i = (size_t)F.c * NTHR + F.tid; i < (size_t)T * D; i += (size_t)F.G * NTHR) F.out[i] = va;
        __syncthreads();
        if (F.c == 0 && F.tid == 0) F.out[12345] = vb;
    }
    return;
#endif
    if (F.c == 0 && F.tid == 0 && hi == N_PHASES) { if (xb_ld(&F.ctl[XB_TMO]) != 0u) F.out[0] = __builtin_nanf(""); }
#undef IN
#undef SEAM
}

extern "C" void kernel_launch(void* const* d_in, const int* in_sizes, int n_in, void* d_out, int out_size, void* d_ws, size_t ws_size, hipStream_t stream) {
    static int grid = 0;
    if (grid == 0) {
        if (n_in != 22 || out_size != T * D || ws_size < WS_END) { fprintf(stderr, "kernel_launch: unexpected shapes (n_in %d, out %d, ws %zu)\n", n_in, out_size, ws_size); grid = -1; return; }
        int dev = 0, cus = 0, per_cu = 0;
        if (hipGetDevice(&dev) != hipSuccess || hipDeviceGetAttribute(&cus, hipDeviceAttributeMultiprocessorCount, dev) != hipSuccess) { grid = -1; return; }
        if (hipFuncSetAttribute((const void*)mega_fwd, hipFuncAttributeMaxDynamicSharedMemorySize, LDS_BYTES) != hipSuccess) { fprintf(stderr, "kernel_launch: hipFuncSetAttribute failed\n"); grid = -1; return; }
        if (hipOccupancyMaxActiveBlocksPerMultiprocessor(&per_cu, (const void*)mega_fwd, NTHR, LDS_BYTES) != hipSuccess || per_cu < 1) fprintf(stderr, "kernel_launch: occupancy query reports %d blocks per CU\n", per_cu);
        (void)hipGetLastError();
        grid = cus;
    }
    if (grid < 0) return;
    (void)hipMemsetAsync((char*)d_ws + WS_CTL, 0, CTL_BYTES, stream);
    Args a{};
    for (int i = 0; i < 22; ++i) a.in[i] = (const float*)d_in[i];
    a.out = (float*)d_out; a.ws = (unsigned char*)d_ws; a.ph_lo = 0; a.ph_hi = N_PHASES;
#ifdef DBG_K
    a.ph_hi = DBG_K;
#endif
    hipLaunchKernelGGL(mega_fwd, dim3(grid), dim3(NTHR), LDS_BYTES, stream, a);
}
```

```cpp
#include <hip/hip_runtime.h>
#include <cstdio>
#include <cstdint>

#define LAS __attribute__((address_space(3)))
typedef unsigned short bf16_t;
typedef short bf16x8 __attribute__((ext_vector_type(8)));
typedef short bf16x4 __attribute__((ext_vector_type(4)));
typedef float f32x4 __attribute__((ext_vector_type(4)));
typedef float f32x2 __attribute__((ext_vector_type(2)));
typedef unsigned u32x4 __attribute__((ext_vector_type(4)));
typedef unsigned u32x2 __attribute__((ext_vector_type(2)));

constexpr int D = 1024, NB = 32, SEQ = 2048, T = NB * SEQ, CTX = 256, TCX = NB * CTX;
#ifndef NCH_SET
#define NCH_SET 1
#endif
constexpr int NEXP = 32, TOPK = 4;
constexpr int NCH = NCH_SET, TCH = T / NCH;
constexpr int ROWS_CH = TCH * TOPK + NEXP * 256;
constexpr float DN_ALPHA = 1.189207115002721f;
constexpr float LN_EPS = 1e-5f, RMS_EPS = 1e-6f;
constexpr int NTHR = 512;

constexpr size_t MiB = 1ull << 20;
constexpr size_t WS_CTL = 0;
constexpr size_t CTL_BYTES = 65536;
constexpr size_t WS_ADA = 65536;
constexpr size_t WS_WIN1T = 1 * MiB;
constexpr size_t WS_WIN2T = 7 * MiB;
constexpr size_t WS_WMT = 12 * MiB;
constexpr size_t WS_WOT = 14 * MiB;
constexpr size_t WS_WGUT = 16 * MiB;
constexpr size_t WS_WDNT = 80 * MiB;
constexpr size_t WS_TOPI = 112 * MiB;
constexpr size_t WS_TOPW = 113 * MiB;
constexpr size_t WS_POS = 114 * MiB;
constexpr size_t WS_ROWTOK = 115 * MiB;
constexpr size_t WS_U = 120 * MiB;
constexpr size_t WS_PA = 184 * MiB;
constexpr size_t WS_PH = 312 * MiB;
constexpr size_t WS_PHC = 568 * MiB;
constexpr size_t WS_PG = 600 * MiB;
constexpr size_t WS_Y = 664 * MiB;
constexpr size_t WS_UC = WS_Y;
constexpr size_t WS_ACT = WS_PA;
constexpr size_t WS_YCH = WS_PA + 264 * MiB;
constexpr size_t WS_X1 = WS_YCH + 264 * MiB;
constexpr size_t WS_END = 976 * MiB;
static_assert(WS_X1 + 128 * MiB <= WS_END && (size_t)ROWS_CH * 1024 <= 264 * MiB && WS_Y + 128 * MiB <= WS_END, "ws map");
constexpr int CW_CNT = 4096;
constexpr int CW_CUR = 4096 + 64;

constexpr int LDS_SCRATCH = 155648;
constexpr int LDS_MISC = LDS_SCRATCH;
constexpr int LDS_BYTES = LDS_SCRATCH + 2048;

typedef __bf16 bf16x2_t __attribute__((ext_vector_type(2)));
__device__ __forceinline__ unsigned cvt_pk_bf16(float lo, float hi) { const f32x2 v = {lo, hi}; const bf16x2_t r = __builtin_convertvector(v, bf16x2_t); return __builtin_bit_cast(unsigned, r); }
__device__ __forceinline__ unsigned cvt_pk4_fp8(float a, float b, float c, float d) {
    a = fminf(fmaxf(a, -448.f), 448.f); b = fminf(fmaxf(b, -448.f), 448.f); c = fminf(fmaxf(c, -448.f), 448.f); d = fminf(fmaxf(d, -448.f), 448.f);
    int w = __builtin_amdgcn_cvt_pk_fp8_f32(a, b, 0, false); w = __builtin_amdgcn_cvt_pk_fp8_f32(c, d, w, true); return (unsigned)w; }
constexpr float W8_SCALE = 32.0f, W8_INV = 1.0f / 32.0f;
typedef float f32x2v __attribute__((ext_vector_type(2)));
__device__ __forceinline__ f32x4 fp8x4_to_f32(unsigned w) { const f32x2v a = __builtin_amdgcn_cvt_pk_f32_fp8((int)w, false), b = __builtin_amdgcn_cvt_pk_f32_fp8((int)w, true); return (f32x4){a[0], a[1], b[0], b[1]}; }
__device__ __forceinline__ u32x4 widen16(u32x2 a, u32x2 b) {
    const u32x2 rx = __builtin_amdgcn_permlane16_swap(a.x, b.x, false, false), ry = __builtin_amdgcn_permlane16_swap(a.y, b.y, false, false);
    return (u32x4){rx[0], ry[0], rx[1], ry[1]}; }
__device__ __forceinline__ void unwiden16(u32x4 L, u32x2& a, u32x2& b) {
    const u32x2 rx = __builtin_amdgcn_permlane16_swap(L.x, L.z, false, false), ry = __builtin_amdgcn_permlane16_swap(L.y, L.w, false, false);
    a = (u32x2){rx[0], ry[0]}; b = (u32x2){rx[1], ry[1]}; }
__device__ __forceinline__ unsigned pack4_u8(float a, float b, float c, float d) {
    unsigned w = __builtin_amdgcn_cvt_pk_u8_f32(__builtin_rintf(a), 0, 0u); w = __builtin_amdgcn_cvt_pk_u8_f32(__builtin_rintf(b), 1, w);
    w = __builtin_amdgcn_cvt_pk_u8_f32(__builtin_rintf(c), 2, w); return __builtin_amdgcn_cvt_pk_u8_f32(__builtin_rintf(d), 3, w); }
__device__ __forceinline__ f32x4 u8x4_to_f32(unsigned w) { return (f32x4){(float)(w & 0xffu), (float)((w >> 8) & 0xffu), (float)((w >> 16) & 0xffu), (float)(w >> 24)}; }
__device__ __forceinline__ float bf_lo(unsigned w) { return __uint_as_float(w << 16); }
__device__ __forceinline__ float bf_hi(unsigned w) { return __uint_as_float(w & 0xffff0000u); }
__device__ __forceinline__ float bf2f(bf16_t v) { return __uint_as_float(((unsigned)v) << 16); }
__device__ __forceinline__ float fast_exp(float x) { return __builtin_amdgcn_exp2f(x * 1.4426950408889634f); }
__device__ __forceinline__ float fast_sigmoid(float x) { return __builtin_amdgcn_rcpf(1.0f + fast_exp(-x)); }
__device__ __forceinline__ float fast_log(float x) { return __builtin_amdgcn_logf(x) * 0.6931471805599453f; }

#define XB_TMO      128
#define XB_XCNT(j)  (256  + 64 * (j))
#define XB_XSUB(j)  (1280 + 64 * (j))
#define XB_XGEN(j)  (2304 + 64 * (j))
#define XB_TOP      3328
#define XB_TOPGEN   3392
#define XCD_BAR_WORDS 3456
#define XB_SPIN_CAP (1u << 18)

__device__ __forceinline__ unsigned xb_ld(unsigned* p)              { return __hip_atomic_load(p, __ATOMIC_RELAXED, __HIP_MEMORY_SCOPE_AGENT); }
__device__ __forceinline__ unsigned xb_add(unsigned* p, unsigned v) { return __hip_atomic_fetch_add(p, v, __ATOMIC_RELAXED, __HIP_MEMORY_SCOPE_AGENT); }
__device__ __forceinline__ unsigned xb_xcc_id() { return (unsigned)__builtin_amdgcn_s_getreg((3 << 11) | 20) & 0xFu; }
#define XB_SPIN(cond, bar) do { unsigned _sp = 0; while (cond) { __builtin_amdgcn_s_sleep(1); \
    if ((++_sp & 255u) == 0u) { if (xb_ld(&(bar)[XB_TMO])) break; if (_sp > XB_SPIN_CAP) { atomicAdd(&(bar)[XB_TMO], 1u); break; } } } } while (0)

struct XcdBarrier { unsigned* bar; unsigned x; volatile LAS unsigned* st; };

__device__ __forceinline__ XcdBarrier xcd_barrier_post(unsigned* bar, volatile LAS unsigned* st) {
    XcdBarrier b; b.bar = bar; b.x = xb_xcc_id(); b.st = st;
    if (threadIdx.x == 0) (void)xb_add(&bar[XB_XCNT(b.x)], 1u);
    return b;
}
__device__ __forceinline__ void xcd_barrier_complete(unsigned* bar, unsigned x, unsigned& nloc, unsigned& nx) {
    const unsigned G = gridDim.x * gridDim.y * gridDim.z;
    unsigned sum, cnt, mine, sp = 0u;
    for (;;) {
        sum = 0u; cnt = 0u; mine = 0u;
#pragma unroll
        for (unsigned j = 0; j < 16; ++j) { const unsigned c = xb_ld(&bar[XB_XCNT(j)]); sum += c; cnt += (c > 0u) ? 1u : 0u; mine = (j == x) ? c : mine; }
        if (sum == G) break;
        __builtin_amdgcn_s_sleep(1);
        if ((++sp & 255u) == 0u) { if (xb_ld(&bar[XB_TMO])) break; if (sp > XB_SPIN_CAP) { atomicAdd(&bar[XB_TMO], 1u); break; } }
    }
    nloc = mine > 0u ? mine : 1u; nx = cnt > 0u ? cnt : 1u;
}
__device__ __forceinline__ void xcd_barrier(const XcdBarrier& b) {
    asm volatile("s_waitcnt vmcnt(0)" ::: "memory");
    __syncthreads();
    if (threadIdx.x == 0) {
        unsigned* bar = b.bar;
        __builtin_amdgcn_s_waitcnt(0);
        unsigned nloc = b.st[0], nx = b.st[1];
        if (nloc == 0u) { xcd_barrier_complete(bar, b.x, nloc, nx); b.st[0] = nloc; b.st[1] = nx; }
        const unsigned old = xb_add(&bar[XB_XSUB(b.x)], 1u);
        const unsigned gen = old / nloc;
        if (old + 1u == (gen + 1u) * nloc) {
            __builtin_amdgcn_fence(__ATOMIC_RELEASE, "agent");
            asm volatile("s_waitcnt vmcnt(0)" ::: "memory");
            const unsigned og = xb_add(&bar[XB_TOP], 1u);
            const unsigned tg = og / nx;
            if (og + 1u == (tg + 1u) * nx) xb_add(&bar[XB_TOPGEN], 1u);
            else XB_SPIN(xb_ld(&bar[XB_TOPGEN]) == tg, bar);
            __builtin_amdgcn_fence(__ATOMIC_ACQUIRE, "agent");
            xb_add(&bar[XB_XGEN(b.x)], 1u);
            asm volatile("s_waitcnt vmcnt(0)" ::: "memory");
        } else {
            XB_SPIN(xb_ld(&bar[XB_XGEN(b.x)]) == gen, bar);
            __builtin_amdgcn_fence(__ATOMIC_ACQUIRE, "agent");
            asm volatile("s_waitcnt vmcnt(0)" ::: "memory");
        }
    }
    __syncthreads();
}

#ifndef WGM_SET
#define WGM_SET 8
#endif
namespace pg8 {
constexpr int BM = 256, BK = 64, HALF = 128, HTB = HALF * BK * 2, STAGE_BYTES = 8 * HTB, NXCD = 8, WGM = WGM_SET;
__host__ __device__ __forceinline__ int lds_byte(int r, int c) { const int st = (r >> 4) * 2 + (c >> 5), rr = r & 15, cc = c & 31, ob = rr * 64 + cc * 2; return st * 1024 + (ob ^ (((ob >> 9) & 1) << 5)); }
__host__ __device__ __forceinline__ void stage_rc(int b, int& R, int& C) { const int st = b / 1024, sb = b % 1024, swz = sb ^ (((sb >> 9) & 1) << 5); R = (st >> 1) * 16 + swz / 64; C = (st & 1) * 32 + (swz % 64) / 2; }
__host__ __device__ __forceinline__ int perm32(int rho) { const int n = rho >> 4, i = rho & 15; return 8 * (i >> 2) + 4 * n + (i & 3); }

struct Unit { int pm, pn, aux; };

__device__ __forceinline__ void grouped(int wgid, int nM, int nN, int& pm, int& pn) {
    const int nig = WGM * nN, gid = wgid / nig, fm = gid * WGM, gsz = (nM - fm) < WGM ? (nM - fm) : WGM;
    pm = fm + ((wgid % nig) % gsz); pn = (wgid % nig) / gsz;
}
__device__ __forceinline__ bool xcd_remap(int i, int G, int c, int nwg, int& wgid) {
    const long L = (long)i * G + c; if (L >= nwg) return false;
    wgid = (int)L; const int q = nwg / NXCD, r = nwg % NXCD, xcd = wgid % NXCD, off = wgid / NXCD;
    wgid = (xcd < r ? xcd * (q + 1) : r * (q + 1) + (xcd - r) * q) + off; return true;
}

typedef int i32x8 __attribute__((ext_vector_type(8)));
typedef int i32x4 __attribute__((ext_vector_type(4)));
template <bool F8> struct Frags;
template <> struct Frags<false> { bf16x8 a[4][2], b0[2][2], b1[2][2]; };
template <> struct Frags<true> { i32x8 a[4], b0[2], b1[2]; };
template <class Prob, class Epi, bool ALIGN_EPI, bool HOOK, bool FP8 = false, int DRY = 0>
__device__ __forceinline__ void gemm_phase(LAS unsigned char* lds, const Prob& P, const Epi& E) {
    int tid_ = threadIdx.x; asm volatile("" : "+v"(tid_));
    const int tid = tid_, wid = __builtin_amdgcn_readfirstlane(tid >> 6), lane = tid & 63, wr = wid >> 2, wc = wid & 3, fr = lane & 15, fq = lane >> 4;
    const int nt = P.nt;
    unsigned voffB[2], voffA[2];
#pragma unroll
    for (int i = 0; i < 2; ++i) { int R, C; stage_rc(tid * 16 + i * 8192, R, C); const int Rb = Epi::PERM ? ((R & ~31) + perm32(R & 31)) : R;
        voffB[i] = (unsigned)Rb * P.ldb2 + (unsigned)C * 2u; voffA[i] = (unsigned)R * P.lda2 + (unsigned)C * 2u; }
    auto gather_offs = [&](const Unit& u, unsigned (&o0)[2], unsigned (&o1)[2]) {
#pragma unroll
        for (int i = 0; i < 2; ++i) { int R, C; int tt = threadIdx.x; asm volatile("" : "+v"(tt)); stage_rc(tt * 16 + i * 8192, R, C); o0[i] = P.a_row(u, R) + (unsigned)C * 2u; o1[i] = P.a_row(u, HALF + R) + (unsigned)C * 2u; } };
    const size_t kstep = (size_t)(BK * 2);
    const size_t hstepB = (size_t)HALF * P.ldb2;
    const size_t hstepA = (size_t)HALF * P.lda2;
    const unsigned ldsw = (unsigned)wid * 1024u;
    const int aoff = lds_byte(wr * 64 + fr, fq * 8), boff = lds_byte(wc * 32 + fr, fq * 8);
#define PG8_SA(b, h) (((b) * 2 + (h)) * HTB)
#define PG8_SB(b, h) ((4 + (b) * 2 + (h)) * HTB)
#define PG8_STAGE(bufoff, gbase, voff) do { if constexpr ((DRY & 2) == 0) _Pragma("unroll") for (int _i = 0; _i < 2; ++_i) \
        __builtin_amdgcn_global_load_lds((const unsigned*)((const char*)(gbase) + (voff)[_i]), (LAS unsigned*)(lds + (bufoff) + ldsw + _i * 8192), 16, 0, 0); } while (0)
#define PG8_LDA(dst, b, h) do { if constexpr (FP8) { _Pragma("unroll") for (int m = 0; m < 4; ++m) { FR.a[m].lo = *(const LAS i32x4*)(lds + PG8_SA(b, h) + aoff + m * 2048); FR.a[m].hi = *(const LAS i32x4*)(lds + PG8_SA(b, h) + aoff + m * 2048 + 1024); } } \
        else { _Pragma("unroll") for (int m = 0; m < 4; ++m) _Pragma("unroll") for (int k = 0; k < 2; ++k) FR.a[m][k] = *(const LAS bf16x8*)(lds + PG8_SA(b, h) + aoff + m * 2048 + k * 1024); } } while (0)
#define PG8_LDB(dst, b, h) do { if constexpr (FP8) { _Pragma("unroll") for (int n = 0; n < 2; ++n) { FR.dst[n].lo = *(const LAS i32x4*)(lds + PG8_SB(b, h) + boff + n * 2048); FR.dst[n].hi = *(const LAS i32x4*)(lds + PG8_SB(b, h) + boff + n * 2048 + 1024); } } \
        else { _Pragma("unroll") for (int n = 0; n < 2; ++n) _Pragma("unroll") for (int k = 0; k < 2; ++k) FR.dst[n][k] = *(const LAS bf16x8*)(lds + PG8_SB(b, h) + boff + n * 2048 + k * 1024); } } while (0)
#define PG8_MMA(ai, bj, At, Bt) do { __builtin_amdgcn_s_setprio(1); if constexpr ((DRY & 1) != 0) { asm volatile("" :: "v"(FR.a[0]), "v"(FR.a[3]), "v"(FR.Bt[0]), "v"(FR.Bt[1])); } else if constexpr (FP8) { _Pragma("unroll") for (int m = 0; m < 4; ++m) _Pragma("unroll") for (int n = 0; n < 2; ++n) \
            asm volatile("v_mfma_f32_16x16x128_f8f6f4 %0, %1, %2, %0" : "+v"(acc[ai][bj][m][n]) : "v"(FR.Bt[n]), "v"(FR.a[m])); } \
        else { _Pragma("unroll") for (int m = 0; m < 4; ++m) _Pragma("unroll") for (int n = 0; n < 2; ++n) _Pragma("unroll") for (int k = 0; k < 2; ++k) \
        acc[ai][bj][m][n] = __builtin_amdgcn_mfma_f32_16x16x32_bf16(FR.Bt[n][k], FR.a[m][k], acc[ai][bj][m][n], 0, 0, 0); } __builtin_amdgcn_s_setprio(0); } while (0)
#define PG8_WAIT_V(n) asm volatile("s_waitcnt vmcnt(" #n ")" ::: "memory")
#define PG8_WAIT_L(n) asm volatile("s_waitcnt lgkmcnt(" #n ")" ::: "memory")
#define PG8_BAR __builtin_amdgcn_s_barrier()
#define PG8_SCHED __builtin_amdgcn_sched_barrier(0)
    Unit cur, nxt; int ui = 0;
    if (!P.unit(0, cur)) return;
    f32x4 acc[2][2][4][2];
#pragma unroll
    for (int a = 0; a < 2; ++a)
#pragma unroll
        for (int b = 0; b < 2; ++b)
#pragma unroll
            for (int m = 0; m < 4; ++m)
#pragma unroll
                for (int n = 0; n < 2; ++n) acc[a][b][m][n] = (f32x4){0.f, 0.f, 0.f, 0.f};
    Frags<FP8> FR;
    unsigned va0[2], va1[2], vn0[2], vn1[2];
    const char* const gA = P.Abase; const char* cA = gA; const char* nA = gA; const char* cB = P.b_tile(cur);
    if constexpr (Prob::GATHER) {
        gather_offs(cur, va0, va1);
    } else { cA = gA + P.a_row(cur, 0); }
#define PG8_STAGE_A(bufoff, h, koff, nx) do { if constexpr (Prob::GATHER) { unsigned _v[2]; _Pragma("unroll") for (int _i = 0; _i < 2; ++_i) _v[_i] = (nx) ? ((h) ? vn1[_i] : vn0[_i]) : ((h) ? va1[_i] : va0[_i]); PG8_STAGE(bufoff, gA + (koff), _v); } \
        else { PG8_STAGE(bufoff, ((nx) ? nA : cA) + (h) * hstepA + (koff), voffA); } } while (0)
    PG8_STAGE(PG8_SB(0, 0), cB, voffB); PG8_STAGE(PG8_SB(0, 1), cB + hstepB, voffB); PG8_STAGE_A(PG8_SA(0, 0), 0, 0, false); PG8_STAGE_A(PG8_SA(0, 1), 1, 0, false);
    if (wr == 1) PG8_BAR;
    PG8_WAIT_V(2); PG8_BAR;
    PG8_STAGE(PG8_SB(1, 0), cB + kstep, voffB); PG8_STAGE_A(PG8_SA(1, 0), 0, kstep, false); PG8_STAGE(PG8_SB(1, 1), cB + hstepB + kstep, voffB);
    PG8_WAIT_V(6); PG8_BAR;
    Unit nx2; unsigned vq0[2], vq1[2]; bool has_next = P.unit(1, nxt);
    if (!has_next) nxt = cur;
    if constexpr (Prob::GATHER) gather_offs(nxt, vn0, vn1);
    for (;;) {
        if constexpr (!Prob::GATHER) { has_next = P.unit(ui + 1, nxt); if (!has_next) nxt = cur; nA = gA + P.a_row(nxt, 0); }
        const char* nB = P.b_tile(nxt);
        for (int t = 0; t < nt; t += 2) {
            const bool last = (t == nt - 2);
            if constexpr (HOOK) { if (t == (nt >> 1)) { if constexpr (FP8) asm volatile("s_nop 15\n\ts_nop 15" ::: "memory"); E.mid(acc, cur, wr, wc, fr, fq); } }
            const size_t k1 = (size_t)(t + 1) * kstep, k2 = last ? 0 : (size_t)(t + 2) * kstep, k3 = k2 + kstep;
            const char* b2 = last ? nB : cB + (size_t)(t + 2) * kstep; const char* b3 = b2 + kstep;
            PG8_LDB(b0, 0, 0); PG8_LDB(b1, 0, 1); PG8_SCHED; PG8_LDA(At, 0, 0); PG8_STAGE_A(PG8_SA(1, 1), 1, k1, false);
            PG8_WAIT_V(8); PG8_WAIT_L(0); PG8_BAR; PG8_MMA(0, 0, At, b0); PG8_MMA(0, 1, At, b1); PG8_BAR; PG8_SCHED;
            PG8_LDA(At, 0, 1); PG8_STAGE(PG8_SB(0, 0), b2, voffB); PG8_STAGE(PG8_SB(0, 1), b2 + hstepB, voffB); PG8_STAGE_A(PG8_SA(0, 0), 0, k2, last);
            PG8_WAIT_V(8); PG8_WAIT_L(0); PG8_BAR; PG8_MMA(1, 0, At, b0); PG8_MMA(1, 1, At, b1); PG8_BAR; PG8_SCHED;
            PG8_LDB(b0, 1, 0); PG8_LDB(b1, 1, 1); PG8_SCHED; PG8_LDA(At, 1, 0); PG8_STAGE_A(PG8_SA(0, 1), 1, k2, last);
            PG8_WAIT_V(8); PG8_WAIT_L(0); PG8_BAR; PG8_MMA(0, 0, At, b0); PG8_MMA(0, 1, At, b1); PG8_BAR; PG8_SCHED;
            PG8_LDA(At, 1, 1); PG8_STAGE(PG8_SB(1, 0), b3, voffB); PG8_STAGE(PG8_SB(1, 1), b3 + hstepB, voffB); PG8_STAGE_A(PG8_SA(1, 0), 0, k3, last);
            PG8_WAIT_V(8); PG8_WAIT_L(0); PG8_BAR; PG8_MMA(1, 0, At, b0); PG8_MMA(1, 1, At, b1); PG8_BAR; PG8_SCHED;
        }
        if constexpr (ALIGN_EPI) { if (wr == 0) PG8_BAR; }
        bool has_next2 = false;
        if constexpr (Prob::GATHER) { has_next2 = has_next && P.unit(ui + 2, nx2); if (!has_next2) nx2 = nxt; gather_offs(nx2, vq0, vq1); }
        if constexpr (FP8) asm volatile("s_nop 15\n\ts_nop 15" ::: "memory");
        if constexpr (DRY == 0) E(acc, cur, wr, wc, fr, fq); else { if (acc[0][0][0][0][0] == 1.2345e30f) *(volatile int*)P.Abase = 1; }
        if (!has_next) break;
#pragma unroll
        for (int a = 0; a < 2; ++a)
#pragma unroll
            for (int b = 0; b < 2; ++b)
#pragma unroll
                for (int m = 0; m < 4; ++m)
#pragma unroll
                    for (int n = 0; n < 2; ++n) acc[a][b][m][n] = (f32x4){0.f, 0.f, 0.f, 0.f};
        cur = nxt; cB = nB; cA = nA; ++ui;
        if constexpr (Prob::GATHER) {
#pragma unroll
            for (int i = 0; i < 2; ++i) { va0[i] = vn0[i]; va1[i] = vn1[i]; vn0[i] = vq0[i]; vn1[i] = vq1[i]; }
            nxt = nx2; has_next = has_next2; }
        if constexpr (ALIGN_EPI) { if (wr == 1) PG8_BAR; }
    }
    PG8_WAIT_V(0);
    if constexpr (!ALIGN_EPI) { if (wr == 0) PG8_BAR; }
    PG8_BAR;
#undef PG8_SA
#undef PG8_SB
#undef PG8_STAGE
#undef PG8_STAGE_A
#undef PG8_LDA
#undef PG8_LDB
#undef PG8_MMA
#undef PG8_WAIT_V
#undef PG8_WAIT_L
#undef PG8_BAR
#undef PG8_SCHED
}
}

using pg8::Unit;

struct ProbDense {
    static constexpr bool GATHER = false;
    const char* Abase; int nt; unsigned ldb2; unsigned lda2; const char* Bt; int nM, nN, G, c; int rev;
    __device__ __forceinline__ bool unit(int i, Unit& u) const { int w; if (!pg8::xcd_remap(i, G, c, nM * nN, w)) return false; pg8::grouped(w, nM, nN, u.pm, u.pn); if (rev) u.pm = nM - 1 - u.pm; u.aux = 0; return true; }
    __device__ __forceinline__ unsigned a_row(const Unit& u, int r) const { return (unsigned)(u.pm * 256 + r) * lda2; }
    __device__ __forceinline__ const char* b_tile(const Unit& u) const { return Bt + (size_t)u.pn * 256 * ldb2; }
};
struct ProbP1 {
    static constexpr bool GATHER = false;
    const char* Abase; int nt; unsigned ldb2; unsigned lda2; const char* Bt; unsigned uc_off; int G, c;
    __device__ __forceinline__ bool unit(int i, Unit& u) const {
        int w; if (!pg8::xcd_remap(i, G, c, 3072 + 256, w)) return false;
        if (w < 3072) { pg8::grouped(w, 256, 12, u.pm, u.pn); u.pm = 255 - u.pm; u.aux = 0; }
        else { pg8::grouped(w - 3072, 32, 8, u.pm, u.pn); u.pn += 4; u.aux = 1; }
        return true; }
    __device__ __forceinline__ unsigned a_row(const Unit& u, int r) const { return (u.aux ? uc_off : 0u) + (unsigned)(u.pm * 256 + r) * lda2; }
    __device__ __forceinline__ const char* b_tile(const Unit& u) const { return Bt + (size_t)u.pn * 256 * ldb2; }
};
template <bool GATHER_> struct ProbMoE {
    static constexpr bool GATHER = GATHER_;
    const char* Abase; int nt; unsigned ldb2; unsigned lda2; const char* Bt; size_t estride; int nN, nblk, G, c; const int* rowtok; const LAS unsigned char* blk_e;
    __device__ __forceinline__ bool unit(int i, Unit& u) const { int w; if (!pg8::xcd_remap(i, G, c, nblk * nN, w)) return false; pg8::grouped(w, nblk, nN, u.pm, u.pn); if (!GATHER) u.pm = nblk - 1 - u.pm;
        u.aux = (int)blk_e[u.pm]; return true; }
    __device__ __forceinline__ unsigned a_row(const Unit& u, int r) const { if (GATHER) return (unsigned)rowtok[u.pm * 256 + r] * lda2; else return (unsigned)(u.pm * 256 + r) * lda2; }
    __device__ __forceinline__ const char* b_tile(const Unit& u) const { return Bt + (size_t)u.aux * estride + (size_t)u.pn * 256 * ldb2; }
};

struct EpiP1 {
    static constexpr bool PERM = true;
    bf16_t* PA; bf16_t* PH; bf16_t* PHC;
    __device__ __forceinline__ void operator()(const f32x4 (&acc)[2][2][4][2], const Unit& u, int wr, int wc, int fr, int fq) const {
        const int row0 = u.pm * 256 + wr * 64 + fr;
        if (!u.aux && u.pn < 4) {
            unsigned char* PA8 = (unsigned char*)PA;
#pragma unroll
            for (int ai = 0; ai < 2; ++ai)
#pragma unroll
                for (int bj = 0; bj < 2; ++bj) { u32x2 pk[4];
#pragma unroll
                    for (int m = 0; m < 4; ++m) { const f32x4 v0 = acc[ai][bj][m][0] * W8_INV, v1 = acc[ai][bj][m][1] * W8_INV;
                        pk[m] = (u32x2){cvt_pk4_fp8(v0[0], v0[1], v0[2], v0[3]), cvt_pk4_fp8(v1[0], v1[1], v1[2], v1[3])}; }
                    const int col = u.pn * 256 + bj * 128 + wc * 32 + (fq >> 1) * 16, reim = col >> 9, slab = (col & 511) >> 4;
#pragma unroll
                    for (int mp = 0; mp < 2; ++mp) { const int row = row0 + ai * 128 + (2 * mp + (fq & 1)) * 16, b = row >> 11, t = row & 2047;
                        *(u32x4*)(PA8 + ((((size_t)(b * 32 + slab) * 2048 + t) * 2 + reim) * 16)) = widen16(pk[2 * mp], pk[2 * mp + 1]); } }
            return;
        }
        bf16_t* base = u.aux ? PHC : PH; const int ldc = 2048, colt = (u.pn - 4) * 256;
        {
            const int kind = u.pn < 6 ? 0 : (u.pn < 8 ? 1 : (u.pn < 10 ? 2 : 3));
            const int reg = kind == 0 ? (u.pn - 4) * 256 : kind == 1 ? 512 + (u.pn - 6) * 256 : kind == 2 ? 3584 + (u.pn - 8) * 256 : 3072 + (u.pn - 10) * 256;
            unsigned char* b8 = (unsigned char*)base + reg + wc * 32 + (fq >> 1) * 16;
#pragma unroll
            for (int ai = 0; ai < 2; ++ai)
#pragma unroll
                for (int bj = 0; bj < 2; ++bj) { u32x2 pk[4];
#pragma unroll
                    for (int m = 0; m < 4; ++m) { f32x4 v0 = acc[ai][bj][m][0] * W8_INV, v1 = acc[ai][bj][m][1] * W8_INV;
                        if (kind == 0) {
#pragma unroll
                            for (int j = 0; j < 4; ++j) { v0[j] *= fast_sigmoid(v0[j]); v1[j] *= fast_sigmoid(v1[j]); } }
                        if (kind == 1 || kind == 2) {
#pragma unroll
                            for (int j = 0; j < 4; ++j) { v0[j] = fast_sigmoid(v0[j]) * 255.0f; v1[j] = fast_sigmoid(v1[j]) * 255.0f; }
                            pk[m] = (u32x2){pack4_u8(v0[0], v0[1], v0[2], v0[3]), pack4_u8(v1[0], v1[1], v1[2], v1[3])};
                        } else pk[m] = (u32x2){cvt_pk4_fp8(v0[0], v0[1], v0[2], v0[3]), cvt_pk4_fp8(v1[0], v1[1], v1[2], v1[3])}; }
#pragma unroll
                    for (int mp = 0; mp < 2; ++mp)
                        *(u32x4*)(b8 + (size_t)(row0 + ai * 128 + (2 * mp + (fq & 1)) * 16) * 4096 + bj * 128) = widen16(pk[2 * mp], pk[2 * mp + 1]); }
        }
    }
    __device__ __forceinline__ void mid(f32x4 (&)[2][2][4][2], const Unit&, int, int, int, int) const {}
};
struct EpiP2 {
    static constexpr bool PERM = true;
    unsigned char* PG; unsigned char* GATES;
    __device__ __forceinline__ void operator()(const f32x4 (&acc)[2][2][4][2], const Unit& u, int wr, int wc, int fr, int fq) const {
        const int row0 = u.pm * 256 + wr * 64 + fr;
        if (u.pn < 2) {
            const int colp = u.pn * 256 + wc * 32 + (fq >> 1) * 16;
#pragma unroll
            for (int ai = 0; ai < 2; ++ai)
#pragma unroll
                for (int bj = 0; bj < 2; ++bj) { u32x2 pk[4];
#pragma unroll
                    for (int m = 0; m < 4; ++m) { f32x4 v0 = acc[ai][bj][m][0] * W8_INV, v1 = acc[ai][bj][m][1] * W8_INV;
#pragma unroll
                        for (int j = 0; j < 4; ++j) { v0[j] *= fast_sigmoid(v0[j]); v1[j] *= fast_sigmoid(v1[j]); }
                        pk[m] = (u32x2){cvt_pk4_fp8(v0[0], v0[1], v0[2], v0[3]), cvt_pk4_fp8(v1[0], v1[1], v1[2], v1[3])}; }
#pragma unroll
                    for (int mp = 0; mp < 2; ++mp)
                        *(u32x4*)(PG + (size_t)(row0 + ai * 128 + (2 * mp + (fq & 1)) * 16) * 512 + colp + bj * 128) = widen16(pk[2 * mp], pk[2 * mp + 1]); }
            return;
        }
        const int colt = (u.pn - 2) * 256 + wc * 32 + (fq >> 1) * 16;
#pragma unroll
        for (int ai = 0; ai < 2; ++ai)
#pragma unroll
            for (int bj = 0; bj < 2; ++bj) { u32x2 pk[4];
#pragma unroll
                for (int m = 0; m < 4; ++m) { f32x4 v0 = acc[ai][bj][m][0] * W8_INV, v1 = acc[ai][bj][m][1] * W8_INV;
#pragma unroll
                    for (int j = 0; j < 4; ++j) { v0[j] = fmaxf(fast_sigmoid(v0[j]) * 255.0f, 1.0f); v1[j] = fmaxf(fast_sigmoid(v1[j]) * 255.0f, 1.0f); }
                    pk[m] = (u32x2){pack4_u8(v0[0], v0[1], v0[2], v0[3]), pack4_u8(v1[0], v1[1], v1[2], v1[3])}; }
#pragma unroll
                for (int mp = 0; mp < 2; ++mp)
                    *(u32x4*)(GATES + (size_t)(row0 + ai * 128 + (2 * mp + (fq & 1)) * 16) * 2048 + colt + bj * 128) = widen16(pk[2 * mp], pk[2 * mp + 1]); }
    }
    __device__ __forceinline__ void mid(f32x4 (&)[2][2][4][2], const Unit&, int, int, int, int) const {}
};
struct EpiM1 {
    static constexpr bool PERM = true;
    const unsigned char* GATES; unsigned char* Mo;
    __device__ __forceinline__ void mid(f32x4 (&acc)[2][2][4][2], const Unit& u, int wr, int wc, int fr, int fq) const {
        int row0 = u.pm * 256 + wr * 64 + fr + (fq & 1) * 16, col0 = u.pn * 256 + wc * 32 + (fq >> 1) * 16;
        asm volatile("" : "+v"(row0), "+v"(col0));
        u32x4 gf[2][2][2], gh[2][2][2];
#pragma unroll
        for (int ai = 0; ai < 2; ++ai)
#pragma unroll
            for (int mp = 0; mp < 2; ++mp) { const unsigned char* gp = GATES + (size_t)(row0 + ai * 128 + mp * 32) * 2048 + col0;
#pragma unroll
                for (int bj = 0; bj < 2; ++bj) { gf[ai][mp][bj] = *(const u32x4*)(gp + bj * 128); gh[ai][mp][bj] = *(const u32x4*)(gp + 1024 + bj * 128); } }
#pragma unroll
        for (int ai = 0; ai < 2; ++ai) {
#pragma unroll
            for (int mp = 0; mp < 2; ++mp)
#pragma unroll
                for (int bj = 0; bj < 2; ++bj) { u32x2 f2[2], h2[2]; unwiden16(gf[ai][mp][bj], f2[0], f2[1]); unwiden16(gh[ai][mp][bj], h2[0], h2[1]);
#pragma unroll
                    for (int q = 0; q < 2; ++q) { const int m = 2 * mp + q;
                        const f32x4 fa = u8x4_to_f32(f2[q].x), fb = u8x4_to_f32(f2[q].y), ha = u8x4_to_f32(h2[q].x), hb = u8x4_to_f32(h2[q].y);
#pragma unroll
                        for (int j = 0; j < 4; ++j) { acc[ai][bj][m][0][j] *= fa[j] * __builtin_amdgcn_rcpf(ha[j]); acc[ai][bj][m][1][j] *= fb[j] * __builtin_amdgcn_rcpf(hb[j]); } } }
        }
        asm volatile("" ::: "memory");
    }
    __device__ __forceinline__ void operator()(const f32x4 (&acc)[2][2][4][2], const Unit& u, int wr, int wc, int fr, int fq) const {
        const int row0 = u.pm * 256 + wr * 64 + fr, col0 = u.pn * 256 + wc * 32 + (fq >> 1) * 16;
        const float sc = W8_INV * (1.0f / 255.0f);
        u32x4 gh[2][2][2];
#pragma unroll
        for (int ai = 0; ai < 2; ++ai)
#pragma unroll
            for (int mp = 0; mp < 2; ++mp) { const unsigned char* gp = GATES + (size_t)(row0 + ai * 128 + (2 * mp + (fq & 1)) * 16) * 2048 + 1024 + col0;
#pragma unroll
                for (int bj = 0; bj < 2; ++bj) gh[ai][mp][bj] = *(const u32x4*)(gp + bj * 128); }
#pragma unroll
        for (int ai = 0; ai < 2; ++ai) {
#pragma unroll
            for (int bj = 0; bj < 2; ++bj) { u32x2 pk[4];
#pragma unroll
                for (int mp = 0; mp < 2; ++mp) { u32x2 h2[2]; unwiden16(gh[ai][mp][bj], h2[0], h2[1]);
#pragma unroll
                    for (int q = 0; q < 2; ++q) { const int m = 2 * mp + q; const f32x4 ha = u8x4_to_f32(h2[q].x) * sc, hb = u8x4_to_f32(h2[q].y) * sc;
                        const f32x4 v0 = acc[ai][bj][m][0] * ha, v1 = acc[ai][bj][m][1] * hb;
                        pk[m] = (u32x2){cvt_pk4_fp8(v0[0], v0[1], v0[2], v0[3]), cvt_pk4_fp8(v1[0], v1[1], v1[2], v1[3])}; } }
#pragma unroll
                for (int mp = 0; mp < 2; ++mp)
                    *(u32x4*)(Mo + (size_t)(row0 + ai * 128 + (2 * mp + (fq & 1)) * 16) * 1024 + col0 + bj * 128) = widen16(pk[2 * mp], pk[2 * mp + 1]); }
        }
    }
};
constexpr float V8_SCALE = 16.0f, V8_INV = 1.0f / 16.0f;
struct EpiM2 {
    static constexpr bool PERM = true;
    const float* ada; unsigned char* V;
    __device__ __forceinline__ void operator()(const f32x4 (&acc)[2][2][4][2], const Unit& u, int wr, int wc, int fr, int fq) const {
        const int row0 = u.pm * 256 + wr * 64 + fr, col0 = u.pn * 256 + wc * 32 + 8 * fq, colw = u.pn * 256 + wc * 32 + (fq >> 1) * 16;
        const float* g1 = ada + (size_t)(u.pm >> 3) * 6144 + 2048 + col0;
        f32x4 gv[2][2];
#pragma unroll
        for (int bj = 0; bj < 2; ++bj)
#pragma unroll
            for (int n = 0; n < 2; ++n) gv[bj][n] = *(const f32x4*)(g1 + bj * 128 + n * 4) * (W8_INV * V8_SCALE);
#pragma unroll
        for (int ai = 0; ai < 2; ++ai)
#pragma unroll
            for (int bj = 0; bj < 2; ++bj) { u32x2 pk[4];
#pragma unroll
                for (int m = 0; m < 4; ++m) { const f32x4 v0 = gv[bj][0] * acc[ai][bj][m][0], v1 = gv[bj][1] * acc[ai][bj][m][1];
                    pk[m] = (u32x2){cvt_pk4_fp8(v0[0], v0[1], v0[2], v0[3]), cvt_pk4_fp8(v1[0], v1[1], v1[2], v1[3])}; }
#pragma unroll
                for (int mp = 0; mp < 2; ++mp)
                    *(u32x4*)(V + (size_t)(row0 + ai * 128 + (2 * mp + (fq & 1)) * 16) * 1024 + colw + bj * 128) = widen16(pk[2 * mp], pk[2 * mp + 1]); }
    }
    __device__ __forceinline__ void mid(f32x4 (&)[2][2][4][2], const Unit&, int, int, int, int) const {}
};
struct EpiGU {
    static constexpr bool PERM = true;
    const float* bgu; unsigned char* ACT;
    __device__ __forceinline__ void operator()(const f32x4 (&acc)[2][2][4][2], const Unit& u, int wr, int wc, int fr, int fq) const {
        const int row0 = u.pm * 256 + wr * 64 + fr, col0 = u.pn * 128 + wc * 32 + 8 * fq;
        const float* bp = bgu + (size_t)u.aux * 2048 + col0;
        const f32x4 bg0 = *(const f32x4*)(bp), bg1 = *(const f32x4*)(bp + 4), bu0 = *(const f32x4*)(bp + 1024), bu1 = *(const f32x4*)(bp + 1028);
#pragma unroll
        for (int ai = 0; ai < 2; ++ai) { u32x2 pk[4];
#pragma unroll
            for (int m = 0; m < 4; ++m) {
                f32x4 g0 = acc[ai][0][m][0] * W8_INV + bg0, g1 = acc[ai][0][m][1] * W8_INV + bg1, p0 = acc[ai][1][m][0] * W8_INV + bu0, p1 = acc[ai][1][m][1] * W8_INV + bu1;
#pragma unroll
                for (int j = 0; j < 4; ++j) {
                    float g = fminf(g0[j], 7.0f), p = fminf(fmaxf(p0[j], -7.0f), 7.0f); g0[j] = (p + 1.0f) * g * fast_sigmoid(1.702f * g);
                    g = fminf(g1[j], 7.0f); p = fminf(fmaxf(p1[j], -7.0f), 7.0f); g1[j] = (p + 1.0f) * g * fast_sigmoid(1.702f * g); }
                pk[m] = (u32x2){cvt_pk4_fp8(g0[0], g0[1], g0[2], g0[3]), cvt_pk4_fp8(g1[0], g1[1], g1[2], g1[3])}; }
#pragma unroll
            for (int mp = 0; mp < 2; ++mp)
                *(u32x4*)(ACT + (size_t)(row0 + ai * 128 + (2 * mp + (fq & 1)) * 16) * 1024 + u.pn * 128 + wc * 32 + (fq >> 1) * 16) = widen16(pk[2 * mp], pk[2 * mp + 1]); }
    }
    __device__ __forceinline__ void mid(f32x4 (&)[2][2][4][2], const Unit&, int, int, int, int) const {}
};
struct EpiDN {
    static constexpr bool PERM = true;
    const float* bdn; unsigned char* Y;
    __device__ __forceinline__ void operator()(const f32x4 (&acc)[2][2][4][2], const Unit& u, int wr, int wc, int fr, int fq) const {
        const int row0 = u.pm * 256 + wr * 64 + fr, col0 = u.pn * 256 + wc * 32 + 8 * fq;
        const float* bp = bdn + (size_t)u.aux * 1024 + col0;
        f32x4 bv[2][2];
#pragma unroll
        for (int bj = 0; bj < 2; ++bj)
#pragma unroll
            for (int n = 0; n < 2; ++n) bv[bj][n] = *(const f32x4*)(bp + bj * 128 + 4 * n);
#pragma unroll
        for (int ai = 0; ai < 2; ++ai)
#pragma unroll
            for (int bj = 0; bj < 2; ++bj) { u32x2 pk[4];
#pragma unroll
                for (int m = 0; m < 4; ++m) { const f32x4 v0 = acc[ai][bj][m][0] * W8_INV + bv[bj][0], v1 = acc[ai][bj][m][1] * W8_INV + bv[bj][1];
                    pk[m] = (u32x2){cvt_pk4_fp8(v0[0], v0[1], v0[2], v0[3]), cvt_pk4_fp8(v1[0], v1[1], v1[2], v1[3])}; }
#pragma unroll
                for (int mp = 0; mp < 2; ++mp)
                    *(u32x4*)(Y + (size_t)(row0 + ai * 128 + (2 * mp + (fq & 1)) * 16) * 1024 + u.pn * 256 + bj * 128 + wc * 32 + (fq >> 1) * 16) = widen16(pk[2 * mp], pk[2 * mp + 1]); }
    }
    __device__ __forceinline__ void mid(f32x4 (&)[2][2][4][2], const Unit&, int, int, int, int) const {}
};

struct Frame {
    LAS unsigned char* lds; int tid, lane, wave, G, c;
    const float* const* in; float* out; unsigned char* ws; unsigned* ctl;
};
enum { I_X = 0, I_C, I_CTX, I_CCTX, I_WADA, I_BADA, I_WIN, I_LBRAW, I_HGG, I_WFO, I_WHO, I_WO, I_LN1G, I_LN1B, I_WR, I_BR, I_WGU, I_BGU, I_WDN, I_BDN, I_LN2G, I_LN2B };

__device__ __forceinline__ float wave_sum(float v) {
#pragma unroll
    for (int o = 32; o >= 1; o >>= 1) v += __shfl_xor(v, o);
    return v;
}

__device__ __forceinline__ Frame fresh(const Frame& F) { Frame G = F; int t = threadIdx.x; asm volatile("" : "+v"(t)); G.tid = t; G.lane = t & 63; G.wave = __builtin_amdgcn_readfirstlane(t >> 6); return G; }

__device__ __forceinline__ void p0_ada(const Frame& F) {
    LAS float* cact = (LAS float*)F.lds;
    float* ada = (float*)(F.ws + WS_ADA);
    for (int cb = F.c; cb < 192; cb += F.G) {
        const int kg = F.tid >> 5, col = F.tid & 31, gcol = cb * 32 + col;
        float w[16][4];
#pragma unroll
        for (int i = 0; i < 16; ++i)
#pragma unroll
            for (int j = 0; j < 4; ++j) w[i][j] = F.in[I_WADA][(size_t)(4 * kg + 64 * i + j) * 6144 + gcol];
        f32x4 cv[17];
#pragma unroll
        for (int it = 0; it < 17; ++it) { const int q = F.tid + it * NTHR, bq = q >> 8, k4 = (q & 255) * 4; cv[it] = (f32x4){0.f, 0.f, 0.f, 0.f};
            if (q < 33 * 256) cv[it] = *(const f32x4*)(bq < 32 ? F.in[I_C] + bq * 1024 + k4 : F.in[I_CCTX] + k4); }
#pragma unroll
        for (int it = 0; it < 17; ++it) { const int q = F.tid + it * NTHR; f32x4 v = cv[it];
#pragma unroll
            for (int j = 0; j < 4; ++j) v[j] = v[j] * fast_sigmoid(v[j]);
            if (q < 33 * 256) *(LAS f32x4*)(cact + q * 4) = v; }
        __syncthreads();
        float acc[33];
#pragma unroll
        for (int bb = 0; bb < 33; ++bb) acc[bb] = 0.f;
#pragma unroll
        for (int i = 0; i < 16; ++i)
#pragma unroll
            for (int bb = 0; bb < 33; ++bb) { const f32x4 c4 = *(const LAS f32x4*)(cact + bb * 1024 + 4 * kg + 64 * i);
                acc[bb] += (c4[0] * w[i][0] + c4[1] * w[i][1]) + (c4[2] * w[i][2] + c4[3] * w[i][3]); }
        __syncthreads();
        LAS float* red = cact;
#pragma unroll
        for (int bb = 0; bb < 33; ++bb) red[(kg * 33 + bb) * 32 + col] = acc[bb];
        __syncthreads();
        for (int o = F.tid; o < 33 * 32; o += NTHR) { const int bb = o >> 5, cc = o & 31; float sum = 0.f;
#pragma unroll
            for (int g = 0; g < 16; ++g) sum += red[(g * 33 + bb) * 32 + cc];
            ada[(size_t)bb * 6144 + cb * 32 + cc] = sum + F.in[I_BADA][cb * 32 + cc]; }
        __syncthreads();
    }
}
__device__ __forceinline__ void p0_fold(const Frame& F) {
    LAS float* xr = (LAS float*)F.lds;
    LAS float* cs = xr + 2048;
    unsigned char* W1 = (unsigned char*)(F.ws + WS_WIN1T);
    if (F.tid < 128) { const float a = (float)F.tid * (1.0f / 128.0f); cs[F.tid] = __builtin_amdgcn_cosf(a); cs[128 + F.tid] = __builtin_amdgcn_sinf(a); }
    for (int kb = F.c; kb < 256; kb += F.G) {
        __syncthreads();
        for (int i = F.tid; i < 2048; i += NTHR) xr[i] = F.in[I_WIN][(size_t)(4 * kb + (i >> 9)) * 5120 + (i & 511)];
        __syncthreads();
        const int g = F.tid >> 7, j = F.tid & 127;
        float ac[4] = {0.f, 0.f, 0.f, 0.f}, as[4] = {0.f, 0.f, 0.f, 0.f};
        for (int d = 0; d < 128; ++d) { const int idx = (d * j) & 127; const float cv = cs[idx], sv = cs[128 + idx];
#pragma unroll
            for (int r = 0; r < 4; ++r) { const float xv = xr[r * 512 + g * 128 + d]; ac[r] += xv * cv; as[r] += xv * sv; } }
        const float sc = 0.08838834764831845f * W8_SCALE;
        *(unsigned*)(W1 + (size_t)(g * 128 + j) * 1024 + 4 * kb) = cvt_pk4_fp8(ac[0] * sc, ac[1] * sc, ac[2] * sc, ac[3] * sc);
        *(unsigned*)(W1 + (size_t)(512 + g * 128 + j) * 1024 + 4 * kb) = cvt_pk4_fp8(-as[0] * sc, -as[1] * sc, -as[2] * sc, -as[3] * sc);
    }
    __syncthreads();
}
struct CvJob { const float* src; int sld; unsigned char* dst; int f8; };
__device__ __forceinline__ CvJob cv_job(const Frame& F, int j) {
    CvJob J;
    if (j < 128) { const int kt = j >> 4, nt = j & 15; J.src = F.in[I_WIN] + (size_t)kt * 128 * 5120 + 512 + nt * 128; J.sld = 5120; J.dst = F.ws + WS_WIN1T + (size_t)(1024 + nt * 128) * 1024 + kt * 128; J.f8 = 1; }
    else if (j < 288) { const int q = j - 128, kt = q / 20, nt = q % 20; J.src = F.in[I_WIN] + (size_t)kt * 128 * 5120 + 2560 + nt * 128; J.sld = 5120; J.dst = F.ws + WS_WIN2T + (size_t)(nt * 128) * 1024 + kt * 128; J.f8 = 1; }
    else if (j < 320) { const int q = j - 288, kt = q >> 3, nt = q & 7; J.src = F.in[I_WFO] + (size_t)kt * 128 * 1024 + nt * 128; J.sld = 1024; J.dst = F.ws + WS_WMT + ((size_t)(nt * 128) * 1024 + kt * 128); J.f8 = 1; }
    else if (j < 352) { const int q = j - 320, kt = q >> 3, nt = q & 7; J.src = F.in[I_WHO] + (size_t)kt * 128 * 1024 + nt * 128; J.sld = 1024; J.dst = F.ws + WS_WMT + ((size_t)(nt * 128) * 1024 + 512 + kt * 128); J.f8 = 1; }
    else if (j < 416) { const int q = j - 352, kt = q >> 3, nt = q & 7; J.src = F.in[I_WO] + (size_t)kt * 128 * 1024 + nt * 128; J.sld = 1024; J.dst = F.ws + WS_WOT + ((size_t)(nt * 128) * 1024 + kt * 128); J.f8 = 1; }
    else if (j < 4512) { const int q = j - 416, e = q >> 7, r = q & 127, kt = r >> 4, jt = r & 15; J.src = F.in[I_WGU] + (size_t)e * 1024 * 2048 + (size_t)kt * 128 * 2048 + jt * 128; J.sld = 2048;
        J.dst = F.ws + WS_WGUT + (size_t)e * 2048 * 1024 + (size_t)((jt & 7) * 256 + (jt >> 3) * 128) * 1024 + kt * 128; J.f8 = 1; }
    else { const int q = j - 4512, e = q >> 6, r = q & 63, kt = r >> 3, nt = r & 7; J.src = F.in[I_WDN] + (size_t)e * 1024 * 1024 + (size_t)kt * 128 * 1024 + nt * 128; J.sld = 1024;
        J.dst = F.ws + WS_WDNT + (size_t)e * 1024 * 1024 + (size_t)(nt * 128) * 1024 + kt * 128; J.f8 = 1; }
    return J;
}
__device__ __forceinline__ void p0_convert(const Frame& F) {
    constexpr int NJ = 128 + 160 + 32 + 32 + 64 + 4096 + 2048;
    LAS float* tile0 = (LAS float*)F.lds; LAS float* tile1 = tile0 + 128 * 129;
    const int j0 = F.c; if (j0 >= NJ) return;
    f32x4 va[8], vb[8];
#define CV_LOAD(dst, jj) do { const CvJob Jl = cv_job(F, (jj)); _Pragma("unroll") for (int i = 0; i < 8; ++i) { const int idx = F.tid + i * NTHR, r = idx >> 5, c4 = idx & 31; dst[i] = *(const f32x4*)(Jl.src + (size_t)r * Jl.sld + c4 * 4); } } while (0)
#define CV_STEP(reg, tile, jj) do { \
        _Pragma("unroll") for (int i = 0; i < 8; ++i) { const int idx = F.tid + i * NTHR, r = idx >> 5, c4 = idx & 31; LAS float* p = tile + r * 129 + c4 * 4; p[0] = reg[i][0] * W8_SCALE; p[1] = reg[i][1] * W8_SCALE; p[2] = reg[i][2] * W8_SCALE; p[3] = reg[i][3] * W8_SCALE; } \
        __syncthreads(); \
        const CvJob Jc = cv_job(F, (jj)); \
        if ((jj) + 2 * F.G < NJ) CV_LOAD(reg, (jj) + 2 * F.G); \
        _Pragma("unroll") for (int i = 0; i < 2; ++i) { const int idx = F.tid + i * NTHR, n = idx >> 3, kc = idx & 7; const LAS float* p = tile + (kc * 16) * 129 + n; \
            u32x4 w; w.x = cvt_pk4_fp8(p[0], p[129], p[2 * 129], p[3 * 129]); w.y = cvt_pk4_fp8(p[4 * 129], p[5 * 129], p[6 * 129], p[7 * 129]); \
            w.z = cvt_pk4_fp8(p[8 * 129], p[9 * 129], p[10 * 129], p[11 * 129]); w.w = cvt_pk4_fp8(p[12 * 129], p[13 * 129], p[14 * 129], p[15 * 129]); \
            *(u32x4*)(Jc.dst + (size_t)n * 1024 + kc * 16) = w; } } while (0)
    CV_LOAD(va, j0);
    if (j0 + F.G < NJ) CV_LOAD(vb, j0 + F.G);
    for (int j = j0; j < NJ; j += 2 * F.G) {
        CV_STEP(va, tile0, j);
        if (j + F.G < NJ) CV_STEP(vb, tile1, j + F.G);
    }
    __syncthreads();
#undef CV_LOAD
#undef CV_STEP
}

__device__ __forceinline__ void p1_uprep(const Frame& F) {
    const float* ada = (const float*)(F.ws + WS_ADA);
    unsigned char* U = (unsigned char*)(F.ws + WS_U); unsigned char* Uc = (unsigned char*)(F.ws + WS_UC);
    const size_t NIT = (size_t)(T + TCX) * 128, stride = (size_t)F.G * NTHR;
    for (size_t base = (size_t)F.c * NTHR + F.tid; base < NIT; base += 4 * stride) {
        const int col = (int)(base & 127) * 8;
        f32x4 a0[4], a1[4], sh0[4], sh1[4], sc0[4], sc1[4]; unsigned char* dst[4]; bool ok[4];
#pragma unroll
        for (int u = 0; u < 4; ++u) {
            const size_t idx = base + (size_t)u * stride; ok[u] = idx < NIT;
            const int row = (int)((ok[u] ? idx : base) >> 7);
            const bool lat = row < T; const int b = lat ? (row >> 11) : 32;
            const float* src = lat ? F.in[I_X] + (size_t)row * 1024 + col : F.in[I_CTX] + (size_t)(row - T) * 1024 + col;
            dst[u] = lat ? U + (size_t)row * 1024 + col : Uc + (size_t)(row - T) * 1024 + col;
            a0[u] = *(const f32x4*)src; a1[u] = *(const f32x4*)(src + 4);
            const float* ap = ada + (size_t)b * 6144 + col;
            sh0[u] = *(const f32x4*)ap; sh1[u] = *(const f32x4*)(ap + 4); sc0[u] = *(const f32x4*)(ap + 1024); sc1[u] = *(const f32x4*)(ap + 1028);
        }
#pragma unroll
        for (int u = 0; u < 4; ++u) {
            const f32x4 r0 = a0[u] * (sc0[u] + 1.0f) + sh0[u], r1 = a1[u] * (sc1[u] + 1.0f) + sh1[u];
            if (ok[u]) *(u32x2*)dst[u] = (u32x2){cvt_pk4_fp8(r0[0], r0[1], r0[2], r0[3]), cvt_pk4_fp8(r1[0], r1[1], r1[2], r1[3])};
        }
    }
    int* rowtok = (int*)(F.ws + WS_ROWTOK);
    for (int i = F.c * NTHR + F.tid; i < NCH * ROWS_CH; i += F.G * NTHR) rowtok[i] = (i / ROWS_CH) * TCH;
}

__device__ __forceinline__ void p6_readout(const Frame& F) {
    const bf16_t* PH = (const bf16_t*)(F.ws + WS_PH); const unsigned char* PG = (const unsigned char*)(F.ws + WS_PG); unsigned char* Y = (unsigned char*)(F.ws + WS_Y);
    const int l8 = F.lane * 8;
    const f32x4 g0 = *(const f32x4*)(F.in[I_HGG] + l8), g1 = *(const f32x4*)(F.in[I_HGG] + l8 + 4);
    const int tstr = F.G * 8;
    for (int t0 = F.c * 8 + F.wave; t0 < T; t0 += 4 * tstr) {
        u32x2 av[4], bv[4], pv[4]; bool ok[4]; int tt[4];
#pragma unroll
        for (int u = 0; u < 4; ++u) { const int t = t0 + u * tstr; ok[u] = t < T; tt[u] = ok[u] ? t : t0;
            av[u] = *(const u32x2*)((const unsigned char*)PH + (size_t)tt[u] * 4096 + 1024 + l8); bv[u] = *(const u32x2*)((const unsigned char*)PH + (size_t)tt[u] * 4096 + 2048 + l8); pv[u] = *(const u32x2*)(PG + (size_t)tt[u] * 512 + l8); }
#pragma unroll
        for (int u = 0; u < 4; ++u) {
            const f32x4 pa = fp8x4_to_f32(pv[u].x), pb = fp8x4_to_f32(pv[u].y);
            const f32x4 oa = fp8x4_to_f32(av[u].x) + fp8x4_to_f32(bv[u].x), oc = fp8x4_to_f32(av[u].y) + fp8x4_to_f32(bv[u].y);
            float o[8] = { oa[0], oa[1], oa[2], oa[3], oc[0], oc[1], oc[2], oc[3] };
            float ss = 0.f;
#pragma unroll
            for (int i = 0; i < 8; ++i) ss += o[i] * o[i];
            ss += __shfl_xor(ss, 1); ss += __shfl_xor(ss, 2); ss += __shfl_xor(ss, 4); ss += __shfl_xor(ss, 8);
            const float rs = __builtin_amdgcn_rsqf(ss * (1.0f / 128.0f) + RMS_EPS);
            const float sp[8] = { pa[0], pa[1], pa[2], pa[3], pb[0], pb[1], pb[2], pb[3] };
            if (ok[u]) *(u32x2*)(Y + (size_t)tt[u] * 1024 + 512 + l8) = (u32x2){cvt_pk4_fp8(o[0] * rs * g0[0] * sp[0], o[1] * rs * g0[1] * sp[1], o[2] * rs * g0[2] * sp[2], o[3] * rs * g0[3] * sp[3]), cvt_pk4_fp8(o[4] * rs * g1[0] * sp[4], o[5] * rs * g1[1] * sp[5], o[6] * rs * g1[2] * sp[6], o[7] * rs * g1[3] * sp[7])};
        }
    }
}

constexpr int RW_STRIDE = 2080;
constexpr int RW_HI = 0, RW_LO = 32 * RW_STRIDE, RW_PAR = 64 * RW_STRIDE, RW_BR = RW_PAR + 16384, RW_HIST = RW_BR + 128;
__device__ __forceinline__ void p9_ln1_router(const Frame& F, const bool dry) {
    LAS unsigned char* L = F.lds;
    LAS float* par = (LAS float*)(L + RW_PAR); LAS float* brs = (LAS float*)(L + RW_BR); LAS int* hist = (LAS int*)(L + RW_HIST);
#pragma unroll 1
    for (int it = 0; it < 8; ++it) { const int item = F.tid + it * NTHR, e = item & 31, k8 = item >> 5;
        float w[8];
#pragma unroll
        for (int i = 0; i < 8; ++i) w[i] = F.in[I_WR][(k8 * 8 + i) * 32 + e];
        u32x4 hi, lo;
#pragma unroll
        for (int i = 0; i < 4; ++i) { const unsigned h = cvt_pk_bf16(w[2 * i], w[2 * i + 1]); hi[i] = h; lo[i] = cvt_pk_bf16(w[2 * i] - bf_lo(h), w[2 * i + 1] - bf_hi(h)); }
        *(LAS u32x4*)(L + RW_HI + e * RW_STRIDE + k8 * 16) = hi; *(LAS u32x4*)(L + RW_LO + e * RW_STRIDE + k8 * 16) = lo; }
    for (int i = F.tid; i < 2048; i += NTHR) par[i] = i < 1024 ? F.in[I_LN1G][i] : F.in[I_LN1B][i - 1024];
    if (F.tid < 32) brs[F.tid] = F.in[I_BR][F.tid];
    if (F.tid < NCH * 32) hist[F.tid] = 0;
    const unsigned char* V = (const unsigned char*)F.out; bf16_t* X1 = (bf16_t*)(F.ws + WS_X1); unsigned char* U2 = (unsigned char*)(F.ws + WS_U); const float* ada = (const float*)(F.ws + WS_ADA);
    int* topi = (int*)(F.ws + WS_TOPI); float* topw = (float*)(F.ws + WS_TOPW);
    for (int gb = F.c * 8; gb < T / 16; gb += F.G * 8) {
        const int g = T / 16 - 1 - (gb + F.wave), t0 = g * 16, b = (T / 16 - 1 - gb) >> 7;
        __syncthreads();
        { int tz = threadIdx.x; asm volatile("" : "+v"(tz));
          for (int i = tz; i < 2048; i += NTHR) par[2048 + i] = i < 1024 ? 1.0f + ada[(size_t)b * 6144 + 4096 + i] : ada[(size_t)b * 6144 + 3072 + (i - 1024)]; }
        __syncthreads();
        int l1 = threadIdx.x; asm volatile("" : "+v"(l1)); l1 &= 63;
        const float* xp = F.in[I_X] + (size_t)(t0 + (l1 & 15)) * 1024 + 8 * (l1 >> 4); const unsigned char* vp = V + (size_t)(t0 + (l1 & 15)) * 1024 + 8 * (l1 >> 4);
        unsigned tb[32][4]; float s1 = 0.f, s2 = 0.f, s1b = 0.f, s2b = 0.f;
#pragma unroll
        for (int c = 0; c < 4; ++c) {
            f32x4 xa[8], xb[8]; u32x2 vv[8];
#pragma unroll
            for (int q = 0; q < 8; ++q) { const int ks = 8 * c + q; xa[q] = *(const f32x4*)(xp + 32 * ks); xb[q] = *(const f32x4*)(xp + 32 * ks + 4); vv[q] = *(const u32x2*)(vp + 32 * ks); }
#pragma unroll
            for (int q = 0; q < 8; ++q) { const int ks = 8 * c + q;
                const f32x4 ta = xa[q] * DN_ALPHA + fp8x4_to_f32(vv[q].x) * V8_INV, tc = xb[q] * DN_ALPHA + fp8x4_to_f32(vv[q].y) * V8_INV;
#pragma unroll
                for (int j = 0; j < 4; ++j) { s1 += ta[j]; s1b += tc[j]; s2 = __builtin_fmaf(ta[j], ta[j], s2); s2b = __builtin_fmaf(tc[j], tc[j], s2b); }
                tb[ks][0] = cvt_pk_bf16(ta[0], ta[1]); tb[ks][1] = cvt_pk_bf16(ta[2], ta[3]); tb[ks][2] = cvt_pk_bf16(tc[0], tc[1]); tb[ks][3] = cvt_pk_bf16(tc[2], tc[3]); }
            asm volatile("" ::: "memory"); __builtin_amdgcn_sched_barrier(0);
        }
        s1 += s1b; s2 += s2b;
        {   int l4 = threadIdx.x; asm volatile("" : "+v"(l4)); l4 &= 63; const int b16 = (l4 ^ 16) << 2, b32 = (l4 ^ 32) << 2;
            s1 += __int_as_float(__builtin_amdgcn_ds_bpermute(b16, __float_as_int(s1))); s2 += __int_as_float(__builtin_amdgcn_ds_bpermute(b16, __float_as_int(s2)));
            s1 += __int_as_float(__builtin_amdgcn_ds_bpermute(b32, __float_as_int(s1))); s2 += __int_as_float(__builtin_amdgcn_ds_bpermute(b32, __float_as_int(s2))); }
        const float mean = s1 * (1.0f / 1024.0f), rstd = __builtin_amdgcn_rsqf(fmaxf(s2 * (1.0f / 1024.0f) - mean * mean, 0.f) + LN_EPS), nmr = -mean * rstd;
        f32x4 acc[2] = {(f32x4){0.f, 0.f, 0.f, 0.f}, (f32x4){0.f, 0.f, 0.f, 0.f}};
        int l2 = threadIdx.x; asm volatile("" : "+v"(l2)); l2 &= 63; const int fr = l2 & 15, fq = l2 >> 4;
        bf16_t* x1p = X1 + (size_t)(t0 + fr) * 1024 + 8 * fq; unsigned char* u2p = U2 + (size_t)(t0 + fr) * 1024 + 8 * fq;
#pragma unroll
        for (int ks = 0; ks < 32; ++ks) {
            const LAS float* pp = par + 32 * ks + 8 * fq;
            const f32x4 ta = {bf_lo(tb[ks][0]), bf_hi(tb[ks][0]), bf_lo(tb[ks][1]), bf_hi(tb[ks][1])}, tc = {bf_lo(tb[ks][2]), bf_hi(tb[ks][2]), bf_lo(tb[ks][3]), bf_hi(tb[ks][3])};
            f32x4 xa, xc, ua, uc;
            {   const f32x4 g0 = *(const LAS f32x4*)pp, b0 = *(const LAS f32x4*)(pp + 1024), c0 = *(const LAS f32x4*)(pp + 2048), h0 = *(const LAS f32x4*)(pp + 3072);
                xa = (ta * rstd + nmr) * g0 + b0; ua = xa * c0 + h0; }
            __builtin_amdgcn_sched_barrier(0);
            {   const f32x4 g1 = *(const LAS f32x4*)(pp + 4), b1 = *(const LAS f32x4*)(pp + 1028), c1 = *(const LAS f32x4*)(pp + 2052), h1 = *(const LAS f32x4*)(pp + 3076);
                xc = (tc * rstd + nmr) * g1 + b1; uc = xc * c1 + h1; }
            if (!dry) *(u32x4*)(x1p + 32 * ks) = (u32x4){cvt_pk_bf16(xa[0], xa[1]), cvt_pk_bf16(xa[2], xa[3]), cvt_pk_bf16(xc[0], xc[1]), cvt_pk_bf16(xc[2], xc[3])};
            if (!dry) *(u32x2*)(u2p + 32 * ks) = (u32x2){cvt_pk4_fp8(ua[0], ua[1], ua[2], ua[3]), cvt_pk4_fp8(uc[0], uc[1], uc[2], uc[3])};
            u32x4 hi = {cvt_pk_bf16(ua[0], ua[1]), cvt_pk_bf16(ua[2], ua[3]), cvt_pk_bf16(uc[0], uc[1]), cvt_pk_bf16(uc[2], uc[3])};
            u32x4 lo = {cvt_pk_bf16(ua[0] - bf_lo(hi[0]), ua[1] - bf_hi(hi[0])), cvt_pk_bf16(ua[2] - bf_lo(hi[1]), ua[3] - bf_hi(hi[1])), cvt_pk_bf16(uc[0] - bf_lo(hi[2]), uc[1] - bf_hi(hi[2])), cvt_pk_bf16(uc[2] - bf_lo(hi[3]), uc[3] - bf_hi(hi[3]))};
            const bf16x8 uh = *(bf16x8*)&hi, ul = *(bf16x8*)&lo;
#pragma unroll
            for (int et = 0; et < 2; ++et) {
                const bf16x8 wh = *(const LAS bf16x8*)(L + RW_HI + (16 * et + fr) * RW_STRIDE + ks * 64 + fq * 16), wl = *(const LAS bf16x8*)(L + RW_LO + (16 * et + fr) * RW_STRIDE + ks * 64 + fq * 16);
                acc[et] = __builtin_amdgcn_mfma_f32_16x16x32_bf16(wh, uh, acc[et], 0, 0, 0);
                acc[et] = __builtin_amdgcn_mfma_f32_16x16x32_bf16(wh, ul, acc[et], 0, 0, 0);
                acc[et] = __builtin_amdgcn_mfma_f32_16x16x32_bf16(wl, uh, acc[et], 0, 0, 0);
                __builtin_amdgcn_sched_barrier(0); }
        }
        int l3 = threadIdx.x; asm volatile("" : "+v"(l3)); l3 &= 63; const int fq3 = l3 >> 4, t = t0 + (l3 & 15), a16 = (l3 ^ 16) << 2, a32 = (l3 ^ 32) << 2;
        float lv[8]; int li[8];
#pragma unroll
        for (int i = 0; i < 4; ++i) { li[i] = 4 * fq3 + i; li[4 + i] = 16 + 4 * fq3 + i; lv[i] = acc[0][i] + brs[4 * fq3 + i]; lv[4 + i] = acc[1][i] + brs[16 + 4 * fq3 + i]; }
        float tv[4]; int ti[4];
#pragma unroll
        for (int r = 0; r < 4; ++r) {
            float bv = lv[0]; int bi = li[0];
#pragma unroll
            for (int i = 1; i < 8; ++i) { const bool gt = lv[i] > bv; bv = gt ? lv[i] : bv; bi = gt ? li[i] : bi; }
#pragma unroll
            for (int o = 0; o < 2; ++o) { const int ad = o ? a32 : a16; const float ov = __int_as_float(__builtin_amdgcn_ds_bpermute(ad, __float_as_int(bv))); const int oi = __builtin_amdgcn_ds_bpermute(ad, bi); const bool tk = ov > bv || (ov == bv && oi < bi); bv = tk ? ov : bv; bi = tk ? oi : bi; }
            tv[r] = bv; ti[r] = bi;
#pragma unroll
            for (int i = 0; i < 8; ++i) lv[i] = (li[i] == bi) ? -3.0e38f : lv[i];
        }
        if (fq3 == 0) {
            const float p1 = fast_exp(tv[1] - tv[0]), p2 = fast_exp(tv[2] - tv[0]), p3 = fast_exp(tv[3] - tv[0]), inv = 1.0f / (1.0f + p1 + p2 + p3);
            *(int4*)(topi + (size_t)t * 4) = make_int4(ti[0], ti[1], ti[2], ti[3]);
            *(f32x4*)(topw + (size_t)t * 4) = (f32x4){inv, p1 * inv, p2 * inv, p3 * inv};
            const int ch = t / TCH;
            if (!dry) { atomicAdd((int*)(hist + ch * 32 + ti[0]), 1); atomicAdd((int*)(hist + ch * 32 + ti[1]), 1); atomicAdd((int*)(hist + ch * 32 + ti[2]), 1); atomicAdd((int*)(hist + ch * 32 + ti[3]), 1); }
        }
    }
    __syncthreads();
    { int t2 = threadIdx.x; asm volatile("" : "+v"(t2));
      if (t2 < NCH * 32) { const int h = hist[t2]; if (h && !dry) atomicAdd(F.ctl + CW_CNT + t2, (unsigned)h); } }
    __syncthreads();
}

__device__ __forceinline__ void p10_dispatch(const Frame& F) {
    LAS int* lcnt = (LAS int*)F.lds; LAS int* lbase = lcnt + 32; LAS int* pstart = lcnt + 64;
    const int* topi = (const int*)(F.ws + WS_TOPI); int* pos = (int*)(F.ws + WS_POS); int* rowtok = (int*)(F.ws + WS_ROWTOK);
    for (int s = F.c; s < T / 256; s += F.G) {
        const int ch = (s * 256) / TCH;
        __syncthreads();
        if (F.tid < 32) { lcnt[F.tid] = 0; int ps = 0; for (int e = 0; e < F.tid; ++e) { const int n = (int)__hip_atomic_load(F.ctl + CW_CNT + ch * 32 + e, __ATOMIC_RELAXED, __HIP_MEMORY_SCOPE_AGENT); ps += (n + 255) & ~255; } pstart[F.tid] = ps; }
        __syncthreads();
        int e2[2], r2[2];
#pragma unroll
        for (int i = 0; i < 2; ++i) { const int a = F.tid + i * NTHR; e2[i] = topi[(size_t)(s * 256) * 4 + a]; r2[i] = atomicAdd((int*)(lcnt + e2[i]), 1); }
        __syncthreads();
        if (F.tid < 32) lbase[F.tid] = (int)atomicAdd(F.ctl + CW_CUR + ch * 32 + F.tid, (unsigned)lcnt[F.tid]);
        __syncthreads();
#pragma unroll
        for (int i = 0; i < 2; ++i) { const int a = F.tid + i * NTHR, slot = pstart[e2[i]] + lbase[e2[i]] + r2[i];
            pos[(size_t)(s * 256) * 4 + a] = slot; rowtok[(size_t)ch * ROWS_CH + slot] = s * 256 + (a >> 2); }
    }
}
__device__ __forceinline__ int moe_blocks(const Frame& F, int ch, LAS unsigned char* blk_e) {
    LAS int* sh = (LAS int*)(blk_e + 1152);
    __syncthreads();
    if (F.tid < 32) {
        int start = 0, mine = 0;
        for (int e = 0; e < 32; ++e) { const int n = ((int)__hip_atomic_load(F.ctl + CW_CNT + ch * 32 + e, __ATOMIC_RELAXED, __HIP_MEMORY_SCOPE_AGENT) + 255) >> 8; if (e < F.tid) start += n; if (e == F.tid) mine = n; }
        for (int i = 0; i < mine; ++i) blk_e[start + i] = (unsigned char)F.tid;
        if (F.tid == 31) sh[0] = start + mine;
    }
    __syncthreads();
    return sh[0];
}

__device__ __forceinline__ void p13_combine_ln2(const Frame& F, int ch, const bool dry) {
    const unsigned char* YC = (const unsigned char*)(F.ws + WS_YCH); const int* pos = (const int*)(F.ws + WS_POS); const float* topw = (const float*)(F.ws + WS_TOPW);
    const float* ada = (const float*)(F.ws + WS_ADA); const bf16_t* X1 = (const bf16_t*)(F.ws + WS_X1); float* O = F.out;
    const int l8 = F.lane * 8;
    for (int t0 = ch * TCH + F.c * 8 + F.wave; t0 < (ch + 1) * TCH; t0 += 2 * F.G * 8) {
        int tt[2]; tt[0] = t0; tt[1] = t0 + F.G * 8; const bool two = tt[1] < (ch + 1) * TCH; if (!two) tt[1] = t0;
        f32x4 v[2][2][2];
#pragma unroll
        for (int q = 0; q < 2; ++q) { const int t = tt[q], b = t >> 11;
            const int4 ps = *(const int4*)(pos + (size_t)t * 4); const f32x4 tw = *(const f32x4*)(topw + (size_t)t * 4);
#pragma unroll
            for (int j = 0; j < 2; ++j) { const int k = 512 * j + l8;
                const u32x2 y0 = *(const u32x2*)(YC + (size_t)ps.x * 1024 + k), y1 = *(const u32x2*)(YC + (size_t)ps.y * 1024 + k), y2 = *(const u32x2*)(YC + (size_t)ps.z * 1024 + k), y3 = *(const u32x2*)(YC + (size_t)ps.w * 1024 + k);
                const u32x4 xw = *(const u32x4*)(X1 + (size_t)t * 1024 + k);
                const f32x4 g2a = *(const f32x4*)(ada + (size_t)b * 6144 + 5120 + k), g2b = *(const f32x4*)(ada + (size_t)b * 6144 + 5120 + k + 4);
                const f32x4 ffa = fp8x4_to_f32(y0.x) * tw[0] + fp8x4_to_f32(y1.x) * tw[1] + fp8x4_to_f32(y2.x) * tw[2] + fp8x4_to_f32(y3.x) * tw[3];
                const f32x4 ffb = fp8x4_to_f32(y0.y) * tw[0] + fp8x4_to_f32(y1.y) * tw[1] + fp8x4_to_f32(y2.y) * tw[2] + fp8x4_to_f32(y3.y) * tw[3];
                v[q][j][0] = (f32x4){bf_lo(xw.x), bf_hi(xw.x), bf_lo(xw.y), bf_hi(xw.y)} * DN_ALPHA + g2a * ffa;
                v[q][j][1] = (f32x4){bf_lo(xw.z), bf_hi(xw.z), bf_lo(xw.w), bf_hi(xw.w)} * DN_ALPHA + g2b * ffb; } }
#pragma unroll
        for (int q = 0; q < 2; ++q) { const int t = tt[q];
            float s = 0.f;
#pragma unroll
            for (int j = 0; j < 2; ++j)
#pragma unroll
                for (int h = 0; h < 2; ++h) s += (v[q][j][h][0] + v[q][j][h][1]) + (v[q][j][h][2] + v[q][j][h][3]);
            s = wave_sum(s); const float mean = s * (1.0f / 1024.0f); float qq = 0.f;
#pragma unroll
            for (int j = 0; j < 2; ++j)
#pragma unroll
                for (int h = 0; h < 2; ++h) { const f32x4 d = v[q][j][h] - mean; qq += (d[0] * d[0] + d[1] * d[1]) + (d[2] * d[2] + d[3] * d[3]); }
            qq = wave_sum(qq); const float rstd = __builtin_amdgcn_rsqf(qq * (1.0f / 1024.0f) + LN_EPS);
            if (q == 0 || two) {
#pragma unroll
                for (int j = 0; j < 2; ++j)
#pragma unroll
                    for (int h = 0; h < 2; ++h) { const int k = 512 * j + l8 + 4 * h; const f32x4 g = *(const f32x4*)(F.in[I_LN2G] + k), bb = *(const f32x4*)(F.in[I_LN2B] + k);
                        const f32x4 o4 = (v[q][j][h] - mean) * rstd * g + bb;
                        if (!dry) *(f32x4*)(O + (size_t)t * 1024 + k) = o4; else if (o4[0] == 1.2345e30f) O[0] = 1.f; } }
        }
    }
}

constexpr int SC_QD = 0, SC_KI = 17408, SC_KE = 34816, SC_VT = 53248, SC_SC = 71680, SC_ST = 80896, SC_GV = 115712, SC_CS = 116224;
__device__ __forceinline__ bf16x8 ldfrag(const LAS unsigned char* p) { return *(const LAS bf16x8*)p; }
__device__ __forceinline__ void p3_scan(const Frame& F, const bool dry) {
    LAS unsigned char* L = F.lds;
    const int tid = F.tid, w = F.wave, lane = F.lane, fr = lane & 15, fq = lane >> 4;
    const int d2 = tid & 63, og = w;
    bf16_t* PH = (bf16_t*)(F.ws + WS_PH); const bf16_t* PHC = (const bf16_t*)(F.ws + WS_PHC);
    for (int it = F.c; it < 256; it += F.G) {
        const int b = it >> 3, h = (it >> 1) & 3, dir = it & 1;
        f32x2 lb2, om2;
        {   const f32x2 r0 = *(const f32x2*)(F.in[I_LBRAW] + dir * 512 + h * 128 + 2 * d2), r1 = *(const f32x2*)(F.in[I_LBRAW] + 1024 + dir * 512 + h * 128 + 2 * d2);
            lb2 = (f32x2){fast_sigmoid(r0[0] - r1[0]), fast_sigmoid(r0[1] - r1[1])}; om2 = (f32x2){1.0f - lb2[0], 1.0f - lb2[1]}; }
        f32x4 Sacc[8];
#pragma unroll
        for (int i = 0; i < 8; ++i) Sacc[i] = (f32x4){0.f, 0.f, 0.f, 0.f};
        __syncthreads();
        for (int i = tid; i < 34816 / 4; i += NTHR) ((LAS unsigned*)(L + SC_ST))[i] = 0u;
        const int cq = h * 128 + 2 * d2, cz = (dir ? 3584 : 512) + h * 128 + 2 * d2;
        unsigned short rq[8], rv[8], rz[8];
        {   const int n = dir ? 3 : 0; const unsigned char* base8 = (const unsigned char*)PHC + (size_t)(b * 256 + 64 * n + 8 * og) * 4096;
#pragma unroll
            for (int i = 0; i < 8; ++i) { rq[i] = *(const unsigned short*)(base8 + (size_t)i * 4096 + cq); rz[i] = *(const unsigned short*)(base8 + (size_t)i * 4096 + cz); rv[i] = *(const unsigned short*)(base8 + (size_t)i * 4096 + 3072 + cq); } }
        for (int s = 0; s < 36; ++s) {
            const bool lat = s >= 4; const int n = lat ? (dir ? 31 - (s - 4) : (s - 4)) : (dir ? 3 - s : s);
            f32x2 kk[8], cum[8], run = {1.0f, 1.0f};
#pragma unroll
            for (int i = 0; i < 8; ++i) { const unsigned zz = rz[i]; const f32x2 sg = (f32x2){(float)(zz & 0xffu), (float)(zz >> 8)} * (1.0f / 255.0f); cum[i] = lb2 + om2 * sg; kk[i] = 1.0f - cum[i]; }
            if (dir == 0) {
#pragma unroll
                for (int i = 0; i < 8; ++i) { run *= cum[i]; cum[i] = run; }
            } else {
#pragma unroll
                for (int i = 7; i >= 0; --i) { run *= cum[i]; cum[i] = run; }
            }
            *(LAS f32x2*)(L + SC_CS + (og * 128 + 2 * d2) * 4) = run;
            __syncthreads();
            {   f32x2 tot = {1.0f, 1.0f}, off = {1.0f, 1.0f};
#pragma unroll
                for (int gq = 0; gq < 8; ++gq) { const f32x2 c = *(const LAS f32x2*)(L + SC_CS + (gq * 128 + 2 * d2) * 4); tot *= c; const bool pre = dir == 0 ? (gq < og) : (gq > og); if (pre) off *= c; }
                if (og == 0) *(LAS f32x2*)(L + SC_GV + 2 * d2 * 4) = tot;
                f32x2 ke[8], vf[8];
#pragma unroll
                for (int i = 0; i < 8; ++i) {
                    const f32x2 ea = cum[i] * off, ia = {__builtin_amdgcn_rcpf(ea[0]), __builtin_amdgcn_rcpf(ea[1])};
                    const f32x2v qf = __builtin_amdgcn_cvt_pk_f32_fp8((int)rq[i], false);
                    const f32x2 qdv = (f32x2){qf[0], qf[1]} * ea, ki = kk[i] * ia;
                    *(LAS unsigned*)(L + SC_QD + (8 * og + i) * 272 + d2 * 4) = cvt_pk_bf16(qdv[0], qdv[1]);
                    *(LAS unsigned*)(L + SC_KI + (8 * og + i) * 272 + d2 * 4) = cvt_pk_bf16(ki[0], ki[1]);
                    ke[i] = ki * tot;
                    const f32x2v vv = __builtin_amdgcn_cvt_pk_f32_fp8((int)rv[i], false); vf[i] = (f32x2){vv[0], vv[1]};
                }
#pragma unroll
                for (int c = 0; c < 2; ++c) {
                    *(LAS u32x4*)(L + SC_KE + (2 * d2 + c) * 144 + 16 * og) = (u32x4){cvt_pk_bf16(ke[0][c], ke[1][c]), cvt_pk_bf16(ke[2][c], ke[3][c]), cvt_pk_bf16(ke[4][c], ke[5][c]), cvt_pk_bf16(ke[6][c], ke[7][c])};
                    *(LAS u32x4*)(L + SC_VT + (2 * d2 + c) * 144 + 16 * og) = (u32x4){cvt_pk_bf16(vf[0][c], vf[1][c]), cvt_pk_bf16(vf[2][c], vf[3][c]), cvt_pk_bf16(vf[4][c], vf[5][c]), cvt_pk_bf16(vf[6][c], vf[7][c])}; }
            }
            if (s + 1 < 36) {
                const int s1 = s + 1; const bool lat1 = s1 >= 4; const int n1 = lat1 ? (dir ? 31 - (s1 - 4) : (s1 - 4)) : (dir ? 3 - s1 : s1);
                const unsigned char* base8 = lat1 ? (const unsigned char*)PH + (size_t)(b * 2048 + 64 * n1 + 8 * og) * 4096 : (const unsigned char*)PHC + (size_t)(b * 256 + 64 * n1 + 8 * og) * 4096;
#pragma unroll
                for (int i = 0; i < 8; ++i) { rq[i] = *(const unsigned short*)(base8 + (size_t)i * 4096 + cq); rz[i] = *(const unsigned short*)(base8 + (size_t)i * 4096 + cz); rv[i] = *(const unsigned short*)(base8 + (size_t)i * 4096 + 3072 + cq); }
            }
            __syncthreads();
            f32x4 oacc[4];
#pragma unroll
            for (int i = 0; i < 4; ++i) oacc[i] = (f32x4){0.f, 0.f, 0.f, 0.f};
            const int kb = fq * 16;
            if (lat) {
                const int ct = w >> 1, st0 = 2 * (w & 1);
#pragma unroll
                for (int j = 0; j < 2; ++j) { const int st = st0 + j; f32x4 sa = (f32x4){0.f, 0.f, 0.f, 0.f};
#pragma unroll
                    for (int ks = 0; ks < 4; ++ks) sa = __builtin_amdgcn_mfma_f32_16x16x32_bf16(ldfrag(L + SC_KI + (16 * st + fr) * 272 + ks * 64 + kb), ldfrag(L + SC_QD + (16 * ct + fr) * 272 + ks * 64 + kb), sa, 0, 0, 0);
                    const int cc = 16 * ct + fr, s0 = 16 * st + 4 * fq;
#pragma unroll
                    for (int i = 0; i < 4; ++i) { const bool keep = dir ? (s0 + i >= cc) : (s0 + i <= cc); sa[i] = keep ? sa[i] : 0.f; }
                    *(LAS u32x2*)(L + SC_SC + cc * 144 + s0 * 2) = (u32x2){cvt_pk_bf16(sa[0], sa[1]), cvt_pk_bf16(sa[2], sa[3])}; }
#pragma unroll
                for (int ct2 = 0; ct2 < 4; ++ct2)
#pragma unroll
                    for (int ks = 0; ks < 4; ++ks) oacc[ct2] = __builtin_amdgcn_mfma_f32_16x16x32_bf16(ldfrag(L + SC_ST + (16 * w + fr) * 272 + ks * 64 + kb), ldfrag(L + SC_QD + (16 * ct2 + fr) * 272 + ks * 64 + kb), oacc[ct2], 0, 0, 0);
            }
            {   const bf16x8 v0 = ldfrag(L + SC_VT + (16 * w + fr) * 144 + kb), v1 = ldfrag(L + SC_VT + (16 * w + fr) * 144 + 64 + kb);
#pragma unroll
                for (int dt = 0; dt < 8; ++dt) { const f32x4 gv = *(const LAS f32x4*)(L + SC_GV + (16 * dt + 4 * fq) * 4);
                    f32x4 a = Sacc[dt] * gv;
                    a = __builtin_amdgcn_mfma_f32_16x16x32_bf16(ldfrag(L + SC_KE + (16 * dt + fr) * 144 + kb), v0, a, 0, 0, 0);
                    a = __builtin_amdgcn_mfma_f32_16x16x32_bf16(ldfrag(L + SC_KE + (16 * dt + fr) * 144 + 64 + kb), v1, a, 0, 0, 0);
                    Sacc[dt] = a; } }
            __syncthreads();
#pragma unroll
            for (int dt = 0; dt < 8; ++dt) *(LAS u32x2*)(L + SC_ST + (16 * w + fr) * 272 + (16 * dt + 4 * fq) * 2) = (u32x2){cvt_pk_bf16(Sacc[dt][0], Sacc[dt][1]), cvt_pk_bf16(Sacc[dt][2], Sacc[dt][3])};
            if (lat) {
                const bf16x8 v0 = ldfrag(L + SC_VT + (16 * w + fr) * 144 + kb), v1 = ldfrag(L + SC_VT + (16 * w + fr) * 144 + 64 + kb);
                unsigned char* ob = (unsigned char*)PH + (size_t)(b * 2048 + 64 * n) * 4096 + 1024 + dir * 1024 + h * 128 + 16 * w + 4 * fq;
#pragma unroll
                for (int ct2 = 0; ct2 < 4; ++ct2) {
                    f32x4 a = oacc[ct2];
                    a = __builtin_amdgcn_mfma_f32_16x16x32_bf16(v0, ldfrag(L + SC_SC + (16 * ct2 + fr) * 144 + kb), a, 0, 0, 0);
                    a = __builtin_amdgcn_mfma_f32_16x16x32_bf16(v1, ldfrag(L + SC_SC + (16 * ct2 + fr) * 144 + 64 + kb), a, 0, 0, 0);
                    if (!dry) *(unsigned*)(ob + (size_t)(16 * ct2 + fr) * 4096) = cvt_pk4_fp8(a[0], a[1], a[2], a[3]);
                    else if (a[0] == 1.2345e30f) ob[0] = 1; }
            }
        }
        __syncthreads();
    }
}

typedef short s16x4 __attribute__((ext_vector_type(4)));
__device__ __forceinline__ s16x4 tr_read(unsigned lds_addr) { s16x4 r; asm volatile("ds_read_b64_tr_b16 %0, %1\n\ts_waitcnt lgkmcnt(0)" : "=&v"(r) : "v"(lds_addr) : "memory"); return r; }
__device__ __forceinline__ void tr_read8(unsigned a0, unsigned a1, unsigned a2, unsigned a3, unsigned d, s16x4 (&r)[8]) {
    asm volatile("ds_read_b64_tr_b16 %0, %8\n\tds_read_b64_tr_b16 %1, %9\n\tds_read_b64_tr_b16 %2, %10\n\tds_read_b64_tr_b16 %3, %11\n\t"
                 "ds_read_b64_tr_b16 %4, %12\n\tds_read_b64_tr_b16 %5, %13\n\tds_read_b64_tr_b16 %6, %14\n\tds_read_b64_tr_b16 %7, %15\n\ts_waitcnt lgkmcnt(0)"
                 : "=&v"(r[0]), "=&v"(r[1]), "=&v"(r[2]), "=&v"(r[3]), "=&v"(r[4]), "=&v"(r[5]), "=&v"(r[6]), "=&v"(r[7])
                 : "v"(a0), "v"(a0 + d), "v"(a1), "v"(a1 + d), "v"(a2), "v"(a2 + d), "v"(a3), "v"(a3 + d) : "memory");
}
__device__ __forceinline__ void tr_read4(unsigned a0, unsigned a1, unsigned d, s16x4 (&r)[4]) {
    asm volatile("ds_read_b64_tr_b16 %0, %4\n\tds_read_b64_tr_b16 %1, %5\n\tds_read_b64_tr_b16 %2, %6\n\tds_read_b64_tr_b16 %3, %7\n\ts_waitcnt lgkmcnt(0)"
                 : "=&v"(r[0]), "=&v"(r[1]), "=&v"(r[2]), "=&v"(r[3]) : "v"(a0), "v"(a0 + d), "v"(a1), "v"(a1 + d) : "memory");
}
__device__ __forceinline__ bf16x8 cat4(s16x4 a, s16x4 b) { return (bf16x8){a[0], a[1], a[2], a[3], b[0], b[1], b[2], b[3]}; }
constexpr int FO_C = 131072, FO_S = 139264;
__device__ __forceinline__ void p4_fourier(const Frame& F) {
    LAS unsigned char* L = F.lds;
    const int tid = F.tid, w = F.wave, lane = F.lane, fr = lane & 15, fq = lane >> 4;
    const bf16_t* PA = (const bf16_t*)(F.ws + WS_PA); unsigned char* Y = (unsigned char*)(F.ws + WS_Y);
    __syncthreads();
    for (int i = tid; i < 4096; i += NTHR) { const int k2 = i >> 6, c = i & 63; const float a = (float)((k2 * c) & 63) * (1.0f / 64.0f);
        *(LAS bf16_t*)(L + FO_C + i * 2) = (bf16_t)(cvt_pk_bf16(__builtin_amdgcn_cosf(a) * 0.125f, 0.f) & 0xffffu);
        *(LAS bf16_t*)(L + FO_S + i * 2) = (bf16_t)(cvt_pk_bf16(__builtin_amdgcn_sinf(a) * 0.125f, 0.f) & 0xffffu); }
    bf16x8 Gf[2][2];
#pragma unroll
    for (int nt = 0; nt < 2; ++nt)
#pragma unroll
        for (int ks = 0; ks < 2; ++ks) { unsigned pk[4];
#pragma unroll
            for (int j = 0; j < 8; j += 2) { const int k1 = 16 * nt + fr, ra = 8 * fq + j, rb = ra + 1; const float aa = (float)((k1 * ra) & 31) * (1.0f / 32.0f), ab = (float)((k1 * rb) & 31) * (1.0f / 32.0f);
                const float va = (ks ? __builtin_amdgcn_sinf(aa) : __builtin_amdgcn_cosf(aa)) * 0.17677669529663687f, vb = (ks ? __builtin_amdgcn_sinf(ab) : __builtin_amdgcn_cosf(ab)) * 0.17677669529663687f;
                pk[j >> 1] = cvt_pk_bf16(va, vb); }
            u32x4 t4 = (u32x4){pk[0], pk[1], pk[2], pk[3]}; Gf[nt][ks] = *(bf16x8*)&t4; }
    const unsigned lbase = (unsigned)(size_t)L;
    u32x4 pv[8];
    if (F.c < 1024) { const int it = F.c, xcd = it & 7, jj = it >> 3, slab = 4 * xcd + (jj & 3), b = jj >> 2; const unsigned char* src = (const unsigned char*)PA + (size_t)(b * 32 + slab) * 65536;
#pragma unroll
        for (int n = 0; n < 8; ++n) pv[n] = *(const u32x4*)(src + (size_t)(tid + NTHR * n) * 16); }
    for (int it = F.c; it < 1024; it += F.G) {
        const int xcd = it & 7, jj = it >> 3, slab = 4 * xcd + (jj & 3), b = jj >> 2;
        __syncthreads();
#pragma unroll
        for (int n = 0; n < 8; ++n) {
            const u32x4 w = pv[n]; u32x4 lo, hi;
            { const f32x4 a = fp8x4_to_f32(w.x), c = fp8x4_to_f32(w.y); lo = (u32x4){cvt_pk_bf16(a[0], a[1]), cvt_pk_bf16(a[2], a[3]), cvt_pk_bf16(c[0], c[1]), cvt_pk_bf16(c[2], c[3])}; }
            { const f32x4 a = fp8x4_to_f32(w.z), c = fp8x4_to_f32(w.w); hi = (u32x4){cvt_pk_bf16(a[0], a[1]), cvt_pk_bf16(a[2], a[3]), cvt_pk_bf16(c[0], c[1]), cvt_pk_bf16(c[2], c[3])}; }
            *(LAS u32x4*)(L + (tid + NTHR * n) * 32) = lo; *(LAS u32x4*)(L + (tid + NTHR * n) * 32 + 16) = hi; }
        __syncthreads();
        if (it + F.G < 1024) { const int it1 = it + F.G, xcd1 = it1 & 7, jj1 = it1 >> 3, slab1 = 4 * xcd1 + (jj1 & 3), b1 = jj1 >> 2; const unsigned char* src = (const unsigned char*)PA + (size_t)(b1 * 32 + slab1) * 65536;
#pragma unroll
            for (int n = 0; n < 8; ++n) pv[n] = *(const u32x4*)(src + (size_t)(tid + NTHR * n) * 16); }
#pragma unroll 1
        for (int rr = 0; rr < 4; ++rr) {
            const int r = w + 8 * rr;
            f32x4 acc[8];
#pragma unroll
            for (int i = 0; i < 8; ++i) acc[i] = (f32x4){0.f, 0.f, 0.f, 0.f};
            s16x4 tr[8];
            {   unsigned aa[4];
#pragma unroll
                for (int ks = 0; ks < 4; ++ks) { const int ri = ks >> 1, c0 = 32 * (ks & 1) + 8 * fq + (fr >> 2); aa[ks] = lbase + (unsigned)((r * 64 + c0) * 64 + ri * 32 + (fr & 3) * 8); }
                tr_read8(aa[0], aa[1], aa[2], aa[3], 4u * 64u, tr); }
#pragma unroll
            for (int ks = 0; ks < 4; ++ks) {
                const int ri = ks >> 1;
                const bf16x8 af = cat4(tr[2 * ks], tr[2 * ks + 1]);
#pragma unroll
                for (int nt = 0; nt < 8; ++nt) { const int ro = nt >> 2, k2 = 16 * (nt & 3) + fr;
                    u32x4 bw = *(const LAS u32x4*)(L + ((ro == ri) ? FO_C : FO_S) + (k2 * 64 + 32 * (ks & 1) + 8 * fq) * 2);
                    if (ro == 1 && ri == 0) { bw.x ^= 0x80008000u; bw.y ^= 0x80008000u; bw.z ^= 0x80008000u; bw.w ^= 0x80008000u; }
                    acc[nt] = __builtin_amdgcn_mfma_f32_16x16x32_bf16(af, *(bf16x8*)&bw, acc[nt], 0, 0, 0); }
            }
#pragma unroll
            for (int nt = 0; nt < 8; ++nt) { const int ro = nt >> 2, k2 = 16 * (nt & 3) + fr;
                *(LAS u32x2*)(L + (r * 64 + k2) * 64 + ro * 32 + fq * 8) = (u32x2){cvt_pk_bf16(acc[nt][0], acc[nt][1]), cvt_pk_bf16(acc[nt][2], acc[nt][3])}; }
        }
        __syncthreads();
#pragma unroll 1
        for (int kk = 0; kk < 8; ++kk) {
            const int k2 = 8 * w + kk;
            f32x4 a2[2] = {(f32x4){0.f, 0.f, 0.f, 0.f}, (f32x4){0.f, 0.f, 0.f, 0.f}};
            s16x4 t4[4];
            {   const int r0 = 8 * fq + (fr >> 2); const unsigned a0 = lbase + (unsigned)((r0 * 64 + k2) * 64 + (fr & 3) * 8);
                tr_read4(a0, a0 + 32u, 4u * 64u * 64u, t4); }
#pragma unroll
            for (int ks = 0; ks < 2; ++ks) {
                const bf16x8 af = cat4(t4[2 * ks], t4[2 * ks + 1]);
                a2[0] = __builtin_amdgcn_mfma_f32_16x16x32_bf16(af, Gf[0][ks], a2[0], 0, 0, 0);
                a2[1] = __builtin_amdgcn_mfma_f32_16x16x32_bf16(af, Gf[1][ks], a2[1], 0, 0, 0);
            }
#pragma unroll
            for (int nt = 0; nt < 2; ++nt) { const int k1 = 16 * nt + fr;
                *(unsigned*)(Y + (size_t)(b * 2048 + k1 * 64 + k2) * 1024 + slab * 16 + 4 * fq) = cvt_pk4_fp8(a2[nt][0], a2[nt][1], a2[nt][2], a2[nt][3]); }
        }
    }
    __syncthreads();
}

struct Args { const float* in[22]; float* out; unsigned char* ws; int ph_lo, ph_hi; };
constexpr int N_PHASES = 9 + 3 * NCH;

__global__ void __launch_bounds__(NTHR, 2) mega_fwd(Args args) {
    extern __shared__ __attribute__((aligned(16))) unsigned char lds_raw[];
    Frame F;
    F.lds = (LAS unsigned char*)lds_raw;
    F.tid = threadIdx.x; F.lane = F.tid & 63; F.wave = __builtin_amdgcn_readfirstlane(F.tid >> 6);
    F.G = gridDim.x; F.c = blockIdx.x;
    F.in = args.in;
    F.out = args.out; F.ws = args.ws; F.ctl = (unsigned*)(args.ws + WS_CTL);
    volatile LAS unsigned* misc = (volatile LAS unsigned*)(F.lds + LDS_MISC);
    if (F.tid < 4) misc[F.tid] = 0u;
    __syncthreads();
    XcdBarrier bar = xcd_barrier_post(F.ctl, misc);
    const int lo = args.ph_lo, hi = args.ph_hi;
#ifndef PHASE_MASK
#define PHASE_MASK 0xFFFFFFFFu
#endif
#define IN(k) ((((PHASE_MASK) >> (k)) & 1u) && lo <= (k) && (k) < hi)
#define SEAM(k) do { if (IN(k) && IN((k) + 1)) xcd_barrier(bar); } while (0)
#ifndef REP_MASK
#define REP_MASK 0u
#endif
#define REPS(b) ((((REP_MASK) >> (b)) & 1u) ? 2 : 1)
#define REPBAR(b, r) do { if ((((REP_MASK) >> (b)) & 1u) && (r) == 0) xcd_barrier(bar); } while (0)
    unsigned char* ws = F.ws;
    LAS unsigned char* blk_e = F.lds + LDS_MISC + 64;
#ifdef PR_A
    unsigned long long* stamps = (unsigned long long*)(ws + 980 * MiB);
#define STAMP(slot) do { if (F.tid == 0) stamps[(slot) * 256 + F.c] = __builtin_amdgcn_s_memrealtime(); } while (0)
#else
#define STAMP(slot) do { } while (0)
#endif
    STAMP(0);

    if (IN(0)) { for (int r = 0; r < REPS(0); ++r) { p0_ada(F); p0_fold(F); p0_convert(F); REPBAR(0, r); } }
    STAMP(1);
    SEAM(0);
    if (IN(1)) { for (int r = 0; r < REPS(1); ++r) { p1_uprep(F); REPBAR(1, r); } }
    STAMP(2);
    SEAM(1);
    if (IN(2)) {
        ProbP1 P{(const char*)(ws + WS_U), 8, 1024u, 1024u, (const char*)(ws + WS_WIN1T), (unsigned)(WS_UC - WS_U), F.G, F.c};
        EpiP1 E{(bf16_t*)(ws + WS_PA), (bf16_t*)(ws + WS_PH), (bf16_t*)(ws + WS_PHC)};
        for (int r = 0; r < REPS(2); ++r) { pg8::gemm_phase<ProbP1, EpiP1, true, false, true>(F.lds, P, E); REPBAR(2, r); }
    }
    STAMP(3);
    SEAM(2);
    if (IN(3)) {
#ifndef NO_FOURIER
        for (int r = 0; r < REPS(4); ++r) { p4_fourier(F); REPBAR(4, r); }
        STAMP(5);
#endif
#ifndef NO_SCAN
        for (int r = 0; r < REPS(3); ++r) { p3_scan(F, r + 1 < REPS(3)); REPBAR(3, r); }
        STAMP(4);
#endif
#ifndef NO_P2GEMM
        ProbDense P{(const char*)(ws + WS_U), 8, 1024u, 1024u, (const char*)(ws + WS_WIN2T), 256, 10, F.G, F.c, 0};
        EpiP2 E{(unsigned char*)(ws + WS_PG), (unsigned char*)F.out};
        for (int r = 0; r < REPS(5); ++r) { pg8::gemm_phase<ProbDense, EpiP2, true, false, true>(F.lds, P, E); REPBAR(5, r); }
#endif
    }
    STAMP(6);
    SEAM(3);
    if (IN(4)) { for (int r = 0; r < REPS(6); ++r) { p6_readout(F); REPBAR(6, r); } }
    STAMP(7);
    SEAM(4);
    if (IN(5)) {
        ProbDense P{(const char*)(ws + WS_Y), 8, 1024u, 1024u, (const char*)(ws + WS_WMT), 256, 4, F.G, F.c, 1};
        EpiM1 E{(const unsigned char*)F.out, (unsigned char*)(ws + WS_PA)};
        for (int r = 0; r < REPS(7); ++r) { pg8::gemm_phase<ProbDense, EpiM1, true, true, true>(F.lds, P, E); REPBAR(7, r); }
    }
    STAMP(8);
    SEAM(5);
    if (IN(6)) {
        ProbDense P{(const char*)(ws + WS_PA), 8, 1024u, 1024u, (const char*)(ws + WS_WOT), 256, 4, F.G, F.c, 0};
        EpiM2 E{(const float*)(ws + WS_ADA), (unsigned char*)F.out};
        for (int r = 0; r < REPS(8); ++r) { pg8::gemm_phase<ProbDense, EpiM2, true, false, true>(F.lds, P, E); REPBAR(8, r); }
    }
    STAMP(9);
    SEAM(6);
    if (IN(7)) { for (int r = 0; r < REPS(9); ++r) { p9_ln1_router(fresh(F), r + 1 < REPS(9)); REPBAR(9, r); } }
    STAMP(10);
    SEAM(7);
    if (IN(8)) { p10_dispatch(F); }
    STAMP(11);
    SEAM(8);
#pragma unroll
    for (int ch = 0; ch < NCH; ++ch) {
        if (IN(9 + 3 * ch)) {
            const int nblk = moe_blocks(F, ch, blk_e);
            ProbMoE<true> P{(const char*)(ws + WS_U), 8, 1024u, 1024u, (const char*)(ws + WS_WGUT), (size_t)2048 * 1024, 8, nblk, F.G, F.c, (const int*)(ws + WS_ROWTOK) + (size_t)ch * ROWS_CH, blk_e};
            EpiGU E{F.in[I_BGU], (unsigned char*)(ws + WS_ACT)};
#ifdef GU_DRY
            pg8::gemm_phase<ProbMoE<true>, EpiGU, true, false, true, GU_DRY>(F.lds, P, E); xcd_barrier(bar);
#endif
            for (int r = 0; r < (ch == 0 ? REPS(10) : 1); ++r) { pg8::gemm_phase<ProbMoE<true>, EpiGU, true, false, true>(F.lds, P, E); if (ch == 0) REPBAR(10, r); }
        }
        STAMP(12);
        SEAM(9 + 3 * ch);
        if (IN(10 + 3 * ch)) {
            const int nblk = moe_blocks(F, ch, blk_e);
            ProbMoE<false> P{(const char*)(ws + WS_ACT), 8, 1024u, 1024u, (const char*)(ws + WS_WDNT), (size_t)1024 * 1024, 4, nblk, F.G, F.c, nullptr, blk_e};
            EpiDN E{F.in[I_BDN], (unsigned char*)(ws + WS_YCH)};
            for (int r = 0; r < (ch == 0 ? REPS(11) : 1); ++r) { pg8::gemm_phase<ProbMoE<false>, EpiDN, true, false, true>(F.lds, P, E); if (ch == 0) REPBAR(11, r); }
        }
        STAMP(13);
        SEAM(10 + 3 * ch);
        if (IN(11 + 3 * ch)) { for (int r = 0; r < (ch == 0 ? REPS(12) : 1); ++r) { p13_combine_ln2(F, ch, ch == 0 && r + 1 < REPS(12)); if (ch == 0) REPBAR(12, r); } }
        STAMP(14);
        SEAM(11 + 3 * ch);
    }
#ifdef DBG_K
    xcd_barrier(bar);
    {
        const unsigned char* buf = (DBG_OUT) ? (const unsigned char*)F.out : (const unsigned char*)(ws + (size_t)(DBG_OFF));
        const size_t wpr = (size_t)(DBG_CW) / 4, nw = (size_t)(DBG_ROWS) * wpr;
        unsigned long long cs = 0; unsigned bad = 0;
        for (size_t i = (size_t)F.c * NTHR + F.tid; i < nw; i += (size_t)F.G * NTHR) { const size_t r = i / wpr, cw = i % wpr; const unsigned w = *(const unsigned*)(buf + r * (size_t)(DBG_LD) + (DBG_C0) + cw * 4); cs += w;
            if (DBG_F32) { if ((w & 0x7f800000u) == 0x7f800000u) ++bad; } else { if ((w & 0x7f80u) == 0x7f80u) ++bad; if ((w & 0x7f800000u) == 0x7f800000u) ++bad; } }
        for (int o = 32; o >= 1; o >>= 1) { cs += __shfl_xor(cs, o); bad += __shfl_xor(bad, o); }
        if (F.lane == 0) { atomicAdd((unsigned long long*)(F.ctl + 8192), cs); atomicAdd(F.ctl + 8200, bad); }
        if (F.c == 0 && F.tid == 0) atomicAdd(F.ctl + 8201, xb_ld(&F.ctl[XB_TMO]));
    }
    xcd_barrier(bar);
    {
        const unsigned long long cs = __hip_atomic_load((unsigned long long*)(F.ctl + 8192), __ATOMIC_RELAXED, __HIP_MEMORY_SCOPE_AGENT);
        const unsigned bad = xb_ld(F.ctl + 8200), tmo = xb_ld(F.ctl + 8201);
        const float val = (float)(unsigned)((cs ^ (cs >> 16) ^ (cs >> 32)) & 0xFFFFu) * (1.0f / 65536.0f) + (bad ? 2.0f : 0.0f) + (tmo ? 4.0f : 0.0f);
        for (size_t i = (size_t)F.c * NTHR + F.tid; i < (size_t)T * D; i += (size_t)F.G * NTHR) F.out[i] = val;
    }
    return;
#endif
#ifdef PR_A
    xcd_barrier(bar);
    {
        auto maxs = [&](int sl) { unsigned long long m = 0; for (int w = 0; w < (int)F.G; ++w) { const unsigned long long v = stamps[sl * 256 + w]; m = v > m ? v : m; } return m; };
        auto dur = [&](int sl) -> float {
            if (sl == 4) { const unsigned long long st = maxs(3); double a = 0; for (int w = 0; w < (int)F.G; ++w) a += (double)(stamps[4 * 256 + w] - st); return (float)(a / F.G) * 0.01f; }
            if (sl == 5) { double a = 0; for (int w = 0; w < (int)F.G; ++w) a += (double)(stamps[5 * 256 + w] - stamps[4 * 256 + w]); return (float)(a / F.G) * 0.01f; }
            if (sl == 6) { double a = 0; for (int w = 0; w < (int)F.G; ++w) a += (double)(stamps[6 * 256 + w] - stamps[5 * 256 + w]); return (float)(a / F.G) * 0.01f; }
            if (sl == 16) return (float)(maxs(6) - maxs(3)) * 0.01f;
            return (float)(maxs(sl) - maxs(sl - 1)) * 0.01f; };
        const float va = rintf(dur(PR_A) * 0.1f + (PR_OFF)) * 0.1f, vb = rintf(dur(PR_B) * 0.1f + (PR_OFF)) * 10.0f;
        for (size_t i = (size_t)F.c * NTHR + F.tid; i < (size_t)T * D; i += (size_t)F.G * NTHR) F.out[i] = va;
        __syncthreads();
        if (F.c == 0 && F.tid == 0) F.out[12345] = vb;
    }
    return;
#endif
    if (F.c == 0 && F.tid == 0 && hi == N_PHASES) { if (xb_ld(&F.ctl[XB_TMO]) != 0u) F.out[0] = __builtin_nanf(""); }
#undef IN
#undef SEAM
}

extern "C" void kernel_launch(void* const* d_in, const int* in_sizes, int n_in, void* d_out, int out_size, void* d_ws, size_t ws_size, hipStream_t stream) {
    static int grid = 0;
    if (grid == 0) {
        if (n_in != 22 || out_size != T * D || ws_size < WS_END) { fprintf(stderr, "kernel_launch: unexpected shapes (n_in %d, out %d, ws %zu)\n", n_in, out_size, ws_size); grid = -1; return; }
        int dev = 0, cus = 0, per_cu = 0;
        if (hipGetDevice(&dev) != hipSuccess || hipDeviceGetAttribute(&cus, hipDeviceAttributeMultiprocessorCount, dev) != hipSuccess) { grid = -1; return; }
        if (hipFuncSetAttribute((const void*)mega_fwd, hipFuncAttributeMaxDynamicSharedMemorySize, LDS_BYTES) != hipSuccess) { fprintf(stderr, "kernel_launch: hipFuncSetAttribute failed\n"); grid = -1; return; }
        if (hipOccupancyMaxActiveBlocksPerMultiprocessor(&per_cu, (const void*)mega_fwd, NTHR, LDS_BYTES) != hipSuccess || per_cu < 1) fprintf(stderr, "kernel_launch: occupancy query reports %d blocks per CU\n", per_cu);
        (void)hipGetLastError();
        grid = cus;
    }
    if (grid < 0) return;
    (void)hipMemsetAsync((char*)d_ws + WS_CTL, 0, CTL_BYTES, stream);
    Args a{};
    for (int i = 0; i < 22; ++i) a.in[i] = (const float*)d_in[i];
    a.out = (float*)d_out; a.ws = (unsigned char*)d_ws; a.ph_lo = 0; a.ph_hi = N_PHASES;
#ifdef DBG_K
    a.ph_hi = DBG_K;
#endif
    hipLaunchKernelGGL(mega_fwd, dim3(grid), dim3(NTHR), LDS_BYTES, stream, a);
}
```
